# Optimizing an MI355X kernel written in HIP

```python
import math
import jax, jax.numpy as jnp
from jax import lax
import numpy as np

D_MODEL = 1024
BATCH = 4
SEQ = 8192
DEPTH = 1
DEC_BATCH = 2
DEC_SEQ = 8192
PAST_LEN = 128

HEAD_DIM = 64
ATTN_GROUPS = ((128, 1), (512, 4), (2048, 16))
N_ATTN_GROUPS = len(ATTN_GROUPS)
HEADS_PER_GROUP = D_MODEL // 128
D_ATTN = HEADS_PER_GROUP * HEAD_DIM
QKV_W = N_ATTN_GROUPS * HEADS_PER_GROUP * HEAD_DIM
BLOCK_Q = 128
ROPE_THETA = 10000.0
D_SSM = D_MODEL // 2
SSM_GROUP_CH = 16
SSM_GROUPS = D_SSM // SSM_GROUP_CH
SSM_STATE = 64
N_DIR = 2
IN_COLS = 3 * QKV_W + D_ATTN + 2 * D_SSM + 2 * D_MODEL
EPS = 1e-6
NEG = -1e30

kernel_name = "hybrid_dilated_attn_s5_encoder"


def rms_norm(x, g):
    xf = x.astype(jnp.float32)
    xf = xf * lax.rsqrt(jnp.mean(xf * xf, axis=-1, keepdims=True) + EPS)
    return (xf * g.astype(jnp.float32)).astype(x.dtype)


def rope(t, pos):
    half = HEAD_DIM // 2
    inv = jnp.float32(ROPE_THETA) ** (-jnp.arange(half, dtype=jnp.float32) / half)
    ang = pos[:, None] * inv[None, :]
    cos = jnp.cos(ang)[None, :, None, None, :]
    sin = jnp.sin(ang)[None, :, None, None, :]
    tf = t.astype(jnp.float32)
    t1, t2 = tf[..., :half], tf[..., half:]
    return jnp.concatenate([t1 * cos - t2 * sin, t2 * cos + t1 * sin], axis=-1).astype(t.dtype)


def dilated_attention(q, k, v):
    B_, L = q.shape[0], q.shape[1]
    dt = q.dtype
    scale = HEAD_DIM ** -0.5
    padded = []
    for g, (w, d) in enumerate(ATTN_GROUPS):
        half = w // (2 * d)
        pad = ((0, 0), (half * d, half * d), (0, 0), (0, 0))
        padded.append((jnp.pad(k[:, :, g], pad), jnp.pad(v[:, :, g], pad)))

    def block(s):
        qb = lax.dynamic_slice_in_dim(q, s, BLOCK_Q, axis=1)
        qpos = s + jnp.arange(BLOCK_Q)
        outs, lses = [], []
        for g, (w, d) in enumerate(ATTN_GROUPS):
            half = w // (2 * d)
            nk = 2 * half + 1
            span = BLOCK_Q + 2 * half * d
            kp, vp = padded[g]
            ks = lax.dynamic_slice_in_dim(kp, s, span, axis=1)
            vs = lax.dynamic_slice_in_dim(vp, s, span, axis=1)
            idx = jnp.arange(BLOCK_Q)[:, None] + d * jnp.arange(nk)[None, :]
            kg = ks[:, idx]
            vg = vs[:, idx]
            kpos = qpos[:, None] + d * (jnp.arange(nk)[None, :] - half)
            valid = (kpos >= 0) & (kpos < L)
            logits = jnp.einsum('bqhd,bqkhd->bhqk', qb[:, :, g].astype(jnp.float32),
                                kg.astype(jnp.float32)) * scale
            logits = jnp.where(valid[None, None], logits, NEG)
            m = jnp.max(logits, axis=-1, keepdims=True)
            p = jnp.exp(logits - m)
            den = jnp.sum(p, axis=-1)
            o = jnp.einsum('bhqk,bqkhd->bqhd', p, vg.astype(jnp.float32))
            o = o / jnp.transpose(den, (0, 2, 1))[..., None]
            outs.append(o)
            lses.append(m[..., 0] + jnp.log(den))
        alpha = jax.nn.softmax(jnp.stack(lses, axis=0), axis=0)
        alpha = jnp.transpose(alpha, (0, 1, 3, 2))[..., None]
        return jnp.sum(alpha * jnp.stack(outs, axis=0), axis=0).astype(dt)

    starts = jnp.arange(L // BLOCK_Q, dtype=jnp.int32) * BLOCK_Q
    res = lax.map(block, starts)
    return jnp.transpose(res, (1, 0, 2, 3, 4)).reshape(B_, L, D_ATTN)


def _scan_op(e1, e2):
    a1, b1 = e1
    a2, b2 = e2
    return a1 * a2, a2 * b1 + b2


def s5_bidirectional(u, lam_re, lam_im, log_step, b_re, b_im, c_re, c_im, d_skip):
    B_, L, _ = u.shape
    uf = u.astype(jnp.float32)
    ug = uf.reshape(B_, L, SSM_GROUPS, SSM_GROUP_CH).astype(jnp.complex64)
    y = (d_skip.astype(jnp.float32) * uf).reshape(B_, L, SSM_GROUPS, SSM_GROUP_CH)
    for r in range(N_DIR):
        lam = lax.complex(lam_re[r].astype(jnp.float32), lam_im[r].astype(jnp.float32))
        step = jnp.exp(log_step[r].astype(jnp.float32))[:, None]
        lam_bar = jnp.exp(lam * step)
        bmat = lax.complex(b_re[r].astype(jnp.float32), b_im[r].astype(jnp.float32))
        b_bar = ((lam_bar - 1.0) / lam)[..., None] * bmat
        bu = jnp.einsum('blgc,gnc->lbgn', ug, b_bar)
        a = jnp.broadcast_to(lam_bar[None, None], (L, 1, SSM_GROUPS, SSM_STATE))
        _, h = lax.associative_scan(_scan_op, (a, bu), reverse=(r == 1), axis=0)
        cmat = lax.complex(c_re[r].astype(jnp.float32), c_im[r].astype(jnp.float32))
        y = y + jnp.real(jnp.einsum('lbgn,gcn->blgc', h, cmat))
    return y.reshape(B_, L, D_SSM).astype(u.dtype)


def encoder_layer(x, norm_g, w_in, lam_re, lam_im, log_step, b_re, b_im, c_re, c_im,
                  d_skip, w_glu, w_branch_a, w_branch_b, w_out):
    B_, L, _ = x.shape
    dt = x.dtype
    h = rms_norm(x, norm_g)
    proj = h @ w_in
    offs = np.cumsum([QKV_W, QKV_W, QKV_W, D_ATTN, D_SSM, D_SSM, D_MODEL]).tolist()
    q, k, v, z_a, u, z_b, g_a, g_b = jnp.split(proj, offs, axis=-1)
    shp = (B_, L, N_ATTN_GROUPS, HEADS_PER_GROUP, HEAD_DIM)
    pos = jnp.arange(L, dtype=jnp.float32)
    q = rope(q.reshape(shp), pos)
    k = rope(k.reshape(shp), pos)
    v = v.reshape(shp)
    attn = dilated_attention(q, k, v)
    a = (attn * jax.nn.silu(z_a)) @ w_branch_a
    s = jax.nn.gelu(s5_bidirectional(u, lam_re, lam_im, log_step, b_re, b_im, c_re, c_im, d_skip))
    s = s * jax.nn.sigmoid(s @ w_glu)
    b = (s * jax.nn.silu(z_b)) @ w_branch_b
    merged = jax.nn.sigmoid(g_a) * a + jax.nn.sigmoid(g_b) * b
    return (x + merged @ w_out).astype(dt)


def trunk(x, norm_g, w_in, lam_re, lam_im, log_step, b_re, b_im, c_re, c_im,
          d_skip, w_glu, w_branch_a, w_branch_b, w_out, final_g):
    for i in range(DEPTH):
        x = encoder_layer(x, norm_g[i], w_in[i], lam_re[i], lam_im[i], log_step[i],
                          b_re[i], b_im[i], c_re[i], c_im[i], d_skip[i], w_glu[i],
                          w_branch_a[i], w_branch_b[i], w_out[i])
    return rms_norm(x, final_g)


def setup_inputs(seed: int = 0) -> dict:
    key = jax.random.key(seed)
    ks = jax.random.split(key, 20)
    f32 = jnp.float32
    G, N, C = SSM_GROUPS, SSM_STATE, SSM_GROUP_CH
    nrm = lambda k, s, sc: jax.random.normal(k, s, f32) * sc
    x_prompt = jax.random.normal(ks[0], (BATCH, SEQ, D_MODEL), f32)
    x_sample = jax.random.normal(ks[1], (DEC_BATCH, DEC_SEQ, D_MODEL), f32)
    norm_g = 1.0 + nrm(ks[2], (DEPTH, D_MODEL), 0.02)
    w_in = nrm(ks[3], (DEPTH, D_MODEL, IN_COLS), D_MODEL ** -0.5)
    lam_re = -0.5 + nrm(ks[4], (DEPTH, N_DIR, G, N), 0.01)
    lam_im = math.pi * jnp.arange(N, dtype=f32) + nrm(ks[5], (DEPTH, N_DIR, G, N), 0.01)
    log_step = jax.random.uniform(ks[6], (DEPTH, N_DIR, G), f32,
                                  math.log(1e-3), math.log(1e-1))
    b_re = nrm(ks[7], (DEPTH, N_DIR, G, N, C), (2.0 * C) ** -0.5)
    b_im = nrm(ks[8], (DEPTH, N_DIR, G, N, C), (2.0 * C) ** -0.5)
    c_re = nrm(ks[9], (DEPTH, N_DIR, G, C, N), (2.0 * N) ** -0.5 * 4.0)
    c_im = nrm(ks[10], (DEPTH, N_DIR, G, C, N), (2.0 * N) ** -0.5 * 4.0)
    d_skip = nrm(ks[11], (DEPTH, D_SSM), 1.0)
    w_glu = nrm(ks[12], (DEPTH, D_SSM, D_SSM), D_SSM ** -0.5)
    w_branch_a = nrm(ks[13], (DEPTH, D_ATTN, D_MODEL), D_ATTN ** -0.5)
    w_branch_b = nrm(ks[14], (DEPTH, D_SSM, D_MODEL), D_SSM ** -0.5)
    w_out = nrm(ks[15], (DEPTH, D_MODEL, D_MODEL), D_MODEL ** -0.5)
    final_g = 1.0 + nrm(ks[16], (D_MODEL,), 0.02)
    return {"x_prompt": x_prompt, "x_sample": x_sample, "norm_g": norm_g, "w_in": w_in,
            "lam_re": lam_re, "lam_im": lam_im, "log_step": log_step,
            "b_re": b_re, "b_im": b_im, "c_re": c_re, "c_im": c_im,
            "d_skip": d_skip, "w_glu": w_glu, "w_branch_a": w_branch_a,
            "w_branch_b": w_branch_b, "w_out": w_out, "final_g": final_g}


def reference(x_prompt, x_sample, norm_g, w_in, lam_re, lam_im, log_step, b_re, b_im,
              c_re, c_im, d_skip, w_glu, w_branch_a, w_branch_b, w_out, final_g):
    y_prompt = trunk(x_prompt, norm_g, w_in, lam_re, lam_im, log_step, b_re, b_im, c_re, c_im,
                     d_skip, w_glu, w_branch_a, w_branch_b, w_out, final_g)
    y_sample = trunk(x_sample, norm_g, w_in, lam_re, lam_im, log_step, b_re, b_im, c_re, c_im,
                     d_skip, w_glu, w_branch_a, w_branch_b, w_out, final_g)
    return (y_prompt, y_sample)
```

```cpp
#include <hip/hip_runtime.h>
#include <hip/hip_cooperative_groups.h>
#include <cstdio>

namespace cg = cooperative_groups;

#define LAS __attribute__((address_space(3)))
typedef unsigned short bf16_t;
typedef short bf16x8 __attribute__((ext_vector_type(8)));
typedef short bf16x4 __attribute__((ext_vector_type(4)));
typedef float f32x4 __attribute__((ext_vector_type(4)));
typedef float f32x2 __attribute__((ext_vector_type(2)));
typedef unsigned u32x4 __attribute__((ext_vector_type(4)));
typedef unsigned u32x2 __attribute__((ext_vector_type(2)));

constexpr int DM = 1024, SEQL = 8192, NSEQ = 6, TTOK = NSEQ * SEQL;
constexpr int NPASS = 2, SEQP = 3, TP = SEQP * SEQL;
constexpr int INC = 8192, QKVW = 1536;
constexpr int LC = 32, NCH = SEQL / LC  , CHP = SEQP * NCH  ;
constexpr int UHK = LC * 16 + 256;
constexpr float EPSN = 1e-6f;
constexpr float QSCALE = 0.18033688011112042f;

constexpr size_t AL(size_t x) { return (x + 255) & ~(size_t)255; }
constexpr size_t WS_CTL = 0;
constexpr size_t WS_WIN = 4096;
constexpr size_t WS_WGLU = WS_WIN + (size_t)INC * DM * 2;
constexpr size_t WS_WA = WS_WGLU + (size_t)512 * 512 * 2;
constexpr size_t WS_WB = WS_WA + (size_t)1024 * 512 * 2;
constexpr size_t WS_WOUT = WS_WB + (size_t)1024 * 512 * 2;
constexpr size_t WS_MTC = WS_WOUT + (size_t)1024 * 1024 * 2;
constexpr size_t WS_BST = WS_MTC + (size_t)32 * 512 * UHK * 2;
constexpr size_t WS_ROPE = WS_BST + (size_t)32 * 256 * 512 * 2;
constexpr size_t WS_PW = WS_ROPE + (size_t)2 * SEQL * 32 * 4;
constexpr size_t WS_KT = WS_PW + (size_t)2 * 32 * 64 * 8;
constexpr size_t WS_Q = WS_KT + (size_t)32 * 2 * 32 * 256 * 4;
constexpr size_t WS_K = WS_Q + (size_t)TP * QKVW * 2;
constexpr size_t WS_VT = WS_K + (size_t)TP * QKVW * 2;
constexpr size_t WS_ZA = WS_VT + (size_t)TP * QKVW * 2;
constexpr size_t WS_ZB = WS_ZA + (size_t)TP * 512 * 2;
constexpr size_t WS_GA = WS_ZB + (size_t)TP * 512 * 2;
constexpr size_t WS_GB = WS_GA + (size_t)TP * 1024 * 2;
constexpr size_t WS_UH = WS_GB + (size_t)TP * 1024 * 2;
constexpr size_t WS_S = WS_UH + (size_t)32 * CHP * UHK * 2;
constexpr size_t WS_GAO = WS_S + (size_t)32 * CHP * 256 * 4;
constexpr size_t WS_END = WS_GAO + (size_t)TP * 512 * 2;
constexpr size_t WS_SG = WS_Q;
constexpr size_t WS_SB = WS_Q + (size_t)TP * 512 * 2;
constexpr size_t WS_M1 = WS_K;
constexpr size_t OUT_HN_OFF = (size_t)SEQP * SEQL * DM * 4;

struct Args {
    const float* in[17];
    float* out;
    unsigned char* ws;
    int st_lo, st_hi;
    int do_sync, pad;
};

typedef __bf16 bf16v2 __attribute__((ext_vector_type(2)));
__device__ __forceinline__ unsigned cvt_pk_bf16(float lo, float hi) { const f32x2 v = (f32x2){lo, hi}; const bf16v2 r = __builtin_convertvector(v, bf16v2); return __builtin_bit_cast(unsigned, r); }
__device__ __forceinline__ float bf_lo(unsigned w) { return __uint_as_float(w << 16); }
__device__ __forceinline__ float bf_hi(unsigned w) { return __uint_as_float(w & 0xffff0000u); }
__device__ __forceinline__ float fast_rcp(float x) { return __builtin_amdgcn_rcpf(x); }
__device__ __forceinline__ float sigmoidf_(float x) { return fast_rcp(1.0f + __builtin_amdgcn_exp2f(-1.4426950408889634f * x)); }
__device__ __forceinline__ float siluf_(float x) { return x * sigmoidf_(x); }
__device__ __forceinline__ float gelu_tanh(float x) { const float u = x * (1.5957691216057308f + 0.07135481627260025f * x * x); return x * sigmoidf_(u); }
__device__ __forceinline__ float wave_sum(float v) {
#pragma unroll
    for (int o = 1; o < 64; o <<= 1) v += __shfl_xor(v, o);
    return v;
}
__device__ __forceinline__ const float* xrow_ptr(const float* xp, const float* xs, int tg) {
    return tg < 4 * SEQL ? xp + (size_t)tg * DM : xs + (size_t)(tg - 4 * SEQL) * DM;
}

constexpr int BM = 256, BK = 64, HALF = 128, HTB = HALF * BK * 2, STAGE_BYTES = 8 * HTB, NXCD = 8, WGM = 8;
__host__ __device__ __forceinline__ int lds_byte(int r, int c) { const int st = (r >> 4) * 2 + (c >> 5), rr = r & 15, cc = c & 31, ob = rr * 64 + cc * 2; return st * 1024 + (ob ^ (((ob >> 9) & 1) << 5)); }
__host__ __device__ __forceinline__ void stage_rc(int b, int& R, int& C) { const int st = b / 1024, sb = b % 1024, swz = sb ^ (((sb >> 9) & 1) << 5); R = (st >> 1) * 16 + swz / 64; C = (st & 1) * 32 + (swz % 64) / 2; }
__host__ __device__ __forceinline__ int perm32(int rho) { const int n = rho >> 4, i = rho & 15; return 8 * (i >> 2) + 4 * n + (i & 3); }

enum { MODE_PROJ = 0, MODE_S = 1, MODE_Y = 2, MODE_GLU = 3, MODE_A = 4, MODE_B = 5, MODE_OUT = 6 };
struct Unit { int pm, pn, bz; };
struct GemmD {
    const bf16_t* A; const bf16_t* Bt;
    int lda, ldb, K, nM, nN, nb;
    size_t sA, sB;
    int mode, pass;
    unsigned char* ws; float* out; const float* xp; const float* xs;
};
__device__ __forceinline__ bool unit_next(const GemmD& g, int i, int G, int c, int& pm, int& pn, int& bz) {
    const int nwg = g.nM * g.nN;
    const long L = (long)i * G + c; const bool ok = L < (long)nwg * g.nb;
    const int Li = ok ? (int)L : 0;
    int wgid = Li; { const int q = nwg / NXCD, r = nwg % NXCD, xcd = wgid % NXCD, off = wgid / NXCD; wgid = (xcd < r ? xcd * (q + 1) : r * (q + 1) + (xcd - r) * q) + off; }
    const int nig = WGM * g.nN, gid = wgid / nig, fm = gid * WGM, gsz = (g.nM - fm) < WGM ? (g.nM - fm) : WGM;
    const int pm1 = fm + ((wgid % nig) % gsz), pn1 = (wgid % nig) / gsz;
    const int w = Li % nwg, bz2 = Li / nwg, pm2 = w % g.nM, pn2 = w / g.nM;
    const bool single = g.nb == 1;
    pm = single ? pm1 : pm2; pn = single ? pn1 : pn2; bz = single ? 0 : bz2;
    return ok;
}

__device__ __forceinline__ void epilogue(const GemmD& g, const f32x4 (&acc)[2][2][4][2], const Unit& u, int wr, int wc, int fr, int fq) {
    asm volatile("" : "+v"(fr), "+v"(fq));
    unsigned char* ws = g.ws;
    const int rbase = u.pm * BM + wr * 64 + fr;
    const int cl = wc * 32 + fq * 8;
    if (g.mode == MODE_PROJ) {
        const int pn = u.pn;
        if (pn < 12) {
            const bool isq = pn < 6;
            bf16_t* dst = (bf16_t*)(ws + (isq ? WS_Q : WS_K));
            const float* rc = (const float*)(ws + WS_ROPE); const float* rs = rc + SEQL * 32;
            const int a4 = 4 * (4 * (wc & 1) + fq);
            const int cbase = (isq ? pn : pn - 6) * 256 + 64 * (wc >> 1) + a4;
            const float sc = isq ? QSCALE : 1.0f;
#pragma unroll
            for (int ai = 0; ai < 2; ++ai)
#pragma unroll
                for (int m = 0; m < 4; ++m) { asm volatile("" ::: "memory");
                    const int tl = rbase + ai * HALF + m * 16; const int pos = tl & (SEQL - 1);
                    const f32x4 cv = *(const f32x4*)(rc + pos * 32 + a4) * sc, sv = *(const f32x4*)(rs + pos * 32 + a4) * sc;
#pragma unroll
                    for (int bj = 0; bj < 2; ++bj) {
                        const f32x4 x1 = acc[ai][bj][m][0], x2 = acc[ai][bj][m][1];
                        const f32x4 o1 = x1 * cv - x2 * sv, o2 = x2 * cv + x1 * sv;
                        bf16_t* p = dst + (size_t)tl * QKVW + cbase + bj * HALF;
                        u32x2 w1, w2; w1.x = cvt_pk_bf16(o1[0], o1[1]); w1.y = cvt_pk_bf16(o1[2], o1[3]); w2.x = cvt_pk_bf16(o2[0], o2[1]); w2.y = cvt_pk_bf16(o2[2], o2[3]);
                        *(u32x2*)p = w1; *(u32x2*)(p + 32) = w2;
                    }
                }
        } else if (pn < 18) {
            bf16_t* dst = (bf16_t*)(ws + WS_VT);
            const int gi = (pn - 12) >> 1, sh = 2 * gi, dmask = (1 << sh) - 1, Lg = SEQL >> sh;
            const int d0 = 32 * (wc & 1) + 8 * fq;
#pragma unroll
            for (int ai = 0; ai < 2; ++ai)
#pragma unroll
                for (int m = 0; m < 4; ++m) { asm volatile("" ::: "memory");
                    const int tl = rbase + ai * HALF + m * 16; const int pos = tl & (SEQL - 1), sq = tl >> 13;
                    const int kidx = (pos & dmask) * Lg + (pos >> sh);
#pragma unroll
                    for (int bj = 0; bj < 2; ++bj) {
                        const int h = (4 * (pn - 12) + 2 * bj + (wc >> 1)) & 7;
                        bf16_t* p = dst + ((size_t)(((sq * 3 + gi) * 8 + h) * 512 + (kidx >> 4)) * 1024) + d0 * 16 + (kidx & 15);
#pragma unroll
                        for (int n = 0; n < 2; ++n)
#pragma unroll
                            for (int j = 0; j < 4; ++j) { const unsigned w = cvt_pk_bf16(acc[ai][bj][m][n][j], 0.f); p[(n * 4 + j) * 16] = (bf16_t)(w & 0xffffu); }
                    }
                }
        } else if (pn == 20 || pn == 21) {
            bf16_t* dst = (bf16_t*)(ws + WS_UH);
#pragma unroll
            for (int ai = 0; ai < 2; ++ai)
#pragma unroll
                for (int m = 0; m < 4; ++m) { asm volatile("" ::: "memory");
                    const int tl = rbase + ai * HALF + m * 16;
#pragma unroll
                    for (int bj = 0; bj < 2; ++bj) {
                        const int gg = 16 * (pn - 20) + 8 * bj + 2 * wc + (fq >> 1);
                        bf16_t* p = dst + ((size_t)(gg * CHP + (tl >> 5)) * UHK) + (tl & 31) * 16 + 8 * (fq & 1);
                        const f32x4 v0 = acc[ai][bj][m][0], v1 = acc[ai][bj][m][1];
                        u32x4 w; w.x = cvt_pk_bf16(v0[0], v0[1]); w.y = cvt_pk_bf16(v0[2], v0[3]); w.z = cvt_pk_bf16(v1[0], v1[1]); w.w = cvt_pk_bf16(v1[2], v1[3]);
                        *(u32x4*)p = w;
                    }
                }
        } else {
            bf16_t* dst; int ld, c0; bool silu;
            if (pn < 20) { dst = (bf16_t*)(ws + WS_ZA); ld = 512; c0 = (pn - 18) * 256; silu = true; }
            else if (pn < 24) { dst = (bf16_t*)(ws + WS_ZB); ld = 512; c0 = (pn - 22) * 256; silu = true; }
            else if (pn < 28) { dst = (bf16_t*)(ws + WS_GA); ld = 1024; c0 = (pn - 24) * 256; silu = false; }
            else { dst = (bf16_t*)(ws + WS_GB); ld = 1024; c0 = (pn - 28) * 256; silu = false; }
#pragma unroll
            for (int ai = 0; ai < 2; ++ai)
#pragma unroll
                for (int m = 0; m < 4; ++m) { asm volatile("" ::: "memory");
                    const int tl = rbase + ai * HALF + m * 16;
#pragma unroll
                    for (int bj = 0; bj < 2; ++bj) {
                        f32x4 v0 = acc[ai][bj][m][0], v1 = acc[ai][bj][m][1];
#pragma unroll
                        for (int j = 0; j < 4; ++j) { const float s0 = sigmoidf_(v0[j]), s1 = sigmoidf_(v1[j]); v0[j] = silu ? v0[j] * s0 : s0; v1[j] = silu ? v1[j] * s1 : s1; }
                        u32x4 w; w.x = cvt_pk_bf16(v0[0], v0[1]); w.y = cvt_pk_bf16(v0[2], v0[3]); w.z = cvt_pk_bf16(v1[0], v1[1]); w.w = cvt_pk_bf16(v1[2], v1[3]);
                        *(u32x4*)(dst + (size_t)tl * ld + c0 + cl + bj * HALF) = w;
                    }
                }
        }
    } else if (g.mode == MODE_S) {
        float* dst = (float*)(ws + WS_S) + (size_t)u.bz * CHP * 256;
#pragma unroll
        for (int ai = 0; ai < 2; ++ai)
#pragma unroll
            for (int m = 0; m < 4; ++m) { asm volatile("" ::: "memory");
                const int r = rbase + ai * HALF + m * 16;
#pragma unroll
                for (int bj = 0; bj < 2; ++bj) { float* p = dst + (size_t)r * 256 + cl + bj * HALF; *(f32x4*)p = acc[ai][bj][m][0]; *(f32x4*)(p + 4) = acc[ai][bj][m][1]; }
            }
    } else if (g.mode == MODE_Y) {
        bf16_t* dst = (bf16_t*)(ws + WS_SG);
#pragma unroll
        for (int ai = 0; ai < 2; ++ai)
#pragma unroll
            for (int m = 0; m < 4; ++m) { asm volatile("" ::: "memory");
                const int r = rbase + ai * HALF + m * 16;
#pragma unroll
                for (int bj = 0; bj < 2; ++bj) {
                    const int t = 16 * u.pn + 8 * bj + 2 * wc + (fq >> 1);
                    f32x4 v0 = acc[ai][bj][m][0], v1 = acc[ai][bj][m][1];
#pragma unroll
                    for (int j = 0; j < 4; ++j) { v0[j] = gelu_tanh(v0[j]); v1[j] = gelu_tanh(v1[j]); }
                    u32x4 w; w.x = cvt_pk_bf16(v0[0], v0[1]); w.y = cvt_pk_bf16(v0[2], v0[3]); w.z = cvt_pk_bf16(v1[0], v1[1]); w.w = cvt_pk_bf16(v1[2], v1[3]);
                    *(u32x4*)(dst + (size_t)(r * LC + t) * 512 + u.bz * 16 + 8 * (fq & 1)) = w;
                }
            }
    } else if (g.mode == MODE_GLU) {
        const bf16_t* sg = (const bf16_t*)(ws + WS_SG); const bf16_t* zb = (const bf16_t*)(ws + WS_ZB); bf16_t* dst = (bf16_t*)(ws + WS_SB);
#pragma unroll
        for (int ai = 0; ai < 2; ++ai)
#pragma unroll
            for (int m = 0; m < 4; ++m) { asm volatile("" ::: "memory");
                const int tl = rbase + ai * HALF + m * 16;
#pragma unroll
                for (int bj = 0; bj < 2; ++bj) {
                    const size_t off = (size_t)tl * 512 + u.pn * BM + cl + bj * HALF;
                    const u32x4 s4 = *(const u32x4*)(sg + off), z4 = *(const u32x4*)(zb + off);
                    const f32x4 v0 = acc[ai][bj][m][0], v1 = acc[ai][bj][m][1];
                    u32x4 w;
                    w.x = cvt_pk_bf16(bf_lo(s4.x) * sigmoidf_(v0[0]) * bf_lo(z4.x), bf_hi(s4.x) * sigmoidf_(v0[1]) * bf_hi(z4.x));
                    w.y = cvt_pk_bf16(bf_lo(s4.y) * sigmoidf_(v0[2]) * bf_lo(z4.y), bf_hi(s4.y) * sigmoidf_(v0[3]) * bf_hi(z4.y));
                    w.z = cvt_pk_bf16(bf_lo(s4.z) * sigmoidf_(v1[0]) * bf_lo(z4.z), bf_hi(s4.z) * sigmoidf_(v1[1]) * bf_hi(z4.z));
                    w.w = cvt_pk_bf16(bf_lo(s4.w) * sigmoidf_(v1[2]) * bf_lo(z4.w), bf_hi(s4.w) * sigmoidf_(v1[3]) * bf_hi(z4.w));
                    *(u32x4*)(dst + off) = w;
                }
            }
    } else if (g.mode == MODE_A || g.mode == MODE_B) {
        const bool isb = g.mode == MODE_B;
        const bf16_t* gt = (const bf16_t*)(ws + (isb ? WS_GB : WS_GA)); bf16_t* dst = (bf16_t*)(ws + WS_M1);
#pragma unroll
        for (int ai = 0; ai < 2; ++ai)
#pragma unroll
            for (int m = 0; m < 4; ++m) { asm volatile("" ::: "memory");
                const int tl = rbase + ai * HALF + m * 16;
#pragma unroll
                for (int bj = 0; bj < 2; ++bj) {
                    const size_t off = (size_t)tl * 1024 + u.pn * BM + cl + bj * HALF;
                    const u32x4 g4 = *(const u32x4*)(gt + off);
                    u32x4 p4 = (u32x4){0u, 0u, 0u, 0u}; if (isb) p4 = *(const u32x4*)(dst + off);
                    f32x4 v0 = acc[ai][bj][m][0], v1 = acc[ai][bj][m][1];
#ifdef DBG_NOA
                    if (!isb) { v0 = v0 * 0.f; v1 = v1 * 0.f; v0 = (f32x4){0.f,0.f,0.f,0.f}; v1 = v0; }
#endif
#ifdef DBG_NOB
                    if (isb) { v0 = (f32x4){0.f,0.f,0.f,0.f}; v1 = v0; }
#endif
                    u32x4 w;
                    w.x = cvt_pk_bf16(bf_lo(p4.x) + bf_lo(g4.x) * v0[0], bf_hi(p4.x) + bf_hi(g4.x) * v0[1]);
                    w.y = cvt_pk_bf16(bf_lo(p4.y) + bf_lo(g4.y) * v0[2], bf_hi(p4.y) + bf_hi(g4.y) * v0[3]);
                    w.z = cvt_pk_bf16(bf_lo(p4.z) + bf_lo(g4.z) * v1[0], bf_hi(p4.z) + bf_hi(g4.z) * v1[1]);
                    w.w = cvt_pk_bf16(bf_lo(p4.w) + bf_lo(g4.w) * v1[2], bf_hi(p4.w) + bf_hi(g4.w) * v1[3]);
                    *(u32x4*)(dst + off) = w;
                }
            }
    } else {
#pragma unroll
        for (int ai = 0; ai < 2; ++ai)
#pragma unroll
            for (int m = 0; m < 4; ++m) { asm volatile("" ::: "memory");
                const int tg = g.pass * TP + rbase + ai * HALF + m * 16;
                const float* xr = xrow_ptr(g.xp, g.xs, tg); float* orow = g.out + (size_t)tg * DM;
#pragma unroll
                for (int bj = 0; bj < 2; ++bj) {
                    const int c = u.pn * BM + cl + bj * HALF;
                    const f32x4 a0 = *(const f32x4*)(xr + c), a1 = *(const f32x4*)(xr + c + 4);
                    *(f32x4*)(orow + c) = a0 + acc[ai][bj][m][0]; *(f32x4*)(orow + c + 4) = a1 + acc[ai][bj][m][1];
                }
            }
    }
}

__device__ __forceinline__ void gemm_phase(LAS unsigned char* lds, const GemmD& g, int G, int cidx, int tid) {
    const int wid = __builtin_amdgcn_readfirstlane(tid >> 6), lane = tid & 63, wr = wid >> 2, wc = wid & 3, fr = lane & 15, fq = lane >> 4;
    const int K = g.K, nt = K / BK;
    unsigned voffA[2], voffB[2];
#pragma unroll
    for (int i = 0; i < 2; ++i) { int R, C; stage_rc(tid * 16 + i * 8192, R, C); const int Rb = (R & ~31) + perm32(R & 31);
        voffA[i] = (unsigned)(R * g.lda + C) * 2u; voffB[i] = (unsigned)(Rb * g.ldb + C) * 2u; }
    const size_t kstep = (size_t)(BK * 2);
    const size_t hstepA = (size_t)HALF * g.lda * 2, hstepB = (size_t)HALF * g.ldb * 2;
    const size_t tstepA = 2 * hstepA, tstepB = 2 * hstepB;
    const unsigned ldsw = (unsigned)wid * 1024u;
    const int aoff = lds_byte(wr * 64 + fr, fq * 8), boff = lds_byte(wc * 32 + fr, fq * 8);
#define PG8_SA(b, h) (((b) * 2 + (h)) * HTB)
#define PG8_SB(b, h) ((4 + (b) * 2 + (h)) * HTB)
#define PG8_STAGE(bufoff, gbase, voff) do { _Pragma("unroll") for (int _i = 0; _i < 2; ++_i) \
        __builtin_amdgcn_global_load_lds((const unsigned*)((const char*)(gbase) + (voff)[_i]), (LAS unsigned*)(lds + (bufoff) + ldsw + _i * 8192), 16, 0, 0); } while (0)
#define PG8_LDA(dst, b, h) do { _Pragma("unroll") for (int m = 0; m < 4; ++m) _Pragma("unroll") for (int k = 0; k < 2; ++k) dst[m][k] = *(const LAS bf16x8*)(lds + PG8_SA(b, h) + aoff + m * 2048 + k * 1024); } while (0)
#define PG8_LDB(dst, b, h) do { _Pragma("unroll") for (int n = 0; n < 2; ++n) _Pragma("unroll") for (int k = 0; k < 2; ++k) dst[n][k] = *(const LAS bf16x8*)(lds + PG8_SB(b, h) + boff + n * 2048 + k * 1024); } while (0)
#define PG8_MMA(ai, bj, At, Bt) do { __builtin_amdgcn_s_setprio(1); _Pragma("unroll") for (int m = 0; m < 4; ++m) _Pragma("unroll") for (int n = 0; n < 2; ++n) _Pragma("unroll") for (int k = 0; k < 2; ++k) \
        acc[ai][bj][m][n] = __builtin_amdgcn_mfma_f32_16x16x32_bf16(Bt[n][k], At[m][k], acc[ai][bj][m][n], 0, 0, 0); __builtin_amdgcn_s_setprio(0); } while (0)
#define PG8_WAIT_V(n) asm volatile("s_waitcnt vmcnt(" #n ")" ::: "memory")
#define PG8_WAIT_L(n) asm volatile("s_waitcnt lgkmcnt(" #n ")" ::: "memory")
#define PG8_BAR __builtin_amdgcn_s_barrier()
#define PG8_SCHED __builtin_amdgcn_sched_barrier(0)
    Unit cur, nxt; int ui = 0;
    { int pm_, pn_, bz_; if (!unit_next(g, 0, G, cidx, pm_, pn_, bz_)) return; cur.pm = pm_; cur.pn = pn_; cur.bz = bz_; }
    f32x4 acc[2][2][4][2];
#pragma unroll
    for (int a = 0; a < 2; ++a)
#pragma unroll
        for (int b = 0; b < 2; ++b)
#pragma unroll
            for (int m = 0; m < 4; ++m)
#pragma unroll
                for (int n = 0; n < 2; ++n) acc[a][b][m][n] = (f32x4){0.f, 0.f, 0.f, 0.f};
    bf16x8 At[4][2], B0[2][2], B1[2][2];
    const char* cA = (const char*)g.A + (size_t)cur.bz * g.sA + (size_t)cur.pm * tstepA; const char* cB = (const char*)g.Bt + (size_t)cur.bz * g.sB + (size_t)cur.pn * tstepB;
    PG8_STAGE(PG8_SB(0, 0), cB, voffB); PG8_STAGE(PG8_SA(0, 0), cA, voffA); PG8_STAGE(PG8_SB(0, 1), cB + hstepB, voffB); PG8_STAGE(PG8_SA(0, 1), cA + hstepA, voffA);
    if (wr == 1) PG8_BAR;
    PG8_WAIT_V(4); PG8_BAR;
    PG8_STAGE(PG8_SB(1, 0), cB + kstep, voffB); PG8_STAGE(PG8_SA(1, 0), cA + kstep, voffA); PG8_STAGE(PG8_SB(1, 1), cB + hstepB + kstep, voffB);
    PG8_WAIT_V(6); PG8_BAR;
    for (;;) {
        int npm, npn, nbz; const bool has_next = unit_next(g, ui + 1, G, cidx, npm, npn, nbz); nxt.pm = npm; nxt.pn = npn; nxt.bz = nbz;
        const char* nA = has_next ? (const char*)g.A + (size_t)nxt.bz * g.sA + (size_t)nxt.pm * tstepA : cA; const char* nB = has_next ? (const char*)g.Bt + (size_t)nxt.bz * g.sB + (size_t)nxt.pn * tstepB : cB;
        for (int t = 0; t < nt; t += 2) {
            const bool last = (t == nt - 2);
            const char* a1 = cA + (size_t)(t + 1) * kstep;
            const char* a2 = last ? nA : cA + (size_t)(t + 2) * kstep; const char* b2 = last ? nB : cB + (size_t)(t + 2) * kstep;
            const char* a3 = a2 + kstep; const char* b3 = b2 + kstep;
            PG8_LDB(B0, 0, 0); PG8_SCHED; PG8_LDA(At, 0, 0); PG8_STAGE(PG8_SA(1, 1), a1 + hstepA, voffA);
            PG8_WAIT_L(8); PG8_BAR; PG8_WAIT_L(0); PG8_MMA(0, 0, At, B0); PG8_BAR; PG8_SCHED;
            PG8_LDB(B1, 0, 1); PG8_STAGE(PG8_SB(0, 0), b2, voffB);
            PG8_BAR; PG8_WAIT_L(0); PG8_MMA(0, 1, At, B1); PG8_BAR;
            PG8_LDA(At, 0, 1); PG8_STAGE(PG8_SA(0, 0), a2, voffA);
            PG8_BAR; PG8_WAIT_L(0); PG8_MMA(1, 0, At, B0); PG8_BAR; PG8_SCHED;
            PG8_STAGE(PG8_SB(0, 1), b2 + hstepB, voffB);
            PG8_WAIT_V(6); PG8_BAR; PG8_MMA(1, 1, At, B1); PG8_BAR;
            PG8_LDB(B0, 1, 0); PG8_SCHED; PG8_LDA(At, 1, 0); PG8_STAGE(PG8_SA(0, 1), a2 + hstepA, voffA);
            PG8_WAIT_L(8); PG8_BAR; PG8_WAIT_L(0); PG8_MMA(0, 0, At, B0); PG8_BAR; PG8_SCHED;
            PG8_LDB(B1, 1, 1); PG8_STAGE(PG8_SB(1, 0), b3, voffB);
            PG8_BAR; PG8_WAIT_L(0); PG8_MMA(0, 1, At, B1); PG8_BAR;
            PG8_LDA(At, 1, 1); PG8_STAGE(PG8_SA(1, 0), a3, voffA);
            PG8_BAR; PG8_WAIT_L(0); PG8_MMA(1, 0, At, B0); PG8_BAR; PG8_SCHED;
            PG8_STAGE(PG8_SB(1, 1), b3 + hstepB, voffB);
            PG8_WAIT_V(6); PG8_BAR; PG8_MMA(1, 1, At, B1); PG8_BAR;
        }
#ifndef NO_EPI
        epilogue(g, acc, cur, wr, wc, fr, fq);
#else
        if (g.mode == 99) *(f32x4*)(g.out) = acc[0][0][0][0] + acc[1][1][3][1] + acc[0][1][2][0]+acc[1][0][1][1];
#endif
        if (!has_next) break;
#pragma unroll
        for (int a = 0; a < 2; ++a)
#pragma unroll
            for (int b = 0; b < 2; ++b)
#pragma unroll
                for (int m = 0; m < 4; ++m)
#pragma unroll
                    for (int n = 0; n < 2; ++n) acc[a][b][m][n] = (f32x4){0.f, 0.f, 0.f, 0.f};
        cur = nxt; cA = nA; cB = nB; ++ui;
    }
    PG8_WAIT_V(0);
    if (wr == 0) PG8_BAR;
    PG8_BAR;
#undef PG8_SA
#undef PG8_SB
#undef PG8_STAGE
#undef PG8_LDA
#undef PG8_LDB
#undef PG8_MMA
#undef PG8_WAIT_V
#undef PG8_WAIT_L
#undef PG8_BAR
#undef PG8_SCHED
}

__device__ __forceinline__ int qk_perm_row(int n) { const int i = n & 63; return (n & ~63) + 8 * ((i & 31) >> 2) + (i & 3) + 4 * (i >> 5); }
__device__ __forceinline__ void transpose_item(const float* W, int K, int N, bf16_t* WT, bool permqk, LAS float* scr, int item, int lane) {
    const int nblk = N / 32, kb = item / nblk, nb = item % nblk, k0 = 64 * kb, n0 = 32 * nb;
#pragma unroll 8
    for (int i = 0; i < 32; ++i) { const int kk = 2 * i + (lane >> 5); scr[kk * 33 + (lane & 31)] = W[(size_t)(k0 + kk) * N + n0 + (lane & 31)]; }
    asm volatile("s_waitcnt lgkmcnt(0)" ::: "memory");
    const int c = lane & 7;
#pragma unroll
    for (int j = 0; j < 4; ++j) { const int n = (lane >> 3) + 8 * j; const LAS float* s = scr + (8 * c) * 33 + n;
        u32x4 o; o.x = cvt_pk_bf16(s[0 * 33], s[1 * 33]); o.y = cvt_pk_bf16(s[2 * 33], s[3 * 33]); o.z = cvt_pk_bf16(s[4 * 33], s[5 * 33]); o.w = cvt_pk_bf16(s[6 * 33], s[7 * 33]);
        int row = n0 + n; if (permqk && row < 2 * QKVW) row = qk_perm_row(row);
        *(u32x4*)(WT + (size_t)row * K + k0 + 8 * c) = o; }
    asm volatile("s_waitcnt lgkmcnt(0)" ::: "memory");
}
__device__ __forceinline__ void reduce_angle(double a, float& c, float& s) {
    const double k = __builtin_rint(a * 0.6366197723675814); const float x = (float)(a - k * 1.5707963267948966), x2 = x * x;
    const float sn = x * (1.0f + x2 * (-1.6666666667e-1f + x2 * (8.3333333333e-3f + x2 * (-1.9841269841e-4f + x2 * 2.7557319224e-6f))));
    const float cs = 1.0f + x2 * (-0.5f + x2 * (4.1666666667e-2f + x2 * (-1.3888888889e-3f + x2 * (2.4801587302e-5f + x2 * -2.7557319224e-7f))));
    const int q = ((int)k) & 3;
    c = (q == 0) ? cs : (q == 1) ? -sn : (q == 2) ? -cs : sn;
    s = (q == 0) ? sn : (q == 1) ? cs : (q == 2) ? -sn : -cs;
}
__device__ __forceinline__ void rms_row_to_bf16(const float* xrow, const float* gw, bf16_t* orow, int lane) {
    const f32x4* xr = (const f32x4*)xrow + lane; const f32x4* gr = (const f32x4*)gw + lane;
    f32x4 v[4]; float s = 0.f;
#pragma unroll
    for (int j = 0; j < 4; ++j) { v[j] = xr[64 * j]; s += (v[j].x * v[j].x + v[j].y * v[j].y) + (v[j].z * v[j].z + v[j].w * v[j].w); }
    const float rstd = 1.0f / sqrtf(wave_sum(s) * (1.f / DM) + EPSN);
    u32x2* o8 = (u32x2*)orow + lane;
#pragma unroll
    for (int j = 0; j < 4; ++j) { const f32x4 gv = gr[64 * j]; u32x2 w; w.x = cvt_pk_bf16(v[j].x * rstd * gv.x, v[j].y * rstd * gv.y); w.y = cvt_pk_bf16(v[j].z * rstd * gv.z, v[j].w * rstd * gv.w); o8[64 * j] = w; }
}

__device__ __forceinline__ void ssm_setup_item(const Args& a, LAS unsigned char* lds, int item, int tid) {
    const int g = item >> 1, dir = item & 1;
    LAS f32x2* pw = (LAS f32x2*)lds; LAS f32x2* Bb = pw + 33 * 64; LAS f32x2* Cc = Bb + 1024;
    const float* lam_re = a.in[4]; const float* lam_im = a.in[5]; const float* log_step = a.in[6];
    const float* b_re = a.in[7]; const float* b_im = a.in[8]; const float* c_re = a.in[9]; const float* c_im = a.in[10];
    unsigned char* ws = a.ws;
    const float dt = expf(log_step[dir * 32 + g]);
    __syncthreads();
    for (int idx = tid; idx < 33 * 64; idx += 512) {
        const int tau = idx >> 6, n = idx & 63; const float lr = lam_re[(dir * 32 + g) * 64 + n], li = lam_im[(dir * 32 + g) * 64 + n];
        const float mag = expf(lr * dt * (float)tau); float c, s; reduce_angle((double)li * (double)dt * (double)tau, c, s);
        pw[idx] = (f32x2){mag * c, mag * s};
    }
    for (int idx = tid; idx < 1024; idx += 512) {
        { const int n = idx >> 4; const float lr = lam_re[(dir * 32 + g) * 64 + n], li = lam_im[(dir * 32 + g) * 64 + n];
          const float ar = lr * dt; float cb, sb, ch, sh; reduce_angle((double)li * (double)dt, cb, sb); reduce_angle(0.5 * (double)li * (double)dt, ch, sh);
          const float em1 = expm1f(ar), ea = em1 + 1.0f;
          const float nr = em1 * cb - 2.0f * sh * sh, ni = ea * sb;
          const float den = 1.0f / (lr * lr + li * li); const float cr = (nr * lr + ni * li) * den, ci = (ni * lr - nr * li) * den;
          const float br = b_re[(size_t)((dir * 32 + g) * 64) * 16 + idx], bi = b_im[(size_t)((dir * 32 + g) * 64) * 16 + idx];
          Bb[idx] = (f32x2){cr * br - ci * bi, cr * bi + ci * br}; }
        { Cc[idx] = (f32x2){c_re[(size_t)((dir * 32 + g) * 16) * 64 + idx], c_im[(size_t)((dir * 32 + g) * 16) * 64 + idx]}; }
    }
    __syncthreads();
    if (tid < 64) { float* PW = (float*)(ws + WS_PW); const f32x2 p = pw[32 * 64 + tid]; PW[((dir * 32 + g) * 64 + tid) * 2] = p.x; PW[((dir * 32 + g) * 64 + tid) * 2 + 1] = p.y; }
    { float* KT = (float*)(ws + WS_KT) + (size_t)(g * 2 + dir) * 32 * 256;
      for (int o = tid; o < 32 * 256; o += 512) {
          const int tau = o >> 8, co = (o >> 4) & 15, ci = o & 15; float acc = 0.f;
_Pragma("unroll 4")
          for (int n = 0; n < 64; ++n) { const f32x2 c = Cc[co * 64 + n], p = pw[tau * 64 + n], b = Bb[n * 16 + ci]; const float tr = c.x * p.x - c.y * p.y, ti = c.x * p.y + c.y * p.x; acc += tr * b.x - ti * b.y; }
          KT[o] = acc; } }
    { bf16_t* BsT = (bf16_t*)(ws + WS_BST) + (size_t)g * 256 * 512;
      for (int ch = tid; ch < 128 * 64; ch += 512) {
          const int row = ch >> 6, part = row >> 6, n = row & 63, kc = ch & 63, s = kc >> 1, ci0 = (kc & 1) * 8; const int e = dir ? s : 31 - s; const f32x2 p = pw[e * 64 + n];
          float v[8];
#pragma unroll
          for (int j = 0; j < 8; ++j) { const f32x2 b = Bb[n * 16 + ci0 + j]; v[j] = part ? (p.x * b.y + p.y * b.x) : (p.x * b.x - p.y * b.y); }
          u32x4 w; w.x = cvt_pk_bf16(v[0], v[1]); w.y = cvt_pk_bf16(v[2], v[3]); w.z = cvt_pk_bf16(v[4], v[5]); w.w = cvt_pk_bf16(v[6], v[7]);
          *(u32x4*)(BsT + (size_t)(dir * 128 + row) * 512 + s * 16 + ci0) = w; } }
    { bf16_t* MtC = (bf16_t*)(ws + WS_MTC) + (size_t)g * 512 * UHK;
      for (int ch = tid; ch < 512 * 16; ch += 512) {
          const int row = ch >> 4, t = row >> 4, co = row & 15, cc = ch & 15, part = cc >> 3, n0 = (cc & 7) * 8; const int e = dir ? 32 - t : t + 1;
          float v[8];
#pragma unroll
          for (int j = 0; j < 8; ++j) { const f32x2 c = Cc[co * 64 + n0 + j], p = pw[e * 64 + n0 + j]; v[j] = part ? -(c.x * p.y + c.y * p.x) : (c.x * p.x - c.y * p.y); }
          u32x4 w; w.x = cvt_pk_bf16(v[0], v[1]); w.y = cvt_pk_bf16(v[2], v[3]); w.z = cvt_pk_bf16(v[4], v[5]); w.w = cvt_pk_bf16(v[6], v[7]);
          *(u32x4*)(MtC + (size_t)row * UHK + 512 + dir * 128 + part * 64 + n0) = w; } }
    __syncthreads();
}

__device__ __forceinline__ void step_setup(const Args& a, LAS unsigned char* lds, int tid, int bx) {
    const int lane = tid & 63, wave = tid >> 6, G = gridDim.x;
    unsigned char* ws = a.ws;
    if (bx == 0 && tid < 64) ((unsigned*)(ws + WS_CTL))[tid] = 0u;
    for (int it = bx; it < 64; it += G) ssm_setup_item(a, lds, it, tid);
    { float* rc = (float*)(ws + WS_ROPE); float* rs = rc + SEQL * 32;
      for (int idx = bx * 512 + tid; idx < SEQL * 32; idx += G * 512) {
          const int pos = idx >> 5, i = idx & 31; double inv = 1.0; for (int k = 0; k < i; ++k) inv *= 0.7498942093324558;
          float c, s; reduce_angle((double)pos * inv, c, s); rc[idx] = c; rs[idx] = s; } }
    { LAS float* scr = (LAS float*)(lds) + wave * (64 * 33);
      const int gw = bx * 8 + wave, NGW = G * 8;
      constexpr int I_IN = (DM / 64) * (INC / 32), I_GLU = (512 / 64) * (512 / 32), I_AB = (512 / 64) * (1024 / 32), I_OUT = (1024 / 64) * (1024 / 32);
      constexpr int NIT = I_IN + I_GLU + 2 * I_AB + I_OUT;
      for (int it = gw; it < NIT; it += NGW) {
          int r = it;
          if (r < I_IN) { transpose_item(a.in[3], DM, INC, (bf16_t*)(ws + WS_WIN), true, scr, r, lane); continue; } r -= I_IN;
          if (r < I_GLU) { transpose_item(a.in[12], 512, 512, (bf16_t*)(ws + WS_WGLU), false, scr, r, lane); continue; } r -= I_GLU;
          if (r < I_AB) { transpose_item(a.in[13], 512, 1024, (bf16_t*)(ws + WS_WA), false, scr, r, lane); continue; } r -= I_AB;
          if (r < I_AB) { transpose_item(a.in[14], 512, 1024, (bf16_t*)(ws + WS_WB), false, scr, r, lane); continue; } r -= I_AB;
          transpose_item(a.in[15], 1024, 1024, (bf16_t*)(ws + WS_WOUT), false, scr, r, lane);
      } }
    { bf16_t* hn = (bf16_t*)((unsigned char*)a.out + OUT_HN_OFF);
      for (int row = bx * 8 + wave; row < TTOK; row += G * 8) rms_row_to_bf16(xrow_ptr(a.in[0], a.in[1], row), a.in[2], hn + (size_t)row * DM, lane); }
}

struct KVBuf { bf16x8 kA0, kA1, kB0, kB1; bf16x4 vA[4], vB[4]; };
__device__ __forceinline__ void step_params(int s, int& gi, int& ls) { gi = s < 12 ? 0 : (s < 18 ? 1 : 2); ls = s < 12 ? s : (s < 18 ? s - 12 : s - 18); }
__device__ __forceinline__ void attn_load(KVBuf& b, const bf16_t* Kp, const bf16_t* Vt, int s, int sq, int h, int blk, int r, int lane) {
    int gi, ls; step_params(s, gi, ls);
    const int sh = 2 * gi, Lg = SEQL >> sh, rho = r & ((1 << sh) - 1);
    int uA = ((256 * blk) >> sh) - 64 + 32 * ls, uB = uA + 16;
    if (uA < 0 || uA >= Lg) uA = 0; if (uB < 0 || uB >= Lg) uB = 0;
    const int kl = lane & 15, quad = lane >> 4;
    const bf16_t* ka = Kp + (size_t)(sq * SEQL + rho + ((uA + kl) << sh)) * QKVW + gi * 512 + h * 64 + quad * 8;
    const bf16_t* kb = Kp + (size_t)(sq * SEQL + rho + ((uB + kl) << sh)) * QKVW + gi * 512 + h * 64 + quad * 8;
    b.kA0 = *(const bf16x8*)ka; b.kA1 = *(const bf16x8*)(ka + 32); b.kB0 = *(const bf16x8*)kb; b.kB1 = *(const bf16x8*)(kb + 32);
    const bf16_t* vbase = Vt + (size_t)(((sq * 3 + gi) * 8 + h) * 512) * 1024 + kl * 16 + quad * 4;
    const bf16_t* va = vbase + (size_t)((rho * Lg + uA) >> 4) * 1024; const bf16_t* vb = vbase + (size_t)((rho * Lg + uB) >> 4) * 1024;
#pragma unroll
    for (int dt = 0; dt < 4; ++dt) { b.vA[dt] = *(const bf16x4*)(va + dt * 256); b.vB[dt] = *(const bf16x4*)(vb + dt * 256); }
}
struct QF { bf16x8 a0, a1, b0, b1, c0, c1; };
template <int gi>
__device__ __forceinline__ void attn_compute(const KVBuf& b, const bf16x8 q0, const bf16x8 q1, f32x4 (&o)[4], float& mrun, float& lrun, int s, int blk, int r, int lane) {
    const int ls = gi == 0 ? s : (gi == 1 ? s - 12 : s - 18);
    const int sh = 2 * gi, Lg = SEQL >> sh;
    const int uA = ((256 * blk) >> sh) - 64 + 32 * ls;
    const int qi = lane & 15, quad = lane >> 4;
    const int uq = (256 * blk + r + 16 * qi) >> sh;
    const int lo = max(0, uq - 64), hi = min(Lg - 1, uq + 64);
    f32x4 sA = (f32x4){0.f, 0.f, 0.f, 0.f}, sB = sA;
    sA = __builtin_amdgcn_mfma_f32_16x16x32_bf16(b.kA0, q0, sA, 0, 0, 0); sA = __builtin_amdgcn_mfma_f32_16x16x32_bf16(b.kA1, q1, sA, 0, 0, 0);
    sB = __builtin_amdgcn_mfma_f32_16x16x32_bf16(b.kB0, q0, sB, 0, 0, 0); sB = __builtin_amdgcn_mfma_f32_16x16x32_bf16(b.kB1, q1, sB, 0, 0, 0);
    const float NEGINF = -__builtin_inff();
    const unsigned span = (unsigned)(hi - lo);
    float mx = NEGINF;
#pragma unroll
    for (int j = 0; j < 4; ++j) {
        const int ua = uA + quad * 4 + j, ub = ua + 16;
        sA[j] = ((unsigned)(ua - lo) <= span) ? sA[j] : NEGINF; sB[j] = ((unsigned)(ub - lo) <= span) ? sB[j] : NEGINF;
        mx = fmaxf(mx, fmaxf(sA[j], sB[j]));
    }
    mx = fmaxf(mx, __shfl_xor(mx, 16)); mx = fmaxf(mx, __shfl_xor(mx, 32));
    const float mnew = fmaxf(mrun, mx), alpha = __builtin_amdgcn_exp2f(mrun - mnew);
    mrun = mnew;
    float ps = 0.f;
#pragma unroll
    for (int j = 0; j < 4; ++j) { sA[j] = __builtin_amdgcn_exp2f(sA[j] - mnew); sB[j] = __builtin_amdgcn_exp2f(sB[j] - mnew); ps += sA[j] + sB[j]; }
    lrun = lrun * alpha + ps;
    u32x4 pw; pw.x = cvt_pk_bf16(sA[0], sA[1]); pw.y = cvt_pk_bf16(sA[2], sA[3]); pw.z = cvt_pk_bf16(sB[0], sB[1]); pw.w = cvt_pk_bf16(sB[2], sB[3]);
    const bf16x8 pf = __builtin_bit_cast(bf16x8, pw);
#pragma unroll
    for (int dt = 0; dt < 4; ++dt) {
        o[dt] *= alpha;
        bf16x8 vf; vf[0] = b.vA[dt][0]; vf[1] = b.vA[dt][1]; vf[2] = b.vA[dt][2]; vf[3] = b.vA[dt][3]; vf[4] = b.vB[dt][0]; vf[5] = b.vB[dt][1]; vf[6] = b.vB[dt][2]; vf[7] = b.vB[dt][3];
#ifdef DBG_ATT2
        for (int e = 0; e < 8; ++e) o[dt][e & 3] += 1e-3f * __uint_as_float(((unsigned)(unsigned short)vf[e]) << 16);
#else
        o[dt] = __builtin_amdgcn_mfma_f32_16x16x32_bf16(vf, pf, o[dt], 0, 0, 0);
#endif
    }
}
__device__ __forceinline__ void step_attention(const Args& a, int pass, int tid) {
    unsigned char* ws = a.ws;
    const int lane = tid & 63;
    const bf16_t* Qp = (const bf16_t*)(ws + WS_Q); const bf16_t* Kp = (const bf16_t*)(ws + WS_K); const bf16_t* Vt = (const bf16_t*)(ws + WS_VT);
    const bf16_t* ZA = (const bf16_t*)(ws + WS_ZA); bf16_t* GAO = (bf16_t*)(ws + WS_GAO);
    unsigned* ctr = (unsigned*)(ws + WS_CTL) + 8 + pass;
    constexpr int NITEMS = SEQP * 8 * 32 * 16;
    for (;;) {
        unsigned it = 0; if (lane == 0) it = atomicAdd(ctr, 1u);
        it = (unsigned)__builtin_amdgcn_readfirstlane((int)it);
        if (it >= (unsigned)NITEMS) break;
        const int r = it & 15, blk = (it >> 4) & 31, h = (it >> 9) & 7, sq = it >> 12;
        const int qi = lane & 15, quad = lane >> 4;
        const int tq = sq * SEQL + 256 * blk + r + 16 * qi;
        QF qf;
        { const bf16_t* qp = Qp + (size_t)tq * QKVW + h * 64 + quad * 8;
          qf.a0 = *(const bf16x8*)qp; qf.a1 = *(const bf16x8*)(qp + 32); qf.b0 = *(const bf16x8*)(qp + 512); qf.b1 = *(const bf16x8*)(qp + 544); qf.c0 = *(const bf16x8*)(qp + 1024); qf.c1 = *(const bf16x8*)(qp + 1056); }
        f32x4 o[4];
#pragma unroll
        for (int dt = 0; dt < 4; ++dt) o[dt] = (f32x4){0.f, 0.f, 0.f, 0.f};
        float mrun = -1e30f, lrun = 0.f;
        KVBuf b0, b1;
        attn_load(b0, Kp, Vt, 0, sq, h, blk, r, lane);
#define ATT_LOOP(GI, S0, S1, QA, QB) _Pragma("unroll 1") for (int s = S0; s < S1; s += 2) { \
            attn_load(b1, Kp, Vt, s + 1, sq, h, blk, r, lane); attn_compute<GI>(b0, QA, QB, o, mrun, lrun, s, blk, r, lane); \
            attn_load(b0, Kp, Vt, s + 2, sq, h, blk, r, lane); attn_compute<GI>(b1, QA, QB, o, mrun, lrun, s + 1, blk, r, lane); }
        ATT_LOOP(0, 0, 12, qf.a0, qf.a1)
        ATT_LOOP(1, 12, 18, qf.b0, qf.b1)
        ATT_LOOP(2, 18, 22, qf.c0, qf.c1)
#undef ATT_LOOP
        attn_compute<2>(b0, qf.c0, qf.c1, o, mrun, lrun, 22, blk, r, lane);
        float l = lrun; l += __shfl_xor(l, 16); l += __shfl_xor(l, 32);
        float inv = 1.0f / l;
#ifdef DBG_ATT1
        for (int dt = 0; dt < 4; ++dt) o[dt] = (f32x4){1.f, 1.f, 1.f, 1.f};
#endif
#pragma unroll
        for (int dt = 0; dt < 4; ++dt) {
            const size_t off = (size_t)tq * 512 + h * 64 + 16 * dt + 4 * quad;
            const u32x2 z = *(const u32x2*)(ZA + off);
            u32x2 w; w.x = cvt_pk_bf16(o[dt][0] * inv * bf_lo(z.x), o[dt][1] * inv * bf_hi(z.x)); w.y = cvt_pk_bf16(o[dt][2] * inv * bf_lo(z.y), o[dt][3] * inv * bf_hi(z.y));
            *(u32x2*)(GAO + off) = w;
        }
    }
}

__device__ __forceinline__ f32x2 cmul(f32x2 a, f32x2 b) { return (f32x2){a.x * b.x - a.y * b.y, a.x * b.y + a.y * b.x}; }
__device__ __forceinline__ void step_scan(const Args& a, LAS unsigned char* lds, int pass, int tid, int bx) {
    unsigned char* ws = a.ws; const int G = gridDim.x;
    const float* PW = (const float*)(ws + WS_PW); const float* S = (const float*)(ws + WS_S); bf16_t* UH = (bf16_t*)(ws + WS_UH);
    LAS f32x2* carry = (LAS f32x2*)lds;
    for (int it = bx; it < SEQP * 32 * 2; it += G) {
        const int dir = it & 1, g = (it >> 1) & 31, sq = it >> 6; const int seg = tid >> 6, n = tid & 63;
        const f32x2 P = (f32x2){PW[((dir * 32 + g) * 64 + n) * 2], PW[((dir * 32 + g) * 64 + n) * 2 + 1]};
        f32x2 z[32];
        { const int c0 = dir ? (NCH - 1 - seg * 32) : seg * 32; const long stp = dir ? -256 : 256;
          const float* sp = S + ((size_t)g * CHP + sq * NCH + c0) * 256 + dir * 128 + n;
#pragma unroll
          for (int i = 0; i < 32; ++i) { z[i] = (f32x2){sp[0], sp[64]}; sp += stp; } }
        f32x2 zz = (f32x2){0.f, 0.f};
#pragma unroll
        for (int i = 0; i < 32; ++i) { const f32x2 t = z[i]; z[i] = zz; zz = cmul(P, zz) + t; }
        __syncthreads();
        carry[seg * 64 + n] = zz;
        __syncthreads();
        f32x2 P32 = P;
#pragma unroll
        for (int k = 0; k < 5; ++k) P32 = cmul(P32, P32);
        f32x2 x = (f32x2){0.f, 0.f};
        for (int sp = 0; sp < seg; ++sp) x = cmul(P32, x) + carry[sp * 64 + n];
        f32x2 pwr = (f32x2){1.f, 0.f};
        { const int c0 = dir ? (NCH - 1 - seg * 32) : seg * 32; const long stp = dir ? -(long)UHK : (long)UHK;
          bf16_t* up = UH + ((size_t)g * CHP + sq * NCH + c0) * UHK + 512 + dir * 128 + n;
#pragma unroll
          for (int i = 0; i < 32; ++i) {
              const f32x2 hin = z[i] + cmul(pwr, x);
              up[0] = (bf16_t)(cvt_pk_bf16(hin.x, 0.f) & 0xffffu); up[64] = (bf16_t)(cvt_pk_bf16(hin.y, 0.f) & 0xffffu);
              pwr = cmul(pwr, P); up += stp;
          } }
    }
    if (pass == 0) {
        const float* KT = (const float*)(ws + WS_KT); const float* dsk = a.in[11]; bf16_t* MtC = (bf16_t*)(ws + WS_MTC);
        for (int ch = bx * 512 + tid; ch < 32 * 512 * 64; ch += G * 512) {
            const int kc = ch & 63, row = (ch >> 6) & 511, g = ch >> 15; const int s = kc >> 1, ci0 = (kc & 1) * 8, t = row >> 4, co = row & 15;
            float v[8];
#pragma unroll
            for (int j = 0; j < 8; ++j) v[j] = 0.f;
            if (t >= s) { const float* kp = KT + ((size_t)((g * 2 + 0) * 32 + (t - s)) * 16 + co) * 16 + ci0;
#pragma unroll
                for (int j = 0; j < 8; ++j) v[j] += kp[j]; }
            if (s >= t) { const float* kp = KT + ((size_t)((g * 2 + 1) * 32 + (s - t)) * 16 + co) * 16 + ci0;
#pragma unroll
                for (int j = 0; j < 8; ++j) v[j] += kp[j]; }
            if (t == s) { const float dv = dsk[g * 16 + co];
#pragma unroll
                for (int j = 0; j < 8; ++j) v[j] += (ci0 + j == co) ? dv : 0.f; }
            u32x4 w; w.x = cvt_pk_bf16(v[0], v[1]); w.y = cvt_pk_bf16(v[2], v[3]); w.z = cvt_pk_bf16(v[4], v[5]); w.w = cvt_pk_bf16(v[6], v[7]);
            *(u32x4*)(MtC + ((size_t)g * 512 + row) * UHK + s * 16 + ci0) = w;
        }
    }
}

__device__ __forceinline__ void step_final_norm(const Args& a, int pass, int tid, int bx) {
    const int lane = tid & 63, wave = tid >> 6, G = gridDim.x;
    const f32x4* gr = (const f32x4*)a.in[16] + lane;
    for (int row = bx * 8 + wave; row < TP; row += G * 8) {
        f32x4* xr = (f32x4*)(a.out + (size_t)(pass * TP + row) * DM) + lane;
        f32x4 v[4]; float s = 0.f;
#pragma unroll
        for (int j = 0; j < 4; ++j) { v[j] = xr[64 * j]; s += (v[j].x * v[j].x + v[j].y * v[j].y) + (v[j].z * v[j].z + v[j].w * v[j].w); }
        const float rstd = 1.0f / sqrtf(wave_sum(s) * (1.f / DM) + EPSN);
#pragma unroll
        for (int j = 0; j < 4; ++j) { f32x4 o = v[j] * rstd * gr[64 * j];
#ifdef DBG_SANITIZE
            for (int e = 0; e < 4; ++e) if (!(fabsf(o[e]) < 1e30f)) o[e] = 100.0f;
#endif
            xr[64 * j] = o; }
    }
}

constexpr int NSTEPS = 1 + 10 * NPASS;
__host__ __device__ __forceinline__ bool sync_after(int st) { if (st == 0) return true; const int k = (st - 1) % 10; return !(k == 1 || k == 6 || k == 9); }

__global__ void __launch_bounds__(512, 2) fwd_kernel(Args a) {
    extern __shared__ __attribute__((aligned(16))) unsigned char lds_raw[];
    LAS unsigned char* lds = (LAS unsigned char*)lds_raw;
    cg::grid_group grid = cg::this_grid();
    const int G = gridDim.x;
    unsigned char* ws = a.ws;
    for (int st = a.st_lo; st < a.st_hi; ++st) {
        int tid = threadIdx.x, bx = blockIdx.x;
        asm volatile("" : "+v"(tid), "+s"(bx));
#ifndef NO_SETUP
        if (st == 0) { step_setup(a, lds, tid, bx); }
#else
        if (st == 0) {}
#endif
        else {
            const int pass = (st - 1) / 10, k = (st - 1) % 10;
            GemmD g; g.ws = ws; g.out = a.out; g.xp = a.in[0]; g.xs = a.in[1]; g.pass = pass; g.nb = 1; g.sA = 0; g.sB = 0;
            bool has_gemm = true;
            switch (k) {
            case 0: g.A = (const bf16_t*)((unsigned char*)a.out + OUT_HN_OFF) + (size_t)pass * TP * DM; g.lda = DM; g.Bt = (const bf16_t*)(ws + WS_WIN); g.ldb = DM; g.K = DM; g.nM = TP / BM; g.nN = INC / BM; g.mode = MODE_PROJ; break;
            case 1: g.A = (const bf16_t*)(ws + WS_UH); g.lda = UHK; g.sA = (size_t)CHP * UHK * 2; g.Bt = (const bf16_t*)(ws + WS_BST); g.ldb = 512; g.sB = (size_t)256 * 512 * 2; g.K = 512; g.nM = CHP / BM; g.nN = 1; g.nb = 32; g.mode = MODE_S; break;
            case 4: g.A = (const bf16_t*)(ws + WS_UH); g.lda = UHK; g.sA = (size_t)CHP * UHK * 2; g.Bt = (const bf16_t*)(ws + WS_MTC); g.ldb = UHK; g.sB = (size_t)512 * UHK * 2; g.K = UHK; g.nM = CHP / BM; g.nN = 2; g.nb = 32; g.mode = MODE_Y; break;
            case 5: g.A = (const bf16_t*)(ws + WS_SG); g.lda = 512; g.Bt = (const bf16_t*)(ws + WS_WGLU); g.ldb = 512; g.K = 512; g.nM = TP / BM; g.nN = 2; g.mode = MODE_GLU; break;
            case 6: g.A = (const bf16_t*)(ws + WS_GAO); g.lda = 512; g.Bt = (const bf16_t*)(ws + WS_WA); g.ldb = 512; g.K = 512; g.nM = TP / BM; g.nN = 4; g.mode = MODE_A; break;
            case 7: g.A = (const bf16_t*)(ws + WS_SB); g.lda = 512; g.Bt = (const bf16_t*)(ws + WS_WB); g.ldb = 512; g.K = 512; g.nM = TP / BM; g.nN = 4; g.mode = MODE_B; break;
            case 8: g.A = (const bf16_t*)(ws + WS_M1); g.lda = 1024; g.Bt = (const bf16_t*)(ws + WS_WOUT); g.ldb = 1024; g.K = 1024; g.nM = TP / BM; g.nN = 4; g.mode = MODE_OUT; break;
            default: has_gemm = false; g.A = nullptr; g.Bt = nullptr; g.lda = g.ldb = g.K = 0; g.nM = g.nN = 0; g.mode = 0; break;
            }
            if (has_gemm) {
#ifndef NO_GEMM
                gemm_phase(lds, g, G, bx, tid);
#endif
            }
#ifndef NO_ATTN
            else if (k == 2) step_attention(a, pass, tid);
#endif
#ifndef NO_SCAN
            else if (k == 3) step_scan(a, lds, pass, tid, bx);
#endif
            else if (k == 9) step_final_norm(a, pass, tid, bx);
        }
        if (a.do_sync && st + 1 < a.st_hi && sync_after(st)) grid.sync();
    }
}

extern "C" void kernel_launch(void* const* d_in, const int* in_sizes, int n_in, void* d_out, int out_size, void* d_ws, size_t ws_size, hipStream_t stream) {
    constexpr int LDS_BYTES = STAGE_BYTES;
    static int grid = 0;
    if (grid == 0) {
        if (n_in != 17 || out_size != TTOK * DM || ws_size < WS_END) { fprintf(stderr, "kernel_launch: unexpected shapes (n_in %d out %d ws %zu need %zu)\n", n_in, out_size, ws_size, (size_t)WS_END); grid = -1; return; }
        int dev = 0, cus = 0, per_cu = 0;
        hipGetDevice(&dev); hipDeviceGetAttribute(&cus, hipDeviceAttributeMultiprocessorCount, dev);
        hipFuncSetAttribute((const void*)fwd_kernel, hipFuncAttributeMaxDynamicSharedMemorySize, LDS_BYTES);
        hipOccupancyMaxActiveBlocksPerMultiprocessor(&per_cu, (const void*)fwd_kernel, 512, LDS_BYTES);
        if (per_cu < 1) per_cu = 1;
        grid = cus * 1;
        (void)hipGetLastError();
    }
    if (grid < 0) return;
    Args a{};
    for (int i = 0; i < 17; ++i) a.in[i] = (const float*)d_in[i];
    a.out = (float*)d_out; a.ws = (unsigned char*)d_ws; a.pad = 0;
#ifndef MULTI_LAUNCH
#define MULTI_LAUNCH 1
#endif
#if MULTI_LAUNCH
    a.do_sync = 0;
    for (int st = 0; st < NSTEPS; ++st) {
        a.st_lo = st; a.st_hi = st + 1;
        hipLaunchKernelGGL(fwd_kernel, dim3(grid), dim3(512), LDS_BYTES, stream, a);
    }
#else
    a.do_sync = 1; a.st_lo = 0; a.st_hi = NSTEPS;
    void* args[] = {&a};
    hipError_t e = hipLaunchCooperativeKernel((const void*)fwd_kernel, dim3(grid), dim3(512), args, LDS_BYTES, stream);
    if (e != hipSuccess) fprintf(stderr, "cooperative launch failed: %s (grid %d)\n", hipGetErrorString(e), grid);
#endif
}
```

```cpp
#include <hip/hip_runtime.h>
#include <hip/hip_cooperative_groups.h>
#include <cstdio>

namespace cg = cooperative_groups;

#define LAS __attribute__((address_space(3)))
typedef unsigned short bf16_t;
typedef short bf16x8 __attribute__((ext_vector_type(8)));
typedef short bf16x4 __attribute__((ext_vector_type(4)));
typedef float f32x4 __attribute__((ext_vector_type(4)));
typedef float f32x2 __attribute__((ext_vector_type(2)));
typedef unsigned u32x4 __attribute__((ext_vector_type(4)));
typedef unsigned u32x2 __attribute__((ext_vector_type(2)));

constexpr int DM = 1024, SEQL = 8192, NSEQ = 6, TTOK = NSEQ * SEQL;
constexpr int NPASS = 2, SEQP = 3, TP = SEQP * SEQL;
constexpr int INC = 8192, QKVW = 1536;
constexpr int LC = 32, NCH = SEQL / LC  , CHP = SEQP * NCH  ;
constexpr int UHK = LC * 16 + 256;
constexpr float EPSN = 1e-6f;
constexpr float QSCALE = 0.18033688011112042f;

constexpr size_t AL(size_t x) { return (x + 255) & ~(size_t)255; }
constexpr size_t WS_CTL = 0;
constexpr size_t WS_WIN = 4096;
constexpr size_t WS_WGLU = WS_WIN + (size_t)INC * DM * 2;
constexpr size_t WS_WA = WS_WGLU + (size_t)512 * 512 * 2;
constexpr size_t WS_WB = WS_WA + (size_t)1024 * 512 * 2;
constexpr size_t WS_WOUT = WS_WB + (size_t)1024 * 512 * 2;
constexpr size_t WS_MTC = WS_WOUT + (size_t)1024 * 1024 * 2;
constexpr size_t WS_BST = WS_MTC + (size_t)32 * 512 * UHK * 2;
constexpr size_t WS_ROPE = WS_BST + (size_t)32 * 256 * 512 * 2;
constexpr size_t WS_PW = WS_ROPE + (size_t)2 * SEQL * 32 * 4;
constexpr size_t WS_KT = WS_PW + (size_t)2 * 32 * 64 * 8;
constexpr size_t WS_Q = WS_KT + (size_t)32 * 2 * 32 * 256 * 4;
constexpr size_t WS_K = WS_Q + (size_t)TP * QKVW * 2;
constexpr size_t WS_VT = WS_K + (size_t)TP * QKVW * 2;
constexpr size_t WS_ZA = WS_VT + (size_t)TP * QKVW * 2;
constexpr size_t WS_ZB = WS_ZA + (size_t)TP * 512 * 2;
constexpr size_t WS_GA = WS_ZB + (size_t)TP * 512 * 2;
constexpr size_t WS_GB = WS_GA + (size_t)TP * 1024 * 2;
constexpr size_t WS_UH = WS_GB + (size_t)TP * 1024 * 2;
constexpr size_t WS_S = WS_UH + (size_t)32 * CHP * UHK * 2;
constexpr size_t WS_GAO = WS_S + (size_t)32 * CHP * 256 * 4;
constexpr size_t WS_END = WS_GAO + (size_t)TP * 512 * 2;
constexpr size_t WS_SG = WS_Q;
constexpr size_t WS_SB = WS_Q + (size_t)TP * 512 * 2;
constexpr size_t WS_M1 = WS_K;
constexpr size_t OUT_HN_OFF = (size_t)SEQP * SEQL * DM * 4;

struct Args {
    const float* in[17];
    float* out;
    unsigned char* ws;
    int st_lo, st_hi;
    int do_sync, pad;
};

typedef __bf16 bf16v2 __attribute__((ext_vector_type(2)));
__device__ __forceinline__ unsigned cvt_pk_bf16(float lo, float hi) { const f32x2 v = (f32x2){lo, hi}; const bf16v2 r = __builtin_convertvector(v, bf16v2); return __builtin_bit_cast(unsigned, r); }
__device__ __forceinline__ float bf_lo(unsigned w) { return __uint_as_float(w << 16); }
__device__ __forceinline__ float bf_hi(unsigned w) { return __uint_as_float(w & 0xffff0000u); }
__device__ __forceinline__ float fast_rcp(float x) { return __builtin_amdgcn_rcpf(x); }
__device__ __forceinline__ float sigmoidf_(float x) { return fast_rcp(1.0f + __builtin_amdgcn_exp2f(-1.4426950408889634f * x)); }
__device__ __forceinline__ float siluf_(float x) { return x * sigmoidf_(x); }
__device__ __forceinline__ float gelu_tanh(float x) { const float u = x * (1.5957691216057308f + 0.07135481627260025f * x * x); return x * sigmoidf_(u); }
__device__ __forceinline__ float wave_sum(float v) {
#pragma unroll
    for (int o = 1; o < 64; o <<= 1) v += __shfl_xor(v, o);
    return v;
}
__device__ __forceinline__ const float* xrow_ptr(const float* xp, const float* xs, int tg) {
    return tg < 4 * SEQL ? xp + (size_t)tg * DM : xs + (size_t)(tg - 4 * SEQL) * DM;
}

constexpr int BM = 256, BK = 64, HALF = 128, HTB = HALF * BK * 2, STAGE_BYTES = 8 * HTB, NXCD = 8, WGM = 8;
__host__ __device__ __forceinline__ int lds_byte(int r, int c) { const int st = (r >> 4) * 2 + (c >> 5), rr = r & 15, cc = c & 31, ob = rr * 64 + cc * 2; return st * 1024 + (ob ^ (((ob >> 9) & 1) << 5)); }
__host__ __device__ __forceinline__ void stage_rc(int b, int& R, int& C) { const int st = b / 1024, sb = b % 1024, swz = sb ^ (((sb >> 9) & 1) << 5); R = (st >> 1) * 16 + swz / 64; C = (st & 1) * 32 + (swz % 64) / 2; }
__host__ __device__ __forceinline__ int perm32(int rho) { const int n = rho >> 4, i = rho & 15; return 8 * (i >> 2) + 4 * n + (i & 3); }

enum { MODE_PROJ = 0, MODE_S = 1, MODE_Y = 2, MODE_GLU = 3, MODE_A = 4, MODE_B = 5, MODE_OUT = 6 };
struct Unit { int pm, pn, bz; };
struct GemmD {
    const bf16_t* A; const bf16_t* Bt;
    int lda, ldb, K, nM, nN, nb;
    size_t sA, sB;
    int mode, pass;
    unsigned char* ws; float* out; const float* xp; const float* xs;
};
__device__ __forceinline__ bool unit_next(const GemmD& g, int i, int G, int c, int& pm, int& pn, int& bz) {
    const int nwg = g.nM * g.nN;
    const long L = (long)i * G + c; const bool ok = L < (long)nwg * g.nb;
    const int Li = ok ? (int)L : 0;
    int wgid = Li; { const int q = nwg / NXCD, r = nwg % NXCD, xcd = wgid % NXCD, off = wgid / NXCD; wgid = (xcd < r ? xcd * (q + 1) : r * (q + 1) + (xcd - r) * q) + off; }
    const int nig = WGM * g.nN, gid = wgid / nig, fm = gid * WGM, gsz = (g.nM - fm) < WGM ? (g.nM - fm) : WGM;
    const int pm1 = fm + ((wgid % nig) % gsz), pn1 = (wgid % nig) / gsz;
    const int w = Li % nwg, bz2 = Li / nwg, pm2 = w % g.nM, pn2 = w / g.nM;
    const bool single = g.nb == 1;
    pm = single ? pm1 : pm2; pn = single ? pn1 : pn2; bz = single ? 0 : bz2;
    return ok;
}

__device__ __forceinline__ void epilogue(const GemmD& g, const f32x4 (&acc)[2][2][4][2], const Unit& u, int wr, int wc, int fr, int fq) {
    asm volatile("" : "+v"(fr), "+v"(fq));
    unsigned char* ws = g.ws;
    const int rbase = u.pm * BM + wr * 64 + fr;
    const int cl = wc * 32 + fq * 8;
    if (g.mode == MODE_PROJ) {
        const int pn = u.pn;
        if (pn < 12) {
            const bool isq = pn < 6;
            bf16_t* dst = (bf16_t*)(ws + (isq ? WS_Q : WS_K));
            const float* rc = (const float*)(ws + WS_ROPE); const float* rs = rc + SEQL * 32;
            const int a4 = 4 * (4 * (wc & 1) + fq);
            const int cbase = (isq ? pn : pn - 6) * 256 + 64 * (wc >> 1) + a4;
            const float sc = isq ? QSCALE : 1.0f;
#pragma unroll
            for (int ai = 0; ai < 2; ++ai)
#pragma unroll
                for (int m = 0; m < 4; ++m) { asm volatile("" ::: "memory");
                    const int tl = rbase + ai * HALF + m * 16; const int pos = tl & (SEQL - 1);
                    const f32x4 cv = *(const f32x4*)(rc + pos * 32 + a4) * sc, sv = *(const f32x4*)(rs + pos * 32 + a4) * sc;
#pragma unroll
                    for (int bj = 0; bj < 2; ++bj) {
                        const f32x4 x1 = acc[ai][bj][m][0], x2 = acc[ai][bj][m][1];
                        const f32x4 o1 = x1 * cv - x2 * sv, o2 = x2 * cv + x1 * sv;
                        bf16_t* p = dst + (size_t)tl * QKVW + cbase + bj * HALF;
                        u32x2 w1, w2; w1.x = cvt_pk_bf16(o1[0], o1[1]); w1.y = cvt_pk_bf16(o1[2], o1[3]); w2.x = cvt_pk_bf16(o2[0], o2[1]); w2.y = cvt_pk_bf16(o2[2], o2[3]);
                        *(u32x2*)p = w1; *(u32x2*)(p + 32) = w2;
                    }
                }
        } else if (pn < 18) {
            bf16_t* dst = (bf16_t*)(ws + WS_VT);
            const int gi = (pn - 12) >> 1, sh = 2 * gi, dmask = (1 << sh) - 1, Lg = SEQL >> sh;
            const int d0 = 32 * (wc & 1) + 8 * fq;
#pragma unroll
            for (int ai = 0; ai < 2; ++ai)
#pragma unroll
                for (int m = 0; m < 4; ++m) { asm volatile("" ::: "memory");
                    const int tl = rbase + ai * HALF + m * 16; const int pos = tl & (SEQL - 1), sq = tl >> 13;
                    const int kidx = (pos & dmask) * Lg + (pos >> sh);
#pragma unroll
                    for (int bj = 0; bj < 2; ++bj) {
                        const int h = (4 * (pn - 12) + 2 * bj + (wc >> 1)) & 7;
                        bf16_t* p = dst + ((size_t)(((sq * 3 + gi) * 8 + h) * 512 + (kidx >> 4)) * 1024) + d0 * 16 + (kidx & 15);
#pragma unroll
                        for (int n = 0; n < 2; ++n)
#pragma unroll
                            for (int j = 0; j < 4; ++j) { const unsigned w = cvt_pk_bf16(acc[ai][bj][m][n][j], 0.f); p[(n * 4 + j) * 16] = (bf16_t)(w & 0xffffu); }
                    }
                }
        } else if (pn == 20 || pn == 21) {
            bf16_t* dst = (bf16_t*)(ws + WS_UH);
#pragma unroll
            for (int ai = 0; ai < 2; ++ai)
#pragma unroll
                for (int m = 0; m < 4; ++m) { asm volatile("" ::: "memory");
                    const int tl = rbase + ai * HALF + m * 16;
#pragma unroll
                    for (int bj = 0; bj < 2; ++bj) {
                        const int gg = 16 * (pn - 20) + 8 * bj + 2 * wc + (fq >> 1);
                        bf16_t* p = dst + ((size_t)(gg * CHP + (tl >> 5)) * UHK) + (tl & 31) * 16 + 8 * (fq & 1);
                        const f32x4 v0 = acc[ai][bj][m][0], v1 = acc[ai][bj][m][1];
                        u32x4 w; w.x = cvt_pk_bf16(v0[0], v0[1]); w.y = cvt_pk_bf16(v0[2], v0[3]); w.z = cvt_pk_bf16(v1[0], v1[1]); w.w = cvt_pk_bf16(v1[2], v1[3]);
                        *(u32x4*)p = w;
                    }
                }
        } else {
            bf16_t* dst; int ld, c0; bool silu;
            if (pn < 20) { dst = (bf16_t*)(ws + WS_ZA); ld = 512; c0 = (pn - 18) * 256; silu = true; }
            else if (pn < 24) { dst = (bf16_t*)(ws + WS_ZB); ld = 512; c0 = (pn - 22) * 256; silu = true; }
            else if (pn < 28) { dst = (bf16_t*)(ws + WS_GA); ld = 1024; c0 = (pn - 24) * 256; silu = false; }
            else { dst = (bf16_t*)(ws + WS_GB); ld = 1024; c0 = (pn - 28) * 256; silu = false; }
#pragma unroll
            for (int ai = 0; ai < 2; ++ai)
#pragma unroll
                for (int m = 0; m < 4; ++m) { asm volatile("" ::: "memory");
                    const int tl = rbase + ai * HALF + m * 16;
#pragma unroll
                    for (int bj = 0; bj < 2; ++bj) {
                        f32x4 v0 = acc[ai][bj][m][0], v1 = acc[ai][bj][m][1];
#pragma unroll
                        for (int j = 0; j < 4; ++j) { const float s0 = sigmoidf_(v0[j]), s1 = sigmoidf_(v1[j]); v0[j] = silu ? v0[j] * s0 : s0; v1[j] = silu ? v1[j] * s1 : s1; }
                        u32x4 w; w.x = cvt_pk_bf16(v0[0], v0[1]); w.y = cvt_pk_bf16(v0[2], v0[3]); w.z = cvt_pk_bf16(v1[0], v1[1]); w.w = cvt_pk_bf16(v1[2], v1[3]);
                        *(u32x4*)(dst + (size_t)tl * ld + c0 + cl + bj * HALF) = w;
                    }
                }
        }
    } else if (g.mode == MODE_S) {
        float* dst = (float*)(ws + WS_S) + (size_t)u.bz * CHP * 256;
#pragma unroll
        for (int ai = 0; ai < 2; ++ai)
#pragma unroll
            for (int m = 0; m < 4; ++m) { asm volatile("" ::: "memory");
                const int r = rbase + ai * HALF + m * 16;
#pragma unroll
                for (int bj = 0; bj < 2; ++bj) { float* p = dst + (size_t)r * 256 + cl + bj * HALF; *(f32x4*)p = acc[ai][bj][m][0]; *(f32x4*)(p + 4) = acc[ai][bj][m][1]; }
            }
    } else if (g.mode == MODE_Y) {
        bf16_t* dst = (bf16_t*)(ws + WS_SG);
#pragma unroll
        for (int ai = 0; ai < 2; ++ai)
#pragma unroll
            for (int m = 0; m < 4; ++m) { asm volatile("" ::: "memory");
                const int r = rbase + ai * HALF + m * 16;
#pragma unroll
                for (int bj = 0; bj < 2; ++bj) {
                    const int t = 16 * u.pn + 8 * bj + 2 * wc + (fq >> 1);
                    f32x4 v0 = acc[ai][bj][m][0], v1 = acc[ai][bj][m][1];
#pragma unroll
                    for (int j = 0; j < 4; ++j) { v0[j] = gelu_tanh(v0[j]); v1[j] = gelu_tanh(v1[j]); }
                    u32x4 w; w.x = cvt_pk_bf16(v0[0], v0[1]); w.y = cvt_pk_bf16(v0[2], v0[3]); w.z = cvt_pk_bf16(v1[0], v1[1]); w.w = cvt_pk_bf16(v1[2], v1[3]);
                    *(u32x4*)(dst + (size_t)(r * LC + t) * 512 + u.bz * 16 + 8 * (fq & 1)) = w;
                }
            }
    } else if (g.mode == MODE_GLU) {
        const bf16_t* sg = (const bf16_t*)(ws + WS_SG); const bf16_t* zb = (const bf16_t*)(ws + WS_ZB); bf16_t* dst = (bf16_t*)(ws + WS_SB);
#pragma unroll
        for (int ai = 0; ai < 2; ++ai)
#pragma unroll
            for (int m = 0; m < 4; ++m) { asm volatile("" ::: "memory");
                const int tl = rbase + ai * HALF + m * 16;
#pragma unroll
                for (int bj = 0; bj < 2; ++bj) {
                    const size_t off = (size_t)tl * 512 + u.pn * BM + cl + bj * HALF;
                    const u32x4 s4 = *(const u32x4*)(sg + off), z4 = *(const u32x4*)(zb + off);
                    const f32x4 v0 = acc[ai][bj][m][0], v1 = acc[ai][bj][m][1];
                    u32x4 w;
                    w.x = cvt_pk_bf16(bf_lo(s4.x) * sigmoidf_(v0[0]) * bf_lo(z4.x), bf_hi(s4.x) * sigmoidf_(v0[1]) * bf_hi(z4.x));
                    w.y = cvt_pk_bf16(bf_lo(s4.y) * sigmoidf_(v0[2]) * bf_lo(z4.y), bf_hi(s4.y) * sigmoidf_(v0[3]) * bf_hi(z4.y));
                    w.z = cvt_pk_bf16(bf_lo(s4.z) * sigmoidf_(v1[0]) * bf_lo(z4.z), bf_hi(s4.z) * sigmoidf_(v1[1]) * bf_hi(z4.z));
                    w.w = cvt_pk_bf16(bf_lo(s4.w) * sigmoidf_(v1[2]) * bf_lo(z4.w), bf_hi(s4.w) * sigmoidf_(v1[3]) * bf_hi(z4.w));
                    *(u32x4*)(dst + off) = w;
                }
            }
    } else if (g.mode == MODE_A || g.mode == MODE_B) {
        const bool isb = g.mode == MODE_B;
        const bf16_t* gt = (const bf16_t*)(ws + (isb ? WS_GB : WS_GA)); bf16_t* dst = (bf16_t*)(ws + WS_M1);
#pragma unroll
        for (int ai = 0; ai < 2; ++ai)
#pragma unroll
            for (int m = 0; m < 4; ++m) { asm volatile("" ::: "memory");
                const int tl = rbase + ai * HALF + m * 16;
#pragma unroll
                for (int bj = 0; bj < 2; ++bj) {
                    const size_t off = (size_t)tl * 1024 + u.pn * BM + cl + bj * HALF;
                    const u32x4 g4 = *(const u32x4*)(gt + off);
                    u32x4 p4 = (u32x4){0u, 0u, 0u, 0u}; if (isb) p4 = *(const u32x4*)(dst + off);
                    f32x4 v0 = acc[ai][bj][m][0], v1 = acc[ai][bj][m][1];
#ifdef DBG_NOA
                    if (!isb) { v0 = v0 * 0.f; v1 = v1 * 0.f; v0 = (f32x4){0.f,0.f,0.f,0.f}; v1 = v0; }
#endif
#ifdef DBG_NOB
                    if (isb) { v0 = (f32x4){0.f,0.f,0.f,0.f}; v1 = v0; }
#endif
                    u32x4 w;
                    w.x = cvt_pk_bf16(bf_lo(p4.x) + bf_lo(g4.x) * v0[0], bf_hi(p4.x) + bf_hi(g4.x) * v0[1]);
                    w.y = cvt_pk_bf16(bf_lo(p4.y) + bf_lo(g4.y) * v0[2], bf_hi(p4.y) + bf_hi(g4.y) * v0[3]);
                    w.z = cvt_pk_bf16(bf_lo(p4.z) + bf_lo(g4.z) * v1[0], bf_hi(p4.z) + bf_hi(g4.z) * v1[1]);
                    w.w = cvt_pk_bf16(bf_lo(p4.w) + bf_lo(g4.w) * v1[2], bf_hi(p4.w) + bf_hi(g4.w) * v1[3]);
                    *(u32x4*)(dst + off) = w;
                }
            }
    } else {
#pragma unroll
        for (int ai = 0; ai < 2; ++ai)
#pragma unroll
            for (int m = 0; m < 4; ++m) { asm volatile("" ::: "memory");
                const int tg = g.pass * TP + rbase + ai * HALF + m * 16;
                const float* xr = xrow_ptr(g.xp, g.xs, tg); float* orow = g.out + (size_t)tg * DM;
#pragma unroll
                for (int bj = 0; bj < 2; ++bj) {
                    const int c = u.pn * BM + cl + bj * HALF;
                    const f32x4 a0 = *(const f32x4*)(xr + c), a1 = *(const f32x4*)(xr + c + 4);
                    *(f32x4*)(orow + c) = a0 + acc[ai][bj][m][0]; *(f32x4*)(orow + c + 4) = a1 + acc[ai][bj][m][1];
                }
            }
    }
}

__device__ __forceinline__ void gemm_phase(LAS unsigned char* lds, const GemmD& g, int G, int cidx, int tid) {
    const int wid = __builtin_amdgcn_readfirstlane(tid >> 6), lane = tid & 63, wr = wid >> 2, wc = wid & 3, fr = lane & 15, fq = lane >> 4;
    const int K = g.K, nt = K / BK;
    unsigned voffA[2], voffB[2];
#pragma unroll
    for (int i = 0; i < 2; ++i) { int R, C; stage_rc(tid * 16 + i * 8192, R, C); const int Rb = (R & ~31) + perm32(R & 31);
        voffA[i] = (unsigned)(R * g.lda + C) * 2u; voffB[i] = (unsigned)(Rb * g.ldb + C) * 2u; }
    const size_t kstep = (size_t)(BK * 2);
    const size_t hstepA = (size_t)HALF * g.lda * 2, hstepB = (size_t)HALF * g.ldb * 2;
    const size_t tstepA = 2 * hstepA, tstepB = 2 * hstepB;
    const unsigned ldsw = (unsigned)wid * 1024u;
    const int aoff = lds_byte(wr * 64 + fr, fq * 8), boff = lds_byte(wc * 32 + fr, fq * 8);
#define PG8_SA(b, h) (((b) * 2 + (h)) * HTB)
#define PG8_SB(b, h) ((4 + (b) * 2 + (h)) * HTB)
#define PG8_STAGE(bufoff, gbase, voff) do { _Pragma("unroll") for (int _i = 0; _i < 2; ++_i) \
        __builtin_amdgcn_global_load_lds((const unsigned*)((const char*)(gbase) + (voff)[_i]), (LAS unsigned*)(lds + (bufoff) + ldsw + _i * 8192), 16, 0, 0); } while (0)
#define PG8_LDA(dst, b, h) do { _Pragma("unroll") for (int m = 0; m < 4; ++m) _Pragma("unroll") for (int k = 0; k < 2; ++k) dst[m][k] = *(const LAS bf16x8*)(lds + PG8_SA(b, h) + aoff + m * 2048 + k * 1024); } while (0)
#define PG8_LDB(dst, b, h) do { _Pragma("unroll") for (int n = 0; n < 2; ++n) _Pragma("unroll") for (int k = 0; k < 2; ++k) dst[n][k] = *(const LAS bf16x8*)(lds + PG8_SB(b, h) + boff + n * 2048 + k * 1024); } while (0)
#define PG8_MMA(ai, bj, At, Bt) do { __builtin_amdgcn_s_setprio(1); _Pragma("unroll") for (int m = 0; m < 4; ++m) _Pragma("unroll") for (int n = 0; n < 2; ++n) _Pragma("unroll") for (int k = 0; k < 2; ++k) \
        acc[ai][bj][m][n] = __builtin_amdgcn_mfma_f32_16x16x32_bf16(Bt[n][k], At[m][k], acc[ai][bj][m][n], 0, 0, 0); __builtin_amdgcn_s_setprio(0); } while (0)
#define PG8_WAIT_V(n) asm volatile("s_waitcnt vmcnt(" #n ")" ::: "memory")
#define PG8_WAIT_L(n) asm volatile("s_waitcnt lgkmcnt(" #n ")" ::: "memory")
#define PG8_BAR __builtin_amdgcn_s_barrier()
#define PG8_SCHED __builtin_amdgcn_sched_barrier(0)
    Unit cur, nxt; int ui = 0;
    { int pm_, pn_, bz_; if (!unit_next(g, 0, G, cidx, pm_, pn_, bz_)) return; cur.pm = pm_; cur.pn = pn_; cur.bz = bz_; }
    f32x4 acc[2][2][4][2];
#pragma unroll
    for (int a = 0; a < 2; ++a)
#pragma unroll
        for (int b = 0; b < 2; ++b)
#pragma unroll
            for (int m = 0; m < 4; ++m)
#pragma unroll
                for (int n = 0; n < 2; ++n) acc[a][b][m][n] = (f32x4){0.f, 0.f, 0.f, 0.f};
    bf16x8 At[4][2], B0[2][2], B1[2][2];
    const char* cA = (const char*)g.A + (size_t)cur.bz * g.sA + (size_t)cur.pm * tstepA; const char* cB = (const char*)g.Bt + (size_t)cur.bz * g.sB + (size_t)cur.pn * tstepB;
    PG8_STAGE(PG8_SB(0, 0), cB, voffB); PG8_STAGE(PG8_SA(0, 0), cA, voffA); PG8_STAGE(PG8_SB(0, 1), cB + hstepB, voffB); PG8_STAGE(PG8_SA(0, 1), cA + hstepA, voffA);
    if (wr == 1) PG8_BAR;
    PG8_WAIT_V(4); PG8_BAR;
    PG8_STAGE(PG8_SB(1, 0), cB + kstep, voffB); PG8_STAGE(PG8_SA(1, 0), cA + kstep, voffA); PG8_STAGE(PG8_SB(1, 1), cB + hstepB + kstep, voffB);
    PG8_WAIT_V(6); PG8_BAR;
    for (;;) {
        int npm, npn, nbz; const bool has_next = unit_next(g, ui + 1, G, cidx, npm, npn, nbz); nxt.pm = npm; nxt.pn = npn; nxt.bz = nbz;
        const char* nA = has_next ? (const char*)g.A + (size_t)nxt.bz * g.sA + (size_t)nxt.pm * tstepA : cA; const char* nB = has_next ? (const char*)g.Bt + (size_t)nxt.bz * g.sB + (size_t)nxt.pn * tstepB : cB;
        for (int t = 0; t < nt; t += 2) {
            const bool last = (t == nt - 2);
            const char* a1 = cA + (size_t)(t + 1) * kstep;
            const char* a2 = last ? nA : cA + (size_t)(t + 2) * kstep; const char* b2 = last ? nB : cB + (size_t)(t + 2) * kstep;
            const char* a3 = a2 + kstep; const char* b3 = b2 + kstep;
            PG8_LDB(B0, 0, 0); PG8_SCHED; PG8_LDA(At, 0, 0); PG8_STAGE(PG8_SA(1, 1), a1 + hstepA, voffA);
            PG8_WAIT_L(8); PG8_BAR; PG8_WAIT_L(0); PG8_MMA(0, 0, At, B0); PG8_BAR; PG8_SCHED;
            PG8_LDB(B1, 0, 1); PG8_STAGE(PG8_SB(0, 0), b2, voffB);
            PG8_BAR; PG8_WAIT_L(0); PG8_MMA(0, 1, At, B1); PG8_BAR;
            PG8_LDA(At, 0, 1); PG8_STAGE(PG8_SA(0, 0), a2, voffA);
            PG8_BAR; PG8_WAIT_L(0); PG8_MMA(1, 0, At, B0); PG8_BAR; PG8_SCHED;
            PG8_STAGE(PG8_SB(0, 1), b2 + hstepB, voffB);
            PG8_WAIT_V(6); PG8_BAR; PG8_MMA(1, 1, At, B1); PG8_BAR;
            PG8_LDB(B0, 1, 0); PG8_SCHED; PG8_LDA(At, 1, 0); PG8_STAGE(PG8_SA(0, 1), a2 + hstepA, voffA);
            PG8_WAIT_L(8); PG8_BAR; PG8_WAIT_L(0); PG8_MMA(0, 0, At, B0); PG8_BAR; PG8_SCHED;
            PG8_LDB(B1, 1, 1); PG8_STAGE(PG8_SB(1, 0), b3, voffB);
            PG8_BAR; PG8_WAIT_L(0); PG8_MMA(0, 1, At, B1); PG8_BAR;
            PG8_LDA(At, 1, 1); PG8_STAGE(PG8_SA(1, 0), a3, voffA);
            PG8_BAR; PG8_WAIT_L(0); PG8_MMA(1, 0, At, B0); PG8_BAR; PG8_SCHED;
            PG8_STAGE(PG8_SB(1, 1), b3 + hstepB, voffB);
            PG8_WAIT_V(6); PG8_BAR; PG8_MMA(1, 1, At, B1); PG8_BAR;
        }
#ifndef NO_EPI
        epilogue(g, acc, cur, wr, wc, fr, fq);
#else
        if (g.mode == 99) *(f32x4*)(g.out) = acc[0][0][0][0] + acc[1][1][3][1] + acc[0][1][2][0]+acc[1][0][1][1];
#endif
        if (!has_next) break;
#pragma unroll
        for (int a = 0; a < 2; ++a)
#pragma unroll
            for (int b = 0; b < 2; ++b)
#pragma unroll
                for (int m = 0; m < 4; ++m)
#pragma unroll
                    for (int n = 0; n < 2; ++n) acc[a][b][m][n] = (f32x4){0.f, 0.f, 0.f, 0.f};
        cur = nxt; cA = nA; cB = nB; ++ui;
    }
    PG8_WAIT_V(0);
    if (wr == 0) PG8_BAR;
    PG8_BAR;
#undef PG8_SA
#undef PG8_SB
#undef PG8_STAGE
#undef PG8_LDA
#undef PG8_LDB
#undef PG8_MMA
#undef PG8_WAIT_V
#undef PG8_WAIT_L
#undef PG8_BAR
#undef PG8_SCHED
}

__device__ __forceinline__ int qk_perm_row(int n) { const int i = n & 63; return (n & ~63) + 8 * ((i & 31) >> 2) + (i & 3) + 4 * (i >> 5); }
__device__ __forceinline__ void transpose_item(const float* W, int K, int N, bf16_t* WT, bool permqk, LAS float* scr, int item, int lane) {
    const int nblk = N / 32, kb = item / nblk, nb = item % nblk, k0 = 64 * kb, n0 = 32 * nb;
#pragma unroll 8
    for (int i = 0; i < 32; ++i) { const int kk = 2 * i + (lane >> 5); scr[kk * 33 + (lane & 31)] = W[(size_t)(k0 + kk) * N + n0 + (lane & 31)]; }
    asm volatile("s_waitcnt lgkmcnt(0)" ::: "memory");
    const int c = lane & 7;
#pragma unroll
    for (int j = 0; j < 4; ++j) { const int n = (lane >> 3) + 8 * j; const LAS float* s = scr + (8 * c) * 33 + n;
        u32x4 o; o.x = cvt_pk_bf16(s[0 * 33], s[1 * 33]); o.y = cvt_pk_bf16(s[2 * 33], s[3 * 33]); o.z = cvt_pk_bf16(s[4 * 33], s[5 * 33]); o.w = cvt_pk_bf16(s[6 * 33], s[7 * 33]);
        int row = n0 + n; if (permqk && row < 2 * QKVW) row = qk_perm_row(row);
        *(u32x4*)(WT + (size_t)row * K + k0 + 8 * c) = o; }
    asm volatile("s_waitcnt lgkmcnt(0)" ::: "memory");
}
__device__ __forceinline__ void reduce_angle(double a, float& c, float& s) {
    const double k = __builtin_rint(a * 0.6366197723675814); const float x = (float)(a - k * 1.5707963267948966), x2 = x * x;
    const float sn = x * (1.0f + x2 * (-1.6666666667e-1f + x2 * (8.3333333333e-3f + x2 * (-1.9841269841e-4f + x2 * 2.7557319224e-6f))));
    const float cs = 1.0f + x2 * (-0.5f + x2 * (4.1666666667e-2f + x2 * (-1.3888888889e-3f + x2 * (2.4801587302e-5f + x2 * -2.7557319224e-7f))));
    const int q = ((int)k) & 3;
    c = (q == 0) ? cs : (q == 1) ? -sn : (q == 2) ? -cs : sn;
    s = (q == 0) ? sn : (q == 1) ? cs : (q == 2) ? -sn : -cs;
}
__device__ __forceinline__ void rms_row_to_bf16(const float* xrow, const float* gw, bf16_t* orow, int lane) {
    const f32x4* xr = (const f32x4*)xrow + lane; const f32x4* gr = (const f32x4*)gw + lane;
    f32x4 v[4]; float s = 0.f;
#pragma unroll
    for (int j = 0; j < 4; ++j) { v[j] = xr[64 * j]; s += (v[j].x * v[j].x + v[j].y * v[j].y) + (v[j].z * v[j].z + v[j].w * v[j].w); }
    const float rstd = 1.0f / sqrtf(wave_sum(s) * (1.f / DM) + EPSN);
    u32x2* o8 = (u32x2*)orow + lane;
#pragma unroll
    for (int j = 0; j < 4; ++j) { const f32x4 gv = gr[64 * j]; u32x2 w; w.x = cvt_pk_bf16(v[j].x * rstd * gv.x, v[j].y * rstd * gv.y); w.y = cvt_pk_bf16(v[j].z * rstd * gv.z, v[j].w * rstd * gv.w); o8[64 * j] = w; }
}

__device__ __forceinline__ void ssm_setup_item(const Args& a, LAS unsigned char* lds, int item, int tid) {
    const int g = item >> 1, dir = item & 1;
    LAS f32x2* pw = (LAS f32x2*)lds; LAS f32x2* Bb = pw + 33 * 64; LAS f32x2* Cc = Bb + 1024;
    const float* lam_re = a.in[4]; const float* lam_im = a.in[5]; const float* log_step = a.in[6];
    const float* b_re = a.in[7]; const float* b_im = a.in[8]; const float* c_re = a.in[9]; const float* c_im = a.in[10];
    unsigned char* ws = a.ws;
    const float dt = expf(log_step[dir * 32 + g]);
    __syncthreads();
    for (int idx = tid; idx < 33 * 64; idx += 512) {
        const int tau = idx >> 6, n = idx & 63; const float lr = lam_re[(dir * 32 + g) * 64 + n], li = lam_im[(dir * 32 + g) * 64 + n];
        const float mag = expf(lr * dt * (float)tau); float c, s; reduce_angle((double)li * (double)dt * (double)tau, c, s);
        pw[idx] = (f32x2){mag * c, mag * s};
    }
    for (int idx = tid; idx < 1024; idx += 512) {
        { const int n = idx >> 4; const float lr = lam_re[(dir * 32 + g) * 64 + n], li = lam_im[(dir * 32 + g) * 64 + n];
          const float ar = lr * dt; float cb, sb, ch, sh; reduce_angle((double)li * (double)dt, cb, sb); reduce_angle(0.5 * (double)li * (double)dt, ch, sh);
          const float em1 = expm1f(ar), ea = em1 + 1.0f;
          const float nr = em1 * cb - 2.0f * sh * sh, ni = ea * sb;
          const float den = 1.0f / (lr * lr + li * li); const float cr = (nr * lr + ni * li) * den, ci = (ni * lr - nr * li) * den;
          const float br = b_re[(size_t)((dir * 32 + g) * 64) * 16 + idx], bi = b_im[(size_t)((dir * 32 + g) * 64) * 16 + idx];
          Bb[idx] = (f32x2){cr * br - ci * bi, cr * bi + ci * br}; }
        { Cc[idx] = (f32x2){c_re[(size_t)((dir * 32 + g) * 16) * 64 + idx], c_im[(size_t)((dir * 32 + g) * 16) * 64 + idx]}; }
    }
    __syncthreads();
    if (tid < 64) { float* PW = (float*)(ws + WS_PW); const f32x2 p = pw[32 * 64 + tid]; PW[((dir * 32 + g) * 64 + tid) * 2] = p.x; PW[((dir * 32 + g) * 64 + tid) * 2 + 1] = p.y; }
    { float* KT = (float*)(ws + WS_KT) + (size_t)(g * 2 + dir) * 32 * 256;
      for (int o = tid; o < 32 * 256; o += 512) {
          const int tau = o >> 8, co = (o >> 4) & 15, ci = o & 15; float acc = 0.f;
_Pragma("unroll 4")
          for (int n = 0; n < 64; ++n) { const f32x2 c = Cc[co * 64 + n], p = pw[tau * 64 + n], b = Bb[n * 16 + ci]; const float tr = c.x * p.x - c.y * p.y, ti = c.x * p.y + c.y * p.x; acc += tr * b.x - ti * b.y; }
          KT[o] = acc; } }
    { bf16_t* BsT = (bf16_t*)(ws + WS_BST) + (size_t)g * 256 * 512;
      for (int ch = tid; ch < 128 * 64; ch += 512) {
          const int row = ch >> 6, part = row >> 6, n = row & 63, kc = ch & 63, s = kc >> 1, ci0 = (kc & 1) * 8; const int e = dir ? s : 31 - s; const f32x2 p = pw[e * 64 + n];
          float v[8];
#pragma unroll
          for (int j = 0; j < 8; ++j) { const f32x2 b = Bb[n * 16 + ci0 + j]; v[j] = part ? (p.x * b.y + p.y * b.x) : (p.x * b.x - p.y * b.y); }
          u32x4 w; w.x = cvt_pk_bf16(v[0], v[1]); w.y = cvt_pk_bf16(v[2], v[3]); w.z = cvt_pk_bf16(v[4], v[5]); w.w = cvt_pk_bf16(v[6], v[7]);
          *(u32x4*)(BsT + (size_t)(dir * 128 + row) * 512 + s * 16 + ci0) = w; } }
    { bf16_t* MtC = (bf16_t*)(ws + WS_MTC) + (size_t)g * 512 * UHK;
      for (int ch = tid; ch < 512 * 16; ch += 512) {
          const int row = ch >> 4, t = row >> 4, co = row & 15, cc = ch & 15, part = cc >> 3, n0 = (cc & 7) * 8; const int e = dir ? 32 - t : t + 1;
          float v[8];
#pragma unroll
          for (int j = 0; j < 8; ++j) { const f32x2 c = Cc[co * 64 + n0 + j], p = pw[e * 64 + n0 + j]; v[j] = part ? -(c.x * p.y + c.y * p.x) : (c.x * p.x - c.y * p.y); }
          u32x4 w; w.x = cvt_pk_bf16(v[0], v[1]); w.y = cvt_pk_bf16(v[2], v[3]); w.z = cvt_pk_bf16(v[4], v[5]); w.w = cvt_pk_bf16(v[6], v[7]);
          *(u32x4*)(MtC + (size_t)row * UHK + 512 + dir * 128 + part * 64 + n0) = w; } }
    __syncthreads();
}

__device__ __forceinline__ void step_setup(const Args& a, LAS unsigned char* lds, int tid, int bx) {
    const int lane = tid & 63, wave = tid >> 6, G = gridDim.x;
    unsigned char* ws = a.ws;
    if (bx == 0 && tid < 64) ((unsigned*)(ws + WS_CTL))[tid] = 0u;
    for (int it = bx; it < 64; it += G) ssm_setup_item(a, lds, it, tid);
    { float* rc = (float*)(ws + WS_ROPE); float* rs = rc + SEQL * 32;
      for (int idx = bx * 512 + tid; idx < SEQL * 32; idx += G * 512) {
          const int pos = idx >> 5, i = idx & 31; double inv = 1.0; for (int k = 0; k < i; ++k) inv *= 0.7498942093324558;
          float c, s; reduce_angle((double)pos * inv, c, s); rc[idx] = c; rs[idx] = s; } }
    { LAS float* scr = (LAS float*)(lds) + wave * (64 * 33);
      const int gw = bx * 8 + wave, NGW = G * 8;
      constexpr int I_IN = (DM / 64) * (INC / 32), I_GLU = (512 / 64) * (512 / 32), I_AB = (512 / 64) * (1024 / 32), I_OUT = (1024 / 64) * (1024 / 32);
      constexpr int NIT = I_IN + I_GLU + 2 * I_AB + I_OUT;
      for (int it = gw; it < NIT; it += NGW) {
          int r = it;
          if (r < I_IN) { transpose_item(a.in[3], DM, INC, (bf16_t*)(ws + WS_WIN), true, scr, r, lane); continue; } r -= I_IN;
          if (r < I_GLU) { transpose_item(a.in[12], 512, 512, (bf16_t*)(ws + WS_WGLU), false, scr, r, lane); continue; } r -= I_GLU;
          if (r < I_AB) { transpose_item(a.in[13], 512, 1024, (bf16_t*)(ws + WS_WA), false, scr, r, lane); continue; } r -= I_AB;
          if (r < I_AB) { transpose_item(a.in[14], 512, 1024, (bf16_t*)(ws + WS_WB), false, scr, r, lane); continue; } r -= I_AB;
          transpose_item(a.in[15], 1024, 1024, (bf16_t*)(ws + WS_WOUT), false, scr, r, lane);
      } }
    { bf16_t* hn = (bf16_t*)((unsigned char*)a.out + OUT_HN_OFF);
      for (int row = bx * 8 + wave; row < TTOK; row += G * 8) rms_row_to_bf16(xrow_ptr(a.in[0], a.in[1], row), a.in[2], hn + (size_t)row * DM, lane); }
}

struct KVBuf { bf16x8 kA0, kA1, kB0, kB1; bf16x4 vA[4], vB[4]; };
__device__ __forceinline__ void step_params(int s, int& gi, int& ls) { gi = s < 12 ? 0 : (s < 18 ? 1 : 2); ls = s < 12 ? s : (s < 18 ? s - 12 : s - 18); }
__device__ __forceinline__ void attn_load(KVBuf& b, const bf16_t* Kp, const bf16_t* Vt, int s, int sq, int h, int blk, int r, int lane) {
    int gi, ls; step_params(s, gi, ls);
    const int sh = 2 * gi, Lg = SEQL >> sh, rho = r & ((1 << sh) - 1);
    int uA = ((256 * blk) >> sh) - 64 + 32 * ls, uB = uA + 16;
    if (uA < 0 || uA >= Lg) uA = 0; if (uB < 0 || uB >= Lg) uB = 0;
    const int kl = lane & 15, quad = lane >> 4;
    const bf16_t* ka = Kp + (size_t)(sq * SEQL + rho + ((uA + kl) << sh)) * QKVW + gi * 512 + h * 64 + quad * 8;
    const bf16_t* kb = Kp + (size_t)(sq * SEQL + rho + ((uB + kl) << sh)) * QKVW + gi * 512 + h * 64 + quad * 8;
    b.kA0 = *(const bf16x8*)ka; b.kA1 = *(const bf16x8*)(ka + 32); b.kB0 = *(const bf16x8*)kb; b.kB1 = *(const bf16x8*)(kb + 32);
    const bf16_t* vbase = Vt + (size_t)(((sq * 3 + gi) * 8 + h) * 512) * 1024 + kl * 16 + quad * 4;
    const bf16_t* va = vbase + (size_t)((rho * Lg + uA) >> 4) * 1024; const bf16_t* vb = vbase + (size_t)((rho * Lg + uB) >> 4) * 1024;
#pragma unroll
    for (int dt = 0; dt < 4; ++dt) { b.vA[dt] = *(const bf16x4*)(va + dt * 256); b.vB[dt] = *(const bf16x4*)(vb + dt * 256); }
}
struct QF { bf16x8 a0, a1, b0, b1, c0, c1; };
template <int gi>
__device__ __forceinline__ void attn_compute(const KVBuf& b, const bf16x8 q0, const bf16x8 q1, f32x4 (&o)[4], float& mrun, float& lrun, int s, int blk, int r, int lane) {
    const int ls = gi == 0 ? s : (gi == 1 ? s - 12 : s - 18);
    const int sh = 2 * gi, Lg = SEQL >> sh;
    const int uA = ((256 * blk) >> sh) - 64 + 32 * ls;
    const int qi = lane & 15, quad = lane >> 4;
    const int uq = (256 * blk + r + 16 * qi) >> sh;
    const int lo = max(0, uq - 64), hi = min(Lg - 1, uq + 64);
    f32x4 sA = (f32x4){0.f, 0.f, 0.f, 0.f}, sB = sA;
    sA = __builtin_amdgcn_mfma_f32_16x16x32_bf16(b.kA0, q0, sA, 0, 0, 0); sA = __builtin_amdgcn_mfma_f32_16x16x32_bf16(b.kA1, q1, sA, 0, 0, 0);
    sB = __builtin_amdgcn_mfma_f32_16x16x32_bf16(b.kB0, q0, sB, 0, 0, 0); sB = __builtin_amdgcn_mfma_f32_16x16x32_bf16(b.kB1, q1, sB, 0, 0, 0);
    const float NEGINF = -__builtin_inff();
    const unsigned span = (unsigned)(hi - lo);
    float mx = NEGINF;
#pragma unroll
    for (int j = 0; j < 4; ++j) {
        const int ua = uA + quad * 4 + j, ub = ua + 16;
        sA[j] = ((unsigned)(ua - lo) <= span) ? sA[j] : NEGINF; sB[j] = ((unsigned)(ub - lo) <= span) ? sB[j] : NEGINF;
        mx = fmaxf(mx, fmaxf(sA[j], sB[j]));
    }
    mx = fmaxf(mx, __shfl_xor(mx, 16)); mx = fmaxf(mx, __shfl_xor(mx, 32));
    const float mnew = fmaxf(mrun, mx), alpha = __builtin_amdgcn_exp2f(mrun - mnew);
    mrun = mnew;
    float ps = 0.f;
#pragma unroll
    for (int j = 0; j < 4; ++j) { sA[j] = __builtin_amdgcn_exp2f(sA[j] - mnew); sB[j] = __builtin_amdgcn_exp2f(sB[j] - mnew); ps += sA[j] + sB[j]; }
    lrun = lrun * alpha + ps;
    u32x4 pw; pw.x = cvt_pk_bf16(sA[0], sA[1]); pw.y = cvt_pk_bf16(sA[2], sA[3]); pw.z = cvt_pk_bf16(sB[0], sB[1]); pw.w = cvt_pk_bf16(sB[2], sB[3]);
    const bf16x8 pf = __builtin_bit_cast(bf16x8, pw);
#pragma unroll
    for (int dt = 0; dt < 4; ++dt) {
        o[dt] *= alpha;
        bf16x8 vf; vf[0] = b.vA[dt][0]; vf[1] = b.vA[dt][1]; vf[2] = b.vA[dt][2]; vf[3] = b.vA[dt][3]; vf[4] = b.vB[dt][0]; vf[5] = b.vB[dt][1]; vf[6] = b.vB[dt][2]; vf[7] = b.vB[dt][3];
#ifdef DBG_ATT2
        for (int e = 0; e < 8; ++e) o[dt][e & 3] += 1e-3f * __uint_as_float(((unsigned)(unsigned short)vf[e]) << 16);
#else
        o[dt] = __builtin_amdgcn_mfma_f32_16x16x32_bf16(vf, pf, o[dt], 0, 0, 0);
#endif
    }
}
__device__ __forceinline__ void step_attention(const Args& a, int pass, int tid) {
    unsigned char* ws = a.ws;
    const int lane = tid & 63;
    const bf16_t* Qp = (const bf16_t*)(ws + WS_Q); const bf16_t* Kp = (const bf16_t*)(ws + WS_K); const bf16_t* Vt = (const bf16_t*)(ws + WS_VT);
    const bf16_t* ZA = (const bf16_t*)(ws + WS_ZA); bf16_t* GAO = (bf16_t*)(ws + WS_GAO);
    unsigned* ctr = (unsigned*)(ws + WS_CTL) + 8 + pass;
    constexpr int NITEMS = SEQP * 8 * 32 * 16;
    for (;;) {
        unsigned it = 0; if (lane == 0) it = atomicAdd(ctr, 1u);
        it = (unsigned)__builtin_amdgcn_readfirstlane((int)it);
        if (it >= (unsigned)NITEMS) break;
        const int r = it & 15, blk = (it >> 4) & 31, h = (it >> 9) & 7, sq = it >> 12;
        const int qi = lane & 15, quad = lane >> 4;
        const int tq = sq * SEQL + 256 * blk + r + 16 * qi;
        QF qf;
        { const bf16_t* qp = Qp + (size_t)tq * QKVW + h * 64 + quad * 8;
          qf.a0 = *(const bf16x8*)qp; qf.a1 = *(const bf16x8*)(qp + 32); qf.b0 = *(const bf16x8*)(qp + 512); qf.b1 = *(const bf16x8*)(qp + 544); qf.c0 = *(const bf16x8*)(qp + 1024); qf.c1 = *(const bf16x8*)(qp + 1056); }
        f32x4 o[4];
#pragma unroll
        for (int dt = 0; dt < 4; ++dt) o[dt] = (f32x4){0.f, 0.f, 0.f, 0.f};
        float mrun = -1e30f, lrun = 0.f;
        KVBuf b0, b1;
        attn_load(b0, Kp, Vt, 0, sq, h, blk, r, lane);
#define ATT_LOOP(GI, S0, S1, QA, QB) _Pragma("unroll 1") for (int s = S0; s < S1; s += 2) { \
            attn_load(b1, Kp, Vt, s + 1, sq, h, blk, r, lane); attn_compute<GI>(b0, QA, QB, o, mrun, lrun, s, blk, r, lane); \
            attn_load(b0, Kp, Vt, s + 2, sq, h, blk, r, lane); attn_compute<GI>(b1, QA, QB, o, mrun, lrun, s + 1, blk, r, lane); }
        ATT_LOOP(0, 0, 12, qf.a0, qf.a1)
        ATT_LOOP(1, 12, 18, qf.b0, qf.b1)
        ATT_LOOP(2, 18, 22, qf.c0, qf.c1)
#undef ATT_LOOP
        attn_compute<2>(b0, qf.c0, qf.c1, o, mrun, lrun, 22, blk, r, lane);
        float l = lrun; l += __shfl_xor(l, 16); l += __shfl_xor(l, 32);
        float inv = 1.0f / l;
#ifdef DBG_ATT1
        for (int dt = 0; dt < 4; ++dt) o[dt] = (f32x4){1.f, 1.f, 1.f, 1.f};
#endif
#pragma unroll
        for (int dt = 0; dt < 4; ++dt) {
            const size_t off = (size_t)tq * 512 + h * 64 + 16 * dt + 4 * quad;
            const u32x2 z = *(const u32x2*)(ZA + off);
            u32x2 w; w.x = cvt_pk_bf16(o[dt][0] * inv * bf_lo(z.x), o[dt][1] * inv * bf_hi(z.x)); w.y = cvt_pk_bf16(o[dt][2] * inv * bf_lo(z.y), o[dt][3] * inv * bf_hi(z.y));
            *(u32x2*)(GAO + off) = w;
        }
    }
}

__device__ __forceinline__ f32x2 cmul(f32x2 a, f32x2 b) { return (f32x2){a.x * b.x - a.y * b.y, a.x * b.y + a.y * b.x}; }
__device__ __forceinline__ void step_scan(const Args& a, LAS unsigned char* lds, int pass, int tid, int bx) {
    unsigned char* ws = a.ws; const int G = gridDim.x;
    const float* PW = (const float*)(ws + WS_PW); const float* S = (const float*)(ws + WS_S); bf16_t* UH = (bf16_t*)(ws + WS_UH);
    LAS f32x2* carry = (LAS f32x2*)lds;
    for (int it = bx; it < SEQP * 32 * 2; it += G) {
        const int dir = it & 1, g = (it >> 1) & 31, sq = it >> 6; const int seg = tid >> 6, n = tid & 63;
        const f32x2 P = (f32x2){PW[((dir * 32 + g) * 64 + n) * 2], PW[((dir * 32 + g) * 64 + n) * 2 + 1]};
        f32x2 z[32];
        { const int c0 = dir ? (NCH - 1 - seg * 32) : seg * 32; const long stp = dir ? -256 : 256;
          const float* sp = S + ((size_t)g * CHP + sq * NCH + c0) * 256 + dir * 128 + n;
#pragma unroll
          for (int i = 0; i < 32; ++i) { z[i] = (f32x2){sp[0], sp[64]}; sp += stp; } }
        f32x2 zz = (f32x2){0.f, 0.f};
#pragma unroll
        for (int i = 0; i < 32; ++i) { const f32x2 t = z[i]; z[i] = zz; zz = cmul(P, zz) + t; }
        __syncthreads();
        carry[seg * 64 + n] = zz;
        __syncthreads();
        f32x2 P32 = P;
#pragma unroll
        for (int k = 0; k < 5; ++k) P32 = cmul(P32, P32);
        f32x2 x = (f32x2){0.f, 0.f};
        for (int sp = 0; sp < seg; ++sp) x = cmul(P32, x) + carry[sp * 64 + n];
        f32x2 pwr = (f32x2){1.f, 0.f};
        { const int c0 = dir ? (NCH - 1 - seg * 32) : seg * 32; const long stp = dir ? -(long)UHK : (long)UHK;
          bf16_t* up = UH + ((size_t)g * CHP + sq * NCH + c0) * UHK + 512 + dir * 128 + n;
#pragma unroll
          for (int i = 0; i < 32; ++i) {
              const f32x2 hin = z[i] + cmul(pwr, x);
              up[0] = (bf16_t)(cvt_pk_bf16(hin.x, 0.f) & 0xffffu); up[64] = (bf16_t)(cvt_pk_bf16(hin.y, 0.f) & 0xffffu);
              pwr = cmul(pwr, P); up += stp;
          } }
    }
    if (pass == 0) {
        const float* KT = (const float*)(ws + WS_KT); const float* dsk = a.in[11]; bf16_t* MtC = (bf16_t*)(ws + WS_MTC);
        for (int ch = bx * 512 + tid; ch < 32 * 512 * 64; ch += G * 512) {
            const int kc = ch & 63, row = (ch >> 6) & 511, g = ch >> 15; const int s = kc >> 1, ci0 = (kc & 1) * 8, t = row >> 4, co = row & 15;
            float v[8];
#pragma unroll
            for (int j = 0; j < 8; ++j) v[j] = 0.f;
            if (t >= s) { const float* kp = KT + ((size_t)((g * 2 + 0) * 32 + (t - s)) * 16 + co) * 16 + ci0;
#pragma unroll
                for (int j = 0; j < 8; ++j) v[j] += kp[j]; }
            if (s >= t) { const float* kp = KT + ((size_t)((g * 2 + 1) * 32 + (s - t)) * 16 + co) * 16 + ci0;
#pragma unroll
                for (int j = 0; j < 8; ++j) v[j] += kp[j]; }
            if (t == s) { const float dv = dsk[g * 16 + co];
#pragma unroll
                for (int j = 0; j < 8; ++j) v[j] += (ci0 + j == co) ? dv : 0.f; }
            u32x4 w; w.x = cvt_pk_bf16(v[0], v[1]); w.y = cvt_pk_bf16(v[2], v[3]); w.z = cvt_pk_bf16(v[4], v[5]); w.w = cvt_pk_bf16(v[6], v[7]);
            *(u32x4*)(MtC + ((size_t)g * 512 + row) * UHK + s * 16 + ci0) = w;
        }
    }
}

__device__ __forceinline__ void step_final_norm(const Args& a, int pass, int tid, int bx) {
    const int lane = tid & 63, wave = tid >> 6, G = gridDim.x;
    const f32x4* gr = (const f32x4*)a.in[16] + lane;
    for (int row = bx * 8 + wave; row < TP; row += G * 8) {
        f32x4* xr = (f32x4*)(a.out + (size_t)(pass * TP + row) * DM) + lane;
        f32x4 v[4]; float s = 0.f;
#pragma unroll
        for (int j = 0; j < 4; ++j) { v[j] = xr[64 * j]; s += (v[j].x * v[j].x + v[j].y * v[j].y) + (v[j].z * v[j].z + v[j].w * v[j].w); }
        const float rstd = 1.0f / sqrtf(wave_sum(s) * (1.f / DM) + EPSN);
#pragma unroll
        for (int j = 0; j < 4; ++j) { f32x4 o = v[j] * rstd * gr[64 * j];
#ifdef DBG_SANITIZE
            for (int e = 0; e < 4; ++e) if (!(fabsf(o[e]) < 1e30f)) o[e] = 100.0f;
#endif
            xr[64 * j] = o; }
    }
}

constexpr int NSTEPS = 1 + 10 * NPASS;
__host__ __device__ __forceinline__ bool sync_after(int st) { if (st == 0) return true; const int k = (st - 1) % 10; return !(k == 1 || k == 6 || k == 9); }

__global__ void __launch_bounds__(512, 2) fwd_kernel(Args a) {
    extern __shared__ __attribute__((aligned(16))) unsigned char lds_raw[];
    LAS unsigned char* lds = (LAS unsigned char*)lds_raw;
    cg::grid_group grid = cg::this_grid();
    const int G = gridDim.x;
    unsigned char* ws = a.ws;
    for (int st = a.st_lo; st < a.st_hi; ++st) {
        int tid = threadIdx.x, bx = blockIdx.x;
        asm volatile("" : "+v"(tid), "+s"(bx));
#ifndef NO_SETUP
        if (st == 0) { step_setup(a, lds, tid, bx); }
#else
        if (st == 0) {}
#endif
        else {
            const int pass = (st - 1) / 10, k = (st - 1) % 10;
            GemmD g; g.ws = ws; g.out = a.out; g.xp = a.in[0]; g.xs = a.in[1]; g.pass = pass; g.nb = 1; g.sA = 0; g.sB = 0;
            bool has_gemm = true;
            switch (k) {
            case 0: g.A = (const bf16_t*)((unsigned char*)a.out + OUT_HN_OFF) + (size_t)pass * TP * DM; g.lda = DM; g.Bt = (const bf16_t*)(ws + WS_WIN); g.ldb = DM; g.K = DM; g.nM = TP / BM; g.nN = INC / BM; g.mode = MODE_PROJ; break;
            case 1: g.A = (const bf16_t*)(ws + WS_UH); g.lda = UHK; g.sA = (size_t)CHP * UHK * 2; g.Bt = (const bf16_t*)(ws + WS_BST); g.ldb = 512; g.sB = (size_t)256 * 512 * 2; g.K = 512; g.nM = CHP / BM; g.nN = 1; g.nb = 32; g.mode = MODE_S; break;
            case 4: g.A = (const bf16_t*)(ws + WS_UH); g.lda = UHK; g.sA = (size_t)CHP * UHK * 2; g.Bt = (const bf16_t*)(ws + WS_MTC); g.ldb = UHK; g.sB = (size_t)512 * UHK * 2; g.K = UHK; g.nM = CHP / BM; g.nN = 2; g.nb = 32; g.mode = MODE_Y; break;
            case 5: g.A = (const bf16_t*)(ws + WS_SG); g.lda = 512; g.Bt = (const bf16_t*)(ws + WS_WGLU); g.ldb = 512; g.K = 512; g.nM = TP / BM; g.nN = 2; g.mode = MODE_GLU; break;
            case 6: g.A = (const bf16_t*)(ws + WS_GAO); g.lda = 512; g.Bt = (const bf16_t*)(ws + WS_WA); g.ldb = 512; g.K = 512; g.nM = TP / BM; g.nN = 4; g.mode = MODE_A; break;
            case 7: g.A = (const bf16_t*)(ws + WS_SB); g.lda = 512; g.Bt = (const bf16_t*)(ws + WS_WB); g.ldb = 512; g.K = 512; g.nM = TP / BM; g.nN = 4; g.mode = MODE_B; break;
            case 8: g.A = (const bf16_t*)(ws + WS_M1); g.lda = 1024; g.Bt = (const bf16_t*)(ws + WS_WOUT); g.ldb = 1024; g.K = 1024; g.nM = TP / BM; g.nN = 4; g.mode = MODE_OUT; break;
            default: has_gemm = false; g.A = nullptr; g.Bt = nullptr; g.lda = g.ldb = g.K = 0; g.nM = g.nN = 0; g.mode = 0; break;
            }
            if (has_gemm) {
#ifndef NO_GEMM
                gemm_phase(lds, g, G, bx, tid);
#endif
            }
#ifndef NO_ATTN
            else if (k == 2) step_attention(a, pass, tid);
#endif
#ifndef NO_SCAN
            else if (k == 3) step_scan(a, lds, pass, tid, bx);
#endif
            else if (k == 9) step_final_norm(a, pass, tid, bx);
        }
        if (a.do_sync && st + 1 < a.st_hi && sync_after(st)) grid.sync();
    }
}

extern "C" void kernel_launch(void* const* d_in, const int* in_sizes, int n_in, void* d_out, int out_size, void* d_ws, size_t ws_size, hipStream_t stream) {
    constexpr int LDS_BYTES = STAGE_BYTES;
    static int grid = 0;
    if (grid == 0) {
        if (n_in != 17 || out_size != TTOK * DM || ws_size < WS_END) { fprintf(stderr, "kernel_launch: unexpected shapes (n_in %d out %d ws %zu need %zu)\n", n_in, out_size, ws_size, (size_t)WS_END); grid = -1; return; }
        int dev = 0, cus = 0, per_cu = 0;
        hipGetDevice(&dev); hipDeviceGetAttribute(&cus, hipDeviceAttributeMultiprocessorCount, dev);
        hipFuncSetAttribute((const void*)fwd_kernel, hipFuncAttributeMaxDynamicSharedMemorySize, LDS_BYTES);
        hipOccupancyMaxActiveBlocksPerMultiprocessor(&per_cu, (const void*)fwd_kernel, 512, LDS_BYTES);
        if (per_cu < 1) per_cu = 1;
        grid = cus * 1;
        (void)hipGetLastError();
    }
    if (grid < 0) return;
    Args a{};
    for (int i = 0; i < 17; ++i) a.in[i] = (const float*)d_in[i];
    a.out = (float*)d_out; a.ws = (unsigned char*)d_ws; a.pad = 0;
#ifndef MULTI_LAUNCH
#define MULTI_LAUNCH 0
#endif
#if MULTI_LAUNCH
    a.do_sync = 0;
    for (int st = 0; st < NSTEPS; ++st) {
        a.st_lo = st; a.st_hi = st + 1;
        hipLaunchKernelGGL(fwd_kernel, dim3(grid), dim3(512), LDS_BYTES, stream, a);
    }
#else
    a.do_sync = 1; a.st_lo = 0; a.st_hi = NSTEPS;
    void* args[] = {&a};
    hipError_t e = hipLaunchCooperativeKernel((const void*)fwd_kernel, dim3(grid), dim3(512), args, LDS_BYTES, stream);
    if (e != hipSuccess) fprintf(stderr, "cooperative launch failed: %s (grid %d)\n", hipGetErrorString(e), grid);
#endif
}
```

```cpp
#include <hip/hip_runtime.h>
#include <hip/hip_cooperative_groups.h>
#include <cstdio>

namespace cg = cooperative_groups;

#define LAS __attribute__((address_space(3)))
typedef unsigned short bf16_t;
typedef short bf16x8 __attribute__((ext_vector_type(8)));
typedef short bf16x4 __attribute__((ext_vector_type(4)));
typedef float f32x4 __attribute__((ext_vector_type(4)));
typedef float f32x2 __attribute__((ext_vector_type(2)));
typedef unsigned u32x4 __attribute__((ext_vector_type(4)));
typedef unsigned u32x2 __attribute__((ext_vector_type(2)));

constexpr int DM = 1024, SEQL = 8192, NSEQ = 6, TTOK = NSEQ * SEQL;
constexpr int NPASS = 2, SEQP = 3, TP = SEQP * SEQL;
constexpr int INC = 8192, QKVW = 1536;
constexpr int LC = 32, NCH = SEQL / LC  , CHP = SEQP * NCH  ;
constexpr int UHK = LC * 16 + 256;
constexpr float EPSN = 1e-6f;
constexpr float QSCALE = 0.18033688011112042f;

constexpr size_t AL(size_t x) { return (x + 255) & ~(size_t)255; }
constexpr size_t WS_CTL = 0;
constexpr size_t WS_WIN = 4096;
constexpr size_t WS_WGLU = WS_WIN + (size_t)INC * DM * 2;
constexpr size_t WS_WA = WS_WGLU + (size_t)512 * 512 * 2;
constexpr size_t WS_WB = WS_WA + (size_t)1024 * 512 * 2;
constexpr size_t WS_WOUT = WS_WB + (size_t)1024 * 512 * 2;
constexpr size_t WS_MTC = WS_WOUT + (size_t)1024 * 1024 * 2;
constexpr size_t WS_BST = WS_MTC + (size_t)32 * 512 * UHK * 2;
constexpr size_t WS_ROPE = WS_BST + (size_t)32 * 256 * 512 * 2;
constexpr size_t WS_PW = WS_ROPE + (size_t)2 * SEQL * 32 * 4;
constexpr size_t WS_KT = WS_PW + (size_t)2 * 32 * 64 * 8;
constexpr size_t WS_Q = WS_KT + (size_t)32 * 2 * 32 * 256 * 4;
constexpr size_t WS_K = WS_Q + (size_t)TP * QKVW * 2;
constexpr size_t WS_VT = WS_K + (size_t)TP * QKVW * 2;
constexpr size_t WS_ZA = WS_VT + (size_t)TP * QKVW * 2;
constexpr size_t WS_ZB = WS_ZA + (size_t)TP * 512 * 2;
constexpr size_t WS_GA = WS_ZB + (size_t)TP * 512 * 2;
constexpr size_t WS_GB = WS_GA + (size_t)TP * 1024 * 2;
constexpr size_t WS_UH = WS_GB + (size_t)TP * 1024 * 2;
constexpr size_t WS_S = WS_UH + (size_t)32 * CHP * UHK * 2;
constexpr size_t WS_GAO = WS_S + (size_t)32 * CHP * 256 * 4;
constexpr size_t WS_END = WS_GAO + (size_t)TP * 512 * 2;
constexpr size_t WS_SG = WS_Q;
constexpr size_t WS_SB = WS_Q + (size_t)TP * 512 * 2;
constexpr size_t WS_M1 = WS_K;
constexpr size_t OUT_HN_OFF = (size_t)SEQP * SEQL * DM * 4;

struct Args {
    const float* in[17];
    float* out;
    unsigned char* ws;
    int st_lo, st_hi;
    int do_sync, pad;
};

typedef __bf16 bf16v2 __attribute__((ext_vector_type(2)));
__device__ __forceinline__ unsigned cvt_pk_bf16(float lo, float hi) { const f32x2 v = (f32x2){lo, hi}; const bf16v2 r = __builtin_convertvector(v, bf16v2); return __builtin_bit_cast(unsigned, r); }
__device__ __forceinline__ float bf_lo(unsigned w) { return __uint_as_float(w << 16); }
__device__ __forceinline__ float bf_hi(unsigned w) { return __uint_as_float(w & 0xffff0000u); }
__device__ __forceinline__ float fast_rcp(float x) { return __builtin_amdgcn_rcpf(x); }
__device__ __forceinline__ float sigmoidf_(float x) { return fast_rcp(1.0f + __builtin_amdgcn_exp2f(-1.4426950408889634f * x)); }
__device__ __forceinline__ float siluf_(float x) { return x * sigmoidf_(x); }
__device__ __forceinline__ float gelu_tanh(float x) { const float u = x * (1.5957691216057308f + 0.07135481627260025f * x * x); return x * sigmoidf_(u); }
__device__ __forceinline__ float wave_sum(float v) {
#pragma unroll
    for (int o = 1; o < 64; o <<= 1) v += __shfl_xor(v, o);
    return v;
}
__device__ __forceinline__ const float* xrow_ptr(const float* xp, const float* xs, int tg) {
    return tg < 4 * SEQL ? xp + (size_t)tg * DM : xs + (size_t)(tg - 4 * SEQL) * DM;
}

constexpr int BM = 256, BK = 64, HALF = 128, HTB = HALF * BK * 2, STAGE_BYTES = 8 * HTB, NXCD = 8, WGM = 8;
__host__ __device__ __forceinline__ int lds_byte(int r, int c) { const int st = (r >> 4) * 2 + (c >> 5), rr = r & 15, cc = c & 31, ob = rr * 64 + cc * 2; return st * 1024 + (ob ^ (((ob >> 9) & 1) << 5)); }
__host__ __device__ __forceinline__ void stage_rc(int b, int& R, int& C) { const int st = b / 1024, sb = b % 1024, swz = sb ^ (((sb >> 9) & 1) << 5); R = (st >> 1) * 16 + swz / 64; C = (st & 1) * 32 + (swz % 64) / 2; }
__host__ __device__ __forceinline__ int perm32(int rho) { const int n = rho >> 4, i = rho & 15; return 8 * (i >> 2) + 4 * n + (i & 3); }

enum { MODE_PROJ = 0, MODE_S = 1, MODE_Y = 2, MODE_GLU = 3, MODE_A = 4, MODE_B = 5, MODE_OUT = 6 };
struct Unit { int pm, pn, bz; };
struct GemmD {
    const bf16_t* A; const bf16_t* Bt;
    int lda, ldb, K, nM, nN, nb;
    size_t sA, sB;
    int mode, pass;
    unsigned char* ws; float* out; const float* xp; const float* xs;
};
__device__ __forceinline__ bool unit_next(const GemmD& g, int i, int G, int c, int& pm, int& pn, int& bz) {
    const int nwg = g.nM * g.nN;
    const long L = (long)i * G + c; const bool ok = L < (long)nwg * g.nb;
    const int Li = ok ? (int)L : 0;
    int wgid = Li; { const int q = nwg / NXCD, r = nwg % NXCD, xcd = wgid % NXCD, off = wgid / NXCD; wgid = (xcd < r ? xcd * (q + 1) : r * (q + 1) + (xcd - r) * q) + off; }
    const int nig = WGM * g.nN, gid = wgid / nig, fm = gid * WGM, gsz = (g.nM - fm) < WGM ? (g.nM - fm) : WGM;
    const int pm1 = fm + ((wgid % nig) % gsz), pn1 = (wgid % nig) / gsz;
    const int w = Li % nwg, bz2 = Li / nwg, pm2 = w % g.nM, pn2 = w / g.nM;
    const bool single = g.nb == 1;
    pm = single ? pm1 : pm2; pn = single ? pn1 : pn2; bz = single ? 0 : bz2;
    return ok;
}

__device__ __forceinline__ void epilogue(LAS unsigned char* lds, const GemmD& g, const f32x4 (&acc)[2][2][4][2], const Unit& u, int wr, int wc, int fr, int fq) {
    asm volatile("" : "+v"(fr), "+v"(fq));
    unsigned char* ws = g.ws;
    const int rbase = u.pm * BM + wr * 64 + fr;
    const int cl = wc * 32 + fq * 8;
    if (g.mode == MODE_PROJ) {
        const int pn = u.pn;
        if (pn < 12) {
            const bool isq = pn < 6;
            bf16_t* dst = (bf16_t*)(ws + (isq ? WS_Q : WS_K));
            const float* rc = (const float*)(ws + WS_ROPE); const float* rs = rc + SEQL * 32;
            const int a4 = 4 * (4 * (wc & 1) + fq);
            const int pq = isq ? pn : pn - 6, gi = pq >> 1, sh = 2 * gi, dmask = (1 << sh) - 1, Lg = SEQL >> sh;
            const float sc = isq ? QSCALE : 1.0f;
#pragma unroll
            for (int ai = 0; ai < 2; ++ai)
#pragma unroll
                for (int m = 0; m < 4; ++m) { asm volatile("" ::: "memory");
                    const int tl = rbase + ai * HALF + m * 16; const int pos = tl & (SEQL - 1), sq = tl >> 13;
                    const int kidx = (pos & dmask) * Lg + (pos >> sh);
                    const f32x4 cv = *(const f32x4*)(rc + pos * 32 + a4) * sc, sv = *(const f32x4*)(rs + pos * 32 + a4) * sc;
#pragma unroll
                    for (int bj = 0; bj < 2; ++bj) {
                        const f32x4 x1 = acc[ai][bj][m][0], x2 = acc[ai][bj][m][1];
                        const f32x4 o1 = x1 * cv - x2 * sv, o2 = x2 * cv + x1 * sv;
                        const int head = pq * 4 + 2 * bj + (wc >> 1);
                        bf16_t* p = dst + (size_t)(sq * 24 + head) * SEQL * 64 + (isq ? (size_t)kidx * 64 + a4 : (size_t)(kidx >> 4) * 1024 + (a4 >> 3) * 128 + (kidx & 15) * 8 + (a4 & 7));
                        const int half2 = isq ? 32 : 512;
                        u32x2 w1, w2; w1.x = cvt_pk_bf16(o1[0], o1[1]); w1.y = cvt_pk_bf16(o1[2], o1[3]); w2.x = cvt_pk_bf16(o2[0], o2[1]); w2.y = cvt_pk_bf16(o2[2], o2[3]);
                        *(u32x2*)p = w1; *(u32x2*)(p + half2) = w2;
                    }
                }
        } else if (pn < 18) {
            bf16_t* dst = (bf16_t*)(ws + WS_VT);
            const int gi = (pn - 12) >> 1, sh = 2 * gi;
            const int wid = wr * 4 + wc, lane = fq * 16 + fr;
            LAS bf16_t* tile = (LAS bf16_t*)(lds + STAGE_BYTES + wid * 4096);
#pragma unroll
            for (int ai = 0; ai < 2; ++ai) {
                const int tl0 = u.pm * BM + wr * 64 + ai * HALF;
                const int pos0 = tl0 & (SEQL - 1), sq = tl0 >> 13;
#pragma unroll
                for (int bj = 0; bj < 2; ++bj) {
                    asm volatile("" ::: "memory");
                    const int h = (4 * (pn - 12) + 2 * bj + (wc >> 1)) & 7;
#pragma unroll
                    for (int m = 0; m < 4; ++m) {
                        const int t = 16 * m + fr;
                        const int slot = gi == 0 ? t : (gi == 1 ? ((t & 3) * 16 + (t >> 2)) : ((t & 15) * 4 + (t >> 4)));
#pragma unroll
                        for (int n = 0; n < 2; ++n)
#pragma unroll
                            for (int j = 0; j < 4; ++j) { const unsigned w = cvt_pk_bf16(acc[ai][bj][m][n][j], 0.f); tile[(8 * fq + 4 * n + j) * 64 + slot] = (bf16_t)(w & 0xffffu); }
                    }
                    bf16_t* hb0 = dst + (size_t)(((sq * 3 + gi) * 8 + h) * 512) * 1024;
#pragma unroll
                    for (int i = 0; i < 4; ++i) {
                        const int c = lane + 64 * i, d = c >> 3, s8 = (c & 7) * 8;
                        const u32x4 v = *(const LAS u32x4*)(tile + d * 64 + s8);
                        const int dg = 32 * (wc & 1) + d; const int doff = (dg >> 4) * 256 + (dg & 15) * 4;
                        if (gi == 0) { const int kidx = pos0 + s8; bf16_t* q = hb0 + (size_t)(kidx >> 4) * 1024 + doff + ((kidx & 15) >> 2) * 64; *(u32x2*)q = (u32x2){v.x, v.y}; *(u32x2*)(q + 64) = (u32x2){v.z, v.w}; }
                        else if (gi == 1) { const int kidx = (s8 >> 4) * 2048 + (pos0 >> 2) + (s8 & 15); bf16_t* q = hb0 + (size_t)(kidx >> 4) * 1024 + doff + ((kidx & 15) >> 2) * 64; *(u32x2*)q = (u32x2){v.x, v.y}; *(u32x2*)(q + 64) = (u32x2){v.z, v.w}; }
                        else { const int ka = (s8 >> 2) * 512 + (pos0 >> 4), kb = ka + 512;
                            *(u32x2*)(hb0 + (size_t)(ka >> 4) * 1024 + doff + ((ka & 15) >> 2) * 64) = (u32x2){v.x, v.y}; *(u32x2*)(hb0 + (size_t)(kb >> 4) * 1024 + doff + ((kb & 15) >> 2) * 64) = (u32x2){v.z, v.w}; }
                    }
                }
            }
        } else if (pn == 20 || pn == 21) {
            bf16_t* dst = (bf16_t*)(ws + WS_UH);
#pragma unroll
            for (int ai = 0; ai < 2; ++ai)
#pragma unroll
                for (int m = 0; m < 4; ++m) { asm volatile("" ::: "memory");
                    const int tl = rbase + ai * HALF + m * 16;
#pragma unroll
                    for (int bj = 0; bj < 2; ++bj) {
                        const int gg = 16 * (pn - 20) + 8 * bj + 2 * wc + (fq >> 1);
                        bf16_t* p = dst + ((size_t)(gg * CHP + (tl >> 5)) * UHK) + (tl & 31) * 16 + 8 * (fq & 1);
                        const f32x4 v0 = acc[ai][bj][m][0], v1 = acc[ai][bj][m][1];
                        u32x4 w; w.x = cvt_pk_bf16(v0[0], v0[1]); w.y = cvt_pk_bf16(v0[2], v0[3]); w.z = cvt_pk_bf16(v1[0], v1[1]); w.w = cvt_pk_bf16(v1[2], v1[3]);
                        *(u32x4*)p = w;
                    }
                }
        } else {
            bf16_t* dst; int ld, c0; bool silu;
            if (pn < 20) { dst = (bf16_t*)(ws + WS_ZA); ld = 512; c0 = (pn - 18) * 256; silu = true; }
            else if (pn < 24) { dst = (bf16_t*)(ws + WS_ZB); ld = 512; c0 = (pn - 22) * 256; silu = true; }
            else if (pn < 28) { dst = (bf16_t*)(ws + WS_GA); ld = 1024; c0 = (pn - 24) * 256; silu = false; }
            else { dst = (bf16_t*)(ws + WS_GB); ld = 1024; c0 = (pn - 28) * 256; silu = false; }
#pragma unroll
            for (int ai = 0; ai < 2; ++ai)
#pragma unroll
                for (int m = 0; m < 4; ++m) { asm volatile("" ::: "memory");
                    const int tl = rbase + ai * HALF + m * 16;
#pragma unroll
                    for (int bj = 0; bj < 2; ++bj) {
                        f32x4 v0 = acc[ai][bj][m][0], v1 = acc[ai][bj][m][1];
#pragma unroll
                        for (int j = 0; j < 4; ++j) { const float s0 = sigmoidf_(v0[j]), s1 = sigmoidf_(v1[j]); v0[j] = silu ? v0[j] * s0 : s0; v1[j] = silu ? v1[j] * s1 : s1; }
                        u32x4 w; w.x = cvt_pk_bf16(v0[0], v0[1]); w.y = cvt_pk_bf16(v0[2], v0[3]); w.z = cvt_pk_bf16(v1[0], v1[1]); w.w = cvt_pk_bf16(v1[2], v1[3]);
                        *(u32x4*)(dst + (size_t)tl * ld + c0 + cl + bj * HALF) = w;
                    }
                }
        }
    } else if (g.mode == MODE_S) {
        float* dst = (float*)(ws + WS_S) + (size_t)u.bz * CHP * 256;
#pragma unroll
        for (int ai = 0; ai < 2; ++ai)
#pragma unroll
            for (int m = 0; m < 4; ++m) { asm volatile("" ::: "memory");
                const int r = rbase + ai * HALF + m * 16;
#pragma unroll
                for (int bj = 0; bj < 2; ++bj) { float* p = dst + (size_t)r * 256 + cl + bj * HALF; *(f32x4*)p = acc[ai][bj][m][0]; *(f32x4*)(p + 4) = acc[ai][bj][m][1]; }
            }
    } else if (g.mode == MODE_Y) {
        bf16_t* dst = (bf16_t*)(ws + WS_SG);
#pragma unroll
        for (int ai = 0; ai < 2; ++ai)
#pragma unroll
            for (int m = 0; m < 4; ++m) { asm volatile("" ::: "memory");
                const int r = rbase + ai * HALF + m * 16;
#pragma unroll
                for (int bj = 0; bj < 2; ++bj) {
                    const int t = 16 * u.pn + 8 * bj + 2 * wc + (fq >> 1);
                    f32x4 v0 = acc[ai][bj][m][0], v1 = acc[ai][bj][m][1];
#pragma unroll
                    for (int j = 0; j < 4; ++j) { v0[j] = gelu_tanh(v0[j]); v1[j] = gelu_tanh(v1[j]); }
                    u32x4 w; w.x = cvt_pk_bf16(v0[0], v0[1]); w.y = cvt_pk_bf16(v0[2], v0[3]); w.z = cvt_pk_bf16(v1[0], v1[1]); w.w = cvt_pk_bf16(v1[2], v1[3]);
                    *(u32x4*)(dst + (size_t)(r * LC + t) * 512 + u.bz * 16 + 8 * (fq & 1)) = w;
                }
            }
    } else if (g.mode == MODE_GLU) {
        const bf16_t* sg = (const bf16_t*)(ws + WS_SG); const bf16_t* zb = (const bf16_t*)(ws + WS_ZB); bf16_t* dst = (bf16_t*)(ws + WS_SB);
#pragma unroll
        for (int ai = 0; ai < 2; ++ai)
#pragma unroll
            for (int m = 0; m < 4; ++m) { asm volatile("" ::: "memory");
                const int tl = rbase + ai * HALF + m * 16;
#pragma unroll
                for (int bj = 0; bj < 2; ++bj) {
                    const size_t off = (size_t)tl * 512 + u.pn * BM + cl + bj * HALF;
                    const u32x4 s4 = *(const u32x4*)(sg + off), z4 = *(const u32x4*)(zb + off);
                    const f32x4 v0 = acc[ai][bj][m][0], v1 = acc[ai][bj][m][1];
                    u32x4 w;
                    w.x = cvt_pk_bf16(bf_lo(s4.x) * sigmoidf_(v0[0]) * bf_lo(z4.x), bf_hi(s4.x) * sigmoidf_(v0[1]) * bf_hi(z4.x));
                    w.y = cvt_pk_bf16(bf_lo(s4.y) * sigmoidf_(v0[2]) * bf_lo(z4.y), bf_hi(s4.y) * sigmoidf_(v0[3]) * bf_hi(z4.y));
                    w.z = cvt_pk_bf16(bf_lo(s4.z) * sigmoidf_(v1[0]) * bf_lo(z4.z), bf_hi(s4.z) * sigmoidf_(v1[1]) * bf_hi(z4.z));
                    w.w = cvt_pk_bf16(bf_lo(s4.w) * sigmoidf_(v1[2]) * bf_lo(z4.w), bf_hi(s4.w) * sigmoidf_(v1[3]) * bf_hi(z4.w));
                    *(u32x4*)(dst + off) = w;
                }
            }
    } else if (g.mode == MODE_A || g.mode == MODE_B) {
        const bool isb = g.mode == MODE_B;
        const bf16_t* gt = (const bf16_t*)(ws + (isb ? WS_GB : WS_GA)); bf16_t* dst = (bf16_t*)(ws + WS_M1);
#pragma unroll
        for (int ai = 0; ai < 2; ++ai)
#pragma unroll
            for (int m = 0; m < 4; ++m) { asm volatile("" ::: "memory");
                const int tl = rbase + ai * HALF + m * 16;
#pragma unroll
                for (int bj = 0; bj < 2; ++bj) {
                    const size_t off = (size_t)tl * 1024 + u.pn * BM + cl + bj * HALF;
                    const u32x4 g4 = *(const u32x4*)(gt + off);
                    u32x4 p4 = (u32x4){0u, 0u, 0u, 0u}; if (isb) p4 = *(const u32x4*)(dst + off);
                    f32x4 v0 = acc[ai][bj][m][0], v1 = acc[ai][bj][m][1];
#ifdef DBG_NOA
                    if (!isb) { v0 = v0 * 0.f; v1 = v1 * 0.f; v0 = (f32x4){0.f,0.f,0.f,0.f}; v1 = v0; }
#endif
#ifdef DBG_NOB
                    if (isb) { v0 = (f32x4){0.f,0.f,0.f,0.f}; v1 = v0; }
#endif
                    u32x4 w;
                    w.x = cvt_pk_bf16(bf_lo(p4.x) + bf_lo(g4.x) * v0[0], bf_hi(p4.x) + bf_hi(g4.x) * v0[1]);
                    w.y = cvt_pk_bf16(bf_lo(p4.y) + bf_lo(g4.y) * v0[2], bf_hi(p4.y) + bf_hi(g4.y) * v0[3]);
                    w.z = cvt_pk_bf16(bf_lo(p4.z) + bf_lo(g4.z) * v1[0], bf_hi(p4.z) + bf_hi(g4.z) * v1[1]);
                    w.w = cvt_pk_bf16(bf_lo(p4.w) + bf_lo(g4.w) * v1[2], bf_hi(p4.w) + bf_hi(g4.w) * v1[3]);
                    *(u32x4*)(dst + off) = w;
                }
            }
    } else {
#pragma unroll
        for (int ai = 0; ai < 2; ++ai)
#pragma unroll
            for (int m = 0; m < 4; ++m) { asm volatile("" ::: "memory");
                const int tg = g.pass * TP + rbase + ai * HALF + m * 16;
                const float* xr = xrow_ptr(g.xp, g.xs, tg); float* orow = g.out + (size_t)tg * DM;
#pragma unroll
                for (int bj = 0; bj < 2; ++bj) {
                    const int c = u.pn * BM + cl + bj * HALF;
                    const f32x4 a0 = *(const f32x4*)(xr + c), a1 = *(const f32x4*)(xr + c + 4);
                    *(f32x4*)(orow + c) = a0 + acc[ai][bj][m][0]; *(f32x4*)(orow + c + 4) = a1 + acc[ai][bj][m][1];
                }
            }
    }
}

__device__ __forceinline__ void gemm_phase(LAS unsigned char* lds, const GemmD& g, int G, int cidx, int tid) {
    const int wid = __builtin_amdgcn_readfirstlane(tid >> 6), lane = tid & 63, wr = wid >> 2, wc = wid & 3, fr = lane & 15, fq = lane >> 4;
    const int K = g.K, nt = K / BK;
    unsigned voffA[2], voffB[2];
#pragma unroll
    for (int i = 0; i < 2; ++i) { int R, C; stage_rc(tid * 16 + i * 8192, R, C); const int Rb = (R & ~31) + perm32(R & 31);
        voffA[i] = (unsigned)(R * g.lda + C) * 2u; voffB[i] = (unsigned)(Rb * g.ldb + C) * 2u; }
    const size_t kstep = (size_t)(BK * 2);
    const size_t hstepA = (size_t)HALF * g.lda * 2, hstepB = (size_t)HALF * g.ldb * 2;
    const size_t tstepA = 2 * hstepA, tstepB = 2 * hstepB;
    const unsigned ldsw = (unsigned)wid * 1024u;
    const int aoff = lds_byte(wr * 64 + fr, fq * 8), boff = lds_byte(wc * 32 + fr, fq * 8);
#define PG8_SA(b, h) (((b) * 2 + (h)) * HTB)
#define PG8_SB(b, h) ((4 + (b) * 2 + (h)) * HTB)
#define PG8_STAGE(bufoff, gbase, voff) do { _Pragma("unroll") for (int _i = 0; _i < 2; ++_i) \
        __builtin_amdgcn_global_load_lds((const unsigned*)((const char*)(gbase) + (voff)[_i]), (LAS unsigned*)(lds + (bufoff) + ldsw + _i * 8192), 16, 0, 0); } while (0)
#define PG8_LDA(dst, b, h) do { _Pragma("unroll") for (int m = 0; m < 4; ++m) _Pragma("unroll") for (int k = 0; k < 2; ++k) dst[m][k] = *(const LAS bf16x8*)(lds + PG8_SA(b, h) + aoff + m * 2048 + k * 1024); } while (0)
#define PG8_LDB(dst, b, h) do { _Pragma("unroll") for (int n = 0; n < 2; ++n) _Pragma("unroll") for (int k = 0; k < 2; ++k) dst[n][k] = *(const LAS bf16x8*)(lds + PG8_SB(b, h) + boff + n * 2048 + k * 1024); } while (0)
#define PG8_MMA(ai, bj, At, Bt) do { __builtin_amdgcn_s_setprio(1); _Pragma("unroll") for (int m = 0; m < 4; ++m) _Pragma("unroll") for (int n = 0; n < 2; ++n) _Pragma("unroll") for (int k = 0; k < 2; ++k) \
        acc[ai][bj][m][n] = __builtin_amdgcn_mfma_f32_16x16x32_bf16(Bt[n][k], At[m][k], acc[ai][bj][m][n], 0, 0, 0); __builtin_amdgcn_s_setprio(0); } while (0)
#define PG8_WAIT_V(n) asm volatile("s_waitcnt vmcnt(" #n ")" ::: "memory")
#define PG8_WAIT_L(n) asm volatile("s_waitcnt lgkmcnt(" #n ")" ::: "memory")
#define PG8_BAR __builtin_amdgcn_s_barrier()
#define PG8_SCHED __builtin_amdgcn_sched_barrier(0)
    Unit cur, nxt; int ui = 0;
    { int pm_, pn_, bz_; if (!unit_next(g, 0, G, cidx, pm_, pn_, bz_)) return; cur.pm = pm_; cur.pn = pn_; cur.bz = bz_; }
    f32x4 acc[2][2][4][2];
#pragma unroll
    for (int a = 0; a < 2; ++a)
#pragma unroll
        for (int b = 0; b < 2; ++b)
#pragma unroll
            for (int m = 0; m < 4; ++m)
#pragma unroll
                for (int n = 0; n < 2; ++n) acc[a][b][m][n] = (f32x4){0.f, 0.f, 0.f, 0.f};
    bf16x8 At[4][2], B0[2][2], B1[2][2];
    const char* cA = (const char*)g.A + (size_t)cur.bz * g.sA + (size_t)cur.pm * tstepA; const char* cB = (const char*)g.Bt + (size_t)cur.bz * g.sB + (size_t)cur.pn * tstepB;
    PG8_STAGE(PG8_SB(0, 0), cB, voffB); PG8_STAGE(PG8_SA(0, 0), cA, voffA); PG8_STAGE(PG8_SB(0, 1), cB + hstepB, voffB); PG8_STAGE(PG8_SA(0, 1), cA + hstepA, voffA);
    if (wr == 1) PG8_BAR;
    PG8_WAIT_V(4); PG8_BAR;
    PG8_STAGE(PG8_SB(1, 0), cB + kstep, voffB); PG8_STAGE(PG8_SA(1, 0), cA + kstep, voffA); PG8_STAGE(PG8_SB(1, 1), cB + hstepB + kstep, voffB);
    PG8_WAIT_V(6); PG8_BAR;
    for (;;) {
        int npm, npn, nbz; const bool has_next = unit_next(g, ui + 1, G, cidx, npm, npn, nbz); nxt.pm = npm; nxt.pn = npn; nxt.bz = nbz;
        const char* nA = has_next ? (const char*)g.A + (size_t)nxt.bz * g.sA + (size_t)nxt.pm * tstepA : cA; const char* nB = has_next ? (const char*)g.Bt + (size_t)nxt.bz * g.sB + (size_t)nxt.pn * tstepB : cB;
        for (int t = 0; t < nt; t += 2) {
            const bool last = (t == nt - 2);
            const char* a1 = cA + (size_t)(t + 1) * kstep;
            const char* a2 = last ? nA : cA + (size_t)(t + 2) * kstep; const char* b2 = last ? nB : cB + (size_t)(t + 2) * kstep;
            const char* a3 = a2 + kstep; const char* b3 = b2 + kstep;
            PG8_LDB(B0, 0, 0); PG8_SCHED; PG8_LDA(At, 0, 0); PG8_STAGE(PG8_SA(1, 1), a1 + hstepA, voffA);
            PG8_WAIT_L(8); PG8_BAR; PG8_WAIT_L(0); PG8_MMA(0, 0, At, B0); PG8_BAR; PG8_SCHED;
            PG8_LDB(B1, 0, 1); PG8_STAGE(PG8_SB(0, 0), b2, voffB);
            PG8_BAR; PG8_WAIT_L(0); PG8_MMA(0, 1, At, B1); PG8_BAR;
            PG8_LDA(At, 0, 1); PG8_STAGE(PG8_SA(0, 0), a2, voffA);
            PG8_BAR; PG8_WAIT_L(0); PG8_MMA(1, 0, At, B0); PG8_BAR; PG8_SCHED;
            PG8_STAGE(PG8_SB(0, 1), b2 + hstepB, voffB);
            PG8_WAIT_V(6); PG8_BAR; PG8_MMA(1, 1, At, B1); PG8_BAR;
            PG8_LDB(B0, 1, 0); PG8_SCHED; PG8_LDA(At, 1, 0); PG8_STAGE(PG8_SA(0, 1), a2 + hstepA, voffA);
            PG8_WAIT_L(8); PG8_BAR; PG8_WAIT_L(0); PG8_MMA(0, 0, At, B0); PG8_BAR; PG8_SCHED;
            PG8_LDB(B1, 1, 1); PG8_STAGE(PG8_SB(1, 0), b3, voffB);
            PG8_BAR; PG8_WAIT_L(0); PG8_MMA(0, 1, At, B1); PG8_BAR;
            PG8_LDA(At, 1, 1); PG8_STAGE(PG8_SA(1, 0), a3, voffA);
            PG8_BAR; PG8_WAIT_L(0); PG8_MMA(1, 0, At, B0); PG8_BAR; PG8_SCHED;
            PG8_STAGE(PG8_SB(1, 1), b3 + hstepB, voffB);
            PG8_WAIT_V(6); PG8_BAR; PG8_MMA(1, 1, At, B1); PG8_BAR;
        }
#ifndef NO_EPI
        epilogue(lds, g, acc, cur, wr, wc, fr, fq);
#else
        if (g.mode == 99) *(f32x4*)(g.out) = acc[0][0][0][0] + acc[1][1][3][1] + acc[0][1][2][0]+acc[1][0][1][1];
#endif
        if (!has_next) break;
#pragma unroll
        for (int a = 0; a < 2; ++a)
#pragma unroll
            for (int b = 0; b < 2; ++b)
#pragma unroll
                for (int m = 0; m < 4; ++m)
#pragma unroll
                    for (int n = 0; n < 2; ++n) acc[a][b][m][n] = (f32x4){0.f, 0.f, 0.f, 0.f};
        cur = nxt; cA = nA; cB = nB; ++ui;
    }
    PG8_WAIT_V(0);
    if (wr == 0) PG8_BAR;
    PG8_BAR;
#undef PG8_SA
#undef PG8_SB
#undef PG8_STAGE
#undef PG8_LDA
#undef PG8_LDB
#undef PG8_MMA
#undef PG8_WAIT_V
#undef PG8_WAIT_L
#undef PG8_BAR
#undef PG8_SCHED
}

__device__ __forceinline__ int qk_perm_row(int n) { const int i = n & 63; return (n & ~63) + 8 * ((i & 31) >> 2) + (i & 3) + 4 * (i >> 5); }
__device__ __forceinline__ void transpose_item(const float* W, int K, int N, bf16_t* WT, bool permqk, LAS float* scr, int item, int lane) {
    const int nblk = N / 32, kb = item / nblk, nb = item % nblk, k0 = 64 * kb, n0 = 32 * nb;
#pragma unroll 8
    for (int i = 0; i < 32; ++i) { const int kk = 2 * i + (lane >> 5); scr[kk * 33 + (lane & 31)] = W[(size_t)(k0 + kk) * N + n0 + (lane & 31)]; }
    asm volatile("s_waitcnt lgkmcnt(0)" ::: "memory");
    const int c = lane & 7;
#pragma unroll
    for (int j = 0; j < 4; ++j) { const int n = (lane >> 3) + 8 * j; const LAS float* s = scr + (8 * c) * 33 + n;
        u32x4 o; o.x = cvt_pk_bf16(s[0 * 33], s[1 * 33]); o.y = cvt_pk_bf16(s[2 * 33], s[3 * 33]); o.z = cvt_pk_bf16(s[4 * 33], s[5 * 33]); o.w = cvt_pk_bf16(s[6 * 33], s[7 * 33]);
        int row = n0 + n; if (permqk && row < 2 * QKVW) row = qk_perm_row(row);
        *(u32x4*)(WT + (size_t)row * K + k0 + 8 * c) = o; }
    asm volatile("s_waitcnt lgkmcnt(0)" ::: "memory");
}
__device__ __forceinline__ void reduce_angle(double a, float& c, float& s) {
    const double k = __builtin_rint(a * 0.6366197723675814); const float x = (float)(a - k * 1.5707963267948966), x2 = x * x;
    const float sn = x * (1.0f + x2 * (-1.6666666667e-1f + x2 * (8.3333333333e-3f + x2 * (-1.9841269841e-4f + x2 * 2.7557319224e-6f))));
    const float cs = 1.0f + x2 * (-0.5f + x2 * (4.1666666667e-2f + x2 * (-1.3888888889e-3f + x2 * (2.4801587302e-5f + x2 * -2.7557319224e-7f))));
    const int q = ((int)k) & 3;
    c = (q == 0) ? cs : (q == 1) ? -sn : (q == 2) ? -cs : sn;
    s = (q == 0) ? sn : (q == 1) ? cs : (q == 2) ? -sn : -cs;
}
__device__ __forceinline__ void rms_row_to_bf16(const float* xrow, const float* gw, bf16_t* orow, int lane) {
    const f32x4* xr = (const f32x4*)xrow + lane; const f32x4* gr = (const f32x4*)gw + lane;
    f32x4 v[4]; float s = 0.f;
#pragma unroll
    for (int j = 0; j < 4; ++j) { v[j] = xr[64 * j]; s += (v[j].x * v[j].x + v[j].y * v[j].y) + (v[j].z * v[j].z + v[j].w * v[j].w); }
    const float rstd = 1.0f / sqrtf(wave_sum(s) * (1.f / DM) + EPSN);
    u32x2* o8 = (u32x2*)orow + lane;
#pragma unroll
    for (int j = 0; j < 4; ++j) { const f32x4 gv = gr[64 * j]; u32x2 w; w.x = cvt_pk_bf16(v[j].x * rstd * gv.x, v[j].y * rstd * gv.y); w.y = cvt_pk_bf16(v[j].z * rstd * gv.z, v[j].w * rstd * gv.w); o8[64 * j] = w; }
}

__device__ __forceinline__ void ssm_setup_item(const Args& a, LAS unsigned char* lds, int item, int tid) {
    const int g = item >> 1, dir = item & 1;
    LAS f32x2* pw = (LAS f32x2*)lds; LAS f32x2* Bb = pw + 33 * 64; LAS f32x2* Cc = Bb + 1024;
    const float* lam_re = a.in[4]; const float* lam_im = a.in[5]; const float* log_step = a.in[6];
    const float* b_re = a.in[7]; const float* b_im = a.in[8]; const float* c_re = a.in[9]; const float* c_im = a.in[10];
    unsigned char* ws = a.ws;
    const float dt = expf(log_step[dir * 32 + g]);
    __syncthreads();
    for (int idx = tid; idx < 33 * 64; idx += 512) {
        const int tau = idx >> 6, n = idx & 63; const float lr = lam_re[(dir * 32 + g) * 64 + n], li = lam_im[(dir * 32 + g) * 64 + n];
        const float mag = expf(lr * dt * (float)tau); float c, s; reduce_angle((double)li * (double)dt * (double)tau, c, s);
        pw[idx] = (f32x2){mag * c, mag * s};
    }
    for (int idx = tid; idx < 1024; idx += 512) {
        { const int n = idx >> 4; const float lr = lam_re[(dir * 32 + g) * 64 + n], li = lam_im[(dir * 32 + g) * 64 + n];
          const float ar = lr * dt; float cb, sb, ch, sh; reduce_angle((double)li * (double)dt, cb, sb); reduce_angle(0.5 * (double)li * (double)dt, ch, sh);
          const float em1 = expm1f(ar), ea = em1 + 1.0f;
          const float nr = em1 * cb - 2.0f * sh * sh, ni = ea * sb;
          const float den = 1.0f / (lr * lr + li * li); const float cr = (nr * lr + ni * li) * den, ci = (ni * lr - nr * li) * den;
          const float br = b_re[(size_t)((dir * 32 + g) * 64) * 16 + idx], bi = b_im[(size_t)((dir * 32 + g) * 64) * 16 + idx];
          Bb[idx] = (f32x2){cr * br - ci * bi, cr * bi + ci * br}; }
        { Cc[idx] = (f32x2){c_re[(size_t)((dir * 32 + g) * 16) * 64 + idx], c_im[(size_t)((dir * 32 + g) * 16) * 64 + idx]}; }
    }
    __syncthreads();
    if (tid < 64) { float* PW = (float*)(ws + WS_PW); const f32x2 p = pw[32 * 64 + tid]; PW[((dir * 32 + g) * 64 + tid) * 2] = p.x; PW[((dir * 32 + g) * 64 + tid) * 2 + 1] = p.y; }
    { float* KT = (float*)(ws + WS_KT) + (size_t)(g * 2 + dir) * 32 * 256;
      for (int o = tid; o < 32 * 256; o += 512) {
          const int tau = o >> 8, co = (o >> 4) & 15, ci = o & 15; float acc = 0.f;
_Pragma("unroll 4")
          for (int n = 0; n < 64; ++n) { const f32x2 c = Cc[co * 64 + n], p = pw[tau * 64 + n], b = Bb[n * 16 + ci]; const float tr = c.x * p.x - c.y * p.y, ti = c.x * p.y + c.y * p.x; acc += tr * b.x - ti * b.y; }
          KT[o] = acc; } }
    { bf16_t* BsT = (bf16_t*)(ws + WS_BST) + (size_t)g * 256 * 512;
      for (int ch = tid; ch < 128 * 64; ch += 512) {
          const int row = ch >> 6, part = row >> 6, n = row & 63, kc = ch & 63, s = kc >> 1, ci0 = (kc & 1) * 8; const int e = dir ? s : 31 - s; const f32x2 p = pw[e * 64 + n];
          float v[8];
#pragma unroll
          for (int j = 0; j < 8; ++j) { const f32x2 b = Bb[n * 16 + ci0 + j]; v[j] = part ? (p.x * b.y + p.y * b.x) : (p.x * b.x - p.y * b.y); }
          u32x4 w; w.x = cvt_pk_bf16(v[0], v[1]); w.y = cvt_pk_bf16(v[2], v[3]); w.z = cvt_pk_bf16(v[4], v[5]); w.w = cvt_pk_bf16(v[6], v[7]);
          *(u32x4*)(BsT + (size_t)(dir * 128 + row) * 512 + s * 16 + ci0) = w; } }
    { bf16_t* MtC = (bf16_t*)(ws + WS_MTC) + (size_t)g * 512 * UHK;
      for (int ch = tid; ch < 512 * 16; ch += 512) {
          const int row = ch >> 4, t = row >> 4, co = row & 15, cc = ch & 15, part = cc >> 3, n0 = (cc & 7) * 8; const int e = dir ? 32 - t : t + 1;
          float v[8];
#pragma unroll
          for (int j = 0; j < 8; ++j) { const f32x2 c = Cc[co * 64 + n0 + j], p = pw[e * 64 + n0 + j]; v[j] = part ? -(c.x * p.y + c.y * p.x) : (c.x * p.x - c.y * p.y); }
          u32x4 w; w.x = cvt_pk_bf16(v[0], v[1]); w.y = cvt_pk_bf16(v[2], v[3]); w.z = cvt_pk_bf16(v[4], v[5]); w.w = cvt_pk_bf16(v[6], v[7]);
          *(u32x4*)(MtC + (size_t)row * UHK + 512 + dir * 128 + part * 64 + n0) = w; } }
    __syncthreads();
}

__device__ __forceinline__ void step_setup(const Args& a, LAS unsigned char* lds, int tid, int bx) {
    const int lane = tid & 63, wave = tid >> 6, G = gridDim.x;
    unsigned char* ws = a.ws;
    if (bx == 0 && tid < 64) ((unsigned*)(ws + WS_CTL))[tid] = 0u;
    for (int it = bx; it < 64; it += G) ssm_setup_item(a, lds, it, tid);
    { float* rc = (float*)(ws + WS_ROPE); float* rs = rc + SEQL * 32;
      for (int idx = bx * 512 + tid; idx < SEQL * 32; idx += G * 512) {
          const int pos = idx >> 5, i = idx & 31; double inv = 1.0; for (int k = 0; k < i; ++k) inv *= 0.7498942093324558;
          float c, s; reduce_angle((double)pos * inv, c, s); rc[idx] = c; rs[idx] = s; } }
    { LAS float* scr = (LAS float*)(lds) + wave * (64 * 33);
      const int gw = bx * 8 + wave, NGW = G * 8;
      constexpr int I_IN = (DM / 64) * (INC / 32), I_GLU = (512 / 64) * (512 / 32), I_AB = (512 / 64) * (1024 / 32), I_OUT = (1024 / 64) * (1024 / 32);
      constexpr int NIT = I_IN + I_GLU + 2 * I_AB + I_OUT;
      for (int it = gw; it < NIT; it += NGW) {
          int r = it;
          if (r < I_IN) { transpose_item(a.in[3], DM, INC, (bf16_t*)(ws + WS_WIN), true, scr, r, lane); continue; } r -= I_IN;
          if (r < I_GLU) { transpose_item(a.in[12], 512, 512, (bf16_t*)(ws + WS_WGLU), false, scr, r, lane); continue; } r -= I_GLU;
          if (r < I_AB) { transpose_item(a.in[13], 512, 1024, (bf16_t*)(ws + WS_WA), false, scr, r, lane); continue; } r -= I_AB;
          if (r < I_AB) { transpose_item(a.in[14], 512, 1024, (bf16_t*)(ws + WS_WB), false, scr, r, lane); continue; } r -= I_AB;
          transpose_item(a.in[15], 1024, 1024, (bf16_t*)(ws + WS_WOUT), false, scr, r, lane);
      } }
    { bf16_t* hn = (bf16_t*)((unsigned char*)a.out + OUT_HN_OFF);
      for (int row = bx * 8 + wave; row < TTOK; row += G * 8) rms_row_to_bf16(xrow_ptr(a.in[0], a.in[1], row), a.in[2], hn + (size_t)row * DM, lane); }
}

struct KVBuf { bf16x8 kA0, kA1, kB0, kB1; bf16x4 vA[4], vB[4]; };
__device__ __forceinline__ void step_params(int s, int& gi, int& ls) { gi = s < 12 ? 0 : (s < 18 ? 1 : 2); ls = s < 12 ? s : (s < 18 ? s - 12 : s - 18); }
__device__ __forceinline__ void attn_load(KVBuf& b, const bf16_t* Kp, const bf16_t* Vt, int s, int sq, int h, int blk, int r, int lane) {
    int gi, ls; step_params(s, gi, ls);
    const int sh = 2 * gi, Lg = SEQL >> sh, rho = r & ((1 << sh) - 1);
    int uA = ((256 * blk) >> sh) - 64 + 32 * ls, uB = uA + 16;
    if (uA < 0 || uA >= Lg) uA = 0; if (uB < 0 || uB >= Lg) uB = 0;
    const int kl = lane & 15, quad = lane >> 4;
    const bf16_t* kh = Kp + (size_t)(sq * 24 + gi * 8 + h) * SEQL * 64 + quad * 128 + kl * 8;
    const bf16_t* ka = kh + (size_t)((rho * Lg + uA) >> 4) * 1024; const bf16_t* kb = kh + (size_t)((rho * Lg + uB) >> 4) * 1024;
    b.kA0 = *(const bf16x8*)ka; b.kA1 = *(const bf16x8*)(ka + 512); b.kB0 = *(const bf16x8*)kb; b.kB1 = *(const bf16x8*)(kb + 512);
    const bf16_t* vbase = Vt + (size_t)(((sq * 3 + gi) * 8 + h) * 512) * 1024 + quad * 64 + kl * 4;
    const bf16_t* va = vbase + (size_t)((rho * Lg + uA) >> 4) * 1024; const bf16_t* vb = vbase + (size_t)((rho * Lg + uB) >> 4) * 1024;
#pragma unroll
    for (int dt = 0; dt < 4; ++dt) { b.vA[dt] = *(const bf16x4*)(va + dt * 256); b.vB[dt] = *(const bf16x4*)(vb + dt * 256); }
}
struct QF { bf16x8 a0, a1, b0, b1, c0, c1; };
template <int gi>
__device__ __forceinline__ void attn_compute(const KVBuf& b, const bf16x8 q0, const bf16x8 q1, f32x4 (&o)[4], float& mrun, float& lrun, int s, int blk, int r, int lane) {
    const int ls = gi == 0 ? s : (gi == 1 ? s - 12 : s - 18);
    const int sh = 2 * gi, Lg = SEQL >> sh;
    const int uA = ((256 * blk) >> sh) - 64 + 32 * ls;
    const int qi = lane & 15, quad = lane >> 4;
    const int uq = (256 * blk + r + 16 * qi) >> sh;
    const int lo = max(0, uq - 64), hi = min(Lg - 1, uq + 64);
    f32x4 sA = (f32x4){0.f, 0.f, 0.f, 0.f}, sB = sA;
    sA = __builtin_amdgcn_mfma_f32_16x16x32_bf16(b.kA0, q0, sA, 0, 0, 0); sA = __builtin_amdgcn_mfma_f32_16x16x32_bf16(b.kA1, q1, sA, 0, 0, 0);
    sB = __builtin_amdgcn_mfma_f32_16x16x32_bf16(b.kB0, q0, sB, 0, 0, 0); sB = __builtin_amdgcn_mfma_f32_16x16x32_bf16(b.kB1, q1, sB, 0, 0, 0);
    const float NEGINF = -__builtin_inff();
    const unsigned span = (unsigned)(hi - lo);
    float mx = NEGINF;
#pragma unroll
    for (int j = 0; j < 4; ++j) {
        const int ua = uA + quad * 4 + j, ub = ua + 16;
        sA[j] = ((unsigned)(ua - lo) <= span) ? sA[j] : NEGINF; sB[j] = ((unsigned)(ub - lo) <= span) ? sB[j] : NEGINF;
        mx = fmaxf(mx, fmaxf(sA[j], sB[j]));
    }
    mx = fmaxf(mx, __shfl_xor(mx, 16)); mx = fmaxf(mx, __shfl_xor(mx, 32));
    const float mnew = fmaxf(mrun, mx), alpha = __builtin_amdgcn_exp2f(mrun - mnew);
    mrun = mnew;
    float ps = 0.f;
#pragma unroll
    for (int j = 0; j < 4; ++j) { sA[j] = __builtin_amdgcn_exp2f(sA[j] - mnew); sB[j] = __builtin_amdgcn_exp2f(sB[j] - mnew); ps += sA[j] + sB[j]; }
    lrun = lrun * alpha + ps;
    u32x4 pw; pw.x = cvt_pk_bf16(sA[0], sA[1]); pw.y = cvt_pk_bf16(sA[2], sA[3]); pw.z = cvt_pk_bf16(sB[0], sB[1]); pw.w = cvt_pk_bf16(sB[2], sB[3]);
    const bf16x8 pf = __builtin_bit_cast(bf16x8, pw);
#pragma unroll
    for (int dt = 0; dt < 4; ++dt) {
        o[dt] *= alpha;
        bf16x8 vf; vf[0] = b.vA[dt][0]; vf[1] = b.vA[dt][1]; vf[2] = b.vA[dt][2]; vf[3] = b.vA[dt][3]; vf[4] = b.vB[dt][0]; vf[5] = b.vB[dt][1]; vf[6] = b.vB[dt][2]; vf[7] = b.vB[dt][3];
#ifdef DBG_ATT2
        for (int e = 0; e < 8; ++e) o[dt][e & 3] += 1e-3f * __uint_as_float(((unsigned)(unsigned short)vf[e]) << 16);
#else
        o[dt] = __builtin_amdgcn_mfma_f32_16x16x32_bf16(vf, pf, o[dt], 0, 0, 0);
#endif
    }
}
__device__ __forceinline__ void step_attention(const Args& a, LAS unsigned char* lds, int pass, int tid, int bx) {
    unsigned char* ws = a.ws;
    const int lane = tid & 63;
    const bf16_t* Qp = (const bf16_t*)(ws + WS_Q); const bf16_t* Kp = (const bf16_t*)(ws + WS_K); const bf16_t* Vt = (const bf16_t*)(ws + WS_VT);
    const bf16_t* ZA = (const bf16_t*)(ws + WS_ZA); bf16_t* GAO = (bf16_t*)(ws + WS_GAO);
    const int xcd = bx & 7;
    unsigned* ctr = (unsigned*)(ws + WS_CTL) + 16 + pass * 8 + xcd;
    LAS unsigned* slot = (LAS unsigned*)lds;
    constexpr int NGRP = 3 * 32 * 2;
    for (;;) {
        __syncthreads();
        if (tid == 0) slot[0] = atomicAdd(ctr, 1u);
        __syncthreads();
        const unsigned grp = (unsigned)__builtin_amdgcn_readfirstlane((int)slot[0]);
        if (grp >= (unsigned)NGRP) break;
        const int r = (int)(grp & 1) * 8 + (tid >> 6), blk = (grp >> 1) & 31, pair = xcd * 3 + (int)(grp >> 6);
        const int h = pair & 7, sq = pair >> 3;
        const int qi = lane & 15, quad = lane >> 4;
        const int tq = sq * SEQL + 256 * blk + r + 16 * qi;
        QF qf;
        { const int pos = 256 * blk + r + 16 * qi;
          const bf16_t* qa = Qp + ((size_t)(sq * 24 + h) * SEQL + pos) * 64 + quad * 8;
          const bf16_t* qb = Qp + ((size_t)(sq * 24 + 8 + h) * SEQL + (pos & 3) * 2048 + (pos >> 2)) * 64 + quad * 8;
          const bf16_t* qc = Qp + ((size_t)(sq * 24 + 16 + h) * SEQL + (pos & 15) * 512 + (pos >> 4)) * 64 + quad * 8;
          qf.a0 = *(const bf16x8*)qa; qf.a1 = *(const bf16x8*)(qa + 32); qf.b0 = *(const bf16x8*)qb; qf.b1 = *(const bf16x8*)(qb + 32); qf.c0 = *(const bf16x8*)qc; qf.c1 = *(const bf16x8*)(qc + 32); }
        f32x4 o[4];
#pragma unroll
        for (int dt = 0; dt < 4; ++dt) o[dt] = (f32x4){0.f, 0.f, 0.f, 0.f};
        float mrun = -1e30f, lrun = 0.f;
        KVBuf b0, b1;
        attn_load(b0, Kp, Vt, 0, sq, h, blk, r, lane);
#define ATT_SB __builtin_amdgcn_sched_barrier(0);
#define ATT_LOOP(GI, S0, S1, QA, QB) _Pragma("unroll 1") for (int s = S0; s < S1; s += 2) { \
            ATT_SB attn_load(b1, Kp, Vt, s + 1, sq, h, blk, r, lane); ATT_SB attn_compute<GI>(b0, QA, QB, o, mrun, lrun, s, blk, r, lane); \
            ATT_SB attn_load(b0, Kp, Vt, s + 2, sq, h, blk, r, lane); ATT_SB attn_compute<GI>(b1, QA, QB, o, mrun, lrun, s + 1, blk, r, lane); ATT_SB }
        ATT_LOOP(0, 0, 12, qf.a0, qf.a1)
        ATT_LOOP(1, 12, 18, qf.b0, qf.b1)
        ATT_LOOP(2, 18, 22, qf.c0, qf.c1)
#undef ATT_LOOP
        attn_compute<2>(b0, qf.c0, qf.c1, o, mrun, lrun, 22, blk, r, lane);
        float l = lrun; l += __shfl_xor(l, 16); l += __shfl_xor(l, 32);
        float inv = 1.0f / l;
#ifdef DBG_ATT1
        for (int dt = 0; dt < 4; ++dt) o[dt] = (f32x4){1.f, 1.f, 1.f, 1.f};
#endif
#pragma unroll
        for (int dt = 0; dt < 4; ++dt) {
            const size_t off = (size_t)tq * 512 + h * 64 + 16 * dt + 4 * quad;
            const u32x2 z = *(const u32x2*)(ZA + off);
            u32x2 w; w.x = cvt_pk_bf16(o[dt][0] * inv * bf_lo(z.x), o[dt][1] * inv * bf_hi(z.x)); w.y = cvt_pk_bf16(o[dt][2] * inv * bf_lo(z.y), o[dt][3] * inv * bf_hi(z.y));
            *(u32x2*)(GAO + off) = w;
        }
    }
}

__device__ __forceinline__ f32x2 cmul(f32x2 a, f32x2 b) { return (f32x2){a.x * b.x - a.y * b.y, a.x * b.y + a.y * b.x}; }
__device__ __forceinline__ void step_scan(const Args& a, LAS unsigned char* lds, int pass, int tid, int bx) {
    unsigned char* ws = a.ws; const int G = gridDim.x;
    const float* PW = (const float*)(ws + WS_PW); const float* S = (const float*)(ws + WS_S); bf16_t* UH = (bf16_t*)(ws + WS_UH);
    LAS f32x2* carry = (LAS f32x2*)lds;
    for (int it = bx; it < SEQP * 32 * 2; it += G) {
        const int dir = it & 1, g = (it >> 1) & 31, sq = it >> 6; const int seg = tid >> 6, n = tid & 63;
        const f32x2 P = (f32x2){PW[((dir * 32 + g) * 64 + n) * 2], PW[((dir * 32 + g) * 64 + n) * 2 + 1]};
        f32x2 z[32];
        { const int c0 = dir ? (NCH - 1 - seg * 32) : seg * 32; const long stp = dir ? -256 : 256;
          const float* sp = S + ((size_t)g * CHP + sq * NCH + c0) * 256 + dir * 128 + n;
#pragma unroll
          for (int i = 0; i < 32; ++i) { z[i] = (f32x2){sp[0], sp[64]}; sp += stp; } }
        f32x2 zz = (f32x2){0.f, 0.f};
#pragma unroll
        for (int i = 0; i < 32; ++i) { const f32x2 t = z[i]; z[i] = zz; zz = cmul(P, zz) + t; }
        __syncthreads();
        carry[seg * 64 + n] = zz;
        __syncthreads();
        f32x2 P32 = P;
#pragma unroll
        for (int k = 0; k < 5; ++k) P32 = cmul(P32, P32);
        f32x2 x = (f32x2){0.f, 0.f};
        for (int sp = 0; sp < seg; ++sp) x = cmul(P32, x) + carry[sp * 64 + n];
        f32x2 pwr = (f32x2){1.f, 0.f};
        { const int c0 = dir ? (NCH - 1 - seg * 32) : seg * 32; const long stp = dir ? -(long)UHK : (long)UHK;
          bf16_t* up = UH + ((size_t)g * CHP + sq * NCH + c0) * UHK + 512 + dir * 128 + n;
#pragma unroll
          for (int i = 0; i < 32; ++i) {
              const f32x2 hin = z[i] + cmul(pwr, x);
              up[0] = (bf16_t)(cvt_pk_bf16(hin.x, 0.f) & 0xffffu); up[64] = (bf16_t)(cvt_pk_bf16(hin.y, 0.f) & 0xffffu);
              pwr = cmul(pwr, P); up += stp;
          } }
    }
    if (pass == 0) {
        const float* KT = (const float*)(ws + WS_KT); const float* dsk = a.in[11]; bf16_t* MtC = (bf16_t*)(ws + WS_MTC);
        for (int ch = bx * 512 + tid; ch < 32 * 512 * 64; ch += G * 512) {
            const int kc = ch & 63, row = (ch >> 6) & 511, g = ch >> 15; const int s = kc >> 1, ci0 = (kc & 1) * 8, t = row >> 4, co = row & 15;
            float v[8];
#pragma unroll
            for (int j = 0; j < 8; ++j) v[j] = 0.f;
            if (t >= s) { const float* kp = KT + ((size_t)((g * 2 + 0) * 32 + (t - s)) * 16 + co) * 16 + ci0;
#pragma unroll
                for (int j = 0; j < 8; ++j) v[j] += kp[j]; }
            if (s >= t) { const float* kp = KT + ((size_t)((g * 2 + 1) * 32 + (s - t)) * 16 + co) * 16 + ci0;
#pragma unroll
                for (int j = 0; j < 8; ++j) v[j] += kp[j]; }
            if (t == s) { const float dv = dsk[g * 16 + co];
#pragma unroll
                for (int j = 0; j < 8; ++j) v[j] += (ci0 + j == co) ? dv : 0.f; }
            u32x4 w; w.x = cvt_pk_bf16(v[0], v[1]); w.y = cvt_pk_bf16(v[2], v[3]); w.z = cvt_pk_bf16(v[4], v[5]); w.w = cvt_pk_bf16(v[6], v[7]);
            *(u32x4*)(MtC + ((size_t)g * 512 + row) * UHK + s * 16 + ci0) = w;
        }
    }
}

__device__ __forceinline__ void step_final_norm(const Args& a, int pass, int tid, int bx) {
    const int lane = tid & 63, wave = tid >> 6, G = gridDim.x;
    const f32x4* gr = (const f32x4*)a.in[16] + lane;
    for (int row = bx * 8 + wave; row < TP; row += G * 8) {
        f32x4* xr = (f32x4*)(a.out + (size_t)(pass * TP + row) * DM) + lane;
        f32x4 v[4]; float s = 0.f;
#pragma unroll
        for (int j = 0; j < 4; ++j) { v[j] = xr[64 * j]; s += (v[j].x * v[j].x + v[j].y * v[j].y) + (v[j].z * v[j].z + v[j].w * v[j].w); }
        const float rstd = 1.0f / sqrtf(wave_sum(s) * (1.f / DM) + EPSN);
#pragma unroll
        for (int j = 0; j < 4; ++j) { f32x4 o = v[j] * rstd * gr[64 * j];
#ifdef DBG_SANITIZE
            for (int e = 0; e < 4; ++e) if (!(fabsf(o[e]) < 1e30f)) o[e] = 100.0f;
#endif
            xr[64 * j] = o; }
    }
}

constexpr int NSTEPS = 1 + 10 * NPASS;
__host__ __device__ __forceinline__ bool sync_after(int st) { if (st == 0) return true; const int k = (st - 1) % 10; return !(k == 1 || k == 6 || k == 9); }

__global__ void __launch_bounds__(512, 2) fwd_kernel(Args a) {
    extern __shared__ __attribute__((aligned(16))) unsigned char lds_raw[];
    LAS unsigned char* lds = (LAS unsigned char*)lds_raw;
    cg::grid_group grid = cg::this_grid();
    const int G = gridDim.x;
    unsigned char* ws = a.ws;
    for (int st = a.st_lo; st < a.st_hi; ++st) {
        int tid = threadIdx.x, bx = blockIdx.x;
        asm volatile("" : "+v"(tid), "+s"(bx));
#ifndef NO_SETUP
        if (st == 0) { step_setup(a, lds, tid, bx); }
#else
        if (st == 0) {}
#endif
        else {
            const int pass = (st - 1) / 10, k = (st - 1) % 10;
            GemmD g; g.ws = ws; g.out = a.out; g.xp = a.in[0]; g.xs = a.in[1]; g.pass = pass; g.nb = 1; g.sA = 0; g.sB = 0;
            bool has_gemm = true;
            switch (k) {
            case 0: g.A = (const bf16_t*)((unsigned char*)a.out + OUT_HN_OFF) + (size_t)pass * TP * DM; g.lda = DM; g.Bt = (const bf16_t*)(ws + WS_WIN); g.ldb = DM; g.K = DM; g.nM = TP / BM; g.nN = INC / BM; g.mode = MODE_PROJ; break;
            case 1: g.A = (const bf16_t*)(ws + WS_UH); g.lda = UHK; g.sA = (size_t)CHP * UHK * 2; g.Bt = (const bf16_t*)(ws + WS_BST); g.ldb = 512; g.sB = (size_t)256 * 512 * 2; g.K = 512; g.nM = CHP / BM; g.nN = 1; g.nb = 32; g.mode = MODE_S; break;
            case 4: g.A = (const bf16_t*)(ws + WS_UH); g.lda = UHK; g.sA = (size_t)CHP * UHK * 2; g.Bt = (const bf16_t*)(ws + WS_MTC); g.ldb = UHK; g.sB = (size_t)512 * UHK * 2; g.K = UHK; g.nM = CHP / BM; g.nN = 2; g.nb = 32; g.mode = MODE_Y; break;
            case 5: g.A = (const bf16_t*)(ws + WS_SG); g.lda = 512; g.Bt = (const bf16_t*)(ws + WS_WGLU); g.ldb = 512; g.K = 512; g.nM = TP / BM; g.nN = 2; g.mode = MODE_GLU; break;
            case 6: g.A = (const bf16_t*)(ws + WS_GAO); g.lda = 512; g.Bt = (const bf16_t*)(ws + WS_WA); g.ldb = 512; g.K = 512; g.nM = TP / BM; g.nN = 4; g.mode = MODE_A; break;
            case 7: g.A = (const bf16_t*)(ws + WS_SB); g.lda = 512; g.Bt = (const bf16_t*)(ws + WS_WB); g.ldb = 512; g.K = 512; g.nM = TP / BM; g.nN = 4; g.mode = MODE_B; break;
            case 8: g.A = (const bf16_t*)(ws + WS_M1); g.lda = 1024; g.Bt = (const bf16_t*)(ws + WS_WOUT); g.ldb = 1024; g.K = 1024; g.nM = TP / BM; g.nN = 4; g.mode = MODE_OUT; break;
            default: has_gemm = false; g.A = nullptr; g.Bt = nullptr; g.lda = g.ldb = g.K = 0; g.nM = g.nN = 0; g.mode = 0; break;
            }
            if (has_gemm) {
#ifndef NO_GEMM
                gemm_phase(lds, g, G, bx, tid);
#endif
            }
#ifndef NO_ATTN
            else if (k == 2) step_attention(a, lds, pass, tid, bx);
#endif
#ifndef NO_SCAN
            else if (k == 3) step_scan(a, lds, pass, tid, bx);
#endif
            else if (k == 9) step_final_norm(a, pass, tid, bx);
        }
        if (a.do_sync && st + 1 < a.st_hi && sync_after(st)) grid.sync();
    }
}

extern "C" void kernel_launch(void* const* d_in, const int* in_sizes, int n_in, void* d_out, int out_size, void* d_ws, size_t ws_size, hipStream_t stream) {
    constexpr int LDS_BYTES = STAGE_BYTES + 32768;
    static int grid = 0;
    if (grid == 0) {
        if (n_in != 17 || out_size != TTOK * DM || ws_size < WS_END) { fprintf(stderr, "kernel_launch: unexpected shapes (n_in %d out %d ws %zu need %zu)\n", n_in, out_size, ws_size, (size_t)WS_END); grid = -1; return; }
        int dev = 0, cus = 0, per_cu = 0;
        hipGetDevice(&dev); hipDeviceGetAttribute(&cus, hipDeviceAttributeMultiprocessorCount, dev);
        hipFuncSetAttribute((const void*)fwd_kernel, hipFuncAttributeMaxDynamicSharedMemorySize, LDS_BYTES);
        hipOccupancyMaxActiveBlocksPerMultiprocessor(&per_cu, (const void*)fwd_kernel, 512, LDS_BYTES);
        if (per_cu < 1) per_cu = 1;
        grid = cus * 1;
        (void)hipGetLastError();
    }
    if (grid < 0) return;
    Args a{};
    for (int i = 0; i < 17; ++i) a.in[i] = (const float*)d_in[i];
    a.out = (float*)d_out; a.ws = (unsigned char*)d_ws; a.pad = 0;
#ifndef MULTI_LAUNCH
#define MULTI_LAUNCH 0
#endif
#if MULTI_LAUNCH
    a.do_sync = 0;
    for (int st = 0; st < NSTEPS; ++st) {
        a.st_lo = st; a.st_hi = st + 1;
        hipLaunchKernelGGL(fwd_kernel, dim3(grid), dim3(512), LDS_BYTES, stream, a);
    }
#else
    a.do_sync = 1; a.st_lo = 0; a.st_hi = NSTEPS;
    void* args[] = {&a};
    hipError_t e = hipLaunchCooperativeKernel((const void*)fwd_kernel, dim3(grid), dim3(512), args, LDS_BYTES, stream);
    if (e != hipSuccess) fprintf(stderr, "cooperative launch failed: %s (grid %d)\n", hipGetErrorString(e), grid);
#endif
}
```

```cpp
#include <hip/hip_runtime.h>
#include <hip/hip_cooperative_groups.h>
#include <cstdio>

namespace cg = cooperative_groups;

#define LAS __attribute__((address_space(3)))
typedef unsigned short bf16_t;
typedef short bf16x8 __attribute__((ext_vector_type(8)));
typedef short bf16x4 __attribute__((ext_vector_type(4)));
typedef float f32x4 __attribute__((ext_vector_type(4)));
typedef float f32x2 __attribute__((ext_vector_type(2)));
typedef unsigned u32x4 __attribute__((ext_vector_type(4)));
typedef unsigned u32x2 __attribute__((ext_vector_type(2)));

constexpr int DM = 1024, SEQL = 8192, NSEQ = 6, TTOK = NSEQ * SEQL;
constexpr int NPASS = 2, SEQP = 3, TP = SEQP * SEQL;
constexpr int INC = 8192, QKVW = 1536;
constexpr int LC = 32, NCH = SEQL / LC  , CHP = SEQP * NCH  ;
constexpr int UHK = LC * 16 + 256;
constexpr float EPSN = 1e-6f;
constexpr float QSCALE = 0.18033688011112042f;

constexpr size_t AL(size_t x) { return (x + 255) & ~(size_t)255; }
constexpr size_t WS_CTL = 0;
constexpr size_t WS_WIN = 4096;
constexpr size_t WS_WGLU = WS_WIN + (size_t)INC * DM * 2;
constexpr size_t WS_WA = WS_WGLU + (size_t)512 * 512 * 2;
constexpr size_t WS_WB = WS_WA + (size_t)1024 * 512 * 2;
constexpr size_t WS_WOUT = WS_WB + (size_t)1024 * 512 * 2;
constexpr size_t WS_MTC = WS_WOUT + (size_t)1024 * 1024 * 2;
constexpr size_t WS_BST = WS_MTC + (size_t)32 * 512 * UHK * 2;
constexpr size_t WS_ROPE = WS_BST + (size_t)32 * 256 * 512 * 2;
constexpr size_t WS_PW = WS_ROPE + (size_t)2 * SEQL * 32 * 4;
constexpr size_t WS_KT = WS_PW + (size_t)2 * 32 * 64 * 8;
constexpr size_t WS_Q = WS_KT + (size_t)32 * 2 * 32 * 256 * 4;
constexpr size_t WS_K = WS_Q + (size_t)TP * QKVW * 2;
constexpr size_t WS_VT = WS_K + (size_t)TP * QKVW * 2;
constexpr size_t WS_ZA = WS_VT + (size_t)TP * QKVW * 2;
constexpr size_t WS_ZB = WS_ZA + (size_t)TP * 512 * 2;
constexpr size_t WS_GA = WS_ZB + (size_t)TP * 512 * 2;
constexpr size_t WS_GB = WS_GA + (size_t)TP * 1024 * 2;
constexpr size_t WS_UH = WS_GB + (size_t)TP * 1024 * 2;
constexpr size_t WS_S = WS_UH + (size_t)32 * CHP * UHK * 2;
constexpr size_t WS_GAO = WS_S + (size_t)32 * CHP * 256 * 4;
constexpr size_t WS_END = WS_GAO + (size_t)TP * 512 * 2;
constexpr size_t WS_SG = WS_Q;
constexpr size_t WS_SB = WS_Q + (size_t)TP * 512 * 2;
constexpr size_t WS_M1 = WS_K;
constexpr size_t OUT_HN_OFF = (size_t)SEQP * SEQL * DM * 4;

struct Args {
    const float* in[17];
    float* out;
    unsigned char* ws;
    int st_lo, st_hi;
    int do_sync, pad;
};

typedef __bf16 bf16v2 __attribute__((ext_vector_type(2)));
__device__ __forceinline__ unsigned cvt_pk_bf16(float lo, float hi) { const f32x2 v = (f32x2){lo, hi}; const bf16v2 r = __builtin_convertvector(v, bf16v2); return __builtin_bit_cast(unsigned, r); }
__device__ __forceinline__ float bf_lo(unsigned w) { return __uint_as_float(w << 16); }
__device__ __forceinline__ float bf_hi(unsigned w) { return __uint_as_float(w & 0xffff0000u); }
__device__ __forceinline__ float fast_rcp(float x) { return __builtin_amdgcn_rcpf(x); }
__device__ __forceinline__ float sigmoidf_(float x) { return fast_rcp(1.0f + __builtin_amdgcn_exp2f(-1.4426950408889634f * x)); }
__device__ __forceinline__ float siluf_(float x) { return x * sigmoidf_(x); }
__device__ __forceinline__ float gelu_tanh(float x) { const float u = x * (1.5957691216057308f + 0.07135481627260025f * x * x); return x * sigmoidf_(u); }
__device__ __forceinline__ float wave_sum(float v) {
#pragma unroll
    for (int o = 1; o < 64; o <<= 1) v += __shfl_xor(v, o);
    return v;
}
__device__ __forceinline__ const float* xrow_ptr(const float* xp, const float* xs, int tg) {
    return tg < 4 * SEQL ? xp + (size_t)tg * DM : xs + (size_t)(tg - 4 * SEQL) * DM;
}

constexpr int BM = 256, BK = 64, HALF = 128, HTB = HALF * BK * 2, STAGE_BYTES = 8 * HTB, NXCD = 8, WGM = 8;
__host__ __device__ __forceinline__ int lds_byte(int r, int c) { const int st = (r >> 4) * 2 + (c >> 5), rr = r & 15, cc = c & 31, ob = rr * 64 + cc * 2; return st * 1024 + (ob ^ (((ob >> 9) & 1) << 5)); }
__host__ __device__ __forceinline__ void stage_rc(int b, int& R, int& C) { const int st = b / 1024, sb = b % 1024, swz = sb ^ (((sb >> 9) & 1) << 5); R = (st >> 1) * 16 + swz / 64; C = (st & 1) * 32 + (swz % 64) / 2; }
__host__ __device__ __forceinline__ int perm32(int rho) { const int n = rho >> 4, i = rho & 15; return 8 * (i >> 2) + 4 * n + (i & 3); }

enum { MODE_PROJ = 0, MODE_S = 1, MODE_Y = 2, MODE_GLU = 3, MODE_A = 4, MODE_B = 5, MODE_OUT = 6 };
struct Unit { int pm, pn, bz; };
struct GemmD {
    const bf16_t* A; const bf16_t* Bt;
    int lda, ldb, K, nM, nN, nb;
    size_t sA, sB;
    int mode, pass;
    unsigned char* ws; float* out; const float* xp; const float* xs;
};
__device__ __forceinline__ bool unit_next(const GemmD& g, int i, int G, int c, int& pm, int& pn, int& bz) {
    const int nwg = g.nM * g.nN;
    const long L = (long)i * G + c; const bool ok = L < (long)nwg * g.nb;
    const int Li = ok ? (int)L : 0;
    int wgid = Li; { const int q = nwg / NXCD, r = nwg % NXCD, xcd = wgid % NXCD, off = wgid / NXCD; wgid = (xcd < r ? xcd * (q + 1) : r * (q + 1) + (xcd - r) * q) + off; }
    const int nig = WGM * g.nN, gid = wgid / nig, fm = gid * WGM, gsz = (g.nM - fm) < WGM ? (g.nM - fm) : WGM;
    const int pm1 = fm + ((wgid % nig) % gsz), pn1 = (wgid % nig) / gsz;
    const int w = Li % nwg, bz2 = Li / nwg, pm2 = w % g.nM, pn2 = w / g.nM;
    const bool single = g.nb == 1;
    pm = single ? pm1 : pm2; pn = single ? pn1 : pn2; bz = single ? 0 : bz2;
    return ok;
}

__device__ __forceinline__ void epilogue(LAS unsigned char* lds, const GemmD& g, const f32x4 (&acc)[2][2][4][2], const Unit& u, int wr, int wc, int fr, int fq) {
    asm volatile("" : "+v"(fr), "+v"(fq));
    unsigned char* ws = g.ws;
    const int rbase = u.pm * BM + wr * 64 + fr;
    const int cl = wc * 32 + fq * 8;
    if (g.mode == MODE_PROJ) {
        const int pn = u.pn;
        if (pn < 12) {
            const bool isq = pn < 6;
            bf16_t* dst = (bf16_t*)(ws + (isq ? WS_Q : WS_K));
            const float* rc = (const float*)(ws + WS_ROPE); const float* rs = rc + SEQL * 32;
            const int a4 = 4 * (4 * (wc & 1) + fq);
            const int pq = isq ? pn : pn - 6, gi = pq >> 1, sh = 2 * gi, dmask = (1 << sh) - 1, Lg = SEQL >> sh;
            const float sc = isq ? QSCALE : 1.0f;
#pragma unroll
            for (int ai = 0; ai < 2; ++ai) {
                asm volatile("" ::: "memory");
                f32x4 cvv[4], svv[4];
#pragma unroll
                for (int m = 0; m < 4; ++m) { const int pos = (rbase + ai * HALF + m * 16) & (SEQL - 1); cvv[m] = *(const f32x4*)(rc + pos * 32 + a4); svv[m] = *(const f32x4*)(rs + pos * 32 + a4); }
#pragma unroll
                for (int m = 0; m < 4; ++m) {
                    const int tl = rbase + ai * HALF + m * 16; const int pos = tl & (SEQL - 1), sq = tl >> 13;
                    const int kidx = (pos & dmask) * Lg + (pos >> sh);
                    const f32x4 cv = cvv[m] * sc, sv = svv[m] * sc;
#pragma unroll
                    for (int bj = 0; bj < 2; ++bj) {
                        const f32x4 x1 = acc[ai][bj][m][0], x2 = acc[ai][bj][m][1];
                        const f32x4 o1 = x1 * cv - x2 * sv, o2 = x2 * cv + x1 * sv;
                        const int head = pq * 4 + 2 * bj + (wc >> 1);
                        bf16_t* p = dst + (size_t)(sq * 24 + head) * SEQL * 64 + (isq ? (size_t)kidx * 64 + a4 : (size_t)(kidx >> 4) * 1024 + (a4 >> 3) * 128 + (kidx & 15) * 8 + (a4 & 7));
                        const int half2 = isq ? 32 : 512;
                        u32x2 w1, w2; w1.x = cvt_pk_bf16(o1[0], o1[1]); w1.y = cvt_pk_bf16(o1[2], o1[3]); w2.x = cvt_pk_bf16(o2[0], o2[1]); w2.y = cvt_pk_bf16(o2[2], o2[3]);
                        *(u32x2*)p = w1; *(u32x2*)(p + half2) = w2;
                    }
                }
            }
        } else if (pn < 18) {
            bf16_t* dst = (bf16_t*)(ws + WS_VT);
            const int gi = (pn - 12) >> 1, sh = 2 * gi;
            const int wid = wr * 4 + wc, lane = fq * 16 + fr;
            LAS bf16_t* tile = (LAS bf16_t*)(lds + STAGE_BYTES + wid * 4096);
#pragma unroll
            for (int ai = 0; ai < 2; ++ai) {
                const int tl0 = u.pm * BM + wr * 64 + ai * HALF;
                const int pos0 = tl0 & (SEQL - 1), sq = tl0 >> 13;
#pragma unroll
                for (int bj = 0; bj < 2; ++bj) {
                    asm volatile("" ::: "memory");
                    const int h = (4 * (pn - 12) + 2 * bj + (wc >> 1)) & 7;
#pragma unroll
                    for (int m = 0; m < 4; ++m) {
                        const int t = 16 * m + fr;
                        const int slot = gi == 0 ? t : (gi == 1 ? ((t & 3) * 16 + (t >> 2)) : ((t & 15) * 4 + (t >> 4)));
#pragma unroll
                        for (int n = 0; n < 2; ++n)
#pragma unroll
                            for (int j = 0; j < 4; ++j) { const unsigned w = cvt_pk_bf16(acc[ai][bj][m][n][j], 0.f); tile[(8 * fq + 4 * n + j) * 64 + slot] = (bf16_t)(w & 0xffffu); }
                    }
                    bf16_t* hb0 = dst + (size_t)(((sq * 3 + gi) * 8 + h) * 512) * 1024;
#pragma unroll
                    for (int i = 0; i < 4; ++i) {
                        const int c = lane + 64 * i, d = c >> 3, s8 = (c & 7) * 8;
                        const u32x4 v = *(const LAS u32x4*)(tile + d * 64 + s8);
                        const int dg = 32 * (wc & 1) + d; const int doff = (dg >> 4) * 256 + (dg & 15) * 4;
                        if (gi == 0) { const int kidx = pos0 + s8; bf16_t* q = hb0 + (size_t)(kidx >> 4) * 1024 + doff + ((kidx & 15) >> 2) * 64; *(u32x2*)q = (u32x2){v.x, v.y}; *(u32x2*)(q + 64) = (u32x2){v.z, v.w}; }
                        else if (gi == 1) { const int kidx = (s8 >> 4) * 2048 + (pos0 >> 2) + (s8 & 15); bf16_t* q = hb0 + (size_t)(kidx >> 4) * 1024 + doff + ((kidx & 15) >> 2) * 64; *(u32x2*)q = (u32x2){v.x, v.y}; *(u32x2*)(q + 64) = (u32x2){v.z, v.w}; }
                        else { const int ka = (s8 >> 2) * 512 + (pos0 >> 4), kb = ka + 512;
                            *(u32x2*)(hb0 + (size_t)(ka >> 4) * 1024 + doff + ((ka & 15) >> 2) * 64) = (u32x2){v.x, v.y}; *(u32x2*)(hb0 + (size_t)(kb >> 4) * 1024 + doff + ((kb & 15) >> 2) * 64) = (u32x2){v.z, v.w}; }
                    }
                }
            }
        } else if (pn == 20 || pn == 21) {
            bf16_t* dst = (bf16_t*)(ws + WS_UH);
#pragma unroll
            for (int ai = 0; ai < 2; ++ai)
#pragma unroll
                for (int m = 0; m < 4; ++m) { asm volatile("" ::: "memory");
                    const int tl = rbase + ai * HALF + m * 16;
#pragma unroll
                    for (int bj = 0; bj < 2; ++bj) {
                        const int gg = 16 * (pn - 20) + 8 * bj + 2 * wc + (fq >> 1);
                        bf16_t* p = dst + ((size_t)(gg * CHP + (tl >> 5)) * UHK) + (tl & 31) * 16 + 8 * (fq & 1);
                        const f32x4 v0 = acc[ai][bj][m][0], v1 = acc[ai][bj][m][1];
                        u32x4 w; w.x = cvt_pk_bf16(v0[0], v0[1]); w.y = cvt_pk_bf16(v0[2], v0[3]); w.z = cvt_pk_bf16(v1[0], v1[1]); w.w = cvt_pk_bf16(v1[2], v1[3]);
                        *(u32x4*)p = w;
                    }
                }
        } else {
            bf16_t* dst; int ld, c0; bool silu;
            if (pn < 20) { dst = (bf16_t*)(ws + WS_ZA); ld = 512; c0 = (pn - 18) * 256; silu = true; }
            else if (pn < 24) { dst = (bf16_t*)(ws + WS_ZB); ld = 512; c0 = (pn - 22) * 256; silu = true; }
            else if (pn < 28) { dst = (bf16_t*)(ws + WS_GA); ld = 1024; c0 = (pn - 24) * 256; silu = false; }
            else { dst = (bf16_t*)(ws + WS_GB); ld = 1024; c0 = (pn - 28) * 256; silu = false; }
#pragma unroll
            for (int ai = 0; ai < 2; ++ai)
#pragma unroll
                for (int m = 0; m < 4; ++m) { asm volatile("" ::: "memory");
                    const int tl = rbase + ai * HALF + m * 16;
#pragma unroll
                    for (int bj = 0; bj < 2; ++bj) {
                        f32x4 v0 = acc[ai][bj][m][0], v1 = acc[ai][bj][m][1];
#pragma unroll
                        for (int j = 0; j < 4; ++j) { const float s0 = sigmoidf_(v0[j]), s1 = sigmoidf_(v1[j]); v0[j] = silu ? v0[j] * s0 : s0; v1[j] = silu ? v1[j] * s1 : s1; }
                        u32x4 w; w.x = cvt_pk_bf16(v0[0], v0[1]); w.y = cvt_pk_bf16(v0[2], v0[3]); w.z = cvt_pk_bf16(v1[0], v1[1]); w.w = cvt_pk_bf16(v1[2], v1[3]);
                        *(u32x4*)(dst + (size_t)tl * ld + c0 + cl + bj * HALF) = w;
                    }
                }
        }
    } else if (g.mode == MODE_S) {
        float* dst = (float*)(ws + WS_S) + (size_t)u.bz * CHP * 256;
#pragma unroll
        for (int ai = 0; ai < 2; ++ai)
#pragma unroll
            for (int m = 0; m < 4; ++m) { asm volatile("" ::: "memory");
                const int r = rbase + ai * HALF + m * 16;
#pragma unroll
                for (int bj = 0; bj < 2; ++bj) { float* p = dst + (size_t)r * 256 + cl + bj * HALF; *(f32x4*)p = acc[ai][bj][m][0]; *(f32x4*)(p + 4) = acc[ai][bj][m][1]; }
            }
    } else if (g.mode == MODE_Y) {
        bf16_t* dst = (bf16_t*)(ws + WS_SG);
#pragma unroll
        for (int ai = 0; ai < 2; ++ai)
#pragma unroll
            for (int m = 0; m < 4; ++m) { asm volatile("" ::: "memory");
                const int r = rbase + ai * HALF + m * 16;
#pragma unroll
                for (int bj = 0; bj < 2; ++bj) {
                    const int t = 16 * u.pn + 8 * bj + 2 * wc + (fq >> 1);
                    f32x4 v0 = acc[ai][bj][m][0], v1 = acc[ai][bj][m][1];
#pragma unroll
                    for (int j = 0; j < 4; ++j) { v0[j] = gelu_tanh(v0[j]); v1[j] = gelu_tanh(v1[j]); }
                    u32x4 w; w.x = cvt_pk_bf16(v0[0], v0[1]); w.y = cvt_pk_bf16(v0[2], v0[3]); w.z = cvt_pk_bf16(v1[0], v1[1]); w.w = cvt_pk_bf16(v1[2], v1[3]);
                    *(u32x4*)(dst + (size_t)(r * LC + t) * 512 + u.bz * 16 + 8 * (fq & 1)) = w;
                }
            }
    } else if (g.mode == MODE_GLU) {
        const bf16_t* sg = (const bf16_t*)(ws + WS_SG); const bf16_t* zb = (const bf16_t*)(ws + WS_ZB); bf16_t* dst = (bf16_t*)(ws + WS_SB);
#pragma unroll
        for (int ai = 0; ai < 2; ++ai) {
            asm volatile("" ::: "memory");
            u32x4 sv4[4][2], zv4[4][2];
#pragma unroll
            for (int m = 0; m < 4; ++m)
#pragma unroll
                for (int bj = 0; bj < 2; ++bj) { const size_t off = (size_t)(rbase + ai * HALF + m * 16) * 512 + u.pn * BM + cl + bj * HALF; sv4[m][bj] = *(const u32x4*)(sg + off); zv4[m][bj] = *(const u32x4*)(zb + off); }
#pragma unroll
            for (int m = 0; m < 4; ++m)
#pragma unroll
                for (int bj = 0; bj < 2; ++bj) {
                    const size_t off = (size_t)(rbase + ai * HALF + m * 16) * 512 + u.pn * BM + cl + bj * HALF;
                    const u32x4 s4 = sv4[m][bj], z4 = zv4[m][bj];
                    const f32x4 v0 = acc[ai][bj][m][0], v1 = acc[ai][bj][m][1];
                    u32x4 w;
                    w.x = cvt_pk_bf16(bf_lo(s4.x) * sigmoidf_(v0[0]) * bf_lo(z4.x), bf_hi(s4.x) * sigmoidf_(v0[1]) * bf_hi(z4.x));
                    w.y = cvt_pk_bf16(bf_lo(s4.y) * sigmoidf_(v0[2]) * bf_lo(z4.y), bf_hi(s4.y) * sigmoidf_(v0[3]) * bf_hi(z4.y));
                    w.z = cvt_pk_bf16(bf_lo(s4.z) * sigmoidf_(v1[0]) * bf_lo(z4.z), bf_hi(s4.z) * sigmoidf_(v1[1]) * bf_hi(z4.z));
                    w.w = cvt_pk_bf16(bf_lo(s4.w) * sigmoidf_(v1[2]) * bf_lo(z4.w), bf_hi(s4.w) * sigmoidf_(v1[3]) * bf_hi(z4.w));
                    *(u32x4*)(dst + off) = w;
                }
        }
    } else if (g.mode == MODE_A || g.mode == MODE_B) {
        const bool isb = g.mode == MODE_B;
        const bf16_t* gt = (const bf16_t*)(ws + (isb ? WS_GB : WS_GA)); bf16_t* dst = (bf16_t*)(ws + WS_M1);
#pragma unroll
        for (int ai = 0; ai < 2; ++ai) {
            asm volatile("" ::: "memory");
            u32x4 gv4[4][2], pv4[4][2];
#pragma unroll
            for (int m = 0; m < 4; ++m)
#pragma unroll
                for (int bj = 0; bj < 2; ++bj) { const size_t off = (size_t)(rbase + ai * HALF + m * 16) * 1024 + u.pn * BM + cl + bj * HALF; gv4[m][bj] = *(const u32x4*)(gt + off); pv4[m][bj] = (u32x4){0u, 0u, 0u, 0u}; if (isb) pv4[m][bj] = *(const u32x4*)(dst + off); }
#pragma unroll
            for (int m = 0; m < 4; ++m)
#pragma unroll
                for (int bj = 0; bj < 2; ++bj) {
                    const size_t off = (size_t)(rbase + ai * HALF + m * 16) * 1024 + u.pn * BM + cl + bj * HALF;
                    const u32x4 g4 = gv4[m][bj], p4 = pv4[m][bj];
                    const f32x4 v0 = acc[ai][bj][m][0], v1 = acc[ai][bj][m][1];
                    u32x4 w;
                    w.x = cvt_pk_bf16(bf_lo(p4.x) + bf_lo(g4.x) * v0[0], bf_hi(p4.x) + bf_hi(g4.x) * v0[1]);
                    w.y = cvt_pk_bf16(bf_lo(p4.y) + bf_lo(g4.y) * v0[2], bf_hi(p4.y) + bf_hi(g4.y) * v0[3]);
                    w.z = cvt_pk_bf16(bf_lo(p4.z) + bf_lo(g4.z) * v1[0], bf_hi(p4.z) + bf_hi(g4.z) * v1[1]);
                    w.w = cvt_pk_bf16(bf_lo(p4.w) + bf_lo(g4.w) * v1[2], bf_hi(p4.w) + bf_hi(g4.w) * v1[3]);
                    *(u32x4*)(dst + off) = w;
                }
        }
    } else {
#pragma unroll
        for (int ai = 0; ai < 2; ++ai) {
            asm volatile("" ::: "memory");
            f32x4 xa[4][2][2];
#pragma unroll
            for (int m = 0; m < 4; ++m) {
                const float* xr = xrow_ptr(g.xp, g.xs, g.pass * TP + rbase + ai * HALF + m * 16);
#pragma unroll
                for (int bj = 0; bj < 2; ++bj) { const int c = u.pn * BM + cl + bj * HALF; xa[m][bj][0] = *(const f32x4*)(xr + c); xa[m][bj][1] = *(const f32x4*)(xr + c + 4); }
            }
#pragma unroll
            for (int m = 0; m < 4; ++m) {
                float* orow = g.out + (size_t)(g.pass * TP + rbase + ai * HALF + m * 16) * DM;
#pragma unroll
                for (int bj = 0; bj < 2; ++bj) {
                    const int c = u.pn * BM + cl + bj * HALF;
                    *(f32x4*)(orow + c) = xa[m][bj][0] + acc[ai][bj][m][0]; *(f32x4*)(orow + c + 4) = xa[m][bj][1] + acc[ai][bj][m][1];
                }
            }
        }
    }
}

__device__ __forceinline__ void gemm_phase(LAS unsigned char* lds, const GemmD& g, int G, int cidx, int tid) {
    const int wid = __builtin_amdgcn_readfirstlane(tid >> 6), lane = tid & 63, wr = wid >> 2, wc = wid & 3, fr = lane & 15, fq = lane >> 4;
    const int K = g.K, nt = K / BK;
    unsigned voffA[2], voffB[2];
#pragma unroll
    for (int i = 0; i < 2; ++i) { int R, C; stage_rc(tid * 16 + i * 8192, R, C); const int Rb = (R & ~31) + perm32(R & 31);
        voffA[i] = (unsigned)(R * g.lda + C) * 2u; voffB[i] = (unsigned)(Rb * g.ldb + C) * 2u; }
    const size_t kstep = (size_t)(BK * 2);
    const size_t hstepA = (size_t)HALF * g.lda * 2, hstepB = (size_t)HALF * g.ldb * 2;
    const size_t tstepA = 2 * hstepA, tstepB = 2 * hstepB;
    const unsigned ldsw = (unsigned)wid * 1024u;
    const int aoff = lds_byte(wr * 64 + fr, fq * 8), boff = lds_byte(wc * 32 + fr, fq * 8);
#define PG8_SA(b, h) (((b) * 2 + (h)) * HTB)
#define PG8_SB(b, h) ((4 + (b) * 2 + (h)) * HTB)
#define PG8_STAGE(bufoff, gbase, voff) do { _Pragma("unroll") for (int _i = 0; _i < 2; ++_i) \
        __builtin_amdgcn_global_load_lds((const unsigned*)((const char*)(gbase) + (voff)[_i]), (LAS unsigned*)(lds + (bufoff) + ldsw + _i * 8192), 16, 0, 0); } while (0)
#define PG8_LDA(dst, b, h) do { _Pragma("unroll") for (int m = 0; m < 4; ++m) _Pragma("unroll") for (int k = 0; k < 2; ++k) dst[m][k] = *(const LAS bf16x8*)(lds + PG8_SA(b, h) + aoff + m * 2048 + k * 1024); } while (0)
#define PG8_LDB(dst, b, h) do { _Pragma("unroll") for (int n = 0; n < 2; ++n) _Pragma("unroll") for (int k = 0; k < 2; ++k) dst[n][k] = *(const LAS bf16x8*)(lds + PG8_SB(b, h) + boff + n * 2048 + k * 1024); } while (0)
#define PG8_MMA(ai, bj, At, Bt) do { __builtin_amdgcn_s_setprio(1); _Pragma("unroll") for (int m = 0; m < 4; ++m) _Pragma("unroll") for (int n = 0; n < 2; ++n) _Pragma("unroll") for (int k = 0; k < 2; ++k) \
        acc[ai][bj][m][n] = __builtin_amdgcn_mfma_f32_16x16x32_bf16(Bt[n][k], At[m][k], acc[ai][bj][m][n], 0, 0, 0); __builtin_amdgcn_s_setprio(0); } while (0)
#define PG8_WAIT_V(n) asm volatile("s_waitcnt vmcnt(" #n ")" ::: "memory")
#define PG8_WAIT_L(n) asm volatile("s_waitcnt lgkmcnt(" #n ")" ::: "memory")
#define PG8_BAR __builtin_amdgcn_s_barrier()
#define PG8_SCHED __builtin_amdgcn_sched_barrier(0)
    Unit cur, nxt; int ui = 0;
    { int pm_, pn_, bz_; if (!unit_next(g, 0, G, cidx, pm_, pn_, bz_)) return; cur.pm = pm_; cur.pn = pn_; cur.bz = bz_; }
    f32x4 acc[2][2][4][2];
#pragma unroll
    for (int a = 0; a < 2; ++a)
#pragma unroll
        for (int b = 0; b < 2; ++b)
#pragma unroll
            for (int m = 0; m < 4; ++m)
#pragma unroll
                for (int n = 0; n < 2; ++n) acc[a][b][m][n] = (f32x4){0.f, 0.f, 0.f, 0.f};
    bf16x8 At[4][2], B0[2][2], B1[2][2];
    const char* cA = (const char*)g.A + (size_t)cur.bz * g.sA + (size_t)cur.pm * tstepA; const char* cB = (const char*)g.Bt + (size_t)cur.bz * g.sB + (size_t)cur.pn * tstepB;
    PG8_STAGE(PG8_SB(0, 0), cB, voffB); PG8_STAGE(PG8_SA(0, 0), cA, voffA); PG8_STAGE(PG8_SB(0, 1), cB + hstepB, voffB); PG8_STAGE(PG8_SA(0, 1), cA + hstepA, voffA);
    if (wr == 1) PG8_BAR;
    PG8_WAIT_V(4); PG8_BAR;
    PG8_STAGE(PG8_SB(1, 0), cB + kstep, voffB); PG8_STAGE(PG8_SA(1, 0), cA + kstep, voffA); PG8_STAGE(PG8_SB(1, 1), cB + hstepB + kstep, voffB);
    PG8_WAIT_V(6); PG8_BAR;
    for (;;) {
        int npm, npn, nbz; const bool has_next = unit_next(g, ui + 1, G, cidx, npm, npn, nbz); nxt.pm = npm; nxt.pn = npn; nxt.bz = nbz;
        const char* nA = has_next ? (const char*)g.A + (size_t)nxt.bz * g.sA + (size_t)nxt.pm * tstepA : cA; const char* nB = has_next ? (const char*)g.Bt + (size_t)nxt.bz * g.sB + (size_t)nxt.pn * tstepB : cB;
        for (int t = 0; t < nt; t += 2) {
            const bool last = (t == nt - 2);
            const char* a1 = cA + (size_t)(t + 1) * kstep;
            const char* a2 = last ? nA : cA + (size_t)(t + 2) * kstep; const char* b2 = last ? nB : cB + (size_t)(t + 2) * kstep;
            const char* a3 = a2 + kstep; const char* b3 = b2 + kstep;
            PG8_LDB(B0, 0, 0); PG8_SCHED; PG8_LDA(At, 0, 0); PG8_STAGE(PG8_SA(1, 1), a1 + hstepA, voffA);
            PG8_WAIT_L(8); PG8_BAR; PG8_WAIT_L(0); PG8_MMA(0, 0, At, B0); PG8_BAR; PG8_SCHED;
            PG8_LDB(B1, 0, 1); PG8_STAGE(PG8_SB(0, 0), b2, voffB);
            PG8_BAR; PG8_WAIT_L(0); PG8_MMA(0, 1, At, B1); PG8_BAR;
            PG8_LDA(At, 0, 1); PG8_STAGE(PG8_SA(0, 0), a2, voffA);
            PG8_BAR; PG8_WAIT_L(0); PG8_MMA(1, 0, At, B0); PG8_BAR; PG8_SCHED;
            PG8_STAGE(PG8_SB(0, 1), b2 + hstepB, voffB);
            PG8_WAIT_V(6); PG8_BAR; PG8_MMA(1, 1, At, B1); PG8_BAR;
            PG8_LDB(B0, 1, 0); PG8_SCHED; PG8_LDA(At, 1, 0); PG8_STAGE(PG8_SA(0, 1), a2 + hstepA, voffA);
            PG8_WAIT_L(8); PG8_BAR; PG8_WAIT_L(0); PG8_MMA(0, 0, At, B0); PG8_BAR; PG8_SCHED;
            PG8_LDB(B1, 1, 1); PG8_STAGE(PG8_SB(1, 0), b3, voffB);
            PG8_BAR; PG8_WAIT_L(0); PG8_MMA(0, 1, At, B1); PG8_BAR;
            PG8_LDA(At, 1, 1); PG8_STAGE(PG8_SA(1, 0), a3, voffA);
            PG8_BAR; PG8_WAIT_L(0); PG8_MMA(1, 0, At, B0); PG8_BAR; PG8_SCHED;
            PG8_STAGE(PG8_SB(1, 1), b3 + hstepB, voffB);
            PG8_WAIT_V(6); PG8_BAR; PG8_MMA(1, 1, At, B1); PG8_BAR;
        }
#ifndef NO_EPI
        epilogue(lds, g, acc, cur, wr, wc, fr, fq);
#else
        if (g.mode == 99) *(f32x4*)(g.out) = acc[0][0][0][0] + acc[1][1][3][1] + acc[0][1][2][0]+acc[1][0][1][1];
#endif
        if (!has_next) break;
#pragma unroll
        for (int a = 0; a < 2; ++a)
#pragma unroll
            for (int b = 0; b < 2; ++b)
#pragma unroll
                for (int m = 0; m < 4; ++m)
#pragma unroll
                    for (int n = 0; n < 2; ++n) acc[a][b][m][n] = (f32x4){0.f, 0.f, 0.f, 0.f};
        cur = nxt; cA = nA; cB = nB; ++ui;
    }
    PG8_WAIT_V(0);
    if (wr == 0) PG8_BAR;
    PG8_BAR;
#undef PG8_SA
#undef PG8_SB
#undef PG8_STAGE
#undef PG8_LDA
#undef PG8_LDB
#undef PG8_MMA
#undef PG8_WAIT_V
#undef PG8_WAIT_L
#undef PG8_BAR
#undef PG8_SCHED
}

__device__ __forceinline__ int qk_perm_row(int n) { const int i = n & 63; return (n & ~63) + 8 * ((i & 31) >> 2) + (i & 3) + 4 * (i >> 5); }
__device__ __forceinline__ void transpose_item(const float* W, int K, int N, bf16_t* WT, bool permqk, LAS float* scr, int item, int lane) {
    const int nblk = N / 32, kb = item / nblk, nb = item % nblk, k0 = 64 * kb, n0 = 32 * nb;
#pragma unroll 8
    for (int i = 0; i < 32; ++i) { const int kk = 2 * i + (lane >> 5); scr[kk * 33 + (lane & 31)] = W[(size_t)(k0 + kk) * N + n0 + (lane & 31)]; }
    asm volatile("s_waitcnt lgkmcnt(0)" ::: "memory");
    const int c = lane & 7;
#pragma unroll
    for (int j = 0; j < 4; ++j) { const int n = (lane >> 3) + 8 * j; const LAS float* s = scr + (8 * c) * 33 + n;
        u32x4 o; o.x = cvt_pk_bf16(s[0 * 33], s[1 * 33]); o.y = cvt_pk_bf16(s[2 * 33], s[3 * 33]); o.z = cvt_pk_bf16(s[4 * 33], s[5 * 33]); o.w = cvt_pk_bf16(s[6 * 33], s[7 * 33]);
        int row = n0 + n; if (permqk && row < 2 * QKVW) row = qk_perm_row(row);
        *(u32x4*)(WT + (size_t)row * K + k0 + 8 * c) = o; }
    asm volatile("s_waitcnt lgkmcnt(0)" ::: "memory");
}
__device__ __forceinline__ void reduce_angle(double a, float& c, float& s) {
    const double k = __builtin_rint(a * 0.6366197723675814); const float x = (float)(a - k * 1.5707963267948966), x2 = x * x;
    const float sn = x * (1.0f + x2 * (-1.6666666667e-1f + x2 * (8.3333333333e-3f + x2 * (-1.9841269841e-4f + x2 * 2.7557319224e-6f))));
    const float cs = 1.0f + x2 * (-0.5f + x2 * (4.1666666667e-2f + x2 * (-1.3888888889e-3f + x2 * (2.4801587302e-5f + x2 * -2.7557319224e-7f))));
    const int q = ((int)k) & 3;
    c = (q == 0) ? cs : (q == 1) ? -sn : (q == 2) ? -cs : sn;
    s = (q == 0) ? sn : (q == 1) ? cs : (q == 2) ? -sn : -cs;
}
__device__ __forceinline__ void rms_row_to_bf16(const float* xrow, const float* gw, bf16_t* orow, int lane) {
    const f32x4* xr = (const f32x4*)xrow + lane; const f32x4* gr = (const f32x4*)gw + lane;
    f32x4 v[4]; float s = 0.f;
#pragma unroll
    for (int j = 0; j < 4; ++j) { v[j] = xr[64 * j]; s += (v[j].x * v[j].x + v[j].y * v[j].y) + (v[j].z * v[j].z + v[j].w * v[j].w); }
    const float rstd = 1.0f / sqrtf(wave_sum(s) * (1.f / DM) + EPSN);
    u32x2* o8 = (u32x2*)orow + lane;
#pragma unroll
    for (int j = 0; j < 4; ++j) { const f32x4 gv = gr[64 * j]; u32x2 w; w.x = cvt_pk_bf16(v[j].x * rstd * gv.x, v[j].y * rstd * gv.y); w.y = cvt_pk_bf16(v[j].z * rstd * gv.z, v[j].w * rstd * gv.w); o8[64 * j] = w; }
}

__device__ __forceinline__ void ssm_setup_item(const Args& a, LAS unsigned char* lds, int item, int tid) {
    const int g = item >> 1, dir = item & 1;
    LAS f32x2* pw = (LAS f32x2*)lds; LAS f32x2* Bb = pw + 33 * 64; LAS f32x2* Cc = Bb + 1024;
    const float* lam_re = a.in[4]; const float* lam_im = a.in[5]; const float* log_step = a.in[6];
    const float* b_re = a.in[7]; const float* b_im = a.in[8]; const float* c_re = a.in[9]; const float* c_im = a.in[10];
    unsigned char* ws = a.ws;
    const float dt = expf(log_step[dir * 32 + g]);
    __syncthreads();
    for (int idx = tid; idx < 33 * 64; idx += 512) {
        const int tau = idx >> 6, n = idx & 63; const float lr = lam_re[(dir * 32 + g) * 64 + n], li = lam_im[(dir * 32 + g) * 64 + n];
        const float mag = expf(lr * dt * (float)tau); float c, s; reduce_angle((double)li * (double)dt * (double)tau, c, s);
        pw[idx] = (f32x2){mag * c, mag * s};
    }
    for (int idx = tid; idx < 1024; idx += 512) {
        { const int n = idx >> 4; const float lr = lam_re[(dir * 32 + g) * 64 + n], li = lam_im[(dir * 32 + g) * 64 + n];
          const float ar = lr * dt; float cb, sb, ch, sh; reduce_angle((double)li * (double)dt, cb, sb); reduce_angle(0.5 * (double)li * (double)dt, ch, sh);
          const float em1 = expm1f(ar), ea = em1 + 1.0f;
          const float nr = em1 * cb - 2.0f * sh * sh, ni = ea * sb;
          const float den = 1.0f / (lr * lr + li * li); const float cr = (nr * lr + ni * li) * den, ci = (ni * lr - nr * li) * den;
          const float br = b_re[(size_t)((dir * 32 + g) * 64) * 16 + idx], bi = b_im[(size_t)((dir * 32 + g) * 64) * 16 + idx];
          Bb[idx] = (f32x2){cr * br - ci * bi, cr * bi + ci * br}; }
        { Cc[idx] = (f32x2){c_re[(size_t)((dir * 32 + g) * 16) * 64 + idx], c_im[(size_t)((dir * 32 + g) * 16) * 64 + idx]}; }
    }
    __syncthreads();
    if (tid < 64) { float* PW = (float*)(ws + WS_PW); const f32x2 p = pw[32 * 64 + tid]; PW[((dir * 32 + g) * 64 + tid) * 2] = p.x; PW[((dir * 32 + g) * 64 + tid) * 2 + 1] = p.y; }
    { float* KT = (float*)(ws + WS_KT) + (size_t)(g * 2 + dir) * 32 * 256;
      for (int o = tid; o < 32 * 256; o += 512) {
          const int tau = o >> 8, co = (o >> 4) & 15, ci = o & 15; float acc = 0.f;
_Pragma("unroll 4")
          for (int n = 0; n < 64; ++n) { const f32x2 c = Cc[co * 64 + n], p = pw[tau * 64 + n], b = Bb[n * 16 + ci]; const float tr = c.x * p.x - c.y * p.y, ti = c.x * p.y + c.y * p.x; acc += tr * b.x - ti * b.y; }
          KT[o] = acc; } }
    { bf16_t* BsT = (bf16_t*)(ws + WS_BST) + (size_t)g * 256 * 512;
      for (int ch = tid; ch < 128 * 64; ch += 512) {
          const int row = ch >> 6, part = row >> 6, n = row & 63, kc = ch & 63, s = kc >> 1, ci0 = (kc & 1) * 8; const int e = dir ? s : 31 - s; const f32x2 p = pw[e * 64 + n];
          float v[8];
#pragma unroll
          for (int j = 0; j < 8; ++j) { const f32x2 b = Bb[n * 16 + ci0 + j]; v[j] = part ? (p.x * b.y + p.y * b.x) : (p.x * b.x - p.y * b.y); }
          u32x4 w; w.x = cvt_pk_bf16(v[0], v[1]); w.y = cvt_pk_bf16(v[2], v[3]); w.z = cvt_pk_bf16(v[4], v[5]); w.w = cvt_pk_bf16(v[6], v[7]);
          *(u32x4*)(BsT + (size_t)(dir * 128 + row) * 512 + s * 16 + ci0) = w; } }
    { bf16_t* MtC = (bf16_t*)(ws + WS_MTC) + (size_t)g * 512 * UHK;
      for (int ch = tid; ch < 512 * 16; ch += 512) {
          const int row = ch >> 4, t = row >> 4, co = row & 15, cc = ch & 15, part = cc >> 3, n0 = (cc & 7) * 8; const int e = dir ? 32 - t : t + 1;
          float v[8];
#pragma unroll
          for (int j = 0; j < 8; ++j) { const f32x2 c = Cc[co * 64 + n0 + j], p = pw[e * 64 + n0 + j]; v[j] = part ? -(c.x * p.y + c.y * p.x) : (c.x * p.x - c.y * p.y); }
          u32x4 w; w.x = cvt_pk_bf16(v[0], v[1]); w.y = cvt_pk_bf16(v[2], v[3]); w.z = cvt_pk_bf16(v[4], v[5]); w.w = cvt_pk_bf16(v[6], v[7]);
          *(u32x4*)(MtC + (size_t)row * UHK + 512 + dir * 128 + part * 64 + n0) = w; } }
    __syncthreads();
}

__device__ __forceinline__ void step_setup(const Args& a, LAS unsigned char* lds, int tid, int bx) {
    const int lane = tid & 63, wave = tid >> 6, G = gridDim.x;
    unsigned char* ws = a.ws;
    if (bx == 0 && tid < 64) ((unsigned*)(ws + WS_CTL))[tid] = 0u;
    for (int it = bx; it < 64; it += G) ssm_setup_item(a, lds, it, tid);
    { float* rc = (float*)(ws + WS_ROPE); float* rs = rc + SEQL * 32;
      for (int idx = bx * 512 + tid; idx < SEQL * 32; idx += G * 512) {
          const int pos = idx >> 5, i = idx & 31; double inv = 1.0; for (int k = 0; k < i; ++k) inv *= 0.7498942093324558;
          float c, s; reduce_angle((double)pos * inv, c, s); rc[idx] = c; rs[idx] = s; } }
    { LAS float* scr = (LAS float*)(lds) + wave * (64 * 33);
      const int gw = bx * 8 + wave, NGW = G * 8;
      constexpr int I_IN = (DM / 64) * (INC / 32), I_GLU = (512 / 64) * (512 / 32), I_AB = (512 / 64) * (1024 / 32), I_OUT = (1024 / 64) * (1024 / 32);
      constexpr int NIT = I_IN + I_GLU + 2 * I_AB + I_OUT;
      for (int it = gw; it < NIT; it += NGW) {
          int r = it;
          if (r < I_IN) { transpose_item(a.in[3], DM, INC, (bf16_t*)(ws + WS_WIN), true, scr, r, lane); continue; } r -= I_IN;
          if (r < I_GLU) { transpose_item(a.in[12], 512, 512, (bf16_t*)(ws + WS_WGLU), false, scr, r, lane); continue; } r -= I_GLU;
          if (r < I_AB) { transpose_item(a.in[13], 512, 1024, (bf16_t*)(ws + WS_WA), false, scr, r, lane); continue; } r -= I_AB;
          if (r < I_AB) { transpose_item(a.in[14], 512, 1024, (bf16_t*)(ws + WS_WB), false, scr, r, lane); continue; } r -= I_AB;
          transpose_item(a.in[15], 1024, 1024, (bf16_t*)(ws + WS_WOUT), false, scr, r, lane);
      } }
    { bf16_t* hn = (bf16_t*)((unsigned char*)a.out + OUT_HN_OFF);
      const f32x4* gr = (const f32x4*)a.in[2] + lane;
      f32x4 gv[4];
#pragma unroll
      for (int j = 0; j < 4; ++j) gv[j] = gr[64 * j];
      int row = bx * 8 + wave;
      f32x4 nx[4];
      { const f32x4* xr = (const f32x4*)xrow_ptr(a.in[0], a.in[1], row) + lane;
#pragma unroll
        for (int j = 0; j < 4; ++j) nx[j] = xr[64 * j]; }
      for (; row < TTOK; row += G * 8) {
          f32x4 v[4];
#pragma unroll
          for (int j = 0; j < 4; ++j) v[j] = nx[j];
          const int nrow = row + G * 8;
          if (nrow < TTOK) { const f32x4* xn = (const f32x4*)xrow_ptr(a.in[0], a.in[1], nrow) + lane;
#pragma unroll
              for (int j = 0; j < 4; ++j) nx[j] = xn[64 * j]; }
          float s = 0.f;
#pragma unroll
          for (int j = 0; j < 4; ++j) s += (v[j].x * v[j].x + v[j].y * v[j].y) + (v[j].z * v[j].z + v[j].w * v[j].w);
          const float rstd = 1.0f / sqrtf(wave_sum(s) * (1.f / DM) + EPSN);
          u32x2* o8 = (u32x2*)(hn + (size_t)row * DM) + lane;
#pragma unroll
          for (int j = 0; j < 4; ++j) { u32x2 w; w.x = cvt_pk_bf16(v[j].x * rstd * gv[j].x, v[j].y * rstd * gv[j].y); w.y = cvt_pk_bf16(v[j].z * rstd * gv[j].z, v[j].w * rstd * gv[j].w); o8[64 * j] = w; }
      } }
}

struct KVBuf { bf16x8 kA0, kA1, kB0, kB1; bf16x4 vA[4], vB[4]; };
__device__ __forceinline__ void step_params(int s, int& gi, int& ls) { gi = s < 12 ? 0 : (s < 18 ? 1 : 2); ls = s < 12 ? s : (s < 18 ? s - 12 : s - 18); }
__device__ __forceinline__ void attn_load(KVBuf& b, const bf16_t* Kp, const bf16_t* Vt, int s, int sq, int h, int blk, int r, int lane) {
    int gi, ls; step_params(s, gi, ls);
    const int sh = 2 * gi, Lg = SEQL >> sh, rho = r & ((1 << sh) - 1);
    int uA = ((256 * blk) >> sh) - 64 + 32 * ls, uB = uA + 16;
    if (uA < 0 || uA >= Lg) uA = 0; if (uB < 0 || uB >= Lg) uB = 0;
    const int kl = lane & 15, quad = lane >> 4;
    const bf16_t* kh = Kp + (size_t)(sq * 24 + gi * 8 + h) * SEQL * 64 + quad * 128 + kl * 8;
    const bf16_t* ka = kh + (size_t)((rho * Lg + uA) >> 4) * 1024; const bf16_t* kb = kh + (size_t)((rho * Lg + uB) >> 4) * 1024;
    b.kA0 = *(const bf16x8*)ka; b.kA1 = *(const bf16x8*)(ka + 512); b.kB0 = *(const bf16x8*)kb; b.kB1 = *(const bf16x8*)(kb + 512);
    const bf16_t* vbase = Vt + (size_t)(((sq * 3 + gi) * 8 + h) * 512) * 1024 + quad * 64 + kl * 4;
    const bf16_t* va = vbase + (size_t)((rho * Lg + uA) >> 4) * 1024; const bf16_t* vb = vbase + (size_t)((rho * Lg + uB) >> 4) * 1024;
#pragma unroll
    for (int dt = 0; dt < 4; ++dt) { b.vA[dt] = *(const bf16x4*)(va + dt * 256); b.vB[dt] = *(const bf16x4*)(vb + dt * 256); }
}
struct QF { bf16x8 a0, a1, b0, b1, c0, c1; };
template <int gi>
__device__ __forceinline__ void attn_compute(const KVBuf& b, const bf16x8 q0, const bf16x8 q1, f32x4 (&o)[4], float& mrun, float& lrun, int s, int blk, int r, int lane) {
    const int ls = gi == 0 ? s : (gi == 1 ? s - 12 : s - 18);
    const int sh = 2 * gi, Lg = SEQL >> sh;
    const int uA = ((256 * blk) >> sh) - 64 + 32 * ls;
    const int qi = lane & 15, quad = lane >> 4;
    const int uq = (256 * blk + r + 16 * qi) >> sh;
    const int lo = max(0, uq - 64), hi = min(Lg - 1, uq + 64);
    f32x4 sA = (f32x4){0.f, 0.f, 0.f, 0.f}, sB = sA;
    sA = __builtin_amdgcn_mfma_f32_16x16x32_bf16(b.kA0, q0, sA, 0, 0, 0); sA = __builtin_amdgcn_mfma_f32_16x16x32_bf16(b.kA1, q1, sA, 0, 0, 0);
    sB = __builtin_amdgcn_mfma_f32_16x16x32_bf16(b.kB0, q0, sB, 0, 0, 0); sB = __builtin_amdgcn_mfma_f32_16x16x32_bf16(b.kB1, q1, sB, 0, 0, 0);
    const float NEGINF = -__builtin_inff();
    const unsigned span = (unsigned)(hi - lo);
    float mx = NEGINF;
#pragma unroll
    for (int j = 0; j < 4; ++j) {
        const int ua = uA + quad * 4 + j, ub = ua + 16;
        sA[j] = ((unsigned)(ua - lo) <= span) ? sA[j] : NEGINF; sB[j] = ((unsigned)(ub - lo) <= span) ? sB[j] : NEGINF;
        mx = fmaxf(mx, fmaxf(sA[j], sB[j]));
    }
    mx = fmaxf(mx, __shfl_xor(mx, 16)); mx = fmaxf(mx, __shfl_xor(mx, 32));
    const float mnew = fmaxf(mrun, mx), alpha = __builtin_amdgcn_exp2f(mrun - mnew);
    mrun = mnew;
    float ps = 0.f;
#pragma unroll
    for (int j = 0; j < 4; ++j) { sA[j] = __builtin_amdgcn_exp2f(sA[j] - mnew); sB[j] = __builtin_amdgcn_exp2f(sB[j] - mnew); ps += sA[j] + sB[j]; }
    lrun = lrun * alpha + ps;
    u32x4 pw; pw.x = cvt_pk_bf16(sA[0], sA[1]); pw.y = cvt_pk_bf16(sA[2], sA[3]); pw.z = cvt_pk_bf16(sB[0], sB[1]); pw.w = cvt_pk_bf16(sB[2], sB[3]);
    const bf16x8 pf = __builtin_bit_cast(bf16x8, pw);
#pragma unroll
    for (int dt = 0; dt < 4; ++dt) {
        o[dt] *= alpha;
        bf16x8 vf; vf[0] = b.vA[dt][0]; vf[1] = b.vA[dt][1]; vf[2] = b.vA[dt][2]; vf[3] = b.vA[dt][3]; vf[4] = b.vB[dt][0]; vf[5] = b.vB[dt][1]; vf[6] = b.vB[dt][2]; vf[7] = b.vB[dt][3];
#ifdef DBG_ATT2
        for (int e = 0; e < 8; ++e) o[dt][e & 3] += 1e-3f * __uint_as_float(((unsigned)(unsigned short)vf[e]) << 16);
#else
        o[dt] = __builtin_amdgcn_mfma_f32_16x16x32_bf16(vf, pf, o[dt], 0, 0, 0);
#endif
    }
}
__device__ __forceinline__ void step_attention(const Args& a, LAS unsigned char* lds, int pass, int tid, int bx) {
    unsigned char* ws = a.ws;
    const int lane = tid & 63;
    const bf16_t* Qp = (const bf16_t*)(ws + WS_Q); const bf16_t* Kp = (const bf16_t*)(ws + WS_K); const bf16_t* Vt = (const bf16_t*)(ws + WS_VT);
    const bf16_t* ZA = (const bf16_t*)(ws + WS_ZA); bf16_t* GAO = (bf16_t*)(ws + WS_GAO);
    const int xcd = bx & 7;
    unsigned* ctr = (unsigned*)(ws + WS_CTL) + 16 + pass * 8 + xcd;
    LAS unsigned* slot = (LAS unsigned*)lds;
    constexpr int NGRP = 3 * 32 * 2;
    for (;;) {
        __syncthreads();
        if (tid == 0) slot[0] = atomicAdd(ctr, 1u);
        __syncthreads();
        const unsigned grp = (unsigned)__builtin_amdgcn_readfirstlane((int)slot[0]);
        if (grp >= (unsigned)NGRP) break;
        const int r = (int)(grp & 1) * 8 + (tid >> 6), blk = (grp >> 1) & 31, pair = xcd * 3 + (int)(grp >> 6);
        const int h = pair & 7, sq = pair >> 3;
        const int qi = lane & 15, quad = lane >> 4;
        const int tq = sq * SEQL + 256 * blk + r + 16 * qi;
        QF qf;
        { const int pos = 256 * blk + r + 16 * qi;
          const bf16_t* qa = Qp + ((size_t)(sq * 24 + h) * SEQL + pos) * 64 + quad * 8;
          const bf16_t* qb = Qp + ((size_t)(sq * 24 + 8 + h) * SEQL + (pos & 3) * 2048 + (pos >> 2)) * 64 + quad * 8;
          const bf16_t* qc = Qp + ((size_t)(sq * 24 + 16 + h) * SEQL + (pos & 15) * 512 + (pos >> 4)) * 64 + quad * 8;
          qf.a0 = *(const bf16x8*)qa; qf.a1 = *(const bf16x8*)(qa + 32); qf.b0 = *(const bf16x8*)qb; qf.b1 = *(const bf16x8*)(qb + 32); qf.c0 = *(const bf16x8*)qc; qf.c1 = *(const bf16x8*)(qc + 32); }
        f32x4 o[4];
#pragma unroll
        for (int dt = 0; dt < 4; ++dt) o[dt] = (f32x4){0.f, 0.f, 0.f, 0.f};
        float mrun = -1e30f, lrun = 0.f;
        KVBuf b0, b1;
        attn_load(b0, Kp, Vt, 0, sq, h, blk, r, lane);
#define ATT_SB __builtin_amdgcn_sched_barrier(0);
#define ATT_LOOP(GI, S0, S1, QA, QB) _Pragma("unroll 1") for (int s = S0; s < S1; s += 2) { \
            ATT_SB attn_load(b1, Kp, Vt, s + 1, sq, h, blk, r, lane); ATT_SB attn_compute<GI>(b0, QA, QB, o, mrun, lrun, s, blk, r, lane); \
            ATT_SB attn_load(b0, Kp, Vt, s + 2, sq, h, blk, r, lane); ATT_SB attn_compute<GI>(b1, QA, QB, o, mrun, lrun, s + 1, blk, r, lane); ATT_SB }
        ATT_LOOP(0, 0, 12, qf.a0, qf.a1)
        ATT_LOOP(1, 12, 18, qf.b0, qf.b1)
        ATT_LOOP(2, 18, 22, qf.c0, qf.c1)
#undef ATT_LOOP
        attn_compute<2>(b0, qf.c0, qf.c1, o, mrun, lrun, 22, blk, r, lane);
        float l = lrun; l += __shfl_xor(l, 16); l += __shfl_xor(l, 32);
        float inv = 1.0f / l;
#ifdef DBG_ATT1
        for (int dt = 0; dt < 4; ++dt) o[dt] = (f32x4){1.f, 1.f, 1.f, 1.f};
#endif
#pragma unroll
        for (int dt = 0; dt < 4; ++dt) {
            const size_t off = (size_t)tq * 512 + h * 64 + 16 * dt + 4 * quad;
            const u32x2 z = *(const u32x2*)(ZA + off);
            u32x2 w; w.x = cvt_pk_bf16(o[dt][0] * inv * bf_lo(z.x), o[dt][1] * inv * bf_hi(z.x)); w.y = cvt_pk_bf16(o[dt][2] * inv * bf_lo(z.y), o[dt][3] * inv * bf_hi(z.y));
            *(u32x2*)(GAO + off) = w;
        }
    }
}

__device__ __forceinline__ f32x2 cmul(f32x2 a, f32x2 b) { return (f32x2){a.x * b.x - a.y * b.y, a.x * b.y + a.y * b.x}; }
__device__ __forceinline__ void step_scan(const Args& a, LAS unsigned char* lds, int pass, int tid, int bx) {
    unsigned char* ws = a.ws; const int G = gridDim.x;
    const float* PW = (const float*)(ws + WS_PW); const float* S = (const float*)(ws + WS_S); bf16_t* UH = (bf16_t*)(ws + WS_UH);
    LAS f32x2* carry = (LAS f32x2*)lds;
    for (int it = bx; it < SEQP * 32 * 2; it += G) {
        const int dir = it & 1, g = (it >> 1) & 31, sq = it >> 6; const int seg = tid >> 6, n = tid & 63;
        const f32x2 P = (f32x2){PW[((dir * 32 + g) * 64 + n) * 2], PW[((dir * 32 + g) * 64 + n) * 2 + 1]};
        f32x2 z[32];
        { const int c0 = dir ? (NCH - 1 - seg * 32) : seg * 32; const long stp = dir ? -256 : 256;
          const float* sp = S + ((size_t)g * CHP + sq * NCH + c0) * 256 + dir * 128 + n;
#pragma unroll
          for (int i = 0; i < 32; ++i) { z[i] = (f32x2){sp[0], sp[64]}; sp += stp; } }
        f32x2 zz = (f32x2){0.f, 0.f};
#pragma unroll
        for (int i = 0; i < 32; ++i) { const f32x2 t = z[i]; z[i] = zz; zz = cmul(P, zz) + t; }
        __syncthreads();
        carry[seg * 64 + n] = zz;
        __syncthreads();
        f32x2 P32 = P;
#pragma unroll
        for (int k = 0; k < 5; ++k) P32 = cmul(P32, P32);
        f32x2 x = (f32x2){0.f, 0.f};
        for (int sp = 0; sp < seg; ++sp) x = cmul(P32, x) + carry[sp * 64 + n];
        f32x2 pwr = (f32x2){1.f, 0.f};
        { const int c0 = dir ? (NCH - 1 - seg * 32) : seg * 32; const long stp = dir ? -(long)UHK : (long)UHK;
          bf16_t* up = UH + ((size_t)g * CHP + sq * NCH + c0) * UHK + 512 + dir * 128 + n;
#pragma unroll
          for (int i = 0; i < 32; ++i) {
              const f32x2 hin = z[i] + cmul(pwr, x);
              up[0] = (bf16_t)(cvt_pk_bf16(hin.x, 0.f) & 0xffffu); up[64] = (bf16_t)(cvt_pk_bf16(hin.y, 0.f) & 0xffffu);
              pwr = cmul(pwr, P); up += stp;
          } }
    }
    if (pass == 0) {
        const float* KT = (const float*)(ws + WS_KT); const float* dsk = a.in[11]; bf16_t* MtC = (bf16_t*)(ws + WS_MTC);
        for (int ch = bx * 512 + tid; ch < 32 * 512 * 64; ch += G * 512) {
            const int kc = ch & 63, row = (ch >> 6) & 511, g = ch >> 15; const int s = kc >> 1, ci0 = (kc & 1) * 8, t = row >> 4, co = row & 15;
            float v[8];
#pragma unroll
            for (int j = 0; j < 8; ++j) v[j] = 0.f;
            if (t >= s) { const float* kp = KT + ((size_t)((g * 2 + 0) * 32 + (t - s)) * 16 + co) * 16 + ci0;
#pragma unroll
                for (int j = 0; j < 8; ++j) v[j] += kp[j]; }
            if (s >= t) { const float* kp = KT + ((size_t)((g * 2 + 1) * 32 + (s - t)) * 16 + co) * 16 + ci0;
#pragma unroll
                for (int j = 0; j < 8; ++j) v[j] += kp[j]; }
            if (t == s) { const float dv = dsk[g * 16 + co];
#pragma unroll
                for (int j = 0; j < 8; ++j) v[j] += (ci0 + j == co) ? dv : 0.f; }
            u32x4 w; w.x = cvt_pk_bf16(v[0], v[1]); w.y = cvt_pk_bf16(v[2], v[3]); w.z = cvt_pk_bf16(v[4], v[5]); w.w = cvt_pk_bf16(v[6], v[7]);
            *(u32x4*)(MtC + ((size_t)g * 512 + row) * UHK + s * 16 + ci0) = w;
        }
    }
}

__device__ __forceinline__ void step_final_norm(const Args& a, int pass, int tid, int bx) {
    const int lane = tid & 63, wave = tid >> 6, G = gridDim.x;
    const f32x4* gr = (const f32x4*)a.in[16] + lane;
    f32x4 gv[4];
#pragma unroll
    for (int j = 0; j < 4; ++j) gv[j] = gr[64 * j];
    int row = bx * 8 + wave;
    f32x4 nx[4];
    if (row < TP) { const f32x4* xr = (const f32x4*)(a.out + (size_t)(pass * TP + row) * DM) + lane;
#pragma unroll
        for (int j = 0; j < 4; ++j) nx[j] = xr[64 * j]; }
    for (; row < TP; row += G * 8) {
        f32x4 v[4];
#pragma unroll
        for (int j = 0; j < 4; ++j) v[j] = nx[j];
        const int nrow = row + G * 8;
        if (nrow < TP) { const f32x4* xn = (const f32x4*)(a.out + (size_t)(pass * TP + nrow) * DM) + lane;
#pragma unroll
            for (int j = 0; j < 4; ++j) nx[j] = xn[64 * j]; }
        float s = 0.f;
#pragma unroll
        for (int j = 0; j < 4; ++j) s += (v[j].x * v[j].x + v[j].y * v[j].y) + (v[j].z * v[j].z + v[j].w * v[j].w);
        const float rstd = 1.0f / sqrtf(wave_sum(s) * (1.f / DM) + EPSN);
        f32x4* xr = (f32x4*)(a.out + (size_t)(pass * TP + row) * DM) + lane;
#pragma unroll
        for (int j = 0; j < 4; ++j) xr[64 * j] = v[j] * rstd * gv[j];
    }
}

constexpr int NSTEPS = 1 + 10 * NPASS;
__host__ __device__ __forceinline__ bool sync_after(int st) { if (st == 0) return true; const int k = (st - 1) % 10; return !(k == 1 || k == 6 || k == 9); }

__global__ void __launch_bounds__(512, 2) fwd_kernel(Args a) {
    extern __shared__ __attribute__((aligned(16))) unsigned char lds_raw[];
    LAS unsigned char* lds = (LAS unsigned char*)lds_raw;
    cg::grid_group grid = cg::this_grid();
    const int G = gridDim.x;
    unsigned char* ws = a.ws;
    for (int st = a.st_lo; st < a.st_hi; ++st) {
        int tid = threadIdx.x, bx = blockIdx.x;
        asm volatile("" : "+v"(tid), "+s"(bx));
#ifndef NO_SETUP
        if (st == 0) { step_setup(a, lds, tid, bx); }
#else
        if (st == 0) {}
#endif
        else {
            const int pass = (st - 1) / 10, k = (st - 1) % 10;
            GemmD g; g.ws = ws; g.out = a.out; g.xp = a.in[0]; g.xs = a.in[1]; g.pass = pass; g.nb = 1; g.sA = 0; g.sB = 0;
            bool has_gemm = true;
            switch (k) {
            case 0: g.A = (const bf16_t*)((unsigned char*)a.out + OUT_HN_OFF) + (size_t)pass * TP * DM; g.lda = DM; g.Bt = (const bf16_t*)(ws + WS_WIN); g.ldb = DM; g.K = DM; g.nM = TP / BM; g.nN = INC / BM; g.mode = MODE_PROJ; break;
            case 1: g.A = (const bf16_t*)(ws + WS_UH); g.lda = UHK; g.sA = (size_t)CHP * UHK * 2; g.Bt = (const bf16_t*)(ws + WS_BST); g.ldb = 512; g.sB = (size_t)256 * 512 * 2; g.K = 512; g.nM = CHP / BM; g.nN = 1; g.nb = 32; g.mode = MODE_S; break;
            case 4: g.A = (const bf16_t*)(ws + WS_UH); g.lda = UHK; g.sA = (size_t)CHP * UHK * 2; g.Bt = (const bf16_t*)(ws + WS_MTC); g.ldb = UHK; g.sB = (size_t)512 * UHK * 2; g.K = UHK; g.nM = CHP / BM; g.nN = 2; g.nb = 32; g.mode = MODE_Y; break;
            case 5: g.A = (const bf16_t*)(ws + WS_SG); g.lda = 512; g.Bt = (const bf16_t*)(ws + WS_WGLU); g.ldb = 512; g.K = 512; g.nM = TP / BM; g.nN = 2; g.mode = MODE_GLU; break;
            case 6: g.A = (const bf16_t*)(ws + WS_GAO); g.lda = 512; g.Bt = (const bf16_t*)(ws + WS_WA); g.ldb = 512; g.K = 512; g.nM = TP / BM; g.nN = 4; g.mode = MODE_A; break;
            case 7: g.A = (const bf16_t*)(ws + WS_SB); g.lda = 512; g.Bt = (const bf16_t*)(ws + WS_WB); g.ldb = 512; g.K = 512; g.nM = TP / BM; g.nN = 4; g.mode = MODE_B; break;
            case 8: g.A = (const bf16_t*)(ws + WS_M1); g.lda = 1024; g.Bt = (const bf16_t*)(ws + WS_WOUT); g.ldb = 1024; g.K = 1024; g.nM = TP / BM; g.nN = 4; g.mode = MODE_OUT; break;
            default: has_gemm = false; g.A = nullptr; g.Bt = nullptr; g.lda = g.ldb = g.K = 0; g.nM = g.nN = 0; g.mode = 0; break;
            }
            if (has_gemm) {
#ifndef NO_GEMM
                gemm_phase(lds, g, G, bx, tid);
#endif
            }
#ifndef NO_ATTN
            else if (k == 2) step_attention(a, lds, pass, tid, bx);
#endif
#ifndef NO_SCAN
            else if (k == 3) step_scan(a, lds, pass, tid, bx);
#endif
            else if (k == 9) step_final_norm(a, pass, tid, bx);
        }
        if (a.do_sync && st + 1 < a.st_hi && sync_after(st)) grid.sync();
    }
}

extern "C" void kernel_launch(void* const* d_in, const int* in_sizes, int n_in, void* d_out, int out_size, void* d_ws, size_t ws_size, hipStream_t stream) {
    constexpr int LDS_BYTES = STAGE_BYTES + 32768;
    static int grid = 0;
    if (grid == 0) {
        if (n_in != 17 || out_size != TTOK * DM || ws_size < WS_END) { fprintf(stderr, "kernel_launch: unexpected shapes (n_in %d out %d ws %zu need %zu)\n", n_in, out_size, ws_size, (size_t)WS_END); grid = -1; return; }
        int dev = 0, cus = 0, per_cu = 0;
        hipGetDevice(&dev); hipDeviceGetAttribute(&cus, hipDeviceAttributeMultiprocessorCount, dev);
        hipFuncSetAttribute((const void*)fwd_kernel, hipFuncAttributeMaxDynamicSharedMemorySize, LDS_BYTES);
        hipOccupancyMaxActiveBlocksPerMultiprocessor(&per_cu, (const void*)fwd_kernel, 512, LDS_BYTES);
        if (per_cu < 1) per_cu = 1;
        grid = cus * 1;
        (void)hipGetLastError();
    }
    if (grid < 0) return;
    Args a{};
    for (int i = 0; i < 17; ++i) a.in[i] = (const float*)d_in[i];
    a.out = (float*)d_out; a.ws = (unsigned char*)d_ws; a.pad = 0;
#ifndef MULTI_LAUNCH
#define MULTI_LAUNCH 0
#endif
#if MULTI_LAUNCH
    a.do_sync = 0;
    for (int st = 0; st < NSTEPS; ++st) {
        a.st_lo = st; a.st_hi = st + 1;
        hipLaunchKernelGGL(fwd_kernel, dim3(grid), dim3(512), LDS_BYTES, stream, a);
    }
#else
    a.do_sync = 1; a.st_lo = 0; a.st_hi = NSTEPS;
    void* args[] = {&a};
    hipError_t e = hipLaunchCooperativeKernel((const void*)fwd_kernel, dim3(grid), dim3(512), args, LDS_BYTES, stream);
    if (e != hipSuccess) fprintf(stderr, "cooperative launch failed: %s (grid %d)\n", hipGetErrorString(e), grid);
#endif
}
```

```cpp
#include <hip/hip_runtime.h>
#include <hip/hip_cooperative_groups.h>
#include <cstdio>

namespace cg = cooperative_groups;

#define LAS __attribute__((address_space(3)))
typedef unsigned short bf16_t;
typedef short bf16x8 __attribute__((ext_vector_type(8)));
typedef short bf16x4 __attribute__((ext_vector_type(4)));
typedef float f32x4 __attribute__((ext_vector_type(4)));
typedef float f32x2 __attribute__((ext_vector_type(2)));
typedef unsigned u32x4 __attribute__((ext_vector_type(4)));
typedef unsigned u32x2 __attribute__((ext_vector_type(2)));

constexpr int DM = 1024, SEQL = 8192, NSEQ = 6, TTOK = NSEQ * SEQL;
constexpr int NPASS = 2, SEQP = 3, TP = SEQP * SEQL;
constexpr int INC = 8192, QKVW = 1536;
constexpr int LC = 32, NCH = SEQL / LC  , CHP = SEQP * NCH  ;
constexpr int UHK = LC * 16 + 256;
constexpr float EPSN = 1e-6f;
constexpr float QSCALE = 0.18033688011112042f;

constexpr size_t AL(size_t x) { return (x + 255) & ~(size_t)255; }
constexpr size_t WS_CTL = 0;
constexpr size_t WS_WIN = 4096;
constexpr size_t WS_WGLU = WS_WIN + (size_t)INC * DM * 2;
constexpr size_t WS_WA = WS_WGLU + (size_t)512 * 512 * 2;
constexpr size_t WS_WB = WS_WA + (size_t)1024 * 512 * 2;
constexpr size_t WS_WOUT = WS_WB + (size_t)1024 * 512 * 2;
constexpr size_t WS_MTC = WS_WOUT + (size_t)1024 * 1024 * 2;
constexpr size_t WS_BST = WS_MTC + (size_t)32 * 512 * UHK * 2;
constexpr size_t WS_ROPE = WS_BST + (size_t)32 * 256 * 512 * 2;
constexpr size_t WS_PW = WS_ROPE + (size_t)2 * SEQL * 32 * 4;
constexpr size_t WS_KT = WS_PW + (size_t)2 * 32 * 64 * 8;
constexpr size_t WS_Q = WS_KT + (size_t)32 * 2 * 32 * 256 * 4;
constexpr size_t WS_K = WS_Q + (size_t)TP * QKVW * 2;
constexpr size_t WS_VT = WS_K + (size_t)TP * QKVW * 2;
constexpr size_t WS_ZA = WS_VT + (size_t)TP * QKVW * 2;
constexpr size_t WS_ZB = WS_ZA + (size_t)TP * 512 * 2;
constexpr size_t WS_GA = WS_ZB + (size_t)TP * 512 * 2;
constexpr size_t WS_GB = WS_GA + (size_t)TP * 1024 * 2;
constexpr size_t WS_UH = WS_GB + (size_t)TP * 1024 * 2;
constexpr size_t WS_S = WS_UH + (size_t)32 * CHP * UHK * 2;
constexpr size_t WS_GAO = WS_S + (size_t)32 * CHP * 256 * 4;
constexpr size_t WS_BAR = WS_GAO + (size_t)TP * 512 * 2;
constexpr size_t WS_BAR_BYTES = 32768;
constexpr size_t WS_END = WS_BAR + WS_BAR_BYTES;
constexpr size_t WS_SG = WS_Q;
constexpr size_t WS_SB = WS_Q + (size_t)TP * 512 * 2;
constexpr size_t WS_M1 = WS_K;
constexpr size_t OUT_HN_OFF = (size_t)SEQP * SEQL * DM * 4;

struct Args {
    const float* in[17];
    float* out;
    unsigned char* ws;
    int st_lo, st_hi;
    int do_sync, pad;
};

typedef __bf16 bf16v2 __attribute__((ext_vector_type(2)));
__device__ __forceinline__ unsigned cvt_pk_bf16(float lo, float hi) { const f32x2 v = (f32x2){lo, hi}; const bf16v2 r = __builtin_convertvector(v, bf16v2); return __builtin_bit_cast(unsigned, r); }
__device__ __forceinline__ float bf_lo(unsigned w) { return __uint_as_float(w << 16); }
__device__ __forceinline__ float bf_hi(unsigned w) { return __uint_as_float(w & 0xffff0000u); }
__device__ __forceinline__ float fast_rcp(float x) { return __builtin_amdgcn_rcpf(x); }
__device__ __forceinline__ float sigmoidf_(float x) { return fast_rcp(1.0f + __builtin_amdgcn_exp2f(-1.4426950408889634f * x)); }
__device__ __forceinline__ float siluf_(float x) { return x * sigmoidf_(x); }
__device__ __forceinline__ float gelu_tanh(float x) { const float u = x * (1.5957691216057308f + 0.07135481627260025f * x * x); return x * sigmoidf_(u); }
__device__ __forceinline__ float wave_sum(float v) {
#pragma unroll
    for (int o = 1; o < 64; o <<= 1) v += __shfl_xor(v, o);
    return v;
}
__device__ __forceinline__ const float* xrow_ptr(const float* xp, const float* xs, int tg) {
    return tg < 4 * SEQL ? xp + (size_t)tg * DM : xs + (size_t)(tg - 4 * SEQL) * DM;
}

constexpr int BM = 256, BK = 64, HALF = 128, HTB = HALF * BK * 2, STAGE_BYTES = 8 * HTB, NXCD = 8, WGM = 8;
__host__ __device__ __forceinline__ int lds_byte(int r, int c) { const int st = (r >> 4) * 2 + (c >> 5), rr = r & 15, cc = c & 31, ob = rr * 64 + cc * 2; return st * 1024 + (ob ^ (((ob >> 9) & 1) << 5)); }
__host__ __device__ __forceinline__ void stage_rc(int b, int& R, int& C) { const int st = b / 1024, sb = b % 1024, swz = sb ^ (((sb >> 9) & 1) << 5); R = (st >> 1) * 16 + swz / 64; C = (st & 1) * 32 + (swz % 64) / 2; }
__host__ __device__ __forceinline__ int perm32(int rho) { const int n = rho >> 4, i = rho & 15; return 8 * (i >> 2) + 4 * n + (i & 3); }

enum { MODE_PROJ = 0, MODE_S = 1, MODE_Y = 2, MODE_GLU = 3, MODE_A = 4, MODE_B = 5, MODE_OUT = 6 };
struct Unit { int pm, pn, bz; };
struct GemmD {
    const bf16_t* A; const bf16_t* Bt;
    int lda, ldb, K, nM, nN, nb;
    size_t sA, sB;
    int mode, pass;
    unsigned char* ws; float* out; const float* xp; const float* xs;
};
__device__ __forceinline__ bool unit_next(const GemmD& g, int i, int G, int c, int& pm, int& pn, int& bz) {
    const int nwg = g.nM * g.nN;
    const long L = (long)i * G + c; const bool ok = L < (long)nwg * g.nb;
    const int Li = ok ? (int)L : 0;
    int wgid = Li; { const int q = nwg / NXCD, r = nwg % NXCD, xcd = wgid % NXCD, off = wgid / NXCD; wgid = (xcd < r ? xcd * (q + 1) : r * (q + 1) + (xcd - r) * q) + off; }
    const int nig = WGM * g.nN, gid = wgid / nig, fm = gid * WGM, gsz = (g.nM - fm) < WGM ? (g.nM - fm) : WGM;
    const int pm1 = fm + ((wgid % nig) % gsz), pn1 = (wgid % nig) / gsz;
    const int w = Li % nwg, bz2 = Li / nwg, pm2 = w % g.nM, pn2 = w / g.nM;
    const bool single = g.nb == 1;
    pm = single ? pm1 : pm2; pn = single ? pn1 : pn2; bz = single ? 0 : bz2;
    return ok;
}

__device__ __forceinline__ void epilogue(LAS unsigned char* lds, const GemmD& g, const f32x4 (&acc)[2][2][4][2], const Unit& u, int wr, int wc, int fr, int fq) {
    asm volatile("" : "+v"(fr), "+v"(fq));
    unsigned char* ws = g.ws;
    const int rbase = u.pm * BM + wr * 64 + fr;
    const int cl = wc * 32 + fq * 8;
    if (g.mode == MODE_PROJ) {
        const int pn = u.pn;
        if (pn < 12) {
            const bool isq = pn < 6;
            bf16_t* dst = (bf16_t*)(ws + (isq ? WS_Q : WS_K));
            const float* rc = (const float*)(ws + WS_ROPE); const float* rs = rc + SEQL * 32;
            const int a4 = 4 * (4 * (wc & 1) + fq);
            const int pq = isq ? pn : pn - 6, gi = pq >> 1, sh = 2 * gi, dmask = (1 << sh) - 1, Lg = SEQL >> sh;
            const float sc = isq ? QSCALE : 1.0f;
#pragma unroll
            for (int ai = 0; ai < 2; ++ai) {
                asm volatile("" ::: "memory");
                f32x4 cvv[4], svv[4];
#pragma unroll
                for (int m = 0; m < 4; ++m) { const int pos = (rbase + ai * HALF + m * 16) & (SEQL - 1); cvv[m] = *(const f32x4*)(rc + pos * 32 + a4); svv[m] = *(const f32x4*)(rs + pos * 32 + a4); }
#pragma unroll
                for (int m = 0; m < 4; ++m) {
                    const int tl = rbase + ai * HALF + m * 16; const int pos = tl & (SEQL - 1), sq = tl >> 13;
                    const int kidx = (pos & dmask) * Lg + (pos >> sh);
                    const f32x4 cv = cvv[m] * sc, sv = svv[m] * sc;
#pragma unroll
                    for (int bj = 0; bj < 2; ++bj) {
                        const f32x4 x1 = acc[ai][bj][m][0], x2 = acc[ai][bj][m][1];
                        const f32x4 o1 = x1 * cv - x2 * sv, o2 = x2 * cv + x1 * sv;
                        const int head = pq * 4 + 2 * bj + (wc >> 1);
                        const int ch = 4 * (wc & 1) + fq;
                        bf16_t* p = dst + (size_t)(sq * 24 + head) * SEQL * 64 + (isq ? (size_t)kidx * 64 + ch * 8 : (size_t)(kidx >> 4) * 1024 + ch * 128 + (kidx & 15) * 8);
                        u32x4 w; w.x = cvt_pk_bf16(o1[0], o1[1]); w.y = cvt_pk_bf16(o1[2], o1[3]); w.z = cvt_pk_bf16(o2[0], o2[1]); w.w = cvt_pk_bf16(o2[2], o2[3]);
                        *(u32x4*)p = w;
                    }
                }
            }
        } else if (pn < 18) {
            bf16_t* dst = (bf16_t*)(ws + WS_VT);
            const int gi = (pn - 12) >> 1, sh = 2 * gi;
            const int wid = wr * 4 + wc, lane = fq * 16 + fr;
            LAS bf16_t* tile = (LAS bf16_t*)(lds + STAGE_BYTES + wid * 4096);
#pragma unroll
            for (int ai = 0; ai < 2; ++ai) {
                const int tl0 = u.pm * BM + wr * 64 + ai * HALF;
                const int pos0 = tl0 & (SEQL - 1), sq = tl0 >> 13;
#pragma unroll
                for (int bj = 0; bj < 2; ++bj) {
                    asm volatile("" ::: "memory");
                    const int h = (4 * (pn - 12) + 2 * bj + (wc >> 1)) & 7;
#pragma unroll
                    for (int m = 0; m < 4; ++m) {
                        const int t = 16 * m + fr;
                        const int slot = gi == 0 ? t : (gi == 1 ? ((t & 3) * 16 + (t >> 2)) : ((t & 15) * 4 + (t >> 4)));
#pragma unroll
                        for (int n = 0; n < 2; ++n)
#pragma unroll
                            for (int j = 0; j < 4; ++j) { const unsigned w = cvt_pk_bf16(acc[ai][bj][m][n][j], 0.f); tile[(8 * fq + 4 * n + j) * 64 + slot] = (bf16_t)(w & 0xffffu); }
                    }
                    bf16_t* hb0 = dst + (size_t)(((sq * 3 + gi) * 8 + h) * 512) * 1024;
#pragma unroll
                    for (int i = 0; i < 4; ++i) {
                        const int c = lane + 64 * i, d = c >> 3, s8 = (c & 7) * 8;
                        const u32x4 v = *(const LAS u32x4*)(tile + d * 64 + s8);
                        const int dg = 32 * (wc & 1) + d; const int doff = (dg >> 4) * 256 + (dg & 15) * 4;
                        if (gi == 0) { const int kidx = pos0 + s8; bf16_t* q = hb0 + (size_t)(kidx >> 4) * 1024 + doff + ((kidx & 15) >> 2) * 64; *(u32x2*)q = (u32x2){v.x, v.y}; *(u32x2*)(q + 64) = (u32x2){v.z, v.w}; }
                        else if (gi == 1) { const int kidx = (s8 >> 4) * 2048 + (pos0 >> 2) + (s8 & 15); bf16_t* q = hb0 + (size_t)(kidx >> 4) * 1024 + doff + ((kidx & 15) >> 2) * 64; *(u32x2*)q = (u32x2){v.x, v.y}; *(u32x2*)(q + 64) = (u32x2){v.z, v.w}; }
                        else { const int ka = (s8 >> 2) * 512 + (pos0 >> 4), kb = ka + 512;
                            *(u32x2*)(hb0 + (size_t)(ka >> 4) * 1024 + doff + ((ka & 15) >> 2) * 64) = (u32x2){v.x, v.y}; *(u32x2*)(hb0 + (size_t)(kb >> 4) * 1024 + doff + ((kb & 15) >> 2) * 64) = (u32x2){v.z, v.w}; }
                    }
                }
            }
        } else if (pn == 20 || pn == 21) {
            bf16_t* dst = (bf16_t*)(ws + WS_UH);
#pragma unroll
            for (int ai = 0; ai < 2; ++ai)
#pragma unroll
                for (int m = 0; m < 4; ++m) { asm volatile("" ::: "memory");
                    const int tl = rbase + ai * HALF + m * 16;
#pragma unroll
                    for (int bj = 0; bj < 2; ++bj) {
                        const int gg = 16 * (pn - 20) + 8 * bj + 2 * wc + (fq >> 1);
                        bf16_t* p = dst + ((size_t)(gg * CHP + (tl >> 5)) * UHK) + (tl & 31) * 16 + 8 * (fq & 1);
                        const f32x4 v0 = acc[ai][bj][m][0], v1 = acc[ai][bj][m][1];
                        u32x4 w; w.x = cvt_pk_bf16(v0[0], v0[1]); w.y = cvt_pk_bf16(v0[2], v0[3]); w.z = cvt_pk_bf16(v1[0], v1[1]); w.w = cvt_pk_bf16(v1[2], v1[3]);
                        *(u32x4*)p = w;
                    }
                }
        } else {
            bf16_t* dst; int ld, c0; bool silu;
            if (pn < 20) { dst = (bf16_t*)(ws + WS_ZA); ld = 512; c0 = (pn - 18) * 256; silu = true; }
            else if (pn < 24) { dst = (bf16_t*)(ws + WS_ZB); ld = 512; c0 = (pn - 22) * 256; silu = true; }
            else if (pn < 28) { dst = (bf16_t*)(ws + WS_GA); ld = 1024; c0 = (pn - 24) * 256; silu = false; }
            else { dst = (bf16_t*)(ws + WS_GB); ld = 1024; c0 = (pn - 28) * 256; silu = false; }
#pragma unroll
            for (int ai = 0; ai < 2; ++ai)
#pragma unroll
                for (int m = 0; m < 4; ++m) { asm volatile("" ::: "memory");
                    const int tl = rbase + ai * HALF + m * 16;
#pragma unroll
                    for (int bj = 0; bj < 2; ++bj) {
                        f32x4 v0 = acc[ai][bj][m][0], v1 = acc[ai][bj][m][1];
#pragma unroll
                        for (int j = 0; j < 4; ++j) { const float s0 = sigmoidf_(v0[j]), s1 = sigmoidf_(v1[j]); v0[j] = silu ? v0[j] * s0 : s0; v1[j] = silu ? v1[j] * s1 : s1; }
                        u32x4 w; w.x = cvt_pk_bf16(v0[0], v0[1]); w.y = cvt_pk_bf16(v0[2], v0[3]); w.z = cvt_pk_bf16(v1[0], v1[1]); w.w = cvt_pk_bf16(v1[2], v1[3]);
                        *(u32x4*)(dst + (size_t)tl * ld + c0 + cl + bj * HALF) = w;
                    }
                }
        }
    } else if (g.mode == MODE_S) {
        float* dst = (float*)(ws + WS_S) + (size_t)u.bz * CHP * 256;
#pragma unroll
        for (int ai = 0; ai < 2; ++ai)
#pragma unroll
            for (int m = 0; m < 4; ++m) { asm volatile("" ::: "memory");
                const int r = rbase + ai * HALF + m * 16;
#pragma unroll
                for (int bj = 0; bj < 2; ++bj) { float* p = dst + (size_t)r * 256 + cl + bj * HALF; *(f32x4*)p = acc[ai][bj][m][0]; *(f32x4*)(p + 4) = acc[ai][bj][m][1]; }
            }
    } else if (g.mode == MODE_Y) {
        bf16_t* dst = (bf16_t*)(ws + WS_SG);
#pragma unroll
        for (int ai = 0; ai < 2; ++ai)
#pragma unroll
            for (int m = 0; m < 4; ++m) { asm volatile("" ::: "memory");
                const int r = rbase + ai * HALF + m * 16;
#pragma unroll
                for (int bj = 0; bj < 2; ++bj) {
                    const int t = 16 * u.pn + 8 * bj + 2 * wc + (fq >> 1);
                    f32x4 v0 = acc[ai][bj][m][0], v1 = acc[ai][bj][m][1];
#pragma unroll
                    for (int j = 0; j < 4; ++j) { v0[j] = gelu_tanh(v0[j]); v1[j] = gelu_tanh(v1[j]); }
                    u32x4 w; w.x = cvt_pk_bf16(v0[0], v0[1]); w.y = cvt_pk_bf16(v0[2], v0[3]); w.z = cvt_pk_bf16(v1[0], v1[1]); w.w = cvt_pk_bf16(v1[2], v1[3]);
                    *(u32x4*)(dst + (size_t)(r * LC + t) * 512 + u.bz * 16 + 8 * (fq & 1)) = w;
                }
            }
    } else if (g.mode == MODE_GLU) {
        const bf16_t* sg = (const bf16_t*)(ws + WS_SG); const bf16_t* zb = (const bf16_t*)(ws + WS_ZB); bf16_t* dst = (bf16_t*)(ws + WS_SB);
#pragma unroll
        for (int ai = 0; ai < 2; ++ai) {
            asm volatile("" ::: "memory");
            u32x4 sv4[4][2], zv4[4][2];
#pragma unroll
            for (int m = 0; m < 4; ++m)
#pragma unroll
                for (int bj = 0; bj < 2; ++bj) { const size_t off = (size_t)(rbase + ai * HALF + m * 16) * 512 + u.pn * BM + cl + bj * HALF; sv4[m][bj] = *(const u32x4*)(sg + off); zv4[m][bj] = *(const u32x4*)(zb + off); }
#pragma unroll
            for (int m = 0; m < 4; ++m)
#pragma unroll
                for (int bj = 0; bj < 2; ++bj) {
                    const size_t off = (size_t)(rbase + ai * HALF + m * 16) * 512 + u.pn * BM + cl + bj * HALF;
                    const u32x4 s4 = sv4[m][bj], z4 = zv4[m][bj];
                    const f32x4 v0 = acc[ai][bj][m][0], v1 = acc[ai][bj][m][1];
                    u32x4 w;
                    w.x = cvt_pk_bf16(bf_lo(s4.x) * sigmoidf_(v0[0]) * bf_lo(z4.x), bf_hi(s4.x) * sigmoidf_(v0[1]) * bf_hi(z4.x));
                    w.y = cvt_pk_bf16(bf_lo(s4.y) * sigmoidf_(v0[2]) * bf_lo(z4.y), bf_hi(s4.y) * sigmoidf_(v0[3]) * bf_hi(z4.y));
                    w.z = cvt_pk_bf16(bf_lo(s4.z) * sigmoidf_(v1[0]) * bf_lo(z4.z), bf_hi(s4.z) * sigmoidf_(v1[1]) * bf_hi(z4.z));
                    w.w = cvt_pk_bf16(bf_lo(s4.w) * sigmoidf_(v1[2]) * bf_lo(z4.w), bf_hi(s4.w) * sigmoidf_(v1[3]) * bf_hi(z4.w));
                    *(u32x4*)(dst + off) = w;
                }
        }
    } else if (g.mode == MODE_A || g.mode == MODE_B) {
        const bool isb = g.mode == MODE_B;
        const bf16_t* gt = (const bf16_t*)(ws + (isb ? WS_GB : WS_GA)); bf16_t* dst = (bf16_t*)(ws + WS_M1);
#pragma unroll
        for (int ai = 0; ai < 2; ++ai) {
            asm volatile("" ::: "memory");
            u32x4 gv4[4][2], pv4[4][2];
#pragma unroll
            for (int m = 0; m < 4; ++m)
#pragma unroll
                for (int bj = 0; bj < 2; ++bj) { const size_t off = (size_t)(rbase + ai * HALF + m * 16) * 1024 + u.pn * BM + cl + bj * HALF; gv4[m][bj] = *(const u32x4*)(gt + off); pv4[m][bj] = (u32x4){0u, 0u, 0u, 0u}; if (isb) pv4[m][bj] = *(const u32x4*)(dst + off); }
#pragma unroll
            for (int m = 0; m < 4; ++m)
#pragma unroll
                for (int bj = 0; bj < 2; ++bj) {
                    const size_t off = (size_t)(rbase + ai * HALF + m * 16) * 1024 + u.pn * BM + cl + bj * HALF;
                    const u32x4 g4 = gv4[m][bj], p4 = pv4[m][bj];
                    const f32x4 v0 = acc[ai][bj][m][0], v1 = acc[ai][bj][m][1];
                    u32x4 w;
                    w.x = cvt_pk_bf16(bf_lo(p4.x) + bf_lo(g4.x) * v0[0], bf_hi(p4.x) + bf_hi(g4.x) * v0[1]);
                    w.y = cvt_pk_bf16(bf_lo(p4.y) + bf_lo(g4.y) * v0[2], bf_hi(p4.y) + bf_hi(g4.y) * v0[3]);
                    w.z = cvt_pk_bf16(bf_lo(p4.z) + bf_lo(g4.z) * v1[0], bf_hi(p4.z) + bf_hi(g4.z) * v1[1]);
                    w.w = cvt_pk_bf16(bf_lo(p4.w) + bf_lo(g4.w) * v1[2], bf_hi(p4.w) + bf_hi(g4.w) * v1[3]);
                    *(u32x4*)(dst + off) = w;
                }
        }
    } else {
#pragma unroll
        for (int ai = 0; ai < 2; ++ai) {
            asm volatile("" ::: "memory");
            f32x4 xa[4][2][2];
#pragma unroll
            for (int m = 0; m < 4; ++m) {
                const float* xr = xrow_ptr(g.xp, g.xs, g.pass * TP + rbase + ai * HALF + m * 16);
#pragma unroll
                for (int bj = 0; bj < 2; ++bj) { const int c = u.pn * BM + cl + bj * HALF; xa[m][bj][0] = *(const f32x4*)(xr + c); xa[m][bj][1] = *(const f32x4*)(xr + c + 4); }
            }
#pragma unroll
            for (int m = 0; m < 4; ++m) {
                float* orow = g.out + (size_t)(g.pass * TP + rbase + ai * HALF + m * 16) * DM;
#pragma unroll
                for (int bj = 0; bj < 2; ++bj) {
                    const int c = u.pn * BM + cl + bj * HALF;
                    *(f32x4*)(orow + c) = xa[m][bj][0] + acc[ai][bj][m][0]; *(f32x4*)(orow + c + 4) = xa[m][bj][1] + acc[ai][bj][m][1];
                }
            }
        }
    }
}

__device__ __forceinline__ void gemm_phase(LAS unsigned char* lds, const GemmD& g, int G, int cidx, int tid) {
    const int wid = __builtin_amdgcn_readfirstlane(tid >> 6), lane = tid & 63, wr = wid >> 2, wc = wid & 3, fr = lane & 15, fq = lane >> 4;
    const int K = g.K, nt = K / BK;
    unsigned voffA[2], voffB[2];
#pragma unroll
    for (int i = 0; i < 2; ++i) { int R, C; stage_rc(tid * 16 + i * 8192, R, C); const int Rb = (R & ~31) + perm32(R & 31);
        voffA[i] = (unsigned)(R * g.lda + C) * 2u; voffB[i] = (unsigned)(Rb * g.ldb + C) * 2u; }
    const size_t kstep = (size_t)(BK * 2);
    const size_t hstepA = (size_t)HALF * g.lda * 2, hstepB = (size_t)HALF * g.ldb * 2;
    const size_t tstepA = 2 * hstepA, tstepB = 2 * hstepB;
    const unsigned ldsw = (unsigned)wid * 1024u;
    const int aoff = lds_byte(wr * 64 + fr, fq * 8), boff = lds_byte(wc * 32 + fr, fq * 8);
#define PG8_SA(b, h) (((b) * 2 + (h)) * HTB)
#define PG8_SB(b, h) ((4 + (b) * 2 + (h)) * HTB)
#define PG8_STAGE(bufoff, gbase, voff) do { _Pragma("unroll") for (int _i = 0; _i < 2; ++_i) \
        __builtin_amdgcn_global_load_lds((const unsigned*)((const char*)(gbase) + (voff)[_i]), (LAS unsigned*)(lds + (bufoff) + ldsw + _i * 8192), 16, 0, 0); } while (0)
#define PG8_LDA(dst, b, h) do { _Pragma("unroll") for (int m = 0; m < 4; ++m) _Pragma("unroll") for (int k = 0; k < 2; ++k) dst[m][k] = *(const LAS bf16x8*)(lds + PG8_SA(b, h) + aoff + m * 2048 + k * 1024); } while (0)
#define PG8_LDB(dst, b, h) do { _Pragma("unroll") for (int n = 0; n < 2; ++n) _Pragma("unroll") for (int k = 0; k < 2; ++k) dst[n][k] = *(const LAS bf16x8*)(lds + PG8_SB(b, h) + boff + n * 2048 + k * 1024); } while (0)
#define PG8_MMA(ai, bj, At, Bt) do { __builtin_amdgcn_s_setprio(1); _Pragma("unroll") for (int m = 0; m < 4; ++m) _Pragma("unroll") for (int n = 0; n < 2; ++n) _Pragma("unroll") for (int k = 0; k < 2; ++k) \
        acc[ai][bj][m][n] = __builtin_amdgcn_mfma_f32_16x16x32_bf16(Bt[n][k], At[m][k], acc[ai][bj][m][n], 0, 0, 0); __builtin_amdgcn_s_setprio(0); } while (0)
#define PG8_WAIT_V(n) asm volatile("s_waitcnt vmcnt(" #n ")" ::: "memory")
#define PG8_WAIT_L(n) asm volatile("s_waitcnt lgkmcnt(" #n ")" ::: "memory")
#define PG8_BAR __builtin_amdgcn_s_barrier()
#define PG8_SCHED __builtin_amdgcn_sched_barrier(0)
    Unit cur, nxt; int ui = 0;
    { int pm_, pn_, bz_; if (!unit_next(g, 0, G, cidx, pm_, pn_, bz_)) return; cur.pm = pm_; cur.pn = pn_; cur.bz = bz_; }
    f32x4 acc[2][2][4][2];
#pragma unroll
    for (int a = 0; a < 2; ++a)
#pragma unroll
        for (int b = 0; b < 2; ++b)
#pragma unroll
            for (int m = 0; m < 4; ++m)
#pragma unroll
                for (int n = 0; n < 2; ++n) acc[a][b][m][n] = (f32x4){0.f, 0.f, 0.f, 0.f};
    bf16x8 At[4][2], B0[2][2], B1[2][2];
    const char* cA = (const char*)g.A + (size_t)cur.bz * g.sA + (size_t)cur.pm * tstepA; const char* cB = (const char*)g.Bt + (size_t)cur.bz * g.sB + (size_t)cur.pn * tstepB;
    PG8_STAGE(PG8_SB(0, 0), cB, voffB); PG8_STAGE(PG8_SA(0, 0), cA, voffA); PG8_STAGE(PG8_SB(0, 1), cB + hstepB, voffB); PG8_STAGE(PG8_SA(0, 1), cA + hstepA, voffA);
    if (wr == 1) PG8_BAR;
    PG8_WAIT_V(4); PG8_BAR;
    PG8_STAGE(PG8_SB(1, 0), cB + kstep, voffB); PG8_STAGE(PG8_SA(1, 0), cA + kstep, voffA); PG8_STAGE(PG8_SB(1, 1), cB + hstepB + kstep, voffB);
    PG8_WAIT_V(6); PG8_BAR;
    for (;;) {
        int npm, npn, nbz; const bool has_next = unit_next(g, ui + 1, G, cidx, npm, npn, nbz); nxt.pm = npm; nxt.pn = npn; nxt.bz = nbz;
        const char* nA = has_next ? (const char*)g.A + (size_t)nxt.bz * g.sA + (size_t)nxt.pm * tstepA : cA; const char* nB = has_next ? (const char*)g.Bt + (size_t)nxt.bz * g.sB + (size_t)nxt.pn * tstepB : cB;
        for (int t = 0; t < nt; t += 2) {
            const bool last = (t == nt - 2);
            const char* a1 = cA + (size_t)(t + 1) * kstep;
            const char* a2 = last ? nA : cA + (size_t)(t + 2) * kstep; const char* b2 = last ? nB : cB + (size_t)(t + 2) * kstep;
            const char* a3 = a2 + kstep; const char* b3 = b2 + kstep;
            PG8_LDB(B0, 0, 0); PG8_SCHED; PG8_LDA(At, 0, 0); PG8_STAGE(PG8_SA(1, 1), a1 + hstepA, voffA);
            PG8_WAIT_L(8); PG8_BAR; PG8_WAIT_L(0); PG8_MMA(0, 0, At, B0); PG8_BAR; PG8_SCHED;
            PG8_LDB(B1, 0, 1); PG8_STAGE(PG8_SB(0, 0), b2, voffB);
            PG8_BAR; PG8_WAIT_L(0); PG8_MMA(0, 1, At, B1); PG8_BAR;
            PG8_LDA(At, 0, 1); PG8_STAGE(PG8_SA(0, 0), a2, voffA);
            PG8_BAR; PG8_WAIT_L(0); PG8_MMA(1, 0, At, B0); PG8_BAR; PG8_SCHED;
            PG8_STAGE(PG8_SB(0, 1), b2 + hstepB, voffB);
            PG8_WAIT_V(6); PG8_BAR; PG8_MMA(1, 1, At, B1); PG8_BAR;
            PG8_LDB(B0, 1, 0); PG8_SCHED; PG8_LDA(At, 1, 0); PG8_STAGE(PG8_SA(0, 1), a2 + hstepA, voffA);
            PG8_WAIT_L(8); PG8_BAR; PG8_WAIT_L(0); PG8_MMA(0, 0, At, B0); PG8_BAR; PG8_SCHED;
            PG8_LDB(B1, 1, 1); PG8_STAGE(PG8_SB(1, 0), b3, voffB);
            PG8_BAR; PG8_WAIT_L(0); PG8_MMA(0, 1, At, B1); PG8_BAR;
            PG8_LDA(At, 1, 1); PG8_STAGE(PG8_SA(1, 0), a3, voffA);
            PG8_BAR; PG8_WAIT_L(0); PG8_MMA(1, 0, At, B0); PG8_BAR; PG8_SCHED;
            PG8_STAGE(PG8_SB(1, 1), b3 + hstepB, voffB);
            PG8_WAIT_V(6); PG8_BAR; PG8_MMA(1, 1, At, B1); PG8_BAR;
        }
#ifndef NO_EPI
        epilogue(lds, g, acc, cur, wr, wc, fr, fq);
#else
        if (g.mode == 99) *(f32x4*)(g.out) = acc[0][0][0][0] + acc[1][1][3][1] + acc[0][1][2][0]+acc[1][0][1][1];
#endif
        if (!has_next) break;
#pragma unroll
        for (int a = 0; a < 2; ++a)
#pragma unroll
            for (int b = 0; b < 2; ++b)
#pragma unroll
                for (int m = 0; m < 4; ++m)
#pragma unroll
                    for (int n = 0; n < 2; ++n) acc[a][b][m][n] = (f32x4){0.f, 0.f, 0.f, 0.f};
        cur = nxt; cA = nA; cB = nB; ++ui;
    }
    PG8_WAIT_V(0);
    if (wr == 0) PG8_BAR;
    PG8_BAR;
#undef PG8_SA
#undef PG8_SB
#undef PG8_STAGE
#undef PG8_LDA
#undef PG8_LDB
#undef PG8_MMA
#undef PG8_WAIT_V
#undef PG8_WAIT_L
#undef PG8_BAR
#undef PG8_SCHED
}

__device__ __forceinline__ int qk_perm_row(int n) { const int i = n & 63; return (n & ~63) + 8 * ((i & 31) >> 2) + (i & 3) + 4 * (i >> 5); }
__device__ __forceinline__ void transpose_item(const float* W, int K, int N, bf16_t* WT, bool permqk, LAS float* scr, int item, int lane) {
    const int nblk = N / 32, kb = item / nblk, nb = item % nblk, k0 = 64 * kb, n0 = 32 * nb;
#pragma unroll 8
    for (int i = 0; i < 32; ++i) { const int kk = 2 * i + (lane >> 5); scr[kk * 33 + (lane & 31)] = W[(size_t)(k0 + kk) * N + n0 + (lane & 31)]; }
    asm volatile("s_waitcnt lgkmcnt(0)" ::: "memory");
    const int c = lane & 7;
#pragma unroll
    for (int j = 0; j < 4; ++j) { const int n = (lane >> 3) + 8 * j; const LAS float* s = scr + (8 * c) * 33 + n;
        u32x4 o; o.x = cvt_pk_bf16(s[0 * 33], s[1 * 33]); o.y = cvt_pk_bf16(s[2 * 33], s[3 * 33]); o.z = cvt_pk_bf16(s[4 * 33], s[5 * 33]); o.w = cvt_pk_bf16(s[6 * 33], s[7 * 33]);
        int row = n0 + n; if (permqk && row < 2 * QKVW) row = qk_perm_row(row);
        *(u32x4*)(WT + (size_t)row * K + k0 + 8 * c) = o; }
    asm volatile("s_waitcnt lgkmcnt(0)" ::: "memory");
}
__device__ __forceinline__ void reduce_angle(double a, float& c, float& s) {
    const double k = __builtin_rint(a * 0.6366197723675814); const float x = (float)(a - k * 1.5707963267948966), x2 = x * x;
    const float sn = x * (1.0f + x2 * (-1.6666666667e-1f + x2 * (8.3333333333e-3f + x2 * (-1.9841269841e-4f + x2 * 2.7557319224e-6f))));
    const float cs = 1.0f + x2 * (-0.5f + x2 * (4.1666666667e-2f + x2 * (-1.3888888889e-3f + x2 * (2.4801587302e-5f + x2 * -2.7557319224e-7f))));
    const int q = ((int)k) & 3;
    c = (q == 0) ? cs : (q == 1) ? -sn : (q == 2) ? -cs : sn;
    s = (q == 0) ? sn : (q == 1) ? cs : (q == 2) ? -sn : -cs;
}
__device__ __forceinline__ void rms_row_to_bf16(const float* xrow, const float* gw, bf16_t* orow, int lane) {
    const f32x4* xr = (const f32x4*)xrow + lane; const f32x4* gr = (const f32x4*)gw + lane;
    f32x4 v[4]; float s = 0.f;
#pragma unroll
    for (int j = 0; j < 4; ++j) { v[j] = xr[64 * j]; s += (v[j].x * v[j].x + v[j].y * v[j].y) + (v[j].z * v[j].z + v[j].w * v[j].w); }
    const float rstd = 1.0f / sqrtf(wave_sum(s) * (1.f / DM) + EPSN);
    u32x2* o8 = (u32x2*)orow + lane;
#pragma unroll
    for (int j = 0; j < 4; ++j) { const f32x4 gv = gr[64 * j]; u32x2 w; w.x = cvt_pk_bf16(v[j].x * rstd * gv.x, v[j].y * rstd * gv.y); w.y = cvt_pk_bf16(v[j].z * rstd * gv.z, v[j].w * rstd * gv.w); o8[64 * j] = w; }
}

__device__ __forceinline__ void ssm_load_bc(const Args& a, int g, int dir, LAS f32x2* Bb, LAS f32x2* Cc, int tid) {
    const float* lam_re = a.in[4]; const float* lam_im = a.in[5]; const float* log_step = a.in[6];
    const float* b_re = a.in[7]; const float* b_im = a.in[8]; const float* c_re = a.in[9]; const float* c_im = a.in[10];
    const float dt = expf(log_step[dir * 32 + g]);
    for (int idx = tid; idx < 1024; idx += 512) {
        { const int n = idx >> 4; const float lr = lam_re[(dir * 32 + g) * 64 + n], li = lam_im[(dir * 32 + g) * 64 + n];
          const float ar = lr * dt; float cb, sb, ch, sh; reduce_angle((double)li * (double)dt, cb, sb); reduce_angle(0.5 * (double)li * (double)dt, ch, sh);
          const float em1 = expm1f(ar), ea = em1 + 1.0f;
          const float nr = em1 * cb - 2.0f * sh * sh, ni = ea * sb;
          const float den = 1.0f / (lr * lr + li * li); const float cr = (nr * lr + ni * li) * den, ci = (ni * lr - nr * li) * den;
          const float br = b_re[(size_t)((dir * 32 + g) * 64) * 16 + idx], bi = b_im[(size_t)((dir * 32 + g) * 64) * 16 + idx];
          Bb[idx] = (f32x2){cr * br - ci * bi, cr * bi + ci * br}; }
        { Cc[idx] = (f32x2){c_re[(size_t)((dir * 32 + g) * 16) * 64 + idx], c_im[(size_t)((dir * 32 + g) * 16) * 64 + idx]}; }
    }
}
__device__ __forceinline__ void ssm_setup_item(const Args& a, LAS unsigned char* lds, int item, int tid) {
    const int g = item >> 1, dir = item & 1;
    LAS f32x2* pw = (LAS f32x2*)lds; LAS f32x2* Bb = pw + 33 * 64; LAS f32x2* Cc = Bb + 1024;
    LAS float* KT = (LAS float*)(Cc + 1024); LAS float* K0 = KT + 32 * 256; LAS f32x2* Bb0 = (LAS f32x2*)(K0 + 256); LAS f32x2* Cc0 = Bb0 + 1024;
    const float* lam_re = a.in[4]; const float* lam_im = a.in[5]; const float* log_step = a.in[6];
    unsigned char* ws = a.ws;
    const float dt = expf(log_step[dir * 32 + g]);
    __syncthreads();
    for (int idx = tid; idx < 33 * 64; idx += 512) {
        const int tau = idx >> 6, n = idx & 63; const float lr = lam_re[(dir * 32 + g) * 64 + n], li = lam_im[(dir * 32 + g) * 64 + n];
        const float mag = expf(lr * dt * (float)tau); float c, s; reduce_angle((double)li * (double)dt * (double)tau, c, s);
        pw[idx] = (f32x2){mag * c, mag * s};
    }
    ssm_load_bc(a, g, dir, Bb, Cc, tid);
    if (dir == 1) ssm_load_bc(a, g, 0, Bb0, Cc0, tid);
    __syncthreads();
    if (tid < 64) { float* PW = (float*)(ws + WS_PW); const f32x2 p = pw[32 * 64 + tid]; PW[((dir * 32 + g) * 64 + tid) * 2] = p.x; PW[((dir * 32 + g) * 64 + tid) * 2 + 1] = p.y; }
    for (int o = tid; o < 32 * 256; o += 512) {
        const int tau = o >> 8, co = (o >> 4) & 15, ci = o & 15; float acc = 0.f;
_Pragma("unroll 4")
        for (int n = 0; n < 64; ++n) { const f32x2 c = Cc[co * 64 + n], p = pw[tau * 64 + n], b = Bb[n * 16 + ci]; const float tr = c.x * p.x - c.y * p.y, ti = c.x * p.y + c.y * p.x; acc += tr * b.x - ti * b.y; }
        KT[o] = acc; }
    if (dir == 1 && tid < 256) { const int co = tid >> 4, ci = tid & 15; float acc = 0.f;
_Pragma("unroll 4")
        for (int n = 0; n < 64; ++n) { const f32x2 c = Cc0[co * 64 + n], b = Bb0[n * 16 + ci]; acc += c.x * b.x - c.y * b.y; }
        K0[tid] = acc; }
    { bf16_t* BsT = (bf16_t*)(ws + WS_BST) + (size_t)g * 256 * 512;
      for (int ch = tid; ch < 128 * 64; ch += 512) {
          const int row = ch >> 6, part = row >> 6, n = row & 63, kc = ch & 63, s = kc >> 1, ci0 = (kc & 1) * 8; const int e = dir ? s : 31 - s; const f32x2 p = pw[e * 64 + n];
          float v[8];
#pragma unroll
          for (int j = 0; j < 8; ++j) { const f32x2 b = Bb[n * 16 + ci0 + j]; v[j] = part ? (p.x * b.y + p.y * b.x) : (p.x * b.x - p.y * b.y); }
          u32x4 w; w.x = cvt_pk_bf16(v[0], v[1]); w.y = cvt_pk_bf16(v[2], v[3]); w.z = cvt_pk_bf16(v[4], v[5]); w.w = cvt_pk_bf16(v[6], v[7]);
          *(u32x4*)(BsT + (size_t)(dir * 128 + row) * 512 + s * 16 + ci0) = w; } }
    bf16_t* MtC = (bf16_t*)(ws + WS_MTC) + (size_t)g * 512 * UHK;
    { for (int ch = tid; ch < 512 * 16; ch += 512) {
          const int row = ch >> 4, t = row >> 4, co = row & 15, cc = ch & 15, part = cc >> 3, n0 = (cc & 7) * 8; const int e = dir ? 32 - t : t + 1;
          float v[8];
#pragma unroll
          for (int j = 0; j < 8; ++j) { const f32x2 c = Cc[co * 64 + n0 + j], p = pw[e * 64 + n0 + j]; v[j] = part ? -(c.x * p.y + c.y * p.x) : (c.x * p.x - c.y * p.y); }
          u32x4 w; w.x = cvt_pk_bf16(v[0], v[1]); w.y = cvt_pk_bf16(v[2], v[3]); w.z = cvt_pk_bf16(v[4], v[5]); w.w = cvt_pk_bf16(v[6], v[7]);
          *(u32x4*)(MtC + (size_t)row * UHK + 512 + dir * 128 + part * 64 + n0) = w; } }
    __syncthreads();
    { const float* dsk = a.in[11];
      for (int ch = tid; ch < 512 * 64; ch += 512) {
          const int kc = ch & 63, row = ch >> 6; const int s = kc >> 1, ci0 = (kc & 1) * 8, t = row >> 4, co = row & 15;
          if (dir == 0 ? (t > s) : (s >= t)) {
              const int tau = dir == 0 ? t - s : s - t;
              float v[8];
#pragma unroll
              for (int j = 0; j < 8; ++j) v[j] = KT[tau * 256 + co * 16 + ci0 + j];
              if (t == s) { const float dv = dsk[g * 16 + co];
#pragma unroll
                  for (int j = 0; j < 8; ++j) v[j] += K0[co * 16 + ci0 + j] + ((ci0 + j == co) ? dv : 0.f); }
              u32x4 w; w.x = cvt_pk_bf16(v[0], v[1]); w.y = cvt_pk_bf16(v[2], v[3]); w.z = cvt_pk_bf16(v[4], v[5]); w.w = cvt_pk_bf16(v[6], v[7]);
              *(u32x4*)(MtC + (size_t)row * UHK + s * 16 + ci0) = w;
          }
      } }
    __syncthreads();
}

__device__ __forceinline__ void step_setup(const Args& a, LAS unsigned char* lds, int tid, int bx) {
    const int lane = tid & 63, wave = tid >> 6, G = gridDim.x;
    unsigned char* ws = a.ws;
    for (int it = bx; it < 64; it += G) ssm_setup_item(a, lds, it, tid);
    { float* rc = (float*)(ws + WS_ROPE); float* rs = rc + SEQL * 32;
      for (int idx = bx * 512 + tid; idx < SEQL * 32; idx += G * 512) {
          const int pos = idx >> 5, i = idx & 31; double inv = 1.0; for (int k = 0; k < i; ++k) inv *= 0.7498942093324558;
          float c, s; reduce_angle((double)pos * inv, c, s); rc[idx] = c; rs[idx] = s; } }
    { LAS float* scr = (LAS float*)(lds) + wave * (64 * 33);
      const int gw = bx * 8 + wave, NGW = G * 8;
      constexpr int I_IN = (DM / 64) * (INC / 32), I_GLU = (512 / 64) * (512 / 32), I_AB = (512 / 64) * (1024 / 32), I_OUT = (1024 / 64) * (1024 / 32);
      constexpr int NIT = I_IN + I_GLU + 2 * I_AB + I_OUT;
      for (int it = gw; it < NIT; it += NGW) {
          int r = it;
          if (r < I_IN) { transpose_item(a.in[3], DM, INC, (bf16_t*)(ws + WS_WIN), true, scr, r, lane); continue; } r -= I_IN;
          if (r < I_GLU) { transpose_item(a.in[12], 512, 512, (bf16_t*)(ws + WS_WGLU), false, scr, r, lane); continue; } r -= I_GLU;
          if (r < I_AB) { transpose_item(a.in[13], 512, 1024, (bf16_t*)(ws + WS_WA), false, scr, r, lane); continue; } r -= I_AB;
          if (r < I_AB) { transpose_item(a.in[14], 512, 1024, (bf16_t*)(ws + WS_WB), false, scr, r, lane); continue; } r -= I_AB;
          transpose_item(a.in[15], 1024, 1024, (bf16_t*)(ws + WS_WOUT), false, scr, r, lane);
      } }
    { bf16_t* hn = (bf16_t*)((unsigned char*)a.out + OUT_HN_OFF);
      const f32x4* gr = (const f32x4*)a.in[2] + lane;
      f32x4 gv[4];
#pragma unroll
      for (int j = 0; j < 4; ++j) gv[j] = gr[64 * j];
      unsigned* rctr = (unsigned*)(ws + WS_CTL) + 4;
      constexpr int RCH = 16;
      for (;;) {
          unsigned cidx = 0; if (lane == 0) cidx = atomicAdd(rctr, 1u);
          cidx = (unsigned)__builtin_amdgcn_readfirstlane((int)cidx);
          if (cidx >= (unsigned)(TTOK / RCH)) break;
          int row = (int)cidx * RCH; const int rend = row + RCH;
          f32x4 nx[4];
          { const f32x4* xr = (const f32x4*)xrow_ptr(a.in[0], a.in[1], row) + lane;
#pragma unroll
            for (int j = 0; j < 4; ++j) nx[j] = xr[64 * j]; }
          for (; row < rend; ++row) {
              f32x4 v[4];
#pragma unroll
              for (int j = 0; j < 4; ++j) v[j] = nx[j];
              if (row + 1 < rend) { const f32x4* xn = (const f32x4*)xrow_ptr(a.in[0], a.in[1], row + 1) + lane;
#pragma unroll
                  for (int j = 0; j < 4; ++j) nx[j] = xn[64 * j]; }
              float s = 0.f;
#pragma unroll
              for (int j = 0; j < 4; ++j) s += (v[j].x * v[j].x + v[j].y * v[j].y) + (v[j].z * v[j].z + v[j].w * v[j].w);
              const float rstd = 1.0f / sqrtf(wave_sum(s) * (1.f / DM) + EPSN);
              u32x2* o8 = (u32x2*)(hn + (size_t)row * DM) + lane;
#pragma unroll
              for (int j = 0; j < 4; ++j) { u32x2 w; w.x = cvt_pk_bf16(v[j].x * rstd * gv[j].x, v[j].y * rstd * gv[j].y); w.y = cvt_pk_bf16(v[j].z * rstd * gv[j].z, v[j].w * rstd * gv[j].w); o8[64 * j] = w; }
          }
      } }
}

struct KVBuf { bf16x8 kA0, kA1, kB0, kB1; bf16x4 vA[4], vB[4]; };
__device__ __forceinline__ void step_params(int s, int& gi, int& ls) { gi = s < 12 ? 0 : (s < 18 ? 1 : 2); ls = s < 12 ? s : (s < 18 ? s - 12 : s - 18); }
__device__ __forceinline__ void attn_load(KVBuf& b, const bf16_t* Kp, const bf16_t* Vt, int s, int sq, int h, int blk, int r, int lane) {
    int gi, ls; step_params(s, gi, ls);
    const int sh = 2 * gi, Lg = SEQL >> sh, rho = r & ((1 << sh) - 1);
    int uA = ((256 * blk) >> sh) - 64 + 32 * ls, uB = uA + 16;
    if (uA < 0 || uA >= Lg) uA = 0; if (uB < 0 || uB >= Lg) uB = 0;
    const int kl = lane & 15, quad = lane >> 4;
    const bf16_t* kh = Kp + (size_t)(sq * 24 + gi * 8 + h) * SEQL * 64 + quad * 128 + kl * 8;
    const bf16_t* ka = kh + (size_t)((rho * Lg + uA) >> 4) * 1024; const bf16_t* kb = kh + (size_t)((rho * Lg + uB) >> 4) * 1024;
    b.kA0 = *(const bf16x8*)ka; b.kA1 = *(const bf16x8*)(ka + 512); b.kB0 = *(const bf16x8*)kb; b.kB1 = *(const bf16x8*)(kb + 512);
    const bf16_t* vbase = Vt + (size_t)(((sq * 3 + gi) * 8 + h) * 512) * 1024 + quad * 64 + kl * 4;
    const bf16_t* va = vbase + (size_t)((rho * Lg + uA) >> 4) * 1024; const bf16_t* vb = vbase + (size_t)((rho * Lg + uB) >> 4) * 1024;
#pragma unroll
    for (int dt = 0; dt < 4; ++dt) { b.vA[dt] = *(const bf16x4*)(va + dt * 256); b.vB[dt] = *(const bf16x4*)(vb + dt * 256); }
}
struct QF { bf16x8 a0, a1, b0, b1, c0, c1; };
template <int gi>
__device__ __forceinline__ void attn_compute(const KVBuf& b, const bf16x8 q0, const bf16x8 q1, f32x4 (&o)[4], float& mrun, float& lrun, int s, int blk, int r, int lane) {
    const int ls = gi == 0 ? s : (gi == 1 ? s - 12 : s - 18);
    const int sh = 2 * gi, Lg = SEQL >> sh;
    const int uA = ((256 * blk) >> sh) - 64 + 32 * ls;
    const int qi = lane & 15, quad = lane >> 4;
    const int uq = (256 * blk + r + 16 * qi) >> sh;
    const int lo = max(0, uq - 64), hi = min(Lg - 1, uq + 64);
    f32x4 sA = (f32x4){0.f, 0.f, 0.f, 0.f}, sB = sA;
    sA = __builtin_amdgcn_mfma_f32_16x16x32_bf16(b.kA0, q0, sA, 0, 0, 0); sA = __builtin_amdgcn_mfma_f32_16x16x32_bf16(b.kA1, q1, sA, 0, 0, 0);
    sB = __builtin_amdgcn_mfma_f32_16x16x32_bf16(b.kB0, q0, sB, 0, 0, 0); sB = __builtin_amdgcn_mfma_f32_16x16x32_bf16(b.kB1, q1, sB, 0, 0, 0);
    const float NEGINF = -__builtin_inff();
    const unsigned span = (unsigned)(hi - lo);
    float mx = NEGINF;
#pragma unroll
    for (int j = 0; j < 4; ++j) {
        const int ua = uA + quad * 4 + j, ub = ua + 16;
        sA[j] = ((unsigned)(ua - lo) <= span) ? sA[j] : NEGINF; sB[j] = ((unsigned)(ub - lo) <= span) ? sB[j] : NEGINF;
        mx = fmaxf(mx, fmaxf(sA[j], sB[j]));
    }
    mx = fmaxf(mx, __shfl_xor(mx, 16)); mx = fmaxf(mx, __shfl_xor(mx, 32));
    const float mnew = fmaxf(mrun, mx), alpha = __builtin_amdgcn_exp2f(mrun - mnew);
    mrun = mnew;
    float ps = 0.f;
#pragma unroll
    for (int j = 0; j < 4; ++j) { sA[j] = __builtin_amdgcn_exp2f(sA[j] - mnew); sB[j] = __builtin_amdgcn_exp2f(sB[j] - mnew); ps += sA[j] + sB[j]; }
    lrun = lrun * alpha + ps;
    u32x4 pw; pw.x = cvt_pk_bf16(sA[0], sA[1]); pw.y = cvt_pk_bf16(sA[2], sA[3]); pw.z = cvt_pk_bf16(sB[0], sB[1]); pw.w = cvt_pk_bf16(sB[2], sB[3]);
    const bf16x8 pf = __builtin_bit_cast(bf16x8, pw);
#pragma unroll
    for (int dt = 0; dt < 4; ++dt) {
        o[dt] *= alpha;
        bf16x8 vf; vf[0] = b.vA[dt][0]; vf[1] = b.vA[dt][1]; vf[2] = b.vA[dt][2]; vf[3] = b.vA[dt][3]; vf[4] = b.vB[dt][0]; vf[5] = b.vB[dt][1]; vf[6] = b.vB[dt][2]; vf[7] = b.vB[dt][3];
#ifdef DBG_ATT2
        for (int e = 0; e < 8; ++e) o[dt][e & 3] += 1e-3f * __uint_as_float(((unsigned)(unsigned short)vf[e]) << 16);
#else
        o[dt] = __builtin_amdgcn_mfma_f32_16x16x32_bf16(vf, pf, o[dt], 0, 0, 0);
#endif
    }
}
__device__ __forceinline__ void step_attention(const Args& a, LAS unsigned char* lds, int pass, int tid, int bx) {
    unsigned char* ws = a.ws;
    const int lane = tid & 63;
    const bf16_t* Qp = (const bf16_t*)(ws + WS_Q); const bf16_t* Kp = (const bf16_t*)(ws + WS_K); const bf16_t* Vt = (const bf16_t*)(ws + WS_VT);
    const bf16_t* ZA = (const bf16_t*)(ws + WS_ZA); bf16_t* GAO = (bf16_t*)(ws + WS_GAO);
    const int xcd = bx & 7;
    unsigned* ctr = (unsigned*)(ws + WS_CTL) + 16 + pass * 8 + xcd;
    LAS unsigned* slot = (LAS unsigned*)lds;
    constexpr int NGRP = 3 * 32 * 2;
    for (;;) {
        __syncthreads();
        if (tid == 0) slot[0] = atomicAdd(ctr, 1u);
        __syncthreads();
        const unsigned grp = (unsigned)__builtin_amdgcn_readfirstlane((int)slot[0]);
        if (grp >= (unsigned)NGRP) break;
        const int r = (int)(grp & 1) * 8 + (tid >> 6), blk = (grp >> 1) & 31, pair = xcd * 3 + (int)(grp >> 6);
        const int h = pair & 7, sq = pair >> 3;
        const int qi = lane & 15, quad = lane >> 4;
        const int tq = sq * SEQL + 256 * blk + r + 16 * qi;
        QF qf;
        { const int pos = 256 * blk + r + 16 * qi;
          const bf16_t* qa = Qp + ((size_t)(sq * 24 + h) * SEQL + pos) * 64 + quad * 8;
          const bf16_t* qb = Qp + ((size_t)(sq * 24 + 8 + h) * SEQL + (pos & 3) * 2048 + (pos >> 2)) * 64 + quad * 8;
          const bf16_t* qc = Qp + ((size_t)(sq * 24 + 16 + h) * SEQL + (pos & 15) * 512 + (pos >> 4)) * 64 + quad * 8;
          qf.a0 = *(const bf16x8*)qa; qf.a1 = *(const bf16x8*)(qa + 32); qf.b0 = *(const bf16x8*)qb; qf.b1 = *(const bf16x8*)(qb + 32); qf.c0 = *(const bf16x8*)qc; qf.c1 = *(const bf16x8*)(qc + 32); }
        f32x4 o[4];
#pragma unroll
        for (int dt = 0; dt < 4; ++dt) o[dt] = (f32x4){0.f, 0.f, 0.f, 0.f};
        float mrun = -1e30f, lrun = 0.f;
        KVBuf b0, b1;
        attn_load(b0, Kp, Vt, 0, sq, h, blk, r, lane);
#define ATT_SB __builtin_amdgcn_sched_barrier(0);
#define ATT_LOOP(GI, S0, S1, QA, QB) _Pragma("unroll 1") for (int s = S0; s < S1; s += 2) { \
            ATT_SB attn_load(b1, Kp, Vt, s + 1, sq, h, blk, r, lane); ATT_SB attn_compute<GI>(b0, QA, QB, o, mrun, lrun, s, blk, r, lane); \
            ATT_SB attn_load(b0, Kp, Vt, s + 2, sq, h, blk, r, lane); ATT_SB attn_compute<GI>(b1, QA, QB, o, mrun, lrun, s + 1, blk, r, lane); ATT_SB }
        ATT_LOOP(0, 0, 12, qf.a0, qf.a1)
        ATT_LOOP(1, 12, 18, qf.b0, qf.b1)
        ATT_LOOP(2, 18, 22, qf.c0, qf.c1)
#undef ATT_LOOP
        attn_compute<2>(b0, qf.c0, qf.c1, o, mrun, lrun, 22, blk, r, lane);
        float l = lrun; l += __shfl_xor(l, 16); l += __shfl_xor(l, 32);
        float inv = 1.0f / l;
#ifdef DBG_ATT1
        for (int dt = 0; dt < 4; ++dt) o[dt] = (f32x4){1.f, 1.f, 1.f, 1.f};
#endif
#pragma unroll
        for (int dt = 0; dt < 4; ++dt) {
            const size_t off = (size_t)tq * 512 + h * 64 + 16 * dt + 4 * quad;
            const u32x2 z = *(const u32x2*)(ZA + off);
            u32x2 w; w.x = cvt_pk_bf16(o[dt][0] * inv * bf_lo(z.x), o[dt][1] * inv * bf_hi(z.x)); w.y = cvt_pk_bf16(o[dt][2] * inv * bf_lo(z.y), o[dt][3] * inv * bf_hi(z.y));
            *(u32x2*)(GAO + off) = w;
        }
    }
}

__device__ __forceinline__ f32x2 cmul(f32x2 a, f32x2 b) { return (f32x2){a.x * b.x - a.y * b.y, a.x * b.y + a.y * b.x}; }
__device__ __forceinline__ void step_scan(const Args& a, LAS unsigned char* lds, int pass, int tid, int bx) {
    unsigned char* ws = a.ws; const int G = gridDim.x;
    const float* PW = (const float*)(ws + WS_PW); const float* S = (const float*)(ws + WS_S); bf16_t* UH = (bf16_t*)(ws + WS_UH);
    LAS f32x2* carry = (LAS f32x2*)lds;
    for (int it = bx; it < SEQP * 32 * 2; it += G) {
        const int dir = it & 1, g = (it >> 1) & 31, sq = it >> 6; const int seg = tid >> 6, n = tid & 63;
        const f32x2 P = (f32x2){PW[((dir * 32 + g) * 64 + n) * 2], PW[((dir * 32 + g) * 64 + n) * 2 + 1]};
        f32x2 z[32];
        { const int c0 = dir ? (NCH - 1 - seg * 32) : seg * 32; const long stp = dir ? -256 : 256;
          const float* sp = S + ((size_t)g * CHP + sq * NCH + c0) * 256 + dir * 128 + n;
#pragma unroll
          for (int i = 0; i < 32; ++i) { z[i] = (f32x2){sp[0], sp[64]}; sp += stp; } }
        f32x2 zz = (f32x2){0.f, 0.f};
#pragma unroll
        for (int i = 0; i < 32; ++i) { const f32x2 t = z[i]; z[i] = zz; zz = cmul(P, zz) + t; }
        __syncthreads();
        carry[seg * 64 + n] = zz;
        __syncthreads();
        f32x2 P32 = P;
#pragma unroll
        for (int k = 0; k < 5; ++k) P32 = cmul(P32, P32);
        f32x2 x = (f32x2){0.f, 0.f};
        for (int sp = 0; sp < seg; ++sp) x = cmul(P32, x) + carry[sp * 64 + n];
        f32x2 pwr = (f32x2){1.f, 0.f};
        { const int c0 = dir ? (NCH - 1 - seg * 32) : seg * 32; const long stp = dir ? -(long)UHK : (long)UHK;
          bf16_t* up = UH + ((size_t)g * CHP + sq * NCH + c0) * UHK + 512 + dir * 128 + n;
#pragma unroll
          for (int i = 0; i < 32; ++i) {
              const f32x2 hin = z[i] + cmul(pwr, x);
              up[0] = (bf16_t)(cvt_pk_bf16(hin.x, 0.f) & 0xffffu); up[64] = (bf16_t)(cvt_pk_bf16(hin.y, 0.f) & 0xffffu);
              pwr = cmul(pwr, P); up += stp;
          } }
    }
}

__device__ __forceinline__ void step_final_norm(const Args& a, int pass, int tid, int bx) {
    const int lane = tid & 63, wave = tid >> 6, G = gridDim.x;
    const f32x4* gr = (const f32x4*)a.in[16] + lane;
    f32x4 gv[4];
#pragma unroll
    for (int j = 0; j < 4; ++j) gv[j] = gr[64 * j];
    int row = bx * 8 + wave;
    f32x4 nx[4];
    if (row < TP) { const f32x4* xr = (const f32x4*)(a.out + (size_t)(pass * TP + row) * DM) + lane;
#pragma unroll
        for (int j = 0; j < 4; ++j) nx[j] = xr[64 * j]; }
    for (; row < TP; row += G * 8) {
        f32x4 v[4];
#pragma unroll
        for (int j = 0; j < 4; ++j) v[j] = nx[j];
        const int nrow = row + G * 8;
        if (nrow < TP) { const f32x4* xn = (const f32x4*)(a.out + (size_t)(pass * TP + nrow) * DM) + lane;
#pragma unroll
            for (int j = 0; j < 4; ++j) nx[j] = xn[64 * j]; }
        float s = 0.f;
#pragma unroll
        for (int j = 0; j < 4; ++j) s += (v[j].x * v[j].x + v[j].y * v[j].y) + (v[j].z * v[j].z + v[j].w * v[j].w);
        const float rstd = 1.0f / sqrtf(wave_sum(s) * (1.f / DM) + EPSN);
        f32x4* xr = (f32x4*)(a.out + (size_t)(pass * TP + row) * DM) + lane;
#pragma unroll
        for (int j = 0; j < 4; ++j) xr[64 * j] = v[j] * rstd * gv[j];
    }
}


#define XB_TMO      128
#define XB_XCNT(j)  (256  + 64 * (j))
#define XB_XSUB(j)  (1280 + 64 * (j))
#define XB_XGEN(j)  (2304 + 64 * (j))
#define XB_TOP      3328
#define XB_TOPGEN   3392
#define XCD_BAR_WORDS 3456
#define XB_SLOT(b)  (4096 + 2 * (b))
#define XB_SPIN_CAP (1u << 18)
__device__ __forceinline__ unsigned xb_ld(unsigned* p)              { return __hip_atomic_load(p, __ATOMIC_RELAXED, __HIP_MEMORY_SCOPE_AGENT); }
__device__ __forceinline__ unsigned xb_add(unsigned* p, unsigned v) { return __hip_atomic_fetch_add(p, v, __ATOMIC_RELAXED, __HIP_MEMORY_SCOPE_AGENT); }
__device__ __forceinline__ unsigned xb_xcc_id() { return (unsigned)__builtin_amdgcn_s_getreg((3 << 11) | 20) & 0xFu; }
#define XB_SPIN(cond, bar) do { unsigned _sp = 0; while (cond) { __builtin_amdgcn_s_sleep(1); \
    if ((++_sp & 255u) == 0u) { if (xb_ld(&(bar)[XB_TMO])) break; if (_sp > XB_SPIN_CAP) { atomicAdd(&(bar)[XB_TMO], 1u); break; } } } } while (0)
__device__ __forceinline__ void xcd_barrier_complete(unsigned* bar, unsigned x, unsigned& nloc, unsigned& nx) {
    const unsigned G = gridDim.x;
    unsigned sum, cnt, mine, sp = 0u;
    for (;;) {
        sum = 0u; cnt = 0u; mine = 0u;
#pragma unroll
        for (unsigned j = 0; j < 16; ++j) { const unsigned c = xb_ld(&bar[XB_XCNT(j)]); sum += c; cnt += (c > 0u) ? 1u : 0u; mine = (j == x) ? c : mine; }
        if (sum == G) break;
        __builtin_amdgcn_s_sleep(1);
        if ((++sp & 255u) == 0u) { if (xb_ld(&bar[XB_TMO])) break; if (sp > XB_SPIN_CAP) { atomicAdd(&bar[XB_TMO], 1u); break; } }
    }
    nloc = mine > 0u ? mine : 1u; nx = cnt > 0u ? cnt : 1u;
}
__device__ __forceinline__ void xcd_barrier(unsigned* bar) {
    asm volatile("s_waitcnt vmcnt(0)" ::: "memory");
    __syncthreads();
    if (threadIdx.x == 0) {
        __builtin_amdgcn_s_waitcnt(0);
        const unsigned x = xb_xcc_id();
        unsigned* slot = bar + XB_SLOT(blockIdx.x);
        unsigned nloc = xb_ld(slot), nx = xb_ld(slot + 1);
        if (nloc == 0u) { xcd_barrier_complete(bar, x, nloc, nx); __hip_atomic_store(slot, nloc, __ATOMIC_RELAXED, __HIP_MEMORY_SCOPE_AGENT); __hip_atomic_store(slot + 1, nx, __ATOMIC_RELAXED, __HIP_MEMORY_SCOPE_AGENT); }
        const unsigned old = xb_add(&bar[XB_XSUB(x)], 1u);
        const unsigned gen = old / nloc;
        if (old + 1u == (gen + 1u) * nloc) {
            __builtin_amdgcn_fence(__ATOMIC_RELEASE, "agent");
            asm volatile("s_waitcnt vmcnt(0)" ::: "memory");
            const unsigned og = xb_add(&bar[XB_TOP], 1u);
            const unsigned tg = og / nx;
            if (og + 1u == (tg + 1u) * nx) xb_add(&bar[XB_TOPGEN], 1u);
            else XB_SPIN(xb_ld(&bar[XB_TOPGEN]) == tg, bar);
            __builtin_amdgcn_fence(__ATOMIC_ACQUIRE, "agent");
            xb_add(&bar[XB_XGEN(x)], 1u);
            asm volatile("s_waitcnt vmcnt(0)" ::: "memory");
        } else {
            XB_SPIN(xb_ld(&bar[XB_XGEN(x)]) == gen, bar);
            __builtin_amdgcn_fence(__ATOMIC_ACQUIRE, "agent");
            asm volatile("s_waitcnt vmcnt(0)" ::: "memory");
        }
    }
    __syncthreads();
}

constexpr int NSTEPS = 1 + 10 * NPASS;
__host__ __device__ __forceinline__ bool sync_after(int st) { if (st == 0) return true; const int k = (st - 1) % 10; return !(k == 1 || k == 6 || k == 9); }

__global__ void __launch_bounds__(512, 2) fwd_kernel(Args a) {
    extern __shared__ __attribute__((aligned(16))) unsigned char lds_raw[];
    LAS unsigned char* lds = (LAS unsigned char*)lds_raw;
    cg::grid_group grid = cg::this_grid();
    const int G = gridDim.x;
    unsigned char* ws = a.ws;
    unsigned* bar = (unsigned*)(ws + WS_BAR);
    if (a.do_sync && threadIdx.x == 0) (void)xb_add(&bar[XB_XCNT(xb_xcc_id())], 1u);
    for (int st = a.st_lo; st < a.st_hi; ++st) {
        int tid = threadIdx.x, bx = blockIdx.x;
        asm volatile("" : "+v"(tid), "+s"(bx));
#ifndef NO_SETUP
        if (st == 0) { step_setup(a, lds, tid, bx); }
#else
        if (st == 0) {}
#endif
        else {
            const int pass = (st - 1) / 10, k = (st - 1) % 10;
            GemmD g; g.ws = ws; g.out = a.out; g.xp = a.in[0]; g.xs = a.in[1]; g.pass = pass; g.nb = 1; g.sA = 0; g.sB = 0;
            bool has_gemm = true;
            switch (k) {
            case 0: g.A = (const bf16_t*)((unsigned char*)a.out + OUT_HN_OFF) + (size_t)pass * TP * DM; g.lda = DM; g.Bt = (const bf16_t*)(ws + WS_WIN); g.ldb = DM; g.K = DM; g.nM = TP / BM; g.nN = INC / BM; g.mode = MODE_PROJ; break;
            case 1: g.A = (const bf16_t*)(ws + WS_UH); g.lda = UHK; g.sA = (size_t)CHP * UHK * 2; g.Bt = (const bf16_t*)(ws + WS_BST); g.ldb = 512; g.sB = (size_t)256 * 512 * 2; g.K = 512; g.nM = CHP / BM; g.nN = 1; g.nb = 32; g.mode = MODE_S; break;
            case 4: g.A = (const bf16_t*)(ws + WS_UH); g.lda = UHK; g.sA = (size_t)CHP * UHK * 2; g.Bt = (const bf16_t*)(ws + WS_MTC); g.ldb = UHK; g.sB = (size_t)512 * UHK * 2; g.K = UHK; g.nM = CHP / BM; g.nN = 2; g.nb = 32; g.mode = MODE_Y; break;
            case 5: g.A = (const bf16_t*)(ws + WS_SG); g.lda = 512; g.Bt = (const bf16_t*)(ws + WS_WGLU); g.ldb = 512; g.K = 512; g.nM = TP / BM; g.nN = 2; g.mode = MODE_GLU; break;
            case 6: g.A = (const bf16_t*)(ws + WS_GAO); g.lda = 512; g.Bt = (const bf16_t*)(ws + WS_WA); g.ldb = 512; g.K = 512; g.nM = TP / BM; g.nN = 4; g.mode = MODE_A; break;
            case 7: g.A = (const bf16_t*)(ws + WS_SB); g.lda = 512; g.Bt = (const bf16_t*)(ws + WS_WB); g.ldb = 512; g.K = 512; g.nM = TP / BM; g.nN = 4; g.mode = MODE_B; break;
            case 8: g.A = (const bf16_t*)(ws + WS_M1); g.lda = 1024; g.Bt = (const bf16_t*)(ws + WS_WOUT); g.ldb = 1024; g.K = 1024; g.nM = TP / BM; g.nN = 4; g.mode = MODE_OUT; break;
            default: has_gemm = false; g.A = nullptr; g.Bt = nullptr; g.lda = g.ldb = g.K = 0; g.nM = g.nN = 0; g.mode = 0; break;
            }
            if (has_gemm) {
#ifndef NO_GEMM
                gemm_phase(lds, g, G, bx, tid);
#endif
            }
#ifndef NO_ATTN
            else if (k == 2) step_attention(a, lds, pass, tid, bx);
#endif
#ifndef NO_SCAN
            else if (k == 3) step_scan(a, lds, pass, tid, bx);
#endif
            else if (k == 9) step_final_norm(a, pass, tid, bx);
        }
        if (a.do_sync && st + 1 < a.st_hi && sync_after(st)) { if (a.do_sync == 2) grid.sync(); else xcd_barrier(bar); }
    }
}

extern "C" void kernel_launch(void* const* d_in, const int* in_sizes, int n_in, void* d_out, int out_size, void* d_ws, size_t ws_size, hipStream_t stream) {
    constexpr int LDS_BYTES = STAGE_BYTES + 32768;
    static int grid = 0;
    if (grid == 0) {
        if (n_in != 17 || out_size != TTOK * DM || ws_size < WS_END) { fprintf(stderr, "kernel_launch: unexpected shapes (n_in %d out %d ws %zu need %zu)\n", n_in, out_size, ws_size, (size_t)WS_END); grid = -1; return; }
        int dev = 0, cus = 0, per_cu = 0;
        hipGetDevice(&dev); hipDeviceGetAttribute(&cus, hipDeviceAttributeMultiprocessorCount, dev);
        hipFuncSetAttribute((const void*)fwd_kernel, hipFuncAttributeMaxDynamicSharedMemorySize, LDS_BYTES);
        hipOccupancyMaxActiveBlocksPerMultiprocessor(&per_cu, (const void*)fwd_kernel, 512, LDS_BYTES);
        if (per_cu < 1) per_cu = 1;
        grid = cus * 1;
        (void)hipGetLastError();
    }
    if (grid < 0) return;
    (void)hipMemsetAsync((unsigned char*)d_ws + WS_CTL, 0, 4096, stream);
    (void)hipMemsetAsync((unsigned char*)d_ws + WS_BAR, 0, WS_BAR_BYTES, stream);
    Args a{};
    for (int i = 0; i < 17; ++i) a.in[i] = (const float*)d_in[i];
    a.out = (float*)d_out; a.ws = (unsigned char*)d_ws; a.pad = 0;
#ifndef MULTI_LAUNCH
#define MULTI_LAUNCH 0
#endif
#if MULTI_LAUNCH
    a.do_sync = 0;
    for (int st = 0; st < NSTEPS; ++st) {
        a.st_lo = st; a.st_hi = st + 1;
        hipLaunchKernelGGL(fwd_kernel, dim3(grid), dim3(512), LDS_BYTES, stream, a);
    }
#else
    a.do_sync = 1; a.st_lo = 0; a.st_hi = NSTEPS;
    void* args[] = {&a};
    hipError_t e = hipLaunchCooperativeKernel((const void*)fwd_kernel, dim3(grid), dim3(512), args, LDS_BYTES, stream);
    if (e != hipSuccess) fprintf(stderr, "cooperative launch failed: %s (grid %d)\n", hipGetErrorString(e), grid);
#endif
}
```

```cpp
#include <hip/hip_runtime.h>
#include <hip/hip_cooperative_groups.h>
#include <cstdio>

namespace cg = cooperative_groups;

#define LAS __attribute__((address_space(3)))
typedef unsigned short bf16_t;
typedef short bf16x8 __attribute__((ext_vector_type(8)));
typedef short bf16x4 __attribute__((ext_vector_type(4)));
typedef float f32x4 __attribute__((ext_vector_type(4)));
typedef float f32x2 __attribute__((ext_vector_type(2)));
typedef unsigned u32x4 __attribute__((ext_vector_type(4)));
typedef unsigned u32x2 __attribute__((ext_vector_type(2)));

constexpr int DM = 1024, SEQL = 8192, NSEQ = 6, TTOK = NSEQ * SEQL;
constexpr int NPASS = 2, SEQP = 3, TP = SEQP * SEQL;
constexpr int INC = 8192, QKVW = 1536;
constexpr int LC = 32, NCH = SEQL / LC  , CHP = SEQP * NCH  ;
constexpr int UHK = LC * 16 + 256;
constexpr float EPSN = 1e-6f;
constexpr float QSCALE = 0.18033688011112042f;

constexpr size_t AL(size_t x) { return (x + 255) & ~(size_t)255; }
constexpr size_t WS_CTL = 0;
constexpr size_t WS_WIN = 4096;
constexpr size_t WS_WGLU = WS_WIN + (size_t)INC * DM * 2;
constexpr size_t WS_WA = WS_WGLU + (size_t)512 * 512 * 2;
constexpr size_t WS_WB = WS_WA + (size_t)1024 * 512 * 2;
constexpr size_t WS_WOUT = WS_WB + (size_t)1024 * 512 * 2;
constexpr size_t WS_MTC = WS_WOUT + (size_t)1024 * 1024 * 2;
constexpr size_t WS_BST = WS_MTC + (size_t)32 * 512 * UHK * 2;
constexpr size_t WS_ROPE = WS_BST + (size_t)32 * 256 * 512 * 2;
constexpr size_t WS_PW = WS_ROPE + (size_t)2 * SEQL * 32 * 4;
constexpr size_t WS_KT = WS_PW + (size_t)2 * 32 * 64 * 8;
constexpr size_t WS_Q = WS_KT + (size_t)32 * 2 * 32 * 256 * 4;
constexpr size_t WS_K = WS_Q + (size_t)TP * QKVW * 2;
constexpr size_t WS_VT = WS_K + (size_t)TP * QKVW * 2;
constexpr size_t WS_ZA = WS_VT + (size_t)TP * QKVW * 2;
constexpr size_t WS_ZB = WS_ZA + (size_t)TP * 512 * 2;
constexpr size_t WS_GA = WS_ZB + (size_t)TP * 512 * 2;
constexpr size_t WS_GB = WS_GA + (size_t)TP * 1024 * 2;
constexpr size_t WS_UH = WS_GB + (size_t)TP * 1024 * 2;
constexpr size_t WS_S = WS_UH + (size_t)32 * CHP * UHK * 2;
constexpr size_t WS_GAO = WS_S + (size_t)32 * CHP * 256 * 4;
constexpr size_t WS_BAR = WS_GAO + (size_t)TP * 512 * 2;
constexpr size_t WS_BAR_BYTES = 32768;
constexpr size_t WS_END = WS_BAR + WS_BAR_BYTES;
constexpr size_t WS_SG = WS_Q;
constexpr size_t WS_SB = WS_Q + (size_t)TP * 512 * 2;
constexpr size_t WS_M1 = WS_K;
constexpr size_t OUT_HN_OFF = (size_t)SEQP * SEQL * DM * 4;

struct Args {
    const float* in[17];
    float* out;
    unsigned char* ws;
    int st_lo, st_hi;
    int do_sync, pad;
};

typedef __bf16 bf16v2 __attribute__((ext_vector_type(2)));
__device__ __forceinline__ unsigned cvt_pk_bf16(float lo, float hi) { const f32x2 v = (f32x2){lo, hi}; const bf16v2 r = __builtin_convertvector(v, bf16v2); return __builtin_bit_cast(unsigned, r); }
__device__ __forceinline__ float bf_lo(unsigned w) { return __uint_as_float(w << 16); }
__device__ __forceinline__ float bf_hi(unsigned w) { return __uint_as_float(w & 0xffff0000u); }
__device__ __forceinline__ float fast_rcp(float x) { return __builtin_amdgcn_rcpf(x); }
__device__ __forceinline__ float sigmoidf_(float x) { return fast_rcp(1.0f + __builtin_amdgcn_exp2f(-1.4426950408889634f * x)); }
__device__ __forceinline__ float siluf_(float x) { return x * sigmoidf_(x); }
__device__ __forceinline__ float gelu_tanh(float x) { const float u = x * (1.5957691216057308f + 0.07135481627260025f * x * x); return x * sigmoidf_(u); }
__device__ __forceinline__ float wave_sum(float v) {
#pragma unroll
    for (int o = 1; o < 64; o <<= 1) v += __shfl_xor(v, o);
    return v;
}
__device__ __forceinline__ const float* xrow_ptr(const float* xp, const float* xs, int tg) {
    return tg < 4 * SEQL ? xp + (size_t)tg * DM : xs + (size_t)(tg - 4 * SEQL) * DM;
}

constexpr int BM = 256, BK = 64, HALF = 128, HTB = HALF * BK * 2, STAGE_BYTES = 8 * HTB, NXCD = 8, WGM = 8;
__host__ __device__ __forceinline__ int lds_byte(int r, int c) { const int st = (r >> 4) * 2 + (c >> 5), rr = r & 15, cc = c & 31, ob = rr * 64 + cc * 2; return st * 1024 + (ob ^ (((ob >> 9) & 1) << 5)); }
__host__ __device__ __forceinline__ void stage_rc(int b, int& R, int& C) { const int st = b / 1024, sb = b % 1024, swz = sb ^ (((sb >> 9) & 1) << 5); R = (st >> 1) * 16 + swz / 64; C = (st & 1) * 32 + (swz % 64) / 2; }
__host__ __device__ __forceinline__ int perm32(int rho) { const int n = rho >> 4, i = rho & 15; return 8 * (i >> 2) + 4 * n + (i & 3); }

enum { MODE_PROJ = 0, MODE_S = 1, MODE_Y = 2, MODE_GLU = 3, MODE_A = 4, MODE_B = 5, MODE_OUT = 6 };
struct Unit { int pm, pn, bz; };
struct GemmD {
    const bf16_t* A; const bf16_t* Bt;
    int lda, ldb, K, nM, nN, nb;
    size_t sA, sB;
    int mode, pass;
    unsigned char* ws; float* out; const float* xp; const float* xs;
};
__device__ __forceinline__ bool unit_next(const GemmD& g, int i, int G, int c, int& pm, int& pn, int& bz) {
    const int nwg = g.nM * g.nN;
    const long L = (long)i * G + c; const bool ok = L < (long)nwg * g.nb;
    const int Li = ok ? (int)L : 0;
    int wgid = Li; { const int q = nwg / NXCD, r = nwg % NXCD, xcd = wgid % NXCD, off = wgid / NXCD; wgid = (xcd < r ? xcd * (q + 1) : r * (q + 1) + (xcd - r) * q) + off; }
    const int nig = WGM * g.nN, gid = wgid / nig, fm = gid * WGM, gsz = (g.nM - fm) < WGM ? (g.nM - fm) : WGM;
    const int pm1 = fm + ((wgid % nig) % gsz), pn1 = (wgid % nig) / gsz;
    const int w = Li % nwg, bz2 = Li / nwg, pm2 = w % g.nM, pn2 = w / g.nM;
    const bool single = g.nb == 1;
    pm = single ? pm1 : pm2; pn = single ? pn1 : pn2; bz = single ? 0 : bz2;
    return ok;
}

__device__ __forceinline__ void epilogue(LAS unsigned char* lds, const GemmD& g, const f32x4 (&acc)[2][2][4][2], const Unit& u, int wr, int wc, int fr, int fq) {
    asm volatile("" : "+v"(fr), "+v"(fq));
    unsigned char* ws = g.ws;
    const int rbase = u.pm * BM + wr * 64 + fr;
    const int cl = wc * 32 + fq * 8;
    if (g.mode == MODE_PROJ) {
        const int pn = u.pn;
        if (pn < 12) {
            const bool isq = pn < 6;
            bf16_t* dst = (bf16_t*)(ws + (isq ? WS_Q : WS_K));
            const float* rc = (const float*)(ws + WS_ROPE); const float* rs = rc + SEQL * 32;
            const int a4 = 4 * (4 * (wc & 1) + fq);
            const int pq = isq ? pn : pn - 6, gi = pq >> 1, sh = 2 * gi, dmask = (1 << sh) - 1, Lg = SEQL >> sh;
            const float sc = isq ? QSCALE : 1.0f;
#pragma unroll
            for (int ai = 0; ai < 2; ++ai) {
                asm volatile("" ::: "memory");
                f32x4 cvv[4], svv[4];
#pragma unroll
                for (int m = 0; m < 4; ++m) { const int pos = (rbase + ai * HALF + m * 16) & (SEQL - 1); cvv[m] = *(const f32x4*)(rc + pos * 32 + a4); svv[m] = *(const f32x4*)(rs + pos * 32 + a4); }
#pragma unroll
                for (int m = 0; m < 4; ++m) {
                    const int tl = rbase + ai * HALF + m * 16; const int pos = tl & (SEQL - 1), sq = tl >> 13;
                    const int kidx = (pos & dmask) * Lg + (pos >> sh);
                    const f32x4 cv = cvv[m] * sc, sv = svv[m] * sc;
#pragma unroll
                    for (int bj = 0; bj < 2; ++bj) {
                        const f32x4 x1 = acc[ai][bj][m][0], x2 = acc[ai][bj][m][1];
                        const f32x4 o1 = x1 * cv - x2 * sv, o2 = x2 * cv + x1 * sv;
                        const int head = pq * 4 + 2 * bj + (wc >> 1);
                        const int ch = 4 * (wc & 1) + fq;
                        bf16_t* p = dst + (size_t)(sq * 24 + head) * SEQL * 64 + (isq ? (size_t)kidx * 64 + ch * 8 : (size_t)(kidx >> 4) * 1024 + ch * 128 + (kidx & 15) * 8);
                        u32x4 w; w.x = cvt_pk_bf16(o1[0], o1[1]); w.y = cvt_pk_bf16(o1[2], o1[3]); w.z = cvt_pk_bf16(o2[0], o2[1]); w.w = cvt_pk_bf16(o2[2], o2[3]);
                        *(u32x4*)p = w;
                    }
                }
            }
        } else if (pn < 18) {
            bf16_t* dst = (bf16_t*)(ws + WS_VT);
            const int gi = (pn - 12) >> 1, sh = 2 * gi;
            const int wid = wr * 4 + wc, lane = fq * 16 + fr;
            LAS bf16_t* tile = (LAS bf16_t*)(lds + STAGE_BYTES + wid * 4096);
#pragma unroll
            for (int ai = 0; ai < 2; ++ai) {
                const int tl0 = u.pm * BM + wr * 64 + ai * HALF;
                const int pos0 = tl0 & (SEQL - 1), sq = tl0 >> 13;
#pragma unroll
                for (int bj = 0; bj < 2; ++bj) {
                    asm volatile("" ::: "memory");
                    const int h = (4 * (pn - 12) + 2 * bj + (wc >> 1)) & 7;
#pragma unroll
                    for (int m = 0; m < 4; ++m) {
                        const int t = 16 * m + fr;
                        const int slot = gi == 0 ? t : (gi == 1 ? ((t & 3) * 16 + (t >> 2)) : ((t & 15) * 4 + (t >> 4)));
#pragma unroll
                        for (int n = 0; n < 2; ++n)
#pragma unroll
                            for (int j = 0; j < 4; ++j) { const unsigned w = cvt_pk_bf16(acc[ai][bj][m][n][j], 0.f); tile[(8 * fq + 4 * n + j) * 64 + slot] = (bf16_t)(w & 0xffffu); }
                    }
                    bf16_t* hb0 = dst + (size_t)(((sq * 3 + gi) * 8 + h) * 512) * 1024;
#pragma unroll
                    for (int i = 0; i < 4; ++i) {
                        const int c = lane + 64 * i, d = c >> 3, s8 = (c & 7) * 8;
                        const u32x4 v = *(const LAS u32x4*)(tile + d * 64 + s8);
                        const int dg = 32 * (wc & 1) + d; const int doff = (dg >> 4) * 256 + (dg & 15) * 4;
                        if (gi == 0) { const int kidx = pos0 + s8; bf16_t* q = hb0 + (size_t)(kidx >> 4) * 1024 + doff + ((kidx & 15) >> 2) * 64; *(u32x2*)q = (u32x2){v.x, v.y}; *(u32x2*)(q + 64) = (u32x2){v.z, v.w}; }
                        else if (gi == 1) { const int kidx = (s8 >> 4) * 2048 + (pos0 >> 2) + (s8 & 15); bf16_t* q = hb0 + (size_t)(kidx >> 4) * 1024 + doff + ((kidx & 15) >> 2) * 64; *(u32x2*)q = (u32x2){v.x, v.y}; *(u32x2*)(q + 64) = (u32x2){v.z, v.w}; }
                        else { const int ka = (s8 >> 2) * 512 + (pos0 >> 4), kb = ka + 512;
                            *(u32x2*)(hb0 + (size_t)(ka >> 4) * 1024 + doff + ((ka & 15) >> 2) * 64) = (u32x2){v.x, v.y}; *(u32x2*)(hb0 + (size_t)(kb >> 4) * 1024 + doff + ((kb & 15) >> 2) * 64) = (u32x2){v.z, v.w}; }
                    }
                }
            }
        } else if (pn == 20 || pn == 21) {
            bf16_t* dst = (bf16_t*)(ws + WS_UH);
#pragma unroll
            for (int ai = 0; ai < 2; ++ai)
#pragma unroll
                for (int m = 0; m < 4; ++m) { asm volatile("" ::: "memory");
                    const int tl = rbase + ai * HALF + m * 16;
#pragma unroll
                    for (int bj = 0; bj < 2; ++bj) {
                        const int gg = 16 * (pn - 20) + 8 * bj + 2 * wc + (fq >> 1);
                        bf16_t* p = dst + ((size_t)(gg * CHP + (tl >> 5)) * UHK) + (tl & 31) * 16 + 8 * (fq & 1);
                        const f32x4 v0 = acc[ai][bj][m][0], v1 = acc[ai][bj][m][1];
                        u32x4 w; w.x = cvt_pk_bf16(v0[0], v0[1]); w.y = cvt_pk_bf16(v0[2], v0[3]); w.z = cvt_pk_bf16(v1[0], v1[1]); w.w = cvt_pk_bf16(v1[2], v1[3]);
                        *(u32x4*)p = w;
                    }
                }
        } else {
            bf16_t* dst; int ld, c0; bool silu;
            if (pn < 20) { dst = (bf16_t*)(ws + WS_ZA); ld = 512; c0 = (pn - 18) * 256; silu = true; }
            else if (pn < 24) { dst = (bf16_t*)(ws + WS_ZB); ld = 512; c0 = (pn - 22) * 256; silu = true; }
            else if (pn < 28) { dst = (bf16_t*)(ws + WS_GA); ld = 1024; c0 = (pn - 24) * 256; silu = false; }
            else { dst = (bf16_t*)(ws + WS_GB); ld = 1024; c0 = (pn - 28) * 256; silu = false; }
#pragma unroll
            for (int ai = 0; ai < 2; ++ai)
#pragma unroll
                for (int m = 0; m < 4; ++m) { asm volatile("" ::: "memory");
                    const int tl = rbase + ai * HALF + m * 16;
#pragma unroll
                    for (int bj = 0; bj < 2; ++bj) {
                        f32x4 v0 = acc[ai][bj][m][0], v1 = acc[ai][bj][m][1];
#pragma unroll
                        for (int j = 0; j < 4; ++j) { const float s0 = sigmoidf_(v0[j]), s1 = sigmoidf_(v1[j]); v0[j] = silu ? v0[j] * s0 : s0; v1[j] = silu ? v1[j] * s1 : s1; }
                        u32x4 w; w.x = cvt_pk_bf16(v0[0], v0[1]); w.y = cvt_pk_bf16(v0[2], v0[3]); w.z = cvt_pk_bf16(v1[0], v1[1]); w.w = cvt_pk_bf16(v1[2], v1[3]);
                        *(u32x4*)(dst + (size_t)tl * ld + c0 + cl + bj * HALF) = w;
                    }
                }
        }
    } else if (g.mode == MODE_S) {
        float* dst = (float*)(ws + WS_S) + (size_t)u.bz * CHP * 256;
#pragma unroll
        for (int ai = 0; ai < 2; ++ai)
#pragma unroll
            for (int m = 0; m < 4; ++m) { asm volatile("" ::: "memory");
                const int r = rbase + ai * HALF + m * 16;
#pragma unroll
                for (int bj = 0; bj < 2; ++bj) { float* p = dst + (size_t)r * 256 + cl + bj * HALF; *(f32x4*)p = acc[ai][bj][m][0]; *(f32x4*)(p + 4) = acc[ai][bj][m][1]; }
            }
    } else if (g.mode == MODE_Y) {
        bf16_t* dst = (bf16_t*)(ws + WS_SG);
#pragma unroll
        for (int ai = 0; ai < 2; ++ai)
#pragma unroll
            for (int m = 0; m < 4; ++m) { asm volatile("" ::: "memory");
                const int r = rbase + ai * HALF + m * 16;
#pragma unroll
                for (int bj = 0; bj < 2; ++bj) {
                    const int t = 16 * u.pn + 8 * bj + 2 * wc + (fq >> 1);
                    f32x4 v0 = acc[ai][bj][m][0], v1 = acc[ai][bj][m][1];
#pragma unroll
                    for (int j = 0; j < 4; ++j) { v0[j] = gelu_tanh(v0[j]); v1[j] = gelu_tanh(v1[j]); }
                    u32x4 w; w.x = cvt_pk_bf16(v0[0], v0[1]); w.y = cvt_pk_bf16(v0[2], v0[3]); w.z = cvt_pk_bf16(v1[0], v1[1]); w.w = cvt_pk_bf16(v1[2], v1[3]);
                    *(u32x4*)(dst + (size_t)(r * LC + t) * 512 + u.bz * 16 + 8 * (fq & 1)) = w;
                }
            }
    } else if (g.mode == MODE_GLU) {
        const bf16_t* sg = (const bf16_t*)(ws + WS_SG); const bf16_t* zb = (const bf16_t*)(ws + WS_ZB); bf16_t* dst = (bf16_t*)(ws + WS_SB);
#pragma unroll
        for (int ai = 0; ai < 2; ++ai) {
            asm volatile("" ::: "memory");
            u32x4 sv4[4][2], zv4[4][2];
#pragma unroll
            for (int m = 0; m < 4; ++m)
#pragma unroll
                for (int bj = 0; bj < 2; ++bj) { const size_t off = (size_t)(rbase + ai * HALF + m * 16) * 512 + u.pn * BM + cl + bj * HALF; sv4[m][bj] = *(const u32x4*)(sg + off); zv4[m][bj] = *(const u32x4*)(zb + off); }
#pragma unroll
            for (int m = 0; m < 4; ++m)
#pragma unroll
                for (int bj = 0; bj < 2; ++bj) {
                    const size_t off = (size_t)(rbase + ai * HALF + m * 16) * 512 + u.pn * BM + cl + bj * HALF;
                    const u32x4 s4 = sv4[m][bj], z4 = zv4[m][bj];
                    const f32x4 v0 = acc[ai][bj][m][0], v1 = acc[ai][bj][m][1];
                    u32x4 w;
                    w.x = cvt_pk_bf16(bf_lo(s4.x) * sigmoidf_(v0[0]) * bf_lo(z4.x), bf_hi(s4.x) * sigmoidf_(v0[1]) * bf_hi(z4.x));
                    w.y = cvt_pk_bf16(bf_lo(s4.y) * sigmoidf_(v0[2]) * bf_lo(z4.y), bf_hi(s4.y) * sigmoidf_(v0[3]) * bf_hi(z4.y));
                    w.z = cvt_pk_bf16(bf_lo(s4.z) * sigmoidf_(v1[0]) * bf_lo(z4.z), bf_hi(s4.z) * sigmoidf_(v1[1]) * bf_hi(z4.z));
                    w.w = cvt_pk_bf16(bf_lo(s4.w) * sigmoidf_(v1[2]) * bf_lo(z4.w), bf_hi(s4.w) * sigmoidf_(v1[3]) * bf_hi(z4.w));
                    *(u32x4*)(dst + off) = w;
                }
        }
    } else if (g.mode == MODE_A || g.mode == MODE_B) {
        const bool isb = g.mode == MODE_B;
        const bf16_t* gt = (const bf16_t*)(ws + (isb ? WS_GB : WS_GA)); bf16_t* dst = (bf16_t*)(ws + WS_M1);
#pragma unroll
        for (int ai = 0; ai < 2; ++ai) {
            asm volatile("" ::: "memory");
            u32x4 gv4[4][2], pv4[4][2];
#pragma unroll
            for (int m = 0; m < 4; ++m)
#pragma unroll
                for (int bj = 0; bj < 2; ++bj) { const size_t off = (size_t)(rbase + ai * HALF + m * 16) * 1024 + u.pn * BM + cl + bj * HALF; gv4[m][bj] = *(const u32x4*)(gt + off); pv4[m][bj] = (u32x4){0u, 0u, 0u, 0u}; if (isb) pv4[m][bj] = *(const u32x4*)(dst + off); }
#pragma unroll
            for (int m = 0; m < 4; ++m)
#pragma unroll
                for (int bj = 0; bj < 2; ++bj) {
                    const size_t off = (size_t)(rbase + ai * HALF + m * 16) * 1024 + u.pn * BM + cl + bj * HALF;
                    const u32x4 g4 = gv4[m][bj], p4 = pv4[m][bj];
                    const f32x4 v0 = acc[ai][bj][m][0], v1 = acc[ai][bj][m][1];
                    u32x4 w;
                    w.x = cvt_pk_bf16(bf_lo(p4.x) + bf_lo(g4.x) * v0[0], bf_hi(p4.x) + bf_hi(g4.x) * v0[1]);
                    w.y = cvt_pk_bf16(bf_lo(p4.y) + bf_lo(g4.y) * v0[2], bf_hi(p4.y) + bf_hi(g4.y) * v0[3]);
                    w.z = cvt_pk_bf16(bf_lo(p4.z) + bf_lo(g4.z) * v1[0], bf_hi(p4.z) + bf_hi(g4.z) * v1[1]);
                    w.w = cvt_pk_bf16(bf_lo(p4.w) + bf_lo(g4.w) * v1[2], bf_hi(p4.w) + bf_hi(g4.w) * v1[3]);
                    *(u32x4*)(dst + off) = w;
                }
        }
    } else {
#pragma unroll
        for (int ai = 0; ai < 2; ++ai) {
            asm volatile("" ::: "memory");
            f32x4 xa[4][2][2];
#pragma unroll
            for (int m = 0; m < 4; ++m) {
                const float* xr = xrow_ptr(g.xp, g.xs, g.pass * TP + rbase + ai * HALF + m * 16);
#pragma unroll
                for (int bj = 0; bj < 2; ++bj) { const int c = u.pn * BM + cl + bj * HALF; xa[m][bj][0] = *(const f32x4*)(xr + c); xa[m][bj][1] = *(const f32x4*)(xr + c + 4); }
            }
#pragma unroll
            for (int m = 0; m < 4; ++m) {
                float* orow = g.out + (size_t)(g.pass * TP + rbase + ai * HALF + m * 16) * DM;
#pragma unroll
                for (int bj = 0; bj < 2; ++bj) {
                    const int c = u.pn * BM + cl + bj * HALF;
                    *(f32x4*)(orow + c) = xa[m][bj][0] + acc[ai][bj][m][0]; *(f32x4*)(orow + c + 4) = xa[m][bj][1] + acc[ai][bj][m][1];
                }
            }
        }
    }
}

__device__ __forceinline__ void gemm_phase(LAS unsigned char* lds, const GemmD& g, int G, int cidx, int tid) {
    const int wid = __builtin_amdgcn_readfirstlane(tid >> 6), lane = tid & 63, wr = wid >> 2, wc = wid & 3, fr = lane & 15, fq = lane >> 4;
    const int K = g.K, nt = K / BK;
    unsigned voffA[2], voffB[2];
#pragma unroll
    for (int i = 0; i < 2; ++i) { int R, C; stage_rc(tid * 16 + i * 8192, R, C); const int Rb = (R & ~31) + perm32(R & 31);
        voffA[i] = (unsigned)(R * g.lda + C) * 2u; voffB[i] = (unsigned)(Rb * g.ldb + C) * 2u; }
    const size_t kstep = (size_t)(BK * 2);
    const size_t hstepA = (size_t)HALF * g.lda * 2, hstepB = (size_t)HALF * g.ldb * 2;
    const size_t tstepA = 2 * hstepA, tstepB = 2 * hstepB;
    const unsigned ldsw = (unsigned)wid * 1024u;
    const int aoff = lds_byte(wr * 64 + fr, fq * 8), boff = lds_byte(wc * 32 + fr, fq * 8);
#define PG8_SA(b, h) (((b) * 2 + (h)) * HTB)
#define PG8_SB(b, h) ((4 + (b) * 2 + (h)) * HTB)
#define PG8_STAGE(bufoff, gbase, voff) do { _Pragma("unroll") for (int _i = 0; _i < 2; ++_i) \
        __builtin_amdgcn_global_load_lds((const unsigned*)((const char*)(gbase) + (voff)[_i]), (LAS unsigned*)(lds + (bufoff) + ldsw + _i * 8192), 16, 0, 0); } while (0)
#define PG8_LDA(dst, b, h) do { _Pragma("unroll") for (int m = 0; m < 4; ++m) _Pragma("unroll") for (int k = 0; k < 2; ++k) dst[m][k] = *(const LAS bf16x8*)(lds + PG8_SA(b, h) + aoff + m * 2048 + k * 1024); } while (0)
#define PG8_LDB(dst, b, h) do { _Pragma("unroll") for (int n = 0; n < 2; ++n) _Pragma("unroll") for (int k = 0; k < 2; ++k) dst[n][k] = *(const LAS bf16x8*)(lds + PG8_SB(b, h) + boff + n * 2048 + k * 1024); } while (0)
#define PG8_MMA(ai, bj, At, Bt) do { __builtin_amdgcn_s_setprio(1); _Pragma("unroll") for (int m = 0; m < 4; ++m) _Pragma("unroll") for (int n = 0; n < 2; ++n) _Pragma("unroll") for (int k = 0; k < 2; ++k) \
        acc[ai][bj][m][n] = __builtin_amdgcn_mfma_f32_16x16x32_bf16(Bt[n][k], At[m][k], acc[ai][bj][m][n], 0, 0, 0); __builtin_amdgcn_s_setprio(0); } while (0)
#define PG8_WAIT_V(n) asm volatile("s_waitcnt vmcnt(" #n ")" ::: "memory")
#define PG8_WAIT_L(n) asm volatile("s_waitcnt lgkmcnt(" #n ")" ::: "memory")
#define PG8_BAR __builtin_amdgcn_s_barrier()
#define PG8_SCHED __builtin_amdgcn_sched_barrier(0)
    Unit cur, nxt; int ui = 0;
    { int pm_, pn_, bz_; if (!unit_next(g, 0, G, cidx, pm_, pn_, bz_)) return; cur.pm = pm_; cur.pn = pn_; cur.bz = bz_; }
    f32x4 acc[2][2][4][2];
#pragma unroll
    for (int a = 0; a < 2; ++a)
#pragma unroll
        for (int b = 0; b < 2; ++b)
#pragma unroll
            for (int m = 0; m < 4; ++m)
#pragma unroll
                for (int n = 0; n < 2; ++n) acc[a][b][m][n] = (f32x4){0.f, 0.f, 0.f, 0.f};
    bf16x8 At[4][2], B0[2][2], B1[2][2];
    const char* cA = (const char*)g.A + (size_t)cur.bz * g.sA + (size_t)cur.pm * tstepA; const char* cB = (const char*)g.Bt + (size_t)cur.bz * g.sB + (size_t)cur.pn * tstepB;
    PG8_STAGE(PG8_SB(0, 0), cB, voffB); PG8_STAGE(PG8_SA(0, 0), cA, voffA); PG8_STAGE(PG8_SB(0, 1), cB + hstepB, voffB); PG8_STAGE(PG8_SA(0, 1), cA + hstepA, voffA);
    if (wr == 1) PG8_BAR;
    PG8_WAIT_V(4); PG8_BAR;
    PG8_STAGE(PG8_SB(1, 0), cB + kstep, voffB); PG8_STAGE(PG8_SA(1, 0), cA + kstep, voffA); PG8_STAGE(PG8_SB(1, 1), cB + hstepB + kstep, voffB);
    PG8_WAIT_V(6); PG8_BAR;
    for (;;) {
        int npm, npn, nbz; const bool has_next = unit_next(g, ui + 1, G, cidx, npm, npn, nbz); nxt.pm = npm; nxt.pn = npn; nxt.bz = nbz;
        const char* nA = has_next ? (const char*)g.A + (size_t)nxt.bz * g.sA + (size_t)nxt.pm * tstepA : cA; const char* nB = has_next ? (const char*)g.Bt + (size_t)nxt.bz * g.sB + (size_t)nxt.pn * tstepB : cB;
        for (int t = 0; t < nt; t += 2) {
            const bool last = (t == nt - 2);
            const char* a1 = cA + (size_t)(t + 1) * kstep;
            const char* a2 = last ? nA : cA + (size_t)(t + 2) * kstep; const char* b2 = last ? nB : cB + (size_t)(t + 2) * kstep;
            const char* a3 = a2 + kstep; const char* b3 = b2 + kstep;
            PG8_LDB(B0, 0, 0); PG8_SCHED; PG8_LDA(At, 0, 0); PG8_STAGE(PG8_SA(1, 1), a1 + hstepA, voffA);
            PG8_WAIT_L(8); PG8_BAR; PG8_WAIT_L(0); PG8_MMA(0, 0, At, B0); PG8_BAR; PG8_SCHED;
            PG8_LDB(B1, 0, 1); PG8_STAGE(PG8_SB(0, 0), b2, voffB);
            PG8_BAR; PG8_WAIT_L(0); PG8_MMA(0, 1, At, B1); PG8_BAR;
            PG8_LDA(At, 0, 1); PG8_STAGE(PG8_SA(0, 0), a2, voffA);
            PG8_BAR; PG8_WAIT_L(0); PG8_MMA(1, 0, At, B0); PG8_BAR; PG8_SCHED;
            PG8_STAGE(PG8_SB(0, 1), b2 + hstepB, voffB);
            PG8_WAIT_V(6); PG8_BAR; PG8_MMA(1, 1, At, B1); PG8_BAR;
            PG8_LDB(B0, 1, 0); PG8_SCHED; PG8_LDA(At, 1, 0); PG8_STAGE(PG8_SA(0, 1), a2 + hstepA, voffA);
            PG8_WAIT_L(8); PG8_BAR; PG8_WAIT_L(0); PG8_MMA(0, 0, At, B0); PG8_BAR; PG8_SCHED;
            PG8_LDB(B1, 1, 1); PG8_STAGE(PG8_SB(1, 0), b3, voffB);
            PG8_BAR; PG8_WAIT_L(0); PG8_MMA(0, 1, At, B1); PG8_BAR;
            PG8_LDA(At, 1, 1); PG8_STAGE(PG8_SA(1, 0), a3, voffA);
            PG8_BAR; PG8_WAIT_L(0); PG8_MMA(1, 0, At, B0); PG8_BAR; PG8_SCHED;
            PG8_STAGE(PG8_SB(1, 1), b3 + hstepB, voffB);
            PG8_WAIT_V(6); PG8_BAR; PG8_MMA(1, 1, At, B1); PG8_BAR;
        }
#ifndef NO_EPI
        epilogue(lds, g, acc, cur, wr, wc, fr, fq);
#else
        if (g.mode == 99) *(f32x4*)(g.out) = acc[0][0][0][0] + acc[1][1][3][1] + acc[0][1][2][0]+acc[1][0][1][1];
#endif
        if (!has_next) break;
#pragma unroll
        for (int a = 0; a < 2; ++a)
#pragma unroll
            for (int b = 0; b < 2; ++b)
#pragma unroll
                for (int m = 0; m < 4; ++m)
#pragma unroll
                    for (int n = 0; n < 2; ++n) acc[a][b][m][n] = (f32x4){0.f, 0.f, 0.f, 0.f};
        cur = nxt; cA = nA; cB = nB; ++ui;
    }
    PG8_WAIT_V(0);
    if (wr == 0) PG8_BAR;
    PG8_BAR;
#undef PG8_SA
#undef PG8_SB
#undef PG8_STAGE
#undef PG8_LDA
#undef PG8_LDB
#undef PG8_MMA
#undef PG8_WAIT_V
#undef PG8_WAIT_L
#undef PG8_BAR
#undef PG8_SCHED
}

__device__ __forceinline__ int qk_perm_row(int n) { const int i = n & 63; return (n & ~63) + 8 * ((i & 31) >> 2) + (i & 3) + 4 * (i >> 5); }
__device__ __forceinline__ void transpose_item(const float* W, int K, int N, bf16_t* WT, bool permqk, LAS float* scr, int item, int lane) {
    const int nblk = N / 32, kb = item / nblk, nb = item % nblk, k0 = 64 * kb, n0 = 32 * nb;
#pragma unroll 8
    for (int i = 0; i < 32; ++i) { const int kk = 2 * i + (lane >> 5); scr[kk * 33 + (lane & 31)] = W[(size_t)(k0 + kk) * N + n0 + (lane & 31)]; }
    asm volatile("s_waitcnt lgkmcnt(0)" ::: "memory");
    const int c = lane & 7;
#pragma unroll
    for (int j = 0; j < 4; ++j) { const int n = (lane >> 3) + 8 * j; const LAS float* s = scr + (8 * c) * 33 + n;
        u32x4 o; o.x = cvt_pk_bf16(s[0 * 33], s[1 * 33]); o.y = cvt_pk_bf16(s[2 * 33], s[3 * 33]); o.z = cvt_pk_bf16(s[4 * 33], s[5 * 33]); o.w = cvt_pk_bf16(s[6 * 33], s[7 * 33]);
        int row = n0 + n; if (permqk && row < 2 * QKVW) row = qk_perm_row(row);
        *(u32x4*)(WT + (size_t)row * K + k0 + 8 * c) = o; }
    asm volatile("s_waitcnt lgkmcnt(0)" ::: "memory");
}
__device__ __forceinline__ void reduce_angle(double a, float& c, float& s) {
    const double k = __builtin_rint(a * 0.6366197723675814); const float x = (float)(a - k * 1.5707963267948966), x2 = x * x;
    const float sn = x * (1.0f + x2 * (-1.6666666667e-1f + x2 * (8.3333333333e-3f + x2 * (-1.9841269841e-4f + x2 * 2.7557319224e-6f))));
    const float cs = 1.0f + x2 * (-0.5f + x2 * (4.1666666667e-2f + x2 * (-1.3888888889e-3f + x2 * (2.4801587302e-5f + x2 * -2.7557319224e-7f))));
    const int q = ((int)k) & 3;
    c = (q == 0) ? cs : (q == 1) ? -sn : (q == 2) ? -cs : sn;
    s = (q == 0) ? sn : (q == 1) ? cs : (q == 2) ? -sn : -cs;
}
__device__ __forceinline__ void rms_row_to_bf16(const float* xrow, const float* gw, bf16_t* orow, int lane) {
    const f32x4* xr = (const f32x4*)xrow + lane; const f32x4* gr = (const f32x4*)gw + lane;
    f32x4 v[4]; float s = 0.f;
#pragma unroll
    for (int j = 0; j < 4; ++j) { v[j] = xr[64 * j]; s += (v[j].x * v[j].x + v[j].y * v[j].y) + (v[j].z * v[j].z + v[j].w * v[j].w); }
    const float rstd = 1.0f / sqrtf(wave_sum(s) * (1.f / DM) + EPSN);
    u32x2* o8 = (u32x2*)orow + lane;
#pragma unroll
    for (int j = 0; j < 4; ++j) { const f32x4 gv = gr[64 * j]; u32x2 w; w.x = cvt_pk_bf16(v[j].x * rstd * gv.x, v[j].y * rstd * gv.y); w.y = cvt_pk_bf16(v[j].z * rstd * gv.z, v[j].w * rstd * gv.w); o8[64 * j] = w; }
}

__device__ __forceinline__ void ssm_load_bc(const Args& a, int g, int dir, LAS f32x2* Bb, LAS f32x2* Cc, int tid) {
    const float* lam_re = a.in[4]; const float* lam_im = a.in[5]; const float* log_step = a.in[6];
    const float* b_re = a.in[7]; const float* b_im = a.in[8]; const float* c_re = a.in[9]; const float* c_im = a.in[10];
    const float dt = expf(log_step[dir * 32 + g]);
    for (int idx = tid; idx < 1024; idx += 512) {
        { const int n = idx >> 4; const float lr = lam_re[(dir * 32 + g) * 64 + n], li = lam_im[(dir * 32 + g) * 64 + n];
          const float ar = lr * dt; float cb, sb, ch, sh; reduce_angle((double)li * (double)dt, cb, sb); reduce_angle(0.5 * (double)li * (double)dt, ch, sh);
          const float em1 = expm1f(ar), ea = em1 + 1.0f;
          const float nr = em1 * cb - 2.0f * sh * sh, ni = ea * sb;
          const float den = 1.0f / (lr * lr + li * li); const float cr = (nr * lr + ni * li) * den, ci = (ni * lr - nr * li) * den;
          const float br = b_re[(size_t)((dir * 32 + g) * 64) * 16 + idx], bi = b_im[(size_t)((dir * 32 + g) * 64) * 16 + idx];
          Bb[idx] = (f32x2){cr * br - ci * bi, cr * bi + ci * br}; }
        { Cc[idx] = (f32x2){c_re[(size_t)((dir * 32 + g) * 16) * 64 + idx], c_im[(size_t)((dir * 32 + g) * 16) * 64 + idx]}; }
    }
}
__device__ __forceinline__ void ssm_setup_item(const Args& a, LAS unsigned char* lds, int item, int tid) {
    const int g = item >> 1, dir = item & 1;
    LAS f32x2* pw = (LAS f32x2*)lds; LAS f32x2* Bb = pw + 33 * 64; LAS f32x2* Cc = Bb + 1024;
    LAS float* KT = (LAS float*)(Cc + 1024); LAS float* K0 = KT + 32 * 256; LAS f32x2* Bb0 = (LAS f32x2*)(K0 + 256); LAS f32x2* Cc0 = Bb0 + 1024;
    const float* lam_re = a.in[4]; const float* lam_im = a.in[5]; const float* log_step = a.in[6];
    unsigned char* ws = a.ws;
    const float dt = expf(log_step[dir * 32 + g]);
    __syncthreads();
    for (int idx = tid; idx < 33 * 64; idx += 512) {
        const int tau = idx >> 6, n = idx & 63; const float lr = lam_re[(dir * 32 + g) * 64 + n], li = lam_im[(dir * 32 + g) * 64 + n];
        const float mag = expf(lr * dt * (float)tau); float c, s; reduce_angle((double)li * (double)dt * (double)tau, c, s);
        pw[idx] = (f32x2){mag * c, mag * s};
    }
    ssm_load_bc(a, g, dir, Bb, Cc, tid);
    if (dir == 1) ssm_load_bc(a, g, 0, Bb0, Cc0, tid);
    __syncthreads();
    if (tid < 64) { float* PW = (float*)(ws + WS_PW); const f32x2 p = pw[32 * 64 + tid]; PW[((dir * 32 + g) * 64 + tid) * 2] = p.x; PW[((dir * 32 + g) * 64 + tid) * 2 + 1] = p.y; }
    for (int o = tid; o < 32 * 256; o += 512) {
        const int tau = o >> 8, co = (o >> 4) & 15, ci = o & 15; float acc = 0.f;
_Pragma("unroll 4")
        for (int n = 0; n < 64; ++n) { const f32x2 c = Cc[co * 64 + n], p = pw[tau * 64 + n], b = Bb[n * 16 + ci]; const float tr = c.x * p.x - c.y * p.y, ti = c.x * p.y + c.y * p.x; acc += tr * b.x - ti * b.y; }
        KT[o] = acc; }
    if (dir == 1 && tid < 256) { const int co = tid >> 4, ci = tid & 15; float acc = 0.f;
_Pragma("unroll 4")
        for (int n = 0; n < 64; ++n) { const f32x2 c = Cc0[co * 64 + n], b = Bb0[n * 16 + ci]; acc += c.x * b.x - c.y * b.y; }
        K0[tid] = acc; }
    { bf16_t* BsT = (bf16_t*)(ws + WS_BST) + (size_t)g * 256 * 512;
      for (int ch = tid; ch < 128 * 64; ch += 512) {
          const int row = ch >> 6, part = row >> 6, n = row & 63, kc = ch & 63, s = kc >> 1, ci0 = (kc & 1) * 8; const int e = dir ? s : 31 - s; const f32x2 p = pw[e * 64 + n];
          float v[8];
#pragma unroll
          for (int j = 0; j < 8; ++j) { const f32x2 b = Bb[n * 16 + ci0 + j]; v[j] = part ? (p.x * b.y + p.y * b.x) : (p.x * b.x - p.y * b.y); }
          u32x4 w; w.x = cvt_pk_bf16(v[0], v[1]); w.y = cvt_pk_bf16(v[2], v[3]); w.z = cvt_pk_bf16(v[4], v[5]); w.w = cvt_pk_bf16(v[6], v[7]);
          *(u32x4*)(BsT + (size_t)(dir * 128 + row) * 512 + s * 16 + ci0) = w; } }
    bf16_t* MtC = (bf16_t*)(ws + WS_MTC) + (size_t)g * 512 * UHK;
    { for (int ch = tid; ch < 512 * 16; ch += 512) {
          const int row = ch >> 4, t = row >> 4, co = row & 15, cc = ch & 15, part = cc >> 3, n0 = (cc & 7) * 8; const int e = dir ? 32 - t : t + 1;
          float v[8];
#pragma unroll
          for (int j = 0; j < 8; ++j) { const f32x2 c = Cc[co * 64 + n0 + j], p = pw[e * 64 + n0 + j]; v[j] = part ? -(c.x * p.y + c.y * p.x) : (c.x * p.x - c.y * p.y); }
          u32x4 w; w.x = cvt_pk_bf16(v[0], v[1]); w.y = cvt_pk_bf16(v[2], v[3]); w.z = cvt_pk_bf16(v[4], v[5]); w.w = cvt_pk_bf16(v[6], v[7]);
          *(u32x4*)(MtC + (size_t)row * UHK + 512 + dir * 128 + part * 64 + n0) = w; } }
    __syncthreads();
    { const float* dsk = a.in[11];
      for (int ch = tid; ch < 512 * 64; ch += 512) {
          const int kc = ch & 63, row = ch >> 6; const int s = kc >> 1, ci0 = (kc & 1) * 8, t = row >> 4, co = row & 15;
          if (dir == 0 ? (t > s) : (s >= t)) {
              const int tau = dir == 0 ? t - s : s - t;
              float v[8];
#pragma unroll
              for (int j = 0; j < 8; ++j) v[j] = KT[tau * 256 + co * 16 + ci0 + j];
              if (t == s) { const float dv = dsk[g * 16 + co];
#pragma unroll
                  for (int j = 0; j < 8; ++j) v[j] += K0[co * 16 + ci0 + j] + ((ci0 + j == co) ? dv : 0.f); }
              u32x4 w; w.x = cvt_pk_bf16(v[0], v[1]); w.y = cvt_pk_bf16(v[2], v[3]); w.z = cvt_pk_bf16(v[4], v[5]); w.w = cvt_pk_bf16(v[6], v[7]);
              *(u32x4*)(MtC + (size_t)row * UHK + s * 16 + ci0) = w;
          }
      } }
    __syncthreads();
}

__device__ __forceinline__ void step_setup(const Args& a, LAS unsigned char* lds, int tid, int bx) {
    const int lane = tid & 63, wave = tid >> 6, G = gridDim.x;
    unsigned char* ws = a.ws;
    for (int it = bx; it < 64; it += G) ssm_setup_item(a, lds, it, tid);
    { float* rc = (float*)(ws + WS_ROPE); float* rs = rc + SEQL * 32;
      for (int idx = bx * 512 + tid; idx < SEQL * 32; idx += G * 512) {
          const int pos = idx >> 5, i = idx & 31; double inv = 1.0; for (int k = 0; k < i; ++k) inv *= 0.7498942093324558;
          float c, s; reduce_angle((double)pos * inv, c, s); rc[idx] = c; rs[idx] = s; } }
    { LAS float* scr = (LAS float*)(lds) + wave * (64 * 33);
      const int gw = bx * 8 + wave, NGW = G * 8;
      constexpr int I_IN = (DM / 64) * (INC / 32), I_GLU = (512 / 64) * (512 / 32), I_AB = (512 / 64) * (1024 / 32), I_OUT = (1024 / 64) * (1024 / 32);
      constexpr int NIT = I_IN + I_GLU + 2 * I_AB + I_OUT;
      for (int it = gw; it < NIT; it += NGW) {
          int r = it;
          if (r < I_IN) { transpose_item(a.in[3], DM, INC, (bf16_t*)(ws + WS_WIN), true, scr, r, lane); continue; } r -= I_IN;
          if (r < I_GLU) { transpose_item(a.in[12], 512, 512, (bf16_t*)(ws + WS_WGLU), false, scr, r, lane); continue; } r -= I_GLU;
          if (r < I_AB) { transpose_item(a.in[13], 512, 1024, (bf16_t*)(ws + WS_WA), false, scr, r, lane); continue; } r -= I_AB;
          if (r < I_AB) { transpose_item(a.in[14], 512, 1024, (bf16_t*)(ws + WS_WB), false, scr, r, lane); continue; } r -= I_AB;
          transpose_item(a.in[15], 1024, 1024, (bf16_t*)(ws + WS_WOUT), false, scr, r, lane);
      } }
    { bf16_t* hn = (bf16_t*)((unsigned char*)a.out + OUT_HN_OFF);
      const f32x4* gr = (const f32x4*)a.in[2] + lane;
      f32x4 gv[4];
#pragma unroll
      for (int j = 0; j < 4; ++j) gv[j] = gr[64 * j];
      unsigned* rctr = (unsigned*)(ws + WS_CTL) + 4;
      constexpr int RCH = 16;
      for (;;) {
          unsigned cidx = 0; if (lane == 0) cidx = atomicAdd(rctr, 1u);
          cidx = (unsigned)__builtin_amdgcn_readfirstlane((int)cidx);
          if (cidx >= (unsigned)(TTOK / RCH)) break;
          int row = (int)cidx * RCH; const int rend = row + RCH;
          f32x4 nx[4];
          { const f32x4* xr = (const f32x4*)xrow_ptr(a.in[0], a.in[1], row) + lane;
#pragma unroll
            for (int j = 0; j < 4; ++j) nx[j] = xr[64 * j]; }
          for (; row < rend; ++row) {
              f32x4 v[4];
#pragma unroll
              for (int j = 0; j < 4; ++j) v[j] = nx[j];
              if (row + 1 < rend) { const f32x4* xn = (const f32x4*)xrow_ptr(a.in[0], a.in[1], row + 1) + lane;
#pragma unroll
                  for (int j = 0; j < 4; ++j) nx[j] = xn[64 * j]; }
              float s = 0.f;
#pragma unroll
              for (int j = 0; j < 4; ++j) s += (v[j].x * v[j].x + v[j].y * v[j].y) + (v[j].z * v[j].z + v[j].w * v[j].w);
              const float rstd = 1.0f / sqrtf(wave_sum(s) * (1.f / DM) + EPSN);
              u32x2* o8 = (u32x2*)(hn + (size_t)row * DM) + lane;
#pragma unroll
              for (int j = 0; j < 4; ++j) { u32x2 w; w.x = cvt_pk_bf16(v[j].x * rstd * gv[j].x, v[j].y * rstd * gv[j].y); w.y = cvt_pk_bf16(v[j].z * rstd * gv[j].z, v[j].w * rstd * gv[j].w); o8[64 * j] = w; }
          }
      } }
}

struct KVBuf { bf16x8 kA0, kA1, kB0, kB1; bf16x4 vA[4], vB[4]; };
__device__ __forceinline__ void step_params(int s, int& gi, int& ls) { gi = s < 12 ? 0 : (s < 18 ? 1 : 2); ls = s < 12 ? s : (s < 18 ? s - 12 : s - 18); }
__device__ __forceinline__ void attn_load(KVBuf& b, const bf16_t* Kp, const bf16_t* Vt, int s, int sq, int h, int blk, int r, int lane) {
    int gi, ls; step_params(s, gi, ls);
    const int sh = 2 * gi, Lg = SEQL >> sh, rho = r & ((1 << sh) - 1);
    int uA = ((256 * blk) >> sh) - 64 + 32 * ls, uB = uA + 16;
    if (uA < 0 || uA >= Lg) uA = 0; if (uB < 0 || uB >= Lg) uB = 0;
    const int kl = lane & 15, quad = lane >> 4;
    const bf16_t* kh = Kp + (size_t)(sq * 24 + gi * 8 + h) * SEQL * 64 + quad * 128 + kl * 8;
    const bf16_t* ka = kh + (size_t)((rho * Lg + uA) >> 4) * 1024; const bf16_t* kb = kh + (size_t)((rho * Lg + uB) >> 4) * 1024;
    b.kA0 = *(const bf16x8*)ka; b.kA1 = *(const bf16x8*)(ka + 512); b.kB0 = *(const bf16x8*)kb; b.kB1 = *(const bf16x8*)(kb + 512);
    const bf16_t* vbase = Vt + (size_t)(((sq * 3 + gi) * 8 + h) * 512) * 1024 + quad * 64 + kl * 4;
    const bf16_t* va = vbase + (size_t)((rho * Lg + uA) >> 4) * 1024; const bf16_t* vb = vbase + (size_t)((rho * Lg + uB) >> 4) * 1024;
#pragma unroll
    for (int dt = 0; dt < 4; ++dt) { b.vA[dt] = *(const bf16x4*)(va + dt * 256); b.vB[dt] = *(const bf16x4*)(vb + dt * 256); }
}
struct QF { bf16x8 a0, a1, b0, b1, c0, c1; };
template <int gi>
__device__ __forceinline__ void attn_compute(const KVBuf& b, const bf16x8 q0, const bf16x8 q1, f32x4 (&o)[4], float& mrun, float& lrun, int s, int blk, int r, int lane) {
    const int ls = gi == 0 ? s : (gi == 1 ? s - 12 : s - 18);
    const int sh = 2 * gi, Lg = SEQL >> sh;
    const int uA = ((256 * blk) >> sh) - 64 + 32 * ls;
    const int qi = lane & 15, quad = lane >> 4;
    const int uq = (256 * blk + r + 16 * qi) >> sh;
    const int lo = max(0, uq - 64), hi = min(Lg - 1, uq + 64);
    f32x4 sA = (f32x4){0.f, 0.f, 0.f, 0.f}, sB = sA;
    sA = __builtin_amdgcn_mfma_f32_16x16x32_bf16(b.kA0, q0, sA, 0, 0, 0); sA = __builtin_amdgcn_mfma_f32_16x16x32_bf16(b.kA1, q1, sA, 0, 0, 0);
    sB = __builtin_amdgcn_mfma_f32_16x16x32_bf16(b.kB0, q0, sB, 0, 0, 0); sB = __builtin_amdgcn_mfma_f32_16x16x32_bf16(b.kB1, q1, sB, 0, 0, 0);
    const float NEGINF = -__builtin_inff();
    const unsigned span = (unsigned)(hi - lo);
    float mx = NEGINF;
#pragma unroll
    for (int j = 0; j < 4; ++j) {
        const int ua = uA + quad * 4 + j, ub = ua + 16;
        sA[j] = ((unsigned)(ua - lo) <= span) ? sA[j] : NEGINF; sB[j] = ((unsigned)(ub - lo) <= span) ? sB[j] : NEGINF;
        mx = fmaxf(mx, fmaxf(sA[j], sB[j]));
    }
    mx = fmaxf(mx, __shfl_xor(mx, 16)); mx = fmaxf(mx, __shfl_xor(mx, 32));
    const float mnew = fmaxf(mrun, mx), alpha = __builtin_amdgcn_exp2f(mrun - mnew);
    mrun = mnew;
    float ps = 0.f;
#pragma unroll
    for (int j = 0; j < 4; ++j) { sA[j] = __builtin_amdgcn_exp2f(sA[j] - mnew); sB[j] = __builtin_amdgcn_exp2f(sB[j] - mnew); ps += sA[j] + sB[j]; }
    lrun = lrun * alpha + ps;
    u32x4 pw; pw.x = cvt_pk_bf16(sA[0], sA[1]); pw.y = cvt_pk_bf16(sA[2], sA[3]); pw.z = cvt_pk_bf16(sB[0], sB[1]); pw.w = cvt_pk_bf16(sB[2], sB[3]);
    const bf16x8 pf = __builtin_bit_cast(bf16x8, pw);
#pragma unroll
    for (int dt = 0; dt < 4; ++dt) {
        o[dt] *= alpha;
        bf16x8 vf; vf[0] = b.vA[dt][0]; vf[1] = b.vA[dt][1]; vf[2] = b.vA[dt][2]; vf[3] = b.vA[dt][3]; vf[4] = b.vB[dt][0]; vf[5] = b.vB[dt][1]; vf[6] = b.vB[dt][2]; vf[7] = b.vB[dt][3];
#ifdef DBG_ATT2
        for (int e = 0; e < 8; ++e) o[dt][e & 3] += 1e-3f * __uint_as_float(((unsigned)(unsigned short)vf[e]) << 16);
#else
        o[dt] = __builtin_amdgcn_mfma_f32_16x16x32_bf16(vf, pf, o[dt], 0, 0, 0);
#endif
    }
}
__device__ __forceinline__ void step_attention(const Args& a, LAS unsigned char* lds, int pass, int tid, int bx) {
    unsigned char* ws = a.ws;
    const int lane = tid & 63;
    const bf16_t* Qp = (const bf16_t*)(ws + WS_Q); const bf16_t* Kp = (const bf16_t*)(ws + WS_K); const bf16_t* Vt = (const bf16_t*)(ws + WS_VT);
    const bf16_t* ZA = (const bf16_t*)(ws + WS_ZA); bf16_t* GAO = (bf16_t*)(ws + WS_GAO);
    const int xcd = bx & 7;
    unsigned* ctr = (unsigned*)(ws + WS_CTL) + 16 + pass * 8 + xcd;
    LAS unsigned* slot = (LAS unsigned*)(lds + 3 * 8192);
    constexpr int NGRP = 3 * 32 * 2;
    for (;;) {
        __syncthreads();
        if (tid == 0) slot[0] = atomicAdd(ctr, 1u);
        __syncthreads();
        const unsigned grp = (unsigned)__builtin_amdgcn_readfirstlane((int)slot[0]);
        if (grp >= (unsigned)NGRP) break;
        const int wv_ = tid >> 6; const int r = ((wv_ & 3) << 2) + (wv_ >> 2) + 2 * (int)(grp & 1)  , blk = (grp >> 1) & 31, pair = xcd * 3 + (int)(grp >> 6);
        const int h = pair & 7, sq = pair >> 3;
        const int qi = lane & 15, quad = lane >> 4;
        const int tq = sq * SEQL + 256 * blk + r + 16 * qi;
        QF qf;
        { const int pos = 256 * blk + r + 16 * qi;
          const bf16_t* qa = Qp + ((size_t)(sq * 24 + h) * SEQL + pos) * 64 + quad * 8;
          const bf16_t* qb = Qp + ((size_t)(sq * 24 + 8 + h) * SEQL + (pos & 3) * 2048 + (pos >> 2)) * 64 + quad * 8;
          const bf16_t* qc = Qp + ((size_t)(sq * 24 + 16 + h) * SEQL + (pos & 15) * 512 + (pos >> 4)) * 64 + quad * 8;
          qf.a0 = *(const bf16x8*)qa; qf.a1 = *(const bf16x8*)(qa + 32); qf.b0 = *(const bf16x8*)qb; qf.b1 = *(const bf16x8*)(qb + 32); qf.c0 = *(const bf16x8*)qc; qf.c1 = *(const bf16x8*)(qc + 32); }
        f32x4 o[4];
#pragma unroll
        for (int dt = 0; dt < 4; ++dt) o[dt] = (f32x4){0.f, 0.f, 0.f, 0.f};
        float mrun = -1e30f, lrun = 0.f;
        KVBuf b0, b1;
#define ATT_SB __builtin_amdgcn_sched_barrier(0);
        {
            const int wv = tid >> 6, region = wv >> 1;
            const bf16_t* gsrc = (region < 2 ? Kp + (size_t)(sq * 24 + h) * SEQL * 64 : Vt + (size_t)((sq * 3) * 8 + h) * 512 * 1024) + (wv & 1) * 512 + lane * 8;
            const int ubase = 256 * blk - 64 + (region & 1) * 16;
#define ATT_DMA(S) do { int uT = ubase + 32 * (S); if (uT < 0 || uT >= SEQL) uT = 0; \
                __builtin_amdgcn_global_load_lds((const unsigned*)(gsrc + (size_t)(uT >> 4) * 1024), (LAS unsigned*)(lds + ((S) % 3) * 8192 + wv * 1024), 16, 0, 0); } while (0)
            ATT_DMA(0); ATT_DMA(1);
            const int kl = lane & 15;
            const unsigned foff = (unsigned)(quad * 256 + kl * 16), voff = (unsigned)(4096 + quad * 128 + kl * 8);
#pragma unroll 1
            for (int s = 0; s < 12; ++s) {
                if (s < 11) asm volatile("s_waitcnt vmcnt(1)" ::: "memory"); else asm volatile("s_waitcnt vmcnt(0)" ::: "memory");
                __syncthreads();
                if (s + 2 < 12) ATT_DMA(s + 2);
                LAS unsigned char* kb = lds + (s % 3) * 8192;
                b0.kA0 = *(const LAS bf16x8*)(kb + foff); b0.kA1 = *(const LAS bf16x8*)(kb + foff + 1024); b0.kB0 = *(const LAS bf16x8*)(kb + 2048 + foff); b0.kB1 = *(const LAS bf16x8*)(kb + 2048 + foff + 1024);
#pragma unroll
                for (int dt = 0; dt < 4; ++dt) { b0.vA[dt] = *(const LAS bf16x4*)(kb + voff + dt * 512); b0.vB[dt] = *(const LAS bf16x4*)(kb + 2048 + voff + dt * 512); }
                attn_compute<0>(b0, qf.a0, qf.a1, o, mrun, lrun, s, blk, r, lane);
            }
#undef ATT_DMA
        }
        attn_load(b0, Kp, Vt, 12, sq, h, blk, r, lane);
#define ATT_LOOP(GI, S0, S1, QA, QB) _Pragma("unroll 1") for (int s = S0; s < S1; s += 2) { \
            ATT_SB attn_load(b1, Kp, Vt, s + 1, sq, h, blk, r, lane); ATT_SB attn_compute<GI>(b0, QA, QB, o, mrun, lrun, s, blk, r, lane); \
            ATT_SB attn_load(b0, Kp, Vt, s + 2, sq, h, blk, r, lane); ATT_SB attn_compute<GI>(b1, QA, QB, o, mrun, lrun, s + 1, blk, r, lane); ATT_SB }
        ATT_LOOP(1, 12, 18, qf.b0, qf.b1)
        ATT_LOOP(2, 18, 22, qf.c0, qf.c1)
#undef ATT_LOOP
        attn_compute<2>(b0, qf.c0, qf.c1, o, mrun, lrun, 22, blk, r, lane);
        float l = lrun; l += __shfl_xor(l, 16); l += __shfl_xor(l, 32);
        float inv = 1.0f / l;
#ifdef DBG_ATT1
        for (int dt = 0; dt < 4; ++dt) o[dt] = (f32x4){1.f, 1.f, 1.f, 1.f};
#endif
#pragma unroll
        for (int dt = 0; dt < 4; ++dt) {
            const size_t off = (size_t)tq * 512 + h * 64 + 16 * dt + 4 * quad;
            const u32x2 z = *(const u32x2*)(ZA + off);
            u32x2 w; w.x = cvt_pk_bf16(o[dt][0] * inv * bf_lo(z.x), o[dt][1] * inv * bf_hi(z.x)); w.y = cvt_pk_bf16(o[dt][2] * inv * bf_lo(z.y), o[dt][3] * inv * bf_hi(z.y));
            *(u32x2*)(GAO + off) = w;
        }
    }
}

__device__ __forceinline__ f32x2 cmul(f32x2 a, f32x2 b) { return (f32x2){a.x * b.x - a.y * b.y, a.x * b.y + a.y * b.x}; }
__device__ __forceinline__ void step_scan(const Args& a, LAS unsigned char* lds, int pass, int tid, int bx) {
    unsigned char* ws = a.ws; const int G = gridDim.x;
    const float* PW = (const float*)(ws + WS_PW); const float* S = (const float*)(ws + WS_S); bf16_t* UH = (bf16_t*)(ws + WS_UH);
    LAS f32x2* carry = (LAS f32x2*)lds;
    for (int it = bx; it < SEQP * 32 * 2; it += G) {
        const int dir = it & 1, g = (it >> 1) & 31, sq = it >> 6; const int seg = tid >> 6, n = tid & 63;
        const f32x2 P = (f32x2){PW[((dir * 32 + g) * 64 + n) * 2], PW[((dir * 32 + g) * 64 + n) * 2 + 1]};
        f32x2 z[32];
        { const int c0 = dir ? (NCH - 1 - seg * 32) : seg * 32; const long stp = dir ? -256 : 256;
          const float* sp = S + ((size_t)g * CHP + sq * NCH + c0) * 256 + dir * 128 + n;
#pragma unroll
          for (int i = 0; i < 32; ++i) { z[i] = (f32x2){sp[0], sp[64]}; sp += stp; } }
        f32x2 zz = (f32x2){0.f, 0.f};
#pragma unroll
        for (int i = 0; i < 32; ++i) { const f32x2 t = z[i]; z[i] = zz; zz = cmul(P, zz) + t; }
        __syncthreads();
        carry[seg * 64 + n] = zz;
        __syncthreads();
        f32x2 P32 = P;
#pragma unroll
        for (int k = 0; k < 5; ++k) P32 = cmul(P32, P32);
        f32x2 x = (f32x2){0.f, 0.f};
        for (int sp = 0; sp < seg; ++sp) x = cmul(P32, x) + carry[sp * 64 + n];
        f32x2 pwr = (f32x2){1.f, 0.f};
        { const int c0 = dir ? (NCH - 1 - seg * 32) : seg * 32; const long stp = dir ? -(long)UHK : (long)UHK;
          bf16_t* up = UH + ((size_t)g * CHP + sq * NCH + c0) * UHK + 512 + dir * 128 + n;
#pragma unroll
          for (int i = 0; i < 32; ++i) {
              const f32x2 hin = z[i] + cmul(pwr, x);
              up[0] = (bf16_t)(cvt_pk_bf16(hin.x, 0.f) & 0xffffu); up[64] = (bf16_t)(cvt_pk_bf16(hin.y, 0.f) & 0xffffu);
              pwr = cmul(pwr, P); up += stp;
          } }
    }
}

__device__ __forceinline__ void step_final_norm(const Args& a, int pass, int tid, int bx) {
    const int lane = tid & 63, wave = tid >> 6, G = gridDim.x;
    const f32x4* gr = (const f32x4*)a.in[16] + lane;
    f32x4 gv[4];
#pragma unroll
    for (int j = 0; j < 4; ++j) gv[j] = gr[64 * j];
    int row = bx * 8 + wave;
    f32x4 nx[4];
    if (row < TP) { const f32x4* xr = (const f32x4*)(a.out + (size_t)(pass * TP + row) * DM) + lane;
#pragma unroll
        for (int j = 0; j < 4; ++j) nx[j] = xr[64 * j]; }
    for (; row < TP; row += G * 8) {
        f32x4 v[4];
#pragma unroll
        for (int j = 0; j < 4; ++j) v[j] = nx[j];
        const int nrow = row + G * 8;
        if (nrow < TP) { const f32x4* xn = (const f32x4*)(a.out + (size_t)(pass * TP + nrow) * DM) + lane;
#pragma unroll
            for (int j = 0; j < 4; ++j) nx[j] = xn[64 * j]; }
        float s = 0.f;
#pragma unroll
        for (int j = 0; j < 4; ++j) s += (v[j].x * v[j].x + v[j].y * v[j].y) + (v[j].z * v[j].z + v[j].w * v[j].w);
        const float rstd = 1.0f / sqrtf(wave_sum(s) * (1.f / DM) + EPSN);
        f32x4* xr = (f32x4*)(a.out + (size_t)(pass * TP + row) * DM) + lane;
#pragma unroll
        for (int j = 0; j < 4; ++j) xr[64 * j] = v[j] * rstd * gv[j];
    }
}


#define XB_TMO      128
#define XB_XCNT(j)  (256  + 64 * (j))
#define XB_XSUB(j)  (1280 + 64 * (j))
#define XB_XGEN(j)  (2304 + 64 * (j))
#define XB_TOP      3328
#define XB_TOPGEN   3392
#define XCD_BAR_WORDS 3456
#define XB_SLOT(b)  (4096 + 2 * (b))
#define XB_SPIN_CAP (1u << 18)
__device__ __forceinline__ unsigned xb_ld(unsigned* p)              { return __hip_atomic_load(p, __ATOMIC_RELAXED, __HIP_MEMORY_SCOPE_AGENT); }
__device__ __forceinline__ unsigned xb_add(unsigned* p, unsigned v) { return __hip_atomic_fetch_add(p, v, __ATOMIC_RELAXED, __HIP_MEMORY_SCOPE_AGENT); }
__device__ __forceinline__ unsigned xb_xcc_id() { return (unsigned)__builtin_amdgcn_s_getreg((3 << 11) | 20) & 0xFu; }
#define XB_SPIN(cond, bar) do { unsigned _sp = 0; while (cond) { __builtin_amdgcn_s_sleep(1); \
    if ((++_sp & 255u) == 0u) { if (xb_ld(&(bar)[XB_TMO])) break; if (_sp > XB_SPIN_CAP) { atomicAdd(&(bar)[XB_TMO], 1u); break; } } } } while (0)
__device__ __forceinline__ void xcd_barrier_complete(unsigned* bar, unsigned x, unsigned& nloc, unsigned& nx) {
    const unsigned G = gridDim.x;
    unsigned sum, cnt, mine, sp = 0u;
    for (;;) {
        sum = 0u; cnt = 0u; mine = 0u;
#pragma unroll
        for (unsigned j = 0; j < 16; ++j) { const unsigned c = xb_ld(&bar[XB_XCNT(j)]); sum += c; cnt += (c > 0u) ? 1u : 0u; mine = (j == x) ? c : mine; }
        if (sum == G) break;
        __builtin_amdgcn_s_sleep(1);
        if ((++sp & 255u) == 0u) { if (xb_ld(&bar[XB_TMO])) break; if (sp > XB_SPIN_CAP) { atomicAdd(&bar[XB_TMO], 1u); break; } }
    }
    nloc = mine > 0u ? mine : 1u; nx = cnt > 0u ? cnt : 1u;
}
__device__ __forceinline__ void xcd_barrier(unsigned* bar) {
    asm volatile("s_waitcnt vmcnt(0)" ::: "memory");
    __syncthreads();
    if (threadIdx.x == 0) {
        __builtin_amdgcn_s_waitcnt(0);
        const unsigned x = xb_xcc_id();
        unsigned* slot = bar + XB_SLOT(blockIdx.x);
        unsigned nloc = xb_ld(slot), nx = xb_ld(slot + 1);
        if (nloc == 0u) { xcd_barrier_complete(bar, x, nloc, nx); __hip_atomic_store(slot, nloc, __ATOMIC_RELAXED, __HIP_MEMORY_SCOPE_AGENT); __hip_atomic_store(slot + 1, nx, __ATOMIC_RELAXED, __HIP_MEMORY_SCOPE_AGENT); }
        const unsigned old = xb_add(&bar[XB_XSUB(x)], 1u);
        const unsigned gen = old / nloc;
        if (old + 1u == (gen + 1u) * nloc) {
            __builtin_amdgcn_fence(__ATOMIC_RELEASE, "agent");
            asm volatile("s_waitcnt vmcnt(0)" ::: "memory");
            const unsigned og = xb_add(&bar[XB_TOP], 1u);
            const unsigned tg = og / nx;
            if (og + 1u == (tg + 1u) * nx) xb_add(&bar[XB_TOPGEN], 1u);
            else XB_SPIN(xb_ld(&bar[XB_TOPGEN]) == tg, bar);
            __builtin_amdgcn_fence(__ATOMIC_ACQUIRE, "agent");
            xb_add(&bar[XB_XGEN(x)], 1u);
            asm volatile("s_waitcnt vmcnt(0)" ::: "memory");
        } else {
            XB_SPIN(xb_ld(&bar[XB_XGEN(x)]) == gen, bar);
            __builtin_amdgcn_fence(__ATOMIC_ACQUIRE, "agent");
            asm volatile("s_waitcnt vmcnt(0)" ::: "memory");
        }
    }
    __syncthreads();
}

constexpr int NSTEPS = 1 + 10 * NPASS;
__host__ __device__ __forceinline__ bool sync_after(int st) { if (st == 0) return true; const int k = (st - 1) % 10; return !(k == 1 || k == 6 || k == 9); }

__global__ void __launch_bounds__(512, 2) fwd_kernel(Args a) {
    extern __shared__ __attribute__((aligned(16))) unsigned char lds_raw[];
    LAS unsigned char* lds = (LAS unsigned char*)lds_raw;
    cg::grid_group grid = cg::this_grid();
    const int G = gridDim.x;
    unsigned char* ws = a.ws;
    unsigned* bar = (unsigned*)(ws + WS_BAR);
    if (a.do_sync && threadIdx.x == 0) (void)xb_add(&bar[XB_XCNT(xb_xcc_id())], 1u);
    for (int st = a.st_lo; st < a.st_hi; ++st) {
        int tid = threadIdx.x, bx = blockIdx.x;
        asm volatile("" : "+v"(tid), "+s"(bx));
#ifndef NO_SETUP
        if (st == 0) { step_setup(a, lds, tid, bx); }
#else
        if (st == 0) {}
#endif
        else {
            const int pass = (st - 1) / 10, k = (st - 1) % 10;
            GemmD g; g.ws = ws; g.out = a.out; g.xp = a.in[0]; g.xs = a.in[1]; g.pass = pass; g.nb = 1; g.sA = 0; g.sB = 0;
            bool has_gemm = true;
            switch (k) {
            case 0: g.A = (const bf16_t*)((unsigned char*)a.out + OUT_HN_OFF) + (size_t)pass * TP * DM; g.lda = DM; g.Bt = (const bf16_t*)(ws + WS_WIN); g.ldb = DM; g.K = DM; g.nM = TP / BM; g.nN = INC / BM; g.mode = MODE_PROJ; break;
            case 1: g.A = (const bf16_t*)(ws + WS_UH); g.lda = UHK; g.sA = (size_t)CHP * UHK * 2; g.Bt = (const bf16_t*)(ws + WS_BST); g.ldb = 512; g.sB = (size_t)256 * 512 * 2; g.K = 512; g.nM = CHP / BM; g.nN = 1; g.nb = 32; g.mode = MODE_S; break;
            case 4: g.A = (const bf16_t*)(ws + WS_UH); g.lda = UHK; g.sA = (size_t)CHP * UHK * 2; g.Bt = (const bf16_t*)(ws + WS_MTC); g.ldb = UHK; g.sB = (size_t)512 * UHK * 2; g.K = UHK; g.nM = CHP / BM; g.nN = 2; g.nb = 32; g.mode = MODE_Y; break;
            case 5: g.A = (const bf16_t*)(ws + WS_SG); g.lda = 512; g.Bt = (const bf16_t*)(ws + WS_WGLU); g.ldb = 512; g.K = 512; g.nM = TP / BM; g.nN = 2; g.mode = MODE_GLU; break;
            case 6: g.A = (const bf16_t*)(ws + WS_GAO); g.lda = 512; g.Bt = (const bf16_t*)(ws + WS_WA); g.ldb = 512; g.K = 512; g.nM = TP / BM; g.nN = 4; g.mode = MODE_A; break;
            case 7: g.A = (const bf16_t*)(ws + WS_SB); g.lda = 512; g.Bt = (const bf16_t*)(ws + WS_WB); g.ldb = 512; g.K = 512; g.nM = TP / BM; g.nN = 4; g.mode = MODE_B; break;
            case 8: g.A = (const bf16_t*)(ws + WS_M1); g.lda = 1024; g.Bt = (const bf16_t*)(ws + WS_WOUT); g.ldb = 1024; g.K = 1024; g.nM = TP / BM; g.nN = 4; g.mode = MODE_OUT; break;
            default: has_gemm = false; g.A = nullptr; g.Bt = nullptr; g.lda = g.ldb = g.K = 0; g.nM = g.nN = 0; g.mode = 0; break;
            }
            if (has_gemm) {
#ifndef NO_GEMM
                gemm_phase(lds, g, G, bx, tid);
#endif
            }
#ifndef NO_ATTN
            else if (k == 2) step_attention(a, lds, pass, tid, bx);
#endif
#ifndef NO_SCAN
            else if (k == 3) step_scan(a, lds, pass, tid, bx);
#endif
            else if (k == 9) step_final_norm(a, pass, tid, bx);
        }
        if (a.do_sync && st + 1 < a.st_hi && sync_after(st)) { if (a.do_sync == 2) grid.sync(); else xcd_barrier(bar); }
    }
}

extern "C" void kernel_launch(void* const* d_in, const int* in_sizes, int n_in, void* d_out, int out_size, void* d_ws, size_t ws_size, hipStream_t stream) {
    constexpr int LDS_BYTES = STAGE_BYTES + 32768;
    static int grid = 0;
    if (grid == 0) {
        if (n_in != 17 || out_size != TTOK * DM || ws_size < WS_END) { fprintf(stderr, "kernel_launch: unexpected shapes (n_in %d out %d ws %zu need %zu)\n", n_in, out_size, ws_size, (size_t)WS_END); grid = -1; return; }
        int dev = 0, cus = 0, per_cu = 0;
        hipGetDevice(&dev); hipDeviceGetAttribute(&cus, hipDeviceAttributeMultiprocessorCount, dev);
        hipFuncSetAttribute((const void*)fwd_kernel, hipFuncAttributeMaxDynamicSharedMemorySize, LDS_BYTES);
        hipOccupancyMaxActiveBlocksPerMultiprocessor(&per_cu, (const void*)fwd_kernel, 512, LDS_BYTES);
        if (per_cu < 1) per_cu = 1;
        grid = cus * 1;
        (void)hipGetLastError();
    }
    if (grid < 0) return;
    (void)hipMemsetAsync((unsigned char*)d_ws + WS_CTL, 0, 4096, stream);
    (void)hipMemsetAsync((unsigned char*)d_ws + WS_BAR, 0, WS_BAR_BYTES, stream);
    Args a{};
    for (int i = 0; i < 17; ++i) a.in[i] = (const float*)d_in[i];
    a.out = (float*)d_out; a.ws = (unsigned char*)d_ws; a.pad = 0;
#ifndef MULTI_LAUNCH
#define MULTI_LAUNCH 0
#endif
#if MULTI_LAUNCH
    a.do_sync = 0;
    for (int st = 0; st < NSTEPS; ++st) {
        a.st_lo = st; a.st_hi = st + 1;
        hipLaunchKernelGGL(fwd_kernel, dim3(grid), dim3(512), LDS_BYTES, stream, a);
    }
#else
    a.do_sync = 1; a.st_lo = 0; a.st_hi = NSTEPS;
    void* args[] = {&a};
    hipError_t e = hipLaunchCooperativeKernel((const void*)fwd_kernel, dim3(grid), dim3(512), args, LDS_BYTES, stream);
    if (e != hipSuccess) fprintf(stderr, "cooperative launch failed: %s (grid %d)\n", hipGetErrorString(e), grid);
#endif
}
```

```cpp
#include <hip/hip_runtime.h>
#include <hip/hip_cooperative_groups.h>
#include <cstdio>

namespace cg = cooperative_groups;

#define LAS __attribute__((address_space(3)))
typedef unsigned short bf16_t;
typedef short bf16x8 __attribute__((ext_vector_type(8)));
typedef short bf16x4 __attribute__((ext_vector_type(4)));
typedef float f32x4 __attribute__((ext_vector_type(4)));
typedef float f32x2 __attribute__((ext_vector_type(2)));
typedef unsigned u32x4 __attribute__((ext_vector_type(4)));
typedef unsigned u32x2 __attribute__((ext_vector_type(2)));

constexpr int DM = 1024, SEQL = 8192, NSEQ = 6, TTOK = NSEQ * SEQL;
constexpr int NPASS = 2, SEQP = 3, TP = SEQP * SEQL;
constexpr int INC = 8192, QKVW = 1536;
constexpr int LC = 32, NCH = SEQL / LC  , CHP = SEQP * NCH  ;
constexpr int UHK = LC * 16 + 256;
constexpr float EPSN = 1e-6f;
constexpr float QSCALE = 0.18033688011112042f;

constexpr size_t AL(size_t x) { return (x + 255) & ~(size_t)255; }
constexpr size_t WS_CTL = 0;
constexpr size_t WS_WIN = 4096;
constexpr size_t WS_WGLU = WS_WIN + (size_t)INC * DM * 2;
constexpr size_t WS_WA = WS_WGLU + (size_t)512 * 512 * 2;
constexpr size_t WS_WB = WS_WA + (size_t)1024 * 512 * 2;
constexpr size_t WS_WOUT = WS_WB + (size_t)1024 * 512 * 2;
constexpr size_t WS_MTC = WS_WOUT + (size_t)1024 * 1024 * 2;
constexpr size_t WS_BST = WS_MTC + (size_t)32 * 512 * UHK * 2;
constexpr size_t WS_ROPE = WS_BST + (size_t)32 * 256 * 512 * 2;
constexpr size_t WS_PW = WS_ROPE + (size_t)2 * SEQL * 32 * 4;
constexpr size_t WS_KT = WS_PW + (size_t)2 * 32 * 64 * 8;
constexpr size_t WS_Q = WS_KT + (size_t)32 * 2 * 32 * 256 * 4;
constexpr size_t WS_K = WS_Q + (size_t)TP * QKVW * 2;
constexpr size_t WS_VT = WS_K + (size_t)TP * QKVW * 2;
constexpr size_t WS_ZA = WS_VT + (size_t)TP * QKVW * 2;
constexpr size_t WS_ZB = WS_ZA + (size_t)TP * 512 * 2;
constexpr size_t WS_GA = WS_ZB + (size_t)TP * 512 * 2;
constexpr size_t WS_GB = WS_GA + (size_t)TP * 1024 * 2;
constexpr size_t WS_UH = WS_GB + (size_t)TP * 1024 * 2;
constexpr size_t WS_S = WS_UH + (size_t)32 * CHP * UHK * 2;
constexpr size_t WS_GAO = WS_S + (size_t)32 * CHP * 256 * 4;
constexpr size_t WS_BAR = WS_GAO + (size_t)TP * 512 * 2;
constexpr size_t WS_BAR_BYTES = 32768;
constexpr size_t WS_END = WS_BAR + WS_BAR_BYTES;
constexpr size_t WS_SG = WS_Q;
constexpr size_t WS_SB = WS_Q + (size_t)TP * 512 * 2;
constexpr size_t WS_M1 = WS_K;
constexpr size_t OUT_HN_OFF = (size_t)SEQP * SEQL * DM * 4;

struct Args {
    const float* in[17];
    float* out;
    unsigned char* ws;
    int st_lo, st_hi;
    int do_sync, pad;
};

typedef __bf16 bf16v2 __attribute__((ext_vector_type(2)));
__device__ __forceinline__ unsigned cvt_pk_bf16(float lo, float hi) { const f32x2 v = (f32x2){lo, hi}; const bf16v2 r = __builtin_convertvector(v, bf16v2); return __builtin_bit_cast(unsigned, r); }
__device__ __forceinline__ float bf_lo(unsigned w) { return __uint_as_float(w << 16); }
__device__ __forceinline__ float bf_hi(unsigned w) { return __uint_as_float(w & 0xffff0000u); }
__device__ __forceinline__ float fast_rcp(float x) { return __builtin_amdgcn_rcpf(x); }
__device__ __forceinline__ float sigmoidf_(float x) { return fast_rcp(1.0f + __builtin_amdgcn_exp2f(-1.4426950408889634f * x)); }
__device__ __forceinline__ float siluf_(float x) { return x * sigmoidf_(x); }
__device__ __forceinline__ float gelu_tanh(float x) { const float u = x * (1.5957691216057308f + 0.07135481627260025f * x * x); return x * sigmoidf_(u); }
__device__ __forceinline__ float wave_sum(float v) {
#pragma unroll
    for (int o = 1; o < 64; o <<= 1) v += __shfl_xor(v, o);
    return v;
}
__device__ __forceinline__ const float* xrow_ptr(const float* xp, const float* xs, int tg) {
    return tg < 4 * SEQL ? xp + (size_t)tg * DM : xs + (size_t)(tg - 4 * SEQL) * DM;
}

constexpr int BM = 256, BK = 64, HALF = 128, HTB = HALF * BK * 2, STAGE_BYTES = 8 * HTB, NXCD = 8, WGM = 8;
__host__ __device__ __forceinline__ int lds_byte(int r, int c) { const int st = (r >> 4) * 2 + (c >> 5), rr = r & 15, cc = c & 31, ob = rr * 64 + cc * 2; return st * 1024 + (ob ^ (((ob >> 9) & 1) << 5)); }
__host__ __device__ __forceinline__ void stage_rc(int b, int& R, int& C) { const int st = b / 1024, sb = b % 1024, swz = sb ^ (((sb >> 9) & 1) << 5); R = (st >> 1) * 16 + swz / 64; C = (st & 1) * 32 + (swz % 64) / 2; }
__host__ __device__ __forceinline__ int perm32(int rho) { const int n = rho >> 4, i = rho & 15; return 8 * (i >> 2) + 4 * n + (i & 3); }

enum { MODE_PROJ = 0, MODE_S = 1, MODE_Y = 2, MODE_GLU = 3, MODE_A = 4, MODE_B = 5, MODE_OUT = 6 };
struct Unit { int pm, pn, bz; };
struct GemmD {
    const bf16_t* A; const bf16_t* Bt;
    int lda, ldb, K, nM, nN, nb;
    unsigned sA, sB;
    int mode, pass, lgnN;
    int u0, ustride, ucount;
};
__device__ __forceinline__ bool unit_next(const GemmD& g, int i, int G, int c, int& pm, int& pn, int& bz) {
    const bool ok = i < g.ucount;
    const int Li = ok ? g.u0 + i * g.ustride : 0;
    if (g.nb == 1) {
        const int lg = g.lgnN, q = (g.nM << lg) >> 3;
        const int wgid = (Li & 7) * q + (Li >> 3);
        const int gid = wgid >> (3 + lg), rem = wgid & ((8 << lg) - 1);
        pm = gid * 8 + (rem & 7); pn = rem >> 3; bz = 0;
    } else {
        const int nwg = g.nM * g.nN;
        const int w = Li % nwg; bz = Li / nwg; pm = w % g.nM; pn = w / g.nM;
    }
    return ok;
}

__device__ __forceinline__ void epilogue(const Args& a, LAS unsigned char* lds, const GemmD& g, const f32x4 (&acc)[2][2][4][2], const Unit& u, int wr, int wc, int fr, int fq) {
    asm volatile("" : "+v"(fr), "+v"(fq));
    unsigned char* ws = a.ws;
    const int rbase = u.pm * BM + wr * 64 + fr;
    const int cl = wc * 32 + fq * 8;
    if (g.mode == MODE_PROJ) {
        const int pn = u.pn;
        if (pn < 12) {
            const bool isq = pn < 6;
            bf16_t* dst = (bf16_t*)(ws + (isq ? WS_Q : WS_K));
            const float* rc = (const float*)(ws + WS_ROPE); const float* rs = rc + SEQL * 32;
            const int a4 = 4 * (4 * (wc & 1) + fq);
            const int pq = isq ? pn : pn - 6, gi = pq >> 1, sh = 2 * gi, dmask = (1 << sh) - 1, Lg = SEQL >> sh;
            const float sc = isq ? QSCALE : 1.0f;
#pragma unroll
            for (int ai = 0; ai < 2; ++ai) {
                asm volatile("" ::: "memory");
                f32x4 cvv[4], svv[4];
#pragma unroll
                for (int m = 0; m < 4; ++m) { const int pos = (rbase + ai * HALF + m * 16) & (SEQL - 1); cvv[m] = *(const f32x4*)(rc + pos * 32 + a4); svv[m] = *(const f32x4*)(rs + pos * 32 + a4); }
#pragma unroll
                for (int m = 0; m < 4; ++m) {
                    const int tl = rbase + ai * HALF + m * 16; const int pos = tl & (SEQL - 1), sq = tl >> 13;
                    const int kidx = (pos & dmask) * Lg + (pos >> sh);
                    const f32x4 cv = cvv[m] * sc, sv = svv[m] * sc;
#pragma unroll
                    for (int bj = 0; bj < 2; ++bj) {
                        const f32x4 x1 = acc[ai][bj][m][0], x2 = acc[ai][bj][m][1];
                        const f32x4 o1 = x1 * cv - x2 * sv, o2 = x2 * cv + x1 * sv;
                        const int head = pq * 4 + 2 * bj + (wc >> 1);
                        const int ch = 4 * (wc & 1) + fq;
                        bf16_t* p = dst + (size_t)(sq * 24 + head) * SEQL * 64 + (isq ? (size_t)kidx * 64 + ch * 8 : (size_t)(kidx >> 4) * 1024 + ch * 128 + (kidx & 15) * 8);
                        u32x4 w; w.x = cvt_pk_bf16(o1[0], o1[1]); w.y = cvt_pk_bf16(o1[2], o1[3]); w.z = cvt_pk_bf16(o2[0], o2[1]); w.w = cvt_pk_bf16(o2[2], o2[3]);
                        *(u32x4*)p = w;
                    }
                }
            }
        } else if (pn < 18) {
            bf16_t* dst = (bf16_t*)(ws + WS_VT);
            const int gi = (pn - 12) >> 1, sh = 2 * gi;
            const int wid = wr * 4 + wc, lane = fq * 16 + fr;
            LAS bf16_t* tile = (LAS bf16_t*)(lds + STAGE_BYTES + wid * 4096);
#pragma unroll
            for (int ai = 0; ai < 2; ++ai) {
                const int tl0 = u.pm * BM + wr * 64 + ai * HALF;
                const int pos0 = tl0 & (SEQL - 1), sq = tl0 >> 13;
#pragma unroll
                for (int bj = 0; bj < 2; ++bj) {
                    asm volatile("" ::: "memory");
                    const int h = (4 * (pn - 12) + 2 * bj + (wc >> 1)) & 7;
#pragma unroll
                    for (int m = 0; m < 4; ++m) {
                        const int t = 16 * m + fr;
                        const int slot = gi == 0 ? t : (gi == 1 ? ((t & 3) * 16 + (t >> 2)) : ((t & 15) * 4 + (t >> 4)));
#pragma unroll
                        for (int n = 0; n < 2; ++n)
#pragma unroll
                            for (int j = 0; j < 4; ++j) { const unsigned w = cvt_pk_bf16(acc[ai][bj][m][n][j], 0.f); tile[(8 * fq + 4 * n + j) * 64 + slot] = (bf16_t)(w & 0xffffu); }
                    }
                    bf16_t* hb0 = dst + (size_t)(((sq * 3 + gi) * 8 + h) * 512) * 1024;
#pragma unroll
                    for (int i = 0; i < 4; ++i) {
                        const int c = lane + 64 * i, d = c >> 3, s8 = (c & 7) * 8;
                        const u32x4 v = *(const LAS u32x4*)(tile + d * 64 + s8);
                        const int dg = 32 * (wc & 1) + d; const int doff = (dg >> 4) * 256 + (dg & 15) * 4;
                        if (gi == 0) { const int kidx = pos0 + s8; bf16_t* q = hb0 + (size_t)(kidx >> 4) * 1024 + doff + ((kidx & 15) >> 2) * 64; *(u32x2*)q = (u32x2){v.x, v.y}; *(u32x2*)(q + 64) = (u32x2){v.z, v.w}; }
                        else if (gi == 1) { const int kidx = (s8 >> 4) * 2048 + (pos0 >> 2) + (s8 & 15); bf16_t* q = hb0 + (size_t)(kidx >> 4) * 1024 + doff + ((kidx & 15) >> 2) * 64; *(u32x2*)q = (u32x2){v.x, v.y}; *(u32x2*)(q + 64) = (u32x2){v.z, v.w}; }
                        else { const int ka = (s8 >> 2) * 512 + (pos0 >> 4), kb = ka + 512;
                            *(u32x2*)(hb0 + (size_t)(ka >> 4) * 1024 + doff + ((ka & 15) >> 2) * 64) = (u32x2){v.x, v.y}; *(u32x2*)(hb0 + (size_t)(kb >> 4) * 1024 + doff + ((kb & 15) >> 2) * 64) = (u32x2){v.z, v.w}; }
                    }
                }
            }
        } else if (pn == 20 || pn == 21) {
            bf16_t* dst = (bf16_t*)(ws + WS_UH);
#pragma unroll
            for (int ai = 0; ai < 2; ++ai)
#pragma unroll
                for (int m = 0; m < 4; ++m) { asm volatile("" ::: "memory");
                    const int tl = rbase + ai * HALF + m * 16;
#pragma unroll
                    for (int bj = 0; bj < 2; ++bj) {
                        const int gg = 16 * (pn - 20) + 8 * bj + 2 * wc + (fq >> 1);
                        bf16_t* p = dst + ((size_t)(gg * CHP + (tl >> 5)) * UHK) + (tl & 31) * 16 + 8 * (fq & 1);
                        const f32x4 v0 = acc[ai][bj][m][0], v1 = acc[ai][bj][m][1];
                        u32x4 w; w.x = cvt_pk_bf16(v0[0], v0[1]); w.y = cvt_pk_bf16(v0[2], v0[3]); w.z = cvt_pk_bf16(v1[0], v1[1]); w.w = cvt_pk_bf16(v1[2], v1[3]);
                        *(u32x4*)p = w;
                    }
                }
        } else {
            bf16_t* dst; int ld, c0; bool silu;
            if (pn < 20) { dst = (bf16_t*)(ws + WS_ZA); ld = 512; c0 = (pn - 18) * 256; silu = true; }
            else if (pn < 24) { dst = (bf16_t*)(ws + WS_ZB); ld = 512; c0 = (pn - 22) * 256; silu = true; }
            else if (pn < 28) { dst = (bf16_t*)(ws + WS_GA); ld = 1024; c0 = (pn - 24) * 256; silu = false; }
            else { dst = (bf16_t*)(ws + WS_GB); ld = 1024; c0 = (pn - 28) * 256; silu = false; }
#pragma unroll
            for (int ai = 0; ai < 2; ++ai)
#pragma unroll
                for (int m = 0; m < 4; ++m) { asm volatile("" ::: "memory");
                    const int tl = rbase + ai * HALF + m * 16;
#pragma unroll
                    for (int bj = 0; bj < 2; ++bj) {
                        f32x4 v0 = acc[ai][bj][m][0], v1 = acc[ai][bj][m][1];
#pragma unroll
                        for (int j = 0; j < 4; ++j) { const float s0 = sigmoidf_(v0[j]), s1 = sigmoidf_(v1[j]); v0[j] = silu ? v0[j] * s0 : s0; v1[j] = silu ? v1[j] * s1 : s1; }
                        u32x4 w; w.x = cvt_pk_bf16(v0[0], v0[1]); w.y = cvt_pk_bf16(v0[2], v0[3]); w.z = cvt_pk_bf16(v1[0], v1[1]); w.w = cvt_pk_bf16(v1[2], v1[3]);
                        *(u32x4*)(dst + (size_t)tl * ld + c0 + cl + bj * HALF) = w;
                    }
                }
        }
    } else if (g.mode == MODE_S) {
        float* dst = (float*)(ws + WS_S) + (size_t)u.bz * CHP * 256;
#pragma unroll
        for (int ai = 0; ai < 2; ++ai)
#pragma unroll
            for (int m = 0; m < 4; ++m) { asm volatile("" ::: "memory");
                const int r = rbase + ai * HALF + m * 16;
#pragma unroll
                for (int bj = 0; bj < 2; ++bj) { float* p = dst + (size_t)r * 256 + cl + bj * HALF; *(f32x4*)p = acc[ai][bj][m][0]; *(f32x4*)(p + 4) = acc[ai][bj][m][1]; }
            }
    } else if (g.mode == MODE_Y) {
        bf16_t* dst = (bf16_t*)(ws + WS_SG);
#pragma unroll
        for (int ai = 0; ai < 2; ++ai)
#pragma unroll
            for (int m = 0; m < 4; ++m) { asm volatile("" ::: "memory");
                const int r = rbase + ai * HALF + m * 16;
#pragma unroll
                for (int bj = 0; bj < 2; ++bj) {
                    const int t = 16 * u.pn + 8 * bj + 2 * wc + (fq >> 1);
                    f32x4 v0 = acc[ai][bj][m][0], v1 = acc[ai][bj][m][1];
#pragma unroll
                    for (int j = 0; j < 4; ++j) { v0[j] = gelu_tanh(v0[j]); v1[j] = gelu_tanh(v1[j]); }
                    u32x4 w; w.x = cvt_pk_bf16(v0[0], v0[1]); w.y = cvt_pk_bf16(v0[2], v0[3]); w.z = cvt_pk_bf16(v1[0], v1[1]); w.w = cvt_pk_bf16(v1[2], v1[3]);
                    *(u32x4*)(dst + (size_t)(r * LC + t) * 512 + u.bz * 16 + 8 * (fq & 1)) = w;
                }
            }
    } else if (g.mode == MODE_GLU) {
        const bf16_t* sg = (const bf16_t*)(ws + WS_SG); const bf16_t* zb = (const bf16_t*)(ws + WS_ZB); bf16_t* dst = (bf16_t*)(ws + WS_SB);
#pragma unroll
        for (int ai = 0; ai < 2; ++ai) {
            asm volatile("" ::: "memory");
            u32x4 sv4[4][2], zv4[4][2];
#pragma unroll
            for (int m = 0; m < 4; ++m)
#pragma unroll
                for (int bj = 0; bj < 2; ++bj) { const size_t off = (size_t)(rbase + ai * HALF + m * 16) * 512 + u.pn * BM + cl + bj * HALF; sv4[m][bj] = *(const u32x4*)(sg + off); zv4[m][bj] = *(const u32x4*)(zb + off); }
#pragma unroll
            for (int m = 0; m < 4; ++m)
#pragma unroll
                for (int bj = 0; bj < 2; ++bj) {
                    const size_t off = (size_t)(rbase + ai * HALF + m * 16) * 512 + u.pn * BM + cl + bj * HALF;
                    const u32x4 s4 = sv4[m][bj], z4 = zv4[m][bj];
                    const f32x4 v0 = acc[ai][bj][m][0], v1 = acc[ai][bj][m][1];
                    u32x4 w;
                    w.x = cvt_pk_bf16(bf_lo(s4.x) * sigmoidf_(v0[0]) * bf_lo(z4.x), bf_hi(s4.x) * sigmoidf_(v0[1]) * bf_hi(z4.x));
                    w.y = cvt_pk_bf16(bf_lo(s4.y) * sigmoidf_(v0[2]) * bf_lo(z4.y), bf_hi(s4.y) * sigmoidf_(v0[3]) * bf_hi(z4.y));
                    w.z = cvt_pk_bf16(bf_lo(s4.z) * sigmoidf_(v1[0]) * bf_lo(z4.z), bf_hi(s4.z) * sigmoidf_(v1[1]) * bf_hi(z4.z));
                    w.w = cvt_pk_bf16(bf_lo(s4.w) * sigmoidf_(v1[2]) * bf_lo(z4.w), bf_hi(s4.w) * sigmoidf_(v1[3]) * bf_hi(z4.w));
                    *(u32x4*)(dst + off) = w;
                }
        }
    } else if (g.mode == MODE_A || g.mode == MODE_B) {
        const bool isb = g.mode == MODE_B;
        const bf16_t* gt = (const bf16_t*)(ws + (isb ? WS_GB : WS_GA)); bf16_t* dst = (bf16_t*)(ws + WS_M1);
#pragma unroll
        for (int ai = 0; ai < 2; ++ai) {
            asm volatile("" ::: "memory");
            u32x4 gv4[4][2], pv4[4][2];
#pragma unroll
            for (int m = 0; m < 4; ++m)
#pragma unroll
                for (int bj = 0; bj < 2; ++bj) { const size_t off = (size_t)(rbase + ai * HALF + m * 16) * 1024 + u.pn * BM + cl + bj * HALF; gv4[m][bj] = *(const u32x4*)(gt + off); pv4[m][bj] = (u32x4){0u, 0u, 0u, 0u}; if (isb) pv4[m][bj] = *(const u32x4*)(dst + off); }
#pragma unroll
            for (int m = 0; m < 4; ++m)
#pragma unroll
                for (int bj = 0; bj < 2; ++bj) {
                    const size_t off = (size_t)(rbase + ai * HALF + m * 16) * 1024 + u.pn * BM + cl + bj * HALF;
                    const u32x4 g4 = gv4[m][bj], p4 = pv4[m][bj];
                    const f32x4 v0 = acc[ai][bj][m][0], v1 = acc[ai][bj][m][1];
                    u32x4 w;
                    w.x = cvt_pk_bf16(bf_lo(p4.x) + bf_lo(g4.x) * v0[0], bf_hi(p4.x) + bf_hi(g4.x) * v0[1]);
                    w.y = cvt_pk_bf16(bf_lo(p4.y) + bf_lo(g4.y) * v0[2], bf_hi(p4.y) + bf_hi(g4.y) * v0[3]);
                    w.z = cvt_pk_bf16(bf_lo(p4.z) + bf_lo(g4.z) * v1[0], bf_hi(p4.z) + bf_hi(g4.z) * v1[1]);
                    w.w = cvt_pk_bf16(bf_lo(p4.w) + bf_lo(g4.w) * v1[2], bf_hi(p4.w) + bf_hi(g4.w) * v1[3]);
                    *(u32x4*)(dst + off) = w;
                }
        }
    } else {
#pragma unroll
        for (int ai = 0; ai < 2; ++ai)
#pragma unroll
          for (int mh = 0; mh < 2; ++mh) {
            asm volatile("" ::: "memory");
            f32x4 xa[2][2][2];
#pragma unroll
            for (int m2 = 0; m2 < 2; ++m2) {
                const float* xr = xrow_ptr(a.in[0], a.in[1], g.pass * TP + rbase + ai * HALF + (2 * mh + m2) * 16);
#pragma unroll
                for (int bj = 0; bj < 2; ++bj) { const int c = u.pn * BM + cl + bj * HALF; xa[m2][bj][0] = *(const f32x4*)(xr + c); xa[m2][bj][1] = *(const f32x4*)(xr + c + 4); }
            }
#pragma unroll
            for (int m2 = 0; m2 < 2; ++m2) {
                const int m = 2 * mh + m2;
                float* orow = a.out + (size_t)(g.pass * TP + rbase + ai * HALF + m * 16) * DM;
#pragma unroll
                for (int bj = 0; bj < 2; ++bj) {
                    const int c = u.pn * BM + cl + bj * HALF;
                    *(f32x4*)(orow + c) = xa[m2][bj][0] + acc[ai][bj][m][0]; *(f32x4*)(orow + c + 4) = xa[m2][bj][1] + acc[ai][bj][m][1];
                }
            }
          }
    }
}

__device__ __forceinline__ void gemm_phase(const Args& a, LAS unsigned char* lds, const GemmD& g, int G, int cidx, int tid) {
    const int wid = __builtin_amdgcn_readfirstlane(tid >> 6), lane = tid & 63, wr = wid >> 2, wc = wid & 3, fr = lane & 15, fq = lane >> 4;
    const int K = g.K, nt = K / BK;
    unsigned voffA[2], voffB[2];
#pragma unroll
    for (int i = 0; i < 2; ++i) { int R, C; stage_rc(tid * 16 + i * 8192, R, C); const int Rb = (R & ~31) + perm32(R & 31);
        voffA[i] = (unsigned)(R * g.lda + C) * 2u; voffB[i] = (unsigned)(Rb * g.ldb + C) * 2u; }
    const size_t kstep = (size_t)(BK * 2);
    const size_t hstepA = (size_t)HALF * g.lda * 2, hstepB = (size_t)HALF * g.ldb * 2;
    const size_t tstepA = 2 * hstepA, tstepB = 2 * hstepB;
    const unsigned ldsw = (unsigned)wid * 1024u;
    const int aoff = lds_byte(wr * 64 + fr, fq * 8), boff = lds_byte(wc * 32 + fr, fq * 8);
#define PG8_SA(b, h) (((b) * 2 + (h)) * HTB)
#define PG8_SB(b, h) ((4 + (b) * 2 + (h)) * HTB)
#define PG8_STAGE(bufoff, gbase, voff) do { _Pragma("unroll") for (int _i = 0; _i < 2; ++_i) \
        __builtin_amdgcn_global_load_lds((const unsigned*)((const char*)(gbase) + (voff)[_i]), (LAS unsigned*)(lds + (bufoff) + ldsw + _i * 8192), 16, 0, 0); } while (0)
#define PG8_LDA(dst, b, h) do { _Pragma("unroll") for (int m = 0; m < 4; ++m) _Pragma("unroll") for (int k = 0; k < 2; ++k) dst[m][k] = *(const LAS bf16x8*)(lds + PG8_SA(b, h) + aoff + m * 2048 + k * 1024); } while (0)
#define PG8_LDB(dst, b, h) do { _Pragma("unroll") for (int n = 0; n < 2; ++n) _Pragma("unroll") for (int k = 0; k < 2; ++k) dst[n][k] = *(const LAS bf16x8*)(lds + PG8_SB(b, h) + boff + n * 2048 + k * 1024); } while (0)
#define PG8_MMA(ai, bj, At, Bt) do { __builtin_amdgcn_s_setprio(1); _Pragma("unroll") for (int m = 0; m < 4; ++m) _Pragma("unroll") for (int n = 0; n < 2; ++n) _Pragma("unroll") for (int k = 0; k < 2; ++k) \
        acc[ai][bj][m][n] = __builtin_amdgcn_mfma_f32_16x16x32_bf16(Bt[n][k], At[m][k], acc[ai][bj][m][n], 0, 0, 0); __builtin_amdgcn_s_setprio(0); } while (0)
#define PG8_WAIT_V(n) asm volatile("s_waitcnt vmcnt(" #n ")" ::: "memory")
#define PG8_WAIT_L(n) asm volatile("s_waitcnt lgkmcnt(" #n ")" ::: "memory")
#define PG8_BAR __builtin_amdgcn_s_barrier()
#define PG8_SCHED __builtin_amdgcn_sched_barrier(0)
    Unit cur, nxt; int ui = 0;
    { int pm_, pn_, bz_; if (!unit_next(g, 0, G, cidx, pm_, pn_, bz_)) return; cur.pm = pm_; cur.pn = pn_; cur.bz = bz_; }
    f32x4 acc[2][2][4][2];
#pragma unroll
    for (int a = 0; a < 2; ++a)
#pragma unroll
        for (int b = 0; b < 2; ++b)
#pragma unroll
            for (int m = 0; m < 4; ++m)
#pragma unroll
                for (int n = 0; n < 2; ++n) acc[a][b][m][n] = (f32x4){0.f, 0.f, 0.f, 0.f};
    bf16x8 At[4][2], B0[2][2], B1[2][2];
    const char* cA = (const char*)g.A + (size_t)cur.bz * g.sA + (size_t)cur.pm * tstepA; const char* cB = (const char*)g.Bt + (size_t)cur.bz * g.sB + (size_t)cur.pn * tstepB;
    PG8_STAGE(PG8_SB(0, 0), cB, voffB); PG8_STAGE(PG8_SA(0, 0), cA, voffA); PG8_STAGE(PG8_SB(0, 1), cB + hstepB, voffB); PG8_STAGE(PG8_SA(0, 1), cA + hstepA, voffA);
    if (wr == 1) PG8_BAR;
    PG8_WAIT_V(4); PG8_BAR;
    PG8_STAGE(PG8_SB(1, 0), cB + kstep, voffB); PG8_STAGE(PG8_SA(1, 0), cA + kstep, voffA); PG8_STAGE(PG8_SB(1, 1), cB + hstepB + kstep, voffB);
    PG8_WAIT_V(6); PG8_BAR;
    for (;;) {
        int npm, npn, nbz; const bool has_next = unit_next(g, ui + 1, G, cidx, npm, npn, nbz); nxt.pm = npm; nxt.pn = npn; nxt.bz = nbz;
        const char* nA = has_next ? (const char*)g.A + (size_t)nxt.bz * g.sA + (size_t)nxt.pm * tstepA : cA; const char* nB = has_next ? (const char*)g.Bt + (size_t)nxt.bz * g.sB + (size_t)nxt.pn * tstepB : cB;
        for (int t = 0; t < nt; t += 2) {
            const bool last = (t == nt - 2);
            const char* a1 = cA + (size_t)(t + 1) * kstep;
            const char* a2 = last ? nA : cA + (size_t)(t + 2) * kstep; const char* b2 = last ? nB : cB + (size_t)(t + 2) * kstep;
            const char* a3 = a2 + kstep; const char* b3 = b2 + kstep;
            PG8_LDB(B0, 0, 0); PG8_SCHED; PG8_LDA(At, 0, 0); PG8_STAGE(PG8_SA(1, 1), a1 + hstepA, voffA);
            PG8_WAIT_L(8); PG8_BAR; PG8_WAIT_L(0); PG8_MMA(0, 0, At, B0); PG8_BAR; PG8_SCHED;
            PG8_LDB(B1, 0, 1); PG8_STAGE(PG8_SB(0, 0), b2, voffB);
            PG8_BAR; PG8_WAIT_L(0); PG8_MMA(0, 1, At, B1); PG8_BAR;
            PG8_LDA(At, 0, 1); PG8_STAGE(PG8_SA(0, 0), a2, voffA);
            PG8_BAR; PG8_WAIT_L(0); PG8_MMA(1, 0, At, B0); PG8_BAR; PG8_SCHED;
            PG8_STAGE(PG8_SB(0, 1), b2 + hstepB, voffB);
            PG8_WAIT_V(6); PG8_BAR; PG8_MMA(1, 1, At, B1); PG8_BAR;
            PG8_LDB(B0, 1, 0); PG8_SCHED; PG8_LDA(At, 1, 0); PG8_STAGE(PG8_SA(0, 1), a2 + hstepA, voffA);
            PG8_WAIT_L(8); PG8_BAR; PG8_WAIT_L(0); PG8_MMA(0, 0, At, B0); PG8_BAR; PG8_SCHED;
            PG8_LDB(B1, 1, 1); PG8_STAGE(PG8_SB(1, 0), b3, voffB);
            PG8_BAR; PG8_WAIT_L(0); PG8_MMA(0, 1, At, B1); PG8_BAR;
            PG8_LDA(At, 1, 1); PG8_STAGE(PG8_SA(1, 0), a3, voffA);
            PG8_BAR; PG8_WAIT_L(0); PG8_MMA(1, 0, At, B0); PG8_BAR; PG8_SCHED;
            PG8_STAGE(PG8_SB(1, 1), b3 + hstepB, voffB);
            PG8_WAIT_V(6); PG8_BAR; PG8_MMA(1, 1, At, B1); PG8_BAR;
        }
#ifndef NO_EPI
        epilogue(a, lds, g, acc, cur, wr, wc, fr, fq);
#else
        if (g.mode == 99) *(f32x4*)(g.out) = acc[0][0][0][0] + acc[1][1][3][1] + acc[0][1][2][0]+acc[1][0][1][1];
#endif
        if (!has_next) break;
#pragma unroll
        for (int a = 0; a < 2; ++a)
#pragma unroll
            for (int b = 0; b < 2; ++b)
#pragma unroll
                for (int m = 0; m < 4; ++m)
#pragma unroll
                    for (int n = 0; n < 2; ++n) acc[a][b][m][n] = (f32x4){0.f, 0.f, 0.f, 0.f};
        cur = nxt; cA = nA; cB = nB; ++ui;
    }
    PG8_WAIT_V(0);
    if (wr == 0) PG8_BAR;
    PG8_BAR;
#undef PG8_SA
#undef PG8_SB
#undef PG8_STAGE
#undef PG8_LDA
#undef PG8_LDB
#undef PG8_MMA
#undef PG8_WAIT_V
#undef PG8_WAIT_L
#undef PG8_BAR
#undef PG8_SCHED
}

__device__ __forceinline__ int qk_perm_row(int n) { const int i = n & 63; return (n & ~63) + 8 * ((i & 31) >> 2) + (i & 3) + 4 * (i >> 5); }
__device__ __forceinline__ void transpose_item(const float* W, int K, int N, bf16_t* WT, bool permqk, LAS float* scr, int item, int lane) {
    const int nblk = N / 32, kb = item / nblk, nb = item % nblk, k0 = 64 * kb, n0 = 32 * nb;
#pragma unroll 8
    for (int i = 0; i < 32; ++i) { const int kk = 2 * i + (lane >> 5); scr[kk * 33 + (lane & 31)] = W[(size_t)(k0 + kk) * N + n0 + (lane & 31)]; }
    asm volatile("s_waitcnt lgkmcnt(0)" ::: "memory");
    const int c = lane & 7;
#pragma unroll
    for (int j = 0; j < 4; ++j) { const int n = (lane >> 3) + 8 * j; const LAS float* s = scr + (8 * c) * 33 + n;
        u32x4 o; o.x = cvt_pk_bf16(s[0 * 33], s[1 * 33]); o.y = cvt_pk_bf16(s[2 * 33], s[3 * 33]); o.z = cvt_pk_bf16(s[4 * 33], s[5 * 33]); o.w = cvt_pk_bf16(s[6 * 33], s[7 * 33]);
        int row = n0 + n; if (permqk && row < 2 * QKVW) row = qk_perm_row(row);
        *(u32x4*)(WT + (size_t)row * K + k0 + 8 * c) = o; }
    asm volatile("s_waitcnt lgkmcnt(0)" ::: "memory");
}
__device__ __forceinline__ void reduce_angle(double a, float& c, float& s) {
    const double k = __builtin_rint(a * 0.6366197723675814); const float x = (float)(a - k * 1.5707963267948966), x2 = x * x;
    const float sn = x * (1.0f + x2 * (-1.6666666667e-1f + x2 * (8.3333333333e-3f + x2 * (-1.9841269841e-4f + x2 * 2.7557319224e-6f))));
    const float cs = 1.0f + x2 * (-0.5f + x2 * (4.1666666667e-2f + x2 * (-1.3888888889e-3f + x2 * (2.4801587302e-5f + x2 * -2.7557319224e-7f))));
    const int q = ((int)k) & 3;
    c = (q == 0) ? cs : (q == 1) ? -sn : (q == 2) ? -cs : sn;
    s = (q == 0) ? sn : (q == 1) ? cs : (q == 2) ? -sn : -cs;
}
__device__ __forceinline__ void rms_row_to_bf16(const float* xrow, const float* gw, bf16_t* orow, int lane) {
    const f32x4* xr = (const f32x4*)xrow + lane; const f32x4* gr = (const f32x4*)gw + lane;
    f32x4 v[4]; float s = 0.f;
#pragma unroll
    for (int j = 0; j < 4; ++j) { v[j] = xr[64 * j]; s += (v[j].x * v[j].x + v[j].y * v[j].y) + (v[j].z * v[j].z + v[j].w * v[j].w); }
    const float rstd = 1.0f / sqrtf(wave_sum(s) * (1.f / DM) + EPSN);
    u32x2* o8 = (u32x2*)orow + lane;
#pragma unroll
    for (int j = 0; j < 4; ++j) { const f32x4 gv = gr[64 * j]; u32x2 w; w.x = cvt_pk_bf16(v[j].x * rstd * gv.x, v[j].y * rstd * gv.y); w.y = cvt_pk_bf16(v[j].z * rstd * gv.z, v[j].w * rstd * gv.w); o8[64 * j] = w; }
}

__device__ __forceinline__ void ssm_load_bc(const Args& a, int g, int dir, LAS f32x2* Bb, LAS f32x2* Cc, int tid) {
    const float* lam_re = a.in[4]; const float* lam_im = a.in[5]; const float* log_step = a.in[6];
    const float* b_re = a.in[7]; const float* b_im = a.in[8]; const float* c_re = a.in[9]; const float* c_im = a.in[10];
    const float dt = expf(log_step[dir * 32 + g]);
    for (int idx = tid; idx < 1024; idx += 512) {
        { const int n = idx >> 4; const float lr = lam_re[(dir * 32 + g) * 64 + n], li = lam_im[(dir * 32 + g) * 64 + n];
          const float ar = lr * dt; float cb, sb, ch, sh; reduce_angle((double)li * (double)dt, cb, sb); reduce_angle(0.5 * (double)li * (double)dt, ch, sh);
          const float em1 = expm1f(ar), ea = em1 + 1.0f;
          const float nr = em1 * cb - 2.0f * sh * sh, ni = ea * sb;
          const float den = 1.0f / (lr * lr + li * li); const float cr = (nr * lr + ni * li) * den, ci = (ni * lr - nr * li) * den;
          const float br = b_re[(size_t)((dir * 32 + g) * 64) * 16 + idx], bi = b_im[(size_t)((dir * 32 + g) * 64) * 16 + idx];
          Bb[idx] = (f32x2){cr * br - ci * bi, cr * bi + ci * br}; }
        { Cc[idx] = (f32x2){c_re[(size_t)((dir * 32 + g) * 16) * 64 + idx], c_im[(size_t)((dir * 32 + g) * 16) * 64 + idx]}; }
    }
}
__device__ __forceinline__ void ssm_setup_item(const Args& a, LAS unsigned char* lds, int item, int tid) {
    const int g = item >> 1, dir = item & 1;
    LAS f32x2* pw = (LAS f32x2*)lds; LAS f32x2* Bb = pw + 33 * 64; LAS f32x2* Cc = Bb + 1024;
    LAS float* KT = (LAS float*)(Cc + 1024); LAS float* K0 = KT + 32 * 256; LAS f32x2* Bb0 = (LAS f32x2*)(K0 + 256); LAS f32x2* Cc0 = Bb0 + 1024;
    const float* lam_re = a.in[4]; const float* lam_im = a.in[5]; const float* log_step = a.in[6];
    unsigned char* ws = a.ws;
    const float dt = expf(log_step[dir * 32 + g]);
    __syncthreads();
    for (int idx = tid; idx < 33 * 64; idx += 512) {
        const int tau = idx >> 6, n = idx & 63; const float lr = lam_re[(dir * 32 + g) * 64 + n], li = lam_im[(dir * 32 + g) * 64 + n];
        const float mag = expf(lr * dt * (float)tau); float c, s; reduce_angle((double)li * (double)dt * (double)tau, c, s);
        pw[idx] = (f32x2){mag * c, mag * s};
    }
    ssm_load_bc(a, g, dir, Bb, Cc, tid);
    if (dir == 1) ssm_load_bc(a, g, 0, Bb0, Cc0, tid);
    __syncthreads();
    if (tid < 64) { float* PW = (float*)(ws + WS_PW); const f32x2 p = pw[32 * 64 + tid]; PW[((dir * 32 + g) * 64 + tid) * 2] = p.x; PW[((dir * 32 + g) * 64 + tid) * 2 + 1] = p.y; }
    for (int o = tid; o < 32 * 256; o += 512) {
        const int tau = o >> 8, co = (o >> 4) & 15, ci = o & 15; float acc = 0.f;
_Pragma("unroll 4")
        for (int n = 0; n < 64; ++n) { const f32x2 c = Cc[co * 64 + n], p = pw[tau * 64 + n], b = Bb[n * 16 + ci]; const float tr = c.x * p.x - c.y * p.y, ti = c.x * p.y + c.y * p.x; acc += tr * b.x - ti * b.y; }
        KT[o] = acc; }
    if (dir == 1 && tid < 256) { const int co = tid >> 4, ci = tid & 15; float acc = 0.f;
_Pragma("unroll 4")
        for (int n = 0; n < 64; ++n) { const f32x2 c = Cc0[co * 64 + n], b = Bb0[n * 16 + ci]; acc += c.x * b.x - c.y * b.y; }
        K0[tid] = acc; }
    { bf16_t* BsT = (bf16_t*)(ws + WS_BST) + (size_t)g * 256 * 512;
      for (int ch = tid; ch < 128 * 64; ch += 512) {
          const int row = ch >> 6, part = row >> 6, n = row & 63, kc = ch & 63, s = kc >> 1, ci0 = (kc & 1) * 8; const int e = dir ? s : 31 - s; const f32x2 p = pw[e * 64 + n];
          float v[8];
#pragma unroll
          for (int j = 0; j < 8; ++j) { const f32x2 b = Bb[n * 16 + ci0 + j]; v[j] = part ? (p.x * b.y + p.y * b.x) : (p.x * b.x - p.y * b.y); }
          u32x4 w; w.x = cvt_pk_bf16(v[0], v[1]); w.y = cvt_pk_bf16(v[2], v[3]); w.z = cvt_pk_bf16(v[4], v[5]); w.w = cvt_pk_bf16(v[6], v[7]);
          *(u32x4*)(BsT + (size_t)(dir * 128 + row) * 512 + s * 16 + ci0) = w; } }
    bf16_t* MtC = (bf16_t*)(ws + WS_MTC) + (size_t)g * 512 * UHK;
    { for (int ch = tid; ch < 512 * 16; ch += 512) {
          const int row = ch >> 4, t = row >> 4, co = row & 15, cc = ch & 15, part = cc >> 3, n0 = (cc & 7) * 8; const int e = dir ? 32 - t : t + 1;
          float v[8];
#pragma unroll
          for (int j = 0; j < 8; ++j) { const f32x2 c = Cc[co * 64 + n0 + j], p = pw[e * 64 + n0 + j]; v[j] = part ? -(c.x * p.y + c.y * p.x) : (c.x * p.x - c.y * p.y); }
          u32x4 w; w.x = cvt_pk_bf16(v[0], v[1]); w.y = cvt_pk_bf16(v[2], v[3]); w.z = cvt_pk_bf16(v[4], v[5]); w.w = cvt_pk_bf16(v[6], v[7]);
          *(u32x4*)(MtC + (size_t)row * UHK + 512 + dir * 128 + part * 64 + n0) = w; } }
    __syncthreads();
    { const float* dsk = a.in[11];
      for (int ch = tid; ch < 512 * 64; ch += 512) {
          const int kc = ch & 63, row = ch >> 6; const int s = kc >> 1, ci0 = (kc & 1) * 8, t = row >> 4, co = row & 15;
          if (dir == 0 ? (t > s) : (s >= t)) {
              const int tau = dir == 0 ? t - s : s - t;
              float v[8];
#pragma unroll
              for (int j = 0; j < 8; ++j) v[j] = KT[tau * 256 + co * 16 + ci0 + j];
              if (t == s) { const float dv = dsk[g * 16 + co];
#pragma unroll
                  for (int j = 0; j < 8; ++j) v[j] += K0[co * 16 + ci0 + j] + ((ci0 + j == co) ? dv : 0.f); }
              u32x4 w; w.x = cvt_pk_bf16(v[0], v[1]); w.y = cvt_pk_bf16(v[2], v[3]); w.z = cvt_pk_bf16(v[4], v[5]); w.w = cvt_pk_bf16(v[6], v[7]);
              *(u32x4*)(MtC + (size_t)row * UHK + s * 16 + ci0) = w;
          }
      } }
    __syncthreads();
}

__device__ __forceinline__ void step_setup(const Args& a, LAS unsigned char* lds, int tid, int bx) {
    const int lane = tid & 63, wave = tid >> 6, G = gridDim.x;
    unsigned char* ws = a.ws;
    for (int it = bx; it < 64; it += G) ssm_setup_item(a, lds, it, tid);
    { float* rc = (float*)(ws + WS_ROPE); float* rs = rc + SEQL * 32;
      for (int idx = bx * 512 + tid; idx < SEQL * 32; idx += G * 512) {
          const int pos = idx >> 5, i = idx & 31; double inv = 1.0; for (int k = 0; k < i; ++k) inv *= 0.7498942093324558;
          float c, s; reduce_angle((double)pos * inv, c, s); rc[idx] = c; rs[idx] = s; } }
    { LAS float* scr = (LAS float*)(lds) + wave * (64 * 33);
      const int gw = bx * 8 + wave, NGW = G * 8;
      constexpr int I_IN = (DM / 64) * (INC / 32), I_GLU = (512 / 64) * (512 / 32), I_AB = (512 / 64) * (1024 / 32), I_OUT = (1024 / 64) * (1024 / 32);
      constexpr int NIT = I_IN + I_GLU + 2 * I_AB + I_OUT;
      for (int it = gw; it < NIT; it += NGW) {
          int r = it;
          if (r < I_IN) { transpose_item(a.in[3], DM, INC, (bf16_t*)(ws + WS_WIN), true, scr, r, lane); continue; } r -= I_IN;
          if (r < I_GLU) { transpose_item(a.in[12], 512, 512, (bf16_t*)(ws + WS_WGLU), false, scr, r, lane); continue; } r -= I_GLU;
          if (r < I_AB) { transpose_item(a.in[13], 512, 1024, (bf16_t*)(ws + WS_WA), false, scr, r, lane); continue; } r -= I_AB;
          if (r < I_AB) { transpose_item(a.in[14], 512, 1024, (bf16_t*)(ws + WS_WB), false, scr, r, lane); continue; } r -= I_AB;
          transpose_item(a.in[15], 1024, 1024, (bf16_t*)(ws + WS_WOUT), false, scr, r, lane);
      } }
    { bf16_t* hn = (bf16_t*)((unsigned char*)a.out + OUT_HN_OFF);
      const f32x4* gr = (const f32x4*)a.in[2] + lane;
      f32x4 gv[4];
#pragma unroll
      for (int j = 0; j < 4; ++j) gv[j] = gr[64 * j];
      unsigned* rctr = (unsigned*)(ws + WS_CTL) + 4;
      constexpr int RCH = 16;
      for (;;) {
          unsigned cidx = 0; if (lane == 0) cidx = atomicAdd(rctr, 1u);
          cidx = (unsigned)__builtin_amdgcn_readfirstlane((int)cidx);
          if (cidx >= (unsigned)(TTOK / RCH)) break;
          int row = (int)cidx * RCH; const int rend = row + RCH;
          f32x4 nx[4];
          { const f32x4* xr = (const f32x4*)xrow_ptr(a.in[0], a.in[1], row) + lane;
#pragma unroll
            for (int j = 0; j < 4; ++j) nx[j] = xr[64 * j]; }
          for (; row < rend; ++row) {
              f32x4 v[4];
#pragma unroll
              for (int j = 0; j < 4; ++j) v[j] = nx[j];
              if (row + 1 < rend) { const f32x4* xn = (const f32x4*)xrow_ptr(a.in[0], a.in[1], row + 1) + lane;
#pragma unroll
                  for (int j = 0; j < 4; ++j) nx[j] = xn[64 * j]; }
              float s = 0.f;
#pragma unroll
              for (int j = 0; j < 4; ++j) s += (v[j].x * v[j].x + v[j].y * v[j].y) + (v[j].z * v[j].z + v[j].w * v[j].w);
              const float rstd = 1.0f / sqrtf(wave_sum(s) * (1.f / DM) + EPSN);
              u32x2* o8 = (u32x2*)(hn + (size_t)row * DM) + lane;
#pragma unroll
              for (int j = 0; j < 4; ++j) { u32x2 w; w.x = cvt_pk_bf16(v[j].x * rstd * gv[j].x, v[j].y * rstd * gv[j].y); w.y = cvt_pk_bf16(v[j].z * rstd * gv[j].z, v[j].w * rstd * gv[j].w); o8[64 * j] = w; }
          }
      } }
}

struct KVBuf { bf16x8 kA0, kA1, kB0, kB1; bf16x4 vA[4], vB[4]; };
__device__ __forceinline__ void step_params(int s, int& gi, int& ls) { gi = s < 12 ? 0 : (s < 18 ? 1 : 2); ls = s < 12 ? s : (s < 18 ? s - 12 : s - 18); }
__device__ __forceinline__ void attn_load(KVBuf& b, const bf16_t* Kp, const bf16_t* Vt, int s, int sq, int h, int blk, int r, int lane) {
    int gi, ls; step_params(s, gi, ls);
    const int sh = 2 * gi, Lg = SEQL >> sh, rho = r & ((1 << sh) - 1);
    int uA = ((256 * blk) >> sh) - 64 + 32 * ls, uB = uA + 16;
    if (uA < 0 || uA >= Lg) uA = 0; if (uB < 0 || uB >= Lg) uB = 0;
    const int kl = lane & 15, quad = lane >> 4;
    const bf16_t* kh = Kp + (size_t)(sq * 24 + gi * 8 + h) * SEQL * 64 + quad * 128 + kl * 8;
    const bf16_t* ka = kh + (size_t)((rho * Lg + uA) >> 4) * 1024; const bf16_t* kb = kh + (size_t)((rho * Lg + uB) >> 4) * 1024;
    b.kA0 = *(const bf16x8*)ka; b.kA1 = *(const bf16x8*)(ka + 512); b.kB0 = *(const bf16x8*)kb; b.kB1 = *(const bf16x8*)(kb + 512);
    const bf16_t* vbase = Vt + (size_t)(((sq * 3 + gi) * 8 + h) * 512) * 1024 + quad * 64 + kl * 4;
    const bf16_t* va = vbase + (size_t)((rho * Lg + uA) >> 4) * 1024; const bf16_t* vb = vbase + (size_t)((rho * Lg + uB) >> 4) * 1024;
#pragma unroll
    for (int dt = 0; dt < 4; ++dt) { b.vA[dt] = *(const bf16x4*)(va + dt * 256); b.vB[dt] = *(const bf16x4*)(vb + dt * 256); }
}
struct QF { bf16x8 a0, a1, b0, b1, c0, c1; };
template <int gi>
__device__ __forceinline__ void attn_compute(const KVBuf& b, const bf16x8 q0, const bf16x8 q1, f32x4 (&o)[4], float& mrun, float& lrun, int s, int blk, int r, int lane) {
    const int ls = gi == 0 ? s : (gi == 1 ? s - 12 : s - 18);
    const int sh = 2 * gi, Lg = SEQL >> sh;
    const int uA = ((256 * blk) >> sh) - 64 + 32 * ls;
    const int qi = lane & 15, quad = lane >> 4;
    const int uq = (256 * blk + r + 16 * qi) >> sh;
    const int lo = max(0, uq - 64), hi = min(Lg - 1, uq + 64);
    f32x4 sA = (f32x4){0.f, 0.f, 0.f, 0.f}, sB = sA;
    sA = __builtin_amdgcn_mfma_f32_16x16x32_bf16(b.kA0, q0, sA, 0, 0, 0); sA = __builtin_amdgcn_mfma_f32_16x16x32_bf16(b.kA1, q1, sA, 0, 0, 0);
    sB = __builtin_amdgcn_mfma_f32_16x16x32_bf16(b.kB0, q0, sB, 0, 0, 0); sB = __builtin_amdgcn_mfma_f32_16x16x32_bf16(b.kB1, q1, sB, 0, 0, 0);
    const float NEGINF = -__builtin_inff();
    const unsigned span = (unsigned)(hi - lo);
    float mx = NEGINF;
#pragma unroll
    for (int j = 0; j < 4; ++j) {
        const int ua = uA + quad * 4 + j, ub = ua + 16;
        sA[j] = ((unsigned)(ua - lo) <= span) ? sA[j] : NEGINF; sB[j] = ((unsigned)(ub - lo) <= span) ? sB[j] : NEGINF;
        mx = fmaxf(mx, fmaxf(sA[j], sB[j]));
    }
    mx = fmaxf(mx, __shfl_xor(mx, 16)); mx = fmaxf(mx, __shfl_xor(mx, 32));
    const float mnew = fmaxf(mrun, mx), alpha = __builtin_amdgcn_exp2f(mrun - mnew);
    mrun = mnew;
    float ps = 0.f;
#pragma unroll
    for (int j = 0; j < 4; ++j) { sA[j] = __builtin_amdgcn_exp2f(sA[j] - mnew); sB[j] = __builtin_amdgcn_exp2f(sB[j] - mnew); ps += sA[j] + sB[j]; }
    lrun = lrun * alpha + ps;
    u32x4 pw; pw.x = cvt_pk_bf16(sA[0], sA[1]); pw.y = cvt_pk_bf16(sA[2], sA[3]); pw.z = cvt_pk_bf16(sB[0], sB[1]); pw.w = cvt_pk_bf16(sB[2], sB[3]);
    const bf16x8 pf = __builtin_bit_cast(bf16x8, pw);
#pragma unroll
    for (int dt = 0; dt < 4; ++dt) {
        o[dt] *= alpha;
        bf16x8 vf; vf[0] = b.vA[dt][0]; vf[1] = b.vA[dt][1]; vf[2] = b.vA[dt][2]; vf[3] = b.vA[dt][3]; vf[4] = b.vB[dt][0]; vf[5] = b.vB[dt][1]; vf[6] = b.vB[dt][2]; vf[7] = b.vB[dt][3];
#ifdef DBG_ATT2
        for (int e = 0; e < 8; ++e) o[dt][e & 3] += 1e-3f * __uint_as_float(((unsigned)(unsigned short)vf[e]) << 16);
#else
        o[dt] = __builtin_amdgcn_mfma_f32_16x16x32_bf16(vf, pf, o[dt], 0, 0, 0);
#endif
    }
}
__device__ __forceinline__ void step_attention(const Args& a, LAS unsigned char* lds, int pass, int tid, int bx) {
    unsigned char* ws = a.ws;
    const int lane = tid & 63;
    const bf16_t* Qp = (const bf16_t*)(ws + WS_Q); const bf16_t* Kp = (const bf16_t*)(ws + WS_K); const bf16_t* Vt = (const bf16_t*)(ws + WS_VT);
    const bf16_t* ZA = (const bf16_t*)(ws + WS_ZA); bf16_t* GAO = (bf16_t*)(ws + WS_GAO);
    const int xcd = bx & 7;
    unsigned* ctr = (unsigned*)(ws + WS_CTL) + 16 + pass * 8 + xcd;
    LAS unsigned* slot = (LAS unsigned*)(lds + 3 * 8192);
    constexpr int NGRP = 3 * 32 * 2;
    for (;;) {
        __syncthreads();
        if (tid == 0) slot[0] = atomicAdd(ctr, 1u);
        __syncthreads();
        const unsigned grp = (unsigned)__builtin_amdgcn_readfirstlane((int)slot[0]);
        if (grp >= (unsigned)NGRP) break;
        const int wv_ = tid >> 6; const int r = ((wv_ & 3) << 2) + (wv_ >> 2) + 2 * (int)(grp & 1)  , blk = (grp >> 1) & 31, pair = xcd * 3 + (int)(grp >> 6);
        const int h = pair & 7, sq = pair >> 3;
        const int qi = lane & 15, quad = lane >> 4;
        const int tq = sq * SEQL + 256 * blk + r + 16 * qi;
        QF qf;
        { const int pos = 256 * blk + r + 16 * qi;
          const bf16_t* qa = Qp + ((size_t)(sq * 24 + h) * SEQL + pos) * 64 + quad * 8;
          const bf16_t* qb = Qp + ((size_t)(sq * 24 + 8 + h) * SEQL + (pos & 3) * 2048 + (pos >> 2)) * 64 + quad * 8;
          const bf16_t* qc = Qp + ((size_t)(sq * 24 + 16 + h) * SEQL + (pos & 15) * 512 + (pos >> 4)) * 64 + quad * 8;
          qf.a0 = *(const bf16x8*)qa; qf.a1 = *(const bf16x8*)(qa + 32); qf.b0 = *(const bf16x8*)qb; qf.b1 = *(const bf16x8*)(qb + 32); qf.c0 = *(const bf16x8*)qc; qf.c1 = *(const bf16x8*)(qc + 32); }
        f32x4 o[4];
#pragma unroll
        for (int dt = 0; dt < 4; ++dt) o[dt] = (f32x4){0.f, 0.f, 0.f, 0.f};
        float mrun = -1e30f, lrun = 0.f;
        KVBuf b0, b1;
#define ATT_SB __builtin_amdgcn_sched_barrier(0);
        {
            const int wv = tid >> 6, region = wv >> 1;
            const bf16_t* gsrc = (region < 2 ? Kp + (size_t)(sq * 24 + h) * SEQL * 64 : Vt + (size_t)((sq * 3) * 8 + h) * 512 * 1024) + (wv & 1) * 512 + lane * 8;
            const int ubase = 256 * blk - 64 + (region & 1) * 16;
#define ATT_DMA(S) do { int uT = ubase + 32 * (S); if (uT < 0 || uT >= SEQL) uT = 0; \
                __builtin_amdgcn_global_load_lds((const unsigned*)(gsrc + (size_t)(uT >> 4) * 1024), (LAS unsigned*)(lds + ((S) % 3) * 8192 + wv * 1024), 16, 0, 0); } while (0)
            ATT_DMA(0); ATT_DMA(1);
            const int kl = lane & 15;
            const unsigned foff = (unsigned)(quad * 256 + kl * 16), voff = (unsigned)(4096 + quad * 128 + kl * 8);
#pragma unroll 1
            for (int s = 0; s < 12; ++s) {
                if (s < 11) asm volatile("s_waitcnt vmcnt(1)" ::: "memory"); else asm volatile("s_waitcnt vmcnt(0)" ::: "memory");
                __syncthreads();
                if (s + 2 < 12) ATT_DMA(s + 2);
                LAS unsigned char* kb = lds + (s % 3) * 8192;
                b0.kA0 = *(const LAS bf16x8*)(kb + foff); b0.kA1 = *(const LAS bf16x8*)(kb + foff + 1024); b0.kB0 = *(const LAS bf16x8*)(kb + 2048 + foff); b0.kB1 = *(const LAS bf16x8*)(kb + 2048 + foff + 1024);
#pragma unroll
                for (int dt = 0; dt < 4; ++dt) { b0.vA[dt] = *(const LAS bf16x4*)(kb + voff + dt * 512); b0.vB[dt] = *(const LAS bf16x4*)(kb + 2048 + voff + dt * 512); }
                attn_compute<0>(b0, qf.a0, qf.a1, o, mrun, lrun, s, blk, r, lane);
            }
#undef ATT_DMA
        }
        attn_load(b0, Kp, Vt, 12, sq, h, blk, r, lane);
#define ATT_LOOP(GI, S0, S1, QA, QB) _Pragma("unroll 1") for (int s = S0; s < S1; s += 2) { \
            ATT_SB attn_load(b1, Kp, Vt, s + 1, sq, h, blk, r, lane); ATT_SB attn_compute<GI>(b0, QA, QB, o, mrun, lrun, s, blk, r, lane); \
            ATT_SB attn_load(b0, Kp, Vt, s + 2, sq, h, blk, r, lane); ATT_SB attn_compute<GI>(b1, QA, QB, o, mrun, lrun, s + 1, blk, r, lane); ATT_SB }
        ATT_LOOP(1, 12, 18, qf.b0, qf.b1)
        ATT_LOOP(2, 18, 22, qf.c0, qf.c1)
#undef ATT_LOOP
        attn_compute<2>(b0, qf.c0, qf.c1, o, mrun, lrun, 22, blk, r, lane);
        float l = lrun; l += __shfl_xor(l, 16); l += __shfl_xor(l, 32);
        float inv = 1.0f / l;
#ifdef DBG_ATT1
        for (int dt = 0; dt < 4; ++dt) o[dt] = (f32x4){1.f, 1.f, 1.f, 1.f};
#endif
#pragma unroll
        for (int dt = 0; dt < 4; ++dt) {
            const size_t off = (size_t)tq * 512 + h * 64 + 16 * dt + 4 * quad;
            const u32x2 z = *(const u32x2*)(ZA + off);
            u32x2 w; w.x = cvt_pk_bf16(o[dt][0] * inv * bf_lo(z.x), o[dt][1] * inv * bf_hi(z.x)); w.y = cvt_pk_bf16(o[dt][2] * inv * bf_lo(z.y), o[dt][3] * inv * bf_hi(z.y));
            *(u32x2*)(GAO + off) = w;
        }
    }
}

__device__ __forceinline__ f32x2 cmul(f32x2 a, f32x2 b) { return (f32x2){a.x * b.x - a.y * b.y, a.x * b.y + a.y * b.x}; }
__device__ __forceinline__ void step_scan(const Args& a, LAS unsigned char* lds, int pass, int tid, int bx) {
    unsigned char* ws = a.ws; const int G = gridDim.x;
    const float* PW = (const float*)(ws + WS_PW); const float* S = (const float*)(ws + WS_S); bf16_t* UH = (bf16_t*)(ws + WS_UH);
    LAS f32x2* carry = (LAS f32x2*)lds;
    for (int it = bx; it < SEQP * 32 * 2; it += G) {
        const int dir = it & 1, g = (it >> 1) & 31, sq = it >> 6; const int seg = tid >> 6, n = tid & 63;
        const f32x2 P = (f32x2){PW[((dir * 32 + g) * 64 + n) * 2], PW[((dir * 32 + g) * 64 + n) * 2 + 1]};
        f32x2 z[32];
        { const int c0 = dir ? (NCH - 1 - seg * 32) : seg * 32; const long stp = dir ? -256 : 256;
          const float* sp = S + ((size_t)g * CHP + sq * NCH + c0) * 256 + dir * 128 + n;
#pragma unroll
          for (int i = 0; i < 32; ++i) { z[i] = (f32x2){sp[0], sp[64]}; sp += stp; } }
        f32x2 zz = (f32x2){0.f, 0.f};
#pragma unroll
        for (int i = 0; i < 32; ++i) { const f32x2 t = z[i]; z[i] = zz; zz = cmul(P, zz) + t; }
        __syncthreads();
        carry[seg * 64 + n] = zz;
        __syncthreads();
        f32x2 P32 = P;
#pragma unroll
        for (int k = 0; k < 5; ++k) P32 = cmul(P32, P32);
        f32x2 x = (f32x2){0.f, 0.f};
        for (int sp = 0; sp < seg; ++sp) x = cmul(P32, x) + carry[sp * 64 + n];
        f32x2 pwr = (f32x2){1.f, 0.f};
        { const int c0 = dir ? (NCH - 1 - seg * 32) : seg * 32; const long stp = dir ? -(long)UHK : (long)UHK;
          bf16_t* up = UH + ((size_t)g * CHP + sq * NCH + c0) * UHK + 512 + dir * 128 + n;
#pragma unroll
          for (int i = 0; i < 32; ++i) {
              const f32x2 hin = z[i] + cmul(pwr, x);
              up[0] = (bf16_t)(cvt_pk_bf16(hin.x, 0.f) & 0xffffu); up[64] = (bf16_t)(cvt_pk_bf16(hin.y, 0.f) & 0xffffu);
              pwr = cmul(pwr, P); up += stp;
          } }
    }
}

__device__ __forceinline__ void step_final_norm(const Args& a, int pass, int tid, int bx) {
    const int lane = tid & 63, wave = tid >> 6, G = gridDim.x;
    const f32x4* gr = (const f32x4*)a.in[16] + lane;
    f32x4 gv[4];
#pragma unroll
    for (int j = 0; j < 4; ++j) gv[j] = gr[64 * j];
    int row = bx * 8 + wave;
    f32x4 nx[4];
    if (row < TP) { const f32x4* xr = (const f32x4*)(a.out + (size_t)(pass * TP + row) * DM) + lane;
#pragma unroll
        for (int j = 0; j < 4; ++j) nx[j] = xr[64 * j]; }
    for (; row < TP; row += G * 8) {
        f32x4 v[4];
#pragma unroll
        for (int j = 0; j < 4; ++j) v[j] = nx[j];
        const int nrow = row + G * 8;
        if (nrow < TP) { const f32x4* xn = (const f32x4*)(a.out + (size_t)(pass * TP + nrow) * DM) + lane;
#pragma unroll
            for (int j = 0; j < 4; ++j) nx[j] = xn[64 * j]; }
        float s = 0.f;
#pragma unroll
        for (int j = 0; j < 4; ++j) s += (v[j].x * v[j].x + v[j].y * v[j].y) + (v[j].z * v[j].z + v[j].w * v[j].w);
        const float rstd = 1.0f / sqrtf(wave_sum(s) * (1.f / DM) + EPSN);
        f32x4* xr = (f32x4*)(a.out + (size_t)(pass * TP + row) * DM) + lane;
#pragma unroll
        for (int j = 0; j < 4; ++j) xr[64 * j] = v[j] * rstd * gv[j];
    }
}


#define XB_TMO      128
#define XB_XCNT(j)  (256  + 64 * (j))
#define XB_XSUB(j)  (1280 + 64 * (j))
#define XB_XGEN(j)  (2304 + 64 * (j))
#define XB_TOP      3328
#define XB_TOPGEN   3392
#define XCD_BAR_WORDS 3456
#define XB_SLOT(b)  (4096 + 2 * (b))
#define XB_SPIN_CAP (1u << 18)
__device__ __forceinline__ unsigned xb_ld(unsigned* p)              { return __hip_atomic_load(p, __ATOMIC_RELAXED, __HIP_MEMORY_SCOPE_AGENT); }
__device__ __forceinline__ unsigned xb_add(unsigned* p, unsigned v) { return __hip_atomic_fetch_add(p, v, __ATOMIC_RELAXED, __HIP_MEMORY_SCOPE_AGENT); }
__device__ __forceinline__ unsigned xb_xcc_id() { return (unsigned)__builtin_amdgcn_s_getreg((3 << 11) | 20) & 0xFu; }
#define XB_SPIN(cond, bar) do { unsigned _sp = 0; while (cond) { __builtin_amdgcn_s_sleep(1); \
    if ((++_sp & 255u) == 0u) { if (xb_ld(&(bar)[XB_TMO])) break; if (_sp > XB_SPIN_CAP) { atomicAdd(&(bar)[XB_TMO], 1u); break; } } } } while (0)
__device__ __forceinline__ void xcd_barrier_complete(unsigned* bar, unsigned x, unsigned& nloc, unsigned& nx) {
    const unsigned G = gridDim.x;
    unsigned sum, cnt, mine, sp = 0u;
    for (;;) {
        sum = 0u; cnt = 0u; mine = 0u;
#pragma unroll
        for (unsigned j = 0; j < 16; ++j) { const unsigned c = xb_ld(&bar[XB_XCNT(j)]); sum += c; cnt += (c > 0u) ? 1u : 0u; mine = (j == x) ? c : mine; }
        if (sum == G) break;
        __builtin_amdgcn_s_sleep(1);
        if ((++sp & 255u) == 0u) { if (xb_ld(&bar[XB_TMO])) break; if (sp > XB_SPIN_CAP) { atomicAdd(&bar[XB_TMO], 1u); break; } }
    }
    nloc = mine > 0u ? mine : 1u; nx = cnt > 0u ? cnt : 1u;
}
__device__ __forceinline__ void xcd_barrier(unsigned* bar) {
    asm volatile("s_waitcnt vmcnt(0)" ::: "memory");
    __syncthreads();
    if (threadIdx.x == 0) {
        __builtin_amdgcn_s_waitcnt(0);
        const unsigned x = xb_xcc_id();
        unsigned* slot = bar + XB_SLOT(blockIdx.x);
        unsigned nloc = xb_ld(slot), nx = xb_ld(slot + 1);
        if (nloc == 0u) { xcd_barrier_complete(bar, x, nloc, nx); __hip_atomic_store(slot, nloc, __ATOMIC_RELAXED, __HIP_MEMORY_SCOPE_AGENT); __hip_atomic_store(slot + 1, nx, __ATOMIC_RELAXED, __HIP_MEMORY_SCOPE_AGENT); }
        const unsigned old = xb_add(&bar[XB_XSUB(x)], 1u);
        const unsigned gen = old / nloc;
        if (old + 1u == (gen + 1u) * nloc) {
            __builtin_amdgcn_fence(__ATOMIC_RELEASE, "agent");
            asm volatile("s_waitcnt vmcnt(0)" ::: "memory");
            const unsigned og = xb_add(&bar[XB_TOP], 1u);
            const unsigned tg = og / nx;
            if (og + 1u == (tg + 1u) * nx) xb_add(&bar[XB_TOPGEN], 1u);
            else XB_SPIN(xb_ld(&bar[XB_TOPGEN]) == tg, bar);
            __builtin_amdgcn_fence(__ATOMIC_ACQUIRE, "agent");
            xb_add(&bar[XB_XGEN(x)], 1u);
            asm volatile("s_waitcnt vmcnt(0)" ::: "memory");
        } else {
            XB_SPIN(xb_ld(&bar[XB_XGEN(x)]) == gen, bar);
            __builtin_amdgcn_fence(__ATOMIC_ACQUIRE, "agent");
            asm volatile("s_waitcnt vmcnt(0)" ::: "memory");
        }
    }
    __syncthreads();
}

constexpr int NSTEPS = 1 + 10 * NPASS;
__host__ __device__ __forceinline__ bool sync_after(int st) { if (st == 0) return true; const int k = (st - 1) % 10; return !(k == 1 || k == 6 || k == 9); }

__global__ void __launch_bounds__(512, 2) fwd_kernel(Args a) {
    extern __shared__ __attribute__((aligned(16))) unsigned char lds_raw[];
    LAS unsigned char* lds = (LAS unsigned char*)lds_raw;
    cg::grid_group grid = cg::this_grid();
    const int G = gridDim.x;
    unsigned char* ws = a.ws;
    unsigned* bar = (unsigned*)(ws + WS_BAR);
    if (a.do_sync == 2) grid.sync();
    if (a.do_sync && threadIdx.x == 0) (void)xb_add(&bar[XB_XCNT(xb_xcc_id())], 1u);
    for (int st = a.st_lo; st < a.st_hi; ++st) {
        int tid = threadIdx.x, bx = blockIdx.x;
        asm volatile("" : "+v"(tid), "+s"(bx));
#ifndef NO_SETUP
        if (st == 0) { step_setup(a, lds, tid, bx); }
#else
        if (st == 0) {}
#endif
        else {
            const int pass = (st - 1) / 10, k = (st - 1) % 10;
            GemmD g; g.lgnN = 0; g.pass = pass; g.nb = 1; g.sA = 0; g.sB = 0;
            bool has_gemm = true;
            const bool split_ay = (G == 256);
            switch (k) {
            case 0: g.A = (const bf16_t*)((unsigned char*)a.out + OUT_HN_OFF) + (size_t)pass * TP * DM; g.lda = DM; g.Bt = (const bf16_t*)(ws + WS_WIN); g.ldb = DM; g.K = DM; g.nM = TP / BM; g.nN = INC / BM; g.lgnN = 5; g.mode = MODE_PROJ; break;
            case 1: g.A = (const bf16_t*)(ws + WS_UH); g.lda = UHK; g.sA = (unsigned)(CHP * UHK * 2); g.Bt = (const bf16_t*)(ws + WS_BST); g.ldb = 512; g.sB = (unsigned)(256 * 512 * 2); g.K = 512; g.nM = CHP / BM; g.nN = 1; g.nb = 32; g.mode = MODE_S; break;
            case 4:
                if (split_ay && bx < 128) { g.A = (const bf16_t*)(ws + WS_GAO); g.lda = 512; g.Bt = (const bf16_t*)(ws + WS_WA); g.ldb = 512; g.K = 512; g.nM = TP / BM; g.nN = 4; g.lgnN = 2; g.mode = MODE_A; }
                else { g.A = (const bf16_t*)(ws + WS_UH); g.lda = UHK; g.sA = (unsigned)(CHP * UHK * 2); g.Bt = (const bf16_t*)(ws + WS_MTC); g.ldb = UHK; g.sB = (unsigned)(512 * UHK * 2); g.K = UHK; g.nM = CHP / BM; g.nN = 2; g.nb = 32; g.mode = MODE_Y; }
                break;
            case 5: g.A = (const bf16_t*)(ws + WS_SG); g.lda = 512; g.Bt = (const bf16_t*)(ws + WS_WGLU); g.ldb = 512; g.K = 512; g.nM = TP / BM; g.nN = 2; g.lgnN = 1; g.mode = MODE_GLU; break;
            case 6: if (split_ay) { has_gemm = false; g.A = nullptr; g.Bt = nullptr; g.lda = g.ldb = g.K = 0; g.nM = g.nN = 0; g.mode = 0; } else { g.A = (const bf16_t*)(ws + WS_GAO); g.lda = 512; g.Bt = (const bf16_t*)(ws + WS_WA); g.ldb = 512; g.K = 512; g.nM = TP / BM; g.nN = 4; g.lgnN = 2; g.mode = MODE_A; } break;
            case 7: g.A = (const bf16_t*)(ws + WS_SB); g.lda = 512; g.Bt = (const bf16_t*)(ws + WS_WB); g.ldb = 512; g.K = 512; g.nM = TP / BM; g.nN = 4; g.lgnN = 2; g.mode = MODE_B; break;
            case 8: g.A = (const bf16_t*)(ws + WS_M1); g.lda = 1024; g.Bt = (const bf16_t*)(ws + WS_WOUT); g.ldb = 1024; g.K = 1024; g.nM = TP / BM; g.nN = 4; g.lgnN = 2; g.mode = MODE_OUT; break;
            default: has_gemm = false; g.A = nullptr; g.Bt = nullptr; g.lda = g.ldb = g.K = 0; g.nM = g.nN = 0; g.mode = 0; break;
            }
            { const int total = g.nM * g.nN * g.nb; g.u0 = bx; g.ustride = G; g.ucount = total > bx ? (total - bx + G - 1) / G : 0; }
            if (k == 4 && split_ay) { if (bx < 128) { g.u0 = bx; g.ustride = 128; g.ucount = 3; } else { g.u0 = bx - 128; g.ustride = 128; g.ucount = (bx - 128) < 64 ? 2 : 1; } }
            if (has_gemm) {
#ifndef NO_GEMM
                gemm_phase(a, lds, g, G, bx, tid);
#endif
            }
#ifndef NO_ATTN
            else if (k == 2) step_attention(a, lds, pass, tid, bx);
#endif
#ifndef NO_SCAN
            else if (k == 3) step_scan(a, lds, pass, tid, bx);
#endif
            else if (k == 9) step_final_norm(a, pass, tid, bx);
        }
        if (a.do_sync && st + 1 < a.st_hi && sync_after(st)) xcd_barrier(bar);
    }
}

extern "C" void kernel_launch(void* const* d_in, const int* in_sizes, int n_in, void* d_out, int out_size, void* d_ws, size_t ws_size, hipStream_t stream) {
    constexpr int LDS_BYTES = STAGE_BYTES + 32768;
    static int grid = 0;
    if (grid == 0) {
        if (n_in != 17 || out_size != TTOK * DM || ws_size < WS_END) { fprintf(stderr, "kernel_launch: unexpected shapes (n_in %d out %d ws %zu need %zu)\n", n_in, out_size, ws_size, (size_t)WS_END); grid = -1; return; }
        int dev = 0, cus = 0, per_cu = 0;
        hipGetDevice(&dev); hipDeviceGetAttribute(&cus, hipDeviceAttributeMultiprocessorCount, dev);
        hipFuncSetAttribute((const void*)fwd_kernel, hipFuncAttributeMaxDynamicSharedMemorySize, LDS_BYTES);
        hipOccupancyMaxActiveBlocksPerMultiprocessor(&per_cu, (const void*)fwd_kernel, 512, LDS_BYTES);
        if (per_cu < 1) per_cu = 1;
        grid = cus * 1;
        (void)hipGetLastError();
    }
    if (grid < 0) return;
    (void)hipMemsetAsync((unsigned char*)d_ws + WS_CTL, 0, 4096, stream);
    (void)hipMemsetAsync((unsigned char*)d_ws + WS_BAR, 0, WS_BAR_BYTES, stream);
    Args a{};
    for (int i = 0; i < 17; ++i) a.in[i] = (const float*)d_in[i];
    a.out = (float*)d_out; a.ws = (unsigned char*)d_ws; a.pad = 0;
#ifndef MULTI_LAUNCH
#define MULTI_LAUNCH 0
#endif
#if MULTI_LAUNCH
    a.do_sync = 0;
    for (int st = 0; st < NSTEPS; ++st) {
        a.st_lo = st; a.st_hi = st + 1;
        hipLaunchKernelGGL(fwd_kernel, dim3(grid), dim3(512), LDS_BYTES, stream, a);
    }
#else
    a.do_sync = 1; a.st_lo = 0; a.st_hi = NSTEPS;
    void* args[] = {&a};
    hipError_t e = hipLaunchCooperativeKernel((const void*)fwd_kernel, dim3(grid), dim3(512), args, LDS_BYTES, stream);
    if (e != hipSuccess) fprintf(stderr, "cooperative launch failed: %s (grid %d)\n", hipGetErrorString(e), grid);
#endif
}
```

```cpp
#include <hip/hip_runtime.h>
#include <hip/hip_cooperative_groups.h>
#include <cstdio>

namespace cg = cooperative_groups;

#define LAS __attribute__((address_space(3)))
typedef unsigned short bf16_t;
typedef short bf16x8 __attribute__((ext_vector_type(8)));
typedef short bf16x4 __attribute__((ext_vector_type(4)));
typedef float f32x4 __attribute__((ext_vector_type(4)));
typedef float f32x2 __attribute__((ext_vector_type(2)));
typedef unsigned u32x4 __attribute__((ext_vector_type(4)));
typedef unsigned u32x2 __attribute__((ext_vector_type(2)));

constexpr int DM = 1024, SEQL = 8192, NSEQ = 6, TTOK = NSEQ * SEQL;
constexpr int NPASS = 2, SEQP = 3, TP = SEQP * SEQL;
constexpr int INC = 8192, QKVW = 1536;
constexpr int LC = 32, NCH = SEQL / LC  , CHP = SEQP * NCH  ;
constexpr int UHK = LC * 16 + 256;
constexpr float EPSN = 1e-6f;
constexpr float QSCALE = 0.18033688011112042f;

constexpr size_t AL(size_t x) { return (x + 255) & ~(size_t)255; }
constexpr size_t WS_CTL = 0;
constexpr size_t WS_WIN = 4096;
constexpr size_t WS_WGLU = WS_WIN + (size_t)INC * DM * 2;
constexpr size_t WS_WA = WS_WGLU + (size_t)512 * 512 * 2;
constexpr size_t WS_WB = WS_WA + (size_t)1024 * 512 * 2;
constexpr size_t WS_WOUT = WS_WB + (size_t)1024 * 512 * 2;
constexpr size_t WS_MTC = WS_WOUT + (size_t)1024 * 1024 * 2;
constexpr size_t WS_BST = WS_MTC + (size_t)32 * 512 * UHK * 2;
constexpr size_t WS_ROPE = WS_BST + (size_t)32 * 256 * 512 * 2;
constexpr size_t WS_PW = WS_ROPE + (size_t)2 * SEQL * 32 * 4;
constexpr size_t WS_KT = WS_PW + (size_t)2 * 32 * 64 * 8;
constexpr size_t WS_Q = WS_KT + (size_t)32 * 2 * 32 * 256 * 4;
constexpr size_t WS_K = WS_Q + (size_t)TP * QKVW * 2;
constexpr size_t WS_VT = WS_K + (size_t)TP * QKVW * 2;
constexpr size_t WS_ZA = WS_VT + (size_t)TP * QKVW * 2;
constexpr size_t WS_ZB = WS_ZA + (size_t)TP * 512 * 2;
constexpr size_t WS_GA = WS_ZB + (size_t)TP * 512 * 2;
constexpr size_t WS_GB = WS_GA + (size_t)TP * 1024 * 2;
constexpr size_t WS_UH = WS_GB + (size_t)TP * 1024 * 2;
constexpr size_t WS_S = WS_UH + (size_t)32 * CHP * UHK * 2;
constexpr size_t WS_GAO = WS_S + (size_t)32 * CHP * 256 * 4;
constexpr size_t WS_BAR = WS_GAO + (size_t)TP * 512 * 2;
constexpr size_t WS_BAR_BYTES = 32768;
constexpr size_t WS_END = WS_BAR + WS_BAR_BYTES;
constexpr size_t WS_SG = WS_Q;
constexpr size_t WS_SB = WS_Q + (size_t)TP * 512 * 2;
constexpr size_t WS_M1 = WS_K;
constexpr size_t WS_ACC = WS_Q;
constexpr size_t OUT_HN_OFF = (size_t)SEQP * SEQL * DM * 4;

struct Args {
    const float* in[17];
    float* out;
    unsigned char* ws;
    int st_lo, st_hi;
    int do_sync, pad;
};

typedef __bf16 bf16v2 __attribute__((ext_vector_type(2)));
__device__ __forceinline__ unsigned cvt_pk_bf16(float lo, float hi) { const f32x2 v = (f32x2){lo, hi}; const bf16v2 r = __builtin_convertvector(v, bf16v2); return __builtin_bit_cast(unsigned, r); }
__device__ __forceinline__ float bf_lo(unsigned w) { return __uint_as_float(w << 16); }
__device__ __forceinline__ float bf_hi(unsigned w) { return __uint_as_float(w & 0xffff0000u); }
__device__ __forceinline__ float fast_rcp(float x) { return __builtin_amdgcn_rcpf(x); }
__device__ __forceinline__ float sigmoidf_(float x) { return fast_rcp(1.0f + __builtin_amdgcn_exp2f(-1.4426950408889634f * x)); }
__device__ __forceinline__ float siluf_(float x) { return x * sigmoidf_(x); }
__device__ __forceinline__ float gelu_tanh(float x) { const float u = x * (1.5957691216057308f + 0.07135481627260025f * x * x); return x * sigmoidf_(u); }
__device__ __forceinline__ float wave_sum(float v) {
#pragma unroll
    for (int o = 1; o < 64; o <<= 1) v += __shfl_xor(v, o);
    return v;
}
__device__ __forceinline__ const float* xrow_ptr(const float* xp, const float* xs, int tg) {
    return tg < 4 * SEQL ? xp + (size_t)tg * DM : xs + (size_t)(tg - 4 * SEQL) * DM;
}

constexpr int BM = 256, BK = 64, HALF = 128, HTB = HALF * BK * 2, STAGE_BYTES = 8 * HTB, NXCD = 8, WGM = 8;
__host__ __device__ __forceinline__ int lds_byte(int r, int c) { const int st = (r >> 4) * 2 + (c >> 5), rr = r & 15, cc = c & 31, ob = rr * 64 + cc * 2; return st * 1024 + (ob ^ (((ob >> 9) & 1) << 5)); }
__host__ __device__ __forceinline__ void stage_rc(int b, int& R, int& C) { const int st = b / 1024, sb = b % 1024, swz = sb ^ (((sb >> 9) & 1) << 5); R = (st >> 1) * 16 + swz / 64; C = (st & 1) * 32 + (swz % 64) / 2; }
__host__ __device__ __forceinline__ int perm32(int rho) { const int n = rho >> 4, i = rho & 15; return 8 * (i >> 2) + 4 * n + (i & 3); }

enum { MODE_PROJ = 0, MODE_S = 1, MODE_Y = 2, MODE_GLU = 3, MODE_A = 4, MODE_B = 5, MODE_OUT = 6 };
struct Unit { int pm, pn, bz; };
struct GemmD {
    const bf16_t* A; const bf16_t* Bt;
    int lda, ldb, K, nM, nN, nb;
    unsigned sA, sB;
    int mode, pass, lgnN;
    int u0, ustride, ucount;
};
__device__ __forceinline__ bool unit_next(const GemmD& g, int i, int G, int c, int& pm, int& pn, int& bz) {
    const bool ok = i < g.ucount;
    const int Li = ok ? g.u0 + i * g.ustride : 0;
    if (g.nb == 1) {
        const int lg = g.lgnN, q = (g.nM << lg) >> 3;
        const int wgid = (Li & 7) * q + (Li >> 3);
        const int gid = wgid >> (3 + lg), rem = wgid & ((8 << lg) - 1);
        pm = gid * 8 + (rem & 7); pn = rem >> 3; bz = 0;
    } else {
        const int nwg = g.nM * g.nN;
        const int w = Li % nwg; bz = Li / nwg; pm = w % g.nM; pn = w / g.nM;
    }
    return ok;
}

__device__ __forceinline__ void epilogue(const Args& a, LAS unsigned char* lds, const GemmD& g, const f32x4 (&acc)[2][2][4][2], const Unit& u, int wr, int wc, int fr, int fq) {
    asm volatile("" : "+v"(fr), "+v"(fq));
    unsigned char* ws = a.ws;
    const int rbase = u.pm * BM + wr * 64 + fr;
    const int cl = wc * 32 + fq * 8;
    if (g.mode == MODE_PROJ) {
        const int pn = u.pn;
        if (pn < 12) {
            const bool isq = pn < 6;
            bf16_t* dst = (bf16_t*)(ws + (isq ? WS_Q : WS_K));
            const float* rc = (const float*)(ws + WS_ROPE); const float* rs = rc + SEQL * 32;
            const int a4 = 4 * (4 * (wc & 1) + fq);
            const int pq = isq ? pn : pn - 6, gi = pq >> 1, sh = 2 * gi, dmask = (1 << sh) - 1, Lg = SEQL >> sh;
            const float sc = isq ? QSCALE : 1.0f;
#pragma unroll
            for (int ai = 0; ai < 2; ++ai) {
                asm volatile("" ::: "memory");
                f32x4 cvv[4], svv[4];
#pragma unroll
                for (int m = 0; m < 4; ++m) { const int pos = (rbase + ai * HALF + m * 16) & (SEQL - 1); cvv[m] = *(const f32x4*)(rc + pos * 32 + a4); svv[m] = *(const f32x4*)(rs + pos * 32 + a4); }
#pragma unroll
                for (int m = 0; m < 4; ++m) {
                    const int tl = rbase + ai * HALF + m * 16; const int pos = tl & (SEQL - 1), sq = tl >> 13;
                    const int kidx = (pos & dmask) * Lg + (pos >> sh);
                    const f32x4 cv = cvv[m] * sc, sv = svv[m] * sc;
#pragma unroll
                    for (int bj = 0; bj < 2; ++bj) {
                        const f32x4 x1 = acc[ai][bj][m][0], x2 = acc[ai][bj][m][1];
                        const f32x4 o1 = x1 * cv - x2 * sv, o2 = x2 * cv + x1 * sv;
                        const int head = pq * 4 + 2 * bj + (wc >> 1);
                        const int ch = 4 * (wc & 1) + fq;
                        bf16_t* p = dst + (size_t)(sq * 24 + head) * SEQL * 64 + (isq ? (size_t)kidx * 64 + ch * 8 : (size_t)(kidx >> 4) * 1024 + ch * 128 + (kidx & 15) * 8);
                        u32x4 w; w.x = cvt_pk_bf16(o1[0], o1[1]); w.y = cvt_pk_bf16(o1[2], o1[3]); w.z = cvt_pk_bf16(o2[0], o2[1]); w.w = cvt_pk_bf16(o2[2], o2[3]);
                        *(u32x4*)p = w;
                    }
                }
            }
        } else if (pn < 18) {
            bf16_t* dst = (bf16_t*)(ws + WS_VT);
            const int gi = (pn - 12) >> 1, sh = 2 * gi;
            const int wid = wr * 4 + wc, lane = fq * 16 + fr;
            LAS bf16_t* tile = (LAS bf16_t*)(lds + STAGE_BYTES + wid * 4096);
#pragma unroll
            for (int ai = 0; ai < 2; ++ai) {
                const int tl0 = u.pm * BM + wr * 64 + ai * HALF;
                const int pos0 = tl0 & (SEQL - 1), sq = tl0 >> 13;
#pragma unroll
                for (int bj = 0; bj < 2; ++bj) {
                    asm volatile("" ::: "memory");
                    const int h = (4 * (pn - 12) + 2 * bj + (wc >> 1)) & 7;
#pragma unroll
                    for (int m = 0; m < 4; ++m) {
                        const int t = 16 * m + fr;
                        const int slot = gi == 0 ? t : (gi == 1 ? ((t & 3) * 16 + (t >> 2)) : ((t & 15) * 4 + (t >> 4)));
#pragma unroll
                        for (int n = 0; n < 2; ++n)
#pragma unroll
                            for (int j = 0; j < 4; ++j) { const unsigned w = cvt_pk_bf16(acc[ai][bj][m][n][j], 0.f); tile[(8 * fq + 4 * n + j) * 64 + slot] = (bf16_t)(w & 0xffffu); }
                    }
                    bf16_t* hb0 = dst + (size_t)(((sq * 3 + gi) * 8 + h) * 512) * 1024;
#pragma unroll
                    for (int i = 0; i < 4; ++i) {
                        const int c = lane + 64 * i, d = c >> 3, s8 = (c & 7) * 8;
                        const u32x4 v = *(const LAS u32x4*)(tile + d * 64 + s8);
                        const int dg = 32 * (wc & 1) + d; const int doff = (dg >> 4) * 256 + (dg & 15) * 4;
                        if (gi == 0) { const int kidx = pos0 + s8; bf16_t* q = hb0 + (size_t)(kidx >> 4) * 1024 + doff + ((kidx & 15) >> 2) * 64; *(u32x2*)q = (u32x2){v.x, v.y}; *(u32x2*)(q + 64) = (u32x2){v.z, v.w}; }
                        else if (gi == 1) { const int kidx = (s8 >> 4) * 2048 + (pos0 >> 2) + (s8 & 15); bf16_t* q = hb0 + (size_t)(kidx >> 4) * 1024 + doff + ((kidx & 15) >> 2) * 64; *(u32x2*)q = (u32x2){v.x, v.y}; *(u32x2*)(q + 64) = (u32x2){v.z, v.w}; }
                        else { const int ka = (s8 >> 2) * 512 + (pos0 >> 4), kb = ka + 512;
                            *(u32x2*)(hb0 + (size_t)(ka >> 4) * 1024 + doff + ((ka & 15) >> 2) * 64) = (u32x2){v.x, v.y}; *(u32x2*)(hb0 + (size_t)(kb >> 4) * 1024 + doff + ((kb & 15) >> 2) * 64) = (u32x2){v.z, v.w}; }
                    }
                }
            }
        } else if (pn == 20 || pn == 21) {
            bf16_t* dst = (bf16_t*)(ws + WS_UH);
#pragma unroll
            for (int ai = 0; ai < 2; ++ai)
#pragma unroll
                for (int m = 0; m < 4; ++m) { asm volatile("" ::: "memory");
                    const int tl = rbase + ai * HALF + m * 16;
#pragma unroll
                    for (int bj = 0; bj < 2; ++bj) {
                        const int gg = 16 * (pn - 20) + 8 * bj + 2 * wc + (fq >> 1);
                        bf16_t* p = dst + ((size_t)(gg * CHP + (tl >> 5)) * UHK) + (tl & 31) * 16 + 8 * (fq & 1);
                        const f32x4 v0 = acc[ai][bj][m][0], v1 = acc[ai][bj][m][1];
                        u32x4 w; w.x = cvt_pk_bf16(v0[0], v0[1]); w.y = cvt_pk_bf16(v0[2], v0[3]); w.z = cvt_pk_bf16(v1[0], v1[1]); w.w = cvt_pk_bf16(v1[2], v1[3]);
                        *(u32x4*)p = w;
                    }
                }
        } else {
            bf16_t* dst; int ld, c0; bool silu;
            if (pn < 20) { dst = (bf16_t*)(ws + WS_ZA); ld = 512; c0 = (pn - 18) * 256; silu = true; }
            else if (pn < 24) { dst = (bf16_t*)(ws + WS_ZB); ld = 512; c0 = (pn - 22) * 256; silu = true; }
            else if (pn < 28) { dst = (bf16_t*)(ws + WS_GA); ld = 1024; c0 = (pn - 24) * 256; silu = false; }
            else { dst = (bf16_t*)(ws + WS_GB); ld = 1024; c0 = (pn - 28) * 256; silu = false; }
#pragma unroll
            for (int ai = 0; ai < 2; ++ai)
#pragma unroll
                for (int m = 0; m < 4; ++m) { asm volatile("" ::: "memory");
                    const int tl = rbase + ai * HALF + m * 16;
#pragma unroll
                    for (int bj = 0; bj < 2; ++bj) {
                        f32x4 v0 = acc[ai][bj][m][0], v1 = acc[ai][bj][m][1];
#pragma unroll
                        for (int j = 0; j < 4; ++j) { const float s0 = sigmoidf_(v0[j]), s1 = sigmoidf_(v1[j]); v0[j] = silu ? v0[j] * s0 : s0; v1[j] = silu ? v1[j] * s1 : s1; }
                        u32x4 w; w.x = cvt_pk_bf16(v0[0], v0[1]); w.y = cvt_pk_bf16(v0[2], v0[3]); w.z = cvt_pk_bf16(v1[0], v1[1]); w.w = cvt_pk_bf16(v1[2], v1[3]);
                        *(u32x4*)(dst + (size_t)tl * ld + c0 + cl + bj * HALF) = w;
                    }
                }
        }
    } else if (g.mode == MODE_S) {
        float* dst = (float*)(ws + WS_S) + (size_t)u.bz * CHP * 256;
#pragma unroll
        for (int ai = 0; ai < 2; ++ai)
#pragma unroll
            for (int m = 0; m < 4; ++m) { asm volatile("" ::: "memory");
                const int r = rbase + ai * HALF + m * 16;
#pragma unroll
                for (int bj = 0; bj < 2; ++bj) { float* p = dst + (size_t)r * 256 + cl + bj * HALF; *(f32x4*)p = acc[ai][bj][m][0]; *(f32x4*)(p + 4) = acc[ai][bj][m][1]; }
            }
    } else if (g.mode == MODE_Y) {
        bf16_t* dst = (bf16_t*)(ws + WS_SG);
#pragma unroll
        for (int ai = 0; ai < 2; ++ai)
#pragma unroll
            for (int m = 0; m < 4; ++m) { asm volatile("" ::: "memory");
                const int r = rbase + ai * HALF + m * 16;
#pragma unroll
                for (int bj = 0; bj < 2; ++bj) {
                    const int t = 16 * u.pn + 8 * bj + 2 * wc + (fq >> 1);
                    f32x4 v0 = acc[ai][bj][m][0], v1 = acc[ai][bj][m][1];
#pragma unroll
                    for (int j = 0; j < 4; ++j) { v0[j] = gelu_tanh(v0[j]); v1[j] = gelu_tanh(v1[j]); }
                    u32x4 w; w.x = cvt_pk_bf16(v0[0], v0[1]); w.y = cvt_pk_bf16(v0[2], v0[3]); w.z = cvt_pk_bf16(v1[0], v1[1]); w.w = cvt_pk_bf16(v1[2], v1[3]);
                    *(u32x4*)(dst + (size_t)(r * LC + t) * 512 + u.bz * 16 + 8 * (fq & 1)) = w;
                }
            }
    } else if (g.mode == MODE_GLU) {
        const bf16_t* sg = (const bf16_t*)(ws + WS_SG); const bf16_t* zb = (const bf16_t*)(ws + WS_ZB); bf16_t* dst = (bf16_t*)(ws + WS_SB);
#pragma unroll
        for (int ai = 0; ai < 2; ++ai) {
            asm volatile("" ::: "memory");
            u32x4 sv4[4][2], zv4[4][2];
#pragma unroll
            for (int m = 0; m < 4; ++m)
#pragma unroll
                for (int bj = 0; bj < 2; ++bj) { const size_t off = (size_t)(rbase + ai * HALF + m * 16) * 512 + u.pn * BM + cl + bj * HALF; sv4[m][bj] = *(const u32x4*)(sg + off); zv4[m][bj] = *(const u32x4*)(zb + off); }
#pragma unroll
            for (int m = 0; m < 4; ++m)
#pragma unroll
                for (int bj = 0; bj < 2; ++bj) {
                    const size_t off = (size_t)(rbase + ai * HALF + m * 16) * 512 + u.pn * BM + cl + bj * HALF;
                    const u32x4 s4 = sv4[m][bj], z4 = zv4[m][bj];
                    const f32x4 v0 = acc[ai][bj][m][0], v1 = acc[ai][bj][m][1];
                    u32x4 w;
                    w.x = cvt_pk_bf16(bf_lo(s4.x) * sigmoidf_(v0[0]) * bf_lo(z4.x), bf_hi(s4.x) * sigmoidf_(v0[1]) * bf_hi(z4.x));
                    w.y = cvt_pk_bf16(bf_lo(s4.y) * sigmoidf_(v0[2]) * bf_lo(z4.y), bf_hi(s4.y) * sigmoidf_(v0[3]) * bf_hi(z4.y));
                    w.z = cvt_pk_bf16(bf_lo(s4.z) * sigmoidf_(v1[0]) * bf_lo(z4.z), bf_hi(s4.z) * sigmoidf_(v1[1]) * bf_hi(z4.z));
                    w.w = cvt_pk_bf16(bf_lo(s4.w) * sigmoidf_(v1[2]) * bf_lo(z4.w), bf_hi(s4.w) * sigmoidf_(v1[3]) * bf_hi(z4.w));
                    *(u32x4*)(dst + off) = w;
                }
        }
    } else if (g.mode == MODE_A || g.mode == MODE_B) {
        const bool isb = g.mode == MODE_B;
        const bf16_t* gt = (const bf16_t*)(ws + (isb ? WS_GB : WS_GA)); bf16_t* dst = (bf16_t*)(ws + WS_M1);
#pragma unroll
        for (int ai = 0; ai < 2; ++ai) {
            asm volatile("" ::: "memory");
            u32x4 gv4[4][2], pv4[4][2];
#pragma unroll
            for (int m = 0; m < 4; ++m)
#pragma unroll
                for (int bj = 0; bj < 2; ++bj) { const size_t off = (size_t)(rbase + ai * HALF + m * 16) * 1024 + u.pn * BM + cl + bj * HALF; gv4[m][bj] = *(const u32x4*)(gt + off); pv4[m][bj] = (u32x4){0u, 0u, 0u, 0u}; if (isb) pv4[m][bj] = *(const u32x4*)(dst + off); }
#pragma unroll
            for (int m = 0; m < 4; ++m)
#pragma unroll
                for (int bj = 0; bj < 2; ++bj) {
                    const size_t off = (size_t)(rbase + ai * HALF + m * 16) * 1024 + u.pn * BM + cl + bj * HALF;
                    const u32x4 g4 = gv4[m][bj], p4 = pv4[m][bj];
                    const f32x4 v0 = acc[ai][bj][m][0], v1 = acc[ai][bj][m][1];
                    u32x4 w;
                    w.x = cvt_pk_bf16(bf_lo(p4.x) + bf_lo(g4.x) * v0[0], bf_hi(p4.x) + bf_hi(g4.x) * v0[1]);
                    w.y = cvt_pk_bf16(bf_lo(p4.y) + bf_lo(g4.y) * v0[2], bf_hi(p4.y) + bf_hi(g4.y) * v0[3]);
                    w.z = cvt_pk_bf16(bf_lo(p4.z) + bf_lo(g4.z) * v1[0], bf_hi(p4.z) + bf_hi(g4.z) * v1[1]);
                    w.w = cvt_pk_bf16(bf_lo(p4.w) + bf_lo(g4.w) * v1[2], bf_hi(p4.w) + bf_hi(g4.w) * v1[3]);
                    *(u32x4*)(dst + off) = w;
                }
        }
    } else {
        bf16_t* dst = (bf16_t*)(ws + WS_ACC);
#pragma unroll
        for (int ai = 0; ai < 2; ++ai)
#pragma unroll
            for (int m = 0; m < 4; ++m) {
                const int tl = rbase + ai * HALF + m * 16;
#pragma unroll
                for (int bj = 0; bj < 2; ++bj) {
                    const f32x4 v0 = acc[ai][bj][m][0], v1 = acc[ai][bj][m][1];
                    u32x4 w; w.x = cvt_pk_bf16(v0[0], v0[1]); w.y = cvt_pk_bf16(v0[2], v0[3]); w.z = cvt_pk_bf16(v1[0], v1[1]); w.w = cvt_pk_bf16(v1[2], v1[3]);
                    *(u32x4*)(dst + (size_t)tl * DM + u.pn * BM + cl + bj * HALF) = w;
                }
            }
    }
}

__device__ __forceinline__ void gemm_phase(const Args& a, LAS unsigned char* lds, const GemmD& g, int G, int cidx, int tid) {
    const int wid = __builtin_amdgcn_readfirstlane(tid >> 6), lane = tid & 63, wr = wid >> 2, wc = wid & 3, fr = lane & 15, fq = lane >> 4;
    const int K = g.K, nt = K / BK;
    unsigned voffA[2], voffB[2];
#pragma unroll
    for (int i = 0; i < 2; ++i) { int R, C; stage_rc(tid * 16 + i * 8192, R, C); const int Rb = (R & ~31) + perm32(R & 31);
        voffA[i] = (unsigned)(R * g.lda + C) * 2u; voffB[i] = (unsigned)(Rb * g.ldb + C) * 2u; }
    const size_t kstep = (size_t)(BK * 2);
    const size_t hstepA = (size_t)HALF * g.lda * 2, hstepB = (size_t)HALF * g.ldb * 2;
    const size_t tstepA = 2 * hstepA, tstepB = 2 * hstepB;
    const unsigned ldsw = (unsigned)wid * 1024u;
    const int aoff = lds_byte(wr * 64 + fr, fq * 8), boff = lds_byte(wc * 32 + fr, fq * 8);
#define PG8_SA(b, h) (((b) * 2 + (h)) * HTB)
#define PG8_SB(b, h) ((4 + (b) * 2 + (h)) * HTB)
#define PG8_STAGE(bufoff, gbase, voff) do { _Pragma("unroll") for (int _i = 0; _i < 2; ++_i) \
        __builtin_amdgcn_global_load_lds((const unsigned*)((const char*)(gbase) + (voff)[_i]), (LAS unsigned*)(lds + (bufoff) + ldsw + _i * 8192), 16, 0, 0); } while (0)
#define PG8_LDA(dst, b, h) do { _Pragma("unroll") for (int m = 0; m < 4; ++m) _Pragma("unroll") for (int k = 0; k < 2; ++k) dst[m][k] = *(const LAS bf16x8*)(lds + PG8_SA(b, h) + aoff + m * 2048 + k * 1024); } while (0)
#define PG8_LDB(dst, b, h) do { _Pragma("unroll") for (int n = 0; n < 2; ++n) _Pragma("unroll") for (int k = 0; k < 2; ++k) dst[n][k] = *(const LAS bf16x8*)(lds + PG8_SB(b, h) + boff + n * 2048 + k * 1024); } while (0)
#define PG8_MMA(ai, bj, At, Bt) do { __builtin_amdgcn_s_setprio(1); _Pragma("unroll") for (int m = 0; m < 4; ++m) _Pragma("unroll") for (int n = 0; n < 2; ++n) _Pragma("unroll") for (int k = 0; k < 2; ++k) \
        acc[ai][bj][m][n] = __builtin_amdgcn_mfma_f32_16x16x32_bf16(Bt[n][k], At[m][k], acc[ai][bj][m][n], 0, 0, 0); __builtin_amdgcn_s_setprio(0); } while (0)
#define PG8_WAIT_V(n) asm volatile("s_waitcnt vmcnt(" #n ")" ::: "memory")
#define PG8_WAIT_L(n) asm volatile("s_waitcnt lgkmcnt(" #n ")" ::: "memory")
#define PG8_BAR __builtin_amdgcn_s_barrier()
#define PG8_SCHED __builtin_amdgcn_sched_barrier(0)
    Unit cur, nxt; int ui = 0;
    { int pm_, pn_, bz_; if (!unit_next(g, 0, G, cidx, pm_, pn_, bz_)) return; cur.pm = pm_; cur.pn = pn_; cur.bz = bz_; }
    f32x4 acc[2][2][4][2];
#pragma unroll
    for (int a = 0; a < 2; ++a)
#pragma unroll
        for (int b = 0; b < 2; ++b)
#pragma unroll
            for (int m = 0; m < 4; ++m)
#pragma unroll
                for (int n = 0; n < 2; ++n) acc[a][b][m][n] = (f32x4){0.f, 0.f, 0.f, 0.f};
    bf16x8 At[4][2], B0[2][2], B1[2][2];
    const char* cA = (const char*)g.A + (size_t)cur.bz * g.sA + (size_t)cur.pm * tstepA; const char* cB = (const char*)g.Bt + (size_t)cur.bz * g.sB + (size_t)cur.pn * tstepB;
    PG8_STAGE(PG8_SB(0, 0), cB, voffB); PG8_STAGE(PG8_SA(0, 0), cA, voffA); PG8_STAGE(PG8_SB(0, 1), cB + hstepB, voffB); PG8_STAGE(PG8_SA(0, 1), cA + hstepA, voffA);
    if (wr == 1) PG8_BAR;
    PG8_WAIT_V(4); PG8_BAR;
    PG8_STAGE(PG8_SB(1, 0), cB + kstep, voffB); PG8_STAGE(PG8_SA(1, 0), cA + kstep, voffA); PG8_STAGE(PG8_SB(1, 1), cB + hstepB + kstep, voffB);
    PG8_WAIT_V(6); PG8_BAR;
    for (;;) {
        int npm, npn, nbz; const bool has_next = unit_next(g, ui + 1, G, cidx, npm, npn, nbz); nxt.pm = npm; nxt.pn = npn; nxt.bz = nbz;
        const char* nA = has_next ? (const char*)g.A + (size_t)nxt.bz * g.sA + (size_t)nxt.pm * tstepA : cA; const char* nB = has_next ? (const char*)g.Bt + (size_t)nxt.bz * g.sB + (size_t)nxt.pn * tstepB : cB;
        for (int t = 0; t < nt; t += 2) {
            const bool last = (t == nt - 2);
            const char* a1 = cA + (size_t)(t + 1) * kstep;
            const char* a2 = last ? nA : cA + (size_t)(t + 2) * kstep; const char* b2 = last ? nB : cB + (size_t)(t + 2) * kstep;
            const char* a3 = a2 + kstep; const char* b3 = b2 + kstep;
            PG8_LDB(B0, 0, 0); PG8_SCHED; PG8_LDA(At, 0, 0); PG8_STAGE(PG8_SA(1, 1), a1 + hstepA, voffA);
            PG8_WAIT_L(8); PG8_BAR; PG8_WAIT_L(0); PG8_MMA(0, 0, At, B0); PG8_BAR; PG8_SCHED;
            PG8_LDB(B1, 0, 1); PG8_STAGE(PG8_SB(0, 0), b2, voffB);
            PG8_BAR; PG8_WAIT_L(0); PG8_MMA(0, 1, At, B1); PG8_BAR;
            PG8_LDA(At, 0, 1); PG8_STAGE(PG8_SA(0, 0), a2, voffA);
            PG8_BAR; PG8_WAIT_L(0); PG8_MMA(1, 0, At, B0); PG8_BAR; PG8_SCHED;
            PG8_STAGE(PG8_SB(0, 1), b2 + hstepB, voffB);
            PG8_WAIT_V(6); PG8_BAR; PG8_MMA(1, 1, At, B1); PG8_BAR;
            PG8_LDB(B0, 1, 0); PG8_SCHED; PG8_LDA(At, 1, 0); PG8_STAGE(PG8_SA(0, 1), a2 + hstepA, voffA);
            PG8_WAIT_L(8); PG8_BAR; PG8_WAIT_L(0); PG8_MMA(0, 0, At, B0); PG8_BAR; PG8_SCHED;
            PG8_LDB(B1, 1, 1); PG8_STAGE(PG8_SB(1, 0), b3, voffB);
            PG8_BAR; PG8_WAIT_L(0); PG8_MMA(0, 1, At, B1); PG8_BAR;
            PG8_LDA(At, 1, 1); PG8_STAGE(PG8_SA(1, 0), a3, voffA);
            PG8_BAR; PG8_WAIT_L(0); PG8_MMA(1, 0, At, B0); PG8_BAR; PG8_SCHED;
            PG8_STAGE(PG8_SB(1, 1), b3 + hstepB, voffB);
            PG8_WAIT_V(6); PG8_BAR; PG8_MMA(1, 1, At, B1); PG8_BAR;
        }
#ifndef NO_EPI
        epilogue(a, lds, g, acc, cur, wr, wc, fr, fq);
#else
        if (g.mode == 99) *(f32x4*)(g.out) = acc[0][0][0][0] + acc[1][1][3][1] + acc[0][1][2][0]+acc[1][0][1][1];
#endif
        if (!has_next) break;
#pragma unroll
        for (int a = 0; a < 2; ++a)
#pragma unroll
            for (int b = 0; b < 2; ++b)
#pragma unroll
                for (int m = 0; m < 4; ++m)
#pragma unroll
                    for (int n = 0; n < 2; ++n) acc[a][b][m][n] = (f32x4){0.f, 0.f, 0.f, 0.f};
        cur = nxt; cA = nA; cB = nB; ++ui;
    }
    PG8_WAIT_V(0);
    if (wr == 0) PG8_BAR;
    PG8_BAR;
#undef PG8_SA
#undef PG8_SB
#undef PG8_STAGE
#undef PG8_LDA
#undef PG8_LDB
#undef PG8_MMA
#undef PG8_WAIT_V
#undef PG8_WAIT_L
#undef PG8_BAR
#undef PG8_SCHED
}

__device__ __forceinline__ int qk_perm_row(int n) { const int i = n & 63; return (n & ~63) + 8 * ((i & 31) >> 2) + (i & 3) + 4 * (i >> 5); }
__device__ __forceinline__ void transpose_item(const float* W, int K, int N, bf16_t* WT, bool permqk, LAS float* scr, int item, int lane) {
    const int nblk = N / 32, kb = item / nblk, nb = item % nblk, k0 = 64 * kb, n0 = 32 * nb;
#pragma unroll 8
    for (int i = 0; i < 32; ++i) { const int kk = 2 * i + (lane >> 5); scr[kk * 33 + (lane & 31)] = W[(size_t)(k0 + kk) * N + n0 + (lane & 31)]; }
    asm volatile("s_waitcnt lgkmcnt(0)" ::: "memory");
    const int c = lane & 7;
#pragma unroll
    for (int j = 0; j < 4; ++j) { const int n = (lane >> 3) + 8 * j; const LAS float* s = scr + (8 * c) * 33 + n;
        u32x4 o; o.x = cvt_pk_bf16(s[0 * 33], s[1 * 33]); o.y = cvt_pk_bf16(s[2 * 33], s[3 * 33]); o.z = cvt_pk_bf16(s[4 * 33], s[5 * 33]); o.w = cvt_pk_bf16(s[6 * 33], s[7 * 33]);
        int row = n0 + n; if (permqk && row < 2 * QKVW) row = qk_perm_row(row);
        *(u32x4*)(WT + (size_t)row * K + k0 + 8 * c) = o; }
    asm volatile("s_waitcnt lgkmcnt(0)" ::: "memory");
}
__device__ __forceinline__ void reduce_angle(double a, float& c, float& s) {
    const double k = __builtin_rint(a * 0.6366197723675814); const float x = (float)(a - k * 1.5707963267948966), x2 = x * x;
    const float sn = x * (1.0f + x2 * (-1.6666666667e-1f + x2 * (8.3333333333e-3f + x2 * (-1.9841269841e-4f + x2 * 2.7557319224e-6f))));
    const float cs = 1.0f + x2 * (-0.5f + x2 * (4.1666666667e-2f + x2 * (-1.3888888889e-3f + x2 * (2.4801587302e-5f + x2 * -2.7557319224e-7f))));
    const int q = ((int)k) & 3;
    c = (q == 0) ? cs : (q == 1) ? -sn : (q == 2) ? -cs : sn;
    s = (q == 0) ? sn : (q == 1) ? cs : (q == 2) ? -sn : -cs;
}
__device__ __forceinline__ void rms_row_to_bf16(const float* xrow, const float* gw, bf16_t* orow, int lane) {
    const f32x4* xr = (const f32x4*)xrow + lane; const f32x4* gr = (const f32x4*)gw + lane;
    f32x4 v[4]; float s = 0.f;
#pragma unroll
    for (int j = 0; j < 4; ++j) { v[j] = xr[64 * j]; s += (v[j].x * v[j].x + v[j].y * v[j].y) + (v[j].z * v[j].z + v[j].w * v[j].w); }
    const float rstd = 1.0f / sqrtf(wave_sum(s) * (1.f / DM) + EPSN);
    u32x2* o8 = (u32x2*)orow + lane;
#pragma unroll
    for (int j = 0; j < 4; ++j) { const f32x4 gv = gr[64 * j]; u32x2 w; w.x = cvt_pk_bf16(v[j].x * rstd * gv.x, v[j].y * rstd * gv.y); w.y = cvt_pk_bf16(v[j].z * rstd * gv.z, v[j].w * rstd * gv.w); o8[64 * j] = w; }
}

__device__ __forceinline__ void ssm_load_bc(const Args& a, int g, int dir, LAS f32x2* Bb, LAS f32x2* Cc, int tid) {
    const float* lam_re = a.in[4]; const float* lam_im = a.in[5]; const float* log_step = a.in[6];
    const float* b_re = a.in[7]; const float* b_im = a.in[8]; const float* c_re = a.in[9]; const float* c_im = a.in[10];
    const float dt = expf(log_step[dir * 32 + g]);
    for (int idx = tid; idx < 1024; idx += 512) {
        { const int n = idx >> 4; const float lr = lam_re[(dir * 32 + g) * 64 + n], li = lam_im[(dir * 32 + g) * 64 + n];
          const float ar = lr * dt; float cb, sb, ch, sh; reduce_angle((double)li * (double)dt, cb, sb); reduce_angle(0.5 * (double)li * (double)dt, ch, sh);
          const float em1 = expm1f(ar), ea = em1 + 1.0f;
          const float nr = em1 * cb - 2.0f * sh * sh, ni = ea * sb;
          const float den = 1.0f / (lr * lr + li * li); const float cr = (nr * lr + ni * li) * den, ci = (ni * lr - nr * li) * den;
          const float br = b_re[(size_t)((dir * 32 + g) * 64) * 16 + idx], bi = b_im[(size_t)((dir * 32 + g) * 64) * 16 + idx];
          Bb[idx] = (f32x2){cr * br - ci * bi, cr * bi + ci * br}; }
        { Cc[idx] = (f32x2){c_re[(size_t)((dir * 32 + g) * 16) * 64 + idx], c_im[(size_t)((dir * 32 + g) * 16) * 64 + idx]}; }
    }
}
__device__ __forceinline__ void ssm_setup_item(const Args& a, LAS unsigned char* lds, int item, int tid) {
    const int g = item >> 1, dir = item & 1;
    LAS f32x2* pw = (LAS f32x2*)lds; LAS f32x2* Bb = pw + 33 * 64; LAS f32x2* Cc = Bb + 1024;
    LAS float* KT = (LAS float*)(Cc + 1024); LAS float* K0 = KT + 32 * 256; LAS f32x2* Bb0 = (LAS f32x2*)(K0 + 256); LAS f32x2* Cc0 = Bb0 + 1024;
    const float* lam_re = a.in[4]; const float* lam_im = a.in[5]; const float* log_step = a.in[6];
    unsigned char* ws = a.ws;
    const float dt = expf(log_step[dir * 32 + g]);
    __syncthreads();
    for (int idx = tid; idx < 33 * 64; idx += 512) {
        const int tau = idx >> 6, n = idx & 63; const float lr = lam_re[(dir * 32 + g) * 64 + n], li = lam_im[(dir * 32 + g) * 64 + n];
        const float mag = expf(lr * dt * (float)tau); float c, s; reduce_angle((double)li * (double)dt * (double)tau, c, s);
        pw[idx] = (f32x2){mag * c, mag * s};
    }
    ssm_load_bc(a, g, dir, Bb, Cc, tid);
    if (dir == 1) ssm_load_bc(a, g, 0, Bb0, Cc0, tid);
    __syncthreads();
    if (tid < 64) { float* PW = (float*)(ws + WS_PW); const f32x2 p = pw[32 * 64 + tid]; PW[((dir * 32 + g) * 64 + tid) * 2] = p.x; PW[((dir * 32 + g) * 64 + tid) * 2 + 1] = p.y; }
    for (int o = tid; o < 32 * 256; o += 512) {
        const int tau = o >> 8, co = (o >> 4) & 15, ci = o & 15; float acc = 0.f;
_Pragma("unroll 4")
        for (int n = 0; n < 64; ++n) { const f32x2 c = Cc[co * 64 + n], p = pw[tau * 64 + n], b = Bb[n * 16 + ci]; const float tr = c.x * p.x - c.y * p.y, ti = c.x * p.y + c.y * p.x; acc += tr * b.x - ti * b.y; }
        KT[o] = acc; }
    if (dir == 1 && tid < 256) { const int co = tid >> 4, ci = tid & 15; float acc = 0.f;
_Pragma("unroll 4")
        for (int n = 0; n < 64; ++n) { const f32x2 c = Cc0[co * 64 + n], b = Bb0[n * 16 + ci]; acc += c.x * b.x - c.y * b.y; }
        K0[tid] = acc; }
    { bf16_t* BsT = (bf16_t*)(ws + WS_BST) + (size_t)g * 256 * 512;
      for (int ch = tid; ch < 128 * 64; ch += 512) {
          const int row = ch >> 6, part = row >> 6, n = row & 63, kc = ch & 63, s = kc >> 1, ci0 = (kc & 1) * 8; const int e = dir ? s : 31 - s; const f32x2 p = pw[e * 64 + n];
          float v[8];
#pragma unroll
          for (int j = 0; j < 8; ++j) { const f32x2 b = Bb[n * 16 + ci0 + j]; v[j] = part ? (p.x * b.y + p.y * b.x) : (p.x * b.x - p.y * b.y); }
          u32x4 w; w.x = cvt_pk_bf16(v[0], v[1]); w.y = cvt_pk_bf16(v[2], v[3]); w.z = cvt_pk_bf16(v[4], v[5]); w.w = cvt_pk_bf16(v[6], v[7]);
          *(u32x4*)(BsT + (size_t)(dir * 128 + row) * 512 + s * 16 + ci0) = w; } }
    bf16_t* MtC = (bf16_t*)(ws + WS_MTC) + (size_t)g * 512 * UHK;
    { for (int ch = tid; ch < 512 * 16; ch += 512) {
          const int row = ch >> 4, t = row >> 4, co = row & 15, cc = ch & 15, part = cc >> 3, n0 = (cc & 7) * 8; const int e = dir ? 32 - t : t + 1;
          float v[8];
#pragma unroll
          for (int j = 0; j < 8; ++j) { const f32x2 c = Cc[co * 64 + n0 + j], p = pw[e * 64 + n0 + j]; v[j] = part ? -(c.x * p.y + c.y * p.x) : (c.x * p.x - c.y * p.y); }
          u32x4 w; w.x = cvt_pk_bf16(v[0], v[1]); w.y = cvt_pk_bf16(v[2], v[3]); w.z = cvt_pk_bf16(v[4], v[5]); w.w = cvt_pk_bf16(v[6], v[7]);
          *(u32x4*)(MtC + (size_t)row * UHK + 512 + dir * 128 + part * 64 + n0) = w; } }
    __syncthreads();
    { const float* dsk = a.in[11];
      for (int ch = tid; ch < 512 * 64; ch += 512) {
          const int kc = ch & 63, row = ch >> 6; const int s = kc >> 1, ci0 = (kc & 1) * 8, t = row >> 4, co = row & 15;
          if (dir == 0 ? (t > s) : (s >= t)) {
              const int tau = dir == 0 ? t - s : s - t;
              float v[8];
#pragma unroll
              for (int j = 0; j < 8; ++j) v[j] = KT[tau * 256 + co * 16 + ci0 + j];
              if (t == s) { const float dv = dsk[g * 16 + co];
#pragma unroll
                  for (int j = 0; j < 8; ++j) v[j] += K0[co * 16 + ci0 + j] + ((ci0 + j == co) ? dv : 0.f); }
              u32x4 w; w.x = cvt_pk_bf16(v[0], v[1]); w.y = cvt_pk_bf16(v[2], v[3]); w.z = cvt_pk_bf16(v[4], v[5]); w.w = cvt_pk_bf16(v[6], v[7]);
              *(u32x4*)(MtC + (size_t)row * UHK + s * 16 + ci0) = w;
          }
      } }
    __syncthreads();
}

__device__ __forceinline__ void step_setup(const Args& a, LAS unsigned char* lds, int tid, int bx) {
    const int lane = tid & 63, wave = tid >> 6, G = gridDim.x;
    unsigned char* ws = a.ws;
    for (int it = bx; it < 64; it += G) ssm_setup_item(a, lds, it, tid);
    { float* rc = (float*)(ws + WS_ROPE); float* rs = rc + SEQL * 32;
      for (int idx = bx * 512 + tid; idx < SEQL * 32; idx += G * 512) {
          const int pos = idx >> 5, i = idx & 31; double inv = 1.0; for (int k = 0; k < i; ++k) inv *= 0.7498942093324558;
          float c, s; reduce_angle((double)pos * inv, c, s); rc[idx] = c; rs[idx] = s; } }
    { LAS float* scr = (LAS float*)(lds) + wave * (64 * 33);
      const int gw = bx * 8 + wave, NGW = G * 8;
      constexpr int I_IN = (DM / 64) * (INC / 32), I_GLU = (512 / 64) * (512 / 32), I_AB = (512 / 64) * (1024 / 32), I_OUT = (1024 / 64) * (1024 / 32);
      constexpr int NIT = I_IN + I_GLU + 2 * I_AB + I_OUT;
      for (int it = gw; it < NIT; it += NGW) {
          int r = it;
          if (r < I_IN) { transpose_item(a.in[3], DM, INC, (bf16_t*)(ws + WS_WIN), true, scr, r, lane); continue; } r -= I_IN;
          if (r < I_GLU) { transpose_item(a.in[12], 512, 512, (bf16_t*)(ws + WS_WGLU), false, scr, r, lane); continue; } r -= I_GLU;
          if (r < I_AB) { transpose_item(a.in[13], 512, 1024, (bf16_t*)(ws + WS_WA), false, scr, r, lane); continue; } r -= I_AB;
          if (r < I_AB) { transpose_item(a.in[14], 512, 1024, (bf16_t*)(ws + WS_WB), false, scr, r, lane); continue; } r -= I_AB;
          transpose_item(a.in[15], 1024, 1024, (bf16_t*)(ws + WS_WOUT), false, scr, r, lane);
      } }
    { bf16_t* hn = (bf16_t*)((unsigned char*)a.out + OUT_HN_OFF);
      const f32x4* gr = (const f32x4*)a.in[2] + lane;
      f32x4 gv[4];
#pragma unroll
      for (int j = 0; j < 4; ++j) gv[j] = gr[64 * j];
      unsigned* rctr = (unsigned*)(ws + WS_CTL) + 4;
      constexpr int RCH = 16;
      for (;;) {
          unsigned cidx = 0; if (lane == 0) cidx = atomicAdd(rctr, 1u);
          cidx = (unsigned)__builtin_amdgcn_readfirstlane((int)cidx);
          if (cidx >= (unsigned)(TTOK / RCH)) break;
          int row = (int)cidx * RCH; const int rend = row + RCH;
          f32x4 nx[4];
          { const f32x4* xr = (const f32x4*)xrow_ptr(a.in[0], a.in[1], row) + lane;
#pragma unroll
            for (int j = 0; j < 4; ++j) nx[j] = xr[64 * j]; }
          for (; row < rend; ++row) {
              f32x4 v[4];
#pragma unroll
              for (int j = 0; j < 4; ++j) v[j] = nx[j];
              if (row + 1 < rend) { const f32x4* xn = (const f32x4*)xrow_ptr(a.in[0], a.in[1], row + 1) + lane;
#pragma unroll
                  for (int j = 0; j < 4; ++j) nx[j] = xn[64 * j]; }
              float s = 0.f;
#pragma unroll
              for (int j = 0; j < 4; ++j) s += (v[j].x * v[j].x + v[j].y * v[j].y) + (v[j].z * v[j].z + v[j].w * v[j].w);
              const float rstd = 1.0f / sqrtf(wave_sum(s) * (1.f / DM) + EPSN);
              u32x2* o8 = (u32x2*)(hn + (size_t)row * DM) + lane;
#pragma unroll
              for (int j = 0; j < 4; ++j) { u32x2 w; w.x = cvt_pk_bf16(v[j].x * rstd * gv[j].x, v[j].y * rstd * gv[j].y); w.y = cvt_pk_bf16(v[j].z * rstd * gv[j].z, v[j].w * rstd * gv[j].w); o8[64 * j] = w; }
          }
      } }
}

struct KVBuf { bf16x8 kA0, kA1, kB0, kB1; bf16x4 vA[4], vB[4]; };
__device__ __forceinline__ void step_params(int s, int& gi, int& ls) { gi = s < 12 ? 0 : (s < 18 ? 1 : 2); ls = s < 12 ? s : (s < 18 ? s - 12 : s - 18); }
__device__ __forceinline__ void attn_load(KVBuf& b, const bf16_t* Kp, const bf16_t* Vt, int s, int sq, int h, int blk, int r, int lane) {
    int gi, ls; step_params(s, gi, ls);
    const int sh = 2 * gi, Lg = SEQL >> sh, rho = r & ((1 << sh) - 1);
    int uA = ((256 * blk) >> sh) - 64 + 32 * ls, uB = uA + 16;
    if (uA < 0 || uA >= Lg) uA = 0; if (uB < 0 || uB >= Lg) uB = 0;
    const int kl = lane & 15, quad = lane >> 4;
    const bf16_t* kh = Kp + (size_t)(sq * 24 + gi * 8 + h) * SEQL * 64 + quad * 128 + kl * 8;
    const bf16_t* ka = kh + (size_t)((rho * Lg + uA) >> 4) * 1024; const bf16_t* kb = kh + (size_t)((rho * Lg + uB) >> 4) * 1024;
    b.kA0 = *(const bf16x8*)ka; b.kA1 = *(const bf16x8*)(ka + 512); b.kB0 = *(const bf16x8*)kb; b.kB1 = *(const bf16x8*)(kb + 512);
    const bf16_t* vbase = Vt + (size_t)(((sq * 3 + gi) * 8 + h) * 512) * 1024 + quad * 64 + kl * 4;
    const bf16_t* va = vbase + (size_t)((rho * Lg + uA) >> 4) * 1024; const bf16_t* vb = vbase + (size_t)((rho * Lg + uB) >> 4) * 1024;
#pragma unroll
    for (int dt = 0; dt < 4; ++dt) { b.vA[dt] = *(const bf16x4*)(va + dt * 256); b.vB[dt] = *(const bf16x4*)(vb + dt * 256); }
}
struct QF { bf16x8 a0, a1, b0, b1, c0, c1; };
template <int gi>
__device__ __forceinline__ void attn_compute(const KVBuf& b, const bf16x8 q0, const bf16x8 q1, f32x4 (&o)[4], float& mrun, float& lrun, int s, int blk, int r, int lane) {
    const int ls = gi == 0 ? s : (gi == 1 ? s - 12 : s - 18);
    const int sh = 2 * gi, Lg = SEQL >> sh;
    const int uA = ((256 * blk) >> sh) - 64 + 32 * ls;
    const int qi = lane & 15, quad = lane >> 4;
    const int uq = (256 * blk + r + 16 * qi) >> sh;
    const int lo = max(0, uq - 64), hi = min(Lg - 1, uq + 64);
    f32x4 sA = (f32x4){0.f, 0.f, 0.f, 0.f}, sB = sA;
    sA = __builtin_amdgcn_mfma_f32_16x16x32_bf16(b.kA0, q0, sA, 0, 0, 0); sA = __builtin_amdgcn_mfma_f32_16x16x32_bf16(b.kA1, q1, sA, 0, 0, 0);
    sB = __builtin_amdgcn_mfma_f32_16x16x32_bf16(b.kB0, q0, sB, 0, 0, 0); sB = __builtin_amdgcn_mfma_f32_16x16x32_bf16(b.kB1, q1, sB, 0, 0, 0);
    const float NEGINF = -__builtin_inff();
    const unsigned span = (unsigned)(hi - lo);
    float mx = NEGINF;
#pragma unroll
    for (int j = 0; j < 4; ++j) {
        const int ua = uA + quad * 4 + j, ub = ua + 16;
        sA[j] = ((unsigned)(ua - lo) <= span) ? sA[j] : NEGINF; sB[j] = ((unsigned)(ub - lo) <= span) ? sB[j] : NEGINF;
        mx = fmaxf(mx, fmaxf(sA[j], sB[j]));
    }
    mx = fmaxf(mx, __shfl_xor(mx, 16)); mx = fmaxf(mx, __shfl_xor(mx, 32));
    const float mnew = fmaxf(mrun, mx), alpha = __builtin_amdgcn_exp2f(mrun - mnew);
    mrun = mnew;
    float ps = 0.f;
#pragma unroll
    for (int j = 0; j < 4; ++j) { sA[j] = __builtin_amdgcn_exp2f(sA[j] - mnew); sB[j] = __builtin_amdgcn_exp2f(sB[j] - mnew); ps += sA[j] + sB[j]; }
    lrun = lrun * alpha + ps;
    u32x4 pw; pw.x = cvt_pk_bf16(sA[0], sA[1]); pw.y = cvt_pk_bf16(sA[2], sA[3]); pw.z = cvt_pk_bf16(sB[0], sB[1]); pw.w = cvt_pk_bf16(sB[2], sB[3]);
    const bf16x8 pf = __builtin_bit_cast(bf16x8, pw);
#pragma unroll
    for (int dt = 0; dt < 4; ++dt) {
        o[dt] *= alpha;
        bf16x8 vf; vf[0] = b.vA[dt][0]; vf[1] = b.vA[dt][1]; vf[2] = b.vA[dt][2]; vf[3] = b.vA[dt][3]; vf[4] = b.vB[dt][0]; vf[5] = b.vB[dt][1]; vf[6] = b.vB[dt][2]; vf[7] = b.vB[dt][3];
#ifdef DBG_ATT2
        for (int e = 0; e < 8; ++e) o[dt][e & 3] += 1e-3f * __uint_as_float(((unsigned)(unsigned short)vf[e]) << 16);
#else
        o[dt] = __builtin_amdgcn_mfma_f32_16x16x32_bf16(vf, pf, o[dt], 0, 0, 0);
#endif
    }
}
__device__ __forceinline__ void step_attention(const Args& a, LAS unsigned char* lds, int pass, int tid, int bx) {
    unsigned char* ws = a.ws;
    const int lane = tid & 63;
    const bf16_t* Qp = (const bf16_t*)(ws + WS_Q); const bf16_t* Kp = (const bf16_t*)(ws + WS_K); const bf16_t* Vt = (const bf16_t*)(ws + WS_VT);
    const bf16_t* ZA = (const bf16_t*)(ws + WS_ZA); bf16_t* GAO = (bf16_t*)(ws + WS_GAO);
    const int xcd = bx & 7;
    unsigned* ctr = (unsigned*)(ws + WS_CTL) + 16 + pass * 8 + xcd;
    LAS unsigned* slot = (LAS unsigned*)(lds + 3 * 8192);
    constexpr int NGRP = 3 * 32 * 2;
    for (;;) {
        __syncthreads();
        if (tid == 0) slot[0] = atomicAdd(ctr, 1u);
        __syncthreads();
        const unsigned grp = (unsigned)__builtin_amdgcn_readfirstlane((int)slot[0]);
        if (grp >= (unsigned)NGRP) break;
        const int wv_ = tid >> 6; const int r = ((wv_ & 3) << 2) + (wv_ >> 2) + 2 * (int)(grp & 1)  , blk = (grp >> 1) & 31, pair = xcd * 3 + (int)(grp >> 6);
        const int h = pair & 7, sq = pair >> 3;
        const int qi = lane & 15, quad = lane >> 4;
        const int tq = sq * SEQL + 256 * blk + r + 16 * qi;
        QF qf;
        { const int pos = 256 * blk + r + 16 * qi;
          const bf16_t* qa = Qp + ((size_t)(sq * 24 + h) * SEQL + pos) * 64 + quad * 8;
          const bf16_t* qb = Qp + ((size_t)(sq * 24 + 8 + h) * SEQL + (pos & 3) * 2048 + (pos >> 2)) * 64 + quad * 8;
          const bf16_t* qc = Qp + ((size_t)(sq * 24 + 16 + h) * SEQL + (pos & 15) * 512 + (pos >> 4)) * 64 + quad * 8;
          qf.a0 = *(const bf16x8*)qa; qf.a1 = *(const bf16x8*)(qa + 32); qf.b0 = *(const bf16x8*)qb; qf.b1 = *(const bf16x8*)(qb + 32); qf.c0 = *(const bf16x8*)qc; qf.c1 = *(const bf16x8*)(qc + 32); }
        f32x4 o[4];
#pragma unroll
        for (int dt = 0; dt < 4; ++dt) o[dt] = (f32x4){0.f, 0.f, 0.f, 0.f};
        float mrun = -1e30f, lrun = 0.f;
        KVBuf b0, b1;
#define ATT_SB __builtin_amdgcn_sched_barrier(0);
        {
            const int wv = tid >> 6, region = wv >> 1;
            const bf16_t* gsrc = (region < 2 ? Kp + (size_t)(sq * 24 + h) * SEQL * 64 : Vt + (size_t)((sq * 3) * 8 + h) * 512 * 1024) + (wv & 1) * 512 + lane * 8;
            const int ubase = 256 * blk - 64 + (region & 1) * 16;
#define ATT_DMA(S) do { int uT = ubase + 32 * (S); if (uT < 0 || uT >= SEQL) uT = 0; \
                __builtin_amdgcn_global_load_lds((const unsigned*)(gsrc + (size_t)(uT >> 4) * 1024), (LAS unsigned*)(lds + ((S) % 3) * 8192 + wv * 1024), 16, 0, 0); } while (0)
            ATT_DMA(0); ATT_DMA(1);
            const int kl = lane & 15;
            const unsigned foff = (unsigned)(quad * 256 + kl * 16), voff = (unsigned)(4096 + quad * 128 + kl * 8);
#pragma unroll 1
            for (int s = 0; s < 12; ++s) {
                if (s < 11) asm volatile("s_waitcnt vmcnt(1)" ::: "memory"); else asm volatile("s_waitcnt vmcnt(0)" ::: "memory");
                __syncthreads();
                if (s + 2 < 12) ATT_DMA(s + 2);
                LAS unsigned char* kb = lds + (s % 3) * 8192;
                b0.kA0 = *(const LAS bf16x8*)(kb + foff); b0.kA1 = *(const LAS bf16x8*)(kb + foff + 1024); b0.kB0 = *(const LAS bf16x8*)(kb + 2048 + foff); b0.kB1 = *(const LAS bf16x8*)(kb + 2048 + foff + 1024);
#pragma unroll
                for (int dt = 0; dt < 4; ++dt) { b0.vA[dt] = *(const LAS bf16x4*)(kb + voff + dt * 512); b0.vB[dt] = *(const LAS bf16x4*)(kb + 2048 + voff + dt * 512); }
                attn_compute<0>(b0, qf.a0, qf.a1, o, mrun, lrun, s, blk, r, lane);
            }
#undef ATT_DMA
        }
        attn_load(b0, Kp, Vt, 12, sq, h, blk, r, lane);
#define ATT_LOOP(GI, S0, S1, QA, QB) _Pragma("unroll 1") for (int s = S0; s < S1; s += 2) { \
            ATT_SB attn_load(b1, Kp, Vt, s + 1, sq, h, blk, r, lane); ATT_SB attn_compute<GI>(b0, QA, QB, o, mrun, lrun, s, blk, r, lane); \
            ATT_SB attn_load(b0, Kp, Vt, s + 2, sq, h, blk, r, lane); ATT_SB attn_compute<GI>(b1, QA, QB, o, mrun, lrun, s + 1, blk, r, lane); ATT_SB }
        ATT_LOOP(1, 12, 18, qf.b0, qf.b1)
        ATT_LOOP(2, 18, 22, qf.c0, qf.c1)
#undef ATT_LOOP
        attn_compute<2>(b0, qf.c0, qf.c1, o, mrun, lrun, 22, blk, r, lane);
        float l = lrun; l += __shfl_xor(l, 16); l += __shfl_xor(l, 32);
        float inv = 1.0f / l;
#ifdef DBG_ATT1
        for (int dt = 0; dt < 4; ++dt) o[dt] = (f32x4){1.f, 1.f, 1.f, 1.f};
#endif
#pragma unroll
        for (int dt = 0; dt < 4; ++dt) {
            const size_t off = (size_t)tq * 512 + h * 64 + 16 * dt + 4 * quad;
            const u32x2 z = *(const u32x2*)(ZA + off);
            u32x2 w; w.x = cvt_pk_bf16(o[dt][0] * inv * bf_lo(z.x), o[dt][1] * inv * bf_hi(z.x)); w.y = cvt_pk_bf16(o[dt][2] * inv * bf_lo(z.y), o[dt][3] * inv * bf_hi(z.y));
            *(u32x2*)(GAO + off) = w;
        }
    }
}

__device__ __forceinline__ f32x2 cmul(f32x2 a, f32x2 b) { return (f32x2){a.x * b.x - a.y * b.y, a.x * b.y + a.y * b.x}; }
__device__ __forceinline__ void step_scan(const Args& a, LAS unsigned char* lds, int pass, int tid, int bx) {
    unsigned char* ws = a.ws; const int G = gridDim.x;
    const float* PW = (const float*)(ws + WS_PW); const float* S = (const float*)(ws + WS_S); bf16_t* UH = (bf16_t*)(ws + WS_UH);
    LAS f32x2* carry = (LAS f32x2*)lds;
    for (int it = bx; it < SEQP * 32 * 2; it += G) {
        const int dir = it & 1, g = (it >> 1) & 31, sq = it >> 6; const int seg = tid >> 6, n = tid & 63;
        const f32x2 P = (f32x2){PW[((dir * 32 + g) * 64 + n) * 2], PW[((dir * 32 + g) * 64 + n) * 2 + 1]};
        f32x2 z[32];
        { const int c0 = dir ? (NCH - 1 - seg * 32) : seg * 32; const long stp = dir ? -256 : 256;
          const float* sp = S + ((size_t)g * CHP + sq * NCH + c0) * 256 + dir * 128 + n;
#pragma unroll
          for (int i = 0; i < 32; ++i) { z[i] = (f32x2){sp[0], sp[64]}; sp += stp; } }
        f32x2 zz = (f32x2){0.f, 0.f};
#pragma unroll
        for (int i = 0; i < 32; ++i) { const f32x2 t = z[i]; z[i] = zz; zz = cmul(P, zz) + t; }
        __syncthreads();
        carry[seg * 64 + n] = zz;
        __syncthreads();
        f32x2 P32 = P;
#pragma unroll
        for (int k = 0; k < 5; ++k) P32 = cmul(P32, P32);
        f32x2 x = (f32x2){0.f, 0.f};
        for (int sp = 0; sp < seg; ++sp) x = cmul(P32, x) + carry[sp * 64 + n];
        f32x2 pwr = (f32x2){1.f, 0.f};
        { const int c0 = dir ? (NCH - 1 - seg * 32) : seg * 32; const long stp = dir ? -(long)UHK : (long)UHK;
          bf16_t* up = UH + ((size_t)g * CHP + sq * NCH + c0) * UHK + 512 + dir * 128 + n;
#pragma unroll
          for (int i = 0; i < 32; ++i) {
              const f32x2 hin = z[i] + cmul(pwr, x);
              up[0] = (bf16_t)(cvt_pk_bf16(hin.x, 0.f) & 0xffffu); up[64] = (bf16_t)(cvt_pk_bf16(hin.y, 0.f) & 0xffffu);
              pwr = cmul(pwr, P); up += stp;
          } }
    }
}

__device__ __forceinline__ void step_final_norm(const Args& a, int pass, int tid, int bx) {
    const int lane = tid & 63, wave = tid >> 6, G = gridDim.x;
    const f32x4* gr = (const f32x4*)a.in[16] + lane;
    f32x4 gv[4];
#pragma unroll
    for (int j = 0; j < 4; ++j) gv[j] = gr[64 * j];
    const bf16_t* accp = (const bf16_t*)(a.ws + WS_ACC);
    int row = bx * 8 + wave;
    f32x4 nx[4]; u32x2 na[4];
    if (row < TP) { const f32x4* xr = (const f32x4*)xrow_ptr(a.in[0], a.in[1], pass * TP + row) + lane; const u32x2* ar = (const u32x2*)(accp + (size_t)row * DM) + lane;
#pragma unroll
        for (int j = 0; j < 4; ++j) { nx[j] = xr[64 * j]; na[j] = ar[64 * j]; } }
    for (; row < TP; row += G * 8) {
        f32x4 v[4];
#pragma unroll
        for (int j = 0; j < 4; ++j) v[j] = nx[j] + (f32x4){bf_lo(na[j].x), bf_hi(na[j].x), bf_lo(na[j].y), bf_hi(na[j].y)};
        const int nrow = row + G * 8;
        if (nrow < TP) { const f32x4* xn = (const f32x4*)xrow_ptr(a.in[0], a.in[1], pass * TP + nrow) + lane; const u32x2* an = (const u32x2*)(accp + (size_t)nrow * DM) + lane;
#pragma unroll
            for (int j = 0; j < 4; ++j) { nx[j] = xn[64 * j]; na[j] = an[64 * j]; } }
        float s = 0.f;
#pragma unroll
        for (int j = 0; j < 4; ++j) s += (v[j].x * v[j].x + v[j].y * v[j].y) + (v[j].z * v[j].z + v[j].w * v[j].w);
        const float rstd = 1.0f / sqrtf(wave_sum(s) * (1.f / DM) + EPSN);
        f32x4* xr = (f32x4*)(a.out + (size_t)(pass * TP + row) * DM) + lane;
#pragma unroll
        for (int j = 0; j < 4; ++j) xr[64 * j] = v[j] * rstd * gv[j];
    }
}


#define XB_TMO      128
#define XB_XCNT(j)  (256  + 64 * (j))
#define XB_XSUB(j)  (1280 + 64 * (j))
#define XB_XGEN(j)  (2304 + 64 * (j))
#define XB_TOP      3328
#define XB_TOPGEN   3392
#define XCD_BAR_WORDS 3456
#define XB_SLOT(b)  (4096 + 2 * (b))
#define XB_SPIN_CAP (1u << 18)
__device__ __forceinline__ unsigned xb_ld(unsigned* p)              { return __hip_atomic_load(p, __ATOMIC_RELAXED, __HIP_MEMORY_SCOPE_AGENT); }
__device__ __forceinline__ unsigned xb_add(unsigned* p, unsigned v) { return __hip_atomic_fetch_add(p, v, __ATOMIC_RELAXED, __HIP_MEMORY_SCOPE_AGENT); }
__device__ __forceinline__ unsigned xb_xcc_id() { return (unsigned)__builtin_amdgcn_s_getreg((3 << 11) | 20) & 0xFu; }
#define XB_SPIN(cond, bar) do { unsigned _sp = 0; while (cond) { __builtin_amdgcn_s_sleep(1); \
    if ((++_sp & 255u) == 0u) { if (xb_ld(&(bar)[XB_TMO])) break; if (_sp > XB_SPIN_CAP) { atomicAdd(&(bar)[XB_TMO], 1u); break; } } } } while (0)
__device__ __forceinline__ void xcd_barrier_complete(unsigned* bar, unsigned x, unsigned& nloc, unsigned& nx) {
    const unsigned G = gridDim.x;
    unsigned sum, cnt, mine, sp = 0u;
    for (;;) {
        sum = 0u; cnt = 0u; mine = 0u;
#pragma unroll
        for (unsigned j = 0; j < 16; ++j) { const unsigned c = xb_ld(&bar[XB_XCNT(j)]); sum += c; cnt += (c > 0u) ? 1u : 0u; mine = (j == x) ? c : mine; }
        if (sum == G) break;
        __builtin_amdgcn_s_sleep(1);
        if ((++sp & 255u) == 0u) { if (xb_ld(&bar[XB_TMO])) break; if (sp > XB_SPIN_CAP) { atomicAdd(&bar[XB_TMO], 1u); break; } }
    }
    nloc = mine > 0u ? mine : 1u; nx = cnt > 0u ? cnt : 1u;
}
__device__ __forceinline__ void xcd_barrier(unsigned* bar) {
    asm volatile("s_waitcnt vmcnt(0)" ::: "memory");
    __syncthreads();
    if (threadIdx.x == 0) {
        __builtin_amdgcn_s_waitcnt(0);
        const unsigned x = xb_xcc_id();
        unsigned* slot = bar + XB_SLOT(blockIdx.x);
        unsigned nloc = xb_ld(slot), nx = xb_ld(slot + 1);
        if (nloc == 0u) { xcd_barrier_complete(bar, x, nloc, nx); __hip_atomic_store(slot, nloc, __ATOMIC_RELAXED, __HIP_MEMORY_SCOPE_AGENT); __hip_atomic_store(slot + 1, nx, __ATOMIC_RELAXED, __HIP_MEMORY_SCOPE_AGENT); }
        const unsigned old = xb_add(&bar[XB_XSUB(x)], 1u);
        const unsigned gen = old / nloc;
        if (old + 1u == (gen + 1u) * nloc) {
            __builtin_amdgcn_fence(__ATOMIC_RELEASE, "agent");
            asm volatile("s_waitcnt vmcnt(0)" ::: "memory");
            const unsigned og = xb_add(&bar[XB_TOP], 1u);
            const unsigned tg = og / nx;
            if (og + 1u == (tg + 1u) * nx) xb_add(&bar[XB_TOPGEN], 1u);
            else XB_SPIN(xb_ld(&bar[XB_TOPGEN]) == tg, bar);
            __builtin_amdgcn_fence(__ATOMIC_ACQUIRE, "agent");
            xb_add(&bar[XB_XGEN(x)], 1u);
            asm volatile("s_waitcnt vmcnt(0)" ::: "memory");
        } else {
            XB_SPIN(xb_ld(&bar[XB_XGEN(x)]) == gen, bar);
            __builtin_amdgcn_fence(__ATOMIC_ACQUIRE, "agent");
            asm volatile("s_waitcnt vmcnt(0)" ::: "memory");
        }
    }
    __syncthreads();
}

constexpr int NSTEPS = 1 + 10 * NPASS;
__host__ __device__ __forceinline__ bool sync_after(int st) { if (st == 0) return true; const int k = (st - 1) % 10; return !(k == 1 || k == 6 || k == 9); }

__global__ void __launch_bounds__(512, 2) fwd_kernel(Args a) {
    extern __shared__ __attribute__((aligned(16))) unsigned char lds_raw[];
    LAS unsigned char* lds = (LAS unsigned char*)lds_raw;
    cg::grid_group grid = cg::this_grid();
    const int G = gridDim.x;
    unsigned char* ws = a.ws;
    unsigned* bar = (unsigned*)(ws + WS_BAR);
    if (a.do_sync == 2) grid.sync();
    if (a.do_sync && threadIdx.x == 0) (void)xb_add(&bar[XB_XCNT(xb_xcc_id())], 1u);
    for (int st = a.st_lo; st < a.st_hi; ++st) {
        int tid = threadIdx.x, bx = blockIdx.x;
        asm volatile("" : "+v"(tid), "+s"(bx));
#ifndef NO_SETUP
        if (st == 0) { step_setup(a, lds, tid, bx); }
#else
        if (st == 0) {}
#endif
        else {
            const int pass = (st - 1) / 10, k = (st - 1) % 10;
            GemmD g; g.lgnN = 0; g.pass = pass; g.nb = 1; g.sA = 0; g.sB = 0;
            bool has_gemm = true;
            const bool split_ay = (G == 256);
            switch (k) {
            case 0: g.A = (const bf16_t*)((unsigned char*)a.out + OUT_HN_OFF) + (size_t)pass * TP * DM; g.lda = DM; g.Bt = (const bf16_t*)(ws + WS_WIN); g.ldb = DM; g.K = DM; g.nM = TP / BM; g.nN = INC / BM; g.lgnN = 5; g.mode = MODE_PROJ; break;
            case 1: g.A = (const bf16_t*)(ws + WS_UH); g.lda = UHK; g.sA = (unsigned)(CHP * UHK * 2); g.Bt = (const bf16_t*)(ws + WS_BST); g.ldb = 512; g.sB = (unsigned)(256 * 512 * 2); g.K = 512; g.nM = CHP / BM; g.nN = 1; g.nb = 32; g.mode = MODE_S; break;
            case 4:
                if (split_ay && bx < 128) { g.A = (const bf16_t*)(ws + WS_GAO); g.lda = 512; g.Bt = (const bf16_t*)(ws + WS_WA); g.ldb = 512; g.K = 512; g.nM = TP / BM; g.nN = 4; g.lgnN = 2; g.mode = MODE_A; }
                else { g.A = (const bf16_t*)(ws + WS_UH); g.lda = UHK; g.sA = (unsigned)(CHP * UHK * 2); g.Bt = (const bf16_t*)(ws + WS_MTC); g.ldb = UHK; g.sB = (unsigned)(512 * UHK * 2); g.K = UHK; g.nM = CHP / BM; g.nN = 2; g.nb = 32; g.mode = MODE_Y; }
                break;
            case 5: g.A = (const bf16_t*)(ws + WS_SG); g.lda = 512; g.Bt = (const bf16_t*)(ws + WS_WGLU); g.ldb = 512; g.K = 512; g.nM = TP / BM; g.nN = 2; g.lgnN = 1; g.mode = MODE_GLU; break;
            case 6: if (split_ay) { has_gemm = false; g.A = nullptr; g.Bt = nullptr; g.lda = g.ldb = g.K = 0; g.nM = g.nN = 0; g.mode = 0; } else { g.A = (const bf16_t*)(ws + WS_GAO); g.lda = 512; g.Bt = (const bf16_t*)(ws + WS_WA); g.ldb = 512; g.K = 512; g.nM = TP / BM; g.nN = 4; g.lgnN = 2; g.mode = MODE_A; } break;
            case 7: g.A = (const bf16_t*)(ws + WS_SB); g.lda = 512; g.Bt = (const bf16_t*)(ws + WS_WB); g.ldb = 512; g.K = 512; g.nM = TP / BM; g.nN = 4; g.lgnN = 2; g.mode = MODE_B; break;
            case 8: g.A = (const bf16_t*)(ws + WS_M1); g.lda = 1024; g.Bt = (const bf16_t*)(ws + WS_WOUT); g.ldb = 1024; g.K = 1024; g.nM = TP / BM; g.nN = 4; g.lgnN = 2; g.mode = MODE_OUT; break;
            default: has_gemm = false; g.A = nullptr; g.Bt = nullptr; g.lda = g.ldb = g.K = 0; g.nM = g.nN = 0; g.mode = 0; break;
            }
            { const int total = g.nM * g.nN * g.nb; g.u0 = bx; g.ustride = G; g.ucount = total > bx ? (total - bx + G - 1) / G : 0; }
            if (k == 4 && split_ay) { if (bx < 128) { g.u0 = bx; g.ustride = 128; g.ucount = 3; } else { g.u0 = bx - 128; g.ustride = 128; g.ucount = (bx - 128) < 64 ? 2 : 1; } }
            if (has_gemm) {
#ifndef NO_GEMM
                gemm_phase(a, lds, g, G, bx, tid);
#endif
            }
#ifndef NO_ATTN
            else if (k == 2) step_attention(a, lds, pass, tid, bx);
#endif
#ifndef NO_SCAN
            else if (k == 3) step_scan(a, lds, pass, tid, bx);
#endif
            else if (k == 9) step_final_norm(a, pass, tid, bx);
        }
        if (a.do_sync && st + 1 < a.st_hi && sync_after(st)) xcd_barrier(bar);
    }
}

extern "C" void kernel_launch(void* const* d_in, const int* in_sizes, int n_in, void* d_out, int out_size, void* d_ws, size_t ws_size, hipStream_t stream) {
    constexpr int LDS_BYTES = STAGE_BYTES + 32768;
    static int grid = 0;
    if (grid == 0) {
        if (n_in != 17 || out_size != TTOK * DM || ws_size < WS_END) { fprintf(stderr, "kernel_launch: unexpected shapes (n_in %d out %d ws %zu need %zu)\n", n_in, out_size, ws_size, (size_t)WS_END); grid = -1; return; }
        int dev = 0, cus = 0, per_cu = 0;
        hipGetDevice(&dev); hipDeviceGetAttribute(&cus, hipDeviceAttributeMultiprocessorCount, dev);
        hipFuncSetAttribute((const void*)fwd_kernel, hipFuncAttributeMaxDynamicSharedMemorySize, LDS_BYTES);
        hipOccupancyMaxActiveBlocksPerMultiprocessor(&per_cu, (const void*)fwd_kernel, 512, LDS_BYTES);
        if (per_cu < 1) per_cu = 1;
        grid = cus * 1;
        (void)hipGetLastError();
    }
    if (grid < 0) return;
    (void)hipMemsetAsync((unsigned char*)d_ws + WS_CTL, 0, 4096, stream);
    (void)hipMemsetAsync((unsigned char*)d_ws + WS_BAR, 0, WS_BAR_BYTES, stream);
    Args a{};
    for (int i = 0; i < 17; ++i) a.in[i] = (const float*)d_in[i];
    a.out = (float*)d_out; a.ws = (unsigned char*)d_ws; a.pad = 0;
#ifndef MULTI_LAUNCH
#define MULTI_LAUNCH 0
#endif
#if MULTI_LAUNCH
    a.do_sync = 0;
    for (int st = 0; st < NSTEPS; ++st) {
        a.st_lo = st; a.st_hi = st + 1;
        hipLaunchKernelGGL(fwd_kernel, dim3(grid), dim3(512), LDS_BYTES, stream, a);
    }
#else
    a.do_sync = 1; a.st_lo = 0; a.st_hi = NSTEPS;
    void* args[] = {&a};
    hipError_t e = hipLaunchCooperativeKernel((const void*)fwd_kernel, dim3(grid), dim3(512), args, LDS_BYTES, stream);
    if (e != hipSuccess) fprintf(stderr, "cooperative launch failed: %s (grid %d)\n", hipGetErrorString(e), grid);
#endif
}
```

```cpp
#include <hip/hip_runtime.h>
#include <hip/hip_cooperative_groups.h>
#include <cstdio>

namespace cg = cooperative_groups;

#define LAS __attribute__((address_space(3)))
typedef unsigned short bf16_t;
typedef short bf16x8 __attribute__((ext_vector_type(8)));
typedef short bf16x4 __attribute__((ext_vector_type(4)));
typedef float f32x4 __attribute__((ext_vector_type(4)));
typedef float f32x2 __attribute__((ext_vector_type(2)));
typedef unsigned u32x4 __attribute__((ext_vector_type(4)));
typedef unsigned u32x2 __attribute__((ext_vector_type(2)));

constexpr int DM = 1024, SEQL = 8192, NSEQ = 6, TTOK = NSEQ * SEQL;
constexpr int NPASS = 2, SEQP = 3, TP = SEQP * SEQL;
constexpr int INC = 8192, QKVW = 1536;
constexpr int LC = 32, NCH = SEQL / LC  , CHP = SEQP * NCH  ;
constexpr int UHK = LC * 16 + 256;
constexpr float EPSN = 1e-6f;
constexpr float QSCALE = 0.18033688011112042f;

constexpr size_t AL(size_t x) { return (x + 255) & ~(size_t)255; }
constexpr size_t WS_CTL = 0;
constexpr size_t WS_WIN = 4096;
constexpr size_t WS_WGLU = WS_WIN + (size_t)INC * DM * 2;
constexpr size_t WS_WA = WS_WGLU + (size_t)512 * 512 * 2;
constexpr size_t WS_WB = WS_WA + (size_t)1024 * 512 * 2;
constexpr size_t WS_WOUT = WS_WB + (size_t)1024 * 512 * 2;
constexpr size_t WS_MTC = WS_WOUT + (size_t)1024 * 1024 * 2;
constexpr size_t WS_BST = WS_MTC + (size_t)32 * 512 * UHK * 2;
constexpr size_t WS_ROPE = WS_BST + (size_t)32 * 256 * 512 * 2;
constexpr size_t WS_PW = WS_ROPE + (size_t)2 * SEQL * 32 * 4;
constexpr size_t WS_KT = WS_PW + (size_t)2 * 32 * 64 * 8;
constexpr size_t WS_Q = WS_KT + (size_t)32 * 2 * 32 * 256 * 4;
constexpr size_t WS_K = WS_Q + (size_t)TP * QKVW * 2;
constexpr size_t WS_VT = WS_K + (size_t)TP * QKVW * 2;
constexpr size_t WS_ZA = WS_VT + (size_t)TP * QKVW * 2;
constexpr size_t WS_ZB = WS_ZA + (size_t)TP * 512 * 2;
constexpr size_t WS_GA = WS_ZB + (size_t)TP * 512 * 2;
constexpr size_t WS_GB = WS_GA + (size_t)TP * 1024 * 2;
constexpr size_t WS_UH = WS_GB + (size_t)TP * 1024 * 2;
constexpr size_t WS_S = WS_UH + (size_t)32 * CHP * UHK * 2;
constexpr size_t WS_GAO = WS_S + (size_t)32 * CHP * 256 * 4;
constexpr size_t WS_BAR = WS_GAO + (size_t)TP * 512 * 2;
constexpr size_t WS_BAR_BYTES = 32768;
constexpr size_t WS_END = WS_BAR + WS_BAR_BYTES;
constexpr size_t WS_SG = WS_Q;
constexpr size_t WS_SB = WS_Q + (size_t)TP * 512 * 2;
constexpr size_t WS_M1 = WS_K;
constexpr size_t WS_ACC = WS_Q;
constexpr size_t OUT_HN_OFF = (size_t)SEQP * SEQL * DM * 4;

struct Args {
    const float* in[17];
    float* out;
    unsigned char* ws;
    int st_lo, st_hi;
    int do_sync, pad;
};

typedef __bf16 bf16v2 __attribute__((ext_vector_type(2)));
__device__ __forceinline__ unsigned cvt_pk_bf16(float lo, float hi) { const f32x2 v = (f32x2){lo, hi}; const bf16v2 r = __builtin_convertvector(v, bf16v2); return __builtin_bit_cast(unsigned, r); }
__device__ __forceinline__ float bf_lo(unsigned w) { return __uint_as_float(w << 16); }
__device__ __forceinline__ float bf_hi(unsigned w) { return __uint_as_float(w & 0xffff0000u); }
__device__ __forceinline__ float fast_rcp(float x) { return __builtin_amdgcn_rcpf(x); }
__device__ __forceinline__ float sigmoidf_(float x) { return fast_rcp(1.0f + __builtin_amdgcn_exp2f(-1.4426950408889634f * x)); }
__device__ __forceinline__ float siluf_(float x) { return x * sigmoidf_(x); }
__device__ __forceinline__ float gelu_tanh(float x) { const float u = x * (1.5957691216057308f + 0.07135481627260025f * x * x); return x * sigmoidf_(u); }
__device__ __forceinline__ float wave_sum(float v) {
#pragma unroll
    for (int o = 1; o < 64; o <<= 1) v += __shfl_xor(v, o);
    return v;
}
__device__ __forceinline__ const float* xrow_ptr(const float* xp, const float* xs, int tg) {
    return tg < 4 * SEQL ? xp + (size_t)tg * DM : xs + (size_t)(tg - 4 * SEQL) * DM;
}

constexpr int BM = 256, BK = 64, HALF = 128, HTB = HALF * BK * 2, STAGE_BYTES = 8 * HTB, NXCD = 8, WGM = 8;
__host__ __device__ __forceinline__ int lds_byte(int r, int c) { const int st = (r >> 4) * 2 + (c >> 5), rr = r & 15, cc = c & 31, ob = rr * 64 + cc * 2; return st * 1024 + (ob ^ (((ob >> 9) & 1) << 5)); }
__host__ __device__ __forceinline__ void stage_rc(int b, int& R, int& C) { const int st = b / 1024, sb = b % 1024, swz = sb ^ (((sb >> 9) & 1) << 5); R = (st >> 1) * 16 + swz / 64; C = (st & 1) * 32 + (swz % 64) / 2; }
__host__ __device__ __forceinline__ int perm32(int rho) { const int n = rho >> 4, i = rho & 15; return 8 * (i >> 2) + 4 * n + (i & 3); }

enum { MODE_PROJ = 0, MODE_S = 1, MODE_Y = 2, MODE_GLU = 3, MODE_A = 4, MODE_B = 5, MODE_OUT = 6 };
struct Unit { int pm, pn, bz; };
struct GemmD {
    const bf16_t* A; const bf16_t* Bt;
    int lda, ldb, K, nM, nN, nb;
    unsigned sA, sB;
    int mode, pass, lgnN;
    int u0, ustride, ucount;
};
__device__ __forceinline__ bool unit_next(const GemmD& g, int i, int G, int c, int& pm, int& pn, int& bz) {
    const bool ok = i < g.ucount;
    const int Li = ok ? g.u0 + i * g.ustride : 0;
    if (g.nb == 1) {
        const int lg = g.lgnN, q = (g.nM << lg) >> 3;
        const int wgid = (Li & 7) * q + (Li >> 3);
        const int gid = wgid >> (3 + lg), rem = wgid & ((8 << lg) - 1);
        pm = gid * 8 + (rem & 7); pn = rem >> 3; bz = 0;
    } else {
        const int nwg = g.nM * g.nN;
        const int w = Li % nwg; bz = Li / nwg; pm = w % g.nM; pn = w / g.nM;
    }
    return ok;
}

__device__ __forceinline__ void epilogue(const Args& a, LAS unsigned char* lds, const GemmD& g, const f32x4 (&acc)[2][2][4][2], const Unit& u, int wr, int wc, int fr, int fq) {
    asm volatile("" : "+v"(fr), "+v"(fq));
    unsigned char* ws = a.ws;
    const int rbase = u.pm * BM + wr * 64 + fr;
    const int cl = wc * 32 + fq * 8;
    if (g.mode == MODE_PROJ) {
        const int pn = u.pn;
        if (pn < 12) {
            const bool isq = pn < 6;
            bf16_t* dst = (bf16_t*)(ws + (isq ? WS_Q : WS_K));
            const float* rc = (const float*)(ws + WS_ROPE); const float* rs = rc + SEQL * 32;
            const int a4 = 4 * (4 * (wc & 1) + fq);
            const int pq = isq ? pn : pn - 6, gi = pq >> 1, sh = 2 * gi, dmask = (1 << sh) - 1, Lg = SEQL >> sh;
            const float sc = isq ? QSCALE : 1.0f;
#pragma unroll
            for (int ai = 0; ai < 2; ++ai) {
                asm volatile("" ::: "memory");
                f32x4 cvv[4], svv[4];
#pragma unroll
                for (int m = 0; m < 4; ++m) { const int pos = (rbase + ai * HALF + m * 16) & (SEQL - 1); cvv[m] = *(const f32x4*)(rc + pos * 32 + a4); svv[m] = *(const f32x4*)(rs + pos * 32 + a4); }
#pragma unroll
                for (int m = 0; m < 4; ++m) {
                    const int tl = rbase + ai * HALF + m * 16; const int pos = tl & (SEQL - 1), sq = tl >> 13;
                    const int kidx = (pos & dmask) * Lg + (pos >> sh);
                    const f32x4 cv = cvv[m] * sc, sv = svv[m] * sc;
#pragma unroll
                    for (int bj = 0; bj < 2; ++bj) {
                        const f32x4 x1 = acc[ai][bj][m][0], x2 = acc[ai][bj][m][1];
                        const f32x4 o1 = x1 * cv - x2 * sv, o2 = x2 * cv + x1 * sv;
                        const int head = pq * 4 + 2 * bj + (wc >> 1);
                        const int ch = 4 * (wc & 1) + fq;
                        bf16_t* p = dst + (size_t)(sq * 24 + head) * SEQL * 64 + (isq ? (size_t)kidx * 64 + ch * 8 : (size_t)(kidx >> 4) * 1024 + ch * 128 + (kidx & 15) * 8);
                        u32x4 w; w.x = cvt_pk_bf16(o1[0], o1[1]); w.y = cvt_pk_bf16(o1[2], o1[3]); w.z = cvt_pk_bf16(o2[0], o2[1]); w.w = cvt_pk_bf16(o2[2], o2[3]);
                        *(u32x4*)p = w;
                    }
                }
            }
        } else if (pn < 18) {
            bf16_t* dst = (bf16_t*)(ws + WS_VT);
            const int gi = (pn - 12) >> 1, sh = 2 * gi;
            const int wid = wr * 4 + wc, lane = fq * 16 + fr;
            LAS bf16_t* tile = (LAS bf16_t*)(lds + STAGE_BYTES + wid * 4096);
#pragma unroll
            for (int ai = 0; ai < 2; ++ai) {
                const int tl0 = u.pm * BM + wr * 64 + ai * HALF;
                const int pos0 = tl0 & (SEQL - 1), sq = tl0 >> 13;
#pragma unroll
                for (int bj = 0; bj < 2; ++bj) {
                    asm volatile("" ::: "memory");
                    const int h = (4 * (pn - 12) + 2 * bj + (wc >> 1)) & 7;
#pragma unroll
                    for (int m = 0; m < 4; ++m) {
                        const int t = 16 * m + fr;
                        const int slot = gi == 0 ? t : (gi == 1 ? ((t & 3) * 16 + (t >> 2)) : ((t & 15) * 4 + (t >> 4)));
#pragma unroll
                        for (int n = 0; n < 2; ++n)
#pragma unroll
                            for (int j = 0; j < 4; ++j) { const unsigned w = cvt_pk_bf16(acc[ai][bj][m][n][j], 0.f); tile[(8 * fq + 4 * n + j) * 64 + slot] = (bf16_t)(w & 0xffffu); }
                    }
                    bf16_t* hb0 = dst + (size_t)(((sq * 3 + gi) * 8 + h) * 512) * 1024;
#pragma unroll
                    for (int i = 0; i < 4; ++i) {
                        const int c = lane + 64 * i, d = c >> 3, s8 = (c & 7) * 8;
                        const u32x4 v = *(const LAS u32x4*)(tile + d * 64 + s8);
                        const int dg = 32 * (wc & 1) + d; const int doff = (dg >> 4) * 256 + (dg & 15) * 4;
                        if (gi == 0) { const int kidx = pos0 + s8; bf16_t* q = hb0 + (size_t)(kidx >> 4) * 1024 + doff + ((kidx & 15) >> 2) * 64; *(u32x2*)q = (u32x2){v.x, v.y}; *(u32x2*)(q + 64) = (u32x2){v.z, v.w}; }
                        else if (gi == 1) { const int kidx = (s8 >> 4) * 2048 + (pos0 >> 2) + (s8 & 15); bf16_t* q = hb0 + (size_t)(kidx >> 4) * 1024 + doff + ((kidx & 15) >> 2) * 64; *(u32x2*)q = (u32x2){v.x, v.y}; *(u32x2*)(q + 64) = (u32x2){v.z, v.w}; }
                        else { const int ka = (s8 >> 2) * 512 + (pos0 >> 4), kb = ka + 512;
                            *(u32x2*)(hb0 + (size_t)(ka >> 4) * 1024 + doff + ((ka & 15) >> 2) * 64) = (u32x2){v.x, v.y}; *(u32x2*)(hb0 + (size_t)(kb >> 4) * 1024 + doff + ((kb & 15) >> 2) * 64) = (u32x2){v.z, v.w}; }
                    }
                }
            }
        } else if (pn == 20 || pn == 21) {
            bf16_t* dst = (bf16_t*)(ws + WS_UH);
#pragma unroll
            for (int ai = 0; ai < 2; ++ai)
#pragma unroll
                for (int m = 0; m < 4; ++m) { asm volatile("" ::: "memory");
                    const int tl = rbase + ai * HALF + m * 16;
#pragma unroll
                    for (int bj = 0; bj < 2; ++bj) {
                        const int gg = 16 * (pn - 20) + 8 * bj + 2 * wc + (fq >> 1);
                        bf16_t* p = dst + ((size_t)(gg * CHP + (tl >> 5)) * UHK) + (tl & 31) * 16 + 8 * (fq & 1);
                        const f32x4 v0 = acc[ai][bj][m][0], v1 = acc[ai][bj][m][1];
                        u32x4 w; w.x = cvt_pk_bf16(v0[0], v0[1]); w.y = cvt_pk_bf16(v0[2], v0[3]); w.z = cvt_pk_bf16(v1[0], v1[1]); w.w = cvt_pk_bf16(v1[2], v1[3]);
                        *(u32x4*)p = w;
                    }
                }
        } else {
            bf16_t* dst; int ld, c0; bool silu;
            if (pn < 20) { dst = (bf16_t*)(ws + WS_ZA); ld = 512; c0 = (pn - 18) * 256; silu = true; }
            else if (pn < 24) { dst = (bf16_t*)(ws + WS_ZB); ld = 512; c0 = (pn - 22) * 256; silu = true; }
            else if (pn < 28) { dst = (bf16_t*)(ws + WS_GA); ld = 1024; c0 = (pn - 24) * 256; silu = false; }
            else { dst = (bf16_t*)(ws + WS_GB); ld = 1024; c0 = (pn - 28) * 256; silu = false; }
#pragma unroll
            for (int ai = 0; ai < 2; ++ai)
#pragma unroll
                for (int m = 0; m < 4; ++m) { asm volatile("" ::: "memory");
                    const int tl = rbase + ai * HALF + m * 16;
#pragma unroll
                    for (int bj = 0; bj < 2; ++bj) {
                        f32x4 v0 = acc[ai][bj][m][0], v1 = acc[ai][bj][m][1];
#pragma unroll
                        for (int j = 0; j < 4; ++j) { const float s0 = sigmoidf_(v0[j]), s1 = sigmoidf_(v1[j]); v0[j] = silu ? v0[j] * s0 : s0; v1[j] = silu ? v1[j] * s1 : s1; }
                        u32x4 w; w.x = cvt_pk_bf16(v0[0], v0[1]); w.y = cvt_pk_bf16(v0[2], v0[3]); w.z = cvt_pk_bf16(v1[0], v1[1]); w.w = cvt_pk_bf16(v1[2], v1[3]);
                        *(u32x4*)(dst + (size_t)tl * ld + c0 + cl + bj * HALF) = w;
                    }
                }
        }
    } else if (g.mode == MODE_S) {
        float* dst = (float*)(ws + WS_S) + (size_t)u.bz * CHP * 256;
#pragma unroll
        for (int ai = 0; ai < 2; ++ai)
#pragma unroll
            for (int m = 0; m < 4; ++m) { asm volatile("" ::: "memory");
                const int r = rbase + ai * HALF + m * 16;
#pragma unroll
                for (int bj = 0; bj < 2; ++bj) { float* p = dst + (size_t)r * 256 + cl + bj * HALF; *(f32x4*)p = acc[ai][bj][m][0]; *(f32x4*)(p + 4) = acc[ai][bj][m][1]; }
            }
    } else if (g.mode == MODE_Y) {
        bf16_t* dst = (bf16_t*)(ws + WS_SG);
#pragma unroll
        for (int ai = 0; ai < 2; ++ai)
#pragma unroll
            for (int m = 0; m < 4; ++m) { asm volatile("" ::: "memory");
                const int r = rbase + ai * HALF + m * 16;
#pragma unroll
                for (int bj = 0; bj < 2; ++bj) {
                    const int t = 16 * u.pn + 8 * bj + 2 * wc + (fq >> 1);
                    f32x4 v0 = acc[ai][bj][m][0], v1 = acc[ai][bj][m][1];
#pragma unroll
                    for (int j = 0; j < 4; ++j) { v0[j] = gelu_tanh(v0[j]); v1[j] = gelu_tanh(v1[j]); }
                    u32x4 w; w.x = cvt_pk_bf16(v0[0], v0[1]); w.y = cvt_pk_bf16(v0[2], v0[3]); w.z = cvt_pk_bf16(v1[0], v1[1]); w.w = cvt_pk_bf16(v1[2], v1[3]);
                    *(u32x4*)(dst + (size_t)(r * LC + t) * 512 + u.bz * 16 + 8 * (fq & 1)) = w;
                }
            }
    } else if (g.mode == MODE_GLU) {
        const bf16_t* sg = (const bf16_t*)(ws + WS_SG); const bf16_t* zb = (const bf16_t*)(ws + WS_ZB); bf16_t* dst = (bf16_t*)(ws + WS_SB);
#pragma unroll
        for (int ai = 0; ai < 2; ++ai) {
            asm volatile("" ::: "memory");
            u32x4 sv4[4][2], zv4[4][2];
#pragma unroll
            for (int m = 0; m < 4; ++m)
#pragma unroll
                for (int bj = 0; bj < 2; ++bj) { const size_t off = (size_t)(rbase + ai * HALF + m * 16) * 512 + u.pn * BM + cl + bj * HALF; sv4[m][bj] = *(const u32x4*)(sg + off); zv4[m][bj] = *(const u32x4*)(zb + off); }
#pragma unroll
            for (int m = 0; m < 4; ++m)
#pragma unroll
                for (int bj = 0; bj < 2; ++bj) {
                    const size_t off = (size_t)(rbase + ai * HALF + m * 16) * 512 + u.pn * BM + cl + bj * HALF;
                    const u32x4 s4 = sv4[m][bj], z4 = zv4[m][bj];
                    const f32x4 v0 = acc[ai][bj][m][0], v1 = acc[ai][bj][m][1];
                    u32x4 w;
                    w.x = cvt_pk_bf16(bf_lo(s4.x) * sigmoidf_(v0[0]) * bf_lo(z4.x), bf_hi(s4.x) * sigmoidf_(v0[1]) * bf_hi(z4.x));
                    w.y = cvt_pk_bf16(bf_lo(s4.y) * sigmoidf_(v0[2]) * bf_lo(z4.y), bf_hi(s4.y) * sigmoidf_(v0[3]) * bf_hi(z4.y));
                    w.z = cvt_pk_bf16(bf_lo(s4.z) * sigmoidf_(v1[0]) * bf_lo(z4.z), bf_hi(s4.z) * sigmoidf_(v1[1]) * bf_hi(z4.z));
                    w.w = cvt_pk_bf16(bf_lo(s4.w) * sigmoidf_(v1[2]) * bf_lo(z4.w), bf_hi(s4.w) * sigmoidf_(v1[3]) * bf_hi(z4.w));
                    *(u32x4*)(dst + off) = w;
                }
        }
    } else if (g.mode == MODE_A || g.mode == MODE_B) {
        const bool isb = g.mode == MODE_B;
        const bf16_t* gt = (const bf16_t*)(ws + (isb ? WS_GB : WS_GA)); bf16_t* dst = (bf16_t*)(ws + WS_M1);
#pragma unroll
        for (int ai = 0; ai < 2; ++ai) {
            asm volatile("" ::: "memory");
            u32x4 gv4[4][2], pv4[4][2];
#pragma unroll
            for (int m = 0; m < 4; ++m)
#pragma unroll
                for (int bj = 0; bj < 2; ++bj) { const size_t off = (size_t)(rbase + ai * HALF + m * 16) * 1024 + u.pn * BM + cl + bj * HALF; gv4[m][bj] = *(const u32x4*)(gt + off); pv4[m][bj] = (u32x4){0u, 0u, 0u, 0u}; if (isb) pv4[m][bj] = *(const u32x4*)(dst + off); }
#pragma unroll
            for (int m = 0; m < 4; ++m)
#pragma unroll
                for (int bj = 0; bj < 2; ++bj) {
                    const size_t off = (size_t)(rbase + ai * HALF + m * 16) * 1024 + u.pn * BM + cl + bj * HALF;
                    const u32x4 g4 = gv4[m][bj], p4 = pv4[m][bj];
                    const f32x4 v0 = acc[ai][bj][m][0], v1 = acc[ai][bj][m][1];
                    u32x4 w;
                    w.x = cvt_pk_bf16(bf_lo(p4.x) + bf_lo(g4.x) * v0[0], bf_hi(p4.x) + bf_hi(g4.x) * v0[1]);
                    w.y = cvt_pk_bf16(bf_lo(p4.y) + bf_lo(g4.y) * v0[2], bf_hi(p4.y) + bf_hi(g4.y) * v0[3]);
                    w.z = cvt_pk_bf16(bf_lo(p4.z) + bf_lo(g4.z) * v1[0], bf_hi(p4.z) + bf_hi(g4.z) * v1[1]);
                    w.w = cvt_pk_bf16(bf_lo(p4.w) + bf_lo(g4.w) * v1[2], bf_hi(p4.w) + bf_hi(g4.w) * v1[3]);
                    *(u32x4*)(dst + off) = w;
                }
        }
    } else {
        bf16_t* dst = (bf16_t*)(ws + WS_ACC);
#pragma unroll
        for (int ai = 0; ai < 2; ++ai)
#pragma unroll
            for (int m = 0; m < 4; ++m) {
                const int tl = rbase + ai * HALF + m * 16;
#pragma unroll
                for (int bj = 0; bj < 2; ++bj) {
                    const f32x4 v0 = acc[ai][bj][m][0], v1 = acc[ai][bj][m][1];
                    u32x4 w; w.x = cvt_pk_bf16(v0[0], v0[1]); w.y = cvt_pk_bf16(v0[2], v0[3]); w.z = cvt_pk_bf16(v1[0], v1[1]); w.w = cvt_pk_bf16(v1[2], v1[3]);
                    *(u32x4*)(dst + (size_t)tl * DM + u.pn * BM + cl + bj * HALF) = w;
                }
            }
    }
}

__device__ __forceinline__ void gemm_phase(const Args& a, LAS unsigned char* lds, const GemmD& g, int G, int cidx, int tid) {
    const int wid = __builtin_amdgcn_readfirstlane(tid >> 6), lane = tid & 63, wr = wid >> 2, wc = wid & 3, fr = lane & 15, fq = lane >> 4;
    const int K = g.K, nt = K / BK;
    unsigned voffA[2], voffB[2];
#pragma unroll
    for (int i = 0; i < 2; ++i) { int R, C; stage_rc(tid * 16 + i * 8192, R, C); const int Rb = (R & ~31) + perm32(R & 31);
        voffA[i] = (unsigned)(R * g.lda + C) * 2u; voffB[i] = (unsigned)(Rb * g.ldb + C) * 2u; }
    const size_t kstep = (size_t)(BK * 2);
    const size_t hstepA = (size_t)HALF * g.lda * 2, hstepB = (size_t)HALF * g.ldb * 2;
    const size_t tstepA = 2 * hstepA, tstepB = 2 * hstepB;
    const unsigned ldsw = (unsigned)wid * 1024u;
    const int aoff = lds_byte(wr * 64 + fr, fq * 8), boff = lds_byte(wc * 32 + fr, fq * 8);
#define PG8_SA(b, h) (((b) * 2 + (h)) * HTB)
#define PG8_SB(b, h) ((4 + (b) * 2 + (h)) * HTB)
#define PG8_STAGE(bufoff, gbase, voff) do { _Pragma("unroll") for (int _i = 0; _i < 2; ++_i) \
        __builtin_amdgcn_global_load_lds((const unsigned*)((const char*)(gbase) + (voff)[_i]), (LAS unsigned*)(lds + (bufoff) + ldsw + _i * 8192), 16, 0, 0); } while (0)
#define PG8_LDA(dst, b, h) do { _Pragma("unroll") for (int m = 0; m < 4; ++m) _Pragma("unroll") for (int k = 0; k < 2; ++k) dst[m][k] = *(const LAS bf16x8*)(lds + PG8_SA(b, h) + aoff + m * 2048 + k * 1024); } while (0)
#define PG8_LDB(dst, b, h) do { _Pragma("unroll") for (int n = 0; n < 2; ++n) _Pragma("unroll") for (int k = 0; k < 2; ++k) dst[n][k] = *(const LAS bf16x8*)(lds + PG8_SB(b, h) + boff + n * 2048 + k * 1024); } while (0)
#define PG8_MMA(ai, bj, At, Bt) do { __builtin_amdgcn_s_setprio(1); _Pragma("unroll") for (int m = 0; m < 4; ++m) _Pragma("unroll") for (int n = 0; n < 2; ++n) _Pragma("unroll") for (int k = 0; k < 2; ++k) \
        acc[ai][bj][m][n] = __builtin_amdgcn_mfma_f32_16x16x32_bf16(Bt[n][k], At[m][k], acc[ai][bj][m][n], 0, 0, 0); __builtin_amdgcn_s_setprio(0); } while (0)
#define PG8_WAIT_V(n) asm volatile("s_waitcnt vmcnt(" #n ")" ::: "memory")
#define PG8_WAIT_L(n) asm volatile("s_waitcnt lgkmcnt(" #n ")" ::: "memory")
#define PG8_BAR __builtin_amdgcn_s_barrier()
#define PG8_SCHED __builtin_amdgcn_sched_barrier(0)
    Unit cur, nxt; int ui = 0;
    { int pm_, pn_, bz_; if (!unit_next(g, 0, G, cidx, pm_, pn_, bz_)) return; cur.pm = pm_; cur.pn = pn_; cur.bz = bz_; }
    f32x4 acc[2][2][4][2];
#pragma unroll
    for (int a = 0; a < 2; ++a)
#pragma unroll
        for (int b = 0; b < 2; ++b)
#pragma unroll
            for (int m = 0; m < 4; ++m)
#pragma unroll
                for (int n = 0; n < 2; ++n) acc[a][b][m][n] = (f32x4){0.f, 0.f, 0.f, 0.f};
    bf16x8 At[4][2], B0[2][2], B1[2][2];
    const char* cA = (const char*)g.A + (size_t)cur.bz * g.sA + (size_t)cur.pm * tstepA; const char* cB = (const char*)g.Bt + (size_t)cur.bz * g.sB + (size_t)cur.pn * tstepB;
    PG8_STAGE(PG8_SB(0, 0), cB, voffB); PG8_STAGE(PG8_SA(0, 0), cA, voffA); PG8_STAGE(PG8_SB(0, 1), cB + hstepB, voffB); PG8_STAGE(PG8_SA(0, 1), cA + hstepA, voffA);
    if (wr == 1) PG8_BAR;
    PG8_WAIT_V(4); PG8_BAR;
    PG8_STAGE(PG8_SB(1, 0), cB + kstep, voffB); PG8_STAGE(PG8_SA(1, 0), cA + kstep, voffA); PG8_STAGE(PG8_SB(1, 1), cB + hstepB + kstep, voffB);
    PG8_WAIT_V(6); PG8_BAR;
    for (;;) {
        int npm, npn, nbz; const bool has_next = unit_next(g, ui + 1, G, cidx, npm, npn, nbz); nxt.pm = npm; nxt.pn = npn; nxt.bz = nbz;
        const char* nA = has_next ? (const char*)g.A + (size_t)nxt.bz * g.sA + (size_t)nxt.pm * tstepA : cA; const char* nB = has_next ? (const char*)g.Bt + (size_t)nxt.bz * g.sB + (size_t)nxt.pn * tstepB : cB;
        for (int t = 0; t < nt; t += 2) {
            const bool last = (t == nt - 2);
            const char* a1 = cA + (size_t)(t + 1) * kstep;
            const char* a2 = last ? nA : cA + (size_t)(t + 2) * kstep; const char* b2 = last ? nB : cB + (size_t)(t + 2) * kstep;
            const char* a3 = a2 + kstep; const char* b3 = b2 + kstep;
            PG8_LDB(B0, 0, 0); PG8_SCHED; PG8_LDA(At, 0, 0); PG8_STAGE(PG8_SA(1, 1), a1 + hstepA, voffA);
            PG8_WAIT_L(8); PG8_BAR; PG8_WAIT_L(0); PG8_MMA(0, 0, At, B0); PG8_BAR; PG8_SCHED;
            PG8_LDB(B1, 0, 1); PG8_STAGE(PG8_SB(0, 0), b2, voffB);
            PG8_BAR; PG8_WAIT_L(0); PG8_MMA(0, 1, At, B1); PG8_BAR;
            PG8_LDA(At, 0, 1); PG8_STAGE(PG8_SA(0, 0), a2, voffA);
            PG8_BAR; PG8_WAIT_L(0); PG8_MMA(1, 0, At, B0); PG8_BAR; PG8_SCHED;
            PG8_STAGE(PG8_SB(0, 1), b2 + hstepB, voffB);
            PG8_WAIT_V(6); PG8_BAR; PG8_MMA(1, 1, At, B1); PG8_BAR;
            PG8_LDB(B0, 1, 0); PG8_SCHED; PG8_LDA(At, 1, 0); PG8_STAGE(PG8_SA(0, 1), a2 + hstepA, voffA);
            PG8_WAIT_L(8); PG8_BAR; PG8_WAIT_L(0); PG8_MMA(0, 0, At, B0); PG8_BAR; PG8_SCHED;
            PG8_LDB(B1, 1, 1); PG8_STAGE(PG8_SB(1, 0), b3, voffB);
            PG8_BAR; PG8_WAIT_L(0); PG8_MMA(0, 1, At, B1); PG8_BAR;
            PG8_LDA(At, 1, 1); PG8_STAGE(PG8_SA(1, 0), a3, voffA);
            PG8_BAR; PG8_WAIT_L(0); PG8_MMA(1, 0, At, B0); PG8_BAR; PG8_SCHED;
            PG8_STAGE(PG8_SB(1, 1), b3 + hstepB, voffB);
            PG8_WAIT_V(6); PG8_BAR; PG8_MMA(1, 1, At, B1); PG8_BAR;
        }
#ifndef NO_EPI
        epilogue(a, lds, g, acc, cur, wr, wc, fr, fq);
#else
        if (g.mode == 99) *(f32x4*)(g.out) = acc[0][0][0][0] + acc[1][1][3][1] + acc[0][1][2][0]+acc[1][0][1][1];
#endif
        if (!has_next) break;
#pragma unroll
        for (int a = 0; a < 2; ++a)
#pragma unroll
            for (int b = 0; b < 2; ++b)
#pragma unroll
                for (int m = 0; m < 4; ++m)
#pragma unroll
                    for (int n = 0; n < 2; ++n) acc[a][b][m][n] = (f32x4){0.f, 0.f, 0.f, 0.f};
        cur = nxt; cA = nA; cB = nB; ++ui;
    }
    PG8_WAIT_V(0);
    if (wr == 0) PG8_BAR;
    PG8_BAR;
#undef PG8_SA
#undef PG8_SB
#undef PG8_STAGE
#undef PG8_LDA
#undef PG8_LDB
#undef PG8_MMA
#undef PG8_WAIT_V
#undef PG8_WAIT_L
#undef PG8_BAR
#undef PG8_SCHED
}

__device__ __forceinline__ int qk_perm_row(int n) { const int i = n & 63; return (n & ~63) + 8 * ((i & 31) >> 2) + (i & 3) + 4 * (i >> 5); }
__device__ __forceinline__ void transpose_item(const float* W, int K, int N, bf16_t* WT, bool permqk, LAS float* scr, int item, int lane) {
    const int nblk = N / 32, kb = item / nblk, nb = item % nblk, k0 = 64 * kb, n0 = 32 * nb;
#pragma unroll 8
    for (int i = 0; i < 32; ++i) { const int kk = 2 * i + (lane >> 5); scr[kk * 33 + (lane & 31)] = W[(size_t)(k0 + kk) * N + n0 + (lane & 31)]; }
    asm volatile("s_waitcnt lgkmcnt(0)" ::: "memory");
    const int c = lane & 7;
#pragma unroll
    for (int j = 0; j < 4; ++j) { const int n = (lane >> 3) + 8 * j; const LAS float* s = scr + (8 * c) * 33 + n;
        u32x4 o; o.x = cvt_pk_bf16(s[0 * 33], s[1 * 33]); o.y = cvt_pk_bf16(s[2 * 33], s[3 * 33]); o.z = cvt_pk_bf16(s[4 * 33], s[5 * 33]); o.w = cvt_pk_bf16(s[6 * 33], s[7 * 33]);
        int row = n0 + n; if (permqk && row < 2 * QKVW) row = qk_perm_row(row);
        *(u32x4*)(WT + (size_t)row * K + k0 + 8 * c) = o; }
    asm volatile("s_waitcnt lgkmcnt(0)" ::: "memory");
}
__device__ __forceinline__ void reduce_angle(double a, float& c, float& s) {
    const double k = __builtin_rint(a * 0.6366197723675814); const float x = (float)(a - k * 1.5707963267948966), x2 = x * x;
    const float sn = x * (1.0f + x2 * (-1.6666666667e-1f + x2 * (8.3333333333e-3f + x2 * (-1.9841269841e-4f + x2 * 2.7557319224e-6f))));
    const float cs = 1.0f + x2 * (-0.5f + x2 * (4.1666666667e-2f + x2 * (-1.3888888889e-3f + x2 * (2.4801587302e-5f + x2 * -2.7557319224e-7f))));
    const int q = ((int)k) & 3;
    c = (q == 0) ? cs : (q == 1) ? -sn : (q == 2) ? -cs : sn;
    s = (q == 0) ? sn : (q == 1) ? cs : (q == 2) ? -sn : -cs;
}
__device__ __forceinline__ void rms_row_to_bf16(const float* xrow, const float* gw, bf16_t* orow, int lane) {
    const f32x4* xr = (const f32x4*)xrow + lane; const f32x4* gr = (const f32x4*)gw + lane;
    f32x4 v[4]; float s = 0.f;
#pragma unroll
    for (int j = 0; j < 4; ++j) { v[j] = xr[64 * j]; s += (v[j].x * v[j].x + v[j].y * v[j].y) + (v[j].z * v[j].z + v[j].w * v[j].w); }
    const float rstd = 1.0f / sqrtf(wave_sum(s) * (1.f / DM) + EPSN);
    u32x2* o8 = (u32x2*)orow + lane;
#pragma unroll
    for (int j = 0; j < 4; ++j) { const f32x4 gv = gr[64 * j]; u32x2 w; w.x = cvt_pk_bf16(v[j].x * rstd * gv.x, v[j].y * rstd * gv.y); w.y = cvt_pk_bf16(v[j].z * rstd * gv.z, v[j].w * rstd * gv.w); o8[64 * j] = w; }
}

__device__ __forceinline__ void ssm_load_bc(const Args& a, int g, int dir, LAS f32x2* Bb, LAS f32x2* Cc, int tid) {
    const float* lam_re = a.in[4]; const float* lam_im = a.in[5]; const float* log_step = a.in[6];
    const float* b_re = a.in[7]; const float* b_im = a.in[8]; const float* c_re = a.in[9]; const float* c_im = a.in[10];
    const float dt = expf(log_step[dir * 32 + g]);
    for (int idx = tid; idx < 1024; idx += 512) {
        { const int n = idx >> 4; const float lr = lam_re[(dir * 32 + g) * 64 + n], li = lam_im[(dir * 32 + g) * 64 + n];
          const float ar = lr * dt; float cb, sb, ch, sh; reduce_angle((double)li * (double)dt, cb, sb); reduce_angle(0.5 * (double)li * (double)dt, ch, sh);
          const float em1 = expm1f(ar), ea = em1 + 1.0f;
          const float nr = em1 * cb - 2.0f * sh * sh, ni = ea * sb;
          const float den = 1.0f / (lr * lr + li * li); const float cr = (nr * lr + ni * li) * den, ci = (ni * lr - nr * li) * den;
          const float br = b_re[(size_t)((dir * 32 + g) * 64) * 16 + idx], bi = b_im[(size_t)((dir * 32 + g) * 64) * 16 + idx];
          Bb[idx] = (f32x2){cr * br - ci * bi, cr * bi + ci * br}; }
        { Cc[idx] = (f32x2){c_re[(size_t)((dir * 32 + g) * 16) * 64 + idx], c_im[(size_t)((dir * 32 + g) * 16) * 64 + idx]}; }
    }
}
__device__ __forceinline__ void ssm_setup_item(const Args& a, LAS unsigned char* lds, int item, int tid) {
    const int g = item >> 1, dir = item & 1;
    LAS f32x2* pw = (LAS f32x2*)lds; LAS f32x2* Bb = pw + 33 * 64; LAS f32x2* Cc = Bb + 1024;
    LAS float* KT = (LAS float*)(Cc + 1024); LAS float* K0 = KT + 32 * 256; LAS f32x2* Bb0 = (LAS f32x2*)(K0 + 256); LAS f32x2* Cc0 = Bb0 + 1024;
    const float* lam_re = a.in[4]; const float* lam_im = a.in[5]; const float* log_step = a.in[6];
    unsigned char* ws = a.ws;
    const float dt = expf(log_step[dir * 32 + g]);
    __syncthreads();
    for (int idx = tid; idx < 33 * 64; idx += 512) {
        const int tau = idx >> 6, n = idx & 63; const float lr = lam_re[(dir * 32 + g) * 64 + n], li = lam_im[(dir * 32 + g) * 64 + n];
        const float mag = expf(lr * dt * (float)tau); float c, s; reduce_angle((double)li * (double)dt * (double)tau, c, s);
        pw[idx] = (f32x2){mag * c, mag * s};
    }
    ssm_load_bc(a, g, dir, Bb, Cc, tid);
    if (dir == 1) ssm_load_bc(a, g, 0, Bb0, Cc0, tid);
    __syncthreads();
    if (tid < 64) { float* PW = (float*)(ws + WS_PW); const f32x2 p = pw[32 * 64 + tid]; PW[((dir * 32 + g) * 64 + tid) * 2] = p.x; PW[((dir * 32 + g) * 64 + tid) * 2 + 1] = p.y; }
    for (int o = tid; o < 32 * 256; o += 512) {
        const int tau = o >> 8, co = (o >> 4) & 15, ci = o & 15; float acc = 0.f;
_Pragma("unroll 4")
        for (int n = 0; n < 64; ++n) { const f32x2 c = Cc[co * 64 + n], p = pw[tau * 64 + n], b = Bb[n * 16 + ci]; const float tr = c.x * p.x - c.y * p.y, ti = c.x * p.y + c.y * p.x; acc += tr * b.x - ti * b.y; }
        KT[o] = acc; }
    if (dir == 1 && tid < 256) { const int co = tid >> 4, ci = tid & 15; float acc = 0.f;
_Pragma("unroll 4")
        for (int n = 0; n < 64; ++n) { const f32x2 c = Cc0[co * 64 + n], b = Bb0[n * 16 + ci]; acc += c.x * b.x - c.y * b.y; }
        K0[tid] = acc; }
    { bf16_t* BsT = (bf16_t*)(ws + WS_BST) + (size_t)g * 256 * 512;
      for (int ch = tid; ch < 128 * 64; ch += 512) {
          const int row = ch >> 6, part = row >> 6, n = row & 63, kc = ch & 63, s = kc >> 1, ci0 = (kc & 1) * 8; const int e = dir ? s : 31 - s; const f32x2 p = pw[e * 64 + n];
          float v[8];
#pragma unroll
          for (int j = 0; j < 8; ++j) { const f32x2 b = Bb[n * 16 + ci0 + j]; v[j] = part ? (p.x * b.y + p.y * b.x) : (p.x * b.x - p.y * b.y); }
          u32x4 w; w.x = cvt_pk_bf16(v[0], v[1]); w.y = cvt_pk_bf16(v[2], v[3]); w.z = cvt_pk_bf16(v[4], v[5]); w.w = cvt_pk_bf16(v[6], v[7]);
          *(u32x4*)(BsT + (size_t)(dir * 128 + row) * 512 + s * 16 + ci0) = w; } }
    bf16_t* MtC = (bf16_t*)(ws + WS_MTC) + (size_t)g * 512 * UHK;
    { for (int ch = tid; ch < 512 * 16; ch += 512) {
          const int row = ch >> 4, t = row >> 4, co = row & 15, cc = ch & 15, part = cc >> 3, n0 = (cc & 7) * 8; const int e = dir ? 32 - t : t + 1;
          float v[8];
#pragma unroll
          for (int j = 0; j < 8; ++j) { const f32x2 c = Cc[co * 64 + n0 + j], p = pw[e * 64 + n0 + j]; v[j] = part ? -(c.x * p.y + c.y * p.x) : (c.x * p.x - c.y * p.y); }
          u32x4 w; w.x = cvt_pk_bf16(v[0], v[1]); w.y = cvt_pk_bf16(v[2], v[3]); w.z = cvt_pk_bf16(v[4], v[5]); w.w = cvt_pk_bf16(v[6], v[7]);
          *(u32x4*)(MtC + (size_t)row * UHK + 512 + dir * 128 + part * 64 + n0) = w; } }
    __syncthreads();
    { const float* dsk = a.in[11];
      for (int ch = tid; ch < 512 * 64; ch += 512) {
          const int kc = ch & 63, row = ch >> 6; const int s = kc >> 1, ci0 = (kc & 1) * 8, t = row >> 4, co = row & 15;
          if (dir == 0 ? (t > s) : (s >= t)) {
              const int tau = dir == 0 ? t - s : s - t;
              float v[8];
#pragma unroll
              for (int j = 0; j < 8; ++j) v[j] = KT[tau * 256 + co * 16 + ci0 + j];
              if (t == s) { const float dv = dsk[g * 16 + co];
#pragma unroll
                  for (int j = 0; j < 8; ++j) v[j] += K0[co * 16 + ci0 + j] + ((ci0 + j == co) ? dv : 0.f); }
              u32x4 w; w.x = cvt_pk_bf16(v[0], v[1]); w.y = cvt_pk_bf16(v[2], v[3]); w.z = cvt_pk_bf16(v[4], v[5]); w.w = cvt_pk_bf16(v[6], v[7]);
              *(u32x4*)(MtC + (size_t)row * UHK + s * 16 + ci0) = w;
          }
      } }
    __syncthreads();
}

__device__ __forceinline__ void step_setup(const Args& a, LAS unsigned char* lds, int tid, int bx) {
    const int lane = tid & 63, wave = tid >> 6, G = gridDim.x;
    unsigned char* ws = a.ws;
    for (int it = bx; it < 64; it += G) ssm_setup_item(a, lds, it, tid);
    { float* rc = (float*)(ws + WS_ROPE); float* rs = rc + SEQL * 32;
      for (int idx = bx * 512 + tid; idx < SEQL * 32; idx += G * 512) {
          const int pos = idx >> 5, i = idx & 31; double inv = 1.0; for (int k = 0; k < i; ++k) inv *= 0.7498942093324558;
          float c, s; reduce_angle((double)pos * inv, c, s); rc[idx] = c; rs[idx] = s; } }
    { LAS float* scr = (LAS float*)(lds) + wave * (64 * 33);
      const int gw = bx * 8 + wave, NGW = G * 8;
      constexpr int I_IN = (DM / 64) * (INC / 32), I_GLU = (512 / 64) * (512 / 32), I_AB = (512 / 64) * (1024 / 32), I_OUT = (1024 / 64) * (1024 / 32);
      constexpr int NIT = I_IN + I_GLU + 2 * I_AB + I_OUT;
      for (int it = gw; it < NIT; it += NGW) {
          int r = it;
          if (r < I_IN) { transpose_item(a.in[3], DM, INC, (bf16_t*)(ws + WS_WIN), true, scr, r, lane); continue; } r -= I_IN;
          if (r < I_GLU) { transpose_item(a.in[12], 512, 512, (bf16_t*)(ws + WS_WGLU), false, scr, r, lane); continue; } r -= I_GLU;
          if (r < I_AB) { transpose_item(a.in[13], 512, 1024, (bf16_t*)(ws + WS_WA), false, scr, r, lane); continue; } r -= I_AB;
          if (r < I_AB) { transpose_item(a.in[14], 512, 1024, (bf16_t*)(ws + WS_WB), false, scr, r, lane); continue; } r -= I_AB;
          transpose_item(a.in[15], 1024, 1024, (bf16_t*)(ws + WS_WOUT), false, scr, r, lane);
      } }
    { bf16_t* hn = (bf16_t*)((unsigned char*)a.out + OUT_HN_OFF);
      const f32x4* gr = (const f32x4*)a.in[2] + lane;
      f32x4 gv[4];
#pragma unroll
      for (int j = 0; j < 4; ++j) gv[j] = gr[64 * j];
      unsigned* rctr = (unsigned*)(ws + WS_CTL) + 4;
      constexpr int RCH = 16;
      for (;;) {
          unsigned cidx = 0; if (lane == 0) cidx = atomicAdd(rctr, 1u);
          cidx = (unsigned)__builtin_amdgcn_readfirstlane((int)cidx);
          if (cidx >= (unsigned)(TTOK / RCH)) break;
          int row = (int)cidx * RCH; const int rend = row + RCH;
          f32x4 nx[4];
          { const f32x4* xr = (const f32x4*)xrow_ptr(a.in[0], a.in[1], row) + lane;
#pragma unroll
            for (int j = 0; j < 4; ++j) nx[j] = xr[64 * j]; }
          for (; row < rend; ++row) {
              f32x4 v[4];
#pragma unroll
              for (int j = 0; j < 4; ++j) v[j] = nx[j];
              if (row + 1 < rend) { const f32x4* xn = (const f32x4*)xrow_ptr(a.in[0], a.in[1], row + 1) + lane;
#pragma unroll
                  for (int j = 0; j < 4; ++j) nx[j] = xn[64 * j]; }
              float s = 0.f;
#pragma unroll
              for (int j = 0; j < 4; ++j) s += (v[j].x * v[j].x + v[j].y * v[j].y) + (v[j].z * v[j].z + v[j].w * v[j].w);
              const float rstd = 1.0f / sqrtf(wave_sum(s) * (1.f / DM) + EPSN);
              u32x2* o8 = (u32x2*)(hn + (size_t)row * DM) + lane;
#pragma unroll
              for (int j = 0; j < 4; ++j) { u32x2 w; w.x = cvt_pk_bf16(v[j].x * rstd * gv[j].x, v[j].y * rstd * gv[j].y); w.y = cvt_pk_bf16(v[j].z * rstd * gv[j].z, v[j].w * rstd * gv[j].w); o8[64 * j] = w; }
          }
      } }
}

struct KVBuf { bf16x8 kA0, kA1, kB0, kB1; bf16x4 vA[4], vB[4]; };
__device__ __forceinline__ void step_params(int s, int& gi, int& ls) { gi = s < 12 ? 0 : (s < 18 ? 1 : 2); ls = s < 12 ? s : (s < 18 ? s - 12 : s - 18); }
__device__ __forceinline__ void attn_load(KVBuf& b, const bf16_t* Kp, const bf16_t* Vt, int s, int sq, int h, int blk, int r, int lane) {
    int gi, ls; step_params(s, gi, ls);
    const int sh = 2 * gi, Lg = SEQL >> sh, rho = r & ((1 << sh) - 1);
    int uA = ((256 * blk) >> sh) - 64 + 32 * ls, uB = uA + 16;
    if (uA < 0 || uA >= Lg) uA = 0; if (uB < 0 || uB >= Lg) uB = 0;
    const int kl = lane & 15, quad = lane >> 4;
    const bf16_t* kh = Kp + (size_t)(sq * 24 + gi * 8 + h) * SEQL * 64 + quad * 128 + kl * 8;
    const bf16_t* ka = kh + (size_t)((rho * Lg + uA) >> 4) * 1024; const bf16_t* kb = kh + (size_t)((rho * Lg + uB) >> 4) * 1024;
    b.kA0 = *(const bf16x8*)ka; b.kA1 = *(const bf16x8*)(ka + 512); b.kB0 = *(const bf16x8*)kb; b.kB1 = *(const bf16x8*)(kb + 512);
    const bf16_t* vbase = Vt + (size_t)(((sq * 3 + gi) * 8 + h) * 512) * 1024 + quad * 64 + kl * 4;
    const bf16_t* va = vbase + (size_t)((rho * Lg + uA) >> 4) * 1024; const bf16_t* vb = vbase + (size_t)((rho * Lg + uB) >> 4) * 1024;
#pragma unroll
    for (int dt = 0; dt < 4; ++dt) { b.vA[dt] = *(const bf16x4*)(va + dt * 256); b.vB[dt] = *(const bf16x4*)(vb + dt * 256); }
}
struct QF { bf16x8 a0, a1, b0, b1, c0, c1; };
template <int gi>
__device__ __forceinline__ void attn_compute(const KVBuf& b, const bf16x8 q0, const bf16x8 q1, f32x4 (&o)[4], float& mrun, float& lrun, int s, int blk, int r, int lane) {
    const int ls = gi == 0 ? s : (gi == 1 ? s - 12 : s - 18);
    const int sh = 2 * gi, Lg = SEQL >> sh;
    const int uA = ((256 * blk) >> sh) - 64 + 32 * ls;
    const int qi = lane & 15, quad = lane >> 4;
    const int uq = (256 * blk + r + 16 * qi) >> sh;
    const int lo = max(0, uq - 64), hi = min(Lg - 1, uq + 64);
    f32x4 sA = (f32x4){0.f, 0.f, 0.f, 0.f}, sB = sA;
    sA = __builtin_amdgcn_mfma_f32_16x16x32_bf16(b.kA0, q0, sA, 0, 0, 0); sA = __builtin_amdgcn_mfma_f32_16x16x32_bf16(b.kA1, q1, sA, 0, 0, 0);
    sB = __builtin_amdgcn_mfma_f32_16x16x32_bf16(b.kB0, q0, sB, 0, 0, 0); sB = __builtin_amdgcn_mfma_f32_16x16x32_bf16(b.kB1, q1, sB, 0, 0, 0);
    const float NEGINF = -__builtin_inff();
    const unsigned span = (unsigned)(hi - lo);
    float mx = NEGINF;
#pragma unroll
    for (int j = 0; j < 4; ++j) {
        const int ua = uA + quad * 4 + j, ub = ua + 16;
        sA[j] = ((unsigned)(ua - lo) <= span) ? sA[j] : NEGINF; sB[j] = ((unsigned)(ub - lo) <= span) ? sB[j] : NEGINF;
        mx = fmaxf(mx, fmaxf(sA[j], sB[j]));
    }
    mx = fmaxf(mx, __shfl_xor(mx, 16)); mx = fmaxf(mx, __shfl_xor(mx, 32));
    const float mnew = fmaxf(mrun, mx), alpha = __builtin_amdgcn_exp2f(mrun - mnew);
    mrun = mnew;
    float ps = 0.f;
#pragma unroll
    for (int j = 0; j < 4; ++j) { sA[j] = __builtin_amdgcn_exp2f(sA[j] - mnew); sB[j] = __builtin_amdgcn_exp2f(sB[j] - mnew); ps += sA[j] + sB[j]; }
    lrun = lrun * alpha + ps;
    u32x4 pw; pw.x = cvt_pk_bf16(sA[0], sA[1]); pw.y = cvt_pk_bf16(sA[2], sA[3]); pw.z = cvt_pk_bf16(sB[0], sB[1]); pw.w = cvt_pk_bf16(sB[2], sB[3]);
    const bf16x8 pf = __builtin_bit_cast(bf16x8, pw);
#pragma unroll
    for (int dt = 0; dt < 4; ++dt) {
        o[dt] *= alpha;
        bf16x8 vf; vf[0] = b.vA[dt][0]; vf[1] = b.vA[dt][1]; vf[2] = b.vA[dt][2]; vf[3] = b.vA[dt][3]; vf[4] = b.vB[dt][0]; vf[5] = b.vB[dt][1]; vf[6] = b.vB[dt][2]; vf[7] = b.vB[dt][3];
#ifdef DBG_ATT2
        for (int e = 0; e < 8; ++e) o[dt][e & 3] += 1e-3f * __uint_as_float(((unsigned)(unsigned short)vf[e]) << 16);
#else
        o[dt] = __builtin_amdgcn_mfma_f32_16x16x32_bf16(vf, pf, o[dt], 0, 0, 0);
#endif
    }
}
template <int gi>
__device__ __forceinline__ void attn_compute2(const KVBuf& b, const KVBuf& c, const bf16x8 q0, const bf16x8 q1, f32x4 (&o)[4], float& mrun, float& lrun, int s, int blk, int r, int lane) {
    const int ls = gi == 0 ? s : (gi == 1 ? s - 12 : s - 18);
    const int sh = 2 * gi, Lg = SEQL >> sh;
    const int uA = ((256 * blk) >> sh) - 64 + 32 * ls;
    const int qi = lane & 15, quad = lane >> 4;
    const int uq = (256 * blk + r + 16 * qi) >> sh;
    const int lo = max(0, uq - 64), hi = min(Lg - 1, uq + 64);
    const f32x4 z4 = (f32x4){0.f, 0.f, 0.f, 0.f};
    f32x4 sA = __builtin_amdgcn_mfma_f32_16x16x32_bf16(b.kA0, q0, z4, 0, 0, 0), sB = __builtin_amdgcn_mfma_f32_16x16x32_bf16(b.kB0, q0, z4, 0, 0, 0);
    f32x4 sC = __builtin_amdgcn_mfma_f32_16x16x32_bf16(c.kA0, q0, z4, 0, 0, 0), sD = __builtin_amdgcn_mfma_f32_16x16x32_bf16(c.kB0, q0, z4, 0, 0, 0);
    sA = __builtin_amdgcn_mfma_f32_16x16x32_bf16(b.kA1, q1, sA, 0, 0, 0); sB = __builtin_amdgcn_mfma_f32_16x16x32_bf16(b.kB1, q1, sB, 0, 0, 0);
    sC = __builtin_amdgcn_mfma_f32_16x16x32_bf16(c.kA1, q1, sC, 0, 0, 0); sD = __builtin_amdgcn_mfma_f32_16x16x32_bf16(c.kB1, q1, sD, 0, 0, 0);
    const float NEGINF = -__builtin_inff();
    const unsigned span = (unsigned)(hi - lo);
    float mx = NEGINF;
#pragma unroll
    for (int j = 0; j < 4; ++j) {
        const int ua = uA + quad * 4 + j;
        sA[j] = ((unsigned)(ua - lo) <= span) ? sA[j] : NEGINF; sB[j] = ((unsigned)(ua + 16 - lo) <= span) ? sB[j] : NEGINF;
        sC[j] = ((unsigned)(ua + 32 - lo) <= span) ? sC[j] : NEGINF; sD[j] = ((unsigned)(ua + 48 - lo) <= span) ? sD[j] : NEGINF;
        mx = fmaxf(fmaxf(mx, fmaxf(sA[j], sB[j])), fmaxf(sC[j], sD[j]));
    }
    mx = fmaxf(mx, __shfl_xor(mx, 16)); mx = fmaxf(mx, __shfl_xor(mx, 32));
    const float mnew = fmaxf(mrun, mx), alpha = __builtin_amdgcn_exp2f(mrun - mnew);
    mrun = mnew;
    float ps = 0.f;
#pragma unroll
    for (int j = 0; j < 4; ++j) { sA[j] = __builtin_amdgcn_exp2f(sA[j] - mnew); sB[j] = __builtin_amdgcn_exp2f(sB[j] - mnew); sC[j] = __builtin_amdgcn_exp2f(sC[j] - mnew); sD[j] = __builtin_amdgcn_exp2f(sD[j] - mnew); ps += (sA[j] + sB[j]) + (sC[j] + sD[j]); }
    lrun = lrun * alpha + ps;
    u32x4 pw, pv; pw.x = cvt_pk_bf16(sA[0], sA[1]); pw.y = cvt_pk_bf16(sA[2], sA[3]); pw.z = cvt_pk_bf16(sB[0], sB[1]); pw.w = cvt_pk_bf16(sB[2], sB[3]);
    pv.x = cvt_pk_bf16(sC[0], sC[1]); pv.y = cvt_pk_bf16(sC[2], sC[3]); pv.z = cvt_pk_bf16(sD[0], sD[1]); pv.w = cvt_pk_bf16(sD[2], sD[3]);
    const bf16x8 pf = __builtin_bit_cast(bf16x8, pw), pg = __builtin_bit_cast(bf16x8, pv);
#pragma unroll
    for (int dt = 0; dt < 4; ++dt) {
        o[dt] *= alpha;
        bf16x8 vf, vg;
        vf[0] = b.vA[dt][0]; vf[1] = b.vA[dt][1]; vf[2] = b.vA[dt][2]; vf[3] = b.vA[dt][3]; vf[4] = b.vB[dt][0]; vf[5] = b.vB[dt][1]; vf[6] = b.vB[dt][2]; vf[7] = b.vB[dt][3];
        vg[0] = c.vA[dt][0]; vg[1] = c.vA[dt][1]; vg[2] = c.vA[dt][2]; vg[3] = c.vA[dt][3]; vg[4] = c.vB[dt][0]; vg[5] = c.vB[dt][1]; vg[6] = c.vB[dt][2]; vg[7] = c.vB[dt][3];
        o[dt] = __builtin_amdgcn_mfma_f32_16x16x32_bf16(vf, pf, o[dt], 0, 0, 0);
        o[dt] = __builtin_amdgcn_mfma_f32_16x16x32_bf16(vg, pg, o[dt], 0, 0, 0);
    }
}
__device__ __forceinline__ void step_attention(const Args& a, LAS unsigned char* lds, int pass, int tid, int bx) {
    unsigned char* ws = a.ws;
    const int lane = tid & 63;
    const bf16_t* Qp = (const bf16_t*)(ws + WS_Q); const bf16_t* Kp = (const bf16_t*)(ws + WS_K); const bf16_t* Vt = (const bf16_t*)(ws + WS_VT);
    const bf16_t* ZA = (const bf16_t*)(ws + WS_ZA); bf16_t* GAO = (bf16_t*)(ws + WS_GAO);
    const int xcd = bx & 7;
    unsigned* ctr = (unsigned*)(ws + WS_CTL) + 16 + pass * 8 + xcd;
    LAS unsigned* slot = (LAS unsigned*)(lds + 3 * 16384);
    constexpr int NGRP = 3 * 32 * 2;
    for (;;) {
        __syncthreads();
        if (tid == 0) slot[0] = atomicAdd(ctr, 1u);
        __syncthreads();
        const unsigned grp = (unsigned)__builtin_amdgcn_readfirstlane((int)slot[0]);
        if (grp >= (unsigned)NGRP) break;
        const int wv_ = tid >> 6; const int r = ((wv_ & 3) << 2) + (wv_ >> 2) + 2 * (int)(grp & 1)  , blk = (grp >> 1) & 31, pair = xcd * 3 + (int)(grp >> 6);
        const int h = pair & 7, sq = pair >> 3;
        const int qi = lane & 15, quad = lane >> 4;
        const int tq = sq * SEQL + 256 * blk + r + 16 * qi;
        QF qf;
        { const int pos = 256 * blk + r + 16 * qi;
          const bf16_t* qa = Qp + ((size_t)(sq * 24 + h) * SEQL + pos) * 64 + quad * 8;
          const bf16_t* qb = Qp + ((size_t)(sq * 24 + 8 + h) * SEQL + (pos & 3) * 2048 + (pos >> 2)) * 64 + quad * 8;
          const bf16_t* qc = Qp + ((size_t)(sq * 24 + 16 + h) * SEQL + (pos & 15) * 512 + (pos >> 4)) * 64 + quad * 8;
          qf.a0 = *(const bf16x8*)qa; qf.a1 = *(const bf16x8*)(qa + 32); qf.b0 = *(const bf16x8*)qb; qf.b1 = *(const bf16x8*)(qb + 32); qf.c0 = *(const bf16x8*)qc; qf.c1 = *(const bf16x8*)(qc + 32); }
        f32x4 o[4];
#pragma unroll
        for (int dt = 0; dt < 4; ++dt) o[dt] = (f32x4){0.f, 0.f, 0.f, 0.f};
        float mrun = -1e30f, lrun = 0.f;
        KVBuf b0, b1;
#define ATT_SB __builtin_amdgcn_sched_barrier(0);
        {
            const int wv = tid >> 6, region = wv >> 1;
            const bf16_t* gsrc = (region < 2 ? Kp + (size_t)(sq * 24 + h) * SEQL * 64 : Vt + (size_t)((sq * 3) * 8 + h) * 512 * 1024) + (wv & 1) * 512 + lane * 8;
            const int ubase = 256 * blk - 64 + (region & 1) * 16;
#define ATT_DMA(S) do { int uT = ubase + 32 * (S); if (uT < 0 || uT >= SEQL) uT = 0; \
                __builtin_amdgcn_global_load_lds((const unsigned*)(gsrc + (size_t)(uT >> 4) * 1024), (LAS unsigned*)(lds + (((S) >> 1) % 3) * 16384 + ((S) & 1) * 8192 + wv * 1024), 16, 0, 0); } while (0)
            ATT_DMA(0); ATT_DMA(1); ATT_DMA(2); ATT_DMA(3);
            const int kl = lane & 15;
            const unsigned foff = (unsigned)(quad * 256 + kl * 16), voff = (unsigned)(4096 + quad * 128 + kl * 8);
#pragma unroll 1
            for (int d = 0; d < 6; ++d) {
                if (d < 5) asm volatile("s_waitcnt vmcnt(2)" ::: "memory"); else asm volatile("s_waitcnt vmcnt(0)" ::: "memory");
                __syncthreads();
                if (d + 2 < 6) { ATT_DMA(2 * d + 4); ATT_DMA(2 * d + 5); }
                LAS unsigned char* kb = lds + (d % 3) * 16384;
                b0.kA0 = *(const LAS bf16x8*)(kb + foff); b0.kA1 = *(const LAS bf16x8*)(kb + foff + 1024); b0.kB0 = *(const LAS bf16x8*)(kb + 2048 + foff); b0.kB1 = *(const LAS bf16x8*)(kb + 2048 + foff + 1024);
                b1.kA0 = *(const LAS bf16x8*)(kb + 8192 + foff); b1.kA1 = *(const LAS bf16x8*)(kb + 8192 + foff + 1024); b1.kB0 = *(const LAS bf16x8*)(kb + 8192 + 2048 + foff); b1.kB1 = *(const LAS bf16x8*)(kb + 8192 + 2048 + foff + 1024);
#pragma unroll
                for (int dt = 0; dt < 4; ++dt) { b0.vA[dt] = *(const LAS bf16x4*)(kb + voff + dt * 512); b0.vB[dt] = *(const LAS bf16x4*)(kb + 2048 + voff + dt * 512);
                                                 b1.vA[dt] = *(const LAS bf16x4*)(kb + 8192 + voff + dt * 512); b1.vB[dt] = *(const LAS bf16x4*)(kb + 8192 + 2048 + voff + dt * 512); }
                attn_compute2<0>(b0, b1, qf.a0, qf.a1, o, mrun, lrun, 2 * d, blk, r, lane);
            }
#undef ATT_DMA
        }
        attn_load(b0, Kp, Vt, 12, sq, h, blk, r, lane);
#define ATT_LOOP(GI, S0, S1, QA, QB) _Pragma("unroll 1") for (int s = S0; s < S1; s += 2) { \
            ATT_SB attn_load(b1, Kp, Vt, s + 1, sq, h, blk, r, lane); ATT_SB attn_compute<GI>(b0, QA, QB, o, mrun, lrun, s, blk, r, lane); \
            ATT_SB attn_load(b0, Kp, Vt, s + 2, sq, h, blk, r, lane); ATT_SB attn_compute<GI>(b1, QA, QB, o, mrun, lrun, s + 1, blk, r, lane); ATT_SB }
        ATT_LOOP(1, 12, 18, qf.b0, qf.b1)
        ATT_LOOP(2, 18, 22, qf.c0, qf.c1)
#undef ATT_LOOP
        attn_compute<2>(b0, qf.c0, qf.c1, o, mrun, lrun, 22, blk, r, lane);
        float l = lrun; l += __shfl_xor(l, 16); l += __shfl_xor(l, 32);
        float inv = 1.0f / l;
#ifdef DBG_ATT1
        for (int dt = 0; dt < 4; ++dt) o[dt] = (f32x4){1.f, 1.f, 1.f, 1.f};
#endif
#pragma unroll
        for (int dt = 0; dt < 4; ++dt) {
            const size_t off = (size_t)tq * 512 + h * 64 + 16 * dt + 4 * quad;
            const u32x2 z = *(const u32x2*)(ZA + off);
            u32x2 w; w.x = cvt_pk_bf16(o[dt][0] * inv * bf_lo(z.x), o[dt][1] * inv * bf_hi(z.x)); w.y = cvt_pk_bf16(o[dt][2] * inv * bf_lo(z.y), o[dt][3] * inv * bf_hi(z.y));
            *(u32x2*)(GAO + off) = w;
        }
    }
}

__device__ __forceinline__ f32x2 cmul(f32x2 a, f32x2 b) { return (f32x2){a.x * b.x - a.y * b.y, a.x * b.y + a.y * b.x}; }
__device__ __forceinline__ void step_scan(const Args& a, LAS unsigned char* lds, int pass, int tid, int bx) {
    unsigned char* ws = a.ws; const int G = gridDim.x;
    const float* PW = (const float*)(ws + WS_PW); const float* S = (const float*)(ws + WS_S); bf16_t* UH = (bf16_t*)(ws + WS_UH);
    LAS f32x2* carry = (LAS f32x2*)lds;
    for (int it = bx; it < SEQP * 32 * 2; it += G) {
        const int dir = it & 1, g = (it >> 1) & 31, sq = it >> 6; const int seg = tid >> 6, n = tid & 63;
        const f32x2 P = (f32x2){PW[((dir * 32 + g) * 64 + n) * 2], PW[((dir * 32 + g) * 64 + n) * 2 + 1]};
        f32x2 z[32];
        { const int c0 = dir ? (NCH - 1 - seg * 32) : seg * 32; const long stp = dir ? -256 : 256;
          const float* sp = S + ((size_t)g * CHP + sq * NCH + c0) * 256 + dir * 128 + n;
#pragma unroll
          for (int i = 0; i < 32; ++i) { z[i] = (f32x2){sp[0], sp[64]}; sp += stp; } }
        f32x2 zz = (f32x2){0.f, 0.f};
#pragma unroll
        for (int i = 0; i < 32; ++i) { const f32x2 t = z[i]; z[i] = zz; zz = cmul(P, zz) + t; }
        __syncthreads();
        carry[seg * 64 + n] = zz;
        __syncthreads();
        f32x2 P32 = P;
#pragma unroll
        for (int k = 0; k < 5; ++k) P32 = cmul(P32, P32);
        f32x2 x = (f32x2){0.f, 0.f};
        for (int sp = 0; sp < seg; ++sp) x = cmul(P32, x) + carry[sp * 64 + n];
        f32x2 pwr = (f32x2){1.f, 0.f};
        { const int c0 = dir ? (NCH - 1 - seg * 32) : seg * 32; const long stp = dir ? -(long)UHK : (long)UHK;
          bf16_t* up = UH + ((size_t)g * CHP + sq * NCH + c0) * UHK + 512 + dir * 128 + n;
#pragma unroll
          for (int i = 0; i < 32; ++i) {
              const f32x2 hin = z[i] + cmul(pwr, x);
              up[0] = (bf16_t)(cvt_pk_bf16(hin.x, 0.f) & 0xffffu); up[64] = (bf16_t)(cvt_pk_bf16(hin.y, 0.f) & 0xffffu);
              pwr = cmul(pwr, P); up += stp;
          } }
    }
}

__device__ __forceinline__ void step_final_norm(const Args& a, int pass, int tid, int bx) {
    const int lane = tid & 63, wave = tid >> 6, G = gridDim.x;
    const f32x4* gr = (const f32x4*)a.in[16] + lane;
    f32x4 gv[4];
#pragma unroll
    for (int j = 0; j < 4; ++j) gv[j] = gr[64 * j];
    const bf16_t* accp = (const bf16_t*)(a.ws + WS_ACC);
    int row = bx * 8 + wave;
    f32x4 nx[4]; u32x2 na[4];
    if (row < TP) { const f32x4* xr = (const f32x4*)xrow_ptr(a.in[0], a.in[1], pass * TP + row) + lane; const u32x2* ar = (const u32x2*)(accp + (size_t)row * DM) + lane;
#pragma unroll
        for (int j = 0; j < 4; ++j) { nx[j] = xr[64 * j]; na[j] = ar[64 * j]; } }
    for (; row < TP; row += G * 8) {
        f32x4 v[4];
#pragma unroll
        for (int j = 0; j < 4; ++j) v[j] = nx[j] + (f32x4){bf_lo(na[j].x), bf_hi(na[j].x), bf_lo(na[j].y), bf_hi(na[j].y)};
        const int nrow = row + G * 8;
        if (nrow < TP) { const f32x4* xn = (const f32x4*)xrow_ptr(a.in[0], a.in[1], pass * TP + nrow) + lane; const u32x2* an = (const u32x2*)(accp + (size_t)nrow * DM) + lane;
#pragma unroll
            for (int j = 0; j < 4; ++j) { nx[j] = xn[64 * j]; na[j] = an[64 * j]; } }
        float s = 0.f;
#pragma unroll
        for (int j = 0; j < 4; ++j) s += (v[j].x * v[j].x + v[j].y * v[j].y) + (v[j].z * v[j].z + v[j].w * v[j].w);
        const float rstd = 1.0f / sqrtf(wave_sum(s) * (1.f / DM) + EPSN);
        f32x4* xr = (f32x4*)(a.out + (size_t)(pass * TP + row) * DM) + lane;
#pragma unroll
        for (int j = 0; j < 4; ++j) xr[64 * j] = v[j] * rstd * gv[j];
    }
}


#define XB_TMO      128
#define XB_XCNT(j)  (256  + 64 * (j))
#define XB_XSUB(j)  (1280 + 64 * (j))
#define XB_XGEN(j)  (2304 + 64 * (j))
#define XB_TOP      3328
#define XB_TOPGEN   3392
#define XCD_BAR_WORDS 3456
#define XB_SLOT(b)  (4096 + 2 * (b))
#define XB_SPIN_CAP (1u << 18)
__device__ __forceinline__ unsigned xb_ld(unsigned* p)              { return __hip_atomic_load(p, __ATOMIC_RELAXED, __HIP_MEMORY_SCOPE_AGENT); }
__device__ __forceinline__ unsigned xb_add(unsigned* p, unsigned v) { return __hip_atomic_fetch_add(p, v, __ATOMIC_RELAXED, __HIP_MEMORY_SCOPE_AGENT); }
__device__ __forceinline__ unsigned xb_xcc_id() { return (unsigned)__builtin_amdgcn_s_getreg((3 << 11) | 20) & 0xFu; }
#define XB_SPIN(cond, bar) do { unsigned _sp = 0; while (cond) { __builtin_amdgcn_s_sleep(1); \
    if ((++_sp & 255u) == 0u) { if (xb_ld(&(bar)[XB_TMO])) break; if (_sp > XB_SPIN_CAP) { atomicAdd(&(bar)[XB_TMO], 1u); break; } } } } while (0)
__device__ __forceinline__ void xcd_barrier_complete(unsigned* bar, unsigned x, unsigned& nloc, unsigned& nx) {
    const unsigned G = gridDim.x;
    unsigned sum, cnt, mine, sp = 0u;
    for (;;) {
        sum = 0u; cnt = 0u; mine = 0u;
#pragma unroll
        for (unsigned j = 0; j < 16; ++j) { const unsigned c = xb_ld(&bar[XB_XCNT(j)]); sum += c; cnt += (c > 0u) ? 1u : 0u; mine = (j == x) ? c : mine; }
        if (sum == G) break;
        __builtin_amdgcn_s_sleep(1);
        if ((++sp & 255u) == 0u) { if (xb_ld(&bar[XB_TMO])) break; if (sp > XB_SPIN_CAP) { atomicAdd(&bar[XB_TMO], 1u); break; } }
    }
    nloc = mine > 0u ? mine : 1u; nx = cnt > 0u ? cnt : 1u;
}
__device__ __forceinline__ void xcd_barrier(unsigned* bar) {
    asm volatile("s_waitcnt vmcnt(0)" ::: "memory");
    __syncthreads();
    if (threadIdx.x == 0) {
        __builtin_amdgcn_s_waitcnt(0);
        const unsigned x = xb_xcc_id();
        unsigned* slot = bar + XB_SLOT(blockIdx.x);
        unsigned nloc = xb_ld(slot), nx = xb_ld(slot + 1);
        if (nloc == 0u) { xcd_barrier_complete(bar, x, nloc, nx); __hip_atomic_store(slot, nloc, __ATOMIC_RELAXED, __HIP_MEMORY_SCOPE_AGENT); __hip_atomic_store(slot + 1, nx, __ATOMIC_RELAXED, __HIP_MEMORY_SCOPE_AGENT); }
        const unsigned old = xb_add(&bar[XB_XSUB(x)], 1u);
        const unsigned gen = old / nloc;
        if (old + 1u == (gen + 1u) * nloc) {
            __builtin_amdgcn_fence(__ATOMIC_RELEASE, "agent");
            asm volatile("s_waitcnt vmcnt(0)" ::: "memory");
            const unsigned og = xb_add(&bar[XB_TOP], 1u);
            const unsigned tg = og / nx;
            if (og + 1u == (tg + 1u) * nx) xb_add(&bar[XB_TOPGEN], 1u);
            else XB_SPIN(xb_ld(&bar[XB_TOPGEN]) == tg, bar);
            __builtin_amdgcn_fence(__ATOMIC_ACQUIRE, "agent");
            xb_add(&bar[XB_XGEN(x)], 1u);
            asm volatile("s_waitcnt vmcnt(0)" ::: "memory");
        } else {
            XB_SPIN(xb_ld(&bar[XB_XGEN(x)]) == gen, bar);
            __builtin_amdgcn_fence(__ATOMIC_ACQUIRE, "agent");
            asm volatile("s_waitcnt vmcnt(0)" ::: "memory");
        }
    }
    __syncthreads();
}

constexpr int NSTEPS = 1 + 10 * NPASS;
__host__ __device__ __forceinline__ bool sync_after(int st) { if (st == 0) return true; const int k = (st - 1) % 10; return !(k == 1 || k == 6 || k == 9); }

__global__ void __launch_bounds__(512, 2) fwd_kernel(Args a) {
    extern __shared__ __attribute__((aligned(16))) unsigned char lds_raw[];
    LAS unsigned char* lds = (LAS unsigned char*)lds_raw;
    cg::grid_group grid = cg::this_grid();
    const int G = gridDim.x;
    unsigned char* ws = a.ws;
    unsigned* bar = (unsigned*)(ws + WS_BAR);
    if (a.do_sync == 2) grid.sync();
    if (a.do_sync && threadIdx.x == 0) (void)xb_add(&bar[XB_XCNT(xb_xcc_id())], 1u);
    for (int st = a.st_lo; st < a.st_hi; ++st) {
        int tid = threadIdx.x, bx = blockIdx.x;
        asm volatile("" : "+v"(tid), "+s"(bx));
#ifndef NO_SETUP
        if (st == 0) { step_setup(a, lds, tid, bx); }
#else
        if (st == 0) {}
#endif
        else {
            const int pass = (st - 1) / 10, k = (st - 1) % 10;
            GemmD g; g.lgnN = 0; g.pass = pass; g.nb = 1; g.sA = 0; g.sB = 0;
            bool has_gemm = true;
            const bool split_ay = (G == 256);
            switch (k) {
            case 0: g.A = (const bf16_t*)((unsigned char*)a.out + OUT_HN_OFF) + (size_t)pass * TP * DM; g.lda = DM; g.Bt = (const bf16_t*)(ws + WS_WIN); g.ldb = DM; g.K = DM; g.nM = TP / BM; g.nN = INC / BM; g.lgnN = 5; g.mode = MODE_PROJ; break;
            case 1: g.A = (const bf16_t*)(ws + WS_UH); g.lda = UHK; g.sA = (unsigned)(CHP * UHK * 2); g.Bt = (const bf16_t*)(ws + WS_BST); g.ldb = 512; g.sB = (unsigned)(256 * 512 * 2); g.K = 512; g.nM = CHP / BM; g.nN = 1; g.nb = 32; g.mode = MODE_S; break;
            case 4:
                if (split_ay && bx < 128) { g.A = (const bf16_t*)(ws + WS_GAO); g.lda = 512; g.Bt = (const bf16_t*)(ws + WS_WA); g.ldb = 512; g.K = 512; g.nM = TP / BM; g.nN = 4; g.lgnN = 2; g.mode = MODE_A; }
                else { g.A = (const bf16_t*)(ws + WS_UH); g.lda = UHK; g.sA = (unsigned)(CHP * UHK * 2); g.Bt = (const bf16_t*)(ws + WS_MTC); g.ldb = UHK; g.sB = (unsigned)(512 * UHK * 2); g.K = UHK; g.nM = CHP / BM; g.nN = 2; g.nb = 32; g.mode = MODE_Y; }
                break;
            case 5: g.A = (const bf16_t*)(ws + WS_SG); g.lda = 512; g.Bt = (const bf16_t*)(ws + WS_WGLU); g.ldb = 512; g.K = 512; g.nM = TP / BM; g.nN = 2; g.lgnN = 1; g.mode = MODE_GLU; break;
            case 6: if (split_ay) { has_gemm = false; g.A = nullptr; g.Bt = nullptr; g.lda = g.ldb = g.K = 0; g.nM = g.nN = 0; g.mode = 0; } else { g.A = (const bf16_t*)(ws + WS_GAO); g.lda = 512; g.Bt = (const bf16_t*)(ws + WS_WA); g.ldb = 512; g.K = 512; g.nM = TP / BM; g.nN = 4; g.lgnN = 2; g.mode = MODE_A; } break;
            case 7: g.A = (const bf16_t*)(ws + WS_SB); g.lda = 512; g.Bt = (const bf16_t*)(ws + WS_WB); g.ldb = 512; g.K = 512; g.nM = TP / BM; g.nN = 4; g.lgnN = 2; g.mode = MODE_B; break;
            case 8: g.A = (const bf16_t*)(ws + WS_M1); g.lda = 1024; g.Bt = (const bf16_t*)(ws + WS_WOUT); g.ldb = 1024; g.K = 1024; g.nM = TP / BM; g.nN = 4; g.lgnN = 2; g.mode = MODE_OUT; break;
            default: has_gemm = false; g.A = nullptr; g.Bt = nullptr; g.lda = g.ldb = g.K = 0; g.nM = g.nN = 0; g.mode = 0; break;
            }
            { const int total = g.nM * g.nN * g.nb; g.u0 = bx; g.ustride = G; g.ucount = total > bx ? (total - bx + G - 1) / G : 0; }
            if (k == 4 && split_ay) { if (bx < 128) { g.u0 = bx; g.ustride = 128; g.ucount = 3; } else { g.u0 = bx - 128; g.ustride = 128; g.ucount = (bx - 128) < 64 ? 2 : 1; } }
            if (has_gemm) {
#ifndef NO_GEMM
                gemm_phase(a, lds, g, G, bx, tid);
#endif
            }
#ifndef NO_ATTN
            else if (k == 2) step_attention(a, lds, pass, tid, bx);
#endif
#ifndef NO_SCAN
            else if (k == 3) step_scan(a, lds, pass, tid, bx);
#endif
            else if (k == 9) step_final_norm(a, pass, tid, bx);
        }
        if (a.do_sync && st + 1 < a.st_hi && sync_after(st)) xcd_barrier(bar);
    }
}

extern "C" void kernel_launch(void* const* d_in, const int* in_sizes, int n_in, void* d_out, int out_size, void* d_ws, size_t ws_size, hipStream_t stream) {
    constexpr int LDS_BYTES = STAGE_BYTES + 32768;
    static int grid = 0;
    if (grid == 0) {
        if (n_in != 17 || out_size != TTOK * DM || ws_size < WS_END) { fprintf(stderr, "kernel_launch: unexpected shapes (n_in %d out %d ws %zu need %zu)\n", n_in, out_size, ws_size, (size_t)WS_END); grid = -1; return; }
        int dev = 0, cus = 0, per_cu = 0;
        hipGetDevice(&dev); hipDeviceGetAttribute(&cus, hipDeviceAttributeMultiprocessorCount, dev);
        hipFuncSetAttribute((const void*)fwd_kernel, hipFuncAttributeMaxDynamicSharedMemorySize, LDS_BYTES);
        hipOccupancyMaxActiveBlocksPerMultiprocessor(&per_cu, (const void*)fwd_kernel, 512, LDS_BYTES);
        if (per_cu < 1) per_cu = 1;
        grid = cus * 1;
        (void)hipGetLastError();
    }
    if (grid < 0) return;
    (void)hipMemsetAsync((unsigned char*)d_ws + WS_CTL, 0, 4096, stream);
    (void)hipMemsetAsync((unsigned char*)d_ws + WS_BAR, 0, WS_BAR_BYTES, stream);
    Args a{};
    for (int i = 0; i < 17; ++i) a.in[i] = (const float*)d_in[i];
    a.out = (float*)d_out; a.ws = (unsigned char*)d_ws; a.pad = 0;
#ifndef MULTI_LAUNCH
#define MULTI_LAUNCH 0
#endif
#if MULTI_LAUNCH
    a.do_sync = 0;
    for (int st = 0; st < NSTEPS; ++st) {
        a.st_lo = st; a.st_hi = st + 1;
        hipLaunchKernelGGL(fwd_kernel, dim3(grid), dim3(512), LDS_BYTES, stream, a);
    }
#else
    a.do_sync = 1; a.st_lo = 0; a.st_hi = NSTEPS;
    void* args[] = {&a};
    hipError_t e = hipLaunchCooperativeKernel((const void*)fwd_kernel, dim3(grid), dim3(512), args, LDS_BYTES, stream);
    if (e != hipSuccess) fprintf(stderr, "cooperative launch failed: %s (grid %d)\n", hipGetErrorString(e), grid);
#endif
}
```

```cpp
#include <hip/hip_runtime.h>
#include <hip/hip_cooperative_groups.h>
#include <cstdio>

namespace cg = cooperative_groups;

#define LAS __attribute__((address_space(3)))
typedef unsigned short bf16_t;
typedef short bf16x8 __attribute__((ext_vector_type(8)));
typedef short bf16x4 __attribute__((ext_vector_type(4)));
typedef float f32x4 __attribute__((ext_vector_type(4)));
typedef float f32x2 __attribute__((ext_vector_type(2)));
typedef unsigned u32x4 __attribute__((ext_vector_type(4)));
typedef unsigned u32x2 __attribute__((ext_vector_type(2)));

constexpr int DM = 1024, SEQL = 8192, NSEQ = 6, TTOK = NSEQ * SEQL;
constexpr int NPASS = 2, SEQP = 3, TP = SEQP * SEQL;
constexpr int INC = 8192, QKVW = 1536;
constexpr int LC = 32, NCH = SEQL / LC  , CHP = SEQP * NCH  ;
constexpr int UHK = LC * 16 + 256;
constexpr float EPSN = 1e-6f;
constexpr float QSCALE = 0.18033688011112042f;

constexpr size_t AL(size_t x) { return (x + 255) & ~(size_t)255; }
constexpr size_t WS_WIN = 4096;
constexpr size_t WS_WGLU = WS_WIN + (size_t)INC * DM * 2;
constexpr size_t WS_WA = WS_WGLU + (size_t)512 * 512 * 2;
constexpr size_t WS_WB = WS_WA + (size_t)1024 * 512 * 2;
constexpr size_t WS_WOUT = WS_WB + (size_t)1024 * 512 * 2;
constexpr size_t WS_MTC = WS_WOUT + (size_t)1024 * 1024 * 2;
constexpr size_t WS_BST = WS_MTC + (size_t)32 * 512 * UHK * 2;
constexpr size_t WS_ROPE = WS_BST + (size_t)32 * 256 * 512 * 2;
constexpr size_t WS_PW = WS_ROPE + (size_t)2 * SEQL * 32 * 4;
constexpr size_t WS_KT = WS_PW + (size_t)2 * 32 * 64 * 8;
constexpr size_t WS_Q = WS_KT + (size_t)32 * 2 * 32 * 256 * 4;
constexpr size_t WS_K = WS_Q + (size_t)TP * QKVW * 2;
constexpr size_t WS_VT = WS_K + (size_t)TP * QKVW * 2;
constexpr size_t WS_ZA = WS_VT + (size_t)TP * QKVW * 2;
constexpr size_t WS_ZB = WS_ZA + (size_t)TP * 512 * 2;
constexpr size_t WS_GA = WS_ZB + (size_t)TP * 512 * 2;
constexpr size_t WS_GB = WS_GA + (size_t)TP * 1024 * 2;
constexpr size_t WS_UH = WS_GB + (size_t)TP * 1024 * 2;
constexpr size_t WS_S = WS_UH + (size_t)32 * CHP * UHK * 2;
constexpr size_t WS_GAO = WS_S + (size_t)32 * CHP * 256 * 4;
constexpr size_t WS_BAR = WS_GAO + (size_t)TP * 512 * 2;
constexpr size_t WS_BAR_BYTES = 32768;
constexpr size_t WS_CTL = WS_BAR + WS_BAR_BYTES;
constexpr size_t WS_END = WS_CTL + 4096;
constexpr size_t WS_SG = WS_Q;
constexpr size_t WS_SB = WS_Q + (size_t)TP * 512 * 2;
constexpr size_t WS_M1 = WS_K;
constexpr size_t WS_ACC = WS_Q;
constexpr size_t OUT_HN_OFF = (size_t)SEQP * SEQL * DM * 4;

struct Args {
    const float* in[17];
    float* out;
    unsigned char* ws;
    int st_lo, st_hi;
    int do_sync, pad;
};

typedef __bf16 bf16v2 __attribute__((ext_vector_type(2)));
__device__ __forceinline__ unsigned cvt_pk_bf16(float lo, float hi) { const f32x2 v = (f32x2){lo, hi}; const bf16v2 r = __builtin_convertvector(v, bf16v2); return __builtin_bit_cast(unsigned, r); }
__device__ __forceinline__ float bf_lo(unsigned w) { return __uint_as_float(w << 16); }
__device__ __forceinline__ float bf_hi(unsigned w) { return __uint_as_float(w & 0xffff0000u); }
__device__ __forceinline__ float fast_rcp(float x) { return __builtin_amdgcn_rcpf(x); }
__device__ __forceinline__ float sigmoidf_(float x) { return fast_rcp(1.0f + __builtin_amdgcn_exp2f(-1.4426950408889634f * x)); }
__device__ __forceinline__ float siluf_(float x) { return x * sigmoidf_(x); }
__device__ __forceinline__ float gelu_tanh(float x) { const float u = x * (1.5957691216057308f + 0.07135481627260025f * x * x); return x * sigmoidf_(u); }
__device__ __forceinline__ float wave_sum(float v) {
#pragma unroll
    for (int o = 1; o < 64; o <<= 1) v += __shfl_xor(v, o);
    return v;
}
__device__ __forceinline__ const float* xrow_ptr(const float* xp, const float* xs, int tg) {
    return tg < 4 * SEQL ? xp + (size_t)tg * DM : xs + (size_t)(tg - 4 * SEQL) * DM;
}

constexpr int BM = 256, BK = 64, HALF = 128, HTB = HALF * BK * 2, STAGE_BYTES = 8 * HTB, NXCD = 8, WGM = 8;
__host__ __device__ __forceinline__ int lds_byte(int r, int c) { const int st = (r >> 4) * 2 + (c >> 5), rr = r & 15, cc = c & 31, ob = rr * 64 + cc * 2; return st * 1024 + (ob ^ (((ob >> 9) & 1) << 5)); }
__host__ __device__ __forceinline__ void stage_rc(int b, int& R, int& C) { const int st = b / 1024, sb = b % 1024, swz = sb ^ (((sb >> 9) & 1) << 5); R = (st >> 1) * 16 + swz / 64; C = (st & 1) * 32 + (swz % 64) / 2; }
__host__ __device__ __forceinline__ int perm32(int rho) { const int n = rho >> 4, i = rho & 15; return 8 * (i >> 2) + 4 * n + (i & 3); }

enum { MODE_PROJ = 0, MODE_S = 1, MODE_Y = 2, MODE_GLU = 3, MODE_A = 4, MODE_B = 5, MODE_OUT = 6 };
struct Unit { int pm, pn, bz; };
struct GemmD {
    const bf16_t* A; const bf16_t* Bt;
    int lda, ldb, K, nM, nN, nb;
    unsigned sA, sB;
    int mode, pass, lgnN;
    int u0, ustride, ucount;
};
__device__ __forceinline__ bool unit_next(const GemmD& g, int i, int G, int c, int& pm, int& pn, int& bz) {
    const bool ok = i < g.ucount;
    const int Li = ok ? g.u0 + i * g.ustride : 0;
    if (g.nb == 1) {
        const int lg = g.lgnN, q = (g.nM << lg) >> 3;
        const int wgid = (Li & 7) * q + (Li >> 3);
        const int gid = wgid >> (3 + lg), rem = wgid & ((8 << lg) - 1);
        pm = gid * 8 + (rem & 7); pn = rem >> 3; bz = 0;
    } else {
        const int nwg = g.nM * g.nN;
        const int w = Li % nwg; bz = Li / nwg; pm = w % g.nM; pn = w / g.nM;
    }
    return ok;
}

__device__ __forceinline__ void epilogue(const Args& a, LAS unsigned char* lds, const GemmD& g, const f32x4 (&acc)[2][2][4][2], const Unit& u, int wr, int wc, int fr, int fq) {
    asm volatile("" : "+v"(fr), "+v"(fq));
    unsigned char* ws = a.ws;
    const int rbase = u.pm * BM + wr * 64 + fr;
    const int cl = wc * 32 + fq * 8;
    if (g.mode == MODE_PROJ) {
        const int pn = u.pn;
        if (pn < 12) {
            const bool isq = pn < 6;
            bf16_t* dst = (bf16_t*)(ws + (isq ? WS_Q : WS_K));
            const float* rc = (const float*)(ws + WS_ROPE); const float* rs = rc + SEQL * 32;
            const int a4 = 4 * (4 * (wc & 1) + fq);
            const int pq = isq ? pn : pn - 6, gi = pq >> 1, sh = 2 * gi, dmask = (1 << sh) - 1, Lg = SEQL >> sh;
            const float sc = isq ? QSCALE : 1.0f;
#pragma unroll
            for (int ai = 0; ai < 2; ++ai) {
                asm volatile("" ::: "memory");
                f32x4 cvv[4], svv[4];
#pragma unroll
                for (int m = 0; m < 4; ++m) { const int pos = (rbase + ai * HALF + m * 16) & (SEQL - 1); cvv[m] = *(const f32x4*)(rc + pos * 32 + a4); svv[m] = *(const f32x4*)(rs + pos * 32 + a4); }
#pragma unroll
                for (int m = 0; m < 4; ++m) {
                    const int tl = rbase + ai * HALF + m * 16; const int pos = tl & (SEQL - 1), sq = tl >> 13;
                    const int kidx = (pos & dmask) * Lg + (pos >> sh);
                    const f32x4 cv = cvv[m] * sc, sv = svv[m] * sc;
#pragma unroll
                    for (int bj = 0; bj < 2; ++bj) {
                        const f32x4 x1 = acc[ai][bj][m][0], x2 = acc[ai][bj][m][1];
                        const f32x4 o1 = x1 * cv - x2 * sv, o2 = x2 * cv + x1 * sv;
                        const int head = pq * 4 + 2 * bj + (wc >> 1);
                        const int ch = 4 * (wc & 1) + fq;
                        bf16_t* p = dst + (size_t)(sq * 24 + head) * SEQL * 64 + (isq ? (size_t)kidx * 64 + ch * 8 : (size_t)(kidx >> 4) * 1024 + ch * 128 + (kidx & 15) * 8);
                        u32x4 w; w.x = cvt_pk_bf16(o1[0], o1[1]); w.y = cvt_pk_bf16(o1[2], o1[3]); w.z = cvt_pk_bf16(o2[0], o2[1]); w.w = cvt_pk_bf16(o2[2], o2[3]);
                        *(u32x4*)p = w;
                    }
                }
            }
        } else if (pn < 18) {
            bf16_t* dst = (bf16_t*)(ws + WS_VT);
            const int gi = (pn - 12) >> 1, sh = 2 * gi;
            const int wid = wr * 4 + wc, lane = fq * 16 + fr;
            LAS bf16_t* tile = (LAS bf16_t*)(lds + STAGE_BYTES + wid * 4096);
#pragma unroll
            for (int ai = 0; ai < 2; ++ai) {
                const int tl0 = u.pm * BM + wr * 64 + ai * HALF;
                const int pos0 = tl0 & (SEQL - 1), sq = tl0 >> 13;
#pragma unroll
                for (int bj = 0; bj < 2; ++bj) {
                    asm volatile("" ::: "memory");
                    const int h = (4 * (pn - 12) + 2 * bj + (wc >> 1)) & 7;
#pragma unroll
                    for (int m = 0; m < 4; ++m) {
                        const int t = 16 * m + fr;
                        const int slot = gi == 0 ? t : (gi == 1 ? ((t & 3) * 16 + (t >> 2)) : ((t & 15) * 4 + (t >> 4)));
#pragma unroll
                        for (int n = 0; n < 2; ++n)
#pragma unroll
                            for (int j = 0; j < 4; ++j) { const unsigned w = cvt_pk_bf16(acc[ai][bj][m][n][j], 0.f); tile[(8 * fq + 4 * n + j) * 64 + slot] = (bf16_t)(w & 0xffffu); }
                    }
                    bf16_t* hb0 = dst + (size_t)(((sq * 3 + gi) * 8 + h) * 512) * 1024;
#pragma unroll
                    for (int i = 0; i < 4; ++i) {
                        const int c = lane + 64 * i, d = c >> 3, s8 = (c & 7) * 8;
                        const u32x4 v = *(const LAS u32x4*)(tile + d * 64 + s8);
                        const int dg = 32 * (wc & 1) + d; const int doff = (dg >> 4) * 256 + (dg & 15) * 4;
                        if (gi == 0) { const int kidx = pos0 + s8; bf16_t* q = hb0 + (size_t)(kidx >> 4) * 1024 + doff + ((kidx & 15) >> 2) * 64; *(u32x2*)q = (u32x2){v.x, v.y}; *(u32x2*)(q + 64) = (u32x2){v.z, v.w}; }
                        else if (gi == 1) { const int kidx = (s8 >> 4) * 2048 + (pos0 >> 2) + (s8 & 15); bf16_t* q = hb0 + (size_t)(kidx >> 4) * 1024 + doff + ((kidx & 15) >> 2) * 64; *(u32x2*)q = (u32x2){v.x, v.y}; *(u32x2*)(q + 64) = (u32x2){v.z, v.w}; }
                        else { const int ka = (s8 >> 2) * 512 + (pos0 >> 4), kb = ka + 512;
                            *(u32x2*)(hb0 + (size_t)(ka >> 4) * 1024 + doff + ((ka & 15) >> 2) * 64) = (u32x2){v.x, v.y}; *(u32x2*)(hb0 + (size_t)(kb >> 4) * 1024 + doff + ((kb & 15) >> 2) * 64) = (u32x2){v.z, v.w}; }
                    }
                }
            }
        } else if (pn == 20 || pn == 21) {
            bf16_t* dst = (bf16_t*)(ws + WS_UH);
#pragma unroll
            for (int ai = 0; ai < 2; ++ai)
#pragma unroll
                for (int m = 0; m < 4; ++m) { asm volatile("" ::: "memory");
                    const int tl = rbase + ai * HALF + m * 16;
#pragma unroll
                    for (int bj = 0; bj < 2; ++bj) {
                        const int gg = 16 * (pn - 20) + 8 * bj + 2 * wc + (fq >> 1);
                        bf16_t* p = dst + ((size_t)(gg * CHP + (tl >> 5)) * UHK) + (tl & 31) * 16 + 8 * (fq & 1);
                        const f32x4 v0 = acc[ai][bj][m][0], v1 = acc[ai][bj][m][1];
                        u32x4 w; w.x = cvt_pk_bf16(v0[0], v0[1]); w.y = cvt_pk_bf16(v0[2], v0[3]); w.z = cvt_pk_bf16(v1[0], v1[1]); w.w = cvt_pk_bf16(v1[2], v1[3]);
                        *(u32x4*)p = w;
                    }
                }
        } else {
            bf16_t* dst; int ld, c0; bool silu;
            if (pn < 20) { dst = (bf16_t*)(ws + WS_ZA); ld = 512; c0 = (pn - 18) * 256; silu = true; }
            else if (pn < 24) { dst = (bf16_t*)(ws + WS_ZB); ld = 512; c0 = (pn - 22) * 256; silu = true; }
            else if (pn < 28) { dst = (bf16_t*)(ws + WS_GA); ld = 1024; c0 = (pn - 24) * 256; silu = false; }
            else { dst = (bf16_t*)(ws + WS_GB); ld = 1024; c0 = (pn - 28) * 256; silu = false; }
#pragma unroll
            for (int ai = 0; ai < 2; ++ai)
#pragma unroll
                for (int m = 0; m < 4; ++m) { asm volatile("" ::: "memory");
                    const int tl = rbase + ai * HALF + m * 16;
#pragma unroll
                    for (int bj = 0; bj < 2; ++bj) {
                        f32x4 v0 = acc[ai][bj][m][0], v1 = acc[ai][bj][m][1];
#pragma unroll
                        for (int j = 0; j < 4; ++j) { const float s0 = sigmoidf_(v0[j]), s1 = sigmoidf_(v1[j]); v0[j] = silu ? v0[j] * s0 : s0; v1[j] = silu ? v1[j] * s1 : s1; }
                        u32x4 w; w.x = cvt_pk_bf16(v0[0], v0[1]); w.y = cvt_pk_bf16(v0[2], v0[3]); w.z = cvt_pk_bf16(v1[0], v1[1]); w.w = cvt_pk_bf16(v1[2], v1[3]);
                        *(u32x4*)(dst + (size_t)tl * ld + c0 + cl + bj * HALF) = w;
                    }
                }
        }
    } else if (g.mode == MODE_S) {
        float* dst = (float*)(ws + WS_S) + (size_t)u.bz * CHP * 256;
#pragma unroll
        for (int ai = 0; ai < 2; ++ai)
#pragma unroll
            for (int m = 0; m < 4; ++m) { asm volatile("" ::: "memory");
                const int r = rbase + ai * HALF + m * 16;
#pragma unroll
                for (int bj = 0; bj < 2; ++bj) { float* p = dst + (size_t)r * 256 + cl + bj * HALF; *(f32x4*)p = acc[ai][bj][m][0]; *(f32x4*)(p + 4) = acc[ai][bj][m][1]; }
            }
    } else if (g.mode == MODE_Y) {
        bf16_t* dst = (bf16_t*)(ws + WS_SG);
#pragma unroll
        for (int ai = 0; ai < 2; ++ai)
#pragma unroll
            for (int m = 0; m < 4; ++m) { asm volatile("" ::: "memory");
                const int r = rbase + ai * HALF + m * 16;
#pragma unroll
                for (int bj = 0; bj < 2; ++bj) {
                    const int t = 16 * u.pn + 8 * bj + 2 * wc + (fq >> 1);
                    f32x4 v0 = acc[ai][bj][m][0], v1 = acc[ai][bj][m][1];
#pragma unroll
                    for (int j = 0; j < 4; ++j) { v0[j] = gelu_tanh(v0[j]); v1[j] = gelu_tanh(v1[j]); }
                    u32x4 w; w.x = cvt_pk_bf16(v0[0], v0[1]); w.y = cvt_pk_bf16(v0[2], v0[3]); w.z = cvt_pk_bf16(v1[0], v1[1]); w.w = cvt_pk_bf16(v1[2], v1[3]);
                    *(u32x4*)(dst + (size_t)(r * LC + t) * 512 + u.bz * 16 + 8 * (fq & 1)) = w;
                }
            }
    } else if (g.mode == MODE_GLU) {
        const bf16_t* sg = (const bf16_t*)(ws + WS_SG); const bf16_t* zb = (const bf16_t*)(ws + WS_ZB); bf16_t* dst = (bf16_t*)(ws + WS_SB);
#pragma unroll
        for (int ai = 0; ai < 2; ++ai) {
            asm volatile("" ::: "memory");
            u32x4 sv4[4][2], zv4[4][2];
#pragma unroll
            for (int m = 0; m < 4; ++m)
#pragma unroll
                for (int bj = 0; bj < 2; ++bj) { const size_t off = (size_t)(rbase + ai * HALF + m * 16) * 512 + u.pn * BM + cl + bj * HALF; sv4[m][bj] = *(const u32x4*)(sg + off); zv4[m][bj] = *(const u32x4*)(zb + off); }
#pragma unroll
            for (int m = 0; m < 4; ++m)
#pragma unroll
                for (int bj = 0; bj < 2; ++bj) {
                    const size_t off = (size_t)(rbase + ai * HALF + m * 16) * 512 + u.pn * BM + cl + bj * HALF;
                    const u32x4 s4 = sv4[m][bj], z4 = zv4[m][bj];
                    const f32x4 v0 = acc[ai][bj][m][0], v1 = acc[ai][bj][m][1];
                    u32x4 w;
                    w.x = cvt_pk_bf16(bf_lo(s4.x) * sigmoidf_(v0[0]) * bf_lo(z4.x), bf_hi(s4.x) * sigmoidf_(v0[1]) * bf_hi(z4.x));
                    w.y = cvt_pk_bf16(bf_lo(s4.y) * sigmoidf_(v0[2]) * bf_lo(z4.y), bf_hi(s4.y) * sigmoidf_(v0[3]) * bf_hi(z4.y));
                    w.z = cvt_pk_bf16(bf_lo(s4.z) * sigmoidf_(v1[0]) * bf_lo(z4.z), bf_hi(s4.z) * sigmoidf_(v1[1]) * bf_hi(z4.z));
                    w.w = cvt_pk_bf16(bf_lo(s4.w) * sigmoidf_(v1[2]) * bf_lo(z4.w), bf_hi(s4.w) * sigmoidf_(v1[3]) * bf_hi(z4.w));
                    *(u32x4*)(dst + off) = w;
                }
        }
    } else if (g.mode == MODE_A || g.mode == MODE_B) {
        const bool isb = g.mode == MODE_B;
        const bf16_t* gt = (const bf16_t*)(ws + (isb ? WS_GB : WS_GA)); bf16_t* dst = (bf16_t*)(ws + WS_M1);
#pragma unroll
        for (int ai = 0; ai < 2; ++ai) {
            asm volatile("" ::: "memory");
            u32x4 gv4[4][2], pv4[4][2];
#pragma unroll
            for (int m = 0; m < 4; ++m)
#pragma unroll
                for (int bj = 0; bj < 2; ++bj) { const size_t off = (size_t)(rbase + ai * HALF + m * 16) * 1024 + u.pn * BM + cl + bj * HALF; gv4[m][bj] = *(const u32x4*)(gt + off); pv4[m][bj] = (u32x4){0u, 0u, 0u, 0u}; if (isb) pv4[m][bj] = *(const u32x4*)(dst + off); }
#pragma unroll
            for (int m = 0; m < 4; ++m)
#pragma unroll
                for (int bj = 0; bj < 2; ++bj) {
                    const size_t off = (size_t)(rbase + ai * HALF + m * 16) * 1024 + u.pn * BM + cl + bj * HALF;
                    const u32x4 g4 = gv4[m][bj], p4 = pv4[m][bj];
                    const f32x4 v0 = acc[ai][bj][m][0], v1 = acc[ai][bj][m][1];
                    u32x4 w;
                    w.x = cvt_pk_bf16(bf_lo(p4.x) + bf_lo(g4.x) * v0[0], bf_hi(p4.x) + bf_hi(g4.x) * v0[1]);
                    w.y = cvt_pk_bf16(bf_lo(p4.y) + bf_lo(g4.y) * v0[2], bf_hi(p4.y) + bf_hi(g4.y) * v0[3]);
                    w.z = cvt_pk_bf16(bf_lo(p4.z) + bf_lo(g4.z) * v1[0], bf_hi(p4.z) + bf_hi(g4.z) * v1[1]);
                    w.w = cvt_pk_bf16(bf_lo(p4.w) + bf_lo(g4.w) * v1[2], bf_hi(p4.w) + bf_hi(g4.w) * v1[3]);
                    *(u32x4*)(dst + off) = w;
                }
        }
    } else {
        bf16_t* dst = (bf16_t*)(ws + WS_ACC);
#pragma unroll
        for (int ai = 0; ai < 2; ++ai)
#pragma unroll
            for (int m = 0; m < 4; ++m) {
                const int tl = rbase + ai * HALF + m * 16;
#pragma unroll
                for (int bj = 0; bj < 2; ++bj) {
                    const f32x4 v0 = acc[ai][bj][m][0], v1 = acc[ai][bj][m][1];
                    u32x4 w; w.x = cvt_pk_bf16(v0[0], v0[1]); w.y = cvt_pk_bf16(v0[2], v0[3]); w.z = cvt_pk_bf16(v1[0], v1[1]); w.w = cvt_pk_bf16(v1[2], v1[3]);
                    *(u32x4*)(dst + (size_t)tl * DM + u.pn * BM + cl + bj * HALF) = w;
                }
            }
    }
}

__device__ __forceinline__ void gemm_phase(const Args& a, LAS unsigned char* lds, const GemmD& g, int G, int cidx, int tid) {
    const int wid = __builtin_amdgcn_readfirstlane(tid >> 6), lane = tid & 63, wr = wid >> 2, wc = wid & 3, fr = lane & 15, fq = lane >> 4;
    const int K = g.K, nt = K / BK;
    unsigned voffA[2], voffB[2];
#pragma unroll
    for (int i = 0; i < 2; ++i) { int R, C; stage_rc(tid * 16 + i * 8192, R, C); const int Rb = (R & ~31) + perm32(R & 31);
        voffA[i] = (unsigned)(R * g.lda + C) * 2u; voffB[i] = (unsigned)(Rb * g.ldb + C) * 2u; }
    const size_t kstep = (size_t)(BK * 2);
    const size_t hstepA = (size_t)HALF * g.lda * 2, hstepB = (size_t)HALF * g.ldb * 2;
    const size_t tstepA = 2 * hstepA, tstepB = 2 * hstepB;
    const unsigned ldsw = (unsigned)wid * 1024u;
    const int aoff = lds_byte(wr * 64 + fr, fq * 8), boff = lds_byte(wc * 32 + fr, fq * 8);
#define PG8_SA(b, h) (((b) * 2 + (h)) * HTB)
#define PG8_SB(b, h) ((4 + (b) * 2 + (h)) * HTB)
#define PG8_STAGE(bufoff, gbase, voff) do { _Pragma("unroll") for (int _i = 0; _i < 2; ++_i) \
        __builtin_amdgcn_global_load_lds((const unsigned*)((const char*)(gbase) + (voff)[_i]), (LAS unsigned*)(lds + (bufoff) + ldsw + _i * 8192), 16, 0, 0); } while (0)
#define PG8_LDA(dst, b, h) do { _Pragma("unroll") for (int m = 0; m < 4; ++m) _Pragma("unroll") for (int k = 0; k < 2; ++k) dst[m][k] = *(const LAS bf16x8*)(lds + PG8_SA(b, h) + aoff + m * 2048 + k * 1024); } while (0)
#define PG8_LDB(dst, b, h) do { _Pragma("unroll") for (int n = 0; n < 2; ++n) _Pragma("unroll") for (int k = 0; k < 2; ++k) dst[n][k] = *(const LAS bf16x8*)(lds + PG8_SB(b, h) + boff + n * 2048 + k * 1024); } while (0)
#define PG8_MMA(ai, bj, At, Bt) do { __builtin_amdgcn_s_setprio(1); _Pragma("unroll") for (int m = 0; m < 4; ++m) _Pragma("unroll") for (int n = 0; n < 2; ++n) _Pragma("unroll") for (int k = 0; k < 2; ++k) \
        acc[ai][bj][m][n] = __builtin_amdgcn_mfma_f32_16x16x32_bf16(Bt[n][k], At[m][k], acc[ai][bj][m][n], 0, 0, 0); __builtin_amdgcn_s_setprio(0); } while (0)
#define PG8_WAIT_V(n) asm volatile("s_waitcnt vmcnt(" #n ")" ::: "memory")
#define PG8_WAIT_L(n) asm volatile("s_waitcnt lgkmcnt(" #n ")" ::: "memory")
#define PG8_BAR __builtin_amdgcn_s_barrier()
#define PG8_SCHED __builtin_amdgcn_sched_barrier(0)
    Unit cur, nxt; int ui = 0;
    { int pm_, pn_, bz_; if (!unit_next(g, 0, G, cidx, pm_, pn_, bz_)) return; cur.pm = pm_; cur.pn = pn_; cur.bz = bz_; }
    f32x4 acc[2][2][4][2];
#pragma unroll
    for (int a = 0; a < 2; ++a)
#pragma unroll
        for (int b = 0; b < 2; ++b)
#pragma unroll
            for (int m = 0; m < 4; ++m)
#pragma unroll
                for (int n = 0; n < 2; ++n) acc[a][b][m][n] = (f32x4){0.f, 0.f, 0.f, 0.f};
    bf16x8 At[4][2], B0[2][2], B1[2][2];
    const char* cA = (const char*)g.A + (size_t)cur.bz * g.sA + (size_t)cur.pm * tstepA; const char* cB = (const char*)g.Bt + (size_t)cur.bz * g.sB + (size_t)cur.pn * tstepB;
    PG8_STAGE(PG8_SB(0, 0), cB, voffB); PG8_STAGE(PG8_SA(0, 0), cA, voffA); PG8_STAGE(PG8_SB(0, 1), cB + hstepB, voffB); PG8_STAGE(PG8_SA(0, 1), cA + hstepA, voffA);
    if (wr == 1) PG8_BAR;
    PG8_WAIT_V(4); PG8_BAR;
    PG8_STAGE(PG8_SB(1, 0), cB + kstep, voffB); PG8_STAGE(PG8_SA(1, 0), cA + kstep, voffA); PG8_STAGE(PG8_SB(1, 1), cB + hstepB + kstep, voffB);
    PG8_WAIT_V(6); PG8_BAR;
    for (;;) {
        int npm, npn, nbz; const bool has_next = unit_next(g, ui + 1, G, cidx, npm, npn, nbz); nxt.pm = npm; nxt.pn = npn; nxt.bz = nbz;
        const char* nA = has_next ? (const char*)g.A + (size_t)nxt.bz * g.sA + (size_t)nxt.pm * tstepA : cA; const char* nB = has_next ? (const char*)g.Bt + (size_t)nxt.bz * g.sB + (size_t)nxt.pn * tstepB : cB;
        for (int t = 0; t < nt; t += 2) {
            const bool last = (t == nt - 2);
            const char* a1 = cA + (size_t)(t + 1) * kstep;
            const char* a2 = last ? nA : cA + (size_t)(t + 2) * kstep; const char* b2 = last ? nB : cB + (size_t)(t + 2) * kstep;
            const char* a3 = a2 + kstep; const char* b3 = b2 + kstep;
            PG8_LDB(B0, 0, 0); PG8_SCHED; PG8_LDA(At, 0, 0); PG8_STAGE(PG8_SA(1, 1), a1 + hstepA, voffA);
            PG8_WAIT_L(8); PG8_BAR; PG8_WAIT_L(0); PG8_MMA(0, 0, At, B0); PG8_BAR; PG8_SCHED;
            PG8_LDB(B1, 0, 1); PG8_STAGE(PG8_SB(0, 0), b2, voffB);
            PG8_BAR; PG8_WAIT_L(0); PG8_MMA(0, 1, At, B1); PG8_BAR;
            PG8_LDA(At, 0, 1); PG8_STAGE(PG8_SA(0, 0), a2, voffA);
            PG8_BAR; PG8_WAIT_L(0); PG8_MMA(1, 0, At, B0); PG8_BAR; PG8_SCHED;
            PG8_STAGE(PG8_SB(0, 1), b2 + hstepB, voffB);
            PG8_WAIT_V(6); PG8_BAR; PG8_MMA(1, 1, At, B1); PG8_BAR;
            PG8_LDB(B0, 1, 0); PG8_SCHED; PG8_LDA(At, 1, 0); PG8_STAGE(PG8_SA(0, 1), a2 + hstepA, voffA);
            PG8_WAIT_L(8); PG8_BAR; PG8_WAIT_L(0); PG8_MMA(0, 0, At, B0); PG8_BAR; PG8_SCHED;
            PG8_LDB(B1, 1, 1); PG8_STAGE(PG8_SB(1, 0), b3, voffB);
            PG8_BAR; PG8_WAIT_L(0); PG8_MMA(0, 1, At, B1); PG8_BAR;
            PG8_LDA(At, 1, 1); PG8_STAGE(PG8_SA(1, 0), a3, voffA);
            PG8_BAR; PG8_WAIT_L(0); PG8_MMA(1, 0, At, B0); PG8_BAR; PG8_SCHED;
            PG8_STAGE(PG8_SB(1, 1), b3 + hstepB, voffB);
            PG8_WAIT_V(6); PG8_BAR; PG8_MMA(1, 1, At, B1); PG8_BAR;
        }
#ifndef NO_EPI
        epilogue(a, lds, g, acc, cur, wr, wc, fr, fq);
#else
        if (g.mode == 99) *(f32x4*)(g.out) = acc[0][0][0][0] + acc[1][1][3][1] + acc[0][1][2][0]+acc[1][0][1][1];
#endif
        if (!has_next) break;
#pragma unroll
        for (int a = 0; a < 2; ++a)
#pragma unroll
            for (int b = 0; b < 2; ++b)
#pragma unroll
                for (int m = 0; m < 4; ++m)
#pragma unroll
                    for (int n = 0; n < 2; ++n) acc[a][b][m][n] = (f32x4){0.f, 0.f, 0.f, 0.f};
        cur = nxt; cA = nA; cB = nB; ++ui;
    }
    PG8_WAIT_V(0);
    if (wr == 0) PG8_BAR;
    PG8_BAR;
#undef PG8_SA
#undef PG8_SB
#undef PG8_STAGE
#undef PG8_LDA
#undef PG8_LDB
#undef PG8_MMA
#undef PG8_WAIT_V
#undef PG8_WAIT_L
#undef PG8_BAR
#undef PG8_SCHED
}

__device__ __forceinline__ int qk_perm_row(int n) { const int i = n & 63; return (n & ~63) + 8 * ((i & 31) >> 2) + (i & 3) + 4 * (i >> 5); }
__device__ __forceinline__ void transpose_item(const float* W, int K, int N, bf16_t* WT, bool permqk, LAS float* scr, int item, int lane) {
    const int nblk = N / 32, kb = item / nblk, nb = item % nblk, k0 = 64 * kb, n0 = 32 * nb;
#pragma unroll 8
    for (int i = 0; i < 32; ++i) { const int kk = 2 * i + (lane >> 5); scr[kk * 33 + (lane & 31)] = W[(size_t)(k0 + kk) * N + n0 + (lane & 31)]; }
    asm volatile("s_waitcnt lgkmcnt(0)" ::: "memory");
    const int c = lane & 7;
#pragma unroll
    for (int j = 0; j < 4; ++j) { const int n = (lane >> 3) + 8 * j; const LAS float* s = scr + (8 * c) * 33 + n;
        u32x4 o; o.x = cvt_pk_bf16(s[0 * 33], s[1 * 33]); o.y = cvt_pk_bf16(s[2 * 33], s[3 * 33]); o.z = cvt_pk_bf16(s[4 * 33], s[5 * 33]); o.w = cvt_pk_bf16(s[6 * 33], s[7 * 33]);
        int row = n0 + n; if (permqk && row < 2 * QKVW) row = qk_perm_row(row);
        *(u32x4*)(WT + (size_t)row * K + k0 + 8 * c) = o; }
    asm volatile("s_waitcnt lgkmcnt(0)" ::: "memory");
}
__device__ __forceinline__ void reduce_angle(double a, float& c, float& s) {
    const double k = __builtin_rint(a * 0.6366197723675814); const float x = (float)(a - k * 1.5707963267948966), x2 = x * x;
    const float sn = x * (1.0f + x2 * (-1.6666666667e-1f + x2 * (8.3333333333e-3f + x2 * (-1.9841269841e-4f + x2 * 2.7557319224e-6f))));
    const float cs = 1.0f + x2 * (-0.5f + x2 * (4.1666666667e-2f + x2 * (-1.3888888889e-3f + x2 * (2.4801587302e-5f + x2 * -2.7557319224e-7f))));
    const int q = ((int)k) & 3;
    c = (q == 0) ? cs : (q == 1) ? -sn : (q == 2) ? -cs : sn;
    s = (q == 0) ? sn : (q == 1) ? cs : (q == 2) ? -sn : -cs;
}
__device__ __forceinline__ void rms_row_to_bf16(const float* xrow, const float* gw, bf16_t* orow, int lane) {
    const f32x4* xr = (const f32x4*)xrow + lane; const f32x4* gr = (const f32x4*)gw + lane;
    f32x4 v[4]; float s = 0.f;
#pragma unroll
    for (int j = 0; j < 4; ++j) { v[j] = xr[64 * j]; s += (v[j].x * v[j].x + v[j].y * v[j].y) + (v[j].z * v[j].z + v[j].w * v[j].w); }
    const float rstd = 1.0f / sqrtf(wave_sum(s) * (1.f / DM) + EPSN);
    u32x2* o8 = (u32x2*)orow + lane;
#pragma unroll
    for (int j = 0; j < 4; ++j) { const f32x4 gv = gr[64 * j]; u32x2 w; w.x = cvt_pk_bf16(v[j].x * rstd * gv.x, v[j].y * rstd * gv.y); w.y = cvt_pk_bf16(v[j].z * rstd * gv.z, v[j].w * rstd * gv.w); o8[64 * j] = w; }
}

__device__ __forceinline__ void ssm_load_bc(const Args& a, int g, int dir, LAS f32x2* Bb, LAS f32x2* Cc, int tid) {
    const float* lam_re = a.in[4]; const float* lam_im = a.in[5]; const float* log_step = a.in[6];
    const float* b_re = a.in[7]; const float* b_im = a.in[8]; const float* c_re = a.in[9]; const float* c_im = a.in[10];
    const float dt = expf(log_step[dir * 32 + g]);
    for (int idx = tid; idx < 1024; idx += 512) {
        { const int n = idx >> 4; const float lr = lam_re[(dir * 32 + g) * 64 + n], li = lam_im[(dir * 32 + g) * 64 + n];
          const float ar = lr * dt; float cb, sb, ch, sh; reduce_angle((double)li * (double)dt, cb, sb); reduce_angle(0.5 * (double)li * (double)dt, ch, sh);
          const float em1 = expm1f(ar), ea = em1 + 1.0f;
          const float nr = em1 * cb - 2.0f * sh * sh, ni = ea * sb;
          const float den = 1.0f / (lr * lr + li * li); const float cr = (nr * lr + ni * li) * den, ci = (ni * lr - nr * li) * den;
          const float br = b_re[(size_t)((dir * 32 + g) * 64) * 16 + idx], bi = b_im[(size_t)((dir * 32 + g) * 64) * 16 + idx];
          Bb[idx] = (f32x2){cr * br - ci * bi, cr * bi + ci * br}; }
        { Cc[idx] = (f32x2){c_re[(size_t)((dir * 32 + g) * 16) * 64 + idx], c_im[(size_t)((dir * 32 + g) * 16) * 64 + idx]}; }
    }
}
__device__ __forceinline__ void ssm_setup_item(const Args& a, LAS unsigned char* lds, int item, int tid) {
    const int g = item >> 1, dir = item & 1;
    LAS f32x2* pw = (LAS f32x2*)lds; LAS f32x2* Bb = pw + 33 * 64; LAS f32x2* Cc = Bb + 1024;
    LAS float* KT = (LAS float*)(Cc + 1024); LAS float* K0 = KT + 32 * 256; LAS f32x2* Bb0 = (LAS f32x2*)(K0 + 256); LAS f32x2* Cc0 = Bb0 + 1024;
    const float* lam_re = a.in[4]; const float* lam_im = a.in[5]; const float* log_step = a.in[6];
    unsigned char* ws = a.ws;
    const float dt = expf(log_step[dir * 32 + g]);
    __syncthreads();
    for (int idx = tid; idx < 33 * 64; idx += 512) {
        const int tau = idx >> 6, n = idx & 63; const float lr = lam_re[(dir * 32 + g) * 64 + n], li = lam_im[(dir * 32 + g) * 64 + n];
        const float mag = expf(lr * dt * (float)tau); float c, s; reduce_angle((double)li * (double)dt * (double)tau, c, s);
        pw[idx] = (f32x2){mag * c, mag * s};
    }
    ssm_load_bc(a, g, dir, Bb, Cc, tid);
    if (dir == 1) ssm_load_bc(a, g, 0, Bb0, Cc0, tid);
    __syncthreads();
    if (tid < 64) { float* PW = (float*)(ws + WS_PW); const f32x2 p = pw[32 * 64 + tid]; PW[((dir * 32 + g) * 64 + tid) * 2] = p.x; PW[((dir * 32 + g) * 64 + tid) * 2 + 1] = p.y; }
    for (int o = tid; o < 32 * 256; o += 512) {
        const int tau = o >> 8, co = (o >> 4) & 15, ci = o & 15; float acc = 0.f;
_Pragma("unroll 4")
        for (int n = 0; n < 64; ++n) { const f32x2 c = Cc[co * 64 + n], p = pw[tau * 64 + n], b = Bb[n * 16 + ci]; const float tr = c.x * p.x - c.y * p.y, ti = c.x * p.y + c.y * p.x; acc += tr * b.x - ti * b.y; }
        KT[o] = acc; }
    if (dir == 1 && tid < 256) { const int co = tid >> 4, ci = tid & 15; float acc = 0.f;
_Pragma("unroll 4")
        for (int n = 0; n < 64; ++n) { const f32x2 c = Cc0[co * 64 + n], b = Bb0[n * 16 + ci]; acc += c.x * b.x - c.y * b.y; }
        K0[tid] = acc; }
    { bf16_t* BsT = (bf16_t*)(ws + WS_BST) + (size_t)g * 256 * 512;
      for (int ch = tid; ch < 128 * 64; ch += 512) {
          const int row = ch >> 6, part = row >> 6, n = row & 63, kc = ch & 63, s = kc >> 1, ci0 = (kc & 1) * 8; const int e = dir ? s : 31 - s; const f32x2 p = pw[e * 64 + n];
          float v[8];
#pragma unroll
          for (int j = 0; j < 8; ++j) { const f32x2 b = Bb[n * 16 + ci0 + j]; v[j] = part ? (p.x * b.y + p.y * b.x) : (p.x * b.x - p.y * b.y); }
          u32x4 w; w.x = cvt_pk_bf16(v[0], v[1]); w.y = cvt_pk_bf16(v[2], v[3]); w.z = cvt_pk_bf16(v[4], v[5]); w.w = cvt_pk_bf16(v[6], v[7]);
          *(u32x4*)(BsT + (size_t)(dir * 128 + row) * 512 + s * 16 + ci0) = w; } }
    bf16_t* MtC = (bf16_t*)(ws + WS_MTC) + (size_t)g * 512 * UHK;
    { for (int ch = tid; ch < 512 * 16; ch += 512) {
          const int row = ch >> 4, t = row >> 4, co = row & 15, cc = ch & 15, part = cc >> 3, n0 = (cc & 7) * 8; const int e = dir ? 32 - t : t + 1;
          float v[8];
#pragma unroll
          for (int j = 0; j < 8; ++j) { const f32x2 c = Cc[co * 64 + n0 + j], p = pw[e * 64 + n0 + j]; v[j] = part ? -(c.x * p.y + c.y * p.x) : (c.x * p.x - c.y * p.y); }
          u32x4 w; w.x = cvt_pk_bf16(v[0], v[1]); w.y = cvt_pk_bf16(v[2], v[3]); w.z = cvt_pk_bf16(v[4], v[5]); w.w = cvt_pk_bf16(v[6], v[7]);
          *(u32x4*)(MtC + (size_t)row * UHK + 512 + dir * 128 + part * 64 + n0) = w; } }
    __syncthreads();
    { const float* dsk = a.in[11];
      for (int ch = tid; ch < 512 * 64; ch += 512) {
          const int kc = ch & 63, row = ch >> 6; const int s = kc >> 1, ci0 = (kc & 1) * 8, t = row >> 4, co = row & 15;
          if (dir == 0 ? (t > s) : (s >= t)) {
              const int tau = dir == 0 ? t - s : s - t;
              float v[8];
#pragma unroll
              for (int j = 0; j < 8; ++j) v[j] = KT[tau * 256 + co * 16 + ci0 + j];
              if (t == s) { const float dv = dsk[g * 16 + co];
#pragma unroll
                  for (int j = 0; j < 8; ++j) v[j] += K0[co * 16 + ci0 + j] + ((ci0 + j == co) ? dv : 0.f); }
              u32x4 w; w.x = cvt_pk_bf16(v[0], v[1]); w.y = cvt_pk_bf16(v[2], v[3]); w.z = cvt_pk_bf16(v[4], v[5]); w.w = cvt_pk_bf16(v[6], v[7]);
              *(u32x4*)(MtC + (size_t)row * UHK + s * 16 + ci0) = w;
          }
      } }
    __syncthreads();
}

__device__ __forceinline__ void step_setup(const Args& a, LAS unsigned char* lds, int tid, int bx) {
    const int lane = tid & 63, wave = tid >> 6, G = gridDim.x;
    unsigned char* ws = a.ws;
    for (int it = bx; it < 64; it += G) ssm_setup_item(a, lds, it, tid);
    { float* rc = (float*)(ws + WS_ROPE); float* rs = rc + SEQL * 32;
      for (int idx = bx * 512 + tid; idx < SEQL * 32; idx += G * 512) {
          const int pos = idx >> 5, i = idx & 31; double inv = 1.0; for (int k = 0; k < i; ++k) inv *= 0.7498942093324558;
          float c, s; reduce_angle((double)pos * inv, c, s); rc[idx] = c; rs[idx] = s; } }
    { LAS float* scr = (LAS float*)(lds) + wave * (64 * 33);
      const int gw = bx * 8 + wave, NGW = G * 8;
      constexpr int I_IN = (DM / 64) * (INC / 32), I_GLU = (512 / 64) * (512 / 32), I_AB = (512 / 64) * (1024 / 32), I_OUT = (1024 / 64) * (1024 / 32);
      constexpr int NIT = I_IN + I_GLU + 2 * I_AB + I_OUT;
      for (int it = gw; it < NIT; it += NGW) {
          int r = it;
          if (r < I_IN) { transpose_item(a.in[3], DM, INC, (bf16_t*)(ws + WS_WIN), true, scr, r, lane); continue; } r -= I_IN;
          if (r < I_GLU) { transpose_item(a.in[12], 512, 512, (bf16_t*)(ws + WS_WGLU), false, scr, r, lane); continue; } r -= I_GLU;
          if (r < I_AB) { transpose_item(a.in[13], 512, 1024, (bf16_t*)(ws + WS_WA), false, scr, r, lane); continue; } r -= I_AB;
          if (r < I_AB) { transpose_item(a.in[14], 512, 1024, (bf16_t*)(ws + WS_WB), false, scr, r, lane); continue; } r -= I_AB;
          transpose_item(a.in[15], 1024, 1024, (bf16_t*)(ws + WS_WOUT), false, scr, r, lane);
      } }
    { bf16_t* hn = (bf16_t*)((unsigned char*)a.out + OUT_HN_OFF);
      const f32x4* gr = (const f32x4*)a.in[2] + lane;
      f32x4 gv[4];
#pragma unroll
      for (int j = 0; j < 4; ++j) gv[j] = gr[64 * j];
      unsigned* rctr = (unsigned*)(ws + WS_CTL) + 4;
      constexpr int RCH = 16;
      for (;;) {
          unsigned cidx = 0; if (lane == 0) cidx = atomicAdd(rctr, 1u);
          cidx = (unsigned)__builtin_amdgcn_readfirstlane((int)cidx);
          if (cidx >= (unsigned)(TTOK / RCH)) break;
          int row = (int)cidx * RCH; const int rend = row + RCH;
          f32x4 nx[4];
          { const f32x4* xr = (const f32x4*)xrow_ptr(a.in[0], a.in[1], row) + lane;
#pragma unroll
            for (int j = 0; j < 4; ++j) nx[j] = xr[64 * j]; }
          for (; row < rend; ++row) {
              f32x4 v[4];
#pragma unroll
              for (int j = 0; j < 4; ++j) v[j] = nx[j];
              if (row + 1 < rend) { const f32x4* xn = (const f32x4*)xrow_ptr(a.in[0], a.in[1], row + 1) + lane;
#pragma unroll
                  for (int j = 0; j < 4; ++j) nx[j] = xn[64 * j]; }
              float s = 0.f;
#pragma unroll
              for (int j = 0; j < 4; ++j) s += (v[j].x * v[j].x + v[j].y * v[j].y) + (v[j].z * v[j].z + v[j].w * v[j].w);
              const float rstd = 1.0f / sqrtf(wave_sum(s) * (1.f / DM) + EPSN);
              u32x2* o8 = (u32x2*)(hn + (size_t)row * DM) + lane;
#pragma unroll
              for (int j = 0; j < 4; ++j) { u32x2 w; w.x = cvt_pk_bf16(v[j].x * rstd * gv[j].x, v[j].y * rstd * gv[j].y); w.y = cvt_pk_bf16(v[j].z * rstd * gv[j].z, v[j].w * rstd * gv[j].w); o8[64 * j] = w; }
          }
      } }
}

struct KVBuf { bf16x8 kA0, kA1, kB0, kB1; bf16x4 vA[4], vB[4]; };
__device__ __forceinline__ void step_params(int s, int& gi, int& ls) { gi = s < 12 ? 0 : (s < 18 ? 1 : 2); ls = s < 12 ? s : (s < 18 ? s - 12 : s - 18); }
__device__ __forceinline__ void attn_load(KVBuf& b, const bf16_t* Kp, const bf16_t* Vt, int s, int sq, int h, int blk, int r, int lane) {
    int gi, ls; step_params(s, gi, ls);
    const int sh = 2 * gi, Lg = SEQL >> sh, rho = r & ((1 << sh) - 1);
    int uA = ((256 * blk) >> sh) - 64 + 32 * ls, uB = uA + 16;
    if (uA < 0 || uA >= Lg) uA = 0; if (uB < 0 || uB >= Lg) uB = 0;
    const int kl = lane & 15, quad = lane >> 4;
    const bf16_t* kh = Kp + (size_t)(sq * 24 + gi * 8 + h) * SEQL * 64 + quad * 128 + kl * 8;
    const bf16_t* ka = kh + (size_t)((rho * Lg + uA) >> 4) * 1024; const bf16_t* kb = kh + (size_t)((rho * Lg + uB) >> 4) * 1024;
    b.kA0 = *(const bf16x8*)ka; b.kA1 = *(const bf16x8*)(ka + 512); b.kB0 = *(const bf16x8*)kb; b.kB1 = *(const bf16x8*)(kb + 512);
    const bf16_t* vbase = Vt + (size_t)(((sq * 3 + gi) * 8 + h) * 512) * 1024 + quad * 64 + kl * 4;
    const bf16_t* va = vbase + (size_t)((rho * Lg + uA) >> 4) * 1024; const bf16_t* vb = vbase + (size_t)((rho * Lg + uB) >> 4) * 1024;
#pragma unroll
    for (int dt = 0; dt < 4; ++dt) { b.vA[dt] = *(const bf16x4*)(va + dt * 256); b.vB[dt] = *(const bf16x4*)(vb + dt * 256); }
}
struct QF { bf16x8 a0, a1, b0, b1, c0, c1; };
template <int gi>
__device__ __forceinline__ void attn_compute(const KVBuf& b, const bf16x8 q0, const bf16x8 q1, f32x4 (&o)[4], float& mrun, float& lrun, int s, int blk, int r, int lane) {
    const int ls = gi == 0 ? s : (gi == 1 ? s - 12 : s - 18);
    const int sh = 2 * gi, Lg = SEQL >> sh;
    const int uA = ((256 * blk) >> sh) - 64 + 32 * ls;
    const int qi = lane & 15, quad = lane >> 4;
    const int uq = (256 * blk + r + 16 * qi) >> sh;
    const int lo = max(0, uq - 64), hi = min(Lg - 1, uq + 64);
    f32x4 sA = (f32x4){0.f, 0.f, 0.f, 0.f}, sB = sA;
    sA = __builtin_amdgcn_mfma_f32_16x16x32_bf16(b.kA0, q0, sA, 0, 0, 0); sA = __builtin_amdgcn_mfma_f32_16x16x32_bf16(b.kA1, q1, sA, 0, 0, 0);
    sB = __builtin_amdgcn_mfma_f32_16x16x32_bf16(b.kB0, q0, sB, 0, 0, 0); sB = __builtin_amdgcn_mfma_f32_16x16x32_bf16(b.kB1, q1, sB, 0, 0, 0);
    const float NEGINF = -__builtin_inff();
    const unsigned span = (unsigned)(hi - lo);
    float mx = NEGINF;
#pragma unroll
    for (int j = 0; j < 4; ++j) {
        const int ua = uA + quad * 4 + j, ub = ua + 16;
        sA[j] = ((unsigned)(ua - lo) <= span) ? sA[j] : NEGINF; sB[j] = ((unsigned)(ub - lo) <= span) ? sB[j] : NEGINF;
        mx = fmaxf(mx, fmaxf(sA[j], sB[j]));
    }
    mx = fmaxf(mx, __shfl_xor(mx, 16)); mx = fmaxf(mx, __shfl_xor(mx, 32));
    const float mnew = fmaxf(mrun, mx), alpha = __builtin_amdgcn_exp2f(mrun - mnew);
    mrun = mnew;
    float ps = 0.f;
#pragma unroll
    for (int j = 0; j < 4; ++j) { sA[j] = __builtin_amdgcn_exp2f(sA[j] - mnew); sB[j] = __builtin_amdgcn_exp2f(sB[j] - mnew); ps += sA[j] + sB[j]; }
    lrun = lrun * alpha + ps;
    u32x4 pw; pw.x = cvt_pk_bf16(sA[0], sA[1]); pw.y = cvt_pk_bf16(sA[2], sA[3]); pw.z = cvt_pk_bf16(sB[0], sB[1]); pw.w = cvt_pk_bf16(sB[2], sB[3]);
    const bf16x8 pf = __builtin_bit_cast(bf16x8, pw);
#pragma unroll
    for (int dt = 0; dt < 4; ++dt) {
        o[dt] *= alpha;
        bf16x8 vf; vf[0] = b.vA[dt][0]; vf[1] = b.vA[dt][1]; vf[2] = b.vA[dt][2]; vf[3] = b.vA[dt][3]; vf[4] = b.vB[dt][0]; vf[5] = b.vB[dt][1]; vf[6] = b.vB[dt][2]; vf[7] = b.vB[dt][3];
#ifdef DBG_ATT2
        for (int e = 0; e < 8; ++e) o[dt][e & 3] += 1e-3f * __uint_as_float(((unsigned)(unsigned short)vf[e]) << 16);
#else
        o[dt] = __builtin_amdgcn_mfma_f32_16x16x32_bf16(vf, pf, o[dt], 0, 0, 0);
#endif
    }
}
template <int gi>
__device__ __forceinline__ void attn_compute2(const KVBuf& b, const KVBuf& c, const bf16x8 q0, const bf16x8 q1, f32x4 (&o)[4], float& mrun, float& lrun, int s, int blk, int r, int lane) {
    const int ls = gi == 0 ? s : (gi == 1 ? s - 12 : s - 18);
    const int sh = 2 * gi, Lg = SEQL >> sh;
    const int uA = ((256 * blk) >> sh) - 64 + 32 * ls;
    const int qi = lane & 15, quad = lane >> 4;
    const int uq = (256 * blk + r + 16 * qi) >> sh;
    const int lo = max(0, uq - 64), hi = min(Lg - 1, uq + 64);
    const f32x4 z4 = (f32x4){0.f, 0.f, 0.f, 0.f};
    f32x4 sA = __builtin_amdgcn_mfma_f32_16x16x32_bf16(b.kA0, q0, z4, 0, 0, 0), sB = __builtin_amdgcn_mfma_f32_16x16x32_bf16(b.kB0, q0, z4, 0, 0, 0);
    f32x4 sC = __builtin_amdgcn_mfma_f32_16x16x32_bf16(c.kA0, q0, z4, 0, 0, 0), sD = __builtin_amdgcn_mfma_f32_16x16x32_bf16(c.kB0, q0, z4, 0, 0, 0);
    sA = __builtin_amdgcn_mfma_f32_16x16x32_bf16(b.kA1, q1, sA, 0, 0, 0); sB = __builtin_amdgcn_mfma_f32_16x16x32_bf16(b.kB1, q1, sB, 0, 0, 0);
    sC = __builtin_amdgcn_mfma_f32_16x16x32_bf16(c.kA1, q1, sC, 0, 0, 0); sD = __builtin_amdgcn_mfma_f32_16x16x32_bf16(c.kB1, q1, sD, 0, 0, 0);
    const float NEGINF = -__builtin_inff();
    const unsigned span = (unsigned)(hi - lo);
    float mx = NEGINF;
#pragma unroll
    for (int j = 0; j < 4; ++j) {
        const int ua = uA + quad * 4 + j;
        sA[j] = ((unsigned)(ua - lo) <= span) ? sA[j] : NEGINF; sB[j] = ((unsigned)(ua + 16 - lo) <= span) ? sB[j] : NEGINF;
        sC[j] = ((unsigned)(ua + 32 - lo) <= span) ? sC[j] : NEGINF; sD[j] = ((unsigned)(ua + 48 - lo) <= span) ? sD[j] : NEGINF;
        mx = fmaxf(fmaxf(mx, fmaxf(sA[j], sB[j])), fmaxf(sC[j], sD[j]));
    }
    mx = fmaxf(mx, __shfl_xor(mx, 16)); mx = fmaxf(mx, __shfl_xor(mx, 32));
    const float mnew = fmaxf(mrun, mx), alpha = __builtin_amdgcn_exp2f(mrun - mnew);
    mrun = mnew;
    float ps = 0.f;
#pragma unroll
    for (int j = 0; j < 4; ++j) { sA[j] = __builtin_amdgcn_exp2f(sA[j] - mnew); sB[j] = __builtin_amdgcn_exp2f(sB[j] - mnew); sC[j] = __builtin_amdgcn_exp2f(sC[j] - mnew); sD[j] = __builtin_amdgcn_exp2f(sD[j] - mnew); ps += (sA[j] + sB[j]) + (sC[j] + sD[j]); }
    lrun = lrun * alpha + ps;
    u32x4 pw, pv; pw.x = cvt_pk_bf16(sA[0], sA[1]); pw.y = cvt_pk_bf16(sA[2], sA[3]); pw.z = cvt_pk_bf16(sB[0], sB[1]); pw.w = cvt_pk_bf16(sB[2], sB[3]);
    pv.x = cvt_pk_bf16(sC[0], sC[1]); pv.y = cvt_pk_bf16(sC[2], sC[3]); pv.z = cvt_pk_bf16(sD[0], sD[1]); pv.w = cvt_pk_bf16(sD[2], sD[3]);
    const bf16x8 pf = __builtin_bit_cast(bf16x8, pw), pg = __builtin_bit_cast(bf16x8, pv);
#pragma unroll
    for (int dt = 0; dt < 4; ++dt) {
        o[dt] *= alpha;
        bf16x8 vf, vg;
        vf[0] = b.vA[dt][0]; vf[1] = b.vA[dt][1]; vf[2] = b.vA[dt][2]; vf[3] = b.vA[dt][3]; vf[4] = b.vB[dt][0]; vf[5] = b.vB[dt][1]; vf[6] = b.vB[dt][2]; vf[7] = b.vB[dt][3];
        vg[0] = c.vA[dt][0]; vg[1] = c.vA[dt][1]; vg[2] = c.vA[dt][2]; vg[3] = c.vA[dt][3]; vg[4] = c.vB[dt][0]; vg[5] = c.vB[dt][1]; vg[6] = c.vB[dt][2]; vg[7] = c.vB[dt][3];
        o[dt] = __builtin_amdgcn_mfma_f32_16x16x32_bf16(vf, pf, o[dt], 0, 0, 0);
        o[dt] = __builtin_amdgcn_mfma_f32_16x16x32_bf16(vg, pg, o[dt], 0, 0, 0);
    }
}
__device__ __forceinline__ void step_attention(const Args& a, LAS unsigned char* lds, int pass, int tid, int bx) {
    unsigned char* ws = a.ws;
    const int lane = tid & 63;
    const bf16_t* Qp = (const bf16_t*)(ws + WS_Q); const bf16_t* Kp = (const bf16_t*)(ws + WS_K); const bf16_t* Vt = (const bf16_t*)(ws + WS_VT);
    const bf16_t* ZA = (const bf16_t*)(ws + WS_ZA); bf16_t* GAO = (bf16_t*)(ws + WS_GAO);
    const int xcd = bx & 7;
    unsigned* ctr = (unsigned*)(ws + WS_CTL) + 16 + pass * 8 + xcd;
    LAS unsigned* slot = (LAS unsigned*)(lds + 3 * 16384);
    constexpr int NGRP = 3 * 32 * 2;
    for (;;) {
        __syncthreads();
        if (tid == 0) slot[0] = atomicAdd(ctr, 1u);
        __syncthreads();
        const unsigned grp = (unsigned)__builtin_amdgcn_readfirstlane((int)slot[0]);
        if (grp >= (unsigned)NGRP) break;
        const int wv_ = tid >> 6; const int r = ((wv_ & 3) << 2) + (wv_ >> 2) + 2 * (int)(grp & 1)  , blk = (grp >> 1) & 31, pair = xcd * 3 + (int)(grp >> 6);
        const int h = pair & 7, sq = pair >> 3;
        const int qi = lane & 15, quad = lane >> 4;
        const int tq = sq * SEQL + 256 * blk + r + 16 * qi;
        QF qf;
        { const int pos = 256 * blk + r + 16 * qi;
          const bf16_t* qa = Qp + ((size_t)(sq * 24 + h) * SEQL + pos) * 64 + quad * 8;
          const bf16_t* qb = Qp + ((size_t)(sq * 24 + 8 + h) * SEQL + (pos & 3) * 2048 + (pos >> 2)) * 64 + quad * 8;
          const bf16_t* qc = Qp + ((size_t)(sq * 24 + 16 + h) * SEQL + (pos & 15) * 512 + (pos >> 4)) * 64 + quad * 8;
          qf.a0 = *(const bf16x8*)qa; qf.a1 = *(const bf16x8*)(qa + 32); qf.b0 = *(const bf16x8*)qb; qf.b1 = *(const bf16x8*)(qb + 32); qf.c0 = *(const bf16x8*)qc; qf.c1 = *(const bf16x8*)(qc + 32); }
        f32x4 o[4];
#pragma unroll
        for (int dt = 0; dt < 4; ++dt) o[dt] = (f32x4){0.f, 0.f, 0.f, 0.f};
        float mrun = -1e30f, lrun = 0.f;
        KVBuf b0, b1;
#define ATT_SB __builtin_amdgcn_sched_barrier(0);
        {
            const int wv = tid >> 6, region = wv >> 1;
            const bf16_t* gsrc = (region < 2 ? Kp + (size_t)(sq * 24 + h) * SEQL * 64 : Vt + (size_t)((sq * 3) * 8 + h) * 512 * 1024) + (wv & 1) * 512 + lane * 8;
            const int ubase = 256 * blk - 64 + (region & 1) * 16;
#define ATT_DMA(S) do { int uT = ubase + 32 * (S); if (uT < 0 || uT >= SEQL) uT = 0; \
                __builtin_amdgcn_global_load_lds((const unsigned*)(gsrc + (size_t)(uT >> 4) * 1024), (LAS unsigned*)(lds + (((S) >> 1) % 3) * 16384 + ((S) & 1) * 8192 + wv * 1024), 16, 0, 0); } while (0)
            ATT_DMA(0); ATT_DMA(1); ATT_DMA(2); ATT_DMA(3);
            const int kl = lane & 15;
            const unsigned foff = (unsigned)(quad * 256 + kl * 16), voff = (unsigned)(4096 + quad * 128 + kl * 8);
#pragma unroll 1
            for (int d = 0; d < 6; ++d) {
                if (d < 5) asm volatile("s_waitcnt vmcnt(2)" ::: "memory"); else asm volatile("s_waitcnt vmcnt(0)" ::: "memory");
                __syncthreads();
                if (d + 2 < 6) { ATT_DMA(2 * d + 4); ATT_DMA(2 * d + 5); }
                LAS unsigned char* kb = lds + (d % 3) * 16384;
                b0.kA0 = *(const LAS bf16x8*)(kb + foff); b0.kA1 = *(const LAS bf16x8*)(kb + foff + 1024); b0.kB0 = *(const LAS bf16x8*)(kb + 2048 + foff); b0.kB1 = *(const LAS bf16x8*)(kb + 2048 + foff + 1024);
                b1.kA0 = *(const LAS bf16x8*)(kb + 8192 + foff); b1.kA1 = *(const LAS bf16x8*)(kb + 8192 + foff + 1024); b1.kB0 = *(const LAS bf16x8*)(kb + 8192 + 2048 + foff); b1.kB1 = *(const LAS bf16x8*)(kb + 8192 + 2048 + foff + 1024);
#pragma unroll
                for (int dt = 0; dt < 4; ++dt) { b0.vA[dt] = *(const LAS bf16x4*)(kb + voff + dt * 512); b0.vB[dt] = *(const LAS bf16x4*)(kb + 2048 + voff + dt * 512);
                                                 b1.vA[dt] = *(const LAS bf16x4*)(kb + 8192 + voff + dt * 512); b1.vB[dt] = *(const LAS bf16x4*)(kb + 8192 + 2048 + voff + dt * 512); }
                attn_compute2<0>(b0, b1, qf.a0, qf.a1, o, mrun, lrun, 2 * d, blk, r, lane);
            }
#undef ATT_DMA
        }
        attn_load(b0, Kp, Vt, 12, sq, h, blk, r, lane);
#define ATT_LOOP(GI, S0, S1, QA, QB) _Pragma("unroll 1") for (int s = S0; s < S1; s += 2) { \
            ATT_SB attn_load(b1, Kp, Vt, s + 1, sq, h, blk, r, lane); ATT_SB attn_compute<GI>(b0, QA, QB, o, mrun, lrun, s, blk, r, lane); \
            ATT_SB attn_load(b0, Kp, Vt, s + 2, sq, h, blk, r, lane); ATT_SB attn_compute<GI>(b1, QA, QB, o, mrun, lrun, s + 1, blk, r, lane); ATT_SB }
        ATT_LOOP(1, 12, 18, qf.b0, qf.b1)
        ATT_LOOP(2, 18, 22, qf.c0, qf.c1)
#undef ATT_LOOP
        attn_compute<2>(b0, qf.c0, qf.c1, o, mrun, lrun, 22, blk, r, lane);
        float l = lrun; l += __shfl_xor(l, 16); l += __shfl_xor(l, 32);
        float inv = 1.0f / l;
#ifdef DBG_ATT1
        for (int dt = 0; dt < 4; ++dt) o[dt] = (f32x4){1.f, 1.f, 1.f, 1.f};
#endif
#pragma unroll
        for (int dt = 0; dt < 4; ++dt) {
            const size_t off = (size_t)tq * 512 + h * 64 + 16 * dt + 4 * quad;
            const u32x2 z = *(const u32x2*)(ZA + off);
            u32x2 w; w.x = cvt_pk_bf16(o[dt][0] * inv * bf_lo(z.x), o[dt][1] * inv * bf_hi(z.x)); w.y = cvt_pk_bf16(o[dt][2] * inv * bf_lo(z.y), o[dt][3] * inv * bf_hi(z.y));
            *(u32x2*)(GAO + off) = w;
        }
    }
}

__device__ __forceinline__ f32x2 cmul(f32x2 a, f32x2 b) { return (f32x2){a.x * b.x - a.y * b.y, a.x * b.y + a.y * b.x}; }
__device__ __forceinline__ void step_scan(const Args& a, LAS unsigned char* lds, int pass, int tid, int bx) {
    unsigned char* ws = a.ws; const int G = gridDim.x;
    const float* PW = (const float*)(ws + WS_PW); const float* S = (const float*)(ws + WS_S); bf16_t* UH = (bf16_t*)(ws + WS_UH);
    LAS f32x2* carry = (LAS f32x2*)lds;
    for (int it = bx; it < SEQP * 32 * 2; it += G) {
        const int dir = it & 1, g = (it >> 1) & 31, sq = it >> 6; const int seg = tid >> 6, n = tid & 63;
        const f32x2 P = (f32x2){PW[((dir * 32 + g) * 64 + n) * 2], PW[((dir * 32 + g) * 64 + n) * 2 + 1]};
        f32x2 z[32];
        { const int c0 = dir ? (NCH - 1 - seg * 32) : seg * 32; const long stp = dir ? -256 : 256;
          const float* sp = S + ((size_t)g * CHP + sq * NCH + c0) * 256 + dir * 128 + n;
#pragma unroll
          for (int i = 0; i < 32; ++i) { z[i] = (f32x2){sp[0], sp[64]}; sp += stp; } }
        f32x2 zz = (f32x2){0.f, 0.f};
#pragma unroll
        for (int i = 0; i < 32; ++i) { const f32x2 t = z[i]; z[i] = zz; zz = cmul(P, zz) + t; }
        __syncthreads();
        carry[seg * 64 + n] = zz;
        __syncthreads();
        f32x2 P32 = P;
#pragma unroll
        for (int k = 0; k < 5; ++k) P32 = cmul(P32, P32);
        f32x2 x = (f32x2){0.f, 0.f};
        for (int sp = 0; sp < seg; ++sp) x = cmul(P32, x) + carry[sp * 64 + n];
        f32x2 pwr = (f32x2){1.f, 0.f};
        { const int c0 = dir ? (NCH - 1 - seg * 32) : seg * 32; const long stp = dir ? -(long)UHK : (long)UHK;
          bf16_t* up = UH + ((size_t)g * CHP + sq * NCH + c0) * UHK + 512 + dir * 128 + n;
#pragma unroll
          for (int i = 0; i < 32; ++i) {
              const f32x2 hin = z[i] + cmul(pwr, x);
              up[0] = (bf16_t)(cvt_pk_bf16(hin.x, 0.f) & 0xffffu); up[64] = (bf16_t)(cvt_pk_bf16(hin.y, 0.f) & 0xffffu);
              pwr = cmul(pwr, P); up += stp;
          } }
    }
}

__device__ __forceinline__ void step_final_norm(const Args& a, int pass, int tid, int bx) {
    const int lane = tid & 63, wave = tid >> 6, G = gridDim.x;
    const f32x4* gr = (const f32x4*)a.in[16] + lane;
    f32x4 gv[4];
#pragma unroll
    for (int j = 0; j < 4; ++j) gv[j] = gr[64 * j];
    const bf16_t* accp = (const bf16_t*)(a.ws + WS_ACC);
    int row = bx * 8 + wave;
    f32x4 nx[4]; u32x2 na[4];
    if (row < TP) { const f32x4* xr = (const f32x4*)xrow_ptr(a.in[0], a.in[1], pass * TP + row) + lane; const u32x2* ar = (const u32x2*)(accp + (size_t)row * DM) + lane;
#pragma unroll
        for (int j = 0; j < 4; ++j) { nx[j] = xr[64 * j]; na[j] = ar[64 * j]; } }
    for (; row < TP; row += G * 8) {
        f32x4 v[4];
#pragma unroll
        for (int j = 0; j < 4; ++j) v[j] = nx[j] + (f32x4){bf_lo(na[j].x), bf_hi(na[j].x), bf_lo(na[j].y), bf_hi(na[j].y)};
        const int nrow = row + G * 8;
        if (nrow < TP) { const f32x4* xn = (const f32x4*)xrow_ptr(a.in[0], a.in[1], pass * TP + nrow) + lane; const u32x2* an = (const u32x2*)(accp + (size_t)nrow * DM) + lane;
#pragma unroll
            for (int j = 0; j < 4; ++j) { nx[j] = xn[64 * j]; na[j] = an[64 * j]; } }
        float s = 0.f;
#pragma unroll
        for (int j = 0; j < 4; ++j) s += (v[j].x * v[j].x + v[j].y * v[j].y) + (v[j].z * v[j].z + v[j].w * v[j].w);
        const float rstd = 1.0f / sqrtf(wave_sum(s) * (1.f / DM) + EPSN);
        f32x4* xr = (f32x4*)(a.out + (size_t)(pass * TP + row) * DM) + lane;
#pragma unroll
        for (int j = 0; j < 4; ++j) xr[64 * j] = v[j] * rstd * gv[j];
    }
}


#define XB_TMO      128
#define XB_XCNT(j)  (256  + 64 * (j))
#define XB_XSUB(j)  (1280 + 64 * (j))
#define XB_XGEN(j)  (2304 + 64 * (j))
#define XB_TOP      3328
#define XB_TOPGEN   3392
#define XCD_BAR_WORDS 3456
#define XB_SLOT(b)  (4096 + 2 * (b))
#define XB_SPIN_CAP (1u << 18)
__device__ __forceinline__ unsigned xb_ld(unsigned* p)              { return __hip_atomic_load(p, __ATOMIC_RELAXED, __HIP_MEMORY_SCOPE_AGENT); }
__device__ __forceinline__ unsigned xb_add(unsigned* p, unsigned v) { return __hip_atomic_fetch_add(p, v, __ATOMIC_RELAXED, __HIP_MEMORY_SCOPE_AGENT); }
__device__ __forceinline__ unsigned xb_xcc_id() { return (unsigned)__builtin_amdgcn_s_getreg((3 << 11) | 20) & 0xFu; }
#define XB_SPIN(cond, bar) do { unsigned _sp = 0; while (cond) { __builtin_amdgcn_s_sleep(1); \
    if ((++_sp & 255u) == 0u) { if (xb_ld(&(bar)[XB_TMO])) break; if (_sp > XB_SPIN_CAP) { atomicAdd(&(bar)[XB_TMO], 1u); break; } } } } while (0)
__device__ __forceinline__ void xcd_barrier_complete(unsigned* bar, unsigned x, unsigned& nloc, unsigned& nx) {
    const unsigned G = gridDim.x;
    unsigned sum, cnt, mine, sp = 0u;
    for (;;) {
        sum = 0u; cnt = 0u; mine = 0u;
#pragma unroll
        for (unsigned j = 0; j < 16; ++j) { const unsigned c = xb_ld(&bar[XB_XCNT(j)]); sum += c; cnt += (c > 0u) ? 1u : 0u; mine = (j == x) ? c : mine; }
        if (sum == G) break;
        __builtin_amdgcn_s_sleep(1);
        if ((++sp & 255u) == 0u) { if (xb_ld(&bar[XB_TMO])) break; if (sp > XB_SPIN_CAP) { atomicAdd(&bar[XB_TMO], 1u); break; } }
    }
    nloc = mine > 0u ? mine : 1u; nx = cnt > 0u ? cnt : 1u;
}
__device__ __forceinline__ void xcd_barrier(unsigned* bar) {
    asm volatile("s_waitcnt vmcnt(0)" ::: "memory");
    __syncthreads();
    if (threadIdx.x == 0) {
        __builtin_amdgcn_s_waitcnt(0);
        const unsigned x = xb_xcc_id();
        unsigned* slot = bar + XB_SLOT(blockIdx.x);
        unsigned nloc = xb_ld(slot), nx = xb_ld(slot + 1);
        if (nloc == 0u) { xcd_barrier_complete(bar, x, nloc, nx); __hip_atomic_store(slot, nloc, __ATOMIC_RELAXED, __HIP_MEMORY_SCOPE_AGENT); __hip_atomic_store(slot + 1, nx, __ATOMIC_RELAXED, __HIP_MEMORY_SCOPE_AGENT); }
        const unsigned old = xb_add(&bar[XB_XSUB(x)], 1u);
        const unsigned gen = old / nloc;
        if (old + 1u == (gen + 1u) * nloc) {
            __builtin_amdgcn_fence(__ATOMIC_RELEASE, "agent");
            asm volatile("s_waitcnt vmcnt(0)" ::: "memory");
            const unsigned og = xb_add(&bar[XB_TOP], 1u);
            const unsigned tg = og / nx;
            if (og + 1u == (tg + 1u) * nx) xb_add(&bar[XB_TOPGEN], 1u);
            else XB_SPIN(xb_ld(&bar[XB_TOPGEN]) == tg, bar);
            __builtin_amdgcn_fence(__ATOMIC_ACQUIRE, "agent");
            xb_add(&bar[XB_XGEN(x)], 1u);
            asm volatile("s_waitcnt vmcnt(0)" ::: "memory");
        } else {
            XB_SPIN(xb_ld(&bar[XB_XGEN(x)]) == gen, bar);
            __builtin_amdgcn_fence(__ATOMIC_ACQUIRE, "agent");
            asm volatile("s_waitcnt vmcnt(0)" ::: "memory");
        }
    }
    __syncthreads();
}

constexpr int NSTEPS = 1 + 10 * NPASS;
__host__ __device__ __forceinline__ bool sync_after(int st) { if (st == 0) return true; const int k = (st - 1) % 10; return !(k == 1 || k == 6 || k == 9); }

__global__ void __launch_bounds__(512, 2) fwd_kernel(Args a) {
    extern __shared__ __attribute__((aligned(16))) unsigned char lds_raw[];
    LAS unsigned char* lds = (LAS unsigned char*)lds_raw;
    cg::grid_group grid = cg::this_grid();
    const int G = gridDim.x;
    unsigned char* ws = a.ws;
    unsigned* bar = (unsigned*)(ws + WS_BAR);
    if (a.do_sync == 2) grid.sync();
    if (a.do_sync && threadIdx.x == 0) (void)xb_add(&bar[XB_XCNT(xb_xcc_id())], 1u);
    for (int st = a.st_lo; st < a.st_hi; ++st) {
        int tid = threadIdx.x, bx = blockIdx.x;
        asm volatile("" : "+v"(tid), "+s"(bx));
#ifndef NO_SETUP
        if (st == 0) { step_setup(a, lds, tid, bx); }
#else
        if (st == 0) {}
#endif
        else {
            const int pass = (st - 1) / 10, k = (st - 1) % 10;
            GemmD g; g.lgnN = 0; g.pass = pass; g.nb = 1; g.sA = 0; g.sB = 0;
            bool has_gemm = true;
            const bool split_ay = (G == 256);
            switch (k) {
            case 0: g.A = (const bf16_t*)((unsigned char*)a.out + OUT_HN_OFF) + (size_t)pass * TP * DM; g.lda = DM; g.Bt = (const bf16_t*)(ws + WS_WIN); g.ldb = DM; g.K = DM; g.nM = TP / BM; g.nN = INC / BM; g.lgnN = 5; g.mode = MODE_PROJ; break;
            case 1: g.A = (const bf16_t*)(ws + WS_UH); g.lda = UHK; g.sA = (unsigned)(CHP * UHK * 2); g.Bt = (const bf16_t*)(ws + WS_BST); g.ldb = 512; g.sB = (unsigned)(256 * 512 * 2); g.K = 512; g.nM = CHP / BM; g.nN = 1; g.nb = 32; g.mode = MODE_S; break;
            case 4:
                if (split_ay && bx < 128) { g.A = (const bf16_t*)(ws + WS_GAO); g.lda = 512; g.Bt = (const bf16_t*)(ws + WS_WA); g.ldb = 512; g.K = 512; g.nM = TP / BM; g.nN = 4; g.lgnN = 2; g.mode = MODE_A; }
                else { g.A = (const bf16_t*)(ws + WS_UH); g.lda = UHK; g.sA = (unsigned)(CHP * UHK * 2); g.Bt = (const bf16_t*)(ws + WS_MTC); g.ldb = UHK; g.sB = (unsigned)(512 * UHK * 2); g.K = UHK; g.nM = CHP / BM; g.nN = 2; g.nb = 32; g.mode = MODE_Y; }
                break;
            case 5: g.A = (const bf16_t*)(ws + WS_SG); g.lda = 512; g.Bt = (const bf16_t*)(ws + WS_WGLU); g.ldb = 512; g.K = 512; g.nM = TP / BM; g.nN = 2; g.lgnN = 1; g.mode = MODE_GLU; break;
            case 6: if (split_ay) { has_gemm = false; g.A = nullptr; g.Bt = nullptr; g.lda = g.ldb = g.K = 0; g.nM = g.nN = 0; g.mode = 0; } else { g.A = (const bf16_t*)(ws + WS_GAO); g.lda = 512; g.Bt = (const bf16_t*)(ws + WS_WA); g.ldb = 512; g.K = 512; g.nM = TP / BM; g.nN = 4; g.lgnN = 2; g.mode = MODE_A; } break;
            case 7: g.A = (const bf16_t*)(ws + WS_SB); g.lda = 512; g.Bt = (const bf16_t*)(ws + WS_WB); g.ldb = 512; g.K = 512; g.nM = TP / BM; g.nN = 4; g.lgnN = 2; g.mode = MODE_B; break;
            case 8: g.A = (const bf16_t*)(ws + WS_M1); g.lda = 1024; g.Bt = (const bf16_t*)(ws + WS_WOUT); g.ldb = 1024; g.K = 1024; g.nM = TP / BM; g.nN = 4; g.lgnN = 2; g.mode = MODE_OUT; break;
            default: has_gemm = false; g.A = nullptr; g.Bt = nullptr; g.lda = g.ldb = g.K = 0; g.nM = g.nN = 0; g.mode = 0; break;
            }
            { const int total = g.nM * g.nN * g.nb; g.u0 = bx; g.ustride = G; g.ucount = total > bx ? (total - bx + G - 1) / G : 0; }
            if (k == 4 && split_ay) { if (bx < 128) { g.u0 = bx; g.ustride = 128; g.ucount = 3; } else { g.u0 = bx - 128; g.ustride = 128; g.ucount = (bx - 128) < 64 ? 2 : 1; } }
            if (has_gemm) {
#ifndef NO_GEMM
                gemm_phase(a, lds, g, G, bx, tid);
#endif
            }
#ifndef NO_ATTN
            else if (k == 2) step_attention(a, lds, pass, tid, bx);
#endif
#ifndef NO_SCAN
            else if (k == 3) step_scan(a, lds, pass, tid, bx);
#endif
            else if (k == 9) step_final_norm(a, pass, tid, bx);
        }
        if (a.do_sync && st + 1 < a.st_hi && sync_after(st)) xcd_barrier(bar);
    }
}

extern "C" void kernel_launch(void* const* d_in, const int* in_sizes, int n_in, void* d_out, int out_size, void* d_ws, size_t ws_size, hipStream_t stream) {
    constexpr int LDS_BYTES = STAGE_BYTES + 32768;
    static int grid = 0;
    if (grid == 0) {
        if (n_in != 17 || out_size != TTOK * DM || ws_size < WS_END) { fprintf(stderr, "kernel_launch: unexpected shapes (n_in %d out %d ws %zu need %zu)\n", n_in, out_size, ws_size, (size_t)WS_END); grid = -1; return; }
        int dev = 0, cus = 0, per_cu = 0;
        hipGetDevice(&dev); hipDeviceGetAttribute(&cus, hipDeviceAttributeMultiprocessorCount, dev);
        hipFuncSetAttribute((const void*)fwd_kernel, hipFuncAttributeMaxDynamicSharedMemorySize, LDS_BYTES);
        hipOccupancyMaxActiveBlocksPerMultiprocessor(&per_cu, (const void*)fwd_kernel, 512, LDS_BYTES);
        if (per_cu < 1) per_cu = 1;
        grid = cus * 1;
        (void)hipGetLastError();
    }
    if (grid < 0) return;
    (void)hipMemsetAsync((unsigned char*)d_ws + WS_BAR, 0, WS_BAR_BYTES + 4096, stream);
    Args a{};
    for (int i = 0; i < 17; ++i) a.in[i] = (const float*)d_in[i];
    a.out = (float*)d_out; a.ws = (unsigned char*)d_ws; a.pad = 0;
#ifndef MULTI_LAUNCH
#define MULTI_LAUNCH 0
#endif
#if MULTI_LAUNCH
    a.do_sync = 0;
    for (int st = 0; st < NSTEPS; ++st) {
        a.st_lo = st; a.st_hi = st + 1;
        hipLaunchKernelGGL(fwd_kernel, dim3(grid), dim3(512), LDS_BYTES, stream, a);
    }
#else
    a.do_sync = 1; a.st_lo = 0; a.st_hi = NSTEPS;
    void* args[] = {&a};
    hipError_t e = hipLaunchCooperativeKernel((const void*)fwd_kernel, dim3(grid), dim3(512), args, LDS_BYTES, stream);
    if (e != hipSuccess) fprintf(stderr, "cooperative launch failed: %s (grid %d)\n", hipGetErrorString(e), grid);
#endif
}
```

```cpp
#include <hip/hip_runtime.h>
#include <hip/hip_cooperative_groups.h>
#include <cstdio>

namespace cg = cooperative_groups;

#define LAS __attribute__((address_space(3)))
typedef unsigned short bf16_t;
typedef short bf16x8 __attribute__((ext_vector_type(8)));
typedef short bf16x4 __attribute__((ext_vector_type(4)));
typedef float f32x4 __attribute__((ext_vector_type(4)));
typedef float f32x2 __attribute__((ext_vector_type(2)));
typedef unsigned u32x4 __attribute__((ext_vector_type(4)));
typedef unsigned u32x2 __attribute__((ext_vector_type(2)));

constexpr int DM = 1024, SEQL = 8192, NSEQ = 6, TTOK = NSEQ * SEQL;
constexpr int NPASS = 2, SEQP = 3, TP = SEQP * SEQL;
constexpr int INC = 8192, QKVW = 1536;
constexpr int LC = 32, NCH = SEQL / LC  , CHP = SEQP * NCH  ;
constexpr int UHK = LC * 16 + 256;
constexpr float EPSN = 1e-6f;
constexpr float QSCALE = 0.18033688011112042f;

constexpr size_t AL(size_t x) { return (x + 255) & ~(size_t)255; }
constexpr size_t WS_WIN = 4096;
constexpr size_t WS_WGLU = WS_WIN + (size_t)INC * DM * 2;
constexpr size_t WS_WA = WS_WGLU + (size_t)512 * 512 * 2;
constexpr size_t WS_WB = WS_WA + (size_t)1024 * 512 * 2;
constexpr size_t WS_WOUT = WS_WB + (size_t)1024 * 512 * 2;
constexpr size_t WS_MTC = WS_WOUT + (size_t)1024 * 1024 * 2;
constexpr size_t WS_BST = WS_MTC + (size_t)32 * 512 * UHK * 2;
constexpr size_t WS_ROPE = WS_BST + (size_t)32 * 256 * 512 * 2;
constexpr size_t WS_PW = WS_ROPE + (size_t)2 * SEQL * 32 * 4;
constexpr size_t WS_KT = WS_PW + (size_t)2 * 32 * 64 * 8;
constexpr size_t WS_Q = WS_KT + (size_t)32 * 2 * 32 * 256 * 4;
constexpr size_t WS_K = WS_Q + (size_t)TP * QKVW * 2;
constexpr size_t WS_VT = WS_K + (size_t)TP * QKVW * 2;
constexpr size_t WS_ZA = WS_VT + (size_t)TP * QKVW * 2;
constexpr size_t WS_ZB = WS_ZA + (size_t)TP * 512 * 2;
constexpr size_t WS_GA = WS_ZB + (size_t)TP * 512 * 2;
constexpr size_t WS_GB = WS_GA + (size_t)TP * 1024 * 2;
constexpr size_t WS_UH = WS_GB + (size_t)TP * 1024 * 2;
constexpr size_t WS_S = WS_UH + (size_t)32 * CHP * UHK * 2;
constexpr size_t WS_GAO = WS_S + (size_t)32 * CHP * 256 * 4;
constexpr size_t WS_BAR = WS_GAO + (size_t)TP * 512 * 2;
constexpr size_t WS_BAR_BYTES = 32768;
constexpr size_t WS_CTL = WS_BAR + WS_BAR_BYTES;
constexpr size_t WS_END = WS_CTL + 4096;
constexpr size_t WS_SG = WS_Q;
constexpr size_t WS_SB = WS_Q + (size_t)TP * 512 * 2;
constexpr size_t WS_M1 = WS_K;
constexpr size_t WS_ACC = WS_Q;
constexpr size_t OUT_HN_OFF = (size_t)SEQP * SEQL * DM * 4;

struct Args {
    const float* in[17];
    float* out;
    unsigned char* ws;
    int st_lo, st_hi;
    int do_sync, pad;
};

typedef __bf16 bf16v2 __attribute__((ext_vector_type(2)));
__device__ __forceinline__ unsigned cvt_pk_bf16(float lo, float hi) { const f32x2 v = (f32x2){lo, hi}; const bf16v2 r = __builtin_convertvector(v, bf16v2); return __builtin_bit_cast(unsigned, r); }
__device__ __forceinline__ float bf_lo(unsigned w) { return __uint_as_float(w << 16); }
__device__ __forceinline__ float bf_hi(unsigned w) { return __uint_as_float(w & 0xffff0000u); }
__device__ __forceinline__ float fast_rcp(float x) { return __builtin_amdgcn_rcpf(x); }
__device__ __forceinline__ float sigmoidf_(float x) { return fast_rcp(1.0f + __builtin_amdgcn_exp2f(-1.4426950408889634f * x)); }
__device__ __forceinline__ float siluf_(float x) { return x * sigmoidf_(x); }
__device__ __forceinline__ float gelu_tanh(float x) { const float u = x * (1.5957691216057308f + 0.07135481627260025f * x * x); return x * sigmoidf_(u); }
__device__ __forceinline__ float wave_sum(float v) {
#pragma unroll
    for (int o = 1; o < 64; o <<= 1) v += __shfl_xor(v, o);
    return v;
}
__device__ __forceinline__ const float* xrow_ptr(const float* xp, const float* xs, int tg) {
    return tg < 4 * SEQL ? xp + (size_t)tg * DM : xs + (size_t)(tg - 4 * SEQL) * DM;
}

constexpr int BM = 256, BK = 64, HALF = 128, HTB = HALF * BK * 2, STAGE_BYTES = 8 * HTB, NXCD = 8, WGM = 8;
__host__ __device__ __forceinline__ int lds_byte(int r, int c) { const int st = (r >> 4) * 2 + (c >> 5), rr = r & 15, cc = c & 31, ob = rr * 64 + cc * 2; return st * 1024 + (ob ^ (((ob >> 9) & 1) << 5)); }
__host__ __device__ __forceinline__ void stage_rc(int b, int& R, int& C) { const int st = b / 1024, sb = b % 1024, swz = sb ^ (((sb >> 9) & 1) << 5); R = (st >> 1) * 16 + swz / 64; C = (st & 1) * 32 + (swz % 64) / 2; }
__host__ __device__ __forceinline__ int perm32(int rho) { const int n = rho >> 4, i = rho & 15; return 8 * (i >> 2) + 4 * n + (i & 3); }

enum { MODE_PROJ = 0, MODE_S = 1, MODE_Y = 2, MODE_GLU = 3, MODE_A = 4, MODE_B = 5, MODE_OUT = 6 };
struct Unit { int pm, pn, bz; };
struct GemmD {
    const bf16_t* A; const bf16_t* Bt;
    int lda, ldb, K, nM, nN, nb;
    unsigned sA, sB;
    int mode, pass, lgnN;
    int u0, ustride, ucount;
};
__device__ __forceinline__ bool unit_next(const GemmD& g, int i, int G, int c, int& pm, int& pn, int& bz) {
    const bool ok = i < g.ucount;
    const int Li = ok ? g.u0 + i * g.ustride : 0;
    if (g.nb == 1) {
        const int lg = g.lgnN, q = (g.nM << lg) >> 3;
        const int wgid = (Li & 7) * q + (Li >> 3);
        const int gid = wgid >> (3 + lg), rem = wgid & ((8 << lg) - 1);
        pm = gid * 8 + (rem & 7); pn = rem >> 3; bz = 0;
    } else {
        const int nwg = g.nM * g.nN;
        const int w = Li % nwg; bz = Li / nwg; pm = w % g.nM; pn = w / g.nM;
    }
    return ok;
}

__device__ __forceinline__ void epilogue(const Args& a, LAS unsigned char* lds, const GemmD& g, const f32x4 (&acc)[2][2][4][2], const Unit& u, int wr, int wc, int fr, int fq) {
    asm volatile("" : "+v"(fr), "+v"(fq));
    unsigned char* ws = a.ws;
    const int rbase = u.pm * BM + wr * 64 + fr;
    const int cl = wc * 32 + fq * 8;
    if (g.mode == MODE_PROJ) {
        const int pn = u.pn;
        if (pn < 12) {
            const bool isq = pn < 6;
            bf16_t* dst = (bf16_t*)(ws + (isq ? WS_Q : WS_K));
            const float* rc = (const float*)(ws + WS_ROPE); const float* rs = rc + SEQL * 32;
            const int a4 = 4 * (4 * (wc & 1) + fq);
            const int pq = isq ? pn : pn - 6, gi = pq >> 1, sh = 2 * gi, dmask = (1 << sh) - 1, Lg = SEQL >> sh;
            const float sc = isq ? QSCALE : 1.0f;
#pragma unroll
            for (int ai = 0; ai < 2; ++ai) {
                asm volatile("" ::: "memory");
                f32x4 cvv[4], svv[4];
#pragma unroll
                for (int m = 0; m < 4; ++m) { const int pos = (rbase + ai * HALF + m * 16) & (SEQL - 1); cvv[m] = *(const f32x4*)(rc + pos * 32 + a4); svv[m] = *(const f32x4*)(rs + pos * 32 + a4); }
#pragma unroll
                for (int m = 0; m < 4; ++m) {
                    const int tl = rbase + ai * HALF + m * 16; const int pos = tl & (SEQL - 1), sq = tl >> 13;
                    const int kidx = (pos & dmask) * Lg + (pos >> sh);
                    const f32x4 cv = cvv[m] * sc, sv = svv[m] * sc;
#pragma unroll
                    for (int bj = 0; bj < 2; ++bj) {
                        const f32x4 x1 = acc[ai][bj][m][0], x2 = acc[ai][bj][m][1];
                        const f32x4 o1 = x1 * cv - x2 * sv, o2 = x2 * cv + x1 * sv;
                        const int head = pq * 4 + 2 * bj + (wc >> 1);
                        const int ch = 4 * (wc & 1) + fq;
                        bf16_t* p = dst + (size_t)(sq * 24 + head) * SEQL * 64 + (isq ? (size_t)kidx * 64 + ch * 8 : (size_t)(kidx >> 4) * 1024 + ch * 128 + (kidx & 15) * 8);
                        u32x4 w; w.x = cvt_pk_bf16(o1[0], o1[1]); w.y = cvt_pk_bf16(o1[2], o1[3]); w.z = cvt_pk_bf16(o2[0], o2[1]); w.w = cvt_pk_bf16(o2[2], o2[3]);
                        *(u32x4*)p = w;
                    }
                }
            }
        } else if (pn < 18) {
            bf16_t* dst = (bf16_t*)(ws + WS_VT);
            const int gi = (pn - 12) >> 1, sh = 2 * gi;
            const int wid = wr * 4 + wc, lane = fq * 16 + fr;
            LAS bf16_t* tile = (LAS bf16_t*)(lds + STAGE_BYTES + wid * 4096);
#pragma unroll
            for (int ai = 0; ai < 2; ++ai) {
                const int tl0 = u.pm * BM + wr * 64 + ai * HALF;
                const int pos0 = tl0 & (SEQL - 1), sq = tl0 >> 13;
#pragma unroll
                for (int bj = 0; bj < 2; ++bj) {
                    asm volatile("" ::: "memory");
                    const int h = (4 * (pn - 12) + 2 * bj + (wc >> 1)) & 7;
#pragma unroll
                    for (int m = 0; m < 4; ++m) {
                        const int t = 16 * m + fr;
                        const int slot = gi == 0 ? t : (gi == 1 ? ((t & 3) * 16 + (t >> 2)) : ((t & 15) * 4 + (t >> 4)));
#pragma unroll
                        for (int n = 0; n < 2; ++n)
#pragma unroll
                            for (int j = 0; j < 4; ++j) { const unsigned w = cvt_pk_bf16(acc[ai][bj][m][n][j], 0.f); tile[(8 * fq + 4 * n + j) * 64 + slot] = (bf16_t)(w & 0xffffu); }
                    }
                    bf16_t* hb0 = dst + (size_t)(((sq * 3 + gi) * 8 + h) * 512) * 1024;
#pragma unroll
                    for (int i = 0; i < 4; ++i) {
                        const int c = lane + 64 * i, d = c >> 3, s8 = (c & 7) * 8;
                        const u32x4 v = *(const LAS u32x4*)(tile + d * 64 + s8);
                        const int dg = 32 * (wc & 1) + d; const int doff = (dg >> 4) * 256 + (dg & 15) * 4;
                        if (gi == 0) { const int kidx = pos0 + s8; bf16_t* q = hb0 + (size_t)(kidx >> 4) * 1024 + doff + ((kidx & 15) >> 2) * 64; *(u32x2*)q = (u32x2){v.x, v.y}; *(u32x2*)(q + 64) = (u32x2){v.z, v.w}; }
                        else if (gi == 1) { const int kidx = (s8 >> 4) * 2048 + (pos0 >> 2) + (s8 & 15); bf16_t* q = hb0 + (size_t)(kidx >> 4) * 1024 + doff + ((kidx & 15) >> 2) * 64; *(u32x2*)q = (u32x2){v.x, v.y}; *(u32x2*)(q + 64) = (u32x2){v.z, v.w}; }
                        else { const int ka = (s8 >> 2) * 512 + (pos0 >> 4), kb = ka + 512;
                            *(u32x2*)(hb0 + (size_t)(ka >> 4) * 1024 + doff + ((ka & 15) >> 2) * 64) = (u32x2){v.x, v.y}; *(u32x2*)(hb0 + (size_t)(kb >> 4) * 1024 + doff + ((kb & 15) >> 2) * 64) = (u32x2){v.z, v.w}; }
                    }
                }
            }
        } else if (pn == 20 || pn == 21) {
            bf16_t* dst = (bf16_t*)(ws + WS_UH);
#pragma unroll
            for (int ai = 0; ai < 2; ++ai)
#pragma unroll
                for (int m = 0; m < 4; ++m) { asm volatile("" ::: "memory");
                    const int tl = rbase + ai * HALF + m * 16;
#pragma unroll
                    for (int bj = 0; bj < 2; ++bj) {
                        const int gg = 16 * (pn - 20) + 8 * bj + 2 * wc + (fq >> 1);
                        bf16_t* p = dst + ((size_t)(gg * CHP + (tl >> 5)) * UHK) + (tl & 31) * 16 + 8 * (fq & 1);
                        const f32x4 v0 = acc[ai][bj][m][0], v1 = acc[ai][bj][m][1];
                        u32x4 w; w.x = cvt_pk_bf16(v0[0], v0[1]); w.y = cvt_pk_bf16(v0[2], v0[3]); w.z = cvt_pk_bf16(v1[0], v1[1]); w.w = cvt_pk_bf16(v1[2], v1[3]);
                        *(u32x4*)p = w;
                    }
                }
        } else {
            bf16_t* dst; int ld, c0; bool silu;
            if (pn < 20) { dst = (bf16_t*)(ws + WS_ZA); ld = 512; c0 = (pn - 18) * 256; silu = true; }
            else if (pn < 24) { dst = (bf16_t*)(ws + WS_ZB); ld = 512; c0 = (pn - 22) * 256; silu = true; }
            else if (pn < 28) { dst = (bf16_t*)(ws + WS_GA); ld = 1024; c0 = (pn - 24) * 256; silu = false; }
            else { dst = (bf16_t*)(ws + WS_GB); ld = 1024; c0 = (pn - 28) * 256; silu = false; }
#pragma unroll
            for (int ai = 0; ai < 2; ++ai)
#pragma unroll
                for (int m = 0; m < 4; ++m) { asm volatile("" ::: "memory");
                    const int tl = rbase + ai * HALF + m * 16;
#pragma unroll
                    for (int bj = 0; bj < 2; ++bj) {
                        f32x4 v0 = acc[ai][bj][m][0], v1 = acc[ai][bj][m][1];
#pragma unroll
                        for (int j = 0; j < 4; ++j) { const float s0 = sigmoidf_(v0[j]), s1 = sigmoidf_(v1[j]); v0[j] = silu ? v0[j] * s0 : s0; v1[j] = silu ? v1[j] * s1 : s1; }
                        u32x4 w; w.x = cvt_pk_bf16(v0[0], v0[1]); w.y = cvt_pk_bf16(v0[2], v0[3]); w.z = cvt_pk_bf16(v1[0], v1[1]); w.w = cvt_pk_bf16(v1[2], v1[3]);
                        *(u32x4*)(dst + (size_t)tl * ld + c0 + cl + bj * HALF) = w;
                    }
                }
        }
    } else if (g.mode == MODE_S) {
        float* dst = (float*)(ws + WS_S) + (size_t)u.bz * CHP * 256;
#pragma unroll
        for (int ai = 0; ai < 2; ++ai)
#pragma unroll
            for (int m = 0; m < 4; ++m) { asm volatile("" ::: "memory");
                const int r = rbase + ai * HALF + m * 16;
#pragma unroll
                for (int bj = 0; bj < 2; ++bj) { float* p = dst + (size_t)r * 256 + cl + bj * HALF; *(f32x4*)p = acc[ai][bj][m][0]; *(f32x4*)(p + 4) = acc[ai][bj][m][1]; }
            }
    } else if (g.mode == MODE_Y) {
        bf16_t* dst = (bf16_t*)(ws + WS_SG);
#pragma unroll
        for (int ai = 0; ai < 2; ++ai)
#pragma unroll
            for (int m = 0; m < 4; ++m) { asm volatile("" ::: "memory");
                const int r = rbase + ai * HALF + m * 16;
#pragma unroll
                for (int bj = 0; bj < 2; ++bj) {
                    const int t = 16 * u.pn + 8 * bj + 2 * wc + (fq >> 1);
                    f32x4 v0 = acc[ai][bj][m][0], v1 = acc[ai][bj][m][1];
#pragma unroll
                    for (int j = 0; j < 4; ++j) { v0[j] = gelu_tanh(v0[j]); v1[j] = gelu_tanh(v1[j]); }
                    u32x4 w; w.x = cvt_pk_bf16(v0[0], v0[1]); w.y = cvt_pk_bf16(v0[2], v0[3]); w.z = cvt_pk_bf16(v1[0], v1[1]); w.w = cvt_pk_bf16(v1[2], v1[3]);
                    *(u32x4*)(dst + (size_t)(r * LC + t) * 512 + u.bz * 16 + 8 * (fq & 1)) = w;
                }
            }
    } else if (g.mode == MODE_GLU) {
        const bf16_t* sg = (const bf16_t*)(ws + WS_SG); const bf16_t* zb = (const bf16_t*)(ws + WS_ZB); bf16_t* dst = (bf16_t*)(ws + WS_SB);
#pragma unroll
        for (int ai = 0; ai < 2; ++ai) {
            asm volatile("" ::: "memory");
            u32x4 sv4[4][2], zv4[4][2];
#pragma unroll
            for (int m = 0; m < 4; ++m)
#pragma unroll
                for (int bj = 0; bj < 2; ++bj) { const size_t off = (size_t)(rbase + ai * HALF + m * 16) * 512 + u.pn * BM + cl + bj * HALF; sv4[m][bj] = *(const u32x4*)(sg + off); zv4[m][bj] = *(const u32x4*)(zb + off); }
#pragma unroll
            for (int m = 0; m < 4; ++m)
#pragma unroll
                for (int bj = 0; bj < 2; ++bj) {
                    const size_t off = (size_t)(rbase + ai * HALF + m * 16) * 512 + u.pn * BM + cl + bj * HALF;
                    const u32x4 s4 = sv4[m][bj], z4 = zv4[m][bj];
                    const f32x4 v0 = acc[ai][bj][m][0], v1 = acc[ai][bj][m][1];
                    u32x4 w;
                    w.x = cvt_pk_bf16(bf_lo(s4.x) * sigmoidf_(v0[0]) * bf_lo(z4.x), bf_hi(s4.x) * sigmoidf_(v0[1]) * bf_hi(z4.x));
                    w.y = cvt_pk_bf16(bf_lo(s4.y) * sigmoidf_(v0[2]) * bf_lo(z4.y), bf_hi(s4.y) * sigmoidf_(v0[3]) * bf_hi(z4.y));
                    w.z = cvt_pk_bf16(bf_lo(s4.z) * sigmoidf_(v1[0]) * bf_lo(z4.z), bf_hi(s4.z) * sigmoidf_(v1[1]) * bf_hi(z4.z));
                    w.w = cvt_pk_bf16(bf_lo(s4.w) * sigmoidf_(v1[2]) * bf_lo(z4.w), bf_hi(s4.w) * sigmoidf_(v1[3]) * bf_hi(z4.w));
                    *(u32x4*)(dst + off) = w;
                }
        }
    } else if (g.mode == MODE_A || g.mode == MODE_B) {
        const bool isb = g.mode == MODE_B;
        const bf16_t* gt = (const bf16_t*)(ws + (isb ? WS_GB : WS_GA)); bf16_t* dst = (bf16_t*)(ws + WS_M1);
#pragma unroll
        for (int ai = 0; ai < 2; ++ai) {
            asm volatile("" ::: "memory");
            u32x4 gv4[4][2], pv4[4][2];
#pragma unroll
            for (int m = 0; m < 4; ++m)
#pragma unroll
                for (int bj = 0; bj < 2; ++bj) { const size_t off = (size_t)(rbase + ai * HALF + m * 16) * 1024 + u.pn * BM + cl + bj * HALF; gv4[m][bj] = *(const u32x4*)(gt + off); pv4[m][bj] = (u32x4){0u, 0u, 0u, 0u}; if (isb) pv4[m][bj] = *(const u32x4*)(dst + off); }
#pragma unroll
            for (int m = 0; m < 4; ++m)
#pragma unroll
                for (int bj = 0; bj < 2; ++bj) {
                    const size_t off = (size_t)(rbase + ai * HALF + m * 16) * 1024 + u.pn * BM + cl + bj * HALF;
                    const u32x4 g4 = gv4[m][bj], p4 = pv4[m][bj];
                    const f32x4 v0 = acc[ai][bj][m][0], v1 = acc[ai][bj][m][1];
                    u32x4 w;
                    w.x = cvt_pk_bf16(bf_lo(p4.x) + bf_lo(g4.x) * v0[0], bf_hi(p4.x) + bf_hi(g4.x) * v0[1]);
                    w.y = cvt_pk_bf16(bf_lo(p4.y) + bf_lo(g4.y) * v0[2], bf_hi(p4.y) + bf_hi(g4.y) * v0[3]);
                    w.z = cvt_pk_bf16(bf_lo(p4.z) + bf_lo(g4.z) * v1[0], bf_hi(p4.z) + bf_hi(g4.z) * v1[1]);
                    w.w = cvt_pk_bf16(bf_lo(p4.w) + bf_lo(g4.w) * v1[2], bf_hi(p4.w) + bf_hi(g4.w) * v1[3]);
                    *(u32x4*)(dst + off) = w;
                }
        }
    } else {
        bf16_t* dst = (bf16_t*)(ws + WS_ACC);
#pragma unroll
        for (int ai = 0; ai < 2; ++ai)
#pragma unroll
            for (int m = 0; m < 4; ++m) {
                const int tl = rbase + ai * HALF + m * 16;
#pragma unroll
                for (int bj = 0; bj < 2; ++bj) {
                    const f32x4 v0 = acc[ai][bj][m][0], v1 = acc[ai][bj][m][1];
                    u32x4 w; w.x = cvt_pk_bf16(v0[0], v0[1]); w.y = cvt_pk_bf16(v0[2], v0[3]); w.z = cvt_pk_bf16(v1[0], v1[1]); w.w = cvt_pk_bf16(v1[2], v1[3]);
                    *(u32x4*)(dst + (size_t)tl * DM + u.pn * BM + cl + bj * HALF) = w;
                }
            }
    }
}

__device__ __forceinline__ void gemm_phase(const Args& a, LAS unsigned char* lds, const GemmD& g, int G, int cidx, int tid) {
    const int wid = __builtin_amdgcn_readfirstlane(tid >> 6), lane = tid & 63, wr = wid >> 2, wc = wid & 3, fr = lane & 15, fq = lane >> 4;
    const int K = g.K, nt = K / BK;
    unsigned voffA[2], voffB[2];
#pragma unroll
    for (int i = 0; i < 2; ++i) { int R, C; stage_rc(tid * 16 + i * 8192, R, C); const int Rb = (R & ~31) + perm32(R & 31);
        voffA[i] = (unsigned)(R * g.lda + C) * 2u; voffB[i] = (unsigned)(Rb * g.ldb + C) * 2u; }
    const size_t kstep = (size_t)(BK * 2);
    const size_t hstepA = (size_t)HALF * g.lda * 2, hstepB = (size_t)HALF * g.ldb * 2;
    const size_t tstepA = 2 * hstepA, tstepB = 2 * hstepB;
    const unsigned ldsw = (unsigned)wid * 1024u;
    const int aoff = lds_byte(wr * 64 + fr, fq * 8), boff = lds_byte(wc * 32 + fr, fq * 8);
#define PG8_SA(b, h) (((b) * 2 + (h)) * HTB)
#define PG8_SB(b, h) ((4 + (b) * 2 + (h)) * HTB)
#define PG8_STAGE(bufoff, gbase, voff) do { _Pragma("unroll") for (int _i = 0; _i < 2; ++_i) \
        __builtin_amdgcn_global_load_lds((const unsigned*)((const char*)(gbase) + (voff)[_i]), (LAS unsigned*)(lds + (bufoff) + ldsw + _i * 8192), 16, 0, 0); } while (0)
#define PG8_LDA(dst, b, h) do { _Pragma("unroll") for (int m = 0; m < 4; ++m) _Pragma("unroll") for (int k = 0; k < 2; ++k) dst[m][k] = *(const LAS bf16x8*)(lds + PG8_SA(b, h) + aoff + m * 2048 + k * 1024); } while (0)
#define PG8_LDB(dst, b, h) do { _Pragma("unroll") for (int n = 0; n < 2; ++n) _Pragma("unroll") for (int k = 0; k < 2; ++k) dst[n][k] = *(const LAS bf16x8*)(lds + PG8_SB(b, h) + boff + n * 2048 + k * 1024); } while (0)
#define PG8_MMA(ai, bj, At, Bt) do { __builtin_amdgcn_s_setprio(1); _Pragma("unroll") for (int m = 0; m < 4; ++m) _Pragma("unroll") for (int n = 0; n < 2; ++n) _Pragma("unroll") for (int k = 0; k < 2; ++k) \
        acc[ai][bj][m][n] = __builtin_amdgcn_mfma_f32_16x16x32_bf16(Bt[n][k], At[m][k], acc[ai][bj][m][n], 0, 0, 0); __builtin_amdgcn_s_setprio(0); } while (0)
#define PG8_WAIT_V(n) asm volatile("s_waitcnt vmcnt(" #n ")" ::: "memory")
#define PG8_WAIT_L(n) asm volatile("s_waitcnt lgkmcnt(" #n ")" ::: "memory")
#define PG8_BAR __builtin_amdgcn_s_barrier()
#define PG8_SCHED __builtin_amdgcn_sched_barrier(0)
    Unit cur, nxt; int ui = 0;
    { int pm_, pn_, bz_; if (!unit_next(g, 0, G, cidx, pm_, pn_, bz_)) return; cur.pm = pm_; cur.pn = pn_; cur.bz = bz_; }
    f32x4 acc[2][2][4][2];
#pragma unroll
    for (int a = 0; a < 2; ++a)
#pragma unroll
        for (int b = 0; b < 2; ++b)
#pragma unroll
            for (int m = 0; m < 4; ++m)
#pragma unroll
                for (int n = 0; n < 2; ++n) acc[a][b][m][n] = (f32x4){0.f, 0.f, 0.f, 0.f};
    bf16x8 At[4][2], B0[2][2], B1[2][2];
    const char* cA = (const char*)g.A + (size_t)cur.bz * g.sA + (size_t)cur.pm * tstepA; const char* cB = (const char*)g.Bt + (size_t)cur.bz * g.sB + (size_t)cur.pn * tstepB;
    PG8_STAGE(PG8_SB(0, 0), cB, voffB); PG8_STAGE(PG8_SA(0, 0), cA, voffA); PG8_STAGE(PG8_SB(0, 1), cB + hstepB, voffB); PG8_STAGE(PG8_SA(0, 1), cA + hstepA, voffA);
    if (wr == 1) PG8_BAR;
    PG8_WAIT_V(4); PG8_BAR;
    PG8_STAGE(PG8_SB(1, 0), cB + kstep, voffB); PG8_STAGE(PG8_SA(1, 0), cA + kstep, voffA); PG8_STAGE(PG8_SB(1, 1), cB + hstepB + kstep, voffB);
    PG8_WAIT_V(6); PG8_BAR;
    for (;;) {
        int npm, npn, nbz; const bool has_next = unit_next(g, ui + 1, G, cidx, npm, npn, nbz); nxt.pm = npm; nxt.pn = npn; nxt.bz = nbz;
        const char* nA = has_next ? (const char*)g.A + (size_t)nxt.bz * g.sA + (size_t)nxt.pm * tstepA : cA; const char* nB = has_next ? (const char*)g.Bt + (size_t)nxt.bz * g.sB + (size_t)nxt.pn * tstepB : cB;
        for (int t = 0; t < nt; t += 2) {
            const bool last = (t == nt - 2);
            const char* a1 = cA + (size_t)(t + 1) * kstep;
            const char* a2 = last ? nA : cA + (size_t)(t + 2) * kstep; const char* b2 = last ? nB : cB + (size_t)(t + 2) * kstep;
            const char* a3 = a2 + kstep; const char* b3 = b2 + kstep;
            PG8_LDB(B0, 0, 0); PG8_SCHED; PG8_LDA(At, 0, 0); PG8_STAGE(PG8_SA(1, 1), a1 + hstepA, voffA);
            PG8_WAIT_L(8); PG8_BAR; PG8_WAIT_L(0); PG8_MMA(0, 0, At, B0); PG8_BAR; PG8_SCHED;
            PG8_LDB(B1, 0, 1); PG8_STAGE(PG8_SB(0, 0), b2, voffB);
            PG8_BAR; PG8_WAIT_L(0); PG8_MMA(0, 1, At, B1); PG8_BAR;
            PG8_LDA(At, 0, 1); PG8_STAGE(PG8_SA(0, 0), a2, voffA);
            PG8_BAR; PG8_WAIT_L(0); PG8_MMA(1, 0, At, B0); PG8_BAR; PG8_SCHED;
            PG8_STAGE(PG8_SB(0, 1), b2 + hstepB, voffB);
            PG8_WAIT_V(6); PG8_BAR; PG8_MMA(1, 1, At, B1); PG8_BAR;
            PG8_LDB(B0, 1, 0); PG8_SCHED; PG8_LDA(At, 1, 0); PG8_STAGE(PG8_SA(0, 1), a2 + hstepA, voffA);
            PG8_WAIT_L(8); PG8_BAR; PG8_WAIT_L(0); PG8_MMA(0, 0, At, B0); PG8_BAR; PG8_SCHED;
            PG8_LDB(B1, 1, 1); PG8_STAGE(PG8_SB(1, 0), b3, voffB);
            PG8_BAR; PG8_WAIT_L(0); PG8_MMA(0, 1, At, B1); PG8_BAR;
            PG8_LDA(At, 1, 1); PG8_STAGE(PG8_SA(1, 0), a3, voffA);
            PG8_BAR; PG8_WAIT_L(0); PG8_MMA(1, 0, At, B0); PG8_BAR; PG8_SCHED;
            PG8_STAGE(PG8_SB(1, 1), b3 + hstepB, voffB);
            PG8_WAIT_V(6); PG8_BAR; PG8_MMA(1, 1, At, B1); PG8_BAR;
        }
#ifndef NO_EPI
        epilogue(a, lds, g, acc, cur, wr, wc, fr, fq);
#else
        if (g.mode == 99) *(f32x4*)(g.out) = acc[0][0][0][0] + acc[1][1][3][1] + acc[0][1][2][0]+acc[1][0][1][1];
#endif
        if (!has_next) break;
#pragma unroll
        for (int a = 0; a < 2; ++a)
#pragma unroll
            for (int b = 0; b < 2; ++b)
#pragma unroll
                for (int m = 0; m < 4; ++m)
#pragma unroll
                    for (int n = 0; n < 2; ++n) acc[a][b][m][n] = (f32x4){0.f, 0.f, 0.f, 0.f};
        cur = nxt; cA = nA; cB = nB; ++ui;
    }
    PG8_WAIT_V(0);
    if (wr == 0) PG8_BAR;
    PG8_BAR;
#undef PG8_SA
#undef PG8_SB
#undef PG8_STAGE
#undef PG8_LDA
#undef PG8_LDB
#undef PG8_MMA
#undef PG8_WAIT_V
#undef PG8_WAIT_L
#undef PG8_BAR
#undef PG8_SCHED
}

__device__ __forceinline__ int qk_perm_row(int n) { const int i = n & 63; return (n & ~63) + 8 * ((i & 31) >> 2) + (i & 3) + 4 * (i >> 5); }
__device__ __forceinline__ void transpose_item(const float* W, int K, int N, bf16_t* WT, bool permqk, LAS float* scr, int item, int lane) {
    const int nblk = N / 32, kb = item / nblk, nb = item % nblk, k0 = 64 * kb, n0 = 32 * nb;
#pragma unroll 8
    for (int i = 0; i < 32; ++i) { const int kk = 2 * i + (lane >> 5); scr[kk * 33 + (lane & 31)] = W[(size_t)(k0 + kk) * N + n0 + (lane & 31)]; }
    asm volatile("s_waitcnt lgkmcnt(0)" ::: "memory");
    const int c = lane & 7;
#pragma unroll
    for (int j = 0; j < 4; ++j) { const int n = (lane >> 3) + 8 * j; const LAS float* s = scr + (8 * c) * 33 + n;
        u32x4 o; o.x = cvt_pk_bf16(s[0 * 33], s[1 * 33]); o.y = cvt_pk_bf16(s[2 * 33], s[3 * 33]); o.z = cvt_pk_bf16(s[4 * 33], s[5 * 33]); o.w = cvt_pk_bf16(s[6 * 33], s[7 * 33]);
        int row = n0 + n; if (permqk && row < 2 * QKVW) row = qk_perm_row(row);
        *(u32x4*)(WT + (size_t)row * K + k0 + 8 * c) = o; }
    asm volatile("s_waitcnt lgkmcnt(0)" ::: "memory");
}
__device__ __forceinline__ void reduce_angle(double a, float& c, float& s) {
    const double k = __builtin_rint(a * 0.6366197723675814); const float x = (float)(a - k * 1.5707963267948966), x2 = x * x;
    const float sn = x * (1.0f + x2 * (-1.6666666667e-1f + x2 * (8.3333333333e-3f + x2 * (-1.9841269841e-4f + x2 * 2.7557319224e-6f))));
    const float cs = 1.0f + x2 * (-0.5f + x2 * (4.1666666667e-2f + x2 * (-1.3888888889e-3f + x2 * (2.4801587302e-5f + x2 * -2.7557319224e-7f))));
    const int q = ((int)k) & 3;
    c = (q == 0) ? cs : (q == 1) ? -sn : (q == 2) ? -cs : sn;
    s = (q == 0) ? sn : (q == 1) ? cs : (q == 2) ? -sn : -cs;
}
__device__ __forceinline__ void rms_row_to_bf16(const float* xrow, const float* gw, bf16_t* orow, int lane) {
    const f32x4* xr = (const f32x4*)xrow + lane; const f32x4* gr = (const f32x4*)gw + lane;
    f32x4 v[4]; float s = 0.f;
#pragma unroll
    for (int j = 0; j < 4; ++j) { v[j] = xr[64 * j]; s += (v[j].x * v[j].x + v[j].y * v[j].y) + (v[j].z * v[j].z + v[j].w * v[j].w); }
    const float rstd = 1.0f / sqrtf(wave_sum(s) * (1.f / DM) + EPSN);
    u32x2* o8 = (u32x2*)orow + lane;
#pragma unroll
    for (int j = 0; j < 4; ++j) { const f32x4 gv = gr[64 * j]; u32x2 w; w.x = cvt_pk_bf16(v[j].x * rstd * gv.x, v[j].y * rstd * gv.y); w.y = cvt_pk_bf16(v[j].z * rstd * gv.z, v[j].w * rstd * gv.w); o8[64 * j] = w; }
}

__device__ __forceinline__ void ssm_load_bc(const Args& a, int g, int dir, LAS f32x2* Bb, LAS f32x2* Cc, int tid) {
    const float* lam_re = a.in[4]; const float* lam_im = a.in[5]; const float* log_step = a.in[6];
    const float* b_re = a.in[7]; const float* b_im = a.in[8]; const float* c_re = a.in[9]; const float* c_im = a.in[10];
    const float dt = expf(log_step[dir * 32 + g]);
    for (int idx = tid; idx < 1024; idx += 512) {
        { const int n = idx >> 4; const float lr = lam_re[(dir * 32 + g) * 64 + n], li = lam_im[(dir * 32 + g) * 64 + n];
          const float ar = lr * dt; float cb, sb, ch, sh; reduce_angle((double)li * (double)dt, cb, sb); reduce_angle(0.5 * (double)li * (double)dt, ch, sh);
          const float em1 = expm1f(ar), ea = em1 + 1.0f;
          const float nr = em1 * cb - 2.0f * sh * sh, ni = ea * sb;
          const float den = 1.0f / (lr * lr + li * li); const float cr = (nr * lr + ni * li) * den, ci = (ni * lr - nr * li) * den;
          const float br = b_re[(size_t)((dir * 32 + g) * 64) * 16 + idx], bi = b_im[(size_t)((dir * 32 + g) * 64) * 16 + idx];
          Bb[idx] = (f32x2){cr * br - ci * bi, cr * bi + ci * br}; }
        { Cc[idx] = (f32x2){c_re[(size_t)((dir * 32 + g) * 16) * 64 + idx], c_im[(size_t)((dir * 32 + g) * 16) * 64 + idx]}; }
    }
}
__device__ __forceinline__ void ssm_setup_item(const Args& a, LAS unsigned char* lds, int item, int tid) {
    const int g = item >> 1, dir = item & 1;
    LAS f32x2* pw = (LAS f32x2*)lds; LAS f32x2* Bb = pw + 33 * 64; LAS f32x2* Cc = Bb + 1024;
    LAS float* KT = (LAS float*)(Cc + 1024); LAS float* K0 = KT + 32 * 256; LAS f32x2* Bb0 = (LAS f32x2*)(K0 + 256); LAS f32x2* Cc0 = Bb0 + 1024;
    const float* lam_re = a.in[4]; const float* lam_im = a.in[5]; const float* log_step = a.in[6];
    unsigned char* ws = a.ws;
    const float dt = expf(log_step[dir * 32 + g]);
    __syncthreads();
    for (int idx = tid; idx < 33 * 64; idx += 512) {
        const int tau = idx >> 6, n = idx & 63; const float lr = lam_re[(dir * 32 + g) * 64 + n], li = lam_im[(dir * 32 + g) * 64 + n];
        const float mag = expf(lr * dt * (float)tau); float c, s; reduce_angle((double)li * (double)dt * (double)tau, c, s);
        pw[idx] = (f32x2){mag * c, mag * s};
    }
    ssm_load_bc(a, g, dir, Bb, Cc, tid);
    if (dir == 1) ssm_load_bc(a, g, 0, Bb0, Cc0, tid);
    __syncthreads();
    if (tid < 64) { float* PW = (float*)(ws + WS_PW); const f32x2 p = pw[32 * 64 + tid]; PW[((dir * 32 + g) * 64 + tid) * 2] = p.x; PW[((dir * 32 + g) * 64 + tid) * 2 + 1] = p.y; }
    for (int o = tid; o < 32 * 256; o += 512) {
        const int tau = o >> 8, co = (o >> 4) & 15, ci = o & 15; float acc = 0.f;
_Pragma("unroll 4")
        for (int n = 0; n < 64; ++n) { const f32x2 c = Cc[co * 64 + n], p = pw[tau * 64 + n], b = Bb[n * 16 + ci]; const float tr = c.x * p.x - c.y * p.y, ti = c.x * p.y + c.y * p.x; acc += tr * b.x - ti * b.y; }
        KT[o] = acc; }
    if (dir == 1 && tid < 256) { const int co = tid >> 4, ci = tid & 15; float acc = 0.f;
_Pragma("unroll 4")
        for (int n = 0; n < 64; ++n) { const f32x2 c = Cc0[co * 64 + n], b = Bb0[n * 16 + ci]; acc += c.x * b.x - c.y * b.y; }
        K0[tid] = acc; }
    { bf16_t* BsT = (bf16_t*)(ws + WS_BST) + (size_t)g * 256 * 512;
      for (int ch = tid; ch < 128 * 64; ch += 512) {
          const int row = ch >> 6, part = row >> 6, n = row & 63, kc = ch & 63, s = kc >> 1, ci0 = (kc & 1) * 8; const int e = dir ? s : 31 - s; const f32x2 p = pw[e * 64 + n];
          float v[8];
#pragma unroll
          for (int j = 0; j < 8; ++j) { const f32x2 b = Bb[n * 16 + ci0 + j]; v[j] = part ? (p.x * b.y + p.y * b.x) : (p.x * b.x - p.y * b.y); }
          u32x4 w; w.x = cvt_pk_bf16(v[0], v[1]); w.y = cvt_pk_bf16(v[2], v[3]); w.z = cvt_pk_bf16(v[4], v[5]); w.w = cvt_pk_bf16(v[6], v[7]);
          *(u32x4*)(BsT + (size_t)(dir * 128 + row) * 512 + s * 16 + ci0) = w; } }
    bf16_t* MtC = (bf16_t*)(ws + WS_MTC) + (size_t)g * 512 * UHK;
    { for (int ch = tid; ch < 512 * 16; ch += 512) {
          const int row = ch >> 4, t = row >> 4, co = row & 15, cc = ch & 15, part = cc >> 3, n0 = (cc & 7) * 8; const int e = dir ? 32 - t : t + 1;
          float v[8];
#pragma unroll
          for (int j = 0; j < 8; ++j) { const f32x2 c = Cc[co * 64 + n0 + j], p = pw[e * 64 + n0 + j]; v[j] = part ? -(c.x * p.y + c.y * p.x) : (c.x * p.x - c.y * p.y); }
          u32x4 w; w.x = cvt_pk_bf16(v[0], v[1]); w.y = cvt_pk_bf16(v[2], v[3]); w.z = cvt_pk_bf16(v[4], v[5]); w.w = cvt_pk_bf16(v[6], v[7]);
          *(u32x4*)(MtC + (size_t)row * UHK + 512 + dir * 128 + part * 64 + n0) = w; } }
    __syncthreads();
    { const float* dsk = a.in[11];
      for (int ch = tid; ch < 512 * 64; ch += 512) {
          const int kc = ch & 63, row = ch >> 6; const int s = kc >> 1, ci0 = (kc & 1) * 8, t = row >> 4, co = row & 15;
          if (dir == 0 ? (t > s) : (s >= t)) {
              const int tau = dir == 0 ? t - s : s - t;
              float v[8];
#pragma unroll
              for (int j = 0; j < 8; ++j) v[j] = KT[tau * 256 + co * 16 + ci0 + j];
              if (t == s) { const float dv = dsk[g * 16 + co];
#pragma unroll
                  for (int j = 0; j < 8; ++j) v[j] += K0[co * 16 + ci0 + j] + ((ci0 + j == co) ? dv : 0.f); }
              u32x4 w; w.x = cvt_pk_bf16(v[0], v[1]); w.y = cvt_pk_bf16(v[2], v[3]); w.z = cvt_pk_bf16(v[4], v[5]); w.w = cvt_pk_bf16(v[6], v[7]);
              *(u32x4*)(MtC + (size_t)row * UHK + s * 16 + ci0) = w;
          }
      } }
    __syncthreads();
}

__device__ __forceinline__ void step_setup(const Args& a, LAS unsigned char* lds, int tid, int bx) {
    const int lane = tid & 63, wave = tid >> 6, G = gridDim.x;
    unsigned char* ws = a.ws;
    for (int it = bx; it < 64; it += G) ssm_setup_item(a, lds, it, tid);
    { float* rc = (float*)(ws + WS_ROPE); float* rs = rc + SEQL * 32;
      for (int idx = bx * 512 + tid; idx < SEQL * 32; idx += G * 512) {
          const int pos = idx >> 5, i = idx & 31; double inv = 1.0; for (int k = 0; k < i; ++k) inv *= 0.7498942093324558;
          float c, s; reduce_angle((double)pos * inv, c, s); rc[idx] = c; rs[idx] = s; } }
    { LAS float* scr = (LAS float*)(lds) + wave * (64 * 33);
      const int gw = bx * 8 + wave, NGW = G * 8;
      constexpr int I_IN = (DM / 64) * (INC / 32), I_GLU = (512 / 64) * (512 / 32), I_AB = (512 / 64) * (1024 / 32), I_OUT = (1024 / 64) * (1024 / 32);
      constexpr int NIT = I_IN + I_GLU + 2 * I_AB + I_OUT;
      for (int it = gw; it < NIT; it += NGW) {
          int r = it;
          if (r < I_IN) { transpose_item(a.in[3], DM, INC, (bf16_t*)(ws + WS_WIN), true, scr, r, lane); continue; } r -= I_IN;
          if (r < I_GLU) { transpose_item(a.in[12], 512, 512, (bf16_t*)(ws + WS_WGLU), false, scr, r, lane); continue; } r -= I_GLU;
          if (r < I_AB) { transpose_item(a.in[13], 512, 1024, (bf16_t*)(ws + WS_WA), false, scr, r, lane); continue; } r -= I_AB;
          if (r < I_AB) { transpose_item(a.in[14], 512, 1024, (bf16_t*)(ws + WS_WB), false, scr, r, lane); continue; } r -= I_AB;
          transpose_item(a.in[15], 1024, 1024, (bf16_t*)(ws + WS_WOUT), false, scr, r, lane);
      } }
    { bf16_t* hn = (bf16_t*)((unsigned char*)a.out + OUT_HN_OFF);
      const f32x4* gr = (const f32x4*)a.in[2] + lane;
      f32x4 gv[4];
#pragma unroll
      for (int j = 0; j < 4; ++j) gv[j] = gr[64 * j];
      unsigned* rctr = (unsigned*)(ws + WS_CTL) + 4;
      constexpr int RCH = 16;
      for (;;) {
          unsigned cidx = 0; if (lane == 0) cidx = atomicAdd(rctr, 1u);
          cidx = (unsigned)__builtin_amdgcn_readfirstlane((int)cidx);
          if (cidx >= (unsigned)(TTOK / RCH)) break;
          int row = (int)cidx * RCH; const int rend = row + RCH;
          f32x4 nx[4];
          { const f32x4* xr = (const f32x4*)xrow_ptr(a.in[0], a.in[1], row) + lane;
#pragma unroll
            for (int j = 0; j < 4; ++j) nx[j] = xr[64 * j]; }
          for (; row < rend; ++row) {
              f32x4 v[4];
#pragma unroll
              for (int j = 0; j < 4; ++j) v[j] = nx[j];
              if (row + 1 < rend) { const f32x4* xn = (const f32x4*)xrow_ptr(a.in[0], a.in[1], row + 1) + lane;
#pragma unroll
                  for (int j = 0; j < 4; ++j) nx[j] = xn[64 * j]; }
              float s = 0.f;
#pragma unroll
              for (int j = 0; j < 4; ++j) s += (v[j].x * v[j].x + v[j].y * v[j].y) + (v[j].z * v[j].z + v[j].w * v[j].w);
              const float rstd = 1.0f / sqrtf(wave_sum(s) * (1.f / DM) + EPSN);
              u32x2* o8 = (u32x2*)(hn + (size_t)row * DM) + lane;
#pragma unroll
              for (int j = 0; j < 4; ++j) { u32x2 w; w.x = cvt_pk_bf16(v[j].x * rstd * gv[j].x, v[j].y * rstd * gv[j].y); w.y = cvt_pk_bf16(v[j].z * rstd * gv[j].z, v[j].w * rstd * gv[j].w); o8[64 * j] = w; }
          }
      } }
}

__device__ __forceinline__ float quad_max(float x) {
    const auto r = __builtin_amdgcn_permlane32_swap(__float_as_uint(x), __float_as_uint(x), false, false);
    x = fmaxf(__uint_as_float(r[0]), __uint_as_float(r[1]));
    const auto q = __builtin_amdgcn_permlane16_swap(__float_as_uint(x), __float_as_uint(x), false, false);
    return fmaxf(__uint_as_float(q[0]), __uint_as_float(q[1]));
}
__device__ __forceinline__ float quad_sum(float x) {
    const auto r = __builtin_amdgcn_permlane32_swap(__float_as_uint(x), __float_as_uint(x), false, false);
    x = __uint_as_float(r[0]) + __uint_as_float(r[1]);
    const auto q = __builtin_amdgcn_permlane16_swap(__float_as_uint(x), __float_as_uint(x), false, false);
    return __uint_as_float(q[0]) + __uint_as_float(q[1]);
}
struct KVBuf { bf16x8 kA0, kA1, kB0, kB1; bf16x4 vA[4], vB[4]; };
__device__ __forceinline__ void step_params(int s, int& gi, int& ls) { gi = s < 12 ? 0 : (s < 18 ? 1 : 2); ls = s < 12 ? s : (s < 18 ? s - 12 : s - 18); }
__device__ __forceinline__ void attn_load(KVBuf& b, const bf16_t* Kp, const bf16_t* Vt, int s, int sq, int h, int blk, int r, int lane) {
    int gi, ls; step_params(s, gi, ls);
    const int sh = 2 * gi, Lg = SEQL >> sh, rho = r & ((1 << sh) - 1);
    int uA = ((256 * blk) >> sh) - 64 + 32 * ls, uB = uA + 16;
    if (uA < 0 || uA >= Lg) uA = 0; if (uB < 0 || uB >= Lg) uB = 0;
    const int kl = lane & 15, quad = lane >> 4;
    const bf16_t* kh = Kp + (size_t)(sq * 24 + gi * 8 + h) * SEQL * 64 + quad * 128 + kl * 8;
    const bf16_t* ka = kh + (size_t)((rho * Lg + uA) >> 4) * 1024; const bf16_t* kb = kh + (size_t)((rho * Lg + uB) >> 4) * 1024;
    b.kA0 = *(const bf16x8*)ka; b.kA1 = *(const bf16x8*)(ka + 512); b.kB0 = *(const bf16x8*)kb; b.kB1 = *(const bf16x8*)(kb + 512);
    const bf16_t* vbase = Vt + (size_t)(((sq * 3 + gi) * 8 + h) * 512) * 1024 + quad * 64 + kl * 4;
    const bf16_t* va = vbase + (size_t)((rho * Lg + uA) >> 4) * 1024; const bf16_t* vb = vbase + (size_t)((rho * Lg + uB) >> 4) * 1024;
#pragma unroll
    for (int dt = 0; dt < 4; ++dt) { b.vA[dt] = *(const bf16x4*)(va + dt * 256); b.vB[dt] = *(const bf16x4*)(vb + dt * 256); }
}
struct QF { bf16x8 a0, a1, b0, b1, c0, c1; };
template <int gi>
__device__ __forceinline__ void attn_compute(const KVBuf& b, const bf16x8 q0, const bf16x8 q1, f32x4 (&o)[4], float& mrun, float& lrun, int s, int blk, int r, int lane) {
    const int ls = gi == 0 ? s : (gi == 1 ? s - 12 : s - 18);
    const int sh = 2 * gi, Lg = SEQL >> sh;
    const int uA = ((256 * blk) >> sh) - 64 + 32 * ls;
    const int qi = lane & 15, quad = lane >> 4;
    const int uq = (256 * blk + r + 16 * qi) >> sh;
    const int lo = max(0, uq - 64), hi = min(Lg - 1, uq + 64);
    f32x4 sA = (f32x4){0.f, 0.f, 0.f, 0.f}, sB = sA;
    sA = __builtin_amdgcn_mfma_f32_16x16x32_bf16(b.kA0, q0, sA, 0, 0, 0); sA = __builtin_amdgcn_mfma_f32_16x16x32_bf16(b.kA1, q1, sA, 0, 0, 0);
    sB = __builtin_amdgcn_mfma_f32_16x16x32_bf16(b.kB0, q0, sB, 0, 0, 0); sB = __builtin_amdgcn_mfma_f32_16x16x32_bf16(b.kB1, q1, sB, 0, 0, 0);
    const float NEGINF = -__builtin_inff();
    const unsigned span = (unsigned)(hi - lo);
    float mx = NEGINF;
#pragma unroll
    for (int j = 0; j < 4; ++j) {
        const int ua = uA + quad * 4 + j, ub = ua + 16;
        sA[j] = ((unsigned)(ua - lo) <= span) ? sA[j] : NEGINF; sB[j] = ((unsigned)(ub - lo) <= span) ? sB[j] : NEGINF;
        mx = fmaxf(mx, fmaxf(sA[j], sB[j]));
    }
    mx = quad_max(mx);
    const float mnew = fmaxf(mrun, mx), alpha = __builtin_amdgcn_exp2f(mrun - mnew);
    mrun = mnew;
    float ps = 0.f;
#pragma unroll
    for (int j = 0; j < 4; ++j) { sA[j] = __builtin_amdgcn_exp2f(sA[j] - mnew); sB[j] = __builtin_amdgcn_exp2f(sB[j] - mnew); ps += sA[j] + sB[j]; }
    lrun = lrun * alpha + ps;
    u32x4 pw; pw.x = cvt_pk_bf16(sA[0], sA[1]); pw.y = cvt_pk_bf16(sA[2], sA[3]); pw.z = cvt_pk_bf16(sB[0], sB[1]); pw.w = cvt_pk_bf16(sB[2], sB[3]);
    const bf16x8 pf = __builtin_bit_cast(bf16x8, pw);
#pragma unroll
    for (int dt = 0; dt < 4; ++dt) {
        o[dt] *= alpha;
        bf16x8 vf; vf[0] = b.vA[dt][0]; vf[1] = b.vA[dt][1]; vf[2] = b.vA[dt][2]; vf[3] = b.vA[dt][3]; vf[4] = b.vB[dt][0]; vf[5] = b.vB[dt][1]; vf[6] = b.vB[dt][2]; vf[7] = b.vB[dt][3];
#ifdef DBG_ATT2
        for (int e = 0; e < 8; ++e) o[dt][e & 3] += 1e-3f * __uint_as_float(((unsigned)(unsigned short)vf[e]) << 16);
#else
        o[dt] = __builtin_amdgcn_mfma_f32_16x16x32_bf16(vf, pf, o[dt], 0, 0, 0);
#endif
    }
}
template <int gi>
__device__ __forceinline__ void attn_compute2(const KVBuf& b, const KVBuf& c, const bf16x8 q0, const bf16x8 q1, f32x4 (&o)[4], float& mrun, float& lrun, int s, int blk, int r, int lane) {
    const int ls = gi == 0 ? s : (gi == 1 ? s - 12 : s - 18);
    const int sh = 2 * gi, Lg = SEQL >> sh;
    const int uA = ((256 * blk) >> sh) - 64 + 32 * ls;
    const int qi = lane & 15, quad = lane >> 4;
    const int uq = (256 * blk + r + 16 * qi) >> sh;
    const int lo = max(0, uq - 64), hi = min(Lg - 1, uq + 64);
    const f32x4 z4 = (f32x4){0.f, 0.f, 0.f, 0.f};
    f32x4 sA = __builtin_amdgcn_mfma_f32_16x16x32_bf16(b.kA0, q0, z4, 0, 0, 0), sB = __builtin_amdgcn_mfma_f32_16x16x32_bf16(b.kB0, q0, z4, 0, 0, 0);
    f32x4 sC = __builtin_amdgcn_mfma_f32_16x16x32_bf16(c.kA0, q0, z4, 0, 0, 0), sD = __builtin_amdgcn_mfma_f32_16x16x32_bf16(c.kB0, q0, z4, 0, 0, 0);
    sA = __builtin_amdgcn_mfma_f32_16x16x32_bf16(b.kA1, q1, sA, 0, 0, 0); sB = __builtin_amdgcn_mfma_f32_16x16x32_bf16(b.kB1, q1, sB, 0, 0, 0);
    sC = __builtin_amdgcn_mfma_f32_16x16x32_bf16(c.kA1, q1, sC, 0, 0, 0); sD = __builtin_amdgcn_mfma_f32_16x16x32_bf16(c.kB1, q1, sD, 0, 0, 0);
    const float NEGINF = -__builtin_inff();
    const unsigned span = (unsigned)(hi - lo);
    float mx = NEGINF;
#pragma unroll
    for (int j = 0; j < 4; ++j) {
        const int ua = uA + quad * 4 + j;
        sA[j] = ((unsigned)(ua - lo) <= span) ? sA[j] : NEGINF; sB[j] = ((unsigned)(ua + 16 - lo) <= span) ? sB[j] : NEGINF;
        sC[j] = ((unsigned)(ua + 32 - lo) <= span) ? sC[j] : NEGINF; sD[j] = ((unsigned)(ua + 48 - lo) <= span) ? sD[j] : NEGINF;
        mx = fmaxf(fmaxf(mx, fmaxf(sA[j], sB[j])), fmaxf(sC[j], sD[j]));
    }
    mx = quad_max(mx);
    const float mnew = fmaxf(mrun, mx), alpha = __builtin_amdgcn_exp2f(mrun - mnew);
    mrun = mnew;
    float ps = 0.f;
#pragma unroll
    for (int j = 0; j < 4; ++j) { sA[j] = __builtin_amdgcn_exp2f(sA[j] - mnew); sB[j] = __builtin_amdgcn_exp2f(sB[j] - mnew); sC[j] = __builtin_amdgcn_exp2f(sC[j] - mnew); sD[j] = __builtin_amdgcn_exp2f(sD[j] - mnew); ps += (sA[j] + sB[j]) + (sC[j] + sD[j]); }
    lrun = lrun * alpha + ps;
    u32x4 pw, pv; pw.x = cvt_pk_bf16(sA[0], sA[1]); pw.y = cvt_pk_bf16(sA[2], sA[3]); pw.z = cvt_pk_bf16(sB[0], sB[1]); pw.w = cvt_pk_bf16(sB[2], sB[3]);
    pv.x = cvt_pk_bf16(sC[0], sC[1]); pv.y = cvt_pk_bf16(sC[2], sC[3]); pv.z = cvt_pk_bf16(sD[0], sD[1]); pv.w = cvt_pk_bf16(sD[2], sD[3]);
    const bf16x8 pf = __builtin_bit_cast(bf16x8, pw), pg = __builtin_bit_cast(bf16x8, pv);
#pragma unroll
    for (int dt = 0; dt < 4; ++dt) {
        o[dt] *= alpha;
        bf16x8 vf, vg;
        vf[0] = b.vA[dt][0]; vf[1] = b.vA[dt][1]; vf[2] = b.vA[dt][2]; vf[3] = b.vA[dt][3]; vf[4] = b.vB[dt][0]; vf[5] = b.vB[dt][1]; vf[6] = b.vB[dt][2]; vf[7] = b.vB[dt][3];
        vg[0] = c.vA[dt][0]; vg[1] = c.vA[dt][1]; vg[2] = c.vA[dt][2]; vg[3] = c.vA[dt][3]; vg[4] = c.vB[dt][0]; vg[5] = c.vB[dt][1]; vg[6] = c.vB[dt][2]; vg[7] = c.vB[dt][3];
        o[dt] = __builtin_amdgcn_mfma_f32_16x16x32_bf16(vf, pf, o[dt], 0, 0, 0);
        o[dt] = __builtin_amdgcn_mfma_f32_16x16x32_bf16(vg, pg, o[dt], 0, 0, 0);
    }
}
__device__ __forceinline__ void step_attention(const Args& a, LAS unsigned char* lds, int pass, int tid, int bx) {
    unsigned char* ws = a.ws;
    const int lane = tid & 63;
    const bf16_t* Qp = (const bf16_t*)(ws + WS_Q); const bf16_t* Kp = (const bf16_t*)(ws + WS_K); const bf16_t* Vt = (const bf16_t*)(ws + WS_VT);
    const bf16_t* ZA = (const bf16_t*)(ws + WS_ZA); bf16_t* GAO = (bf16_t*)(ws + WS_GAO);
    const int xcd = bx & 7;
    unsigned* ctr = (unsigned*)(ws + WS_CTL) + 16 + pass * 8 + xcd;
    LAS unsigned* slot = (LAS unsigned*)(lds + 3 * 16384);
    constexpr int NGRP = 3 * 32 * 2;
    for (;;) {
        __syncthreads();
        if (tid == 0) slot[0] = atomicAdd(ctr, 1u);
        __syncthreads();
        const unsigned grp = (unsigned)__builtin_amdgcn_readfirstlane((int)slot[0]);
        if (grp >= (unsigned)NGRP) break;
        const int wv_ = tid >> 6; const int r = ((wv_ & 3) << 2) + (wv_ >> 2) + 2 * (int)(grp & 1)  , blk = (grp >> 1) & 31, pair = xcd * 3 + (int)(grp >> 6);
        const int h = pair & 7, sq = pair >> 3;
        const int qi = lane & 15, quad = lane >> 4;
        const int tq = sq * SEQL + 256 * blk + r + 16 * qi;
        QF qf;
        { const int pos = 256 * blk + r + 16 * qi;
          const bf16_t* qa = Qp + ((size_t)(sq * 24 + h) * SEQL + pos) * 64 + quad * 8;
          const bf16_t* qb = Qp + ((size_t)(sq * 24 + 8 + h) * SEQL + (pos & 3) * 2048 + (pos >> 2)) * 64 + quad * 8;
          const bf16_t* qc = Qp + ((size_t)(sq * 24 + 16 + h) * SEQL + (pos & 15) * 512 + (pos >> 4)) * 64 + quad * 8;
          qf.a0 = *(const bf16x8*)qa; qf.a1 = *(const bf16x8*)(qa + 32); qf.b0 = *(const bf16x8*)qb; qf.b1 = *(const bf16x8*)(qb + 32); qf.c0 = *(const bf16x8*)qc; qf.c1 = *(const bf16x8*)(qc + 32); }
        f32x4 o[4];
#pragma unroll
        for (int dt = 0; dt < 4; ++dt) o[dt] = (f32x4){0.f, 0.f, 0.f, 0.f};
        float mrun = -1e30f, lrun = 0.f;
        KVBuf b0, b1;
#define ATT_SB __builtin_amdgcn_sched_barrier(0);
        {
            const int wv = tid >> 6, region = wv >> 1;
            const bf16_t* gsrc = (region < 2 ? Kp + (size_t)(sq * 24 + h) * SEQL * 64 : Vt + (size_t)((sq * 3) * 8 + h) * 512 * 1024) + (wv & 1) * 512 + lane * 8;
            const int ubase = 256 * blk - 64 + (region & 1) * 16;
#define ATT_DMA(S) do { int uT = ubase + 32 * (S); if (uT < 0 || uT >= SEQL) uT = 0; \
                __builtin_amdgcn_global_load_lds((const unsigned*)(gsrc + (size_t)(uT >> 4) * 1024), (LAS unsigned*)(lds + (((S) >> 1) % 3) * 16384 + ((S) & 1) * 8192 + wv * 1024), 16, 0, 0); } while (0)
            ATT_DMA(0); ATT_DMA(1); ATT_DMA(2); ATT_DMA(3);
            const int kl = lane & 15;
            const unsigned foff = (unsigned)(quad * 256 + kl * 16), voff = (unsigned)(4096 + quad * 128 + kl * 8);
#pragma unroll 1
            for (int d = 0; d < 6; ++d) {
                if (d < 5) asm volatile("s_waitcnt vmcnt(2)" ::: "memory"); else asm volatile("s_waitcnt vmcnt(0)" ::: "memory");
                __syncthreads();
                if (d + 2 < 6) { ATT_DMA(2 * d + 4); ATT_DMA(2 * d + 5); }
                LAS unsigned char* kb = lds + (d % 3) * 16384;
                b0.kA0 = *(const LAS bf16x8*)(kb + foff); b0.kA1 = *(const LAS bf16x8*)(kb + foff + 1024); b0.kB0 = *(const LAS bf16x8*)(kb + 2048 + foff); b0.kB1 = *(const LAS bf16x8*)(kb + 2048 + foff + 1024);
                b1.kA0 = *(const LAS bf16x8*)(kb + 8192 + foff); b1.kA1 = *(const LAS bf16x8*)(kb + 8192 + foff + 1024); b1.kB0 = *(const LAS bf16x8*)(kb + 8192 + 2048 + foff); b1.kB1 = *(const LAS bf16x8*)(kb + 8192 + 2048 + foff + 1024);
#pragma unroll
                for (int dt = 0; dt < 4; ++dt) { b0.vA[dt] = *(const LAS bf16x4*)(kb + voff + dt * 512); b0.vB[dt] = *(const LAS bf16x4*)(kb + 2048 + voff + dt * 512);
                                                 b1.vA[dt] = *(const LAS bf16x4*)(kb + 8192 + voff + dt * 512); b1.vB[dt] = *(const LAS bf16x4*)(kb + 8192 + 2048 + voff + dt * 512); }
                attn_compute2<0>(b0, b1, qf.a0, qf.a1, o, mrun, lrun, 2 * d, blk, r, lane);
            }
#undef ATT_DMA
        }
        attn_load(b0, Kp, Vt, 12, sq, h, blk, r, lane);
#define ATT_LOOP(GI, S0, S1, QA, QB) _Pragma("unroll 1") for (int s = S0; s < S1; s += 2) { \
            ATT_SB attn_load(b1, Kp, Vt, s + 1, sq, h, blk, r, lane); ATT_SB attn_compute<GI>(b0, QA, QB, o, mrun, lrun, s, blk, r, lane); \
            ATT_SB attn_load(b0, Kp, Vt, s + 2, sq, h, blk, r, lane); ATT_SB attn_compute<GI>(b1, QA, QB, o, mrun, lrun, s + 1, blk, r, lane); ATT_SB }
        ATT_LOOP(1, 12, 18, qf.b0, qf.b1)
        ATT_LOOP(2, 18, 22, qf.c0, qf.c1)
#undef ATT_LOOP
        attn_compute<2>(b0, qf.c0, qf.c1, o, mrun, lrun, 22, blk, r, lane);
        const float l = quad_sum(lrun);
        float inv = 1.0f / l;
#ifdef DBG_ATT1
        for (int dt = 0; dt < 4; ++dt) o[dt] = (f32x4){1.f, 1.f, 1.f, 1.f};
#endif
#pragma unroll
        for (int dt = 0; dt < 4; ++dt) {
            const size_t off = (size_t)tq * 512 + h * 64 + 16 * dt + 4 * quad;
            const u32x2 z = *(const u32x2*)(ZA + off);
            u32x2 w; w.x = cvt_pk_bf16(o[dt][0] * inv * bf_lo(z.x), o[dt][1] * inv * bf_hi(z.x)); w.y = cvt_pk_bf16(o[dt][2] * inv * bf_lo(z.y), o[dt][3] * inv * bf_hi(z.y));
            *(u32x2*)(GAO + off) = w;
        }
    }
}

__device__ __forceinline__ f32x2 cmul(f32x2 a, f32x2 b) { return (f32x2){a.x * b.x - a.y * b.y, a.x * b.y + a.y * b.x}; }
__device__ __forceinline__ void step_scan(const Args& a, LAS unsigned char* lds, int pass, int tid, int bx) {
    unsigned char* ws = a.ws; const int G = gridDim.x;
    const float* PW = (const float*)(ws + WS_PW); const float* S = (const float*)(ws + WS_S); bf16_t* UH = (bf16_t*)(ws + WS_UH);
    LAS f32x2* carry = (LAS f32x2*)lds;
    for (int it = bx; it < SEQP * 32 * 2; it += G) {
        const int dir = it & 1, g = (it >> 1) & 31, sq = it >> 6; const int seg = tid >> 6, n = tid & 63;
        const f32x2 P = (f32x2){PW[((dir * 32 + g) * 64 + n) * 2], PW[((dir * 32 + g) * 64 + n) * 2 + 1]};
        f32x2 z[32];
        { const int c0 = dir ? (NCH - 1 - seg * 32) : seg * 32; const long stp = dir ? -256 : 256;
          const float* sp = S + ((size_t)g * CHP + sq * NCH + c0) * 256 + dir * 128 + n;
#pragma unroll
          for (int i = 0; i < 32; ++i) { z[i] = (f32x2){sp[0], sp[64]}; sp += stp; } }
        f32x2 zz = (f32x2){0.f, 0.f};
#pragma unroll
        for (int i = 0; i < 32; ++i) { const f32x2 t = z[i]; z[i] = zz; zz = cmul(P, zz) + t; }
        __syncthreads();
        carry[seg * 64 + n] = zz;
        __syncthreads();
        f32x2 P32 = P;
#pragma unroll
        for (int k = 0; k < 5; ++k) P32 = cmul(P32, P32);
        f32x2 x = (f32x2){0.f, 0.f};
        for (int sp = 0; sp < seg; ++sp) x = cmul(P32, x) + carry[sp * 64 + n];
        f32x2 pwr = (f32x2){1.f, 0.f};
        { const int c0 = dir ? (NCH - 1 - seg * 32) : seg * 32; const long stp = dir ? -(long)UHK : (long)UHK;
          bf16_t* up = UH + ((size_t)g * CHP + sq * NCH + c0) * UHK + 512 + dir * 128 + n;
#pragma unroll
          for (int i = 0; i < 32; ++i) {
              const f32x2 hin = z[i] + cmul(pwr, x);
              up[0] = (bf16_t)(cvt_pk_bf16(hin.x, 0.f) & 0xffffu); up[64] = (bf16_t)(cvt_pk_bf16(hin.y, 0.f) & 0xffffu);
              pwr = cmul(pwr, P); up += stp;
          } }
    }
}

__device__ __forceinline__ void step_final_norm(const Args& a, int pass, int tid, int bx) {
    const int lane = tid & 63, wave = tid >> 6, G = gridDim.x;
    const f32x4* gr = (const f32x4*)a.in[16] + lane;
    f32x4 gv[4];
#pragma unroll
    for (int j = 0; j < 4; ++j) gv[j] = gr[64 * j];
    const bf16_t* accp = (const bf16_t*)(a.ws + WS_ACC);
    int row = bx * 8 + wave;
    f32x4 nx[4]; u32x2 na[4];
    if (row < TP) { const f32x4* xr = (const f32x4*)xrow_ptr(a.in[0], a.in[1], pass * TP + row) + lane; const u32x2* ar = (const u32x2*)(accp + (size_t)row * DM) + lane;
#pragma unroll
        for (int j = 0; j < 4; ++j) { nx[j] = xr[64 * j]; na[j] = ar[64 * j]; } }
    for (; row < TP; row += G * 8) {
        f32x4 v[4];
#pragma unroll
        for (int j = 0; j < 4; ++j) v[j] = nx[j] + (f32x4){bf_lo(na[j].x), bf_hi(na[j].x), bf_lo(na[j].y), bf_hi(na[j].y)};
        const int nrow = row + G * 8;
        if (nrow < TP) { const f32x4* xn = (const f32x4*)xrow_ptr(a.in[0], a.in[1], pass * TP + nrow) + lane; const u32x2* an = (const u32x2*)(accp + (size_t)nrow * DM) + lane;
#pragma unroll
            for (int j = 0; j < 4; ++j) { nx[j] = xn[64 * j]; na[j] = an[64 * j]; } }
        float s = 0.f;
#pragma unroll
        for (int j = 0; j < 4; ++j) s += (v[j].x * v[j].x + v[j].y * v[j].y) + (v[j].z * v[j].z + v[j].w * v[j].w);
        const float rstd = 1.0f / sqrtf(wave_sum(s) * (1.f / DM) + EPSN);
        f32x4* xr = (f32x4*)(a.out + (size_t)(pass * TP + row) * DM) + lane;
#pragma unroll
        for (int j = 0; j < 4; ++j) xr[64 * j] = v[j] * rstd * gv[j];
    }
}


#define XB_TMO      128
#define XB_XCNT(j)  (256  + 64 * (j))
#define XB_XSUB(j)  (1280 + 64 * (j))
#define XB_XGEN(j)  (2304 + 64 * (j))
#define XB_TOP      3328
#define XB_TOPGEN   3392
#define XCD_BAR_WORDS 3456
#define XB_SLOT(b)  (4096 + 2 * (b))
#define XB_SPIN_CAP (1u << 18)
__device__ __forceinline__ unsigned xb_ld(unsigned* p)              { return __hip_atomic_load(p, __ATOMIC_RELAXED, __HIP_MEMORY_SCOPE_AGENT); }
__device__ __forceinline__ unsigned xb_add(unsigned* p, unsigned v) { return __hip_atomic_fetch_add(p, v, __ATOMIC_RELAXED, __HIP_MEMORY_SCOPE_AGENT); }
__device__ __forceinline__ unsigned xb_xcc_id() { return (unsigned)__builtin_amdgcn_s_getreg((3 << 11) | 20) & 0xFu; }
#define XB_SPIN(cond, bar) do { unsigned _sp = 0; while (cond) { __builtin_amdgcn_s_sleep(1); \
    if ((++_sp & 255u) == 0u) { if (xb_ld(&(bar)[XB_TMO])) break; if (_sp > XB_SPIN_CAP) { atomicAdd(&(bar)[XB_TMO], 1u); break; } } } } while (0)
__device__ __forceinline__ void xcd_barrier_complete(unsigned* bar, unsigned x, unsigned& nloc, unsigned& nx) {
    const unsigned G = gridDim.x;
    unsigned sum, cnt, mine, sp = 0u;
    for (;;) {
        sum = 0u; cnt = 0u; mine = 0u;
#pragma unroll
        for (unsigned j = 0; j < 16; ++j) { const unsigned c = xb_ld(&bar[XB_XCNT(j)]); sum += c; cnt += (c > 0u) ? 1u : 0u; mine = (j == x) ? c : mine; }
        if (sum == G) break;
        __builtin_amdgcn_s_sleep(1);
        if ((++sp & 255u) == 0u) { if (xb_ld(&bar[XB_TMO])) break; if (sp > XB_SPIN_CAP) { atomicAdd(&bar[XB_TMO], 1u); break; } }
    }
    nloc = mine > 0u ? mine : 1u; nx = cnt > 0u ? cnt : 1u;
}
__device__ __forceinline__ void xcd_barrier(unsigned* bar) {
    asm volatile("s_waitcnt vmcnt(0)" ::: "memory");
    __syncthreads();
    if (threadIdx.x == 0) {
        __builtin_amdgcn_s_waitcnt(0);
        const unsigned x = xb_xcc_id();
        unsigned* slot = bar + XB_SLOT(blockIdx.x);
        unsigned nloc = xb_ld(slot), nx = xb_ld(slot + 1);
        if (nloc == 0u) { xcd_barrier_complete(bar, x, nloc, nx); __hip_atomic_store(slot, nloc, __ATOMIC_RELAXED, __HIP_MEMORY_SCOPE_AGENT); __hip_atomic_store(slot + 1, nx, __ATOMIC_RELAXED, __HIP_MEMORY_SCOPE_AGENT); }
        const unsigned old = xb_add(&bar[XB_XSUB(x)], 1u);
        const unsigned gen = old / nloc;
        if (old + 1u == (gen + 1u) * nloc) {
            __builtin_amdgcn_fence(__ATOMIC_RELEASE, "agent");
            asm volatile("s_waitcnt vmcnt(0)" ::: "memory");
            const unsigned og = xb_add(&bar[XB_TOP], 1u);
            const unsigned tg = og / nx;
            if (og + 1u == (tg + 1u) * nx) xb_add(&bar[XB_TOPGEN], 1u);
            else XB_SPIN(xb_ld(&bar[XB_TOPGEN]) == tg, bar);
            __builtin_amdgcn_fence(__ATOMIC_ACQUIRE, "agent");
            xb_add(&bar[XB_XGEN(x)], 1u);
            asm volatile("s_waitcnt vmcnt(0)" ::: "memory");
        } else {
            XB_SPIN(xb_ld(&bar[XB_XGEN(x)]) == gen, bar);
            __builtin_amdgcn_fence(__ATOMIC_ACQUIRE, "agent");
            asm volatile("s_waitcnt vmcnt(0)" ::: "memory");
        }
    }
    __syncthreads();
}

constexpr int NSTEPS = 1 + 10 * NPASS;
__host__ __device__ __forceinline__ bool sync_after(int st) { if (st == 0) return true; const int k = (st - 1) % 10; return !(k == 1 || k == 6 || k == 9); }

__global__ void __launch_bounds__(512, 2) fwd_kernel(Args a) {
    extern __shared__ __attribute__((aligned(16))) unsigned char lds_raw[];
    LAS unsigned char* lds = (LAS unsigned char*)lds_raw;
    cg::grid_group grid = cg::this_grid();
    const int G = gridDim.x;
    unsigned char* ws = a.ws;
    unsigned* bar = (unsigned*)(ws + WS_BAR);
    if (a.do_sync == 2) grid.sync();
    if (a.do_sync && threadIdx.x == 0) (void)xb_add(&bar[XB_XCNT(xb_xcc_id())], 1u);
    for (int st = a.st_lo; st < a.st_hi; ++st) {
        int tid = threadIdx.x, bx = blockIdx.x;
        asm volatile("" : "+v"(tid), "+s"(bx));
#ifndef NO_SETUP
        if (st == 0) { step_setup(a, lds, tid, bx); }
#else
        if (st == 0) {}
#endif
        else {
            const int pass = (st - 1) / 10, k = (st - 1) % 10;
            GemmD g; g.lgnN = 0; g.pass = pass; g.nb = 1; g.sA = 0; g.sB = 0;
            bool has_gemm = true;
            const bool split_ay = (G == 256);
            switch (k) {
            case 0: g.A = (const bf16_t*)((unsigned char*)a.out + OUT_HN_OFF) + (size_t)pass * TP * DM; g.lda = DM; g.Bt = (const bf16_t*)(ws + WS_WIN); g.ldb = DM; g.K = DM; g.nM = TP / BM; g.nN = INC / BM; g.lgnN = 5; g.mode = MODE_PROJ; break;
            case 1: g.A = (const bf16_t*)(ws + WS_UH); g.lda = UHK; g.sA = (unsigned)(CHP * UHK * 2); g.Bt = (const bf16_t*)(ws + WS_BST); g.ldb = 512; g.sB = (unsigned)(256 * 512 * 2); g.K = 512; g.nM = CHP / BM; g.nN = 1; g.nb = 32; g.mode = MODE_S; break;
            case 4:
                if (split_ay && bx < 128) { g.A = (const bf16_t*)(ws + WS_GAO); g.lda = 512; g.Bt = (const bf16_t*)(ws + WS_WA); g.ldb = 512; g.K = 512; g.nM = TP / BM; g.nN = 4; g.lgnN = 2; g.mode = MODE_A; }
                else { g.A = (const bf16_t*)(ws + WS_UH); g.lda = UHK; g.sA = (unsigned)(CHP * UHK * 2); g.Bt = (const bf16_t*)(ws + WS_MTC); g.ldb = UHK; g.sB = (unsigned)(512 * UHK * 2); g.K = UHK; g.nM = CHP / BM; g.nN = 2; g.nb = 32; g.mode = MODE_Y; }
                break;
            case 5: g.A = (const bf16_t*)(ws + WS_SG); g.lda = 512; g.Bt = (const bf16_t*)(ws + WS_WGLU); g.ldb = 512; g.K = 512; g.nM = TP / BM; g.nN = 2; g.lgnN = 1; g.mode = MODE_GLU; break;
            case 6: if (split_ay) { has_gemm = false; g.A = nullptr; g.Bt = nullptr; g.lda = g.ldb = g.K = 0; g.nM = g.nN = 0; g.mode = 0; } else { g.A = (const bf16_t*)(ws + WS_GAO); g.lda = 512; g.Bt = (const bf16_t*)(ws + WS_WA); g.ldb = 512; g.K = 512; g.nM = TP / BM; g.nN = 4; g.lgnN = 2; g.mode = MODE_A; } break;
            case 7: g.A = (const bf16_t*)(ws + WS_SB); g.lda = 512; g.Bt = (const bf16_t*)(ws + WS_WB); g.ldb = 512; g.K = 512; g.nM = TP / BM; g.nN = 4; g.lgnN = 2; g.mode = MODE_B; break;
            case 8: g.A = (const bf16_t*)(ws + WS_M1); g.lda = 1024; g.Bt = (const bf16_t*)(ws + WS_WOUT); g.ldb = 1024; g.K = 1024; g.nM = TP / BM; g.nN = 4; g.lgnN = 2; g.mode = MODE_OUT; break;
            default: has_gemm = false; g.A = nullptr; g.Bt = nullptr; g.lda = g.ldb = g.K = 0; g.nM = g.nN = 0; g.mode = 0; break;
            }
            { const int total = g.nM * g.nN * g.nb; g.u0 = bx; g.ustride = G; g.ucount = total > bx ? (total - bx + G - 1) / G : 0; }
            if (k == 4 && split_ay) { if (bx < 128) { g.u0 = bx; g.ustride = 128; g.ucount = 3; } else { g.u0 = bx - 128; g.ustride = 128; g.ucount = (bx - 128) < 64 ? 2 : 1; } }
            if (has_gemm) {
#ifndef NO_GEMM
                gemm_phase(a, lds, g, G, bx, tid);
#endif
            }
#ifndef NO_ATTN
            else if (k == 2) step_attention(a, lds, pass, tid, bx);
#endif
#ifndef NO_SCAN
            else if (k == 3) step_scan(a, lds, pass, tid, bx);
#endif
            else if (k == 9) step_final_norm(a, pass, tid, bx);
        }
        if (a.do_sync && st + 1 < a.st_hi && sync_after(st)) xcd_barrier(bar);
    }
}

extern "C" void kernel_launch(void* const* d_in, const int* in_sizes, int n_in, void* d_out, int out_size, void* d_ws, size_t ws_size, hipStream_t stream) {
    constexpr int LDS_BYTES = STAGE_BYTES + 32768;
    static int grid = 0;
    if (grid == 0) {
        if (n_in != 17 || out_size != TTOK * DM || ws_size < WS_END) { fprintf(stderr, "kernel_launch: unexpected shapes (n_in %d out %d ws %zu need %zu)\n", n_in, out_size, ws_size, (size_t)WS_END); grid = -1; return; }
        int dev = 0, cus = 0, per_cu = 0;
        hipGetDevice(&dev); hipDeviceGetAttribute(&cus, hipDeviceAttributeMultiprocessorCount, dev);
        hipFuncSetAttribute((const void*)fwd_kernel, hipFuncAttributeMaxDynamicSharedMemorySize, LDS_BYTES);
        hipOccupancyMaxActiveBlocksPerMultiprocessor(&per_cu, (const void*)fwd_kernel, 512, LDS_BYTES);
        if (per_cu < 1) per_cu = 1;
        grid = cus * 1;
        (void)hipGetLastError();
    }
    if (grid < 0) return;
    (void)hipMemsetAsync((unsigned char*)d_ws + WS_BAR, 0, WS_BAR_BYTES + 4096, stream);
    Args a{};
    for (int i = 0; i < 17; ++i) a.in[i] = (const float*)d_in[i];
    a.out = (float*)d_out; a.ws = (unsigned char*)d_ws; a.pad = 0;
#ifndef MULTI_LAUNCH
#define MULTI_LAUNCH 0
#endif
#if MULTI_LAUNCH
    a.do_sync = 0;
    for (int st = 0; st < NSTEPS; ++st) {
        a.st_lo = st; a.st_hi = st + 1;
        hipLaunchKernelGGL(fwd_kernel, dim3(grid), dim3(512), LDS_BYTES, stream, a);
    }
#else
    a.do_sync = 1; a.st_lo = 0; a.st_hi = NSTEPS;
    void* args[] = {&a};
    hipError_t e = hipLaunchCooperativeKernel((const void*)fwd_kernel, dim3(grid), dim3(512), args, LDS_BYTES, stream);
    if (e != hipSuccess) fprintf(stderr, "cooperative launch failed: %s (grid %d)\n", hipGetErrorString(e), grid);
#endif
}
```

```cpp
#include <hip/hip_runtime.h>
#include <hip/hip_cooperative_groups.h>
#include <cstdio>

namespace cg = cooperative_groups;

#define LAS __attribute__((address_space(3)))
typedef unsigned short bf16_t;
typedef short bf16x8 __attribute__((ext_vector_type(8)));
typedef short bf16x4 __attribute__((ext_vector_type(4)));
typedef float f32x4 __attribute__((ext_vector_type(4)));
typedef float f32x2 __attribute__((ext_vector_type(2)));
typedef unsigned u32x4 __attribute__((ext_vector_type(4)));
typedef unsigned u32x2 __attribute__((ext_vector_type(2)));

constexpr int DM = 1024, SEQL = 8192, NSEQ = 6, TTOK = NSEQ * SEQL;
constexpr int NPASS = 2, SEQP = 3, TP = SEQP * SEQL;
constexpr int INC = 8192, QKVW = 1536;
constexpr int LC = 32, NCH = SEQL / LC  , CHP = SEQP * NCH  ;
constexpr int UHK = LC * 16 + 256;
constexpr float EPSN = 1e-6f;
constexpr float QSCALE = 0.18033688011112042f;

constexpr size_t AL(size_t x) { return (x + 255) & ~(size_t)255; }
constexpr size_t WS_WIN = 4096;
constexpr size_t WS_WGLU = WS_WIN + (size_t)INC * DM * 2;
constexpr size_t WS_WA = WS_WGLU + (size_t)512 * 512 * 2;
constexpr size_t WS_WB = WS_WA + (size_t)1024 * 512 * 2;
constexpr size_t WS_WOUT = WS_WB + (size_t)1024 * 512 * 2;
constexpr size_t WS_MTC = WS_WOUT + (size_t)1024 * 1024 * 2;
constexpr size_t WS_BST = WS_MTC + (size_t)32 * 512 * UHK * 2;
constexpr size_t WS_ROPE = WS_BST + (size_t)32 * 256 * 512 * 2;
constexpr size_t WS_PW = WS_ROPE + (size_t)2 * SEQL * 32 * 4;
constexpr size_t WS_KT = WS_PW + (size_t)2 * 32 * 64 * 8;
constexpr size_t WS_Q = WS_KT + (size_t)32 * 2 * 32 * 256 * 4;
constexpr size_t WS_K = WS_Q + (size_t)TP * QKVW * 2;
constexpr size_t WS_VT = WS_K + (size_t)TP * QKVW * 2;
constexpr size_t WS_ZA = WS_VT + (size_t)TP * QKVW * 2;
constexpr size_t WS_ZB = WS_ZA + (size_t)TP * 512 * 2;
constexpr size_t WS_GA = WS_ZB + (size_t)TP * 512 * 2;
constexpr size_t WS_GB = WS_GA + (size_t)TP * 1024 * 2;
constexpr size_t WS_UH = WS_GB + (size_t)TP * 1024 * 2;
constexpr size_t WS_S = WS_UH + (size_t)32 * CHP * UHK * 2;
constexpr size_t WS_GAO = WS_S + (size_t)32 * CHP * 256 * 4;
constexpr size_t WS_BAR = WS_GAO + (size_t)TP * 512 * 2;
constexpr size_t WS_BAR_BYTES = 32768;
constexpr size_t WS_CTL = WS_BAR + WS_BAR_BYTES;
constexpr size_t WS_END = WS_CTL + 4096;
constexpr size_t WS_SG = WS_Q;
constexpr size_t WS_SB = WS_Q + (size_t)TP * 512 * 2;
constexpr size_t WS_M1 = WS_K;
constexpr size_t WS_ACC = WS_Q;
constexpr size_t OUT_HN_OFF = (size_t)SEQP * SEQL * DM * 4;

struct Args {
    const float* in[17];
    float* out;
    unsigned char* ws;
    int st_lo, st_hi;
    int do_sync, pad;
};

typedef __bf16 bf16v2 __attribute__((ext_vector_type(2)));
__device__ __forceinline__ unsigned cvt_pk_bf16(float lo, float hi) { const f32x2 v = (f32x2){lo, hi}; const bf16v2 r = __builtin_convertvector(v, bf16v2); return __builtin_bit_cast(unsigned, r); }
__device__ __forceinline__ float bf_lo(unsigned w) { return __uint_as_float(w << 16); }
__device__ __forceinline__ float bf_hi(unsigned w) { return __uint_as_float(w & 0xffff0000u); }
__device__ __forceinline__ float fast_rcp(float x) { return __builtin_amdgcn_rcpf(x); }
__device__ __forceinline__ float sigmoidf_(float x) { return fast_rcp(1.0f + __builtin_amdgcn_exp2f(-1.4426950408889634f * x)); }
__device__ __forceinline__ float siluf_(float x) { return x * sigmoidf_(x); }
__device__ __forceinline__ float gelu_tanh(float x) { const float u = x * (1.5957691216057308f + 0.07135481627260025f * x * x); return x * sigmoidf_(u); }
__device__ __forceinline__ float wave_sum(float v) {
#pragma unroll
    for (int o = 1; o < 64; o <<= 1) v += __shfl_xor(v, o);
    return v;
}
__device__ __forceinline__ const float* xrow_ptr(const float* xp, const float* xs, int tg) {
    return tg < 4 * SEQL ? xp + (size_t)tg * DM : xs + (size_t)(tg - 4 * SEQL) * DM;
}

constexpr int BM = 256, BK = 64, HALF = 128, HTB = HALF * BK * 2, STAGE_BYTES = 8 * HTB, NXCD = 8, WGM = 8;
__host__ __device__ __forceinline__ int lds_byte(int r, int c) { const int st = (r >> 4) * 2 + (c >> 5), rr = r & 15, cc = c & 31, ob = rr * 64 + cc * 2; return st * 1024 + (ob ^ (((ob >> 9) & 1) << 5)); }
__host__ __device__ __forceinline__ void stage_rc(int b, int& R, int& C) { const int st = b / 1024, sb = b % 1024, swz = sb ^ (((sb >> 9) & 1) << 5); R = (st >> 1) * 16 + swz / 64; C = (st & 1) * 32 + (swz % 64) / 2; }
__host__ __device__ __forceinline__ int perm32(int rho) { const int n = rho >> 4, i = rho & 15; return 8 * (i >> 2) + 4 * n + (i & 3); }

enum { MODE_PROJ = 0, MODE_S = 1, MODE_Y = 2, MODE_GLU = 3, MODE_A = 4, MODE_B = 5, MODE_OUT = 6 };
struct Unit { int pm, pn, bz; };
struct GemmD {
    const bf16_t* A; const bf16_t* Bt;
    int lda, ldb, K, nM, nN, nb;
    unsigned sA, sB;
    int mode, pass, lgnN;
    int u0, ustride, ucount;
};
__device__ __forceinline__ bool unit_next(const GemmD& g, int i, int G, int c, int& pm, int& pn, int& bz) {
    const bool ok = i < g.ucount;
    const int Li = ok ? g.u0 + i * g.ustride : 0;
    if (g.nb == 1) {
        const int lg = g.lgnN, q = (g.nM << lg) >> 3;
        const int wgid = (Li & 7) * q + (Li >> 3);
        const int gid = wgid >> (3 + lg), rem = wgid & ((8 << lg) - 1);
        pm = gid * 8 + (rem & 7); pn = rem >> 3; bz = 0;
    } else {
        const int nwg = g.nM * g.nN;
        const int w = Li % nwg; bz = Li / nwg; pm = w % g.nM; pn = w / g.nM;
    }
    return ok;
}

__device__ __forceinline__ void epilogue(const Args& a, LAS unsigned char* lds, const GemmD& g, const f32x4 (&acc)[2][2][4][2], const Unit& u, int wr, int wc, int fr, int fq) {
    asm volatile("" : "+v"(fr), "+v"(fq));
    unsigned char* ws = a.ws;
    const int rbase = u.pm * BM + wr * 64 + fr;
    const int cl = wc * 32 + fq * 8;
    if (g.mode == MODE_PROJ) {
        const int pn = u.pn;
        if (pn < 12) {
            const bool isq = pn < 6;
            bf16_t* dst = (bf16_t*)(ws + (isq ? WS_Q : WS_K));
            const float* rc = (const float*)(ws + WS_ROPE); const float* rs = rc + SEQL * 32;
            const int a4 = 4 * (4 * (wc & 1) + fq);
            const int pq = isq ? pn : pn - 6, gi = pq >> 1, sh = 2 * gi, dmask = (1 << sh) - 1, Lg = SEQL >> sh;
            const float sc = isq ? QSCALE : 1.0f;
#pragma unroll
            for (int ai = 0; ai < 2; ++ai) {
                asm volatile("" ::: "memory");
                f32x4 cvv[4], svv[4];
#pragma unroll
                for (int m = 0; m < 4; ++m) { const int pos = (rbase + ai * HALF + m * 16) & (SEQL - 1); cvv[m] = *(const f32x4*)(rc + pos * 32 + a4); svv[m] = *(const f32x4*)(rs + pos * 32 + a4); }
#pragma unroll
                for (int m = 0; m < 4; ++m) {
                    const int tl = rbase + ai * HALF + m * 16; const int pos = tl & (SEQL - 1), sq = tl >> 13;
                    const int kidx = (pos & dmask) * Lg + (pos >> sh);
                    const f32x4 cv = cvv[m] * sc, sv = svv[m] * sc;
#pragma unroll
                    for (int bj = 0; bj < 2; ++bj) {
                        const f32x4 x1 = acc[ai][bj][m][0], x2 = acc[ai][bj][m][1];
                        const f32x4 o1 = x1 * cv - x2 * sv, o2 = x2 * cv + x1 * sv;
                        const int head = pq * 4 + 2 * bj + (wc >> 1);
                        const int ch = 4 * (wc & 1) + fq;
                        bf16_t* p = dst + (size_t)(sq * 24 + head) * SEQL * 64 + (isq ? (size_t)kidx * 64 + ch * 8 : (size_t)(kidx >> 4) * 1024 + ch * 128 + (kidx & 15) * 8);
                        u32x4 w; w.x = cvt_pk_bf16(o1[0], o1[1]); w.y = cvt_pk_bf16(o1[2], o1[3]); w.z = cvt_pk_bf16(o2[0], o2[1]); w.w = cvt_pk_bf16(o2[2], o2[3]);
                        *(u32x4*)p = w;
                    }
                }
            }
        } else if (pn < 18) {
            bf16_t* dst = (bf16_t*)(ws + WS_VT);
            const int gi = (pn - 12) >> 1, sh = 2 * gi;
            const int wid = wr * 4 + wc, lane = fq * 16 + fr;
            LAS bf16_t* tile = (LAS bf16_t*)(lds + STAGE_BYTES + wid * 4096);
#pragma unroll
            for (int ai = 0; ai < 2; ++ai) {
                const int tl0 = u.pm * BM + wr * 64 + ai * HALF;
                const int pos0 = tl0 & (SEQL - 1), sq = tl0 >> 13;
#pragma unroll
                for (int bj = 0; bj < 2; ++bj) {
                    asm volatile("" ::: "memory");
                    const int h = (4 * (pn - 12) + 2 * bj + (wc >> 1)) & 7;
#pragma unroll
                    for (int m = 0; m < 4; ++m) {
                        const int t = 16 * m + fr;
                        const int slot = gi == 0 ? t : (gi == 1 ? ((t & 3) * 16 + (t >> 2)) : ((t & 15) * 4 + (t >> 4)));
#pragma unroll
                        for (int n = 0; n < 2; ++n)
#pragma unroll
                            for (int j = 0; j < 4; ++j) { const unsigned w = cvt_pk_bf16(acc[ai][bj][m][n][j], 0.f); tile[(8 * fq + 4 * n + j) * 64 + slot] = (bf16_t)(w & 0xffffu); }
                    }
                    bf16_t* hb0 = dst + (size_t)(((sq * 3 + gi) * 8 + h) * 512) * 1024;
#pragma unroll
                    for (int i = 0; i < 4; ++i) {
                        const int c = lane + 64 * i, d = c >> 3, s8 = (c & 7) * 8;
                        const u32x4 v = *(const LAS u32x4*)(tile + d * 64 + s8);
                        const int dg = 32 * (wc & 1) + d; const int doff = (dg >> 4) * 256 + (dg & 15) * 4;
                        if (gi == 0) { const int kidx = pos0 + s8; bf16_t* q = hb0 + (size_t)(kidx >> 4) * 1024 + doff + ((kidx & 15) >> 2) * 64; *(u32x2*)q = (u32x2){v.x, v.y}; *(u32x2*)(q + 64) = (u32x2){v.z, v.w}; }
                        else if (gi == 1) { const int kidx = (s8 >> 4) * 2048 + (pos0 >> 2) + (s8 & 15); bf16_t* q = hb0 + (size_t)(kidx >> 4) * 1024 + doff + ((kidx & 15) >> 2) * 64; *(u32x2*)q = (u32x2){v.x, v.y}; *(u32x2*)(q + 64) = (u32x2){v.z, v.w}; }
                        else { const int ka = (s8 >> 2) * 512 + (pos0 >> 4), kb = ka + 512;
                            *(u32x2*)(hb0 + (size_t)(ka >> 4) * 1024 + doff + ((ka & 15) >> 2) * 64) = (u32x2){v.x, v.y}; *(u32x2*)(hb0 + (size_t)(kb >> 4) * 1024 + doff + ((kb & 15) >> 2) * 64) = (u32x2){v.z, v.w}; }
                    }
                }
            }
        } else if (pn == 20 || pn == 21) {
            bf16_t* dst = (bf16_t*)(ws + WS_UH);
#pragma unroll
            for (int ai = 0; ai < 2; ++ai)
#pragma unroll
                for (int m = 0; m < 4; ++m) { asm volatile("" ::: "memory");
                    const int tl = rbase + ai * HALF + m * 16;
#pragma unroll
                    for (int bj = 0; bj < 2; ++bj) {
                        const int gg = 16 * (pn - 20) + 8 * bj + 2 * wc + (fq >> 1);
                        bf16_t* p = dst + ((size_t)(gg * CHP + (tl >> 5)) * UHK) + (tl & 31) * 16 + 8 * (fq & 1);
                        const f32x4 v0 = acc[ai][bj][m][0], v1 = acc[ai][bj][m][1];
                        u32x4 w; w.x = cvt_pk_bf16(v0[0], v0[1]); w.y = cvt_pk_bf16(v0[2], v0[3]); w.z = cvt_pk_bf16(v1[0], v1[1]); w.w = cvt_pk_bf16(v1[2], v1[3]);
                        *(u32x4*)p = w;
                    }
                }
        } else {
            bf16_t* dst; int ld, c0; bool silu;
            if (pn < 20) { dst = (bf16_t*)(ws + WS_ZA); ld = 512; c0 = (pn - 18) * 256; silu = true; }
            else if (pn < 24) { dst = (bf16_t*)(ws + WS_ZB); ld = 512; c0 = (pn - 22) * 256; silu = true; }
            else if (pn < 28) { dst = (bf16_t*)(ws + WS_GA); ld = 1024; c0 = (pn - 24) * 256; silu = false; }
            else { dst = (bf16_t*)(ws + WS_GB); ld = 1024; c0 = (pn - 28) * 256; silu = false; }
#pragma unroll
            for (int ai = 0; ai < 2; ++ai)
#pragma unroll
                for (int m = 0; m < 4; ++m) { asm volatile("" ::: "memory");
                    const int tl = rbase + ai * HALF + m * 16;
#pragma unroll
                    for (int bj = 0; bj < 2; ++bj) {
                        f32x4 v0 = acc[ai][bj][m][0], v1 = acc[ai][bj][m][1];
#pragma unroll
                        for (int j = 0; j < 4; ++j) { const float s0 = sigmoidf_(v0[j]), s1 = sigmoidf_(v1[j]); v0[j] = silu ? v0[j] * s0 : s0; v1[j] = silu ? v1[j] * s1 : s1; }
                        u32x4 w; w.x = cvt_pk_bf16(v0[0], v0[1]); w.y = cvt_pk_bf16(v0[2], v0[3]); w.z = cvt_pk_bf16(v1[0], v1[1]); w.w = cvt_pk_bf16(v1[2], v1[3]);
                        *(u32x4*)(dst + (size_t)tl * ld + c0 + cl + bj * HALF) = w;
                    }
                }
        }
    } else if (g.mode == MODE_S) {
        float* dst = (float*)(ws + WS_S) + (size_t)u.bz * CHP * 256;
#pragma unroll
        for (int ai = 0; ai < 2; ++ai)
#pragma unroll
            for (int m = 0; m < 4; ++m) { asm volatile("" ::: "memory");
                const int r = rbase + ai * HALF + m * 16;
#pragma unroll
                for (int bj = 0; bj < 2; ++bj) { float* p = dst + (size_t)r * 256 + cl + bj * HALF; *(f32x4*)p = acc[ai][bj][m][0]; *(f32x4*)(p + 4) = acc[ai][bj][m][1]; }
            }
    } else if (g.mode == MODE_Y) {
        bf16_t* dst = (bf16_t*)(ws + WS_SG);
#pragma unroll
        for (int ai = 0; ai < 2; ++ai)
#pragma unroll
            for (int m = 0; m < 4; ++m) { asm volatile("" ::: "memory");
                const int r = rbase + ai * HALF + m * 16;
#pragma unroll
                for (int bj = 0; bj < 2; ++bj) {
                    const int t = 16 * u.pn + 8 * bj + 2 * wc + (fq >> 1);
                    f32x4 v0 = acc[ai][bj][m][0], v1 = acc[ai][bj][m][1];
#pragma unroll
                    for (int j = 0; j < 4; ++j) { v0[j] = gelu_tanh(v0[j]); v1[j] = gelu_tanh(v1[j]); }
                    u32x4 w; w.x = cvt_pk_bf16(v0[0], v0[1]); w.y = cvt_pk_bf16(v0[2], v0[3]); w.z = cvt_pk_bf16(v1[0], v1[1]); w.w = cvt_pk_bf16(v1[2], v1[3]);
                    *(u32x4*)(dst + (size_t)(r * LC + t) * 512 + u.bz * 16 + 8 * (fq & 1)) = w;
                }
            }
    } else if (g.mode == MODE_GLU) {
        const bf16_t* sg = (const bf16_t*)(ws + WS_SG); const bf16_t* zb = (const bf16_t*)(ws + WS_ZB); bf16_t* dst = (bf16_t*)(ws + WS_SB);
#pragma unroll
        for (int ai = 0; ai < 2; ++ai) {
            asm volatile("" ::: "memory");
            u32x4 sv4[4][2], zv4[4][2];
#pragma unroll
            for (int m = 0; m < 4; ++m)
#pragma unroll
                for (int bj = 0; bj < 2; ++bj) { const size_t off = (size_t)(rbase + ai * HALF + m * 16) * 512 + u.pn * BM + cl + bj * HALF; sv4[m][bj] = *(const u32x4*)(sg + off); zv4[m][bj] = *(const u32x4*)(zb + off); }
#pragma unroll
            for (int m = 0; m < 4; ++m)
#pragma unroll
                for (int bj = 0; bj < 2; ++bj) {
                    const size_t off = (size_t)(rbase + ai * HALF + m * 16) * 512 + u.pn * BM + cl + bj * HALF;
                    const u32x4 s4 = sv4[m][bj], z4 = zv4[m][bj];
                    const f32x4 v0 = acc[ai][bj][m][0], v1 = acc[ai][bj][m][1];
                    u32x4 w;
                    w.x = cvt_pk_bf16(bf_lo(s4.x) * sigmoidf_(v0[0]) * bf_lo(z4.x), bf_hi(s4.x) * sigmoidf_(v0[1]) * bf_hi(z4.x));
                    w.y = cvt_pk_bf16(bf_lo(s4.y) * sigmoidf_(v0[2]) * bf_lo(z4.y), bf_hi(s4.y) * sigmoidf_(v0[3]) * bf_hi(z4.y));
                    w.z = cvt_pk_bf16(bf_lo(s4.z) * sigmoidf_(v1[0]) * bf_lo(z4.z), bf_hi(s4.z) * sigmoidf_(v1[1]) * bf_hi(z4.z));
                    w.w = cvt_pk_bf16(bf_lo(s4.w) * sigmoidf_(v1[2]) * bf_lo(z4.w), bf_hi(s4.w) * sigmoidf_(v1[3]) * bf_hi(z4.w));
                    *(u32x4*)(dst + off) = w;
                }
        }
    } else if (g.mode == MODE_A || g.mode == MODE_B) {
        const bool isb = g.mode == MODE_B;
        const bf16_t* gt = (const bf16_t*)(ws + (isb ? WS_GB : WS_GA)); bf16_t* dst = (bf16_t*)(ws + WS_M1);
#pragma unroll
        for (int ai = 0; ai < 2; ++ai) {
            asm volatile("" ::: "memory");
            u32x4 gv4[4][2], pv4[4][2];
#pragma unroll
            for (int m = 0; m < 4; ++m)
#pragma unroll
                for (int bj = 0; bj < 2; ++bj) { const size_t off = (size_t)(rbase + ai * HALF + m * 16) * 1024 + u.pn * BM + cl + bj * HALF; gv4[m][bj] = *(const u32x4*)(gt + off); pv4[m][bj] = (u32x4){0u, 0u, 0u, 0u}; if (isb) pv4[m][bj] = *(const u32x4*)(dst + off); }
#pragma unroll
            for (int m = 0; m < 4; ++m)
#pragma unroll
                for (int bj = 0; bj < 2; ++bj) {
                    const size_t off = (size_t)(rbase + ai * HALF + m * 16) * 1024 + u.pn * BM + cl + bj * HALF;
                    const u32x4 g4 = gv4[m][bj], p4 = pv4[m][bj];
                    const f32x4 v0 = acc[ai][bj][m][0], v1 = acc[ai][bj][m][1];
                    u32x4 w;
                    w.x = cvt_pk_bf16(bf_lo(p4.x) + bf_lo(g4.x) * v0[0], bf_hi(p4.x) + bf_hi(g4.x) * v0[1]);
                    w.y = cvt_pk_bf16(bf_lo(p4.y) + bf_lo(g4.y) * v0[2], bf_hi(p4.y) + bf_hi(g4.y) * v0[3]);
                    w.z = cvt_pk_bf16(bf_lo(p4.z) + bf_lo(g4.z) * v1[0], bf_hi(p4.z) + bf_hi(g4.z) * v1[1]);
                    w.w = cvt_pk_bf16(bf_lo(p4.w) + bf_lo(g4.w) * v1[2], bf_hi(p4.w) + bf_hi(g4.w) * v1[3]);
                    *(u32x4*)(dst + off) = w;
                }
        }
    } else {
        bf16_t* dst = (bf16_t*)(ws + WS_ACC);
#pragma unroll
        for (int ai = 0; ai < 2; ++ai)
#pragma unroll
            for (int m = 0; m < 4; ++m) {
                const int tl = rbase + ai * HALF + m * 16;
#pragma unroll
                for (int bj = 0; bj < 2; ++bj) {
                    const f32x4 v0 = acc[ai][bj][m][0], v1 = acc[ai][bj][m][1];
                    u32x4 w; w.x = cvt_pk_bf16(v0[0], v0[1]); w.y = cvt_pk_bf16(v0[2], v0[3]); w.z = cvt_pk_bf16(v1[0], v1[1]); w.w = cvt_pk_bf16(v1[2], v1[3]);
                    *(u32x4*)(dst + (size_t)tl * DM + u.pn * BM + cl + bj * HALF) = w;
                }
            }
    }
}

__device__ __forceinline__ void gemm_phase(const Args& a, LAS unsigned char* lds, const GemmD& g, int G, int cidx, int tid) {
    const int wid = __builtin_amdgcn_readfirstlane(tid >> 6), lane = tid & 63, wr = wid >> 2, wc = wid & 3, fr = lane & 15, fq = lane >> 4;
    const int K = g.K, nt = K / BK;
    unsigned voffA[2], voffB[2];
#pragma unroll
    for (int i = 0; i < 2; ++i) { int R, C; stage_rc(tid * 16 + i * 8192, R, C); const int Rb = (R & ~31) + perm32(R & 31);
        voffA[i] = (unsigned)(R * g.lda + C) * 2u; voffB[i] = (unsigned)(Rb * g.ldb + C) * 2u; }
    const size_t kstep = (size_t)(BK * 2);
    const size_t hstepA = (size_t)HALF * g.lda * 2, hstepB = (size_t)HALF * g.ldb * 2;
    const size_t tstepA = 2 * hstepA, tstepB = 2 * hstepB;
    const unsigned ldsw = (unsigned)wid * 1024u;
    const int aoff = lds_byte(wr * 64 + fr, fq * 8), boff = lds_byte(wc * 32 + fr, fq * 8);
#define PG8_SA(b, h) (((b) * 2 + (h)) * HTB)
#define PG8_SB(b, h) ((4 + (b) * 2 + (h)) * HTB)
#define PG8_STAGE(bufoff, gbase, voff) do { _Pragma("unroll") for (int _i = 0; _i < 2; ++_i) \
        __builtin_amdgcn_global_load_lds((const unsigned*)((const char*)(gbase) + (voff)[_i]), (LAS unsigned*)(lds + (bufoff) + ldsw + _i * 8192), 16, 0, 0); } while (0)
#define PG8_LDA(dst, b, h) do { _Pragma("unroll") for (int m = 0; m < 4; ++m) _Pragma("unroll") for (int k = 0; k < 2; ++k) dst[m][k] = *(const LAS bf16x8*)(lds + PG8_SA(b, h) + aoff + m * 2048 + k * 1024); } while (0)
#define PG8_LDB(dst, b, h) do { _Pragma("unroll") for (int n = 0; n < 2; ++n) _Pragma("unroll") for (int k = 0; k < 2; ++k) dst[n][k] = *(const LAS bf16x8*)(lds + PG8_SB(b, h) + boff + n * 2048 + k * 1024); } while (0)
#define PG8_MMA(ai, bj, At, Bt) do { __builtin_amdgcn_s_setprio(1); _Pragma("unroll") for (int m = 0; m < 4; ++m) _Pragma("unroll") for (int n = 0; n < 2; ++n) _Pragma("unroll") for (int k = 0; k < 2; ++k) \
        acc[ai][bj][m][n] = __builtin_amdgcn_mfma_f32_16x16x32_bf16(Bt[n][k], At[m][k], acc[ai][bj][m][n], 0, 0, 0); __builtin_amdgcn_s_setprio(0); } while (0)
#define PG8_WAIT_V(n) asm volatile("s_waitcnt vmcnt(" #n ")" ::: "memory")
#define PG8_WAIT_L(n) asm volatile("s_waitcnt lgkmcnt(" #n ")" ::: "memory")
#define PG8_BAR __builtin_amdgcn_s_barrier()
#define PG8_SCHED __builtin_amdgcn_sched_barrier(0)
    Unit cur, nxt; int ui = 0;
    { int pm_, pn_, bz_; if (!unit_next(g, 0, G, cidx, pm_, pn_, bz_)) return; cur.pm = pm_; cur.pn = pn_; cur.bz = bz_; }
    f32x4 acc[2][2][4][2];
#pragma unroll
    for (int a = 0; a < 2; ++a)
#pragma unroll
        for (int b = 0; b < 2; ++b)
#pragma unroll
            for (int m = 0; m < 4; ++m)
#pragma unroll
                for (int n = 0; n < 2; ++n) acc[a][b][m][n] = (f32x4){0.f, 0.f, 0.f, 0.f};
    bf16x8 At[4][2], B0[2][2], B1[2][2];
    const char* cA = (const char*)g.A + (size_t)cur.bz * g.sA + (size_t)cur.pm * tstepA; const char* cB = (const char*)g.Bt + (size_t)cur.bz * g.sB + (size_t)cur.pn * tstepB;
    PG8_STAGE(PG8_SB(0, 0), cB, voffB); PG8_STAGE(PG8_SA(0, 0), cA, voffA); PG8_STAGE(PG8_SB(0, 1), cB + hstepB, voffB); PG8_STAGE(PG8_SA(0, 1), cA + hstepA, voffA);
    if (wr == 1) PG8_BAR;
    PG8_WAIT_V(4); PG8_BAR;
    PG8_STAGE(PG8_SB(1, 0), cB + kstep, voffB); PG8_STAGE(PG8_SA(1, 0), cA + kstep, voffA); PG8_STAGE(PG8_SB(1, 1), cB + hstepB + kstep, voffB);
    PG8_WAIT_V(6); PG8_BAR;
    for (;;) {
        int npm, npn, nbz; const bool has_next = unit_next(g, ui + 1, G, cidx, npm, npn, nbz); nxt.pm = npm; nxt.pn = npn; nxt.bz = nbz;
        const char* nA = has_next ? (const char*)g.A + (size_t)nxt.bz * g.sA + (size_t)nxt.pm * tstepA : cA; const char* nB = has_next ? (const char*)g.Bt + (size_t)nxt.bz * g.sB + (size_t)nxt.pn * tstepB : cB;
        for (int t = 0; t < nt; t += 2) {
            const bool last = (t == nt - 2);
            const char* a1 = cA + (size_t)(t + 1) * kstep;
            const char* a2 = last ? nA : cA + (size_t)(t + 2) * kstep; const char* b2 = last ? nB : cB + (size_t)(t + 2) * kstep;
            const char* a3 = a2 + kstep; const char* b3 = b2 + kstep;
            PG8_LDB(B0, 0, 0); PG8_SCHED; PG8_LDA(At, 0, 0); PG8_STAGE(PG8_SA(1, 1), a1 + hstepA, voffA);
            PG8_WAIT_L(8); PG8_BAR; PG8_WAIT_L(0); PG8_MMA(0, 0, At, B0); PG8_BAR; PG8_SCHED;
            PG8_LDB(B1, 0, 1); PG8_STAGE(PG8_SB(0, 0), b2, voffB);
            PG8_BAR; PG8_WAIT_L(0); PG8_MMA(0, 1, At, B1); PG8_BAR;
            PG8_LDA(At, 0, 1); PG8_STAGE(PG8_SA(0, 0), a2, voffA);
            PG8_BAR; PG8_WAIT_L(0); PG8_MMA(1, 0, At, B0); PG8_BAR; PG8_SCHED;
            PG8_STAGE(PG8_SB(0, 1), b2 + hstepB, voffB);
            PG8_WAIT_V(6); PG8_BAR; PG8_MMA(1, 1, At, B1); PG8_BAR;
            PG8_LDB(B0, 1, 0); PG8_SCHED; PG8_LDA(At, 1, 0); PG8_STAGE(PG8_SA(0, 1), a2 + hstepA, voffA);
            PG8_WAIT_L(8); PG8_BAR; PG8_WAIT_L(0); PG8_MMA(0, 0, At, B0); PG8_BAR; PG8_SCHED;
            PG8_LDB(B1, 1, 1); PG8_STAGE(PG8_SB(1, 0), b3, voffB);
            PG8_BAR; PG8_WAIT_L(0); PG8_MMA(0, 1, At, B1); PG8_BAR;
            PG8_LDA(At, 1, 1); PG8_STAGE(PG8_SA(1, 0), a3, voffA);
            PG8_BAR; PG8_WAIT_L(0); PG8_MMA(1, 0, At, B0); PG8_BAR; PG8_SCHED;
            PG8_STAGE(PG8_SB(1, 1), b3 + hstepB, voffB);
            PG8_WAIT_V(6); PG8_BAR; PG8_MMA(1, 1, At, B1); PG8_BAR;
        }
#ifndef NO_EPI
        epilogue(a, lds, g, acc, cur, wr, wc, fr, fq);
#else
        if (g.mode == 99) *(f32x4*)(g.out) = acc[0][0][0][0] + acc[1][1][3][1] + acc[0][1][2][0]+acc[1][0][1][1];
#endif
        if (!has_next) break;
#pragma unroll
        for (int a = 0; a < 2; ++a)
#pragma unroll
            for (int b = 0; b < 2; ++b)
#pragma unroll
                for (int m = 0; m < 4; ++m)
#pragma unroll
                    for (int n = 0; n < 2; ++n) acc[a][b][m][n] = (f32x4){0.f, 0.f, 0.f, 0.f};
        cur = nxt; cA = nA; cB = nB; ++ui;
    }
    PG8_WAIT_V(0);
    if (wr == 0) PG8_BAR;
    PG8_BAR;
#undef PG8_SA
#undef PG8_SB
#undef PG8_STAGE
#undef PG8_LDA
#undef PG8_LDB
#undef PG8_MMA
#undef PG8_WAIT_V
#undef PG8_WAIT_L
#undef PG8_BAR
#undef PG8_SCHED
}

__device__ __forceinline__ int qk_perm_row(int n) { const int i = n & 63; return (n & ~63) + 8 * ((i & 31) >> 2) + (i & 3) + 4 * (i >> 5); }
__device__ __forceinline__ void transpose_item(const float* W, int K, int N, bf16_t* WT, bool permqk, LAS float* scr, int item, int lane) {
    const int nblk = N / 32, kb = item / nblk, nb = item % nblk, k0 = 64 * kb, n0 = 32 * nb;
#pragma unroll 8
    for (int i = 0; i < 32; ++i) { const int kk = 2 * i + (lane >> 5); scr[kk * 33 + (lane & 31)] = W[(size_t)(k0 + kk) * N + n0 + (lane & 31)]; }
    asm volatile("s_waitcnt lgkmcnt(0)" ::: "memory");
    const int c = lane & 7;
#pragma unroll
    for (int j = 0; j < 4; ++j) { const int n = (lane >> 3) + 8 * j; const LAS float* s = scr + (8 * c) * 33 + n;
        u32x4 o; o.x = cvt_pk_bf16(s[0 * 33], s[1 * 33]); o.y = cvt_pk_bf16(s[2 * 33], s[3 * 33]); o.z = cvt_pk_bf16(s[4 * 33], s[5 * 33]); o.w = cvt_pk_bf16(s[6 * 33], s[7 * 33]);
        int row = n0 + n; if (permqk && row < 2 * QKVW) row = qk_perm_row(row);
        *(u32x4*)(WT + (size_t)row * K + k0 + 8 * c) = o; }
    asm volatile("s_waitcnt lgkmcnt(0)" ::: "memory");
}
__device__ __forceinline__ void reduce_angle(double a, float& c, float& s) {
    const double k = __builtin_rint(a * 0.6366197723675814); const float x = (float)(a - k * 1.5707963267948966), x2 = x * x;
    const float sn = x * (1.0f + x2 * (-1.6666666667e-1f + x2 * (8.3333333333e-3f + x2 * (-1.9841269841e-4f + x2 * 2.7557319224e-6f))));
    const float cs = 1.0f + x2 * (-0.5f + x2 * (4.1666666667e-2f + x2 * (-1.3888888889e-3f + x2 * (2.4801587302e-5f + x2 * -2.7557319224e-7f))));
    const int q = ((int)k) & 3;
    c = (q == 0) ? cs : (q == 1) ? -sn : (q == 2) ? -cs : sn;
    s = (q == 0) ? sn : (q == 1) ? cs : (q == 2) ? -sn : -cs;
}
__device__ __forceinline__ void rms_row_to_bf16(const float* xrow, const float* gw, bf16_t* orow, int lane) {
    const f32x4* xr = (const f32x4*)xrow + lane; const f32x4* gr = (const f32x4*)gw + lane;
    f32x4 v[4]; float s = 0.f;
#pragma unroll
    for (int j = 0; j < 4; ++j) { v[j] = xr[64 * j]; s += (v[j].x * v[j].x + v[j].y * v[j].y) + (v[j].z * v[j].z + v[j].w * v[j].w); }
    const float rstd = 1.0f / sqrtf(wave_sum(s) * (1.f / DM) + EPSN);
    u32x2* o8 = (u32x2*)orow + lane;
#pragma unroll
    for (int j = 0; j < 4; ++j) { const f32x4 gv = gr[64 * j]; u32x2 w; w.x = cvt_pk_bf16(v[j].x * rstd * gv.x, v[j].y * rstd * gv.y); w.y = cvt_pk_bf16(v[j].z * rstd * gv.z, v[j].w * rstd * gv.w); o8[64 * j] = w; }
}

__device__ __forceinline__ void ssm_load_bc(const Args& a, int g, int dir, LAS f32x2* Bb, LAS f32x2* Cc, int tid) {
    const float* lam_re = a.in[4]; const float* lam_im = a.in[5]; const float* log_step = a.in[6];
    const float* b_re = a.in[7]; const float* b_im = a.in[8]; const float* c_re = a.in[9]; const float* c_im = a.in[10];
    const float dt = expf(log_step[dir * 32 + g]);
    for (int idx = tid; idx < 1024; idx += 512) {
        { const int n = idx >> 4; const float lr = lam_re[(dir * 32 + g) * 64 + n], li = lam_im[(dir * 32 + g) * 64 + n];
          const float ar = lr * dt; float cb, sb, ch, sh; reduce_angle((double)li * (double)dt, cb, sb); reduce_angle(0.5 * (double)li * (double)dt, ch, sh);
          const float em1 = expm1f(ar), ea = em1 + 1.0f;
          const float nr = em1 * cb - 2.0f * sh * sh, ni = ea * sb;
          const float den = 1.0f / (lr * lr + li * li); const float cr = (nr * lr + ni * li) * den, ci = (ni * lr - nr * li) * den;
          const float br = b_re[(size_t)((dir * 32 + g) * 64) * 16 + idx], bi = b_im[(size_t)((dir * 32 + g) * 64) * 16 + idx];
          Bb[idx] = (f32x2){cr * br - ci * bi, cr * bi + ci * br}; }
        { Cc[idx] = (f32x2){c_re[(size_t)((dir * 32 + g) * 16) * 64 + idx], c_im[(size_t)((dir * 32 + g) * 16) * 64 + idx]}; }
    }
}
__device__ __forceinline__ void ssm_setup_item(const Args& a, LAS unsigned char* lds, int item, int tid) {
    const int g = item >> 1, dir = item & 1;
    LAS f32x2* pw = (LAS f32x2*)lds; LAS f32x2* Bb = pw + 33 * 64; LAS f32x2* Cc = Bb + 1024;
    LAS float* KT = (LAS float*)(Cc + 1024); LAS float* K0 = KT + 32 * 256; LAS f32x2* Bb0 = (LAS f32x2*)(K0 + 256); LAS f32x2* Cc0 = Bb0 + 1024;
    const float* lam_re = a.in[4]; const float* lam_im = a.in[5]; const float* log_step = a.in[6];
    unsigned char* ws = a.ws;
    const float dt = expf(log_step[dir * 32 + g]);
    __syncthreads();
    for (int idx = tid; idx < 33 * 64; idx += 512) {
        const int tau = idx >> 6, n = idx & 63; const float lr = lam_re[(dir * 32 + g) * 64 + n], li = lam_im[(dir * 32 + g) * 64 + n];
        const float mag = expf(lr * dt * (float)tau); float c, s; reduce_angle((double)li * (double)dt * (double)tau, c, s);
        pw[idx] = (f32x2){mag * c, mag * s};
    }
    ssm_load_bc(a, g, dir, Bb, Cc, tid);
    if (dir == 1) ssm_load_bc(a, g, 0, Bb0, Cc0, tid);
    __syncthreads();
    if (tid < 64) { float* PW = (float*)(ws + WS_PW); const f32x2 p = pw[32 * 64 + tid]; PW[((dir * 32 + g) * 64 + tid) * 2] = p.x; PW[((dir * 32 + g) * 64 + tid) * 2 + 1] = p.y; }
    for (int o = tid; o < 32 * 256; o += 512) {
        const int tau = o >> 8, co = (o >> 4) & 15, ci = o & 15; float acc = 0.f;
_Pragma("unroll 4")
        for (int n = 0; n < 64; ++n) { const f32x2 c = Cc[co * 64 + n], p = pw[tau * 64 + n], b = Bb[n * 16 + ci]; const float tr = c.x * p.x - c.y * p.y, ti = c.x * p.y + c.y * p.x; acc += tr * b.x - ti * b.y; }
        KT[o] = acc; }
    if (dir == 1 && tid < 256) { const int co = tid >> 4, ci = tid & 15; float acc = 0.f;
_Pragma("unroll 4")
        for (int n = 0; n < 64; ++n) { const f32x2 c = Cc0[co * 64 + n], b = Bb0[n * 16 + ci]; acc += c.x * b.x - c.y * b.y; }
        K0[tid] = acc; }
    { bf16_t* BsT = (bf16_t*)(ws + WS_BST) + (size_t)g * 256 * 512;
      for (int ch = tid; ch < 128 * 64; ch += 512) {
          const int row = ch >> 6, part = row >> 6, n = row & 63, kc = ch & 63, s = kc >> 1, ci0 = (kc & 1) * 8; const int e = dir ? s : 31 - s; const f32x2 p = pw[e * 64 + n];
          float v[8];
#pragma unroll
          for (int j = 0; j < 8; ++j) { const f32x2 b = Bb[n * 16 + ci0 + j]; v[j] = part ? (p.x * b.y + p.y * b.x) : (p.x * b.x - p.y * b.y); }
          u32x4 w; w.x = cvt_pk_bf16(v[0], v[1]); w.y = cvt_pk_bf16(v[2], v[3]); w.z = cvt_pk_bf16(v[4], v[5]); w.w = cvt_pk_bf16(v[6], v[7]);
          *(u32x4*)(BsT + (size_t)(dir * 128 + row) * 512 + s * 16 + ci0) = w; } }
    bf16_t* MtC = (bf16_t*)(ws + WS_MTC) + (size_t)g * 512 * UHK;
    { for (int ch = tid; ch < 512 * 16; ch += 512) {
          const int row = ch >> 4, t = row >> 4, co = row & 15, cc = ch & 15, part = cc >> 3, n0 = (cc & 7) * 8; const int e = dir ? 32 - t : t + 1;
          float v[8];
#pragma unroll
          for (int j = 0; j < 8; ++j) { const f32x2 c = Cc[co * 64 + n0 + j], p = pw[e * 64 + n0 + j]; v[j] = part ? -(c.x * p.y + c.y * p.x) : (c.x * p.x - c.y * p.y); }
          u32x4 w; w.x = cvt_pk_bf16(v[0], v[1]); w.y = cvt_pk_bf16(v[2], v[3]); w.z = cvt_pk_bf16(v[4], v[5]); w.w = cvt_pk_bf16(v[6], v[7]);
          *(u32x4*)(MtC + (size_t)row * UHK + 512 + dir * 128 + part * 64 + n0) = w; } }
    __syncthreads();
    { const float* dsk = a.in[11];
      for (int ch = tid; ch < 512 * 64; ch += 512) {
          const int kc = ch & 63, row = ch >> 6; const int s = kc >> 1, ci0 = (kc & 1) * 8, t = row >> 4, co = row & 15;
          if (dir == 0 ? (t > s) : (s >= t)) {
              const int tau = dir == 0 ? t - s : s - t;
              float v[8];
#pragma unroll
              for (int j = 0; j < 8; ++j) v[j] = KT[tau * 256 + co * 16 + ci0 + j];
              if (t == s) { const float dv = dsk[g * 16 + co];
#pragma unroll
                  for (int j = 0; j < 8; ++j) v[j] += K0[co * 16 + ci0 + j] + ((ci0 + j == co) ? dv : 0.f); }
              u32x4 w; w.x = cvt_pk_bf16(v[0], v[1]); w.y = cvt_pk_bf16(v[2], v[3]); w.z = cvt_pk_bf16(v[4], v[5]); w.w = cvt_pk_bf16(v[6], v[7]);
              *(u32x4*)(MtC + (size_t)row * UHK + s * 16 + ci0) = w;
          }
      } }
    __syncthreads();
}

__device__ __forceinline__ void step_setup(const Args& a, LAS unsigned char* lds, int tid, int bx) {
    const int lane = tid & 63, wave = tid >> 6, G = gridDim.x;
    unsigned char* ws = a.ws;
    for (int it = bx; it < 64; it += G) ssm_setup_item(a, lds, it, tid);
    { float* rc = (float*)(ws + WS_ROPE); float* rs = rc + SEQL * 32;
      for (int idx = bx * 512 + tid; idx < SEQL * 32; idx += G * 512) {
          const int pos = idx >> 5, i = idx & 31; double inv = 1.0; for (int k = 0; k < i; ++k) inv *= 0.7498942093324558;
          float c, s; reduce_angle((double)pos * inv, c, s); rc[idx] = c; rs[idx] = s; } }
    { LAS float* scr = (LAS float*)(lds) + wave * (64 * 33);
      const int gw = bx * 8 + wave, NGW = G * 8;
      constexpr int I_IN = (DM / 64) * (INC / 32), I_GLU = (512 / 64) * (512 / 32), I_AB = (512 / 64) * (1024 / 32), I_OUT = (1024 / 64) * (1024 / 32);
      constexpr int NIT = I_IN + I_GLU + 2 * I_AB + I_OUT;
      for (int it = gw; it < NIT; it += NGW) {
          int r = it;
          if (r < I_IN) { transpose_item(a.in[3], DM, INC, (bf16_t*)(ws + WS_WIN), true, scr, r, lane); continue; } r -= I_IN;
          if (r < I_GLU) { transpose_item(a.in[12], 512, 512, (bf16_t*)(ws + WS_WGLU), false, scr, r, lane); continue; } r -= I_GLU;
          if (r < I_AB) { transpose_item(a.in[13], 512, 1024, (bf16_t*)(ws + WS_WA), false, scr, r, lane); continue; } r -= I_AB;
          if (r < I_AB) { transpose_item(a.in[14], 512, 1024, (bf16_t*)(ws + WS_WB), false, scr, r, lane); continue; } r -= I_AB;
          transpose_item(a.in[15], 1024, 1024, (bf16_t*)(ws + WS_WOUT), false, scr, r, lane);
      } }
    { bf16_t* hn = (bf16_t*)((unsigned char*)a.out + OUT_HN_OFF);
      const f32x4* gr = (const f32x4*)a.in[2] + lane;
      f32x4 gv[4];
#pragma unroll
      for (int j = 0; j < 4; ++j) gv[j] = gr[64 * j];
      unsigned* rctr = (unsigned*)(ws + WS_CTL) + 4;
      constexpr int RCH = 16;
      for (;;) {
          unsigned cidx = 0; if (lane == 0) cidx = atomicAdd(rctr, 1u);
          cidx = (unsigned)__builtin_amdgcn_readfirstlane((int)cidx);
          if (cidx >= (unsigned)(TTOK / RCH)) break;
          int row = (int)cidx * RCH; const int rend = row + RCH;
          f32x4 nx[4];
          { const f32x4* xr = (const f32x4*)xrow_ptr(a.in[0], a.in[1], row) + lane;
#pragma unroll
            for (int j = 0; j < 4; ++j) nx[j] = xr[64 * j]; }
          for (; row < rend; ++row) {
              f32x4 v[4];
#pragma unroll
              for (int j = 0; j < 4; ++j) v[j] = nx[j];
              if (row + 1 < rend) { const f32x4* xn = (const f32x4*)xrow_ptr(a.in[0], a.in[1], row + 1) + lane;
#pragma unroll
                  for (int j = 0; j < 4; ++j) nx[j] = xn[64 * j]; }
              float s = 0.f;
#pragma unroll
              for (int j = 0; j < 4; ++j) s += (v[j].x * v[j].x + v[j].y * v[j].y) + (v[j].z * v[j].z + v[j].w * v[j].w);
              const float rstd = 1.0f / sqrtf(wave_sum(s) * (1.f / DM) + EPSN);
              u32x2* o8 = (u32x2*)(hn + (size_t)row * DM) + lane;
#pragma unroll
              for (int j = 0; j < 4; ++j) { u32x2 w; w.x = cvt_pk_bf16(v[j].x * rstd * gv[j].x, v[j].y * rstd * gv[j].y); w.y = cvt_pk_bf16(v[j].z * rstd * gv[j].z, v[j].w * rstd * gv[j].w); o8[64 * j] = w; }
          }
      } }
}

__device__ __forceinline__ float quad_max(float x) {
    const auto r = __builtin_amdgcn_permlane32_swap(__float_as_uint(x), __float_as_uint(x), false, false);
    x = fmaxf(__uint_as_float(r[0]), __uint_as_float(r[1]));
    const auto q = __builtin_amdgcn_permlane16_swap(__float_as_uint(x), __float_as_uint(x), false, false);
    return fmaxf(__uint_as_float(q[0]), __uint_as_float(q[1]));
}
__device__ __forceinline__ float quad_sum(float x) {
    const auto r = __builtin_amdgcn_permlane32_swap(__float_as_uint(x), __float_as_uint(x), false, false);
    x = __uint_as_float(r[0]) + __uint_as_float(r[1]);
    const auto q = __builtin_amdgcn_permlane16_swap(__float_as_uint(x), __float_as_uint(x), false, false);
    return __uint_as_float(q[0]) + __uint_as_float(q[1]);
}
struct KVBuf { bf16x8 kA0, kA1, kB0, kB1; bf16x4 vA[4], vB[4]; };
__device__ __forceinline__ void step_params(int s, int& gi, int& ls) { gi = s < 12 ? 0 : (s < 18 ? 1 : 2); ls = s < 12 ? s : (s < 18 ? s - 12 : s - 18); }
__device__ __forceinline__ void attn_load(KVBuf& b, const bf16_t* Kp, const bf16_t* Vt, int s, int sq, int h, int blk, int r, int lane) {
    int gi, ls; step_params(s, gi, ls);
    const int sh = 2 * gi, Lg = SEQL >> sh, rho = r & ((1 << sh) - 1);
    int uA = ((256 * blk) >> sh) - 64 + 32 * ls, uB = uA + 16;
    if (uA < 0 || uA >= Lg) uA = 0; if (uB < 0 || uB >= Lg) uB = 0;
    const int kl = lane & 15, quad = lane >> 4;
    const bf16_t* kh = Kp + (size_t)(sq * 24 + gi * 8 + h) * SEQL * 64 + quad * 128 + kl * 8;
    const bf16_t* ka = kh + (size_t)((rho * Lg + uA) >> 4) * 1024; const bf16_t* kb = kh + (size_t)((rho * Lg + uB) >> 4) * 1024;
    b.kA0 = *(const bf16x8*)ka; b.kA1 = *(const bf16x8*)(ka + 512); b.kB0 = *(const bf16x8*)kb; b.kB1 = *(const bf16x8*)(kb + 512);
    const bf16_t* vbase = Vt + (size_t)(((sq * 3 + gi) * 8 + h) * 512) * 1024 + quad * 64 + kl * 4;
    const bf16_t* va = vbase + (size_t)((rho * Lg + uA) >> 4) * 1024; const bf16_t* vb = vbase + (size_t)((rho * Lg + uB) >> 4) * 1024;
#pragma unroll
    for (int dt = 0; dt < 4; ++dt) { b.vA[dt] = *(const bf16x4*)(va + dt * 256); b.vB[dt] = *(const bf16x4*)(vb + dt * 256); }
}
struct QF { bf16x8 a0, a1, b0, b1, c0, c1; };
template <int gi>
__device__ __forceinline__ void attn_compute(const KVBuf& b, const bf16x8 q0, const bf16x8 q1, f32x4 (&o)[4], float& mrun, float& lrun, int s, int blk, int r, int lane) {
    const int ls = gi == 0 ? s : (gi == 1 ? s - 12 : s - 18);
    const int sh = 2 * gi, Lg = SEQL >> sh;
    const int uA = ((256 * blk) >> sh) - 64 + 32 * ls;
    const int qi = lane & 15, quad = lane >> 4;
    const int uq = (256 * blk + r + 16 * qi) >> sh;
    const int lo = max(0, uq - 64), hi = min(Lg - 1, uq + 64);
    f32x4 sA = (f32x4){0.f, 0.f, 0.f, 0.f}, sB = sA;
    sA = __builtin_amdgcn_mfma_f32_16x16x32_bf16(b.kA0, q0, sA, 0, 0, 0); sA = __builtin_amdgcn_mfma_f32_16x16x32_bf16(b.kA1, q1, sA, 0, 0, 0);
    sB = __builtin_amdgcn_mfma_f32_16x16x32_bf16(b.kB0, q0, sB, 0, 0, 0); sB = __builtin_amdgcn_mfma_f32_16x16x32_bf16(b.kB1, q1, sB, 0, 0, 0);
    const float NEGINF = -__builtin_inff();
    const unsigned span = (unsigned)(hi - lo);
    float mx = NEGINF;
#pragma unroll
    for (int j = 0; j < 4; ++j) {
        const int ua = uA + quad * 4 + j, ub = ua + 16;
        sA[j] = ((unsigned)(ua - lo) <= span) ? sA[j] : NEGINF; sB[j] = ((unsigned)(ub - lo) <= span) ? sB[j] : NEGINF;
        mx = fmaxf(mx, fmaxf(sA[j], sB[j]));
    }
    mx = quad_max(mx);
    const float mnew = fmaxf(mrun, mx), alpha = __builtin_amdgcn_exp2f(mrun - mnew);
    mrun = mnew;
    float ps = 0.f;
#pragma unroll
    for (int j = 0; j < 4; ++j) { sA[j] = __builtin_amdgcn_exp2f(sA[j] - mnew); sB[j] = __builtin_amdgcn_exp2f(sB[j] - mnew); ps += sA[j] + sB[j]; }
    lrun = lrun * alpha + ps;
    u32x4 pw; pw.x = cvt_pk_bf16(sA[0], sA[1]); pw.y = cvt_pk_bf16(sA[2], sA[3]); pw.z = cvt_pk_bf16(sB[0], sB[1]); pw.w = cvt_pk_bf16(sB[2], sB[3]);
    const bf16x8 pf = __builtin_bit_cast(bf16x8, pw);
#pragma unroll
    for (int dt = 0; dt < 4; ++dt) {
        o[dt] *= alpha;
        bf16x8 vf; vf[0] = b.vA[dt][0]; vf[1] = b.vA[dt][1]; vf[2] = b.vA[dt][2]; vf[3] = b.vA[dt][3]; vf[4] = b.vB[dt][0]; vf[5] = b.vB[dt][1]; vf[6] = b.vB[dt][2]; vf[7] = b.vB[dt][3];
#ifdef DBG_ATT2
        for (int e = 0; e < 8; ++e) o[dt][e & 3] += 1e-3f * __uint_as_float(((unsigned)(unsigned short)vf[e]) << 16);
#else
        o[dt] = __builtin_amdgcn_mfma_f32_16x16x32_bf16(vf, pf, o[dt], 0, 0, 0);
#endif
    }
}
template <int gi>
__device__ __forceinline__ void attn_compute2(const KVBuf& b, const KVBuf& c, const bf16x8 q0, const bf16x8 q1, f32x4 (&o)[4], float& mrun, float& lrun, int s, int blk, int r, int lane) {
    const int ls = gi == 0 ? s : (gi == 1 ? s - 12 : s - 18);
    const int sh = 2 * gi, Lg = SEQL >> sh;
    const int uA = ((256 * blk) >> sh) - 64 + 32 * ls;
    const int qi = lane & 15, quad = lane >> 4;
    const int uq = (256 * blk + r + 16 * qi) >> sh;
    const int lo = max(0, uq - 64), hi = min(Lg - 1, uq + 64);
    const f32x4 z4 = (f32x4){0.f, 0.f, 0.f, 0.f};
    f32x4 sA = __builtin_amdgcn_mfma_f32_16x16x32_bf16(b.kA0, q0, z4, 0, 0, 0), sB = __builtin_amdgcn_mfma_f32_16x16x32_bf16(b.kB0, q0, z4, 0, 0, 0);
    f32x4 sC = __builtin_amdgcn_mfma_f32_16x16x32_bf16(c.kA0, q0, z4, 0, 0, 0), sD = __builtin_amdgcn_mfma_f32_16x16x32_bf16(c.kB0, q0, z4, 0, 0, 0);
    sA = __builtin_amdgcn_mfma_f32_16x16x32_bf16(b.kA1, q1, sA, 0, 0, 0); sB = __builtin_amdgcn_mfma_f32_16x16x32_bf16(b.kB1, q1, sB, 0, 0, 0);
    sC = __builtin_amdgcn_mfma_f32_16x16x32_bf16(c.kA1, q1, sC, 0, 0, 0); sD = __builtin_amdgcn_mfma_f32_16x16x32_bf16(c.kB1, q1, sD, 0, 0, 0);
    const float NEGINF = -__builtin_inff();
    const unsigned span = (unsigned)(hi - lo);
    float mx = NEGINF;
#pragma unroll
    for (int j = 0; j < 4; ++j) {
        const int ua = uA + quad * 4 + j;
        sA[j] = ((unsigned)(ua - lo) <= span) ? sA[j] : NEGINF; sB[j] = ((unsigned)(ua + 16 - lo) <= span) ? sB[j] : NEGINF;
        sC[j] = ((unsigned)(ua + 32 - lo) <= span) ? sC[j] : NEGINF; sD[j] = ((unsigned)(ua + 48 - lo) <= span) ? sD[j] : NEGINF;
        mx = fmaxf(fmaxf(mx, fmaxf(sA[j], sB[j])), fmaxf(sC[j], sD[j]));
    }
    mx = quad_max(mx);
    const float mnew = fmaxf(mrun, mx), alpha = __builtin_amdgcn_exp2f(mrun - mnew);
    mrun = mnew;
    float ps = 0.f;
#pragma unroll
    for (int j = 0; j < 4; ++j) { sA[j] = __builtin_amdgcn_exp2f(sA[j] - mnew); sB[j] = __builtin_amdgcn_exp2f(sB[j] - mnew); sC[j] = __builtin_amdgcn_exp2f(sC[j] - mnew); sD[j] = __builtin_amdgcn_exp2f(sD[j] - mnew); ps += (sA[j] + sB[j]) + (sC[j] + sD[j]); }
    lrun = lrun * alpha + ps;
    u32x4 pw, pv; pw.x = cvt_pk_bf16(sA[0], sA[1]); pw.y = cvt_pk_bf16(sA[2], sA[3]); pw.z = cvt_pk_bf16(sB[0], sB[1]); pw.w = cvt_pk_bf16(sB[2], sB[3]);
    pv.x = cvt_pk_bf16(sC[0], sC[1]); pv.y = cvt_pk_bf16(sC[2], sC[3]); pv.z = cvt_pk_bf16(sD[0], sD[1]); pv.w = cvt_pk_bf16(sD[2], sD[3]);
    const bf16x8 pf = __builtin_bit_cast(bf16x8, pw), pg = __builtin_bit_cast(bf16x8, pv);
#pragma unroll
    for (int dt = 0; dt < 4; ++dt) {
        o[dt] *= alpha;
        bf16x8 vf, vg;
        vf[0] = b.vA[dt][0]; vf[1] = b.vA[dt][1]; vf[2] = b.vA[dt][2]; vf[3] = b.vA[dt][3]; vf[4] = b.vB[dt][0]; vf[5] = b.vB[dt][1]; vf[6] = b.vB[dt][2]; vf[7] = b.vB[dt][3];
        vg[0] = c.vA[dt][0]; vg[1] = c.vA[dt][1]; vg[2] = c.vA[dt][2]; vg[3] = c.vA[dt][3]; vg[4] = c.vB[dt][0]; vg[5] = c.vB[dt][1]; vg[6] = c.vB[dt][2]; vg[7] = c.vB[dt][3];
        o[dt] = __builtin_amdgcn_mfma_f32_16x16x32_bf16(vf, pf, o[dt], 0, 0, 0);
        o[dt] = __builtin_amdgcn_mfma_f32_16x16x32_bf16(vg, pg, o[dt], 0, 0, 0);
    }
}
__device__ __forceinline__ void step_attention(const Args& a, LAS unsigned char* lds, int pass, int tid, int bx) {
    unsigned char* ws = a.ws;
    const int lane = tid & 63;
    const bf16_t* Qp = (const bf16_t*)(ws + WS_Q); const bf16_t* Kp = (const bf16_t*)(ws + WS_K); const bf16_t* Vt = (const bf16_t*)(ws + WS_VT);
    const bf16_t* ZA = (const bf16_t*)(ws + WS_ZA); bf16_t* GAO = (bf16_t*)(ws + WS_GAO);
    const int xcd = bx & 7;
    unsigned* ctr = (unsigned*)(ws + WS_CTL) + 16 + pass * 8 + xcd;
    LAS unsigned* slot = (LAS unsigned*)(lds + 3 * 16384);
    constexpr int NGRP = 3 * 32 * 2;
    for (;;) {
        __syncthreads();
        if (tid == 0) slot[0] = atomicAdd(ctr, 1u);
        __syncthreads();
        const unsigned grp = (unsigned)__builtin_amdgcn_readfirstlane((int)slot[0]);
        if (grp >= (unsigned)NGRP) break;
        const int wv_ = tid >> 6; const int r = ((wv_ & 3) << 2) + (wv_ >> 2) + 2 * (int)(grp & 1)  , blk = (grp >> 1) & 31, pair = xcd * 3 + (int)(grp >> 6);
        const int h = pair & 7, sq = pair >> 3;
        const int qi = lane & 15, quad = lane >> 4;
        const int tq = sq * SEQL + 256 * blk + r + 16 * qi;
        QF qf;
        { const int pos = 256 * blk + r + 16 * qi;
          const bf16_t* qa = Qp + ((size_t)(sq * 24 + h) * SEQL + pos) * 64 + quad * 8;
          const bf16_t* qb = Qp + ((size_t)(sq * 24 + 8 + h) * SEQL + (pos & 3) * 2048 + (pos >> 2)) * 64 + quad * 8;
          const bf16_t* qc = Qp + ((size_t)(sq * 24 + 16 + h) * SEQL + (pos & 15) * 512 + (pos >> 4)) * 64 + quad * 8;
          qf.a0 = *(const bf16x8*)qa; qf.a1 = *(const bf16x8*)(qa + 32); qf.b0 = *(const bf16x8*)qb; qf.b1 = *(const bf16x8*)(qb + 32); qf.c0 = *(const bf16x8*)qc; qf.c1 = *(const bf16x8*)(qc + 32); }
        f32x4 o[4];
#pragma unroll
        for (int dt = 0; dt < 4; ++dt) o[dt] = (f32x4){0.f, 0.f, 0.f, 0.f};
        float mrun = -1e30f, lrun = 0.f;
        KVBuf b0, b1;
#define ATT_SB __builtin_amdgcn_sched_barrier(0);
        {
            const int wv = tid >> 6, region = wv >> 1;
            const bf16_t* gsrc = (region < 2 ? Kp + (size_t)(sq * 24 + h) * SEQL * 64 : Vt + (size_t)((sq * 3) * 8 + h) * 512 * 1024) + (wv & 1) * 512 + lane * 8;
            const int ubase = 256 * blk - 64 + (region & 1) * 16;
#define ATT_DMA(S) do { int uT = ubase + 32 * (S); if (uT < 0 || uT >= SEQL) uT = 0; \
                __builtin_amdgcn_global_load_lds((const unsigned*)(gsrc + (size_t)(uT >> 4) * 1024), (LAS unsigned*)(lds + (((S) >> 1) % 3) * 16384 + ((S) & 1) * 8192 + wv * 1024), 16, 0, 0); } while (0)
            ATT_DMA(0); ATT_DMA(1); ATT_DMA(2); ATT_DMA(3);
            const int kl = lane & 15;
            const unsigned foff = (unsigned)(quad * 256 + kl * 16), voff = (unsigned)(4096 + quad * 128 + kl * 8);
#pragma unroll 1
            for (int d = 0; d < 6; ++d) {
                if (d < 5) asm volatile("s_waitcnt vmcnt(2)" ::: "memory"); else asm volatile("s_waitcnt vmcnt(0)" ::: "memory");
                __syncthreads();
                if (d + 2 < 6) { ATT_DMA(2 * d + 4); ATT_DMA(2 * d + 5); }
                LAS unsigned char* kb = lds + (d % 3) * 16384;
                b0.kA0 = *(const LAS bf16x8*)(kb + foff); b0.kA1 = *(const LAS bf16x8*)(kb + foff + 1024); b0.kB0 = *(const LAS bf16x8*)(kb + 2048 + foff); b0.kB1 = *(const LAS bf16x8*)(kb + 2048 + foff + 1024);
                b1.kA0 = *(const LAS bf16x8*)(kb + 8192 + foff); b1.kA1 = *(const LAS bf16x8*)(kb + 8192 + foff + 1024); b1.kB0 = *(const LAS bf16x8*)(kb + 8192 + 2048 + foff); b1.kB1 = *(const LAS bf16x8*)(kb + 8192 + 2048 + foff + 1024);
#pragma unroll
                for (int dt = 0; dt < 4; ++dt) { b0.vA[dt] = *(const LAS bf16x4*)(kb + voff + dt * 512); b0.vB[dt] = *(const LAS bf16x4*)(kb + 2048 + voff + dt * 512);
                                                 b1.vA[dt] = *(const LAS bf16x4*)(kb + 8192 + voff + dt * 512); b1.vB[dt] = *(const LAS bf16x4*)(kb + 8192 + 2048 + voff + dt * 512); }
                attn_compute2<0>(b0, b1, qf.a0, qf.a1, o, mrun, lrun, 2 * d, blk, r, lane);
            }
#undef ATT_DMA
        }
        attn_load(b0, Kp, Vt, 12, sq, h, blk, r, lane);
#define ATT_LOOP(GI, S0, S1, QA, QB) _Pragma("unroll 1") for (int s = S0; s < S1; s += 2) { \
            ATT_SB attn_load(b1, Kp, Vt, s + 1, sq, h, blk, r, lane); ATT_SB attn_compute<GI>(b0, QA, QB, o, mrun, lrun, s, blk, r, lane); \
            ATT_SB attn_load(b0, Kp, Vt, s + 2, sq, h, blk, r, lane); ATT_SB attn_compute<GI>(b1, QA, QB, o, mrun, lrun, s + 1, blk, r, lane); ATT_SB }
        ATT_LOOP(1, 12, 18, qf.b0, qf.b1)
        ATT_LOOP(2, 18, 22, qf.c0, qf.c1)
#undef ATT_LOOP
        attn_compute<2>(b0, qf.c0, qf.c1, o, mrun, lrun, 22, blk, r, lane);
        const float l = quad_sum(lrun);
        float inv = 1.0f / l;
#ifdef DBG_ATT1
        for (int dt = 0; dt < 4; ++dt) o[dt] = (f32x4){1.f, 1.f, 1.f, 1.f};
#endif
#pragma unroll
        for (int dt = 0; dt < 4; ++dt) {
            const size_t off = (size_t)tq * 512 + h * 64 + 16 * dt + 4 * quad;
            const u32x2 z = *(const u32x2*)(ZA + off);
            u32x2 w; w.x = cvt_pk_bf16(o[dt][0] * inv * bf_lo(z.x), o[dt][1] * inv * bf_hi(z.x)); w.y = cvt_pk_bf16(o[dt][2] * inv * bf_lo(z.y), o[dt][3] * inv * bf_hi(z.y));
            *(u32x2*)(GAO + off) = w;
        }
    }
}

__device__ __forceinline__ f32x2 cmul(f32x2 a, f32x2 b) { return (f32x2){a.x * b.x - a.y * b.y, a.x * b.y + a.y * b.x}; }
__device__ __forceinline__ void step_scan(const Args& a, LAS unsigned char* lds, int tid, int it0, int it1, int itstep) {
    unsigned char* ws = a.ws; const int G = gridDim.x;
    const float* PW = (const float*)(ws + WS_PW); const float* S = (const float*)(ws + WS_S); bf16_t* UH = (bf16_t*)(ws + WS_UH);
    LAS f32x2* carry = (LAS f32x2*)lds;
    for (int it = it0; it < it1; it += itstep) {
        const int dir = it & 1, g = (it >> 1) & 31, sq = it >> 6; const int seg = tid >> 6, n = tid & 63;
        const f32x2 P = (f32x2){PW[((dir * 32 + g) * 64 + n) * 2], PW[((dir * 32 + g) * 64 + n) * 2 + 1]};
        f32x2 z[32];
        { const int c0 = dir ? (NCH - 1 - seg * 32) : seg * 32; const long stp = dir ? -256 : 256;
          const float* sp = S + ((size_t)g * CHP + sq * NCH + c0) * 256 + dir * 128 + n;
#pragma unroll
          for (int i = 0; i < 32; ++i) { z[i] = (f32x2){sp[0], sp[64]}; sp += stp; } }
        f32x2 zz = (f32x2){0.f, 0.f};
#pragma unroll
        for (int i = 0; i < 32; ++i) { const f32x2 t = z[i]; z[i] = zz; zz = cmul(P, zz) + t; }
        __syncthreads();
        carry[seg * 64 + n] = zz;
        __syncthreads();
        f32x2 P32 = P;
#pragma unroll
        for (int k = 0; k < 5; ++k) P32 = cmul(P32, P32);
        f32x2 x = (f32x2){0.f, 0.f};
        for (int sp = 0; sp < seg; ++sp) x = cmul(P32, x) + carry[sp * 64 + n];
        f32x2 pwr = (f32x2){1.f, 0.f};
        { const int c0 = dir ? (NCH - 1 - seg * 32) : seg * 32; const long stp = dir ? -(long)UHK : (long)UHK;
          bf16_t* up = UH + ((size_t)g * CHP + sq * NCH + c0) * UHK + 512 + dir * 128 + n;
#pragma unroll
          for (int i = 0; i < 32; ++i) {
              const f32x2 hin = z[i] + cmul(pwr, x);
              up[0] = (bf16_t)(cvt_pk_bf16(hin.x, 0.f) & 0xffffu); up[64] = (bf16_t)(cvt_pk_bf16(hin.y, 0.f) & 0xffffu);
              pwr = cmul(pwr, P); up += stp;
          } }
    }
}

__device__ __forceinline__ void step_final_norm(const Args& a, int pass, int tid, int bx) {
    const int lane = tid & 63, wave = tid >> 6, G = gridDim.x;
    const f32x4* gr = (const f32x4*)a.in[16] + lane;
    f32x4 gv[4];
#pragma unroll
    for (int j = 0; j < 4; ++j) gv[j] = gr[64 * j];
    const bf16_t* accp = (const bf16_t*)(a.ws + WS_ACC);
    int row = bx * 8 + wave;
    f32x4 nx[4]; u32x2 na[4];
    if (row < TP) { const f32x4* xr = (const f32x4*)xrow_ptr(a.in[0], a.in[1], pass * TP + row) + lane; const u32x2* ar = (const u32x2*)(accp + (size_t)row * DM) + lane;
#pragma unroll
        for (int j = 0; j < 4; ++j) { nx[j] = xr[64 * j]; na[j] = ar[64 * j]; } }
    for (; row < TP; row += G * 8) {
        f32x4 v[4];
#pragma unroll
        for (int j = 0; j < 4; ++j) v[j] = nx[j] + (f32x4){bf_lo(na[j].x), bf_hi(na[j].x), bf_lo(na[j].y), bf_hi(na[j].y)};
        const int nrow = row + G * 8;
        if (nrow < TP) { const f32x4* xn = (const f32x4*)xrow_ptr(a.in[0], a.in[1], pass * TP + nrow) + lane; const u32x2* an = (const u32x2*)(accp + (size_t)nrow * DM) + lane;
#pragma unroll
            for (int j = 0; j < 4; ++j) { nx[j] = xn[64 * j]; na[j] = an[64 * j]; } }
        float s = 0.f;
#pragma unroll
        for (int j = 0; j < 4; ++j) s += (v[j].x * v[j].x + v[j].y * v[j].y) + (v[j].z * v[j].z + v[j].w * v[j].w);
        const float rstd = 1.0f / sqrtf(wave_sum(s) * (1.f / DM) + EPSN);
        f32x4* xr = (f32x4*)(a.out + (size_t)(pass * TP + row) * DM) + lane;
#pragma unroll
        for (int j = 0; j < 4; ++j) xr[64 * j] = v[j] * rstd * gv[j];
    }
}


#define XB_TMO      128
#define XB_XCNT(j)  (256  + 64 * (j))
#define XB_XSUB(j)  (1280 + 64 * (j))
#define XB_XGEN(j)  (2304 + 64 * (j))
#define XB_TOP      3328
#define XB_TOPGEN   3392
#define XCD_BAR_WORDS 3456
#define XB_SLOT(b)  (4096 + 2 * (b))
#define XB_SPIN_CAP (1u << 18)
__device__ __forceinline__ unsigned xb_ld(unsigned* p)              { return __hip_atomic_load(p, __ATOMIC_RELAXED, __HIP_MEMORY_SCOPE_AGENT); }
__device__ __forceinline__ unsigned xb_add(unsigned* p, unsigned v) { return __hip_atomic_fetch_add(p, v, __ATOMIC_RELAXED, __HIP_MEMORY_SCOPE_AGENT); }
__device__ __forceinline__ unsigned xb_xcc_id() { return (unsigned)__builtin_amdgcn_s_getreg((3 << 11) | 20) & 0xFu; }
#define XB_SPIN(cond, bar) do { unsigned _sp = 0; while (cond) { __builtin_amdgcn_s_sleep(1); \
    if ((++_sp & 255u) == 0u) { if (xb_ld(&(bar)[XB_TMO])) break; if (_sp > XB_SPIN_CAP) { atomicAdd(&(bar)[XB_TMO], 1u); break; } } } } while (0)
__device__ __forceinline__ void xcd_barrier_complete(unsigned* bar, unsigned x, unsigned& nloc, unsigned& nx) {
    const unsigned G = gridDim.x;
    unsigned sum, cnt, mine, sp = 0u;
    for (;;) {
        sum = 0u; cnt = 0u; mine = 0u;
#pragma unroll
        for (unsigned j = 0; j < 16; ++j) { const unsigned c = xb_ld(&bar[XB_XCNT(j)]); sum += c; cnt += (c > 0u) ? 1u : 0u; mine = (j == x) ? c : mine; }
        if (sum == G) break;
        __builtin_amdgcn_s_sleep(1);
        if ((++sp & 255u) == 0u) { if (xb_ld(&bar[XB_TMO])) break; if (sp > XB_SPIN_CAP) { atomicAdd(&bar[XB_TMO], 1u); break; } }
    }
    nloc = mine > 0u ? mine : 1u; nx = cnt > 0u ? cnt : 1u;
}
__device__ __forceinline__ void xcd_barrier(unsigned* bar) {
    asm volatile("s_waitcnt vmcnt(0)" ::: "memory");
    __syncthreads();
    if (threadIdx.x == 0) {
        __builtin_amdgcn_s_waitcnt(0);
        const unsigned x = xb_xcc_id();
        unsigned* slot = bar + XB_SLOT(blockIdx.x);
        unsigned nloc = xb_ld(slot), nx = xb_ld(slot + 1);
        if (nloc == 0u) { xcd_barrier_complete(bar, x, nloc, nx); __hip_atomic_store(slot, nloc, __ATOMIC_RELAXED, __HIP_MEMORY_SCOPE_AGENT); __hip_atomic_store(slot + 1, nx, __ATOMIC_RELAXED, __HIP_MEMORY_SCOPE_AGENT); }
        const unsigned old = xb_add(&bar[XB_XSUB(x)], 1u);
        const unsigned gen = old / nloc;
        if (old + 1u == (gen + 1u) * nloc) {
            __builtin_amdgcn_fence(__ATOMIC_RELEASE, "agent");
            asm volatile("s_waitcnt vmcnt(0)" ::: "memory");
            const unsigned og = xb_add(&bar[XB_TOP], 1u);
            const unsigned tg = og / nx;
            if (og + 1u == (tg + 1u) * nx) xb_add(&bar[XB_TOPGEN], 1u);
            else XB_SPIN(xb_ld(&bar[XB_TOPGEN]) == tg, bar);
            __builtin_amdgcn_fence(__ATOMIC_ACQUIRE, "agent");
            xb_add(&bar[XB_XGEN(x)], 1u);
            asm volatile("s_waitcnt vmcnt(0)" ::: "memory");
        } else {
            XB_SPIN(xb_ld(&bar[XB_XGEN(x)]) == gen, bar);
            __builtin_amdgcn_fence(__ATOMIC_ACQUIRE, "agent");
            asm volatile("s_waitcnt vmcnt(0)" ::: "memory");
        }
    }
    __syncthreads();
}

constexpr int NSTEPS = 1 + 10 * NPASS;
__host__ __device__ __forceinline__ bool sync_after(int st) { if (st == 0) return true; const int k = (st - 1) % 10; return !(k == 1 || k == 6 || k == 9); }

__global__ void __launch_bounds__(512, 2) fwd_kernel(Args a) {
    extern __shared__ __attribute__((aligned(16))) unsigned char lds_raw[];
    LAS unsigned char* lds = (LAS unsigned char*)lds_raw;
    cg::grid_group grid = cg::this_grid();
    const int G = gridDim.x;
    unsigned char* ws = a.ws;
    unsigned* bar = (unsigned*)(ws + WS_BAR);
    if (a.do_sync == 2) grid.sync();
    if (a.do_sync && threadIdx.x == 0) (void)xb_add(&bar[XB_XCNT(xb_xcc_id())], 1u);
    for (int st = a.st_lo; st < a.st_hi; ++st) {
        int tid = threadIdx.x, bx = blockIdx.x;
        asm volatile("" : "+v"(tid), "+s"(bx));
#ifndef NO_SETUP
        if (st == 0) { step_setup(a, lds, tid, bx); }
#else
        if (st == 0) {}
#endif
        else {
            const int pass = (st - 1) / 10, k = (st - 1) % 10;
            GemmD g; g.lgnN = 0; g.pass = pass; g.nb = 1; g.sA = 0; g.sB = 0;
            bool has_gemm = true;
            const bool split_ay = (G == 256);
            switch (k) {
            case 0: g.A = (const bf16_t*)((unsigned char*)a.out + OUT_HN_OFF) + (size_t)pass * TP * DM; g.lda = DM; g.Bt = (const bf16_t*)(ws + WS_WIN); g.ldb = DM; g.K = DM; g.nM = TP / BM; g.nN = INC / BM; g.lgnN = 5; g.mode = MODE_PROJ; break;
            case 1: g.A = (const bf16_t*)(ws + WS_UH); g.lda = UHK; g.sA = (unsigned)(CHP * UHK * 2); g.Bt = (const bf16_t*)(ws + WS_BST); g.ldb = 512; g.sB = (unsigned)(256 * 512 * 2); g.K = 512; g.nM = CHP / BM; g.nN = 1; g.nb = 32; g.mode = MODE_S; break;
            case 4:
                if (split_ay && bx < 128) { g.A = (const bf16_t*)(ws + WS_GAO); g.lda = 512; g.Bt = (const bf16_t*)(ws + WS_WA); g.ldb = 512; g.K = 512; g.nM = TP / BM; g.nN = 4; g.lgnN = 2; g.mode = MODE_A; }
                else { g.A = (const bf16_t*)(ws + WS_UH); g.lda = UHK; g.sA = (unsigned)(CHP * UHK * 2); g.Bt = (const bf16_t*)(ws + WS_MTC); g.ldb = UHK; g.sB = (unsigned)(512 * UHK * 2); g.K = UHK; g.nM = CHP / BM; g.nN = 2; g.nb = 32; g.mode = MODE_Y; }
                break;
            case 5: g.A = (const bf16_t*)(ws + WS_SG); g.lda = 512; g.Bt = (const bf16_t*)(ws + WS_WGLU); g.ldb = 512; g.K = 512; g.nM = TP / BM; g.nN = 2; g.lgnN = 1; g.mode = MODE_GLU; break;
            case 6: if (split_ay) { has_gemm = false; g.A = nullptr; g.Bt = nullptr; g.lda = g.ldb = g.K = 0; g.nM = g.nN = 0; g.mode = 0; } else { g.A = (const bf16_t*)(ws + WS_GAO); g.lda = 512; g.Bt = (const bf16_t*)(ws + WS_WA); g.ldb = 512; g.K = 512; g.nM = TP / BM; g.nN = 4; g.lgnN = 2; g.mode = MODE_A; } break;
            case 7: g.A = (const bf16_t*)(ws + WS_SB); g.lda = 512; g.Bt = (const bf16_t*)(ws + WS_WB); g.ldb = 512; g.K = 512; g.nM = TP / BM; g.nN = 4; g.lgnN = 2; g.mode = MODE_B; break;
            case 8: g.A = (const bf16_t*)(ws + WS_M1); g.lda = 1024; g.Bt = (const bf16_t*)(ws + WS_WOUT); g.ldb = 1024; g.K = 1024; g.nM = TP / BM; g.nN = 4; g.lgnN = 2; g.mode = MODE_OUT; break;
            default: has_gemm = false; g.A = nullptr; g.Bt = nullptr; g.lda = g.ldb = g.K = 0; g.nM = g.nN = 0; g.mode = 0; break;
            }
            { const int total = g.nM * g.nN * g.nb; g.u0 = bx; g.ustride = G; g.ucount = total > bx ? (total - bx + G - 1) / G : 0; }
            if (k == 4 && split_ay) { if (bx < 128) { g.u0 = bx; g.ustride = 128; g.ucount = 3; } else { g.u0 = bx - 128; g.ustride = 128; g.ucount = (bx - 128) < 64 ? 2 : 1; } }
            const bool fuse_scan = (G >= SEQP * 32);
            if (has_gemm) {
#ifndef NO_GEMM
                gemm_phase(a, lds, g, G, bx, tid);
#endif
#ifndef NO_SCAN
                if (k == 1 && fuse_scan && bx < SEQP * 32) {
                    asm volatile("s_waitcnt vmcnt(0)" ::: "memory"); __syncthreads();
                    const int it0 = (bx % SEQP) * 64 + (bx / SEQP) * 2;
                    step_scan(a, lds, tid, it0, it0 + 2, 1);
                }
#endif
            }
#ifndef NO_ATTN
            else if (k == 2) step_attention(a, lds, pass, tid, bx);
#endif
#ifndef NO_SCAN
            else if (k == 3 && !fuse_scan) step_scan(a, lds, tid, bx, SEQP * 32 * 2, G);
#endif
            else if (k == 9) step_final_norm(a, pass, tid, bx);
        }
        if (a.do_sync && st + 1 < a.st_hi && sync_after(st) && !(st > 0 && (st - 1) % 10 == 3 && G >= SEQP * 32)) xcd_barrier(bar);
    }
}

extern "C" void kernel_launch(void* const* d_in, const int* in_sizes, int n_in, void* d_out, int out_size, void* d_ws, size_t ws_size, hipStream_t stream) {
    constexpr int LDS_BYTES = STAGE_BYTES + 32768;
    static int grid = 0;
    if (grid == 0) {
        if (n_in != 17 || out_size != TTOK * DM || ws_size < WS_END) { fprintf(stderr, "kernel_launch: unexpected shapes (n_in %d out %d ws %zu need %zu)\n", n_in, out_size, ws_size, (size_t)WS_END); grid = -1; return; }
        int dev = 0, cus = 0, per_cu = 0;
        hipGetDevice(&dev); hipDeviceGetAttribute(&cus, hipDeviceAttributeMultiprocessorCount, dev);
        hipFuncSetAttribute((const void*)fwd_kernel, hipFuncAttributeMaxDynamicSharedMemorySize, LDS_BYTES);
        hipOccupancyMaxActiveBlocksPerMultiprocessor(&per_cu, (const void*)fwd_kernel, 512, LDS_BYTES);
        if (per_cu < 1) per_cu = 1;
        grid = cus * 1;
        (void)hipGetLastError();
    }
    if (grid < 0) return;
    (void)hipMemsetAsync((unsigned char*)d_ws + WS_BAR, 0, WS_BAR_BYTES + 4096, stream);
    Args a{};
    for (int i = 0; i < 17; ++i) a.in[i] = (const float*)d_in[i];
    a.out = (float*)d_out; a.ws = (unsigned char*)d_ws; a.pad = 0;
#ifndef MULTI_LAUNCH
#define MULTI_LAUNCH 0
#endif
#if MULTI_LAUNCH
    a.do_sync = 0;
    for (int st = 0; st < NSTEPS; ++st) {
        a.st_lo = st; a.st_hi = st + 1;
        hipLaunchKernelGGL(fwd_kernel, dim3(grid), dim3(512), LDS_BYTES, stream, a);
    }
#else
    a.do_sync = 1; a.st_lo = 0; a.st_hi = NSTEPS;
    void* args[] = {&a};
    hipError_t e = hipLaunchCooperativeKernel((const void*)fwd_kernel, dim3(grid), dim3(512), args, LDS_BYTES, stream);
    if (e != hipSuccess) fprintf(stderr, "cooperative launch failed: %s (grid %d)\n", hipGetErrorString(e), grid);
#endif
}
```

```cpp
#include <hip/hip_runtime.h>
#include <hip/hip_cooperative_groups.h>
#include <cstdio>

namespace cg = cooperative_groups;

#define LAS __attribute__((address_space(3)))
typedef unsigned short bf16_t;
typedef short bf16x8 __attribute__((ext_vector_type(8)));
typedef short bf16x4 __attribute__((ext_vector_type(4)));
typedef float f32x4 __attribute__((ext_vector_type(4)));
typedef float f32x2 __attribute__((ext_vector_type(2)));
typedef unsigned u32x4 __attribute__((ext_vector_type(4)));
typedef unsigned u32x2 __attribute__((ext_vector_type(2)));

constexpr int DM = 1024, SEQL = 8192, NSEQ = 6, TTOK = NSEQ * SEQL;
constexpr int NPASS = 2, SEQP = 3, TP = SEQP * SEQL;
constexpr int INC = 8192, QKVW = 1536;
constexpr int LC = 32, NCH = SEQL / LC  , CHP = SEQP * NCH  ;
constexpr int UHK = LC * 16 + 256;
constexpr float EPSN = 1e-6f;
constexpr float QSCALE = 0.18033688011112042f;

constexpr size_t AL(size_t x) { return (x + 255) & ~(size_t)255; }
constexpr size_t WS_WIN = 4096;
constexpr size_t WS_WGLU = WS_WIN + (size_t)INC * DM * 2;
constexpr size_t WS_WA = WS_WGLU + (size_t)512 * 512 * 2;
constexpr size_t WS_WB = WS_WA + (size_t)1024 * 512 * 2;
constexpr size_t WS_WOUT = WS_WB + (size_t)1024 * 512 * 2;
constexpr size_t WS_MTC = WS_WOUT + (size_t)1024 * 1024 * 2;
constexpr size_t WS_BST = WS_MTC + (size_t)32 * 512 * UHK * 2;
constexpr size_t WS_ROPE = WS_BST + (size_t)32 * 256 * 512 * 2;
constexpr size_t WS_PW = WS_ROPE + (size_t)2 * SEQL * 32 * 4;
constexpr size_t WS_KT = WS_PW + (size_t)2 * 32 * 64 * 8;
constexpr size_t WS_Q = WS_KT + (size_t)32 * 2 * 32 * 256 * 4;
constexpr size_t WS_K = WS_Q + (size_t)TP * QKVW * 2;
constexpr size_t WS_VT = WS_K + (size_t)TP * QKVW * 2;
constexpr size_t WS_ZA = WS_VT + (size_t)TP * QKVW * 2;
constexpr size_t WS_ZB = WS_ZA + (size_t)TP * 512 * 2;
constexpr size_t WS_GA = WS_ZB + (size_t)TP * 512 * 2;
constexpr size_t WS_GB = WS_GA + (size_t)TP * 1024 * 2;
constexpr size_t WS_UH = WS_GB + (size_t)TP * 1024 * 2;
constexpr size_t WS_S = WS_UH + (size_t)32 * CHP * UHK * 2;
constexpr size_t WS_GAO = WS_S + (size_t)32 * CHP * 256 * 4;
constexpr size_t WS_BAR = WS_GAO + (size_t)TP * 512 * 2;
constexpr size_t WS_BAR_BYTES = 32768;
constexpr size_t WS_CTL = WS_BAR + WS_BAR_BYTES;
constexpr size_t WS_END = WS_CTL + 4096;
constexpr size_t WS_SB = WS_Q + (size_t)TP * 512 * 2;
constexpr size_t WS_M1 = WS_K;
constexpr size_t WS_ACC = WS_Q;
constexpr size_t OUT_HN_OFF = (size_t)SEQP * SEQL * DM * 4;

struct Args {
    const float* in[17];
    float* out;
    unsigned char* ws;
    int st_lo, st_hi;
    int do_sync, pad;
};

typedef __bf16 bf16v2 __attribute__((ext_vector_type(2)));
__device__ __forceinline__ unsigned cvt_pk_bf16(float lo, float hi) { const f32x2 v = (f32x2){lo, hi}; const bf16v2 r = __builtin_convertvector(v, bf16v2); return __builtin_bit_cast(unsigned, r); }
__device__ __forceinline__ float bf_lo(unsigned w) { return __uint_as_float(w << 16); }
__device__ __forceinline__ float bf_hi(unsigned w) { return __uint_as_float(w & 0xffff0000u); }
__device__ __forceinline__ float fast_rcp(float x) { return __builtin_amdgcn_rcpf(x); }
__device__ __forceinline__ float sigmoidf_(float x) { return fast_rcp(1.0f + __builtin_amdgcn_exp2f(-1.4426950408889634f * x)); }
__device__ __forceinline__ float siluf_(float x) { return x * sigmoidf_(x); }
__device__ __forceinline__ float gelu_tanh(float x) { const float u = x * (1.5957691216057308f + 0.07135481627260025f * x * x); return x * sigmoidf_(u); }
__device__ __forceinline__ float wave_sum(float v) {
#pragma unroll
    for (int o = 1; o < 64; o <<= 1) v += __shfl_xor(v, o);
    return v;
}
__device__ __forceinline__ const float* xrow_ptr(const float* xp, const float* xs, int tg) {
    return tg < 4 * SEQL ? xp + (size_t)tg * DM : xs + (size_t)(tg - 4 * SEQL) * DM;
}

constexpr int BM = 256, BK = 64, HALF = 128, HTB = HALF * BK * 2, STAGE_BYTES = 8 * HTB, NXCD = 8, WGM = 8;
__host__ __device__ __forceinline__ int lds_byte(int r, int c) { const int st = (r >> 4) * 2 + (c >> 5), rr = r & 15, cc = c & 31, ob = rr * 64 + cc * 2; return st * 1024 + (ob ^ (((ob >> 9) & 1) << 5)); }
__host__ __device__ __forceinline__ void stage_rc(int b, int& R, int& C) { const int st = b / 1024, sb = b % 1024, swz = sb ^ (((sb >> 9) & 1) << 5); R = (st >> 1) * 16 + swz / 64; C = (st & 1) * 32 + (swz % 64) / 2; }
__host__ __device__ __forceinline__ int perm32(int rho) { const int n = rho >> 4, i = rho & 15; return 8 * (i >> 2) + 4 * n + (i & 3); }

enum { MODE_PROJ = 0, MODE_S = 1, MODE_Y = 2, MODE_GLU = 3, MODE_A = 4, MODE_B = 5, MODE_OUT = 6 };
struct Unit { int pm, pn, bz; };
struct GemmD {
    const bf16_t* A; const bf16_t* Bt;
    int lda, ldb, K, nM, nN, nb;
    unsigned sA, sB;
    int mode, pass, lgnN;
    int u0, ustride, ucount;
};
__device__ __forceinline__ bool unit_next(const GemmD& g, int i, int G, int c, int& pm, int& pn, int& bz) {
    const bool ok = i < g.ucount;
    const int Li = ok ? g.u0 + i * g.ustride : 0;
    if (g.nb == 1) {
        const int lg = g.lgnN, q = (g.nM << lg) >> 3;
        const int wgid = (Li & 7) * q + (Li >> 3);
        const int gid = wgid >> (3 + lg), rem = wgid & ((8 << lg) - 1);
        pm = gid * 8 + (rem & 7); pn = rem >> 3; bz = 0;
    } else {
        const int nwg = g.nM * g.nN;
        const int w = Li % nwg; bz = Li / nwg; pm = w % g.nM; pn = w / g.nM;
    }
    return ok;
}

__device__ __forceinline__ void epilogue(const Args& a, LAS unsigned char* lds, const GemmD& g, const f32x4 (&acc)[2][2][4][2], const Unit& u, int wr, int wc, int fr, int fq) {
    asm volatile("" : "+v"(fr), "+v"(fq));
    unsigned char* ws = a.ws;
    const int rbase = u.pm * BM + wr * 64 + fr;
    const int cl = wc * 32 + fq * 8;
    if (g.mode == MODE_PROJ) {
        const int pn = u.pn;
        if (pn < 12) {
            const bool isq = pn < 6;
            bf16_t* dst = (bf16_t*)(ws + (isq ? WS_Q : WS_K));
            const float* rc = (const float*)(ws + WS_ROPE); const float* rs = rc + SEQL * 32;
            const int a4 = 4 * (4 * (wc & 1) + fq);
            const int pq = isq ? pn : pn - 6, gi = pq >> 1, sh = 2 * gi, dmask = (1 << sh) - 1, Lg = SEQL >> sh;
            const float sc = isq ? QSCALE : 1.0f;
#pragma unroll
            for (int ai = 0; ai < 2; ++ai) {
                asm volatile("" ::: "memory");
                f32x4 cvv[4], svv[4];
#pragma unroll
                for (int m = 0; m < 4; ++m) { const int pos = (rbase + ai * HALF + m * 16) & (SEQL - 1); cvv[m] = *(const f32x4*)(rc + pos * 32 + a4); svv[m] = *(const f32x4*)(rs + pos * 32 + a4); }
#pragma unroll
                for (int m = 0; m < 4; ++m) {
                    const int tl = rbase + ai * HALF + m * 16; const int pos = tl & (SEQL - 1), sq = tl >> 13;
                    const int kidx = (pos & dmask) * Lg + (pos >> sh);
                    const f32x4 cv = cvv[m] * sc, sv = svv[m] * sc;
#pragma unroll
                    for (int bj = 0; bj < 2; ++bj) {
                        const f32x4 x1 = acc[ai][bj][m][0], x2 = acc[ai][bj][m][1];
                        const f32x4 o1 = x1 * cv - x2 * sv, o2 = x2 * cv + x1 * sv;
                        const int head = pq * 4 + 2 * bj + (wc >> 1);
                        const int ch = 4 * (wc & 1) + fq;
                        bf16_t* p = dst + (size_t)(sq * 24 + head) * SEQL * 64 + (isq ? (size_t)kidx * 64 + ch * 8 : (size_t)(kidx >> 4) * 1024 + ch * 128 + (kidx & 15) * 8);
                        u32x4 w; w.x = cvt_pk_bf16(o1[0], o1[1]); w.y = cvt_pk_bf16(o1[2], o1[3]); w.z = cvt_pk_bf16(o2[0], o2[1]); w.w = cvt_pk_bf16(o2[2], o2[3]);
                        *(u32x4*)p = w;
                    }
                }
            }
        } else if (pn < 18) {
            bf16_t* dst = (bf16_t*)(ws + WS_VT);
            const int gi = (pn - 12) >> 1, sh = 2 * gi;
            const int wid = wr * 4 + wc, lane = fq * 16 + fr;
            LAS bf16_t* tile = (LAS bf16_t*)(lds + STAGE_BYTES + wid * 4096);
#pragma unroll
            for (int ai = 0; ai < 2; ++ai) {
                const int tl0 = u.pm * BM + wr * 64 + ai * HALF;
                const int pos0 = tl0 & (SEQL - 1), sq = tl0 >> 13;
#pragma unroll
                for (int bj = 0; bj < 2; ++bj) {
                    asm volatile("" ::: "memory");
                    const int h = (4 * (pn - 12) + 2 * bj + (wc >> 1)) & 7;
#pragma unroll
                    for (int m = 0; m < 4; ++m) {
                        const int t = 16 * m + fr;
                        const int slot = gi == 0 ? t : (gi == 1 ? ((t & 3) * 16 + (t >> 2)) : ((t & 15) * 4 + (t >> 4)));
#pragma unroll
                        for (int n = 0; n < 2; ++n)
#pragma unroll
                            for (int j = 0; j < 4; ++j) { const unsigned w = cvt_pk_bf16(acc[ai][bj][m][n][j], 0.f); tile[(8 * fq + 4 * n + j) * 64 + slot] = (bf16_t)(w & 0xffffu); }
                    }
                    bf16_t* hb0 = dst + (size_t)(((sq * 3 + gi) * 8 + h) * 512) * 1024;
#pragma unroll
                    for (int i = 0; i < 4; ++i) {
                        const int c = lane + 64 * i, d = c >> 3, s8 = (c & 7) * 8;
                        const u32x4 v = *(const LAS u32x4*)(tile + d * 64 + s8);
                        const int dg = 32 * (wc & 1) + d; const int doff = (dg >> 4) * 256 + (dg & 15) * 4;
                        if (gi == 0) { const int kidx = pos0 + s8; bf16_t* q = hb0 + (size_t)(kidx >> 4) * 1024 + doff + ((kidx & 15) >> 2) * 64; *(u32x2*)q = (u32x2){v.x, v.y}; *(u32x2*)(q + 64) = (u32x2){v.z, v.w}; }
                        else if (gi == 1) { const int kidx = (s8 >> 4) * 2048 + (pos0 >> 2) + (s8 & 15); bf16_t* q = hb0 + (size_t)(kidx >> 4) * 1024 + doff + ((kidx & 15) >> 2) * 64; *(u32x2*)q = (u32x2){v.x, v.y}; *(u32x2*)(q + 64) = (u32x2){v.z, v.w}; }
                        else { const int ka = (s8 >> 2) * 512 + (pos0 >> 4), kb = ka + 512;
                            *(u32x2*)(hb0 + (size_t)(ka >> 4) * 1024 + doff + ((ka & 15) >> 2) * 64) = (u32x2){v.x, v.y}; *(u32x2*)(hb0 + (size_t)(kb >> 4) * 1024 + doff + ((kb & 15) >> 2) * 64) = (u32x2){v.z, v.w}; }
                    }
                }
            }
        } else if (pn == 20 || pn == 21) {
            bf16_t* dst = (bf16_t*)(ws + WS_UH);
#pragma unroll
            for (int ai = 0; ai < 2; ++ai)
#pragma unroll
                for (int m = 0; m < 4; ++m) { asm volatile("" ::: "memory");
                    const int tl = rbase + ai * HALF + m * 16;
#pragma unroll
                    for (int bj = 0; bj < 2; ++bj) {
                        const int gg = 16 * (pn - 20) + 8 * bj + 2 * wc + (fq >> 1);
                        bf16_t* p = dst + ((size_t)(gg * CHP + (tl >> 5)) * UHK) + (tl & 31) * 16 + 8 * (fq & 1);
                        const f32x4 v0 = acc[ai][bj][m][0], v1 = acc[ai][bj][m][1];
                        u32x4 w; w.x = cvt_pk_bf16(v0[0], v0[1]); w.y = cvt_pk_bf16(v0[2], v0[3]); w.z = cvt_pk_bf16(v1[0], v1[1]); w.w = cvt_pk_bf16(v1[2], v1[3]);
                        *(u32x4*)p = w;
                    }
                }
        } else {
            bf16_t* dst; int ld, c0; bool silu;
            if (pn < 20) { dst = (bf16_t*)(ws + WS_ZA); ld = 512; c0 = (pn - 18) * 256; silu = true; }
            else if (pn < 24) { dst = (bf16_t*)(ws + WS_ZB); ld = 512; c0 = (pn - 22) * 256; silu = true; }
            else if (pn < 28) { dst = (bf16_t*)(ws + WS_GA); ld = 1024; c0 = (pn - 24) * 256; silu = false; }
            else { dst = (bf16_t*)(ws + WS_GB); ld = 1024; c0 = (pn - 28) * 256; silu = false; }
#pragma unroll
            for (int ai = 0; ai < 2; ++ai)
#pragma unroll
                for (int m = 0; m < 4; ++m) { asm volatile("" ::: "memory");
                    const int tl = rbase + ai * HALF + m * 16;
#pragma unroll
                    for (int bj = 0; bj < 2; ++bj) {
                        f32x4 v0 = acc[ai][bj][m][0], v1 = acc[ai][bj][m][1];
#pragma unroll
                        for (int j = 0; j < 4; ++j) { const float s0 = sigmoidf_(v0[j]), s1 = sigmoidf_(v1[j]); v0[j] = silu ? v0[j] * s0 : s0; v1[j] = silu ? v1[j] * s1 : s1; }
                        u32x4 w; w.x = cvt_pk_bf16(v0[0], v0[1]); w.y = cvt_pk_bf16(v0[2], v0[3]); w.z = cvt_pk_bf16(v1[0], v1[1]); w.w = cvt_pk_bf16(v1[2], v1[3]);
                        *(u32x4*)(dst + (size_t)tl * ld + c0 + cl + bj * HALF) = w;
                    }
                }
        }
    } else if (g.mode == MODE_S) {
        float* dst = (float*)(ws + WS_S) + (size_t)u.bz * CHP * 256;
#pragma unroll
        for (int ai = 0; ai < 2; ++ai)
#pragma unroll
            for (int m = 0; m < 4; ++m) { asm volatile("" ::: "memory");
                const int r = rbase + ai * HALF + m * 16;
#pragma unroll
                for (int bj = 0; bj < 2; ++bj) { float* p = dst + (size_t)r * 256 + cl + bj * HALF; *(f32x4*)p = acc[ai][bj][m][0]; *(f32x4*)(p + 4) = acc[ai][bj][m][1]; }
            }
    } else if (g.mode == MODE_Y) {
        bf16_t* dst = (bf16_t*)((unsigned char*)a.out + OUT_HN_OFF) + (size_t)g.pass * TP * DM;
#pragma unroll
        for (int ai = 0; ai < 2; ++ai)
#pragma unroll
            for (int m = 0; m < 4; ++m) { asm volatile("" ::: "memory");
                const int r = rbase + ai * HALF + m * 16;
#pragma unroll
                for (int bj = 0; bj < 2; ++bj) {
                    const int t = 16 * u.pn + 8 * bj + 2 * wc + (fq >> 1);
                    f32x4 v0 = acc[ai][bj][m][0], v1 = acc[ai][bj][m][1];
#pragma unroll
                    for (int j = 0; j < 4; ++j) { v0[j] = gelu_tanh(v0[j]); v1[j] = gelu_tanh(v1[j]); }
                    u32x4 w; w.x = cvt_pk_bf16(v0[0], v0[1]); w.y = cvt_pk_bf16(v0[2], v0[3]); w.z = cvt_pk_bf16(v1[0], v1[1]); w.w = cvt_pk_bf16(v1[2], v1[3]);
                    *(u32x4*)(dst + (size_t)(r * LC + t) * 512 + u.bz * 16 + 8 * (fq & 1)) = w;
                }
            }
    } else if (g.mode == MODE_GLU) {
        const bf16_t* sg = (const bf16_t*)((unsigned char*)a.out + OUT_HN_OFF) + (size_t)g.pass * TP * DM; const bf16_t* zb = (const bf16_t*)(ws + WS_ZB); bf16_t* dst = (bf16_t*)(ws + WS_SB);
#pragma unroll
        for (int ai = 0; ai < 2; ++ai) {
            asm volatile("" ::: "memory");
            u32x4 sv4[4][2], zv4[4][2];
#pragma unroll
            for (int m = 0; m < 4; ++m)
#pragma unroll
                for (int bj = 0; bj < 2; ++bj) { const size_t off = (size_t)(rbase + ai * HALF + m * 16) * 512 + u.pn * BM + cl + bj * HALF; sv4[m][bj] = *(const u32x4*)(sg + off); zv4[m][bj] = *(const u32x4*)(zb + off); }
#pragma unroll
            for (int m = 0; m < 4; ++m)
#pragma unroll
                for (int bj = 0; bj < 2; ++bj) {
                    const size_t off = (size_t)(rbase + ai * HALF + m * 16) * 512 + u.pn * BM + cl + bj * HALF;
                    const u32x4 s4 = sv4[m][bj], z4 = zv4[m][bj];
                    const f32x4 v0 = acc[ai][bj][m][0], v1 = acc[ai][bj][m][1];
                    u32x4 w;
                    w.x = cvt_pk_bf16(bf_lo(s4.x) * sigmoidf_(v0[0]) * bf_lo(z4.x), bf_hi(s4.x) * sigmoidf_(v0[1]) * bf_hi(z4.x));
                    w.y = cvt_pk_bf16(bf_lo(s4.y) * sigmoidf_(v0[2]) * bf_lo(z4.y), bf_hi(s4.y) * sigmoidf_(v0[3]) * bf_hi(z4.y));
                    w.z = cvt_pk_bf16(bf_lo(s4.z) * sigmoidf_(v1[0]) * bf_lo(z4.z), bf_hi(s4.z) * sigmoidf_(v1[1]) * bf_hi(z4.z));
                    w.w = cvt_pk_bf16(bf_lo(s4.w) * sigmoidf_(v1[2]) * bf_lo(z4.w), bf_hi(s4.w) * sigmoidf_(v1[3]) * bf_hi(z4.w));
                    *(u32x4*)(dst + off) = w;
                }
        }
    } else if (g.mode == MODE_A || g.mode == MODE_B) {
        const bool isb = g.mode == MODE_B;
        const bf16_t* gt = (const bf16_t*)(ws + (isb ? WS_GB : WS_GA)); bf16_t* dst = (bf16_t*)(ws + WS_M1);
#pragma unroll
        for (int ai = 0; ai < 2; ++ai) {
            asm volatile("" ::: "memory");
            u32x4 gv4[4][2], pv4[4][2];
#pragma unroll
            for (int m = 0; m < 4; ++m)
#pragma unroll
                for (int bj = 0; bj < 2; ++bj) { const size_t off = (size_t)(rbase + ai * HALF + m * 16) * 1024 + u.pn * BM + cl + bj * HALF; gv4[m][bj] = *(const u32x4*)(gt + off); pv4[m][bj] = (u32x4){0u, 0u, 0u, 0u}; if (isb) pv4[m][bj] = *(const u32x4*)(dst + off); }
#pragma unroll
            for (int m = 0; m < 4; ++m)
#pragma unroll
                for (int bj = 0; bj < 2; ++bj) {
                    const size_t off = (size_t)(rbase + ai * HALF + m * 16) * 1024 + u.pn * BM + cl + bj * HALF;
                    const u32x4 g4 = gv4[m][bj], p4 = pv4[m][bj];
                    const f32x4 v0 = acc[ai][bj][m][0], v1 = acc[ai][bj][m][1];
                    u32x4 w;
                    w.x = cvt_pk_bf16(bf_lo(p4.x) + bf_lo(g4.x) * v0[0], bf_hi(p4.x) + bf_hi(g4.x) * v0[1]);
                    w.y = cvt_pk_bf16(bf_lo(p4.y) + bf_lo(g4.y) * v0[2], bf_hi(p4.y) + bf_hi(g4.y) * v0[3]);
                    w.z = cvt_pk_bf16(bf_lo(p4.z) + bf_lo(g4.z) * v1[0], bf_hi(p4.z) + bf_hi(g4.z) * v1[1]);
                    w.w = cvt_pk_bf16(bf_lo(p4.w) + bf_lo(g4.w) * v1[2], bf_hi(p4.w) + bf_hi(g4.w) * v1[3]);
                    *(u32x4*)(dst + off) = w;
                }
        }
    } else {
        bf16_t* dst = (bf16_t*)(ws + WS_ACC);
#pragma unroll
        for (int ai = 0; ai < 2; ++ai)
#pragma unroll
            for (int m = 0; m < 4; ++m) {
                const int tl = rbase + ai * HALF + m * 16;
#pragma unroll
                for (int bj = 0; bj < 2; ++bj) {
                    const f32x4 v0 = acc[ai][bj][m][0], v1 = acc[ai][bj][m][1];
                    u32x4 w; w.x = cvt_pk_bf16(v0[0], v0[1]); w.y = cvt_pk_bf16(v0[2], v0[3]); w.z = cvt_pk_bf16(v1[0], v1[1]); w.w = cvt_pk_bf16(v1[2], v1[3]);
                    *(u32x4*)(dst + (size_t)tl * DM + u.pn * BM + cl + bj * HALF) = w;
                }
            }
    }
}

__device__ __forceinline__ void gemm_phase(const Args& a, LAS unsigned char* lds, const GemmD& g, int G, int cidx, int tid) {
    const int wid = __builtin_amdgcn_readfirstlane(tid >> 6), lane = tid & 63, wr = wid >> 2, wc = wid & 3, fr = lane & 15, fq = lane >> 4;
    const int K = g.K, nt = K / BK;
    unsigned voffA[2], voffB[2];
#pragma unroll
    for (int i = 0; i < 2; ++i) { int R, C; stage_rc(tid * 16 + i * 8192, R, C); const int Rb = (R & ~31) + perm32(R & 31);
        voffA[i] = (unsigned)(R * g.lda + C) * 2u; voffB[i] = (unsigned)(Rb * g.ldb + C) * 2u; }
    const size_t kstep = (size_t)(BK * 2);
    const size_t hstepA = (size_t)HALF * g.lda * 2, hstepB = (size_t)HALF * g.ldb * 2;
    const size_t tstepA = 2 * hstepA, tstepB = 2 * hstepB;
    const unsigned ldsw = (unsigned)wid * 1024u;
    const int aoff = lds_byte(wr * 64 + fr, fq * 8), boff = lds_byte(wc * 32 + fr, fq * 8);
#define PG8_SA(b, h) (((b) * 2 + (h)) * HTB)
#define PG8_SB(b, h) ((4 + (b) * 2 + (h)) * HTB)
#define PG8_STAGE(bufoff, gbase, voff) do { _Pragma("unroll") for (int _i = 0; _i < 2; ++_i) \
        __builtin_amdgcn_global_load_lds((const unsigned*)((const char*)(gbase) + (voff)[_i]), (LAS unsigned*)(lds + (bufoff) + ldsw + _i * 8192), 16, 0, 0); } while (0)
#define PG8_LDA(dst, b, h) do { _Pragma("unroll") for (int m = 0; m < 4; ++m) _Pragma("unroll") for (int k = 0; k < 2; ++k) dst[m][k] = *(const LAS bf16x8*)(lds + PG8_SA(b, h) + aoff + m * 2048 + k * 1024); } while (0)
#define PG8_LDB(dst, b, h) do { _Pragma("unroll") for (int n = 0; n < 2; ++n) _Pragma("unroll") for (int k = 0; k < 2; ++k) dst[n][k] = *(const LAS bf16x8*)(lds + PG8_SB(b, h) + boff + n * 2048 + k * 1024); } while (0)
#define PG8_MMA(ai, bj, At, Bt) do { __builtin_amdgcn_s_setprio(1); _Pragma("unroll") for (int m = 0; m < 4; ++m) _Pragma("unroll") for (int n = 0; n < 2; ++n) _Pragma("unroll") for (int k = 0; k < 2; ++k) \
        acc[ai][bj][m][n] = __builtin_amdgcn_mfma_f32_16x16x32_bf16(Bt[n][k], At[m][k], acc[ai][bj][m][n], 0, 0, 0); __builtin_amdgcn_s_setprio(0); } while (0)
#define PG8_WAIT_V(n) asm volatile("s_waitcnt vmcnt(" #n ")" ::: "memory")
#define PG8_WAIT_L(n) asm volatile("s_waitcnt lgkmcnt(" #n ")" ::: "memory")
#define PG8_BAR __builtin_amdgcn_s_barrier()
#define PG8_SCHED __builtin_amdgcn_sched_barrier(0)
    Unit cur, nxt; int ui = 0;
    { int pm_, pn_, bz_; if (!unit_next(g, 0, G, cidx, pm_, pn_, bz_)) return; cur.pm = pm_; cur.pn = pn_; cur.bz = bz_; }
    f32x4 acc[2][2][4][2];
#pragma unroll
    for (int a = 0; a < 2; ++a)
#pragma unroll
        for (int b = 0; b < 2; ++b)
#pragma unroll
            for (int m = 0; m < 4; ++m)
#pragma unroll
                for (int n = 0; n < 2; ++n) acc[a][b][m][n] = (f32x4){0.f, 0.f, 0.f, 0.f};
    bf16x8 At[4][2], B0[2][2], B1[2][2];
    const char* cA = (const char*)g.A + (size_t)cur.bz * g.sA + (size_t)cur.pm * tstepA; const char* cB = (const char*)g.Bt + (size_t)cur.bz * g.sB + (size_t)cur.pn * tstepB;
    PG8_STAGE(PG8_SB(0, 0), cB, voffB); PG8_STAGE(PG8_SA(0, 0), cA, voffA); PG8_STAGE(PG8_SB(0, 1), cB + hstepB, voffB); PG8_STAGE(PG8_SA(0, 1), cA + hstepA, voffA);
    if (wr == 1) PG8_BAR;
    PG8_WAIT_V(4); PG8_BAR;
    PG8_STAGE(PG8_SB(1, 0), cB + kstep, voffB); PG8_STAGE(PG8_SA(1, 0), cA + kstep, voffA); PG8_STAGE(PG8_SB(1, 1), cB + hstepB + kstep, voffB);
    PG8_WAIT_V(6); PG8_BAR;
    for (;;) {
        int npm, npn, nbz; const bool has_next = unit_next(g, ui + 1, G, cidx, npm, npn, nbz); nxt.pm = npm; nxt.pn = npn; nxt.bz = nbz;
        const char* nA = has_next ? (const char*)g.A + (size_t)nxt.bz * g.sA + (size_t)nxt.pm * tstepA : cA; const char* nB = has_next ? (const char*)g.Bt + (size_t)nxt.bz * g.sB + (size_t)nxt.pn * tstepB : cB;
        for (int t = 0; t < nt; t += 2) {
            const bool last = (t == nt - 2);
            const char* a1 = cA + (size_t)(t + 1) * kstep;
            const char* a2 = last ? nA : cA + (size_t)(t + 2) * kstep; const char* b2 = last ? nB : cB + (size_t)(t + 2) * kstep;
            const char* a3 = a2 + kstep; const char* b3 = b2 + kstep;
            PG8_LDB(B0, 0, 0); PG8_SCHED; PG8_LDA(At, 0, 0); PG8_STAGE(PG8_SA(1, 1), a1 + hstepA, voffA);
            PG8_WAIT_L(8); PG8_BAR; PG8_WAIT_L(0); PG8_MMA(0, 0, At, B0); PG8_BAR; PG8_SCHED;
            PG8_LDB(B1, 0, 1); PG8_STAGE(PG8_SB(0, 0), b2, voffB);
            PG8_BAR; PG8_WAIT_L(0); PG8_MMA(0, 1, At, B1); PG8_BAR;
            PG8_LDA(At, 0, 1); PG8_STAGE(PG8_SA(0, 0), a2, voffA);
            PG8_BAR; PG8_WAIT_L(0); PG8_MMA(1, 0, At, B0); PG8_BAR; PG8_SCHED;
            PG8_STAGE(PG8_SB(0, 1), b2 + hstepB, voffB);
            PG8_WAIT_V(6); PG8_BAR; PG8_MMA(1, 1, At, B1); PG8_BAR;
            PG8_LDB(B0, 1, 0); PG8_SCHED; PG8_LDA(At, 1, 0); PG8_STAGE(PG8_SA(0, 1), a2 + hstepA, voffA);
            PG8_WAIT_L(8); PG8_BAR; PG8_WAIT_L(0); PG8_MMA(0, 0, At, B0); PG8_BAR; PG8_SCHED;
            PG8_LDB(B1, 1, 1); PG8_STAGE(PG8_SB(1, 0), b3, voffB);
            PG8_BAR; PG8_WAIT_L(0); PG8_MMA(0, 1, At, B1); PG8_BAR;
            PG8_LDA(At, 1, 1); PG8_STAGE(PG8_SA(1, 0), a3, voffA);
            PG8_BAR; PG8_WAIT_L(0); PG8_MMA(1, 0, At, B0); PG8_BAR; PG8_SCHED;
            PG8_STAGE(PG8_SB(1, 1), b3 + hstepB, voffB);
            PG8_WAIT_V(6); PG8_BAR; PG8_MMA(1, 1, At, B1); PG8_BAR;
        }
#ifndef NO_EPI
        epilogue(a, lds, g, acc, cur, wr, wc, fr, fq);
#else
        if (g.mode == 99) *(f32x4*)(g.out) = acc[0][0][0][0] + acc[1][1][3][1] + acc[0][1][2][0]+acc[1][0][1][1];
#endif
        if (!has_next) break;
#pragma unroll
        for (int a = 0; a < 2; ++a)
#pragma unroll
            for (int b = 0; b < 2; ++b)
#pragma unroll
                for (int m = 0; m < 4; ++m)
#pragma unroll
                    for (int n = 0; n < 2; ++n) acc[a][b][m][n] = (f32x4){0.f, 0.f, 0.f, 0.f};
        cur = nxt; cA = nA; cB = nB; ++ui;
    }
    PG8_WAIT_V(0);
    if (wr == 0) PG8_BAR;
    PG8_BAR;
#undef PG8_SA
#undef PG8_SB
#undef PG8_STAGE
#undef PG8_LDA
#undef PG8_LDB
#undef PG8_MMA
#undef PG8_WAIT_V
#undef PG8_WAIT_L
#undef PG8_BAR
#undef PG8_SCHED
}

__device__ __forceinline__ int qk_perm_row(int n) { const int i = n & 63; return (n & ~63) + 8 * ((i & 31) >> 2) + (i & 3) + 4 * (i >> 5); }
__device__ __forceinline__ void transpose_item(const float* W, int K, int N, bf16_t* WT, bool permqk, LAS float* scr, int item, int lane) {
    const int nblk = N / 32, kb = item / nblk, nb = item % nblk, k0 = 64 * kb, n0 = 32 * nb;
#pragma unroll 8
    for (int i = 0; i < 32; ++i) { const int kk = 2 * i + (lane >> 5); scr[kk * 33 + (lane & 31)] = W[(size_t)(k0 + kk) * N + n0 + (lane & 31)]; }
    asm volatile("s_waitcnt lgkmcnt(0)" ::: "memory");
    const int c = lane & 7;
#pragma unroll
    for (int j = 0; j < 4; ++j) { const int n = (lane >> 3) + 8 * j; const LAS float* s = scr + (8 * c) * 33 + n;
        u32x4 o; o.x = cvt_pk_bf16(s[0 * 33], s[1 * 33]); o.y = cvt_pk_bf16(s[2 * 33], s[3 * 33]); o.z = cvt_pk_bf16(s[4 * 33], s[5 * 33]); o.w = cvt_pk_bf16(s[6 * 33], s[7 * 33]);
        int row = n0 + n; if (permqk && row < 2 * QKVW) row = qk_perm_row(row);
        *(u32x4*)(WT + (size_t)row * K + k0 + 8 * c) = o; }
    asm volatile("s_waitcnt lgkmcnt(0)" ::: "memory");
}
__device__ __forceinline__ void reduce_angle(double a, float& c, float& s) {
    const double k = __builtin_rint(a * 0.6366197723675814); const float x = (float)(a - k * 1.5707963267948966), x2 = x * x;
    const float sn = x * (1.0f + x2 * (-1.6666666667e-1f + x2 * (8.3333333333e-3f + x2 * (-1.9841269841e-4f + x2 * 2.7557319224e-6f))));
    const float cs = 1.0f + x2 * (-0.5f + x2 * (4.1666666667e-2f + x2 * (-1.3888888889e-3f + x2 * (2.4801587302e-5f + x2 * -2.7557319224e-7f))));
    const int q = ((int)k) & 3;
    c = (q == 0) ? cs : (q == 1) ? -sn : (q == 2) ? -cs : sn;
    s = (q == 0) ? sn : (q == 1) ? cs : (q == 2) ? -sn : -cs;
}
__device__ __forceinline__ void rms_row_to_bf16(const float* xrow, const float* gw, bf16_t* orow, int lane) {
    const f32x4* xr = (const f32x4*)xrow + lane; const f32x4* gr = (const f32x4*)gw + lane;
    f32x4 v[4]; float s = 0.f;
#pragma unroll
    for (int j = 0; j < 4; ++j) { v[j] = xr[64 * j]; s += (v[j].x * v[j].x + v[j].y * v[j].y) + (v[j].z * v[j].z + v[j].w * v[j].w); }
    const float rstd = 1.0f / sqrtf(wave_sum(s) * (1.f / DM) + EPSN);
    u32x2* o8 = (u32x2*)orow + lane;
#pragma unroll
    for (int j = 0; j < 4; ++j) { const f32x4 gv = gr[64 * j]; u32x2 w; w.x = cvt_pk_bf16(v[j].x * rstd * gv.x, v[j].y * rstd * gv.y); w.y = cvt_pk_bf16(v[j].z * rstd * gv.z, v[j].w * rstd * gv.w); o8[64 * j] = w; }
}

__device__ __forceinline__ void ssm_load_bc(const Args& a, int g, int dir, LAS f32x2* Bb, LAS f32x2* Cc, int tid) {
    const float* lam_re = a.in[4]; const float* lam_im = a.in[5]; const float* log_step = a.in[6];
    const float* b_re = a.in[7]; const float* b_im = a.in[8]; const float* c_re = a.in[9]; const float* c_im = a.in[10];
    const float dt = expf(log_step[dir * 32 + g]);
    for (int idx = tid; idx < 1024; idx += 512) {
        { const int n = idx >> 4; const float lr = lam_re[(dir * 32 + g) * 64 + n], li = lam_im[(dir * 32 + g) * 64 + n];
          const float ar = lr * dt; float cb, sb, ch, sh; reduce_angle((double)li * (double)dt, cb, sb); reduce_angle(0.5 * (double)li * (double)dt, ch, sh);
          const float em1 = expm1f(ar), ea = em1 + 1.0f;
          const float nr = em1 * cb - 2.0f * sh * sh, ni = ea * sb;
          const float den = 1.0f / (lr * lr + li * li); const float cr = (nr * lr + ni * li) * den, ci = (ni * lr - nr * li) * den;
          const float br = b_re[(size_t)((dir * 32 + g) * 64) * 16 + idx], bi = b_im[(size_t)((dir * 32 + g) * 64) * 16 + idx];
          Bb[idx] = (f32x2){cr * br - ci * bi, cr * bi + ci * br}; }
        { Cc[idx] = (f32x2){c_re[(size_t)((dir * 32 + g) * 16) * 64 + idx], c_im[(size_t)((dir * 32 + g) * 16) * 64 + idx]}; }
    }
}
__device__ __forceinline__ void ssm_setup_item(const Args& a, LAS unsigned char* lds, int item, int tid) {
    const int g = item >> 1, dir = item & 1;
    LAS f32x2* pw = (LAS f32x2*)lds; LAS f32x2* Bb = pw + 33 * 64; LAS f32x2* Cc = Bb + 1024;
    LAS float* KT = (LAS float*)(Cc + 1024); LAS float* K0 = KT + 32 * 256; LAS f32x2* Bb0 = (LAS f32x2*)(K0 + 256); LAS f32x2* Cc0 = Bb0 + 1024;
    const float* lam_re = a.in[4]; const float* lam_im = a.in[5]; const float* log_step = a.in[6];
    unsigned char* ws = a.ws;
    const float dt = expf(log_step[dir * 32 + g]);
    __syncthreads();
    for (int idx = tid; idx < 33 * 64; idx += 512) {
        const int tau = idx >> 6, n = idx & 63; const float lr = lam_re[(dir * 32 + g) * 64 + n], li = lam_im[(dir * 32 + g) * 64 + n];
        const float mag = expf(lr * dt * (float)tau); float c, s; reduce_angle((double)li * (double)dt * (double)tau, c, s);
        pw[idx] = (f32x2){mag * c, mag * s};
    }
    ssm_load_bc(a, g, dir, Bb, Cc, tid);
    if (dir == 1) ssm_load_bc(a, g, 0, Bb0, Cc0, tid);
    __syncthreads();
    if (tid < 64) { float* PW = (float*)(ws + WS_PW); const f32x2 p = pw[32 * 64 + tid]; PW[((dir * 32 + g) * 64 + tid) * 2] = p.x; PW[((dir * 32 + g) * 64 + tid) * 2 + 1] = p.y; }
    for (int o = tid; o < 32 * 256; o += 512) {
        const int tau = o >> 8, co = (o >> 4) & 15, ci = o & 15; float acc = 0.f;
_Pragma("unroll 4")
        for (int n = 0; n < 64; ++n) { const f32x2 c = Cc[co * 64 + n], p = pw[tau * 64 + n], b = Bb[n * 16 + ci]; const float tr = c.x * p.x - c.y * p.y, ti = c.x * p.y + c.y * p.x; acc += tr * b.x - ti * b.y; }
        KT[o] = acc; }
    if (dir == 1 && tid < 256) { const int co = tid >> 4, ci = tid & 15; float acc = 0.f;
_Pragma("unroll 4")
        for (int n = 0; n < 64; ++n) { const f32x2 c = Cc0[co * 64 + n], b = Bb0[n * 16 + ci]; acc += c.x * b.x - c.y * b.y; }
        K0[tid] = acc; }
    { bf16_t* BsT = (bf16_t*)(ws + WS_BST) + (size_t)g * 256 * 512;
      for (int ch = tid; ch < 128 * 64; ch += 512) {
          const int row = ch >> 6, part = row >> 6, n = row & 63, kc = ch & 63, s = kc >> 1, ci0 = (kc & 1) * 8; const int e = dir ? s : 31 - s; const f32x2 p = pw[e * 64 + n];
          float v[8];
#pragma unroll
          for (int j = 0; j < 8; ++j) { const f32x2 b = Bb[n * 16 + ci0 + j]; v[j] = part ? (p.x * b.y + p.y * b.x) : (p.x * b.x - p.y * b.y); }
          u32x4 w; w.x = cvt_pk_bf16(v[0], v[1]); w.y = cvt_pk_bf16(v[2], v[3]); w.z = cvt_pk_bf16(v[4], v[5]); w.w = cvt_pk_bf16(v[6], v[7]);
          *(u32x4*)(BsT + (size_t)(dir * 128 + row) * 512 + s * 16 + ci0) = w; } }
    bf16_t* MtC = (bf16_t*)(ws + WS_MTC) + (size_t)g * 512 * UHK;
    { for (int ch = tid; ch < 512 * 16; ch += 512) {
          const int row = ch >> 4, t = row >> 4, co = row & 15, cc = ch & 15, part = cc >> 3, n0 = (cc & 7) * 8; const int e = dir ? 32 - t : t + 1;
          float v[8];
#pragma unroll
          for (int j = 0; j < 8; ++j) { const f32x2 c = Cc[co * 64 + n0 + j], p = pw[e * 64 + n0 + j]; v[j] = part ? -(c.x * p.y + c.y * p.x) : (c.x * p.x - c.y * p.y); }
          u32x4 w; w.x = cvt_pk_bf16(v[0], v[1]); w.y = cvt_pk_bf16(v[2], v[3]); w.z = cvt_pk_bf16(v[4], v[5]); w.w = cvt_pk_bf16(v[6], v[7]);
          *(u32x4*)(MtC + (size_t)row * UHK + 512 + dir * 128 + part * 64 + n0) = w; } }
    __syncthreads();
    { const float* dsk = a.in[11];
      for (int ch = tid; ch < 512 * 64; ch += 512) {
          const int kc = ch & 63, row = ch >> 6; const int s = kc >> 1, ci0 = (kc & 1) * 8, t = row >> 4, co = row & 15;
          if (dir == 0 ? (t > s) : (s >= t)) {
              const int tau = dir == 0 ? t - s : s - t;
              float v[8];
#pragma unroll
              for (int j = 0; j < 8; ++j) v[j] = KT[tau * 256 + co * 16 + ci0 + j];
              if (t == s) { const float dv = dsk[g * 16 + co];
#pragma unroll
                  for (int j = 0; j < 8; ++j) v[j] += K0[co * 16 + ci0 + j] + ((ci0 + j == co) ? dv : 0.f); }
              u32x4 w; w.x = cvt_pk_bf16(v[0], v[1]); w.y = cvt_pk_bf16(v[2], v[3]); w.z = cvt_pk_bf16(v[4], v[5]); w.w = cvt_pk_bf16(v[6], v[7]);
              *(u32x4*)(MtC + (size_t)row * UHK + s * 16 + ci0) = w;
          }
      } }
    __syncthreads();
}

__device__ __forceinline__ void step_setup(const Args& a, LAS unsigned char* lds, int tid, int bx) {
    const int lane = tid & 63, wave = tid >> 6, G = gridDim.x;
    unsigned char* ws = a.ws;
    for (int it = bx; it < 64; it += G) ssm_setup_item(a, lds, it, tid);
    { float* rc = (float*)(ws + WS_ROPE); float* rs = rc + SEQL * 32;
      for (int idx = bx * 512 + tid; idx < SEQL * 32; idx += G * 512) {
          const int pos = idx >> 5, i = idx & 31; double inv = 1.0; for (int k = 0; k < i; ++k) inv *= 0.7498942093324558;
          float c, s; reduce_angle((double)pos * inv, c, s); rc[idx] = c; rs[idx] = s; } }
    { LAS float* scr = (LAS float*)(lds) + wave * (64 * 33);
      const int gw = bx * 8 + wave, NGW = G * 8;
      constexpr int I_IN = (DM / 64) * (INC / 32), I_GLU = (512 / 64) * (512 / 32), I_AB = (512 / 64) * (1024 / 32), I_OUT = (1024 / 64) * (1024 / 32);
      constexpr int NIT = I_IN + I_GLU + 2 * I_AB + I_OUT;
      for (int it = gw; it < NIT; it += NGW) {
          int r = it;
          if (r < I_IN) { transpose_item(a.in[3], DM, INC, (bf16_t*)(ws + WS_WIN), true, scr, r, lane); continue; } r -= I_IN;
          if (r < I_GLU) { transpose_item(a.in[12], 512, 512, (bf16_t*)(ws + WS_WGLU), false, scr, r, lane); continue; } r -= I_GLU;
          if (r < I_AB) { transpose_item(a.in[13], 512, 1024, (bf16_t*)(ws + WS_WA), false, scr, r, lane); continue; } r -= I_AB;
          if (r < I_AB) { transpose_item(a.in[14], 512, 1024, (bf16_t*)(ws + WS_WB), false, scr, r, lane); continue; } r -= I_AB;
          transpose_item(a.in[15], 1024, 1024, (bf16_t*)(ws + WS_WOUT), false, scr, r, lane);
      } }
    { bf16_t* hn = (bf16_t*)((unsigned char*)a.out + OUT_HN_OFF);
      const f32x4* gr = (const f32x4*)a.in[2] + lane;
      f32x4 gv[4];
#pragma unroll
      for (int j = 0; j < 4; ++j) gv[j] = gr[64 * j];
      unsigned* rctr = (unsigned*)(ws + WS_CTL) + 4;
      constexpr int RCH = 16;
      for (;;) {
          unsigned cidx = 0; if (lane == 0) cidx = atomicAdd(rctr, 1u);
          cidx = (unsigned)__builtin_amdgcn_readfirstlane((int)cidx);
          if (cidx >= (unsigned)(TTOK / RCH)) break;
          int row = (int)cidx * RCH; const int rend = row + RCH;
          f32x4 nx[4];
          { const f32x4* xr = (const f32x4*)xrow_ptr(a.in[0], a.in[1], row) + lane;
#pragma unroll
            for (int j = 0; j < 4; ++j) nx[j] = xr[64 * j]; }
          for (; row < rend; ++row) {
              f32x4 v[4];
#pragma unroll
              for (int j = 0; j < 4; ++j) v[j] = nx[j];
              if (row + 1 < rend) { const f32x4* xn = (const f32x4*)xrow_ptr(a.in[0], a.in[1], row + 1) + lane;
#pragma unroll
                  for (int j = 0; j < 4; ++j) nx[j] = xn[64 * j]; }
              float s = 0.f;
#pragma unroll
              for (int j = 0; j < 4; ++j) s += (v[j].x * v[j].x + v[j].y * v[j].y) + (v[j].z * v[j].z + v[j].w * v[j].w);
              const float rstd = 1.0f / sqrtf(wave_sum(s) * (1.f / DM) + EPSN);
              u32x2* o8 = (u32x2*)(hn + (size_t)row * DM) + lane;
#pragma unroll
              for (int j = 0; j < 4; ++j) { u32x2 w; w.x = cvt_pk_bf16(v[j].x * rstd * gv[j].x, v[j].y * rstd * gv[j].y); w.y = cvt_pk_bf16(v[j].z * rstd * gv[j].z, v[j].w * rstd * gv[j].w); o8[64 * j] = w; }
          }
      } }
}

__device__ __forceinline__ float quad_max(float x) {
    const auto r = __builtin_amdgcn_permlane32_swap(__float_as_uint(x), __float_as_uint(x), false, false);
    x = fmaxf(__uint_as_float(r[0]), __uint_as_float(r[1]));
    const auto q = __builtin_amdgcn_permlane16_swap(__float_as_uint(x), __float_as_uint(x), false, false);
    return fmaxf(__uint_as_float(q[0]), __uint_as_float(q[1]));
}
__device__ __forceinline__ float quad_sum(float x) {
    const auto r = __builtin_amdgcn_permlane32_swap(__float_as_uint(x), __float_as_uint(x), false, false);
    x = __uint_as_float(r[0]) + __uint_as_float(r[1]);
    const auto q = __builtin_amdgcn_permlane16_swap(__float_as_uint(x), __float_as_uint(x), false, false);
    return __uint_as_float(q[0]) + __uint_as_float(q[1]);
}
struct KVBuf { bf16x8 kA0, kA1, kB0, kB1; bf16x4 vA[4], vB[4]; };
__device__ __forceinline__ void step_params(int s, int& gi, int& ls) { gi = s < 12 ? 0 : (s < 18 ? 1 : 2); ls = s < 12 ? s : (s < 18 ? s - 12 : s - 18); }
__device__ __forceinline__ void attn_load(KVBuf& b, const bf16_t* Kp, const bf16_t* Vt, int s, int sq, int h, int blk, int r, int lane) {
    int gi, ls; step_params(s, gi, ls);
    const int sh = 2 * gi, Lg = SEQL >> sh, rho = r & ((1 << sh) - 1);
    int uA = ((256 * blk) >> sh) - 64 + 32 * ls, uB = uA + 16;
    if (uA < 0 || uA >= Lg) uA = 0; if (uB < 0 || uB >= Lg) uB = 0;
    const int kl = lane & 15, quad = lane >> 4;
    const bf16_t* kh = Kp + (size_t)(sq * 24 + gi * 8 + h) * SEQL * 64 + quad * 128 + kl * 8;
    const bf16_t* ka = kh + (size_t)((rho * Lg + uA) >> 4) * 1024; const bf16_t* kb = kh + (size_t)((rho * Lg + uB) >> 4) * 1024;
    b.kA0 = *(const bf16x8*)ka; b.kA1 = *(const bf16x8*)(ka + 512); b.kB0 = *(const bf16x8*)kb; b.kB1 = *(const bf16x8*)(kb + 512);
    const bf16_t* vbase = Vt + (size_t)(((sq * 3 + gi) * 8 + h) * 512) * 1024 + quad * 64 + kl * 4;
    const bf16_t* va = vbase + (size_t)((rho * Lg + uA) >> 4) * 1024; const bf16_t* vb = vbase + (size_t)((rho * Lg + uB) >> 4) * 1024;
#pragma unroll
    for (int dt = 0; dt < 4; ++dt) { b.vA[dt] = *(const bf16x4*)(va + dt * 256); b.vB[dt] = *(const bf16x4*)(vb + dt * 256); }
}
struct QF { bf16x8 a0, a1, b0, b1, c0, c1; };
template <int gi>
__device__ __forceinline__ void attn_compute(const KVBuf& b, const bf16x8 q0, const bf16x8 q1, f32x4 (&o)[4], float& mrun, float& lrun, int s, int blk, int r, int lane) {
    const int ls = gi == 0 ? s : (gi == 1 ? s - 12 : s - 18);
    const int sh = 2 * gi, Lg = SEQL >> sh;
    const int uA = ((256 * blk) >> sh) - 64 + 32 * ls;
    const int qi = lane & 15, quad = lane >> 4;
    const int uq = (256 * blk + r + 16 * qi) >> sh;
    const int lo = max(0, uq - 64), hi = min(Lg - 1, uq + 64);
    f32x4 sA = (f32x4){0.f, 0.f, 0.f, 0.f}, sB = sA;
    sA = __builtin_amdgcn_mfma_f32_16x16x32_bf16(b.kA0, q0, sA, 0, 0, 0); sA = __builtin_amdgcn_mfma_f32_16x16x32_bf16(b.kA1, q1, sA, 0, 0, 0);
    sB = __builtin_amdgcn_mfma_f32_16x16x32_bf16(b.kB0, q0, sB, 0, 0, 0); sB = __builtin_amdgcn_mfma_f32_16x16x32_bf16(b.kB1, q1, sB, 0, 0, 0);
    const float NEGINF = -__builtin_inff();
    const unsigned span = (unsigned)(hi - lo);
    float mx = NEGINF;
#pragma unroll
    for (int j = 0; j < 4; ++j) {
        const int ua = uA + quad * 4 + j, ub = ua + 16;
        sA[j] = ((unsigned)(ua - lo) <= span) ? sA[j] : NEGINF; sB[j] = ((unsigned)(ub - lo) <= span) ? sB[j] : NEGINF;
        mx = fmaxf(mx, fmaxf(sA[j], sB[j]));
    }
    mx = quad_max(mx);
    const float mnew = fmaxf(mrun, mx), alpha = __builtin_amdgcn_exp2f(mrun - mnew);
    mrun = mnew;
    float ps = 0.f;
#pragma unroll
    for (int j = 0; j < 4; ++j) { sA[j] = __builtin_amdgcn_exp2f(sA[j] - mnew); sB[j] = __builtin_amdgcn_exp2f(sB[j] - mnew); ps += sA[j] + sB[j]; }
    lrun = lrun * alpha + ps;
    u32x4 pw; pw.x = cvt_pk_bf16(sA[0], sA[1]); pw.y = cvt_pk_bf16(sA[2], sA[3]); pw.z = cvt_pk_bf16(sB[0], sB[1]); pw.w = cvt_pk_bf16(sB[2], sB[3]);
    const bf16x8 pf = __builtin_bit_cast(bf16x8, pw);
#pragma unroll
    for (int dt = 0; dt < 4; ++dt) {
        o[dt] *= alpha;
        bf16x8 vf; vf[0] = b.vA[dt][0]; vf[1] = b.vA[dt][1]; vf[2] = b.vA[dt][2]; vf[3] = b.vA[dt][3]; vf[4] = b.vB[dt][0]; vf[5] = b.vB[dt][1]; vf[6] = b.vB[dt][2]; vf[7] = b.vB[dt][3];
#ifdef DBG_ATT2
        for (int e = 0; e < 8; ++e) o[dt][e & 3] += 1e-3f * __uint_as_float(((unsigned)(unsigned short)vf[e]) << 16);
#else
        o[dt] = __builtin_amdgcn_mfma_f32_16x16x32_bf16(vf, pf, o[dt], 0, 0, 0);
#endif
    }
}
template <int gi>
__device__ __forceinline__ void attn_compute2(const KVBuf& b, const KVBuf& c, const bf16x8 q0, const bf16x8 q1, f32x4 (&o)[4], float& mrun, float& lrun, int s, int blk, int r, int lane) {
    const int ls = gi == 0 ? s : (gi == 1 ? s - 12 : s - 18);
    const int sh = 2 * gi, Lg = SEQL >> sh;
    const int uA = ((256 * blk) >> sh) - 64 + 32 * ls;
    const int qi = lane & 15, quad = lane >> 4;
    const int uq = (256 * blk + r + 16 * qi) >> sh;
    const int lo = max(0, uq - 64), hi = min(Lg - 1, uq + 64);
    const f32x4 z4 = (f32x4){0.f, 0.f, 0.f, 0.f};
    f32x4 sA = __builtin_amdgcn_mfma_f32_16x16x32_bf16(b.kA0, q0, z4, 0, 0, 0), sB = __builtin_amdgcn_mfma_f32_16x16x32_bf16(b.kB0, q0, z4, 0, 0, 0);
    f32x4 sC = __builtin_amdgcn_mfma_f32_16x16x32_bf16(c.kA0, q0, z4, 0, 0, 0), sD = __builtin_amdgcn_mfma_f32_16x16x32_bf16(c.kB0, q0, z4, 0, 0, 0);
    sA = __builtin_amdgcn_mfma_f32_16x16x32_bf16(b.kA1, q1, sA, 0, 0, 0); sB = __builtin_amdgcn_mfma_f32_16x16x32_bf16(b.kB1, q1, sB, 0, 0, 0);
    sC = __builtin_amdgcn_mfma_f32_16x16x32_bf16(c.kA1, q1, sC, 0, 0, 0); sD = __builtin_amdgcn_mfma_f32_16x16x32_bf16(c.kB1, q1, sD, 0, 0, 0);
    const float NEGINF = -__builtin_inff();
    const unsigned span = (unsigned)(hi - lo);
    float mx = NEGINF;
#pragma unroll
    for (int j = 0; j < 4; ++j) {
        const int ua = uA + quad * 4 + j;
        sA[j] = ((unsigned)(ua - lo) <= span) ? sA[j] : NEGINF; sB[j] = ((unsigned)(ua + 16 - lo) <= span) ? sB[j] : NEGINF;
        sC[j] = ((unsigned)(ua + 32 - lo) <= span) ? sC[j] : NEGINF; sD[j] = ((unsigned)(ua + 48 - lo) <= span) ? sD[j] : NEGINF;
        mx = fmaxf(fmaxf(mx, fmaxf(sA[j], sB[j])), fmaxf(sC[j], sD[j]));
    }
    mx = quad_max(mx);
    const float mnew = fmaxf(mrun, mx), alpha = __builtin_amdgcn_exp2f(mrun - mnew);
    mrun = mnew;
    float ps = 0.f;
#pragma unroll
    for (int j = 0; j < 4; ++j) { sA[j] = __builtin_amdgcn_exp2f(sA[j] - mnew); sB[j] = __builtin_amdgcn_exp2f(sB[j] - mnew); sC[j] = __builtin_amdgcn_exp2f(sC[j] - mnew); sD[j] = __builtin_amdgcn_exp2f(sD[j] - mnew); ps += (sA[j] + sB[j]) + (sC[j] + sD[j]); }
    lrun = lrun * alpha + ps;
    u32x4 pw, pv; pw.x = cvt_pk_bf16(sA[0], sA[1]); pw.y = cvt_pk_bf16(sA[2], sA[3]); pw.z = cvt_pk_bf16(sB[0], sB[1]); pw.w = cvt_pk_bf16(sB[2], sB[3]);
    pv.x = cvt_pk_bf16(sC[0], sC[1]); pv.y = cvt_pk_bf16(sC[2], sC[3]); pv.z = cvt_pk_bf16(sD[0], sD[1]); pv.w = cvt_pk_bf16(sD[2], sD[3]);
    const bf16x8 pf = __builtin_bit_cast(bf16x8, pw), pg = __builtin_bit_cast(bf16x8, pv);
#pragma unroll
    for (int dt = 0; dt < 4; ++dt) {
        o[dt] *= alpha;
        bf16x8 vf, vg;
        vf[0] = b.vA[dt][0]; vf[1] = b.vA[dt][1]; vf[2] = b.vA[dt][2]; vf[3] = b.vA[dt][3]; vf[4] = b.vB[dt][0]; vf[5] = b.vB[dt][1]; vf[6] = b.vB[dt][2]; vf[7] = b.vB[dt][3];
        vg[0] = c.vA[dt][0]; vg[1] = c.vA[dt][1]; vg[2] = c.vA[dt][2]; vg[3] = c.vA[dt][3]; vg[4] = c.vB[dt][0]; vg[5] = c.vB[dt][1]; vg[6] = c.vB[dt][2]; vg[7] = c.vB[dt][3];
        o[dt] = __builtin_amdgcn_mfma_f32_16x16x32_bf16(vf, pf, o[dt], 0, 0, 0);
        o[dt] = __builtin_amdgcn_mfma_f32_16x16x32_bf16(vg, pg, o[dt], 0, 0, 0);
    }
}
__device__ __forceinline__ void step_attention(const Args& a, LAS unsigned char* lds, int pass, int tid, int bx) {
    unsigned char* ws = a.ws;
    const int lane = tid & 63;
    const bf16_t* Qp = (const bf16_t*)(ws + WS_Q); const bf16_t* Kp = (const bf16_t*)(ws + WS_K); const bf16_t* Vt = (const bf16_t*)(ws + WS_VT);
    const bf16_t* ZA = (const bf16_t*)(ws + WS_ZA); bf16_t* GAO = (bf16_t*)(ws + WS_GAO);
    const int xcd = bx & 7;
    unsigned* ctr = (unsigned*)(ws + WS_CTL) + 16 + pass * 8 + xcd;
    LAS unsigned* slot = (LAS unsigned*)(lds + 3 * 16384);
    constexpr int NGRP = 3 * 32 * 2;
    for (;;) {
        __syncthreads();
        if (tid == 0) slot[0] = atomicAdd(ctr, 1u);
        __syncthreads();
        const unsigned grp = (unsigned)__builtin_amdgcn_readfirstlane((int)slot[0]);
        if (grp >= (unsigned)NGRP) break;
        const int wv_ = tid >> 6; const int r = ((wv_ & 3) << 2) + (wv_ >> 2) + 2 * (int)(grp & 1)  , blk = (grp >> 1) & 31, pair = xcd * 3 + (int)(grp >> 6);
        const int h = pair & 7, sq = pair >> 3;
        const int qi = lane & 15, quad = lane >> 4;
        const int tq = sq * SEQL + 256 * blk + r + 16 * qi;
        QF qf;
        { const int pos = 256 * blk + r + 16 * qi;
          const bf16_t* qa = Qp + ((size_t)(sq * 24 + h) * SEQL + pos) * 64 + quad * 8;
          const bf16_t* qb = Qp + ((size_t)(sq * 24 + 8 + h) * SEQL + (pos & 3) * 2048 + (pos >> 2)) * 64 + quad * 8;
          const bf16_t* qc = Qp + ((size_t)(sq * 24 + 16 + h) * SEQL + (pos & 15) * 512 + (pos >> 4)) * 64 + quad * 8;
          qf.a0 = *(const bf16x8*)qa; qf.a1 = *(const bf16x8*)(qa + 32); qf.b0 = *(const bf16x8*)qb; qf.b1 = *(const bf16x8*)(qb + 32); qf.c0 = *(const bf16x8*)qc; qf.c1 = *(const bf16x8*)(qc + 32); }
        f32x4 o[4];
#pragma unroll
        for (int dt = 0; dt < 4; ++dt) o[dt] = (f32x4){0.f, 0.f, 0.f, 0.f};
        float mrun = -1e30f, lrun = 0.f;
        KVBuf b0, b1;
#define ATT_SB __builtin_amdgcn_sched_barrier(0);
        {
            const int wv = tid >> 6, region = wv >> 1;
            const bf16_t* gsrc = (region < 2 ? Kp + (size_t)(sq * 24 + h) * SEQL * 64 : Vt + (size_t)((sq * 3) * 8 + h) * 512 * 1024) + (wv & 1) * 512 + lane * 8;
            const int ubase = 256 * blk - 64 + (region & 1) * 16;
#define ATT_DMA(S) do { int uT = ubase + 32 * (S); if (uT < 0 || uT >= SEQL) uT = 0; \
                __builtin_amdgcn_global_load_lds((const unsigned*)(gsrc + (size_t)(uT >> 4) * 1024), (LAS unsigned*)(lds + (((S) >> 1) % 3) * 16384 + ((S) & 1) * 8192 + wv * 1024), 16, 0, 0); } while (0)
            ATT_DMA(0); ATT_DMA(1); ATT_DMA(2); ATT_DMA(3);
            const int kl = lane & 15;
            const unsigned foff = (unsigned)(quad * 256 + kl * 16), voff = (unsigned)(4096 + quad * 128 + kl * 8);
#pragma unroll 1
            for (int d = 0; d < 6; ++d) {
                if (d < 5) asm volatile("s_waitcnt vmcnt(2)" ::: "memory"); else asm volatile("s_waitcnt vmcnt(0)" ::: "memory");
                __syncthreads();
                if (d + 2 < 6) { ATT_DMA(2 * d + 4); ATT_DMA(2 * d + 5); }
                LAS unsigned char* kb = lds + (d % 3) * 16384;
                b0.kA0 = *(const LAS bf16x8*)(kb + foff); b0.kA1 = *(const LAS bf16x8*)(kb + foff + 1024); b0.kB0 = *(const LAS bf16x8*)(kb + 2048 + foff); b0.kB1 = *(const LAS bf16x8*)(kb + 2048 + foff + 1024);
                b1.kA0 = *(const LAS bf16x8*)(kb + 8192 + foff); b1.kA1 = *(const LAS bf16x8*)(kb + 8192 + foff + 1024); b1.kB0 = *(const LAS bf16x8*)(kb + 8192 + 2048 + foff); b1.kB1 = *(const LAS bf16x8*)(kb + 8192 + 2048 + foff + 1024);
#pragma unroll
                for (int dt = 0; dt < 4; ++dt) { b0.vA[dt] = *(const LAS bf16x4*)(kb + voff + dt * 512); b0.vB[dt] = *(const LAS bf16x4*)(kb + 2048 + voff + dt * 512);
                                                 b1.vA[dt] = *(const LAS bf16x4*)(kb + 8192 + voff + dt * 512); b1.vB[dt] = *(const LAS bf16x4*)(kb + 8192 + 2048 + voff + dt * 512); }
                attn_compute2<0>(b0, b1, qf.a0, qf.a1, o, mrun, lrun, 2 * d, blk, r, lane);
            }
#undef ATT_DMA
        }
        attn_load(b0, Kp, Vt, 12, sq, h, blk, r, lane);
#define ATT_LOOP(GI, S0, S1, QA, QB) _Pragma("unroll 1") for (int s = S0; s < S1; s += 2) { \
            ATT_SB attn_load(b1, Kp, Vt, s + 1, sq, h, blk, r, lane); ATT_SB attn_compute<GI>(b0, QA, QB, o, mrun, lrun, s, blk, r, lane); \
            ATT_SB attn_load(b0, Kp, Vt, s + 2, sq, h, blk, r, lane); ATT_SB attn_compute<GI>(b1, QA, QB, o, mrun, lrun, s + 1, blk, r, lane); ATT_SB }
        ATT_LOOP(1, 12, 18, qf.b0, qf.b1)
        ATT_LOOP(2, 18, 22, qf.c0, qf.c1)
#undef ATT_LOOP
        attn_compute<2>(b0, qf.c0, qf.c1, o, mrun, lrun, 22, blk, r, lane);
        const float l = quad_sum(lrun);
        float inv = 1.0f / l;
#ifdef DBG_ATT1
        for (int dt = 0; dt < 4; ++dt) o[dt] = (f32x4){1.f, 1.f, 1.f, 1.f};
#endif
#pragma unroll
        for (int dt = 0; dt < 4; ++dt) {
            const size_t off = (size_t)tq * 512 + h * 64 + 16 * dt + 4 * quad;
            const u32x2 z = *(const u32x2*)(ZA + off);
            u32x2 w; w.x = cvt_pk_bf16(o[dt][0] * inv * bf_lo(z.x), o[dt][1] * inv * bf_hi(z.x)); w.y = cvt_pk_bf16(o[dt][2] * inv * bf_lo(z.y), o[dt][3] * inv * bf_hi(z.y));
            *(u32x2*)(GAO + off) = w;
        }
    }
}

__device__ __forceinline__ f32x2 cmul(f32x2 a, f32x2 b) { return (f32x2){a.x * b.x - a.y * b.y, a.x * b.y + a.y * b.x}; }
__device__ __forceinline__ void step_scan(const Args& a, LAS unsigned char* lds, int tid, int it0, int it1, int itstep) {
    unsigned char* ws = a.ws; const int G = gridDim.x;
    const float* PW = (const float*)(ws + WS_PW); const float* S = (const float*)(ws + WS_S); bf16_t* UH = (bf16_t*)(ws + WS_UH);
    LAS f32x2* carry = (LAS f32x2*)lds;
    for (int it = it0; it < it1; it += itstep) {
        const int dir = it & 1, g = (it >> 1) & 31, sq = it >> 6; const int seg = tid >> 6, n = tid & 63;
        const f32x2 P = (f32x2){PW[((dir * 32 + g) * 64 + n) * 2], PW[((dir * 32 + g) * 64 + n) * 2 + 1]};
        f32x2 z[32];
        { const int c0 = dir ? (NCH - 1 - seg * 32) : seg * 32; const long stp = dir ? -256 : 256;
          const float* sp = S + ((size_t)g * CHP + sq * NCH + c0) * 256 + dir * 128 + n;
#pragma unroll
          for (int i = 0; i < 32; ++i) { z[i] = (f32x2){sp[0], sp[64]}; sp += stp; } }
        f32x2 zz = (f32x2){0.f, 0.f};
#pragma unroll
        for (int i = 0; i < 32; ++i) { const f32x2 t = z[i]; z[i] = zz; zz = cmul(P, zz) + t; }
        __syncthreads();
        carry[seg * 64 + n] = zz;
        __syncthreads();
        f32x2 P32 = P;
#pragma unroll
        for (int k = 0; k < 5; ++k) P32 = cmul(P32, P32);
        f32x2 x = (f32x2){0.f, 0.f};
        for (int sp = 0; sp < seg; ++sp) x = cmul(P32, x) + carry[sp * 64 + n];
        f32x2 pwr = (f32x2){1.f, 0.f};
        { const int c0 = dir ? (NCH - 1 - seg * 32) : seg * 32; const long stp = dir ? -(long)UHK : (long)UHK;
          bf16_t* up = UH + ((size_t)g * CHP + sq * NCH + c0) * UHK + 512 + dir * 128 + n;
#pragma unroll
          for (int i = 0; i < 32; ++i) {
              const f32x2 hin = z[i] + cmul(pwr, x);
              up[0] = (bf16_t)(cvt_pk_bf16(hin.x, 0.f) & 0xffffu); up[64] = (bf16_t)(cvt_pk_bf16(hin.y, 0.f) & 0xffffu);
              pwr = cmul(pwr, P); up += stp;
          } }
    }
}

__device__ __forceinline__ void step_final_norm(const Args& a, int pass, int tid, int bx) {
    const int lane = tid & 63, wave = tid >> 6, G = gridDim.x;
    const f32x4* gr = (const f32x4*)a.in[16] + lane;
    f32x4 gv[4];
#pragma unroll
    for (int j = 0; j < 4; ++j) gv[j] = gr[64 * j];
    const bf16_t* accp = (const bf16_t*)(a.ws + WS_ACC);
    int row = bx * 8 + wave;
    f32x4 nx[4]; u32x2 na[4];
    if (row < TP) { const f32x4* xr = (const f32x4*)xrow_ptr(a.in[0], a.in[1], pass * TP + row) + lane; const u32x2* ar = (const u32x2*)(accp + (size_t)row * DM) + lane;
#pragma unroll
        for (int j = 0; j < 4; ++j) { nx[j] = xr[64 * j]; na[j] = ar[64 * j]; } }
    for (; row < TP; row += G * 8) {
        f32x4 v[4];
#pragma unroll
        for (int j = 0; j < 4; ++j) v[j] = nx[j] + (f32x4){bf_lo(na[j].x), bf_hi(na[j].x), bf_lo(na[j].y), bf_hi(na[j].y)};
        const int nrow = row + G * 8;
        if (nrow < TP) { const f32x4* xn = (const f32x4*)xrow_ptr(a.in[0], a.in[1], pass * TP + nrow) + lane; const u32x2* an = (const u32x2*)(accp + (size_t)nrow * DM) + lane;
#pragma unroll
            for (int j = 0; j < 4; ++j) { nx[j] = xn[64 * j]; na[j] = an[64 * j]; } }
        float s = 0.f;
#pragma unroll
        for (int j = 0; j < 4; ++j) s += (v[j].x * v[j].x + v[j].y * v[j].y) + (v[j].z * v[j].z + v[j].w * v[j].w);
        const float rstd = 1.0f / sqrtf(wave_sum(s) * (1.f / DM) + EPSN);
        f32x4* xr = (f32x4*)(a.out + (size_t)(pass * TP + row) * DM) + lane;
#pragma unroll
        for (int j = 0; j < 4; ++j) xr[64 * j] = v[j] * rstd * gv[j];
    }
}


#define XB_TMO      128
#define XB_XCNT(j)  (256  + 64 * (j))
#define XB_XSUB(j)  (1280 + 64 * (j))
#define XB_XGEN(j)  (2304 + 64 * (j))
#define XB_TOP      3328
#define XB_TOPGEN   3392
#define XCD_BAR_WORDS 3456
#define XB_SLOT(b)  (4096 + 2 * (b))
#define XB_SPIN_CAP (1u << 18)
__device__ __forceinline__ unsigned xb_ld(unsigned* p)              { return __hip_atomic_load(p, __ATOMIC_RELAXED, __HIP_MEMORY_SCOPE_AGENT); }
__device__ __forceinline__ unsigned xb_add(unsigned* p, unsigned v) { return __hip_atomic_fetch_add(p, v, __ATOMIC_RELAXED, __HIP_MEMORY_SCOPE_AGENT); }
__device__ __forceinline__ unsigned xb_xcc_id() { return (unsigned)__builtin_amdgcn_s_getreg((3 << 11) | 20) & 0xFu; }
#define XB_SPIN(cond, bar) do { unsigned _sp = 0; while (cond) { __builtin_amdgcn_s_sleep(1); \
    if ((++_sp & 255u) == 0u) { if (xb_ld(&(bar)[XB_TMO])) break; if (_sp > XB_SPIN_CAP) { atomicAdd(&(bar)[XB_TMO], 1u); break; } } } } while (0)
__device__ __forceinline__ void xcd_barrier_complete(unsigned* bar, unsigned x, unsigned& nloc, unsigned& nx) {
    const unsigned G = gridDim.x;
    unsigned sum, cnt, mine, sp = 0u;
    for (;;) {
        sum = 0u; cnt = 0u; mine = 0u;
#pragma unroll
        for (unsigned j = 0; j < 16; ++j) { const unsigned c = xb_ld(&bar[XB_XCNT(j)]); sum += c; cnt += (c > 0u) ? 1u : 0u; mine = (j == x) ? c : mine; }
        if (sum == G) break;
        __builtin_amdgcn_s_sleep(1);
        if ((++sp & 255u) == 0u) { if (xb_ld(&bar[XB_TMO])) break; if (sp > XB_SPIN_CAP) { atomicAdd(&bar[XB_TMO], 1u); break; } }
    }
    nloc = mine > 0u ? mine : 1u; nx = cnt > 0u ? cnt : 1u;
}
__device__ __forceinline__ void xcd_barrier(unsigned* bar) {
    asm volatile("s_waitcnt vmcnt(0)" ::: "memory");
    __syncthreads();
    if (threadIdx.x == 0) {
        __builtin_amdgcn_s_waitcnt(0);
        const unsigned x = xb_xcc_id();
        unsigned* slot = bar + XB_SLOT(blockIdx.x);
        unsigned nloc = xb_ld(slot), nx = xb_ld(slot + 1);
        if (nloc == 0u) { xcd_barrier_complete(bar, x, nloc, nx); __hip_atomic_store(slot, nloc, __ATOMIC_RELAXED, __HIP_MEMORY_SCOPE_AGENT); __hip_atomic_store(slot + 1, nx, __ATOMIC_RELAXED, __HIP_MEMORY_SCOPE_AGENT); }
        const unsigned old = xb_add(&bar[XB_XSUB(x)], 1u);
        const unsigned gen = old / nloc;
        if (old + 1u == (gen + 1u) * nloc) {
            __builtin_amdgcn_fence(__ATOMIC_RELEASE, "agent");
            asm volatile("s_waitcnt vmcnt(0)" ::: "memory");
            const unsigned og = xb_add(&bar[XB_TOP], 1u);
            const unsigned tg = og / nx;
            if (og + 1u == (tg + 1u) * nx) xb_add(&bar[XB_TOPGEN], 1u);
            else XB_SPIN(xb_ld(&bar[XB_TOPGEN]) == tg, bar);
            __builtin_amdgcn_fence(__ATOMIC_ACQUIRE, "agent");
            xb_add(&bar[XB_XGEN(x)], 1u);
            asm volatile("s_waitcnt vmcnt(0)" ::: "memory");
        } else {
            XB_SPIN(xb_ld(&bar[XB_XGEN(x)]) == gen, bar);
            __builtin_amdgcn_fence(__ATOMIC_ACQUIRE, "agent");
            asm volatile("s_waitcnt vmcnt(0)" ::: "memory");
        }
    }
    __syncthreads();
}

constexpr int NSTEPS = 1 + 10 * NPASS;
__host__ __device__ __forceinline__ bool sync_after(int st) { if (st == 0) return true; const int k = (st - 1) % 10; return !(k == 1 || k == 6 || k == 9); }

__global__ void __launch_bounds__(512, 2) fwd_kernel(Args a) {
    extern __shared__ __attribute__((aligned(16))) unsigned char lds_raw[];
    LAS unsigned char* lds = (LAS unsigned char*)lds_raw;
    cg::grid_group grid = cg::this_grid();
    const int G = gridDim.x;
    unsigned char* ws = a.ws;
    unsigned* bar = (unsigned*)(ws + WS_BAR);
    if (a.do_sync == 2) grid.sync();
    if (a.do_sync && threadIdx.x == 0) (void)xb_add(&bar[XB_XCNT(xb_xcc_id())], 1u);
    for (int st = a.st_lo; st < a.st_hi; ++st) {
        int tid = threadIdx.x, bx = blockIdx.x;
        asm volatile("" : "+v"(tid), "+s"(bx));
#ifndef NO_SETUP
        if (st == 0) { step_setup(a, lds, tid, bx); }
#else
        if (st == 0) {}
#endif
        else {
            const int pass = (st - 1) / 10, k = (st - 1) % 10;
            GemmD g; g.lgnN = 0; g.pass = pass; g.nb = 1; g.sA = 0; g.sB = 0;
            bool has_gemm = true;
            const bool fz = (G == 256);
            const bool split_ay = false;
            const bf16_t* sgp = (const bf16_t*)((unsigned char*)a.out + OUT_HN_OFF) + (size_t)pass * TP * DM;
#define DESC_Y { g.A = (const bf16_t*)(ws + WS_UH); g.lda = UHK; g.sA = (unsigned)(CHP * UHK * 2); g.Bt = (const bf16_t*)(ws + WS_MTC); g.ldb = UHK; g.sB = (unsigned)(512 * UHK * 2); g.K = UHK; g.nM = CHP / BM; g.nN = 2; g.nb = 32; g.mode = MODE_Y; }
#define DESC_A { g.A = (const bf16_t*)(ws + WS_GAO); g.lda = 512; g.Bt = (const bf16_t*)(ws + WS_WA); g.ldb = 512; g.K = 512; g.nM = TP / BM; g.nN = 4; g.lgnN = 2; g.mode = MODE_A; }
#define DESC_GLU { g.A = sgp; g.lda = 512; g.Bt = (const bf16_t*)(ws + WS_WGLU); g.ldb = 512; g.K = 512; g.nM = TP / BM; g.nN = 2; g.lgnN = 1; g.mode = MODE_GLU; }
#define DESC_NONE { has_gemm = false; g.A = nullptr; g.Bt = nullptr; g.lda = g.ldb = g.K = 0; g.nM = g.nN = 0; g.mode = 0; }
            switch (k) {
            case 0: g.A = (const bf16_t*)((unsigned char*)a.out + OUT_HN_OFF) + (size_t)pass * TP * DM; g.lda = DM; g.Bt = (const bf16_t*)(ws + WS_WIN); g.ldb = DM; g.K = DM; g.nM = TP / BM; g.nN = INC / BM; g.lgnN = 5; g.mode = MODE_PROJ; break;
            case 1: g.A = (const bf16_t*)(ws + WS_UH); g.lda = UHK; g.sA = (unsigned)(CHP * UHK * 2); g.Bt = (const bf16_t*)(ws + WS_BST); g.ldb = 512; g.sB = (unsigned)(256 * 512 * 2); g.K = 512; g.nM = CHP / BM; g.nN = 1; g.nb = 32; g.mode = MODE_S; break;
            case 2: if (fz) DESC_Y else DESC_NONE break;
            case 4: if (fz) { if (bx < 128) DESC_A else DESC_GLU } else DESC_Y break;
            case 5: if (fz) DESC_NONE else DESC_GLU break;
            case 6: if (fz) DESC_NONE else DESC_A break;
            case 7: g.A = (const bf16_t*)(ws + WS_SB); g.lda = 512; g.Bt = (const bf16_t*)(ws + WS_WB); g.ldb = 512; g.K = 512; g.nM = TP / BM; g.nN = 4; g.lgnN = 2; g.mode = MODE_B; break;
            case 8: g.A = (const bf16_t*)(ws + WS_M1); g.lda = 1024; g.Bt = (const bf16_t*)(ws + WS_WOUT); g.ldb = 1024; g.K = 1024; g.nM = TP / BM; g.nN = 4; g.lgnN = 2; g.mode = MODE_OUT; break;
            default: DESC_NONE break;
            }
#undef DESC_Y
#undef DESC_A
#undef DESC_GLU
#undef DESC_NONE
            { const int total = g.nM * g.nN * g.nb; g.u0 = bx; g.ustride = G; g.ucount = total > bx ? (total - bx + G - 1) / G : 0; }
            if (fz && k == 2) { g.u0 = (bx / SEQP) * 6 + (bx % SEQP); g.ustride = SEQP; g.ucount = bx < SEQP * 32 ? 2 : 0; }
            if (fz && k == 4) { if (bx < 128) { g.u0 = bx; g.ustride = 128; g.ucount = 3; } else { g.u0 = bx - 128; g.ustride = 128; g.ucount = (bx - 128) < 64 ? 2 : 1; } }
            const bool fuse_scan = (G >= SEQP * 32);
            if (has_gemm) {
#ifndef NO_GEMM
                gemm_phase(a, lds, g, G, bx, tid);
#endif
#ifndef NO_SCAN
                if (k == 1 && fuse_scan && bx < SEQP * 32) {
                    asm volatile("s_waitcnt vmcnt(0)" ::: "memory"); __syncthreads();
                    const int it0 = (bx % SEQP) * 64 + (bx / SEQP) * 2;
                    step_scan(a, lds, tid, it0, it0 + 2, 1);
                    asm volatile("s_waitcnt vmcnt(0)" ::: "memory"); __syncthreads();
                }
#endif
            }
#ifndef NO_ATTN
            else if (k == (fz ? 3 : 2)) step_attention(a, lds, pass, tid, bx);
#endif
#ifndef NO_SCAN
            else if (k == 3 && !fz && !fuse_scan) step_scan(a, lds, tid, bx, SEQP * 32 * 2, G);
#endif
            else if (k == 9) step_final_norm(a, pass, tid, bx);
        }
        { bool need = sync_after(st) && !(st > 0 && (st - 1) % 10 == 3 && G >= SEQP * 32);
          if (G == 256 && st > 0) { const int kk = (st - 1) % 10; need = (kk == 0 || kk == 3 || kk == 4 || kk == 7 || kk == 8); }
          if (a.do_sync && st + 1 < a.st_hi && need) xcd_barrier(bar); }
    }
}

extern "C" void kernel_launch(void* const* d_in, const int* in_sizes, int n_in, void* d_out, int out_size, void* d_ws, size_t ws_size, hipStream_t stream) {
    constexpr int LDS_BYTES = STAGE_BYTES + 32768;
    static int grid = 0;
    if (grid == 0) {
        if (n_in != 17 || out_size != TTOK * DM || ws_size < WS_END) { fprintf(stderr, "kernel_launch: unexpected shapes (n_in %d out %d ws %zu need %zu)\n", n_in, out_size, ws_size, (size_t)WS_END); grid = -1; return; }
        int dev = 0, cus = 0, per_cu = 0;
        hipGetDevice(&dev); hipDeviceGetAttribute(&cus, hipDeviceAttributeMultiprocessorCount, dev);
        hipFuncSetAttribute((const void*)fwd_kernel, hipFuncAttributeMaxDynamicSharedMemorySize, LDS_BYTES);
        hipOccupancyMaxActiveBlocksPerMultiprocessor(&per_cu, (const void*)fwd_kernel, 512, LDS_BYTES);
        if (per_cu < 1) per_cu = 1;
        grid = cus * 1;
        (void)hipGetLastError();
    }
    if (grid < 0) return;
    (void)hipMemsetAsync((unsigned char*)d_ws + WS_BAR, 0, WS_BAR_BYTES + 4096, stream);
    Args a{};
    for (int i = 0; i < 17; ++i) a.in[i] = (const float*)d_in[i];
    a.out = (float*)d_out; a.ws = (unsigned char*)d_ws; a.pad = 0;
#ifndef MULTI_LAUNCH
#define MULTI_LAUNCH 0
#endif
#if MULTI_LAUNCH
    a.do_sync = 0;
    for (int st = 0; st < NSTEPS; ++st) {
        a.st_lo = st; a.st_hi = st + 1;
        hipLaunchKernelGGL(fwd_kernel, dim3(grid), dim3(512), LDS_BYTES, stream, a);
    }
#else
    a.do_sync = 1; a.st_lo = 0; a.st_hi = NSTEPS;
    void* args[] = {&a};
    hipError_t e = hipLaunchCooperativeKernel((const void*)fwd_kernel, dim3(grid), dim3(512), args, LDS_BYTES, stream);
    if (e != hipSuccess) fprintf(stderr, "cooperative launch failed: %s (grid %d)\n", hipGetErrorString(e), grid);
#endif
}
```

```cpp
#include <hip/hip_runtime.h>
#include <hip/hip_cooperative_groups.h>
#include <cstdio>

namespace cg = cooperative_groups;

#define LAS __attribute__((address_space(3)))
typedef unsigned short bf16_t;
typedef short bf16x8 __attribute__((ext_vector_type(8)));
typedef short bf16x4 __attribute__((ext_vector_type(4)));
typedef float f32x4 __attribute__((ext_vector_type(4)));
typedef float f32x2 __attribute__((ext_vector_type(2)));
typedef unsigned u32x4 __attribute__((ext_vector_type(4)));
typedef unsigned u32x2 __attribute__((ext_vector_type(2)));

constexpr int DM = 1024, SEQL = 8192, NSEQ = 6, TTOK = NSEQ * SEQL;
constexpr int NPASS = 2, SEQP = 3, TP = SEQP * SEQL;
constexpr int INC = 8192, QKVW = 1536;
constexpr int LC = 32, NCH = SEQL / LC  , CHP = SEQP * NCH  ;
constexpr int UHK = LC * 16 + 256;
constexpr float EPSN = 1e-6f;
constexpr float QSCALE = 0.18033688011112042f;

constexpr size_t AL(size_t x) { return (x + 255) & ~(size_t)255; }
constexpr size_t WS_WIN = 4096;
constexpr size_t WS_WGLU = WS_WIN + (size_t)INC * DM * 2;
constexpr size_t WS_WA = WS_WGLU + (size_t)512 * 512 * 2;
constexpr size_t WS_WB = WS_WA + (size_t)1024 * 512 * 2;
constexpr size_t WS_WOUT = WS_WB + (size_t)1024 * 512 * 2;
constexpr size_t WS_MTC = WS_WOUT + (size_t)1024 * 1024 * 2;
constexpr size_t WS_BST = WS_MTC + (size_t)32 * 512 * UHK * 2;
constexpr size_t WS_ROPE = WS_BST + (size_t)32 * 256 * 512 * 2;
constexpr size_t WS_PW = WS_ROPE + (size_t)2 * SEQL * 32 * 4;
constexpr size_t WS_KT = WS_PW + (size_t)2 * 32 * 64 * 8;
constexpr size_t WS_Q = WS_KT + (size_t)32 * 2 * 32 * 256 * 4;
constexpr size_t WS_K = WS_Q + (size_t)TP * QKVW * 2;
constexpr size_t WS_VT = WS_K + (size_t)TP * QKVW * 2;
constexpr size_t WS_ZA = WS_VT + (size_t)TP * QKVW * 2;
constexpr size_t WS_ZB = WS_ZA + (size_t)TP * 512 * 2;
constexpr size_t WS_GA = WS_ZB + (size_t)TP * 512 * 2;
constexpr size_t WS_GB = WS_GA + (size_t)TP * 1024 * 2;
constexpr size_t WS_UH = WS_GB + (size_t)TP * 1024 * 2;
constexpr size_t WS_S = WS_UH + (size_t)32 * CHP * UHK * 2;
constexpr size_t WS_GAO = WS_S + (size_t)32 * CHP * 256 * 4;
constexpr size_t WS_BAR = WS_GAO + (size_t)TP * 512 * 2;
constexpr size_t WS_BAR_BYTES = 32768;
constexpr size_t WS_CTL = WS_BAR + WS_BAR_BYTES;
constexpr size_t WS_END = WS_CTL + 4096;
constexpr size_t WS_SB = WS_Q + (size_t)TP * 512 * 2;
constexpr size_t WS_M1 = WS_K;
constexpr size_t WS_ACC = WS_Q;
constexpr size_t OUT_HN_OFF = (size_t)SEQP * SEQL * DM * 4;

struct Args {
    const float* in[17];
    float* out;
    unsigned char* ws;
    int st_lo, st_hi;
    int do_sync, pad;
};

typedef __bf16 bf16v2 __attribute__((ext_vector_type(2)));
__device__ __forceinline__ unsigned cvt_pk_bf16(float lo, float hi) { const f32x2 v = (f32x2){lo, hi}; const bf16v2 r = __builtin_convertvector(v, bf16v2); return __builtin_bit_cast(unsigned, r); }
__device__ __forceinline__ float bf_lo(unsigned w) { return __uint_as_float(w << 16); }
__device__ __forceinline__ float bf_hi(unsigned w) { return __uint_as_float(w & 0xffff0000u); }
__device__ __forceinline__ float fast_rcp(float x) { return __builtin_amdgcn_rcpf(x); }
__device__ __forceinline__ float sigmoidf_(float x) { return fast_rcp(1.0f + __builtin_amdgcn_exp2f(-1.4426950408889634f * x)); }
__device__ __forceinline__ float siluf_(float x) { return x * sigmoidf_(x); }
__device__ __forceinline__ float gelu_tanh(float x) { const float u = x * (1.5957691216057308f + 0.07135481627260025f * x * x); return x * sigmoidf_(u); }
__device__ __forceinline__ float wave_sum(float v) {
#pragma unroll
    for (int o = 1; o < 64; o <<= 1) v += __shfl_xor(v, o);
    return v;
}
__device__ __forceinline__ const float* xrow_ptr(const float* xp, const float* xs, int tg) {
    return tg < 4 * SEQL ? xp + (size_t)tg * DM : xs + (size_t)(tg - 4 * SEQL) * DM;
}

constexpr int BM = 256, BK = 64, HALF = 128, HTB = HALF * BK * 2, STAGE_BYTES = 8 * HTB, NXCD = 8, WGM = 8;
__host__ __device__ __forceinline__ int lds_byte(int r, int c) { const int st = (r >> 4) * 2 + (c >> 5), rr = r & 15, cc = c & 31, ob = rr * 64 + cc * 2; return st * 1024 + (ob ^ (((ob >> 9) & 1) << 5)); }
__host__ __device__ __forceinline__ void stage_rc(int b, int& R, int& C) { const int st = b / 1024, sb = b % 1024, swz = sb ^ (((sb >> 9) & 1) << 5); R = (st >> 1) * 16 + swz / 64; C = (st & 1) * 32 + (swz % 64) / 2; }
__host__ __device__ __forceinline__ int perm32(int rho) { const int n = rho >> 4, i = rho & 15; return 8 * (i >> 2) + 4 * n + (i & 3); }

enum { MODE_PROJ = 0, MODE_S = 1, MODE_Y = 2, MODE_GLU = 3, MODE_A = 4, MODE_B = 5, MODE_OUT = 6 };
struct Unit { int pm, pn, bz; };
struct GemmD {
    const bf16_t* A; const bf16_t* Bt;
    int lda, ldb, K, nM, nN, nb;
    unsigned sA, sB;
    int mode, pass, lgnN;
    int u0, ustride, ucount;
};
__device__ __forceinline__ bool unit_next(const GemmD& g, int i, int G, int c, int& pm, int& pn, int& bz) {
    const bool ok = i < g.ucount;
    const int Li = ok ? g.u0 + i * g.ustride : 0;
    if (g.nb == 1) {
        const int lg = g.lgnN, q = (g.nM << lg) >> 3;
        const int wgid = (Li & 7) * q + (Li >> 3);
        const int gid = wgid >> (3 + lg), rem = wgid & ((8 << lg) - 1);
        pm = gid * 8 + (rem & 7); pn = rem >> 3; bz = 0;
    } else {
        const int nwg = g.nM * g.nN;
        const int w = Li % nwg; bz = Li / nwg; pm = w % g.nM; pn = w / g.nM;
    }
    return ok;
}

__device__ __forceinline__ void epilogue(const Args& a, LAS unsigned char* lds, const GemmD& g, const f32x4 (&acc)[2][2][4][2], const Unit& u, int wr, int wc, int fr, int fq) {
    asm volatile("" : "+v"(fr), "+v"(fq));
    unsigned char* ws = a.ws;
    const int rbase = u.pm * BM + wr * 64 + fr;
    const int cl = wc * 32 + fq * 8;
    if (g.mode == MODE_PROJ) {
        const int pn = u.pn;
        if (pn < 12) {
            const bool isq = pn < 6;
            bf16_t* dst = (bf16_t*)(ws + (isq ? WS_Q : WS_K));
            const float* rc = (const float*)(ws + WS_ROPE); const float* rs = rc + SEQL * 32;
            const int a4 = 4 * (4 * (wc & 1) + fq);
            const int pq = isq ? pn : pn - 6, gi = pq >> 1, sh = 2 * gi, dmask = (1 << sh) - 1, Lg = SEQL >> sh;
            const float sc = isq ? QSCALE : 1.0f;
#pragma unroll
            for (int ai = 0; ai < 2; ++ai) {
                asm volatile("" ::: "memory");
                f32x4 cvv[4], svv[4];
#pragma unroll
                for (int m = 0; m < 4; ++m) { const int pos = (rbase + ai * HALF + m * 16) & (SEQL - 1); cvv[m] = *(const f32x4*)(rc + pos * 32 + a4); svv[m] = *(const f32x4*)(rs + pos * 32 + a4); }
#pragma unroll
                for (int m = 0; m < 4; ++m) {
                    const int tl = rbase + ai * HALF + m * 16; const int pos = tl & (SEQL - 1), sq = tl >> 13;
                    const int kidx = (pos & dmask) * Lg + (pos >> sh);
                    const f32x4 cv = cvv[m] * sc, sv = svv[m] * sc;
#pragma unroll
                    for (int bj = 0; bj < 2; ++bj) {
                        const f32x4 x1 = acc[ai][bj][m][0], x2 = acc[ai][bj][m][1];
                        const f32x4 o1 = x1 * cv - x2 * sv, o2 = x2 * cv + x1 * sv;
                        const int head = pq * 4 + 2 * bj + (wc >> 1);
                        const int ch = 4 * (wc & 1) + fq;
                        bf16_t* p = dst + (size_t)(sq * 24 + head) * SEQL * 64 + (isq ? (size_t)kidx * 64 + ch * 8 : (size_t)(kidx >> 4) * 1024 + ch * 128 + (kidx & 15) * 8);
                        u32x4 w; w.x = cvt_pk_bf16(o1[0], o1[1]); w.y = cvt_pk_bf16(o1[2], o1[3]); w.z = cvt_pk_bf16(o2[0], o2[1]); w.w = cvt_pk_bf16(o2[2], o2[3]);
                        *(u32x4*)p = w;
                    }
                }
            }
        } else if (pn < 18) {
            bf16_t* dst = (bf16_t*)(ws + WS_VT);
            const int gi = (pn - 12) >> 1, sh = 2 * gi;
            const int wid = wr * 4 + wc, lane = fq * 16 + fr;
            LAS bf16_t* tile = (LAS bf16_t*)(lds + STAGE_BYTES + wid * 4096);
#pragma unroll
            for (int ai = 0; ai < 2; ++ai) {
                const int tl0 = u.pm * BM + wr * 64 + ai * HALF;
                const int pos0 = tl0 & (SEQL - 1), sq = tl0 >> 13;
#pragma unroll
                for (int bj = 0; bj < 2; ++bj) {
                    asm volatile("" ::: "memory");
                    const int h = (4 * (pn - 12) + 2 * bj + (wc >> 1)) & 7;
#pragma unroll
                    for (int m = 0; m < 4; ++m) {
                        const int t = 16 * m + fr;
                        const int slot = gi == 0 ? t : (gi == 1 ? ((t & 3) * 16 + (t >> 2)) : ((t & 15) * 4 + (t >> 4)));
#pragma unroll
                        for (int n = 0; n < 2; ++n)
#pragma unroll
                            for (int j = 0; j < 4; ++j) { const unsigned w = cvt_pk_bf16(acc[ai][bj][m][n][j], 0.f); tile[(8 * fq + 4 * n + j) * 64 + slot] = (bf16_t)(w & 0xffffu); }
                    }
                    bf16_t* hb0 = dst + (size_t)(((sq * 3 + gi) * 8 + h) * 512) * 1024;
#pragma unroll
                    for (int i = 0; i < 4; ++i) {
                        const int c = lane + 64 * i, d = c >> 3, s8 = (c & 7) * 8;
                        const u32x4 v = *(const LAS u32x4*)(tile + d * 64 + s8);
                        const int dg = 32 * (wc & 1) + d; const int doff = (dg >> 4) * 256 + (dg & 15) * 4;
                        if (gi == 0) { const int kidx = pos0 + s8; bf16_t* q = hb0 + (size_t)(kidx >> 4) * 1024 + doff + ((kidx & 15) >> 2) * 64; *(u32x2*)q = (u32x2){v.x, v.y}; *(u32x2*)(q + 64) = (u32x2){v.z, v.w}; }
                        else if (gi == 1) { const int kidx = (s8 >> 4) * 2048 + (pos0 >> 2) + (s8 & 15); bf16_t* q = hb0 + (size_t)(kidx >> 4) * 1024 + doff + ((kidx & 15) >> 2) * 64; *(u32x2*)q = (u32x2){v.x, v.y}; *(u32x2*)(q + 64) = (u32x2){v.z, v.w}; }
                        else { const int ka = (s8 >> 2) * 512 + (pos0 >> 4), kb = ka + 512;
                            *(u32x2*)(hb0 + (size_t)(ka >> 4) * 1024 + doff + ((ka & 15) >> 2) * 64) = (u32x2){v.x, v.y}; *(u32x2*)(hb0 + (size_t)(kb >> 4) * 1024 + doff + ((kb & 15) >> 2) * 64) = (u32x2){v.z, v.w}; }
                    }
                }
            }
        } else if (pn == 20 || pn == 21) {
            bf16_t* dst = (bf16_t*)(ws + WS_UH);
#pragma unroll
            for (int ai = 0; ai < 2; ++ai)
#pragma unroll
                for (int m = 0; m < 4; ++m) { asm volatile("" ::: "memory");
                    const int tl = rbase + ai * HALF + m * 16;
#pragma unroll
                    for (int bj = 0; bj < 2; ++bj) {
                        const int gg = 16 * (pn - 20) + 8 * bj + 2 * wc + (fq >> 1);
                        bf16_t* p = dst + ((size_t)(gg * CHP + (tl >> 5)) * UHK) + (tl & 31) * 16 + 8 * (fq & 1);
                        const f32x4 v0 = acc[ai][bj][m][0], v1 = acc[ai][bj][m][1];
                        u32x4 w; w.x = cvt_pk_bf16(v0[0], v0[1]); w.y = cvt_pk_bf16(v0[2], v0[3]); w.z = cvt_pk_bf16(v1[0], v1[1]); w.w = cvt_pk_bf16(v1[2], v1[3]);
                        *(u32x4*)p = w;
                    }
                }
        } else {
            bf16_t* dst; int ld, c0; bool silu;
            if (pn < 20) { dst = (bf16_t*)(ws + WS_ZA); ld = 512; c0 = (pn - 18) * 256; silu = true; }
            else if (pn < 24) { dst = (bf16_t*)(ws + WS_ZB); ld = 512; c0 = (pn - 22) * 256; silu = true; }
            else if (pn < 28) { dst = (bf16_t*)(ws + WS_GA); ld = 1024; c0 = (pn - 24) * 256; silu = false; }
            else { dst = (bf16_t*)(ws + WS_GB); ld = 1024; c0 = (pn - 28) * 256; silu = false; }
#pragma unroll
            for (int ai = 0; ai < 2; ++ai)
#pragma unroll
                for (int m = 0; m < 4; ++m) { asm volatile("" ::: "memory");
                    const int tl = rbase + ai * HALF + m * 16;
#pragma unroll
                    for (int bj = 0; bj < 2; ++bj) {
                        f32x4 v0 = acc[ai][bj][m][0], v1 = acc[ai][bj][m][1];
#pragma unroll
                        for (int j = 0; j < 4; ++j) { const float s0 = sigmoidf_(v0[j]), s1 = sigmoidf_(v1[j]); v0[j] = silu ? v0[j] * s0 : s0; v1[j] = silu ? v1[j] * s1 : s1; }
                        u32x4 w; w.x = cvt_pk_bf16(v0[0], v0[1]); w.y = cvt_pk_bf16(v0[2], v0[3]); w.z = cvt_pk_bf16(v1[0], v1[1]); w.w = cvt_pk_bf16(v1[2], v1[3]);
                        *(u32x4*)(dst + (size_t)tl * ld + c0 + cl + bj * HALF) = w;
                    }
                }
        }
    } else if (g.mode == MODE_S) {
        float* dst = (float*)(ws + WS_S) + (size_t)u.bz * CHP * 256;
#pragma unroll
        for (int ai = 0; ai < 2; ++ai)
#pragma unroll
            for (int m = 0; m < 4; ++m) { asm volatile("" ::: "memory");
                const int r = rbase + ai * HALF + m * 16;
#pragma unroll
                for (int bj = 0; bj < 2; ++bj) { float* p = dst + (size_t)r * 256 + cl + bj * HALF; *(f32x4*)p = acc[ai][bj][m][0]; *(f32x4*)(p + 4) = acc[ai][bj][m][1]; }
            }
    } else if (g.mode == MODE_Y) {
        bf16_t* dst = (bf16_t*)((unsigned char*)a.out + OUT_HN_OFF) + (size_t)g.pass * TP * DM;
#pragma unroll
        for (int ai = 0; ai < 2; ++ai)
#pragma unroll
            for (int m = 0; m < 4; ++m) { asm volatile("" ::: "memory");
                const int r = rbase + ai * HALF + m * 16;
#pragma unroll
                for (int bj = 0; bj < 2; ++bj) {
                    const int t = 16 * u.pn + 8 * bj + 2 * wc + (fq >> 1);
                    f32x4 v0 = acc[ai][bj][m][0], v1 = acc[ai][bj][m][1];
#pragma unroll
                    for (int j = 0; j < 4; ++j) { v0[j] = gelu_tanh(v0[j]); v1[j] = gelu_tanh(v1[j]); }
                    u32x4 w; w.x = cvt_pk_bf16(v0[0], v0[1]); w.y = cvt_pk_bf16(v0[2], v0[3]); w.z = cvt_pk_bf16(v1[0], v1[1]); w.w = cvt_pk_bf16(v1[2], v1[3]);
                    *(u32x4*)(dst + (size_t)(r * LC + t) * 512 + u.bz * 16 + 8 * (fq & 1)) = w;
                }
            }
    } else if (g.mode == MODE_GLU) {
        const bf16_t* sg = (const bf16_t*)((unsigned char*)a.out + OUT_HN_OFF) + (size_t)g.pass * TP * DM; const bf16_t* zb = (const bf16_t*)(ws + WS_ZB); bf16_t* dst = (bf16_t*)(ws + WS_SB);
#pragma unroll
        for (int ai = 0; ai < 2; ++ai) {
            asm volatile("" ::: "memory");
            u32x4 sv4[4][2], zv4[4][2];
#pragma unroll
            for (int m = 0; m < 4; ++m)
#pragma unroll
                for (int bj = 0; bj < 2; ++bj) { const size_t off = (size_t)(rbase + ai * HALF + m * 16) * 512 + u.pn * BM + cl + bj * HALF; sv4[m][bj] = *(const u32x4*)(sg + off); zv4[m][bj] = *(const u32x4*)(zb + off); }
#pragma unroll
            for (int m = 0; m < 4; ++m)
#pragma unroll
                for (int bj = 0; bj < 2; ++bj) {
                    const size_t off = (size_t)(rbase + ai * HALF + m * 16) * 512 + u.pn * BM + cl + bj * HALF;
                    const u32x4 s4 = sv4[m][bj], z4 = zv4[m][bj];
                    const f32x4 v0 = acc[ai][bj][m][0], v1 = acc[ai][bj][m][1];
                    u32x4 w;
                    w.x = cvt_pk_bf16(bf_lo(s4.x) * sigmoidf_(v0[0]) * bf_lo(z4.x), bf_hi(s4.x) * sigmoidf_(v0[1]) * bf_hi(z4.x));
                    w.y = cvt_pk_bf16(bf_lo(s4.y) * sigmoidf_(v0[2]) * bf_lo(z4.y), bf_hi(s4.y) * sigmoidf_(v0[3]) * bf_hi(z4.y));
                    w.z = cvt_pk_bf16(bf_lo(s4.z) * sigmoidf_(v1[0]) * bf_lo(z4.z), bf_hi(s4.z) * sigmoidf_(v1[1]) * bf_hi(z4.z));
                    w.w = cvt_pk_bf16(bf_lo(s4.w) * sigmoidf_(v1[2]) * bf_lo(z4.w), bf_hi(s4.w) * sigmoidf_(v1[3]) * bf_hi(z4.w));
                    *(u32x4*)(dst + off) = w;
                }
        }
    } else if (g.mode == MODE_A || g.mode == MODE_B) {
        const bool isb = g.mode == MODE_B;
        const bf16_t* gt = (const bf16_t*)(ws + (isb ? WS_GB : WS_GA)); bf16_t* dst = (bf16_t*)(ws + WS_M1);
#pragma unroll
        for (int ai = 0; ai < 2; ++ai) {
            asm volatile("" ::: "memory");
            u32x4 gv4[4][2], pv4[4][2];
#pragma unroll
            for (int m = 0; m < 4; ++m)
#pragma unroll
                for (int bj = 0; bj < 2; ++bj) { const size_t off = (size_t)(rbase + ai * HALF + m * 16) * 1024 + u.pn * BM + cl + bj * HALF; gv4[m][bj] = *(const u32x4*)(gt + off); pv4[m][bj] = (u32x4){0u, 0u, 0u, 0u}; if (isb) pv4[m][bj] = *(const u32x4*)(dst + off); }
#pragma unroll
            for (int m = 0; m < 4; ++m)
#pragma unroll
                for (int bj = 0; bj < 2; ++bj) {
                    const size_t off = (size_t)(rbase + ai * HALF + m * 16) * 1024 + u.pn * BM + cl + bj * HALF;
                    const u32x4 g4 = gv4[m][bj], p4 = pv4[m][bj];
                    const f32x4 v0 = acc[ai][bj][m][0], v1 = acc[ai][bj][m][1];
                    u32x4 w;
                    w.x = cvt_pk_bf16(bf_lo(p4.x) + bf_lo(g4.x) * v0[0], bf_hi(p4.x) + bf_hi(g4.x) * v0[1]);
                    w.y = cvt_pk_bf16(bf_lo(p4.y) + bf_lo(g4.y) * v0[2], bf_hi(p4.y) + bf_hi(g4.y) * v0[3]);
                    w.z = cvt_pk_bf16(bf_lo(p4.z) + bf_lo(g4.z) * v1[0], bf_hi(p4.z) + bf_hi(g4.z) * v1[1]);
                    w.w = cvt_pk_bf16(bf_lo(p4.w) + bf_lo(g4.w) * v1[2], bf_hi(p4.w) + bf_hi(g4.w) * v1[3]);
                    *(u32x4*)(dst + off) = w;
                }
        }
    } else {
        bf16_t* dst = (bf16_t*)(ws + WS_ACC);
#pragma unroll
        for (int ai = 0; ai < 2; ++ai)
#pragma unroll
            for (int m = 0; m < 4; ++m) {
                const int tl = rbase + ai * HALF + m * 16;
#pragma unroll
                for (int bj = 0; bj < 2; ++bj) {
                    const f32x4 v0 = acc[ai][bj][m][0], v1 = acc[ai][bj][m][1];
                    u32x4 w; w.x = cvt_pk_bf16(v0[0], v0[1]); w.y = cvt_pk_bf16(v0[2], v0[3]); w.z = cvt_pk_bf16(v1[0], v1[1]); w.w = cvt_pk_bf16(v1[2], v1[3]);
                    *(u32x4*)(dst + (size_t)tl * DM + u.pn * BM + cl + bj * HALF) = w;
                }
            }
    }
}

__device__ __forceinline__ void gemm_phase(const Args& a, LAS unsigned char* lds, const GemmD& g, int G, int cidx, int tid) {
    const int wid = __builtin_amdgcn_readfirstlane(tid >> 6), lane = tid & 63, wr = wid >> 2, wc = wid & 3, fr = lane & 15, fq = lane >> 4;
    const int K = g.K, nt = K / BK;
    unsigned voffA[2], voffB[2];
#pragma unroll
    for (int i = 0; i < 2; ++i) { int R, C; stage_rc(tid * 16 + i * 8192, R, C); const int Rb = (R & ~31) + perm32(R & 31);
        voffA[i] = (unsigned)(R * g.lda + C) * 2u; voffB[i] = (unsigned)(Rb * g.ldb + C) * 2u; }
    const size_t kstep = (size_t)(BK * 2);
    const size_t hstepA = (size_t)HALF * g.lda * 2, hstepB = (size_t)HALF * g.ldb * 2;
    const size_t tstepA = 2 * hstepA, tstepB = 2 * hstepB;
    const unsigned ldsw = (unsigned)wid * 1024u;
    const int aoff = lds_byte(wr * 64 + fr, fq * 8), boff = lds_byte(wc * 32 + fr, fq * 8);
#define PG8_SA(b, h) (((b) * 2 + (h)) * HTB)
#define PG8_SB(b, h) ((4 + (b) * 2 + (h)) * HTB)
#define PG8_STAGE(bufoff, gbase, voff) do { _Pragma("unroll") for (int _i = 0; _i < 2; ++_i) \
        __builtin_amdgcn_global_load_lds((const unsigned*)((const char*)(gbase) + (voff)[_i]), (LAS unsigned*)(lds + (bufoff) + ldsw + _i * 8192), 16, 0, 0); } while (0)
#define PG8_LDA(dst, b, h) do { _Pragma("unroll") for (int m = 0; m < 4; ++m) _Pragma("unroll") for (int k = 0; k < 2; ++k) dst[m][k] = *(const LAS bf16x8*)(lds + PG8_SA(b, h) + aoff + m * 2048 + k * 1024); } while (0)
#define PG8_LDB(dst, b, h) do { _Pragma("unroll") for (int n = 0; n < 2; ++n) _Pragma("unroll") for (int k = 0; k < 2; ++k) dst[n][k] = *(const LAS bf16x8*)(lds + PG8_SB(b, h) + boff + n * 2048 + k * 1024); } while (0)
#define PG8_MMA(ai, bj, At, Bt) do { __builtin_amdgcn_s_setprio(1); _Pragma("unroll") for (int m = 0; m < 4; ++m) _Pragma("unroll") for (int n = 0; n < 2; ++n) _Pragma("unroll") for (int k = 0; k < 2; ++k) \
        acc[ai][bj][m][n] = __builtin_amdgcn_mfma_f32_16x16x32_bf16(Bt[n][k], At[m][k], acc[ai][bj][m][n], 0, 0, 0); __builtin_amdgcn_s_setprio(0); } while (0)
#define PG8_WAIT_V(n) asm volatile("s_waitcnt vmcnt(" #n ")" ::: "memory")
#define PG8_WAIT_L(n) asm volatile("s_waitcnt lgkmcnt(" #n ")" ::: "memory")
#define PG8_BAR __builtin_amdgcn_s_barrier()
#define PG8_SCHED __builtin_amdgcn_sched_barrier(0)
    Unit cur, nxt; int ui = 0;
    { int pm_, pn_, bz_; if (!unit_next(g, 0, G, cidx, pm_, pn_, bz_)) return; cur.pm = pm_; cur.pn = pn_; cur.bz = bz_; }
    f32x4 acc[2][2][4][2];
#pragma unroll
    for (int a = 0; a < 2; ++a)
#pragma unroll
        for (int b = 0; b < 2; ++b)
#pragma unroll
            for (int m = 0; m < 4; ++m)
#pragma unroll
                for (int n = 0; n < 2; ++n) acc[a][b][m][n] = (f32x4){0.f, 0.f, 0.f, 0.f};
    bf16x8 At[4][2], B0[2][2], B1[2][2];
    const char* cA = (const char*)g.A + (size_t)cur.bz * g.sA + (size_t)cur.pm * tstepA; const char* cB = (const char*)g.Bt + (size_t)cur.bz * g.sB + (size_t)cur.pn * tstepB;
    PG8_STAGE(PG8_SB(0, 0), cB, voffB); PG8_STAGE(PG8_SA(0, 0), cA, voffA); PG8_STAGE(PG8_SB(0, 1), cB + hstepB, voffB); PG8_STAGE(PG8_SA(0, 1), cA + hstepA, voffA);
    if (wr == 1) PG8_BAR;
    PG8_WAIT_V(4); PG8_BAR;
    PG8_STAGE(PG8_SB(1, 0), cB + kstep, voffB); PG8_STAGE(PG8_SA(1, 0), cA + kstep, voffA); PG8_STAGE(PG8_SB(1, 1), cB + hstepB + kstep, voffB);
    PG8_WAIT_V(6); PG8_BAR;
    for (;;) {
        int npm, npn, nbz; const bool has_next = unit_next(g, ui + 1, G, cidx, npm, npn, nbz); nxt.pm = npm; nxt.pn = npn; nxt.bz = nbz;
        const char* nA = has_next ? (const char*)g.A + (size_t)nxt.bz * g.sA + (size_t)nxt.pm * tstepA : cA; const char* nB = has_next ? (const char*)g.Bt + (size_t)nxt.bz * g.sB + (size_t)nxt.pn * tstepB : cB;
        for (int t = 0; t < nt; t += 2) {
            const bool last = (t == nt - 2);
            const char* a1 = cA + (size_t)(t + 1) * kstep;
            const char* a2 = last ? nA : cA + (size_t)(t + 2) * kstep; const char* b2 = last ? nB : cB + (size_t)(t + 2) * kstep;
            const char* a3 = a2 + kstep; const char* b3 = b2 + kstep;
            PG8_LDB(B0, 0, 0); PG8_SCHED; PG8_LDA(At, 0, 0); PG8_STAGE(PG8_SA(1, 1), a1 + hstepA, voffA);
            PG8_WAIT_L(8); PG8_BAR; PG8_WAIT_L(0); PG8_MMA(0, 0, At, B0); PG8_BAR; PG8_SCHED;
            PG8_LDB(B1, 0, 1); PG8_STAGE(PG8_SB(0, 0), b2, voffB);
            PG8_BAR; PG8_WAIT_L(0); PG8_MMA(0, 1, At, B1); PG8_BAR;
            PG8_LDA(At, 0, 1); PG8_STAGE(PG8_SA(0, 0), a2, voffA);
            PG8_BAR; PG8_WAIT_L(0); PG8_MMA(1, 0, At, B0); PG8_BAR; PG8_SCHED;
            PG8_STAGE(PG8_SB(0, 1), b2 + hstepB, voffB);
            PG8_WAIT_V(6); PG8_BAR; PG8_MMA(1, 1, At, B1); PG8_BAR;
            PG8_LDB(B0, 1, 0); PG8_SCHED; PG8_LDA(At, 1, 0); PG8_STAGE(PG8_SA(0, 1), a2 + hstepA, voffA);
            PG8_WAIT_L(8); PG8_BAR; PG8_WAIT_L(0); PG8_MMA(0, 0, At, B0); PG8_BAR; PG8_SCHED;
            PG8_LDB(B1, 1, 1); PG8_STAGE(PG8_SB(1, 0), b3, voffB);
            PG8_BAR; PG8_WAIT_L(0); PG8_MMA(0, 1, At, B1); PG8_BAR;
            PG8_LDA(At, 1, 1); PG8_STAGE(PG8_SA(1, 0), a3, voffA);
            PG8_BAR; PG8_WAIT_L(0); PG8_MMA(1, 0, At, B0); PG8_BAR; PG8_SCHED;
            PG8_STAGE(PG8_SB(1, 1), b3 + hstepB, voffB);
            PG8_WAIT_V(6); PG8_BAR; PG8_MMA(1, 1, At, B1); PG8_BAR;
        }
#ifndef NO_EPI
        epilogue(a, lds, g, acc, cur, wr, wc, fr, fq);
#else
        if (g.mode == 99) *(f32x4*)(g.out) = acc[0][0][0][0] + acc[1][1][3][1] + acc[0][1][2][0]+acc[1][0][1][1];
#endif
        if (!has_next) break;
#pragma unroll
        for (int a = 0; a < 2; ++a)
#pragma unroll
            for (int b = 0; b < 2; ++b)
#pragma unroll
                for (int m = 0; m < 4; ++m)
#pragma unroll
                    for (int n = 0; n < 2; ++n) acc[a][b][m][n] = (f32x4){0.f, 0.f, 0.f, 0.f};
        cur = nxt; cA = nA; cB = nB; ++ui;
    }
    PG8_WAIT_V(0);
    if (wr == 0) PG8_BAR;
    PG8_BAR;
#undef PG8_SA
#undef PG8_SB
#undef PG8_STAGE
#undef PG8_LDA
#undef PG8_LDB
#undef PG8_MMA
#undef PG8_WAIT_V
#undef PG8_WAIT_L
#undef PG8_BAR
#undef PG8_SCHED
}

__device__ __forceinline__ int qk_perm_row(int n) { const int i = n & 63; return (n & ~63) + 8 * ((i & 31) >> 2) + (i & 3) + 4 * (i >> 5); }
__device__ __forceinline__ void transpose_item(const float* W, int K, int N, bf16_t* WT, bool permqk, LAS float* scr, int item, int lane) {
    const int nblk = N / 32, kb = item / nblk, nb = item % nblk, k0 = 64 * kb, n0 = 32 * nb;
#pragma unroll 8
    for (int i = 0; i < 32; ++i) { const int kk = 2 * i + (lane >> 5); scr[kk * 33 + (lane & 31)] = W[(size_t)(k0 + kk) * N + n0 + (lane & 31)]; }
    asm volatile("s_waitcnt lgkmcnt(0)" ::: "memory");
    const int c = lane & 7;
#pragma unroll
    for (int j = 0; j < 4; ++j) { const int n = (lane >> 3) + 8 * j; const LAS float* s = scr + (8 * c) * 33 + n;
        u32x4 o; o.x = cvt_pk_bf16(s[0 * 33], s[1 * 33]); o.y = cvt_pk_bf16(s[2 * 33], s[3 * 33]); o.z = cvt_pk_bf16(s[4 * 33], s[5 * 33]); o.w = cvt_pk_bf16(s[6 * 33], s[7 * 33]);
        int row = n0 + n; if (permqk && row < 2 * QKVW) row = qk_perm_row(row);
        *(u32x4*)(WT + (size_t)row * K + k0 + 8 * c) = o; }
    asm volatile("s_waitcnt lgkmcnt(0)" ::: "memory");
}
__device__ __forceinline__ void reduce_angle(double a, float& c, float& s) {
    const double k = __builtin_rint(a * 0.6366197723675814); const float x = (float)(a - k * 1.5707963267948966), x2 = x * x;
    const float sn = x * (1.0f + x2 * (-1.6666666667e-1f + x2 * (8.3333333333e-3f + x2 * (-1.9841269841e-4f + x2 * 2.7557319224e-6f))));
    const float cs = 1.0f + x2 * (-0.5f + x2 * (4.1666666667e-2f + x2 * (-1.3888888889e-3f + x2 * (2.4801587302e-5f + x2 * -2.7557319224e-7f))));
    const int q = ((int)k) & 3;
    c = (q == 0) ? cs : (q == 1) ? -sn : (q == 2) ? -cs : sn;
    s = (q == 0) ? sn : (q == 1) ? cs : (q == 2) ? -sn : -cs;
}
__device__ __forceinline__ void rms_row_to_bf16(const float* xrow, const float* gw, bf16_t* orow, int lane) {
    const f32x4* xr = (const f32x4*)xrow + lane; const f32x4* gr = (const f32x4*)gw + lane;
    f32x4 v[4]; float s = 0.f;
#pragma unroll
    for (int j = 0; j < 4; ++j) { v[j] = xr[64 * j]; s += (v[j].x * v[j].x + v[j].y * v[j].y) + (v[j].z * v[j].z + v[j].w * v[j].w); }
    const float rstd = 1.0f / sqrtf(wave_sum(s) * (1.f / DM) + EPSN);
    u32x2* o8 = (u32x2*)orow + lane;
#pragma unroll
    for (int j = 0; j < 4; ++j) { const f32x4 gv = gr[64 * j]; u32x2 w; w.x = cvt_pk_bf16(v[j].x * rstd * gv.x, v[j].y * rstd * gv.y); w.y = cvt_pk_bf16(v[j].z * rstd * gv.z, v[j].w * rstd * gv.w); o8[64 * j] = w; }
}

__device__ __forceinline__ void ssm_load_bc(const Args& a, int g, int dir, LAS f32x2* Bb, LAS f32x2* Cc, int tid) {
    const float* lam_re = a.in[4]; const float* lam_im = a.in[5]; const float* log_step = a.in[6];
    const float* b_re = a.in[7]; const float* b_im = a.in[8]; const float* c_re = a.in[9]; const float* c_im = a.in[10];
    const float dt = expf(log_step[dir * 32 + g]);
    for (int idx = tid; idx < 1024; idx += 512) {
        { const int n = idx >> 4; const float lr = lam_re[(dir * 32 + g) * 64 + n], li = lam_im[(dir * 32 + g) * 64 + n];
          const float ar = lr * dt; float cb, sb, ch, sh; reduce_angle((double)li * (double)dt, cb, sb); reduce_angle(0.5 * (double)li * (double)dt, ch, sh);
          const float em1 = expm1f(ar), ea = em1 + 1.0f;
          const float nr = em1 * cb - 2.0f * sh * sh, ni = ea * sb;
          const float den = 1.0f / (lr * lr + li * li); const float cr = (nr * lr + ni * li) * den, ci = (ni * lr - nr * li) * den;
          const float br = b_re[(size_t)((dir * 32 + g) * 64) * 16 + idx], bi = b_im[(size_t)((dir * 32 + g) * 64) * 16 + idx];
          Bb[idx] = (f32x2){cr * br - ci * bi, cr * bi + ci * br}; }
        { Cc[idx] = (f32x2){c_re[(size_t)((dir * 32 + g) * 16) * 64 + idx], c_im[(size_t)((dir * 32 + g) * 16) * 64 + idx]}; }
    }
}
__device__ __forceinline__ void ssm_setup_item(const Args& a, LAS unsigned char* lds, int item, int tid) {
    const int g = item >> 1, dir = item & 1;
    LAS f32x2* pw = (LAS f32x2*)lds; LAS f32x2* Bb = pw + 33 * 64; LAS f32x2* Cc = Bb + 1024;
    LAS float* KT = (LAS float*)(Cc + 1024); LAS float* K0 = KT + 32 * 256; LAS f32x2* Bb0 = (LAS f32x2*)(K0 + 256); LAS f32x2* Cc0 = Bb0 + 1024;
    const float* lam_re = a.in[4]; const float* lam_im = a.in[5]; const float* log_step = a.in[6];
    unsigned char* ws = a.ws;
    const float dt = expf(log_step[dir * 32 + g]);
    __syncthreads();
    for (int idx = tid; idx < 33 * 64; idx += 512) {
        const int tau = idx >> 6, n = idx & 63; const float lr = lam_re[(dir * 32 + g) * 64 + n], li = lam_im[(dir * 32 + g) * 64 + n];
        const float mag = expf(lr * dt * (float)tau); float c, s; reduce_angle((double)li * (double)dt * (double)tau, c, s);
        pw[idx] = (f32x2){mag * c, mag * s};
    }
    ssm_load_bc(a, g, dir, Bb, Cc, tid);
    if (dir == 1) ssm_load_bc(a, g, 0, Bb0, Cc0, tid);
    __syncthreads();
    if (tid < 64) { float* PW = (float*)(ws + WS_PW); const f32x2 p = pw[32 * 64 + tid]; PW[((dir * 32 + g) * 64 + tid) * 2] = p.x; PW[((dir * 32 + g) * 64 + tid) * 2 + 1] = p.y; }
    for (int o = tid; o < 32 * 256; o += 512) {
        const int tau = o >> 8, co = (o >> 4) & 15, ci = o & 15; float acc = 0.f;
_Pragma("unroll 4")
        for (int n = 0; n < 64; ++n) { const f32x2 c = Cc[co * 64 + n], p = pw[tau * 64 + n], b = Bb[n * 16 + ci]; const float tr = c.x * p.x - c.y * p.y, ti = c.x * p.y + c.y * p.x; acc += tr * b.x - ti * b.y; }
        KT[o] = acc; }
    if (dir == 1 && tid < 256) { const int co = tid >> 4, ci = tid & 15; float acc = 0.f;
_Pragma("unroll 4")
        for (int n = 0; n < 64; ++n) { const f32x2 c = Cc0[co * 64 + n], b = Bb0[n * 16 + ci]; acc += c.x * b.x - c.y * b.y; }
        K0[tid] = acc; }
    { bf16_t* BsT = (bf16_t*)(ws + WS_BST) + (size_t)g * 256 * 512;
      for (int ch = tid; ch < 128 * 64; ch += 512) {
          const int row = ch >> 6, part = row >> 6, n = row & 63, kc = ch & 63, s = kc >> 1, ci0 = (kc & 1) * 8; const int e = dir ? s : 31 - s; const f32x2 p = pw[e * 64 + n];
          float v[8];
#pragma unroll
          for (int j = 0; j < 8; ++j) { const f32x2 b = Bb[n * 16 + ci0 + j]; v[j] = part ? (p.x * b.y + p.y * b.x) : (p.x * b.x - p.y * b.y); }
          u32x4 w; w.x = cvt_pk_bf16(v[0], v[1]); w.y = cvt_pk_bf16(v[2], v[3]); w.z = cvt_pk_bf16(v[4], v[5]); w.w = cvt_pk_bf16(v[6], v[7]);
          *(u32x4*)(BsT + (size_t)(dir * 128 + row) * 512 + s * 16 + ci0) = w; } }
    bf16_t* MtC = (bf16_t*)(ws + WS_MTC) + (size_t)g * 512 * UHK;
    { for (int ch = tid; ch < 512 * 16; ch += 512) {
          const int row = ch >> 4, t = row >> 4, co = row & 15, cc = ch & 15, part = cc >> 3, n0 = (cc & 7) * 8; const int e = dir ? 32 - t : t + 1;
          float v[8];
#pragma unroll
          for (int j = 0; j < 8; ++j) { const f32x2 c = Cc[co * 64 + n0 + j], p = pw[e * 64 + n0 + j]; v[j] = part ? -(c.x * p.y + c.y * p.x) : (c.x * p.x - c.y * p.y); }
          u32x4 w; w.x = cvt_pk_bf16(v[0], v[1]); w.y = cvt_pk_bf16(v[2], v[3]); w.z = cvt_pk_bf16(v[4], v[5]); w.w = cvt_pk_bf16(v[6], v[7]);
          *(u32x4*)(MtC + (size_t)row * UHK + 512 + dir * 128 + part * 64 + n0) = w; } }
    __syncthreads();
    { const float* dsk = a.in[11];
      for (int ch = tid; ch < 512 * 64; ch += 512) {
          const int kc = ch & 63, row = ch >> 6; const int s = kc >> 1, ci0 = (kc & 1) * 8, t = row >> 4, co = row & 15;
          if (dir == 0 ? (t > s) : (s >= t)) {
              const int tau = dir == 0 ? t - s : s - t;
              float v[8];
#pragma unroll
              for (int j = 0; j < 8; ++j) v[j] = KT[tau * 256 + co * 16 + ci0 + j];
              if (t == s) { const float dv = dsk[g * 16 + co];
#pragma unroll
                  for (int j = 0; j < 8; ++j) v[j] += K0[co * 16 + ci0 + j] + ((ci0 + j == co) ? dv : 0.f); }
              u32x4 w; w.x = cvt_pk_bf16(v[0], v[1]); w.y = cvt_pk_bf16(v[2], v[3]); w.z = cvt_pk_bf16(v[4], v[5]); w.w = cvt_pk_bf16(v[6], v[7]);
              *(u32x4*)(MtC + (size_t)row * UHK + s * 16 + ci0) = w;
          }
      } }
    __syncthreads();
}

__device__ __forceinline__ void step_setup(const Args& a, LAS unsigned char* lds, int tid, int bx) {
    const int lane = tid & 63, wave = tid >> 6, G = gridDim.x;
    unsigned char* ws = a.ws;
    for (int it = bx; it < 64; it += G) ssm_setup_item(a, lds, it, tid);
    { float* rc = (float*)(ws + WS_ROPE); float* rs = rc + SEQL * 32;
      for (int idx = bx * 512 + tid; idx < SEQL * 32; idx += G * 512) {
          const int pos = idx >> 5, i = idx & 31; double inv = 1.0; for (int k = 0; k < i; ++k) inv *= 0.7498942093324558;
          float c, s; reduce_angle((double)pos * inv, c, s); rc[idx] = c; rs[idx] = s; } }
    { LAS float* scr = (LAS float*)(lds) + wave * (64 * 33);
      const int gw = bx * 8 + wave, NGW = G * 8;
      constexpr int I_IN = (DM / 64) * (INC / 32), I_GLU = (512 / 64) * (512 / 32), I_AB = (512 / 64) * (1024 / 32), I_OUT = (1024 / 64) * (1024 / 32);
      constexpr int NIT = I_IN + I_GLU + 2 * I_AB + I_OUT;
      for (int it = gw; it < NIT; it += NGW) {
          int r = it;
          if (r < I_IN) { transpose_item(a.in[3], DM, INC, (bf16_t*)(ws + WS_WIN), true, scr, r, lane); continue; } r -= I_IN;
          if (r < I_GLU) { transpose_item(a.in[12], 512, 512, (bf16_t*)(ws + WS_WGLU), false, scr, r, lane); continue; } r -= I_GLU;
          if (r < I_AB) { transpose_item(a.in[13], 512, 1024, (bf16_t*)(ws + WS_WA), false, scr, r, lane); continue; } r -= I_AB;
          if (r < I_AB) { transpose_item(a.in[14], 512, 1024, (bf16_t*)(ws + WS_WB), false, scr, r, lane); continue; } r -= I_AB;
          transpose_item(a.in[15], 1024, 1024, (bf16_t*)(ws + WS_WOUT), false, scr, r, lane);
      } }
    { bf16_t* hn = (bf16_t*)((unsigned char*)a.out + OUT_HN_OFF);
      const f32x4* gr = (const f32x4*)a.in[2] + lane;
      f32x4 gv[4];
#pragma unroll
      for (int j = 0; j < 4; ++j) gv[j] = gr[64 * j];
      unsigned* rctr = (unsigned*)(ws + WS_CTL) + 4;
      constexpr int RCH = 16;
      for (;;) {
          unsigned cidx = 0; if (lane == 0) cidx = atomicAdd(rctr, 1u);
          cidx = (unsigned)__builtin_amdgcn_readfirstlane((int)cidx);
          if (cidx >= (unsigned)(TTOK / RCH)) break;
          int row = (int)cidx * RCH; const int rend = row + RCH;
          f32x4 nx[4];
          { const f32x4* xr = (const f32x4*)xrow_ptr(a.in[0], a.in[1], row) + lane;
#pragma unroll
            for (int j = 0; j < 4; ++j) nx[j] = __builtin_nontemporal_load(xr + 64 * j); }
          for (; row < rend; ++row) {
              f32x4 v[4];
#pragma unroll
              for (int j = 0; j < 4; ++j) v[j] = nx[j];
              if (row + 1 < rend) { const f32x4* xn = (const f32x4*)xrow_ptr(a.in[0], a.in[1], row + 1) + lane;
#pragma unroll
                  for (int j = 0; j < 4; ++j) nx[j] = __builtin_nontemporal_load(xn + 64 * j); }
              float s = 0.f;
#pragma unroll
              for (int j = 0; j < 4; ++j) s += (v[j].x * v[j].x + v[j].y * v[j].y) + (v[j].z * v[j].z + v[j].w * v[j].w);
              const float rstd = 1.0f / sqrtf(wave_sum(s) * (1.f / DM) + EPSN);
              u32x2* o8 = (u32x2*)(hn + (size_t)row * DM) + lane;
#pragma unroll
              for (int j = 0; j < 4; ++j) { u32x2 w; w.x = cvt_pk_bf16(v[j].x * rstd * gv[j].x, v[j].y * rstd * gv[j].y); w.y = cvt_pk_bf16(v[j].z * rstd * gv[j].z, v[j].w * rstd * gv[j].w); o8[64 * j] = w; }
          }
      } }
}

__device__ __forceinline__ float quad_max(float x) {
    const auto r = __builtin_amdgcn_permlane32_swap(__float_as_uint(x), __float_as_uint(x), false, false);
    x = fmaxf(__uint_as_float(r[0]), __uint_as_float(r[1]));
    const auto q = __builtin_amdgcn_permlane16_swap(__float_as_uint(x), __float_as_uint(x), false, false);
    return fmaxf(__uint_as_float(q[0]), __uint_as_float(q[1]));
}
__device__ __forceinline__ float quad_sum(float x) {
    const auto r = __builtin_amdgcn_permlane32_swap(__float_as_uint(x), __float_as_uint(x), false, false);
    x = __uint_as_float(r[0]) + __uint_as_float(r[1]);
    const auto q = __builtin_amdgcn_permlane16_swap(__float_as_uint(x), __float_as_uint(x), false, false);
    return __uint_as_float(q[0]) + __uint_as_float(q[1]);
}
struct KVBuf { bf16x8 kA0, kA1, kB0, kB1; bf16x4 vA[4], vB[4]; };
__device__ __forceinline__ void step_params(int s, int& gi, int& ls) { gi = s < 12 ? 0 : (s < 18 ? 1 : 2); ls = s < 12 ? s : (s < 18 ? s - 12 : s - 18); }
__device__ __forceinline__ void attn_load(KVBuf& b, const bf16_t* Kp, const bf16_t* Vt, int s, int sq, int h, int blk, int r, int lane) {
    int gi, ls; step_params(s, gi, ls);
    const int sh = 2 * gi, Lg = SEQL >> sh, rho = r & ((1 << sh) - 1);
    int uA = ((256 * blk) >> sh) - 64 + 32 * ls, uB = uA + 16;
    if (uA < 0 || uA >= Lg) uA = 0; if (uB < 0 || uB >= Lg) uB = 0;
    const int kl = lane & 15, quad = lane >> 4;
    const bf16_t* kh = Kp + (size_t)(sq * 24 + gi * 8 + h) * SEQL * 64 + quad * 128 + kl * 8;
    const bf16_t* ka = kh + (size_t)((rho * Lg + uA) >> 4) * 1024; const bf16_t* kb = kh + (size_t)((rho * Lg + uB) >> 4) * 1024;
    b.kA0 = *(const bf16x8*)ka; b.kA1 = *(const bf16x8*)(ka + 512); b.kB0 = *(const bf16x8*)kb; b.kB1 = *(const bf16x8*)(kb + 512);
    const bf16_t* vbase = Vt + (size_t)(((sq * 3 + gi) * 8 + h) * 512) * 1024 + quad * 64 + kl * 4;
    const bf16_t* va = vbase + (size_t)((rho * Lg + uA) >> 4) * 1024; const bf16_t* vb = vbase + (size_t)((rho * Lg + uB) >> 4) * 1024;
#pragma unroll
    for (int dt = 0; dt < 4; ++dt) { b.vA[dt] = *(const bf16x4*)(va + dt * 256); b.vB[dt] = *(const bf16x4*)(vb + dt * 256); }
}
struct QF { bf16x8 a0, a1, b0, b1, c0, c1; };
template <int gi>
__device__ __forceinline__ void attn_compute(const KVBuf& b, const bf16x8 q0, const bf16x8 q1, f32x4 (&o)[4], float& mrun, float& lrun, int s, int blk, int r, int lane) {
    const int ls = gi == 0 ? s : (gi == 1 ? s - 12 : s - 18);
    const int sh = 2 * gi, Lg = SEQL >> sh;
    const int uA = ((256 * blk) >> sh) - 64 + 32 * ls;
    const int qi = lane & 15, quad = lane >> 4;
    const int uq = (256 * blk + r + 16 * qi) >> sh;
    const int lo = max(0, uq - 64), hi = min(Lg - 1, uq + 64);
    f32x4 sA = (f32x4){0.f, 0.f, 0.f, 0.f}, sB = sA;
    sA = __builtin_amdgcn_mfma_f32_16x16x32_bf16(b.kA0, q0, sA, 0, 0, 0); sA = __builtin_amdgcn_mfma_f32_16x16x32_bf16(b.kA1, q1, sA, 0, 0, 0);
    sB = __builtin_amdgcn_mfma_f32_16x16x32_bf16(b.kB0, q0, sB, 0, 0, 0); sB = __builtin_amdgcn_mfma_f32_16x16x32_bf16(b.kB1, q1, sB, 0, 0, 0);
    const float NEGINF = -__builtin_inff();
    const unsigned span = (unsigned)(hi - lo);
    float mx = NEGINF;
#pragma unroll
    for (int j = 0; j < 4; ++j) {
        const int ua = uA + quad * 4 + j, ub = ua + 16;
        sA[j] = ((unsigned)(ua - lo) <= span) ? sA[j] : NEGINF; sB[j] = ((unsigned)(ub - lo) <= span) ? sB[j] : NEGINF;
        mx = fmaxf(mx, fmaxf(sA[j], sB[j]));
    }
    mx = quad_max(mx);
    const float mnew = fmaxf(mrun, mx), alpha = __builtin_amdgcn_exp2f(mrun - mnew);
    mrun = mnew;
    float ps = 0.f;
#pragma unroll
    for (int j = 0; j < 4; ++j) { sA[j] = __builtin_amdgcn_exp2f(sA[j] - mnew); sB[j] = __builtin_amdgcn_exp2f(sB[j] - mnew); ps += sA[j] + sB[j]; }
    lrun = lrun * alpha + ps;
    u32x4 pw; pw.x = cvt_pk_bf16(sA[0], sA[1]); pw.y = cvt_pk_bf16(sA[2], sA[3]); pw.z = cvt_pk_bf16(sB[0], sB[1]); pw.w = cvt_pk_bf16(sB[2], sB[3]);
    const bf16x8 pf = __builtin_bit_cast(bf16x8, pw);
#pragma unroll
    for (int dt = 0; dt < 4; ++dt) {
        o[dt] *= alpha;
        bf16x8 vf; vf[0] = b.vA[dt][0]; vf[1] = b.vA[dt][1]; vf[2] = b.vA[dt][2]; vf[3] = b.vA[dt][3]; vf[4] = b.vB[dt][0]; vf[5] = b.vB[dt][1]; vf[6] = b.vB[dt][2]; vf[7] = b.vB[dt][3];
#ifdef DBG_ATT2
        for (int e = 0; e < 8; ++e) o[dt][e & 3] += 1e-3f * __uint_as_float(((unsigned)(unsigned short)vf[e]) << 16);
#else
        o[dt] = __builtin_amdgcn_mfma_f32_16x16x32_bf16(vf, pf, o[dt], 0, 0, 0);
#endif
    }
}
template <int gi>
__device__ __forceinline__ void attn_compute2(const KVBuf& b, const KVBuf& c, const bf16x8 q0, const bf16x8 q1, f32x4 (&o)[4], float& mrun, float& lrun, int s, int blk, int r, int lane) {
    const int ls = gi == 0 ? s : (gi == 1 ? s - 12 : s - 18);
    const int sh = 2 * gi, Lg = SEQL >> sh;
    const int uA = ((256 * blk) >> sh) - 64 + 32 * ls;
    const int qi = lane & 15, quad = lane >> 4;
    const int uq = (256 * blk + r + 16 * qi) >> sh;
    const int lo = max(0, uq - 64), hi = min(Lg - 1, uq + 64);
    const f32x4 z4 = (f32x4){0.f, 0.f, 0.f, 0.f};
    f32x4 sA = __builtin_amdgcn_mfma_f32_16x16x32_bf16(b.kA0, q0, z4, 0, 0, 0), sB = __builtin_amdgcn_mfma_f32_16x16x32_bf16(b.kB0, q0, z4, 0, 0, 0);
    f32x4 sC = __builtin_amdgcn_mfma_f32_16x16x32_bf16(c.kA0, q0, z4, 0, 0, 0), sD = __builtin_amdgcn_mfma_f32_16x16x32_bf16(c.kB0, q0, z4, 0, 0, 0);
    sA = __builtin_amdgcn_mfma_f32_16x16x32_bf16(b.kA1, q1, sA, 0, 0, 0); sB = __builtin_amdgcn_mfma_f32_16x16x32_bf16(b.kB1, q1, sB, 0, 0, 0);
    sC = __builtin_amdgcn_mfma_f32_16x16x32_bf16(c.kA1, q1, sC, 0, 0, 0); sD = __builtin_amdgcn_mfma_f32_16x16x32_bf16(c.kB1, q1, sD, 0, 0, 0);
    const float NEGINF = -__builtin_inff();
    const unsigned span = (unsigned)(hi - lo);
    float mx = NEGINF;
#pragma unroll
    for (int j = 0; j < 4; ++j) {
        const int ua = uA + quad * 4 + j;
        sA[j] = ((unsigned)(ua - lo) <= span) ? sA[j] : NEGINF; sB[j] = ((unsigned)(ua + 16 - lo) <= span) ? sB[j] : NEGINF;
        sC[j] = ((unsigned)(ua + 32 - lo) <= span) ? sC[j] : NEGINF; sD[j] = ((unsigned)(ua + 48 - lo) <= span) ? sD[j] : NEGINF;
        mx = fmaxf(fmaxf(mx, fmaxf(sA[j], sB[j])), fmaxf(sC[j], sD[j]));
    }
    mx = quad_max(mx);
    const float mnew = fmaxf(mrun, mx), alpha = __builtin_amdgcn_exp2f(mrun - mnew);
    mrun = mnew;
    float ps = 0.f;
#pragma unroll
    for (int j = 0; j < 4; ++j) { sA[j] = __builtin_amdgcn_exp2f(sA[j] - mnew); sB[j] = __builtin_amdgcn_exp2f(sB[j] - mnew); sC[j] = __builtin_amdgcn_exp2f(sC[j] - mnew); sD[j] = __builtin_amdgcn_exp2f(sD[j] - mnew); ps += (sA[j] + sB[j]) + (sC[j] + sD[j]); }
    lrun = lrun * alpha + ps;
    u32x4 pw, pv; pw.x = cvt_pk_bf16(sA[0], sA[1]); pw.y = cvt_pk_bf16(sA[2], sA[3]); pw.z = cvt_pk_bf16(sB[0], sB[1]); pw.w = cvt_pk_bf16(sB[2], sB[3]);
    pv.x = cvt_pk_bf16(sC[0], sC[1]); pv.y = cvt_pk_bf16(sC[2], sC[3]); pv.z = cvt_pk_bf16(sD[0], sD[1]); pv.w = cvt_pk_bf16(sD[2], sD[3]);
    const bf16x8 pf = __builtin_bit_cast(bf16x8, pw), pg = __builtin_bit_cast(bf16x8, pv);
#pragma unroll
    for (int dt = 0; dt < 4; ++dt) {
        o[dt] *= alpha;
        bf16x8 vf, vg;
        vf[0] = b.vA[dt][0]; vf[1] = b.vA[dt][1]; vf[2] = b.vA[dt][2]; vf[3] = b.vA[dt][3]; vf[4] = b.vB[dt][0]; vf[5] = b.vB[dt][1]; vf[6] = b.vB[dt][2]; vf[7] = b.vB[dt][3];
        vg[0] = c.vA[dt][0]; vg[1] = c.vA[dt][1]; vg[2] = c.vA[dt][2]; vg[3] = c.vA[dt][3]; vg[4] = c.vB[dt][0]; vg[5] = c.vB[dt][1]; vg[6] = c.vB[dt][2]; vg[7] = c.vB[dt][3];
        o[dt] = __builtin_amdgcn_mfma_f32_16x16x32_bf16(vf, pf, o[dt], 0, 0, 0);
        o[dt] = __builtin_amdgcn_mfma_f32_16x16x32_bf16(vg, pg, o[dt], 0, 0, 0);
    }
}
__device__ __forceinline__ void step_attention(const Args& a, LAS unsigned char* lds, int pass, int tid, int bx) {
    unsigned char* ws = a.ws;
    const int lane = tid & 63;
    const bf16_t* Qp = (const bf16_t*)(ws + WS_Q); const bf16_t* Kp = (const bf16_t*)(ws + WS_K); const bf16_t* Vt = (const bf16_t*)(ws + WS_VT);
    const bf16_t* ZA = (const bf16_t*)(ws + WS_ZA); bf16_t* GAO = (bf16_t*)(ws + WS_GAO);
    const int xcd = bx & 7;
    unsigned* ctr = (unsigned*)(ws + WS_CTL) + 16 + pass * 8 + xcd;
    LAS unsigned* slot = (LAS unsigned*)(lds + 3 * 16384);
    constexpr int NGRP = 3 * 32 * 2;
    for (;;) {
        __syncthreads();
        if (tid == 0) slot[0] = atomicAdd(ctr, 1u);
        __syncthreads();
        const unsigned grp = (unsigned)__builtin_amdgcn_readfirstlane((int)slot[0]);
        if (grp >= (unsigned)NGRP) break;
        const int wv_ = tid >> 6; const int r = ((wv_ & 3) << 2) + (wv_ >> 2) + 2 * (int)(grp & 1)  , blk = (grp >> 1) & 31, pair = xcd * 3 + (int)(grp >> 6);
        const int h = pair & 7, sq = pair >> 3;
        const int qi = lane & 15, quad = lane >> 4;
        const int tq = sq * SEQL + 256 * blk + r + 16 * qi;
        QF qf;
        { const int pos = 256 * blk + r + 16 * qi;
          const bf16_t* qa = Qp + ((size_t)(sq * 24 + h) * SEQL + pos) * 64 + quad * 8;
          const bf16_t* qb = Qp + ((size_t)(sq * 24 + 8 + h) * SEQL + (pos & 3) * 2048 + (pos >> 2)) * 64 + quad * 8;
          const bf16_t* qc = Qp + ((size_t)(sq * 24 + 16 + h) * SEQL + (pos & 15) * 512 + (pos >> 4)) * 64 + quad * 8;
          qf.a0 = *(const bf16x8*)qa; qf.a1 = *(const bf16x8*)(qa + 32); qf.b0 = *(const bf16x8*)qb; qf.b1 = *(const bf16x8*)(qb + 32); qf.c0 = *(const bf16x8*)qc; qf.c1 = *(const bf16x8*)(qc + 32); }
        f32x4 o[4];
#pragma unroll
        for (int dt = 0; dt < 4; ++dt) o[dt] = (f32x4){0.f, 0.f, 0.f, 0.f};
        float mrun = -1e30f, lrun = 0.f;
        KVBuf b0, b1;
#define ATT_SB __builtin_amdgcn_sched_barrier(0);
        {
            const int wv = tid >> 6, region = wv >> 1;
            const bf16_t* gsrc = (region < 2 ? Kp + (size_t)(sq * 24 + h) * SEQL * 64 : Vt + (size_t)((sq * 3) * 8 + h) * 512 * 1024) + (wv & 1) * 512 + lane * 8;
            const int ubase = 256 * blk - 64 + (region & 1) * 16;
#define ATT_DMA(S) do { int uT = ubase + 32 * (S); if (uT < 0 || uT >= SEQL) uT = 0; \
                __builtin_amdgcn_global_load_lds((const unsigned*)(gsrc + (size_t)(uT >> 4) * 1024), (LAS unsigned*)(lds + (((S) >> 1) % 3) * 16384 + ((S) & 1) * 8192 + wv * 1024), 16, 0, 0); } while (0)
            ATT_DMA(0); ATT_DMA(1); ATT_DMA(2); ATT_DMA(3);
            const int kl = lane & 15;
            const unsigned foff = (unsigned)(quad * 256 + kl * 16), voff = (unsigned)(4096 + quad * 128 + kl * 8);
#pragma unroll 1
            for (int d = 0; d < 6; ++d) {
                if (d < 5) asm volatile("s_waitcnt vmcnt(2)" ::: "memory"); else asm volatile("s_waitcnt vmcnt(0)" ::: "memory");
                __syncthreads();
                if (d + 2 < 6) { ATT_DMA(2 * d + 4); ATT_DMA(2 * d + 5); }
                LAS unsigned char* kb = lds + (d % 3) * 16384;
                b0.kA0 = *(const LAS bf16x8*)(kb + foff); b0.kA1 = *(const LAS bf16x8*)(kb + foff + 1024); b0.kB0 = *(const LAS bf16x8*)(kb + 2048 + foff); b0.kB1 = *(const LAS bf16x8*)(kb + 2048 + foff + 1024);
                b1.kA0 = *(const LAS bf16x8*)(kb + 8192 + foff); b1.kA1 = *(const LAS bf16x8*)(kb + 8192 + foff + 1024); b1.kB0 = *(const LAS bf16x8*)(kb + 8192 + 2048 + foff); b1.kB1 = *(const LAS bf16x8*)(kb + 8192 + 2048 + foff + 1024);
#pragma unroll
                for (int dt = 0; dt < 4; ++dt) { b0.vA[dt] = *(const LAS bf16x4*)(kb + voff + dt * 512); b0.vB[dt] = *(const LAS bf16x4*)(kb + 2048 + voff + dt * 512);
                                                 b1.vA[dt] = *(const LAS bf16x4*)(kb + 8192 + voff + dt * 512); b1.vB[dt] = *(const LAS bf16x4*)(kb + 8192 + 2048 + voff + dt * 512); }
                attn_compute2<0>(b0, b1, qf.a0, qf.a1, o, mrun, lrun, 2 * d, blk, r, lane);
            }
#undef ATT_DMA
        }
        attn_load(b0, Kp, Vt, 12, sq, h, blk, r, lane);
#define ATT_LOOP(GI, S0, S1, QA, QB) _Pragma("unroll 1") for (int s = S0; s < S1; s += 2) { \
            ATT_SB attn_load(b1, Kp, Vt, s + 1, sq, h, blk, r, lane); ATT_SB attn_compute<GI>(b0, QA, QB, o, mrun, lrun, s, blk, r, lane); \
            ATT_SB attn_load(b0, Kp, Vt, s + 2, sq, h, blk, r, lane); ATT_SB attn_compute<GI>(b1, QA, QB, o, mrun, lrun, s + 1, blk, r, lane); ATT_SB }
        ATT_LOOP(1, 12, 18, qf.b0, qf.b1)
        ATT_LOOP(2, 18, 22, qf.c0, qf.c1)
#undef ATT_LOOP
        attn_compute<2>(b0, qf.c0, qf.c1, o, mrun, lrun, 22, blk, r, lane);
        const float l = quad_sum(lrun);
        float inv = 1.0f / l;
#ifdef DBG_ATT1
        for (int dt = 0; dt < 4; ++dt) o[dt] = (f32x4){1.f, 1.f, 1.f, 1.f};
#endif
#pragma unroll
        for (int dt = 0; dt < 4; ++dt) {
            const size_t off = (size_t)tq * 512 + h * 64 + 16 * dt + 4 * quad;
            const u32x2 z = *(const u32x2*)(ZA + off);
            u32x2 w; w.x = cvt_pk_bf16(o[dt][0] * inv * bf_lo(z.x), o[dt][1] * inv * bf_hi(z.x)); w.y = cvt_pk_bf16(o[dt][2] * inv * bf_lo(z.y), o[dt][3] * inv * bf_hi(z.y));
            *(u32x2*)(GAO + off) = w;
        }
    }
}

__device__ __forceinline__ f32x2 cmul(f32x2 a, f32x2 b) { return (f32x2){a.x * b.x - a.y * b.y, a.x * b.y + a.y * b.x}; }
__device__ __forceinline__ void step_scan(const Args& a, LAS unsigned char* lds, int tid, int it0, int it1, int itstep) {
    unsigned char* ws = a.ws; const int G = gridDim.x;
    const float* PW = (const float*)(ws + WS_PW); const float* S = (const float*)(ws + WS_S); bf16_t* UH = (bf16_t*)(ws + WS_UH);
    LAS f32x2* carry = (LAS f32x2*)lds;
    for (int it = it0; it < it1; it += itstep) {
        const int dir = it & 1, g = (it >> 1) & 31, sq = it >> 6; const int seg = tid >> 6, n = tid & 63;
        const f32x2 P = (f32x2){PW[((dir * 32 + g) * 64 + n) * 2], PW[((dir * 32 + g) * 64 + n) * 2 + 1]};
        f32x2 z[32];
        { const int c0 = dir ? (NCH - 1 - seg * 32) : seg * 32; const long stp = dir ? -256 : 256;
          const float* sp = S + ((size_t)g * CHP + sq * NCH + c0) * 256 + dir * 128 + n;
#pragma unroll
          for (int i = 0; i < 32; ++i) { z[i] = (f32x2){sp[0], sp[64]}; sp += stp; } }
        f32x2 zz = (f32x2){0.f, 0.f};
#pragma unroll
        for (int i = 0; i < 32; ++i) { const f32x2 t = z[i]; z[i] = zz; zz = cmul(P, zz) + t; }
        __syncthreads();
        carry[seg * 64 + n] = zz;
        __syncthreads();
        f32x2 P32 = P;
#pragma unroll
        for (int k = 0; k < 5; ++k) P32 = cmul(P32, P32);
        f32x2 x = (f32x2){0.f, 0.f};
        for (int sp = 0; sp < seg; ++sp) x = cmul(P32, x) + carry[sp * 64 + n];
        f32x2 pwr = (f32x2){1.f, 0.f};
        { const int c0 = dir ? (NCH - 1 - seg * 32) : seg * 32; const long stp = dir ? -(long)UHK : (long)UHK;
          bf16_t* up = UH + ((size_t)g * CHP + sq * NCH + c0) * UHK + 512 + dir * 128 + n;
#pragma unroll
          for (int i = 0; i < 32; ++i) {
              const f32x2 hin = z[i] + cmul(pwr, x);
              up[0] = (bf16_t)(cvt_pk_bf16(hin.x, 0.f) & 0xffffu); up[64] = (bf16_t)(cvt_pk_bf16(hin.y, 0.f) & 0xffffu);
              pwr = cmul(pwr, P); up += stp;
          } }
    }
}

__device__ __forceinline__ void step_final_norm(const Args& a, int pass, int tid, int bx) {
    const int lane = tid & 63, wave = tid >> 6, G = gridDim.x;
    const f32x4* gr = (const f32x4*)a.in[16] + lane;
    f32x4 gv[4];
#pragma unroll
    for (int j = 0; j < 4; ++j) gv[j] = gr[64 * j];
    const bf16_t* accp = (const bf16_t*)(a.ws + WS_ACC);
    int row = bx * 8 + wave;
    f32x4 nx[4]; u32x2 na[4];
    if (row < TP) { const f32x4* xr = (const f32x4*)xrow_ptr(a.in[0], a.in[1], pass * TP + row) + lane; const u32x2* ar = (const u32x2*)(accp + (size_t)row * DM) + lane;
#pragma unroll
        for (int j = 0; j < 4; ++j) { nx[j] = __builtin_nontemporal_load(xr + 64 * j); na[j] = ar[64 * j]; } }
    for (; row < TP; row += G * 8) {
        f32x4 v[4];
#pragma unroll
        for (int j = 0; j < 4; ++j) v[j] = nx[j] + (f32x4){bf_lo(na[j].x), bf_hi(na[j].x), bf_lo(na[j].y), bf_hi(na[j].y)};
        const int nrow = row + G * 8;
        if (nrow < TP) { const f32x4* xn = (const f32x4*)xrow_ptr(a.in[0], a.in[1], pass * TP + nrow) + lane; const u32x2* an = (const u32x2*)(accp + (size_t)nrow * DM) + lane;
#pragma unroll
            for (int j = 0; j < 4; ++j) { nx[j] = __builtin_nontemporal_load(xn + 64 * j); na[j] = an[64 * j]; } }
        float s = 0.f;
#pragma unroll
        for (int j = 0; j < 4; ++j) s += (v[j].x * v[j].x + v[j].y * v[j].y) + (v[j].z * v[j].z + v[j].w * v[j].w);
        const float rstd = 1.0f / sqrtf(wave_sum(s) * (1.f / DM) + EPSN);
        f32x4* xr = (f32x4*)(a.out + (size_t)(pass * TP + row) * DM) + lane;
#pragma unroll
        for (int j = 0; j < 4; ++j) __builtin_nontemporal_store(v[j] * rstd * gv[j], xr + 64 * j);
    }
}


#define XB_TMO      128
#define XB_XCNT(j)  (256  + 64 * (j))
#define XB_XSUB(j)  (1280 + 64 * (j))
#define XB_XGEN(j)  (2304 + 64 * (j))
#define XB_TOP      3328
#define XB_TOPGEN   3392
#define XCD_BAR_WORDS 3456
#define XB_SLOT(b)  (4096 + 2 * (b))
#define XB_SPIN_CAP (1u << 18)
__device__ __forceinline__ unsigned xb_ld(unsigned* p)              { return __hip_atomic_load(p, __ATOMIC_RELAXED, __HIP_MEMORY_SCOPE_AGENT); }
__device__ __forceinline__ unsigned xb_add(unsigned* p, unsigned v) { return __hip_atomic_fetch_add(p, v, __ATOMIC_RELAXED, __HIP_MEMORY_SCOPE_AGENT); }
__device__ __forceinline__ unsigned xb_xcc_id() { return (unsigned)__builtin_amdgcn_s_getreg((3 << 11) | 20) & 0xFu; }
#define XB_SPIN(cond, bar) do { unsigned _sp = 0; while (cond) { __builtin_amdgcn_s_sleep(1); \
    if ((++_sp & 255u) == 0u) { if (xb_ld(&(bar)[XB_TMO])) break; if (_sp > XB_SPIN_CAP) { atomicAdd(&(bar)[XB_TMO], 1u); break; } } } } while (0)
__device__ __forceinline__ void xcd_barrier_complete(unsigned* bar, unsigned x, unsigned& nloc, unsigned& nx) {
    const unsigned G = gridDim.x;
    unsigned sum, cnt, mine, sp = 0u;
    for (;;) {
        sum = 0u; cnt = 0u; mine = 0u;
#pragma unroll
        for (unsigned j = 0; j < 16; ++j) { const unsigned c = xb_ld(&bar[XB_XCNT(j)]); sum += c; cnt += (c > 0u) ? 1u : 0u; mine = (j == x) ? c : mine; }
        if (sum == G) break;
        __builtin_amdgcn_s_sleep(1);
        if ((++sp & 255u) == 0u) { if (xb_ld(&bar[XB_TMO])) break; if (sp > XB_SPIN_CAP) { atomicAdd(&bar[XB_TMO], 1u); break; } }
    }
    nloc = mine > 0u ? mine : 1u; nx = cnt > 0u ? cnt : 1u;
}
__device__ __forceinline__ void xcd_barrier(unsigned* bar) {
    asm volatile("s_waitcnt vmcnt(0)" ::: "memory");
    __syncthreads();
    if (threadIdx.x == 0) {
        __builtin_amdgcn_s_waitcnt(0);
        const unsigned x = xb_xcc_id();
        unsigned* slot = bar + XB_SLOT(blockIdx.x);
        unsigned nloc = xb_ld(slot), nx = xb_ld(slot + 1);
        if (nloc == 0u) { xcd_barrier_complete(bar, x, nloc, nx); __hip_atomic_store(slot, nloc, __ATOMIC_RELAXED, __HIP_MEMORY_SCOPE_AGENT); __hip_atomic_store(slot + 1, nx, __ATOMIC_RELAXED, __HIP_MEMORY_SCOPE_AGENT); }
        const unsigned old = xb_add(&bar[XB_XSUB(x)], 1u);
        const unsigned gen = old / nloc;
        if (old + 1u == (gen + 1u) * nloc) {
            __builtin_amdgcn_fence(__ATOMIC_RELEASE, "agent");
            asm volatile("s_waitcnt vmcnt(0)" ::: "memory");
            const unsigned og = xb_add(&bar[XB_TOP], 1u);
            const unsigned tg = og / nx;
            if (og + 1u == (tg + 1u) * nx) xb_add(&bar[XB_TOPGEN], 1u);
            else XB_SPIN(xb_ld(&bar[XB_TOPGEN]) == tg, bar);
            __builtin_amdgcn_fence(__ATOMIC_ACQUIRE, "agent");
            xb_add(&bar[XB_XGEN(x)], 1u);
            asm volatile("s_waitcnt vmcnt(0)" ::: "memory");
        } else {
            XB_SPIN(xb_ld(&bar[XB_XGEN(x)]) == gen, bar);
            __builtin_amdgcn_fence(__ATOMIC_ACQUIRE, "agent");
            asm volatile("s_waitcnt vmcnt(0)" ::: "memory");
        }
    }
    __syncthreads();
}

constexpr int NSTEPS = 1 + 10 * NPASS;
__host__ __device__ __forceinline__ bool sync_after(int st) { if (st == 0) return true; const int k = (st - 1) % 10; return !(k == 1 || k == 6 || k == 9); }

__global__ void __launch_bounds__(512, 2) fwd_kernel(Args a) {
    extern __shared__ __attribute__((aligned(16))) unsigned char lds_raw[];
    LAS unsigned char* lds = (LAS unsigned char*)lds_raw;
    cg::grid_group grid = cg::this_grid();
    const int G = gridDim.x;
    unsigned char* ws = a.ws;
    unsigned* bar = (unsigned*)(ws + WS_BAR);
    if (a.do_sync == 2) grid.sync();
    if (a.do_sync && threadIdx.x == 0) (void)xb_add(&bar[XB_XCNT(xb_xcc_id())], 1u);
    for (int st = a.st_lo; st < a.st_hi; ++st) {
        int tid = threadIdx.x, bx = blockIdx.x;
        asm volatile("" : "+v"(tid), "+s"(bx));
#ifndef NO_SETUP
        if (st == 0) { step_setup(a, lds, tid, bx); }
#else
        if (st == 0) {}
#endif
        else {
            const int pass = (st - 1) / 10, k = (st - 1) % 10;
            GemmD g; g.lgnN = 0; g.pass = pass; g.nb = 1; g.sA = 0; g.sB = 0;
            bool has_gemm = true;
            const bool fz = (G == 256);
            const bool split_ay = false;
            const bf16_t* sgp = (const bf16_t*)((unsigned char*)a.out + OUT_HN_OFF) + (size_t)pass * TP * DM;
#define DESC_Y { g.A = (const bf16_t*)(ws + WS_UH); g.lda = UHK; g.sA = (unsigned)(CHP * UHK * 2); g.Bt = (const bf16_t*)(ws + WS_MTC); g.ldb = UHK; g.sB = (unsigned)(512 * UHK * 2); g.K = UHK; g.nM = CHP / BM; g.nN = 2; g.nb = 32; g.mode = MODE_Y; }
#define DESC_A { g.A = (const bf16_t*)(ws + WS_GAO); g.lda = 512; g.Bt = (const bf16_t*)(ws + WS_WA); g.ldb = 512; g.K = 512; g.nM = TP / BM; g.nN = 4; g.lgnN = 2; g.mode = MODE_A; }
#define DESC_GLU { g.A = sgp; g.lda = 512; g.Bt = (const bf16_t*)(ws + WS_WGLU); g.ldb = 512; g.K = 512; g.nM = TP / BM; g.nN = 2; g.lgnN = 1; g.mode = MODE_GLU; }
#define DESC_NONE { has_gemm = false; g.A = nullptr; g.Bt = nullptr; g.lda = g.ldb = g.K = 0; g.nM = g.nN = 0; g.mode = 0; }
            switch (k) {
            case 0: g.A = (const bf16_t*)((unsigned char*)a.out + OUT_HN_OFF) + (size_t)pass * TP * DM; g.lda = DM; g.Bt = (const bf16_t*)(ws + WS_WIN); g.ldb = DM; g.K = DM; g.nM = TP / BM; g.nN = INC / BM; g.lgnN = 5; g.mode = MODE_PROJ; break;
            case 1: g.A = (const bf16_t*)(ws + WS_UH); g.lda = UHK; g.sA = (unsigned)(CHP * UHK * 2); g.Bt = (const bf16_t*)(ws + WS_BST); g.ldb = 512; g.sB = (unsigned)(256 * 512 * 2); g.K = 512; g.nM = CHP / BM; g.nN = 1; g.nb = 32; g.mode = MODE_S; break;
            case 2: if (fz) DESC_Y else DESC_NONE break;
            case 4: if (fz) { if (bx < 128) DESC_A else DESC_GLU } else DESC_Y break;
            case 5: if (fz) DESC_NONE else DESC_GLU break;
            case 6: if (fz) DESC_NONE else DESC_A break;
            case 7: g.A = (const bf16_t*)(ws + WS_SB); g.lda = 512; g.Bt = (const bf16_t*)(ws + WS_WB); g.ldb = 512; g.K = 512; g.nM = TP / BM; g.nN = 4; g.lgnN = 2; g.mode = MODE_B; break;
            case 8: g.A = (const bf16_t*)(ws + WS_M1); g.lda = 1024; g.Bt = (const bf16_t*)(ws + WS_WOUT); g.ldb = 1024; g.K = 1024; g.nM = TP / BM; g.nN = 4; g.lgnN = 2; g.mode = MODE_OUT; break;
            default: DESC_NONE break;
            }
#undef DESC_Y
#undef DESC_A
#undef DESC_GLU
#undef DESC_NONE
            { const int total = g.nM * g.nN * g.nb; g.u0 = bx; g.ustride = G; g.ucount = total > bx ? (total - bx + G - 1) / G : 0; }
            if (fz && k == 2) { g.u0 = (bx / SEQP) * 6 + (bx % SEQP); g.ustride = SEQP; g.ucount = bx < SEQP * 32 ? 2 : 0; }
            if (fz && k == 4) { if (bx < 128) { g.u0 = bx; g.ustride = 128; g.ucount = 3; } else { g.u0 = bx - 128; g.ustride = 128; g.ucount = (bx - 128) < 64 ? 2 : 1; } }
            const bool fuse_scan = (G >= SEQP * 32);
            if (has_gemm) {
#ifndef NO_GEMM
                gemm_phase(a, lds, g, G, bx, tid);
#endif
#ifndef NO_SCAN
                if (k == 1 && fuse_scan && bx < SEQP * 32) {
                    asm volatile("s_waitcnt vmcnt(0)" ::: "memory"); __syncthreads();
                    const int it0 = (bx % SEQP) * 64 + (bx / SEQP) * 2;
                    step_scan(a, lds, tid, it0, it0 + 2, 1);
                    asm volatile("s_waitcnt vmcnt(0)" ::: "memory"); __syncthreads();
                }
#endif
            }
#ifndef NO_ATTN
            else if (k == (fz ? 3 : 2)) step_attention(a, lds, pass, tid, bx);
#endif
#ifndef NO_SCAN
            else if (k == 3 && !fz && !fuse_scan) step_scan(a, lds, tid, bx, SEQP * 32 * 2, G);
#endif
            else if (k == 9) step_final_norm(a, pass, tid, bx);
        }
        { bool need = sync_after(st) && !(st > 0 && (st - 1) % 10 == 3 && G >= SEQP * 32);
          if (G == 256 && st > 0) { const int kk = (st - 1) % 10; need = (kk == 0 || kk == 3 || kk == 4 || kk == 7 || kk == 8); }
          if (a.do_sync && st + 1 < a.st_hi && need) xcd_barrier(bar); }
    }
}

extern "C" void kernel_launch(void* const* d_in, const int* in_sizes, int n_in, void* d_out, int out_size, void* d_ws, size_t ws_size, hipStream_t stream) {
    constexpr int LDS_BYTES = STAGE_BYTES + 32768;
    static int grid = 0;
    if (grid == 0) {
        if (n_in != 17 || out_size != TTOK * DM || ws_size < WS_END) { fprintf(stderr, "kernel_launch: unexpected shapes (n_in %d out %d ws %zu need %zu)\n", n_in, out_size, ws_size, (size_t)WS_END); grid = -1; return; }
        int dev = 0, cus = 0, per_cu = 0;
        hipGetDevice(&dev); hipDeviceGetAttribute(&cus, hipDeviceAttributeMultiprocessorCount, dev);
        hipFuncSetAttribute((const void*)fwd_kernel, hipFuncAttributeMaxDynamicSharedMemorySize, LDS_BYTES);
        hipOccupancyMaxActiveBlocksPerMultiprocessor(&per_cu, (const void*)fwd_kernel, 512, LDS_BYTES);
        if (per_cu < 1) per_cu = 1;
        grid = cus * 1;
        (void)hipGetLastError();
    }
    if (grid < 0) return;
    (void)hipMemsetAsync((unsigned char*)d_ws + WS_BAR, 0, WS_BAR_BYTES + 4096, stream);
    Args a{};
    for (int i = 0; i < 17; ++i) a.in[i] = (const float*)d_in[i];
    a.out = (float*)d_out; a.ws = (unsigned char*)d_ws; a.pad = 0;
#ifndef MULTI_LAUNCH
#define MULTI_LAUNCH 0
#endif
#if MULTI_LAUNCH
    a.do_sync = 0;
    for (int st = 0; st < NSTEPS; ++st) {
        a.st_lo = st; a.st_hi = st + 1;
        hipLaunchKernelGGL(fwd_kernel, dim3(grid), dim3(512), LDS_BYTES, stream, a);
    }
#else
    a.do_sync = 1; a.st_lo = 0; a.st_hi = NSTEPS;
    void* args[] = {&a};
    hipError_t e = hipLaunchCooperativeKernel((const void*)fwd_kernel, dim3(grid), dim3(512), args, LDS_BYTES, stream);
    if (e != hipSuccess) fprintf(stderr, "cooperative launch failed: %s (grid %d)\n", hipGetErrorString(e), grid);
#endif
}
```

```cpp
#include <hip/hip_runtime.h>
#include <hip/hip_cooperative_groups.h>
#include <cstdio>

namespace cg = cooperative_groups;

#define LAS __attribute__((address_space(3)))
typedef unsigned short bf16_t;
typedef short bf16x8 __attribute__((ext_vector_type(8)));
typedef short bf16x4 __attribute__((ext_vector_type(4)));
typedef float f32x4 __attribute__((ext_vector_type(4)));
typedef float f32x2 __attribute__((ext_vector_type(2)));
typedef unsigned u32x4 __attribute__((ext_vector_type(4)));
typedef unsigned u32x2 __attribute__((ext_vector_type(2)));

constexpr int DM = 1024, SEQL = 8192, NSEQ = 6, TTOK = NSEQ * SEQL;
constexpr int NPASS = 2, SEQP = 3, TP = SEQP * SEQL;
constexpr int INC = 8192, QKVW = 1536;
constexpr int LC = 32, NCH = SEQL / LC  , CHP = SEQP * NCH  ;
constexpr int UHK = LC * 16 + 256;
constexpr float EPSN = 1e-6f;
constexpr float QSCALE = 0.18033688011112042f;

constexpr size_t AL(size_t x) { return (x + 255) & ~(size_t)255; }
constexpr size_t WS_WIN = 4096;
constexpr size_t WS_WGLU = WS_WIN + (size_t)INC * DM * 2;
constexpr size_t WS_WA = WS_WGLU + (size_t)512 * 512 * 2;
constexpr size_t WS_WB = WS_WA + (size_t)1024 * 512 * 2;
constexpr size_t WS_WOUT = WS_WB + (size_t)1024 * 512 * 2;
constexpr size_t WS_MTC = WS_WOUT + (size_t)1024 * 1024 * 2;
constexpr size_t WS_BST = WS_MTC + (size_t)32 * 512 * UHK * 2;
constexpr size_t WS_ROPE = WS_BST + (size_t)32 * 256 * 512 * 2;
constexpr size_t WS_PW = WS_ROPE + (size_t)2 * SEQL * 32 * 4;
constexpr size_t WS_KT = WS_PW + (size_t)2 * 32 * 64 * 8;
constexpr size_t WS_Q = WS_KT + (size_t)32 * 2 * 32 * 256 * 4;
constexpr size_t WS_K = WS_Q + (size_t)TP * QKVW * 2;
constexpr size_t WS_VT = WS_K + (size_t)TP * QKVW * 2;
constexpr size_t WS_ZA = WS_VT + (size_t)TP * QKVW * 2;
constexpr size_t WS_ZB = WS_ZA + (size_t)TP * 512 * 2;
constexpr size_t WS_GA = WS_ZB + (size_t)TP * 512 * 2;
constexpr size_t WS_GB = WS_GA + (size_t)TP * 1024 * 2;
constexpr size_t WS_UH = WS_GB + (size_t)TP * 1024 * 2;
constexpr size_t WS_S = WS_UH + (size_t)32 * CHP * UHK * 2;
constexpr size_t WS_GAO = WS_S + (size_t)32 * CHP * 256 * 4;
constexpr size_t WS_BAR = WS_GAO + (size_t)TP * 512 * 2;
constexpr size_t WS_BAR_BYTES = 32768;
constexpr size_t WS_CTL = WS_BAR + WS_BAR_BYTES;
constexpr size_t WS_END = WS_CTL + 4096;
constexpr size_t WS_SB = WS_Q + (size_t)TP * 512 * 2;
constexpr size_t WS_M1 = WS_K;
constexpr size_t WS_ACC = WS_Q;
constexpr size_t OUT_HN_OFF = (size_t)SEQP * SEQL * DM * 4;

struct Args {
    const float* in[17];
    float* out;
    unsigned char* ws;
    int st_lo, st_hi;
    int do_sync, pad;
};

typedef __bf16 bf16v2 __attribute__((ext_vector_type(2)));
__device__ __forceinline__ unsigned cvt_pk_bf16(float lo, float hi) { const f32x2 v = (f32x2){lo, hi}; const bf16v2 r = __builtin_convertvector(v, bf16v2); return __builtin_bit_cast(unsigned, r); }
__device__ __forceinline__ float bf_lo(unsigned w) { return __uint_as_float(w << 16); }
__device__ __forceinline__ float bf_hi(unsigned w) { return __uint_as_float(w & 0xffff0000u); }
__device__ __forceinline__ float fast_rcp(float x) { return __builtin_amdgcn_rcpf(x); }
__device__ __forceinline__ float sigmoidf_(float x) { return fast_rcp(1.0f + __builtin_amdgcn_exp2f(-1.4426950408889634f * x)); }
__device__ __forceinline__ float siluf_(float x) { return x * sigmoidf_(x); }
__device__ __forceinline__ float gelu_tanh(float x) { const float u = x * (1.5957691216057308f + 0.07135481627260025f * x * x); return x * sigmoidf_(u); }
__device__ __forceinline__ float wave_sum(float v) {
#pragma unroll
    for (int o = 1; o < 64; o <<= 1) v += __shfl_xor(v, o);
    return v;
}
__device__ __forceinline__ const float* xrow_ptr(const float* xp, const float* xs, int tg) {
    return tg < 4 * SEQL ? xp + (size_t)tg * DM : xs + (size_t)(tg - 4 * SEQL) * DM;
}

constexpr int BM = 256, BK = 64, HALF = 128, HTB = HALF * BK * 2, STAGE_BYTES = 8 * HTB, NXCD = 8, WGM = 8;
__host__ __device__ __forceinline__ int lds_byte(int r, int c) { const int st = (r >> 4) * 2 + (c >> 5), rr = r & 15, cc = c & 31, ob = rr * 64 + cc * 2; return st * 1024 + (ob ^ (((ob >> 9) & 1) << 5)); }
__host__ __device__ __forceinline__ void stage_rc(int b, int& R, int& C) { const int st = b / 1024, sb = b % 1024, swz = sb ^ (((sb >> 9) & 1) << 5); R = (st >> 1) * 16 + swz / 64; C = (st & 1) * 32 + (swz % 64) / 2; }
__host__ __device__ __forceinline__ int perm32(int rho) { const int n = rho >> 4, i = rho & 15; return 8 * (i >> 2) + 4 * n + (i & 3); }

enum { MODE_PROJ = 0, MODE_S = 1, MODE_Y = 2, MODE_GLU = 3, MODE_A = 4, MODE_B = 5, MODE_OUT = 6 };
struct Unit { int pm, pn, bz; };
struct GemmD {
    const bf16_t* A; const bf16_t* Bt;
    int lda, ldb, K, nM, nN, nb;
    unsigned sA, sB;
    int mode, pass, lgnN;
    int u0, ustride, ucount;
};
__device__ __forceinline__ bool unit_next(const GemmD& g, int i, int G, int c, int& pm, int& pn, int& bz) {
    const bool ok = i < g.ucount;
    const int Li = ok ? g.u0 + i * g.ustride : 0;
    if (g.nb == 1) {
        const int lg = g.lgnN, q = (g.nM << lg) >> 3;
        const int wgid = (Li & 7) * q + (Li >> 3);
        const int gid = wgid >> (3 + lg), rem = wgid & ((8 << lg) - 1);
        pm = gid * 8 + (rem & 7); pn = rem >> 3; bz = 0;
    } else {
        const int nwg = g.nM * g.nN;
        const int w = Li % nwg; bz = Li / nwg; pm = w % g.nM; pn = w / g.nM;
    }
    return ok;
}

__device__ __forceinline__ void epilogue(const Args& a, LAS unsigned char* lds, const GemmD& g, const f32x4 (&acc)[2][2][4][2], const Unit& u, int wr, int wc, int fr, int fq) {
    asm volatile("" : "+v"(fr), "+v"(fq));
    unsigned char* ws = a.ws;
    const int rbase = u.pm * BM + wr * 64 + fr;
    const int cl = wc * 32 + fq * 8;
    if (g.mode == MODE_PROJ) {
        const int pn = u.pn;
        if (pn < 12) {
            const bool isq = pn < 6;
            bf16_t* dst = (bf16_t*)(ws + (isq ? WS_Q : WS_K));
            const float* rc = (const float*)(ws + WS_ROPE); const float* rs = rc + SEQL * 32;
            const int a4 = 4 * (4 * (wc & 1) + fq);
            const int pq = isq ? pn : pn - 6, gi = pq >> 1, sh = 2 * gi, dmask = (1 << sh) - 1, Lg = SEQL >> sh;
            const float sc = isq ? QSCALE : 1.0f;
            const int pos0 = rbase & (SEQL - 1);
            const f32x4 cb = *(const f32x4*)(rc + pos0 * 32 + a4), sb = *(const f32x4*)(rs + pos0 * 32 + a4);
            const f32x4 c16 = *(const f32x4*)(rc + 16 * 32 + a4), s16 = *(const f32x4*)(rs + 16 * 32 + a4);
            const f32x4 c128 = *(const f32x4*)(rc + 128 * 32 + a4), s128 = *(const f32x4*)(rs + 128 * 32 + a4);
#pragma unroll
            for (int ai = 0; ai < 2; ++ai) {
                asm volatile("" ::: "memory");
                f32x4 cvv[4], svv[4];
                cvv[0] = ai ? cb * c128 - sb * s128 : cb; svv[0] = ai ? sb * c128 + cb * s128 : sb;
#pragma unroll
                for (int m = 1; m < 4; ++m) { cvv[m] = cvv[m - 1] * c16 - svv[m - 1] * s16; svv[m] = svv[m - 1] * c16 + cvv[m - 1] * s16; }
#pragma unroll
                for (int m = 0; m < 4; ++m) {
                    const int tl = rbase + ai * HALF + m * 16; const int pos = tl & (SEQL - 1), sq = tl >> 13;
                    const int kidx = (pos & dmask) * Lg + (pos >> sh);
                    const f32x4 cv = cvv[m] * sc, sv = svv[m] * sc;
#pragma unroll
                    for (int bj = 0; bj < 2; ++bj) {
                        const f32x4 x1 = acc[ai][bj][m][0], x2 = acc[ai][bj][m][1];
                        const f32x4 o1 = x1 * cv - x2 * sv, o2 = x2 * cv + x1 * sv;
                        const int head = pq * 4 + 2 * bj + (wc >> 1);
                        const int ch = 4 * (wc & 1) + fq;
                        bf16_t* p = dst + (size_t)(sq * 24 + head) * SEQL * 64 + (isq ? (size_t)kidx * 64 + ch * 8 : (size_t)(kidx >> 4) * 1024 + ch * 128 + (kidx & 15) * 8);
                        u32x4 w; w.x = cvt_pk_bf16(o1[0], o1[1]); w.y = cvt_pk_bf16(o1[2], o1[3]); w.z = cvt_pk_bf16(o2[0], o2[1]); w.w = cvt_pk_bf16(o2[2], o2[3]);
                        *(u32x4*)p = w;
                    }
                }
            }
        } else if (pn < 18) {
            bf16_t* dst = (bf16_t*)(ws + WS_VT);
            const int gi = (pn - 12) >> 1, sh = 2 * gi;
            const int wid = wr * 4 + wc, lane = fq * 16 + fr;
            LAS bf16_t* tile = (LAS bf16_t*)(lds + STAGE_BYTES + wid * 4096);
#pragma unroll
            for (int ai = 0; ai < 2; ++ai) {
                const int tl0 = u.pm * BM + wr * 64 + ai * HALF;
                const int pos0 = tl0 & (SEQL - 1), sq = tl0 >> 13;
#pragma unroll
                for (int bj = 0; bj < 2; ++bj) {
                    asm volatile("" ::: "memory");
                    const int h = (4 * (pn - 12) + 2 * bj + (wc >> 1)) & 7;
#pragma unroll
                    for (int m = 0; m < 4; ++m) {
                        const int t = 16 * m + fr;
                        const int slot = gi == 0 ? t : (gi == 1 ? ((t & 3) * 16 + (t >> 2)) : ((t & 15) * 4 + (t >> 4)));
#pragma unroll
                        for (int n = 0; n < 2; ++n)
#pragma unroll
                            for (int j = 0; j < 4; ++j) { const unsigned w = cvt_pk_bf16(acc[ai][bj][m][n][j], 0.f); tile[(8 * fq + 4 * n + j) * 64 + slot] = (bf16_t)(w & 0xffffu); }
                    }
                    bf16_t* hb0 = dst + (size_t)(((sq * 3 + gi) * 8 + h) * 512) * 1024;
#pragma unroll
                    for (int i = 0; i < 4; ++i) {
                        const int c = lane + 64 * i, d = c >> 3, s8 = (c & 7) * 8;
                        const u32x4 v = *(const LAS u32x4*)(tile + d * 64 + s8);
                        const int dg = 32 * (wc & 1) + d; const int doff = (dg >> 4) * 256 + (dg & 15) * 4;
                        if (gi == 0) { const int kidx = pos0 + s8; bf16_t* q = hb0 + (size_t)(kidx >> 4) * 1024 + doff + ((kidx & 15) >> 2) * 64; *(u32x2*)q = (u32x2){v.x, v.y}; *(u32x2*)(q + 64) = (u32x2){v.z, v.w}; }
                        else if (gi == 1) { const int kidx = (s8 >> 4) * 2048 + (pos0 >> 2) + (s8 & 15); bf16_t* q = hb0 + (size_t)(kidx >> 4) * 1024 + doff + ((kidx & 15) >> 2) * 64; *(u32x2*)q = (u32x2){v.x, v.y}; *(u32x2*)(q + 64) = (u32x2){v.z, v.w}; }
                        else { const int ka = (s8 >> 2) * 512 + (pos0 >> 4), kb = ka + 512;
                            *(u32x2*)(hb0 + (size_t)(ka >> 4) * 1024 + doff + ((ka & 15) >> 2) * 64) = (u32x2){v.x, v.y}; *(u32x2*)(hb0 + (size_t)(kb >> 4) * 1024 + doff + ((kb & 15) >> 2) * 64) = (u32x2){v.z, v.w}; }
                    }
                }
            }
        } else if (pn == 20 || pn == 21) {
            bf16_t* dst = (bf16_t*)(ws + WS_UH);
#pragma unroll
            for (int ai = 0; ai < 2; ++ai)
#pragma unroll
                for (int m = 0; m < 4; ++m) { asm volatile("" ::: "memory");
                    const int tl = rbase + ai * HALF + m * 16;
#pragma unroll
                    for (int bj = 0; bj < 2; ++bj) {
                        const int gg = 16 * (pn - 20) + 8 * bj + 2 * wc + (fq >> 1);
                        bf16_t* p = dst + ((size_t)(gg * CHP + (tl >> 5)) * UHK) + (tl & 31) * 16 + 8 * (fq & 1);
                        const f32x4 v0 = acc[ai][bj][m][0], v1 = acc[ai][bj][m][1];
                        u32x4 w; w.x = cvt_pk_bf16(v0[0], v0[1]); w.y = cvt_pk_bf16(v0[2], v0[3]); w.z = cvt_pk_bf16(v1[0], v1[1]); w.w = cvt_pk_bf16(v1[2], v1[3]);
                        *(u32x4*)p = w;
                    }
                }
        } else {
            bf16_t* dst; int ld, c0; bool silu;
            if (pn < 20) { dst = (bf16_t*)(ws + WS_ZA); ld = 512; c0 = (pn - 18) * 256; silu = true; }
            else if (pn < 24) { dst = (bf16_t*)(ws + WS_ZB); ld = 512; c0 = (pn - 22) * 256; silu = true; }
            else if (pn < 28) { dst = (bf16_t*)(ws + WS_GA); ld = 1024; c0 = (pn - 24) * 256; silu = false; }
            else { dst = (bf16_t*)(ws + WS_GB); ld = 1024; c0 = (pn - 28) * 256; silu = false; }
#pragma unroll
            for (int ai = 0; ai < 2; ++ai)
#pragma unroll
                for (int m = 0; m < 4; ++m) { asm volatile("" ::: "memory");
                    const int tl = rbase + ai * HALF + m * 16;
#pragma unroll
                    for (int bj = 0; bj < 2; ++bj) {
                        f32x4 v0 = acc[ai][bj][m][0], v1 = acc[ai][bj][m][1];
#pragma unroll
                        for (int j = 0; j < 4; ++j) { const float s0 = sigmoidf_(v0[j]), s1 = sigmoidf_(v1[j]); v0[j] = silu ? v0[j] * s0 : s0; v1[j] = silu ? v1[j] * s1 : s1; }
                        u32x4 w; w.x = cvt_pk_bf16(v0[0], v0[1]); w.y = cvt_pk_bf16(v0[2], v0[3]); w.z = cvt_pk_bf16(v1[0], v1[1]); w.w = cvt_pk_bf16(v1[2], v1[3]);
                        *(u32x4*)(dst + (size_t)tl * ld + c0 + cl + bj * HALF) = w;
                    }
                }
        }
    } else if (g.mode == MODE_S) {
        float* dst = (float*)(ws + WS_S) + (size_t)u.bz * CHP * 256;
#pragma unroll
        for (int ai = 0; ai < 2; ++ai)
#pragma unroll
            for (int m = 0; m < 4; ++m) { asm volatile("" ::: "memory");
                const int r = rbase + ai * HALF + m * 16;
#pragma unroll
                for (int bj = 0; bj < 2; ++bj) { float* p = dst + (size_t)r * 256 + cl + bj * HALF; *(f32x4*)p = acc[ai][bj][m][0]; *(f32x4*)(p + 4) = acc[ai][bj][m][1]; }
            }
    } else if (g.mode == MODE_Y) {
        bf16_t* dst = (bf16_t*)((unsigned char*)a.out + OUT_HN_OFF) + (size_t)g.pass * TP * DM;
#pragma unroll
        for (int ai = 0; ai < 2; ++ai)
#pragma unroll
            for (int m = 0; m < 4; ++m) { asm volatile("" ::: "memory");
                const int r = rbase + ai * HALF + m * 16;
#pragma unroll
                for (int bj = 0; bj < 2; ++bj) {
                    const int t = 16 * u.pn + 8 * bj + 2 * wc + (fq >> 1);
                    f32x4 v0 = acc[ai][bj][m][0], v1 = acc[ai][bj][m][1];
#pragma unroll
                    for (int j = 0; j < 4; ++j) { v0[j] = gelu_tanh(v0[j]); v1[j] = gelu_tanh(v1[j]); }
                    u32x4 w; w.x = cvt_pk_bf16(v0[0], v0[1]); w.y = cvt_pk_bf16(v0[2], v0[3]); w.z = cvt_pk_bf16(v1[0], v1[1]); w.w = cvt_pk_bf16(v1[2], v1[3]);
                    *(u32x4*)(dst + (size_t)(r * LC + t) * 512 + u.bz * 16 + 8 * (fq & 1)) = w;
                }
            }
    } else if (g.mode == MODE_GLU) {
        const bf16_t* sg = (const bf16_t*)((unsigned char*)a.out + OUT_HN_OFF) + (size_t)g.pass * TP * DM; const bf16_t* zb = (const bf16_t*)(ws + WS_ZB); bf16_t* dst = (bf16_t*)(ws + WS_SB);
#pragma unroll
        for (int ai = 0; ai < 2; ++ai) {
            asm volatile("" ::: "memory");
            u32x4 sv4[4][2], zv4[4][2];
#pragma unroll
            for (int m = 0; m < 4; ++m)
#pragma unroll
                for (int bj = 0; bj < 2; ++bj) { const size_t off = (size_t)(rbase + ai * HALF + m * 16) * 512 + u.pn * BM + cl + bj * HALF; sv4[m][bj] = *(const u32x4*)(sg + off); zv4[m][bj] = *(const u32x4*)(zb + off); }
#pragma unroll
            for (int m = 0; m < 4; ++m)
#pragma unroll
                for (int bj = 0; bj < 2; ++bj) {
                    const size_t off = (size_t)(rbase + ai * HALF + m * 16) * 512 + u.pn * BM + cl + bj * HALF;
                    const u32x4 s4 = sv4[m][bj], z4 = zv4[m][bj];
                    const f32x4 v0 = acc[ai][bj][m][0], v1 = acc[ai][bj][m][1];
                    u32x4 w;
                    w.x = cvt_pk_bf16(bf_lo(s4.x) * sigmoidf_(v0[0]) * bf_lo(z4.x), bf_hi(s4.x) * sigmoidf_(v0[1]) * bf_hi(z4.x));
                    w.y = cvt_pk_bf16(bf_lo(s4.y) * sigmoidf_(v0[2]) * bf_lo(z4.y), bf_hi(s4.y) * sigmoidf_(v0[3]) * bf_hi(z4.y));
                    w.z = cvt_pk_bf16(bf_lo(s4.z) * sigmoidf_(v1[0]) * bf_lo(z4.z), bf_hi(s4.z) * sigmoidf_(v1[1]) * bf_hi(z4.z));
                    w.w = cvt_pk_bf16(bf_lo(s4.w) * sigmoidf_(v1[2]) * bf_lo(z4.w), bf_hi(s4.w) * sigmoidf_(v1[3]) * bf_hi(z4.w));
                    *(u32x4*)(dst + off) = w;
                }
        }
    } else if (g.mode == MODE_A || g.mode == MODE_B) {
        const bool isb = g.mode == MODE_B;
        const bf16_t* gt = (const bf16_t*)(ws + (isb ? WS_GB : WS_GA)); bf16_t* dst = (bf16_t*)(ws + WS_M1);
#pragma unroll
        for (int ai = 0; ai < 2; ++ai) {
            asm volatile("" ::: "memory");
            u32x4 gv4[4][2], pv4[4][2];
#pragma unroll
            for (int m = 0; m < 4; ++m)
#pragma unroll
                for (int bj = 0; bj < 2; ++bj) { const size_t off = (size_t)(rbase + ai * HALF + m * 16) * 1024 + u.pn * BM + cl + bj * HALF; gv4[m][bj] = *(const u32x4*)(gt + off); pv4[m][bj] = (u32x4){0u, 0u, 0u, 0u}; if (isb) pv4[m][bj] = *(const u32x4*)(dst + off); }
#pragma unroll
            for (int m = 0; m < 4; ++m)
#pragma unroll
                for (int bj = 0; bj < 2; ++bj) {
                    const size_t off = (size_t)(rbase + ai * HALF + m * 16) * 1024 + u.pn * BM + cl + bj * HALF;
                    const u32x4 g4 = gv4[m][bj], p4 = pv4[m][bj];
                    const f32x4 v0 = acc[ai][bj][m][0], v1 = acc[ai][bj][m][1];
                    u32x4 w;
                    w.x = cvt_pk_bf16(bf_lo(p4.x) + bf_lo(g4.x) * v0[0], bf_hi(p4.x) + bf_hi(g4.x) * v0[1]);
                    w.y = cvt_pk_bf16(bf_lo(p4.y) + bf_lo(g4.y) * v0[2], bf_hi(p4.y) + bf_hi(g4.y) * v0[3]);
                    w.z = cvt_pk_bf16(bf_lo(p4.z) + bf_lo(g4.z) * v1[0], bf_hi(p4.z) + bf_hi(g4.z) * v1[1]);
                    w.w = cvt_pk_bf16(bf_lo(p4.w) + bf_lo(g4.w) * v1[2], bf_hi(p4.w) + bf_hi(g4.w) * v1[3]);
                    *(u32x4*)(dst + off) = w;
                }
        }
    } else {
        bf16_t* dst = (bf16_t*)(ws + WS_ACC);
#pragma unroll
        for (int ai = 0; ai < 2; ++ai)
#pragma unroll
            for (int m = 0; m < 4; ++m) {
                const int tl = rbase + ai * HALF + m * 16;
#pragma unroll
                for (int bj = 0; bj < 2; ++bj) {
                    const f32x4 v0 = acc[ai][bj][m][0], v1 = acc[ai][bj][m][1];
                    u32x4 w; w.x = cvt_pk_bf16(v0[0], v0[1]); w.y = cvt_pk_bf16(v0[2], v0[3]); w.z = cvt_pk_bf16(v1[0], v1[1]); w.w = cvt_pk_bf16(v1[2], v1[3]);
                    *(u32x4*)(dst + (size_t)tl * DM + u.pn * BM + cl + bj * HALF) = w;
                }
            }
    }
}

__device__ __forceinline__ void gemm_phase(const Args& a, LAS unsigned char* lds, const GemmD& g, int G, int cidx, int tid) {
    const int wid = __builtin_amdgcn_readfirstlane(tid >> 6), lane = tid & 63, wr = wid >> 2, wc = wid & 3, fr = lane & 15, fq = lane >> 4;
    const int K = g.K, nt = K / BK;
    unsigned voffA[2], voffB[2];
#pragma unroll
    for (int i = 0; i < 2; ++i) { int R, C; stage_rc(tid * 16 + i * 8192, R, C); const int Rb = (R & ~31) + perm32(R & 31);
        voffA[i] = (unsigned)(R * g.lda + C) * 2u; voffB[i] = (unsigned)(Rb * g.ldb + C) * 2u; }
    const size_t kstep = (size_t)(BK * 2);
    const size_t hstepA = (size_t)HALF * g.lda * 2, hstepB = (size_t)HALF * g.ldb * 2;
    const size_t tstepA = 2 * hstepA, tstepB = 2 * hstepB;
    const unsigned ldsw = (unsigned)wid * 1024u;
    const int aoff = lds_byte(wr * 64 + fr, fq * 8), boff = lds_byte(wc * 32 + fr, fq * 8);
#define PG8_SA(b, h) (((b) * 2 + (h)) * HTB)
#define PG8_SB(b, h) ((4 + (b) * 2 + (h)) * HTB)
#define PG8_STAGE(bufoff, gbase, voff) do { _Pragma("unroll") for (int _i = 0; _i < 2; ++_i) \
        __builtin_amdgcn_global_load_lds((const unsigned*)((const char*)(gbase) + (voff)[_i]), (LAS unsigned*)(lds + (bufoff) + ldsw + _i * 8192), 16, 0, 0); } while (0)
#define PG8_LDA(dst, b, h) do { _Pragma("unroll") for (int m = 0; m < 4; ++m) _Pragma("unroll") for (int k = 0; k < 2; ++k) dst[m][k] = *(const LAS bf16x8*)(lds + PG8_SA(b, h) + aoff + m * 2048 + k * 1024); } while (0)
#define PG8_LDB(dst, b, h) do { _Pragma("unroll") for (int n = 0; n < 2; ++n) _Pragma("unroll") for (int k = 0; k < 2; ++k) dst[n][k] = *(const LAS bf16x8*)(lds + PG8_SB(b, h) + boff + n * 2048 + k * 1024); } while (0)
#define PG8_MMA(ai, bj, At, Bt) do { __builtin_amdgcn_s_setprio(1); _Pragma("unroll") for (int m = 0; m < 4; ++m) _Pragma("unroll") for (int n = 0; n < 2; ++n) _Pragma("unroll") for (int k = 0; k < 2; ++k) \
        acc[ai][bj][m][n] = __builtin_amdgcn_mfma_f32_16x16x32_bf16(Bt[n][k], At[m][k], acc[ai][bj][m][n], 0, 0, 0); __builtin_amdgcn_s_setprio(0); } while (0)
#define PG8_WAIT_V(n) asm volatile("s_waitcnt vmcnt(" #n ")" ::: "memory")
#define PG8_WAIT_L(n) asm volatile("s_waitcnt lgkmcnt(" #n ")" ::: "memory")
#define PG8_BAR __builtin_amdgcn_s_barrier()
#define PG8_SCHED __builtin_amdgcn_sched_barrier(0)
    Unit cur, nxt; int ui = 0;
    { int pm_, pn_, bz_; if (!unit_next(g, 0, G, cidx, pm_, pn_, bz_)) return; cur.pm = pm_; cur.pn = pn_; cur.bz = bz_; }
    f32x4 acc[2][2][4][2];
#pragma unroll
    for (int a = 0; a < 2; ++a)
#pragma unroll
        for (int b = 0; b < 2; ++b)
#pragma unroll
            for (int m = 0; m < 4; ++m)
#pragma unroll
                for (int n = 0; n < 2; ++n) acc[a][b][m][n] = (f32x4){0.f, 0.f, 0.f, 0.f};
    bf16x8 At[4][2], B0[2][2], B1[2][2];
    const char* cA = (const char*)g.A + (size_t)cur.bz * g.sA + (size_t)cur.pm * tstepA; const char* cB = (const char*)g.Bt + (size_t)cur.bz * g.sB + (size_t)cur.pn * tstepB;
    PG8_STAGE(PG8_SB(0, 0), cB, voffB); PG8_STAGE(PG8_SA(0, 0), cA, voffA); PG8_STAGE(PG8_SB(0, 1), cB + hstepB, voffB); PG8_STAGE(PG8_SA(0, 1), cA + hstepA, voffA);
    if (wr == 1) PG8_BAR;
    PG8_WAIT_V(4); PG8_BAR;
    PG8_STAGE(PG8_SB(1, 0), cB + kstep, voffB); PG8_STAGE(PG8_SA(1, 0), cA + kstep, voffA); PG8_STAGE(PG8_SB(1, 1), cB + hstepB + kstep, voffB);
    PG8_WAIT_V(6); PG8_BAR;
    for (;;) {
        int npm, npn, nbz; const bool has_next = unit_next(g, ui + 1, G, cidx, npm, npn, nbz); nxt.pm = npm; nxt.pn = npn; nxt.bz = nbz;
        const char* nA = has_next ? (const char*)g.A + (size_t)nxt.bz * g.sA + (size_t)nxt.pm * tstepA : cA; const char* nB = has_next ? (const char*)g.Bt + (size_t)nxt.bz * g.sB + (size_t)nxt.pn * tstepB : cB;
        for (int t = 0; t < nt; t += 2) {
            const bool last = (t == nt - 2);
            const char* a1 = cA + (size_t)(t + 1) * kstep;
            const char* a2 = last ? nA : cA + (size_t)(t + 2) * kstep; const char* b2 = last ? nB : cB + (size_t)(t + 2) * kstep;
            const char* a3 = a2 + kstep; const char* b3 = b2 + kstep;
            PG8_LDB(B0, 0, 0); PG8_SCHED; PG8_LDA(At, 0, 0); PG8_STAGE(PG8_SA(1, 1), a1 + hstepA, voffA);
            PG8_WAIT_L(8); PG8_BAR; PG8_WAIT_L(0); PG8_MMA(0, 0, At, B0); PG8_BAR; PG8_SCHED;
            PG8_LDB(B1, 0, 1); PG8_STAGE(PG8_SB(0, 0), b2, voffB);
            PG8_BAR; PG8_WAIT_L(0); PG8_MMA(0, 1, At, B1); PG8_BAR;
            PG8_LDA(At, 0, 1); PG8_STAGE(PG8_SA(0, 0), a2, voffA);
            PG8_BAR; PG8_WAIT_L(0); PG8_MMA(1, 0, At, B0); PG8_BAR; PG8_SCHED;
            PG8_STAGE(PG8_SB(0, 1), b2 + hstepB, voffB);
            PG8_WAIT_V(6); PG8_BAR; PG8_MMA(1, 1, At, B1); PG8_BAR;
            PG8_LDB(B0, 1, 0); PG8_SCHED; PG8_LDA(At, 1, 0); PG8_STAGE(PG8_SA(0, 1), a2 + hstepA, voffA);
            PG8_WAIT_L(8); PG8_BAR; PG8_WAIT_L(0); PG8_MMA(0, 0, At, B0); PG8_BAR; PG8_SCHED;
            PG8_LDB(B1, 1, 1); PG8_STAGE(PG8_SB(1, 0), b3, voffB);
            PG8_BAR; PG8_WAIT_L(0); PG8_MMA(0, 1, At, B1); PG8_BAR;
            PG8_LDA(At, 1, 1); PG8_STAGE(PG8_SA(1, 0), a3, voffA);
            PG8_BAR; PG8_WAIT_L(0); PG8_MMA(1, 0, At, B0); PG8_BAR; PG8_SCHED;
            PG8_STAGE(PG8_SB(1, 1), b3 + hstepB, voffB);
            PG8_WAIT_V(6); PG8_BAR; PG8_MMA(1, 1, At, B1); PG8_BAR;
        }
#ifndef NO_EPI
        epilogue(a, lds, g, acc, cur, wr, wc, fr, fq);
#else
        if (g.mode == 99) *(f32x4*)(g.out) = acc[0][0][0][0] + acc[1][1][3][1] + acc[0][1][2][0]+acc[1][0][1][1];
#endif
        if (!has_next) break;
#pragma unroll
        for (int a = 0; a < 2; ++a)
#pragma unroll
            for (int b = 0; b < 2; ++b)
#pragma unroll
                for (int m = 0; m < 4; ++m)
#pragma unroll
                    for (int n = 0; n < 2; ++n) acc[a][b][m][n] = (f32x4){0.f, 0.f, 0.f, 0.f};
        cur = nxt; cA = nA; cB = nB; ++ui;
    }
    PG8_WAIT_V(0);
    if (wr == 0) PG8_BAR;
    PG8_BAR;
#undef PG8_SA
#undef PG8_SB
#undef PG8_STAGE
#undef PG8_LDA
#undef PG8_LDB
#undef PG8_MMA
#undef PG8_WAIT_V
#undef PG8_WAIT_L
#undef PG8_BAR
#undef PG8_SCHED
}

__device__ __forceinline__ int qk_perm_row(int n) { const int i = n & 63; return (n & ~63) + 8 * ((i & 31) >> 2) + (i & 3) + 4 * (i >> 5); }
__device__ __forceinline__ void transpose_item(const float* W, int K, int N, bf16_t* WT, bool permqk, LAS float* scr, int item, int lane) {
    const int nblk = N / 32, kb = item / nblk, nb = item % nblk, k0 = 64 * kb, n0 = 32 * nb;
#pragma unroll 8
    for (int i = 0; i < 32; ++i) { const int kk = 2 * i + (lane >> 5); scr[kk * 33 + (lane & 31)] = W[(size_t)(k0 + kk) * N + n0 + (lane & 31)]; }
    asm volatile("s_waitcnt lgkmcnt(0)" ::: "memory");
    const int c = lane & 7;
#pragma unroll
    for (int j = 0; j < 4; ++j) { const int n = (lane >> 3) + 8 * j; const LAS float* s = scr + (8 * c) * 33 + n;
        u32x4 o; o.x = cvt_pk_bf16(s[0 * 33], s[1 * 33]); o.y = cvt_pk_bf16(s[2 * 33], s[3 * 33]); o.z = cvt_pk_bf16(s[4 * 33], s[5 * 33]); o.w = cvt_pk_bf16(s[6 * 33], s[7 * 33]);
        int row = n0 + n; if (permqk && row < 2 * QKVW) row = qk_perm_row(row);
        *(u32x4*)(WT + (size_t)row * K + k0 + 8 * c) = o; }
    asm volatile("s_waitcnt lgkmcnt(0)" ::: "memory");
}
__device__ __forceinline__ void reduce_angle(double a, float& c, float& s) {
    const double k = __builtin_rint(a * 0.6366197723675814); const float x = (float)(a - k * 1.5707963267948966), x2 = x * x;
    const float sn = x * (1.0f + x2 * (-1.6666666667e-1f + x2 * (8.3333333333e-3f + x2 * (-1.9841269841e-4f + x2 * 2.7557319224e-6f))));
    const float cs = 1.0f + x2 * (-0.5f + x2 * (4.1666666667e-2f + x2 * (-1.3888888889e-3f + x2 * (2.4801587302e-5f + x2 * -2.7557319224e-7f))));
    const int q = ((int)k) & 3;
    c = (q == 0) ? cs : (q == 1) ? -sn : (q == 2) ? -cs : sn;
    s = (q == 0) ? sn : (q == 1) ? cs : (q == 2) ? -sn : -cs;
}
__device__ __forceinline__ void rms_row_to_bf16(const float* xrow, const float* gw, bf16_t* orow, int lane) {
    const f32x4* xr = (const f32x4*)xrow + lane; const f32x4* gr = (const f32x4*)gw + lane;
    f32x4 v[4]; float s = 0.f;
#pragma unroll
    for (int j = 0; j < 4; ++j) { v[j] = xr[64 * j]; s += (v[j].x * v[j].x + v[j].y * v[j].y) + (v[j].z * v[j].z + v[j].w * v[j].w); }
    const float rstd = 1.0f / sqrtf(wave_sum(s) * (1.f / DM) + EPSN);
    u32x2* o8 = (u32x2*)orow + lane;
#pragma unroll
    for (int j = 0; j < 4; ++j) { const f32x4 gv = gr[64 * j]; u32x2 w; w.x = cvt_pk_bf16(v[j].x * rstd * gv.x, v[j].y * rstd * gv.y); w.y = cvt_pk_bf16(v[j].z * rstd * gv.z, v[j].w * rstd * gv.w); o8[64 * j] = w; }
}

__device__ __forceinline__ void ssm_load_bc(const Args& a, int g, int dir, LAS f32x2* Bb, LAS f32x2* Cc, int tid) {
    const float* lam_re = a.in[4]; const float* lam_im = a.in[5]; const float* log_step = a.in[6];
    const float* b_re = a.in[7]; const float* b_im = a.in[8]; const float* c_re = a.in[9]; const float* c_im = a.in[10];
    const float dt = expf(log_step[dir * 32 + g]);
    for (int idx = tid; idx < 1024; idx += 512) {
        { const int n = idx >> 4; const float lr = lam_re[(dir * 32 + g) * 64 + n], li = lam_im[(dir * 32 + g) * 64 + n];
          const float ar = lr * dt; float cb, sb, ch, sh; reduce_angle((double)li * (double)dt, cb, sb); reduce_angle(0.5 * (double)li * (double)dt, ch, sh);
          const float em1 = expm1f(ar), ea = em1 + 1.0f;
          const float nr = em1 * cb - 2.0f * sh * sh, ni = ea * sb;
          const float den = 1.0f / (lr * lr + li * li); const float cr = (nr * lr + ni * li) * den, ci = (ni * lr - nr * li) * den;
          const float br = b_re[(size_t)((dir * 32 + g) * 64) * 16 + idx], bi = b_im[(size_t)((dir * 32 + g) * 64) * 16 + idx];
          Bb[idx] = (f32x2){cr * br - ci * bi, cr * bi + ci * br}; }
        { Cc[idx] = (f32x2){c_re[(size_t)((dir * 32 + g) * 16) * 64 + idx], c_im[(size_t)((dir * 32 + g) * 16) * 64 + idx]}; }
    }
}
__device__ __forceinline__ void ssm_setup_item(const Args& a, LAS unsigned char* lds, int item, int tid) {
    const int g = item >> 1, dir = item & 1;
    LAS f32x2* pw = (LAS f32x2*)lds; LAS f32x2* Bb = pw + 33 * 64; LAS f32x2* Cc = Bb + 1024;
    LAS float* KT = (LAS float*)(Cc + 1024); LAS float* K0 = KT + 32 * 256; LAS f32x2* Bb0 = (LAS f32x2*)(K0 + 256); LAS f32x2* Cc0 = Bb0 + 1024;
    const float* lam_re = a.in[4]; const float* lam_im = a.in[5]; const float* log_step = a.in[6];
    unsigned char* ws = a.ws;
    const float dt = expf(log_step[dir * 32 + g]);
    __syncthreads();
    for (int idx = tid; idx < 33 * 64; idx += 512) {
        const int tau = idx >> 6, n = idx & 63; const float lr = lam_re[(dir * 32 + g) * 64 + n], li = lam_im[(dir * 32 + g) * 64 + n];
        const float mag = expf(lr * dt * (float)tau); float c, s; reduce_angle((double)li * (double)dt * (double)tau, c, s);
        pw[idx] = (f32x2){mag * c, mag * s};
    }
    ssm_load_bc(a, g, dir, Bb, Cc, tid);
    if (dir == 1) ssm_load_bc(a, g, 0, Bb0, Cc0, tid);
    __syncthreads();
    if (tid < 64) { float* PW = (float*)(ws + WS_PW); const f32x2 p = pw[32 * 64 + tid]; PW[((dir * 32 + g) * 64 + tid) * 2] = p.x; PW[((dir * 32 + g) * 64 + tid) * 2 + 1] = p.y; }
    for (int o = tid; o < 32 * 256; o += 512) {
        const int tau = o >> 8, co = (o >> 4) & 15, ci = o & 15; float acc = 0.f;
_Pragma("unroll 4")
        for (int n = 0; n < 64; ++n) { const f32x2 c = Cc[co * 64 + n], p = pw[tau * 64 + n], b = Bb[n * 16 + ci]; const float tr = c.x * p.x - c.y * p.y, ti = c.x * p.y + c.y * p.x; acc += tr * b.x - ti * b.y; }
        KT[o] = acc; }
    if (dir == 1 && tid < 256) { const int co = tid >> 4, ci = tid & 15; float acc = 0.f;
_Pragma("unroll 4")
        for (int n = 0; n < 64; ++n) { const f32x2 c = Cc0[co * 64 + n], b = Bb0[n * 16 + ci]; acc += c.x * b.x - c.y * b.y; }
        K0[tid] = acc; }
    { bf16_t* BsT = (bf16_t*)(ws + WS_BST) + (size_t)g * 256 * 512;
      for (int ch = tid; ch < 128 * 64; ch += 512) {
          const int row = ch >> 6, part = row >> 6, n = row & 63, kc = ch & 63, s = kc >> 1, ci0 = (kc & 1) * 8; const int e = dir ? s : 31 - s; const f32x2 p = pw[e * 64 + n];
          float v[8];
#pragma unroll
          for (int j = 0; j < 8; ++j) { const f32x2 b = Bb[n * 16 + ci0 + j]; v[j] = part ? (p.x * b.y + p.y * b.x) : (p.x * b.x - p.y * b.y); }
          u32x4 w; w.x = cvt_pk_bf16(v[0], v[1]); w.y = cvt_pk_bf16(v[2], v[3]); w.z = cvt_pk_bf16(v[4], v[5]); w.w = cvt_pk_bf16(v[6], v[7]);
          *(u32x4*)(BsT + (size_t)(dir * 128 + row) * 512 + s * 16 + ci0) = w; } }
    bf16_t* MtC = (bf16_t*)(ws + WS_MTC) + (size_t)g * 512 * UHK;
    { for (int ch = tid; ch < 512 * 16; ch += 512) {
          const int row = ch >> 4, t = row >> 4, co = row & 15, cc = ch & 15, part = cc >> 3, n0 = (cc & 7) * 8; const int e = dir ? 32 - t : t + 1;
          float v[8];
#pragma unroll
          for (int j = 0; j < 8; ++j) { const f32x2 c = Cc[co * 64 + n0 + j], p = pw[e * 64 + n0 + j]; v[j] = part ? -(c.x * p.y + c.y * p.x) : (c.x * p.x - c.y * p.y); }
          u32x4 w; w.x = cvt_pk_bf16(v[0], v[1]); w.y = cvt_pk_bf16(v[2], v[3]); w.z = cvt_pk_bf16(v[4], v[5]); w.w = cvt_pk_bf16(v[6], v[7]);
          *(u32x4*)(MtC + (size_t)row * UHK + 512 + dir * 128 + part * 64 + n0) = w; } }
    __syncthreads();
    { const float* dsk = a.in[11];
      for (int ch = tid; ch < 512 * 64; ch += 512) {
          const int kc = ch & 63, row = ch >> 6; const int s = kc >> 1, ci0 = (kc & 1) * 8, t = row >> 4, co = row & 15;
          if (dir == 0 ? (t > s) : (s >= t)) {
              const int tau = dir == 0 ? t - s : s - t;
              float v[8];
#pragma unroll
              for (int j = 0; j < 8; ++j) v[j] = KT[tau * 256 + co * 16 + ci0 + j];
              if (t == s) { const float dv = dsk[g * 16 + co];
#pragma unroll
                  for (int j = 0; j < 8; ++j) v[j] += K0[co * 16 + ci0 + j] + ((ci0 + j == co) ? dv : 0.f); }
              u32x4 w; w.x = cvt_pk_bf16(v[0], v[1]); w.y = cvt_pk_bf16(v[2], v[3]); w.z = cvt_pk_bf16(v[4], v[5]); w.w = cvt_pk_bf16(v[6], v[7]);
              *(u32x4*)(MtC + (size_t)row * UHK + s * 16 + ci0) = w;
          }
      } }
    __syncthreads();
}

__device__ __forceinline__ void step_setup(const Args& a, LAS unsigned char* lds, int tid, int bx) {
    const int lane = tid & 63, wave = tid >> 6, G = gridDim.x;
    unsigned char* ws = a.ws;
    for (int it = bx; it < 64; it += G) ssm_setup_item(a, lds, it, tid);
    { float* rc = (float*)(ws + WS_ROPE); float* rs = rc + SEQL * 32;
      for (int idx = bx * 512 + tid; idx < SEQL * 32; idx += G * 512) {
          const int pos = idx >> 5, i = idx & 31; double inv = 1.0; for (int k = 0; k < i; ++k) inv *= 0.7498942093324558;
          float c, s; reduce_angle((double)pos * inv, c, s); rc[idx] = c; rs[idx] = s; } }
    { LAS float* scr = (LAS float*)(lds) + wave * (64 * 33);
      const int gw = bx * 8 + wave, NGW = G * 8;
      constexpr int I_IN = (DM / 64) * (INC / 32), I_GLU = (512 / 64) * (512 / 32), I_AB = (512 / 64) * (1024 / 32), I_OUT = (1024 / 64) * (1024 / 32);
      constexpr int NIT = I_IN + I_GLU + 2 * I_AB + I_OUT;
      for (int it = gw; it < NIT; it += NGW) {
          int r = it;
          if (r < I_IN) { transpose_item(a.in[3], DM, INC, (bf16_t*)(ws + WS_WIN), true, scr, r, lane); continue; } r -= I_IN;
          if (r < I_GLU) { transpose_item(a.in[12], 512, 512, (bf16_t*)(ws + WS_WGLU), false, scr, r, lane); continue; } r -= I_GLU;
          if (r < I_AB) { transpose_item(a.in[13], 512, 1024, (bf16_t*)(ws + WS_WA), false, scr, r, lane); continue; } r -= I_AB;
          if (r < I_AB) { transpose_item(a.in[14], 512, 1024, (bf16_t*)(ws + WS_WB), false, scr, r, lane); continue; } r -= I_AB;
          transpose_item(a.in[15], 1024, 1024, (bf16_t*)(ws + WS_WOUT), false, scr, r, lane);
      } }
    { bf16_t* hn = (bf16_t*)((unsigned char*)a.out + OUT_HN_OFF);
      const f32x4* gr = (const f32x4*)a.in[2] + lane;
      f32x4 gv[4];
#pragma unroll
      for (int j = 0; j < 4; ++j) gv[j] = gr[64 * j];
      unsigned* rctr = (unsigned*)(ws + WS_CTL) + 4;
      constexpr int RCH = 16;
      for (;;) {
          unsigned cidx = 0; if (lane == 0) cidx = atomicAdd(rctr, 1u);
          cidx = (unsigned)__builtin_amdgcn_readfirstlane((int)cidx);
          if (cidx >= (unsigned)(TTOK / RCH)) break;
          int row = (int)cidx * RCH; const int rend = row + RCH;
          f32x4 nx[4];
          { const f32x4* xr = (const f32x4*)xrow_ptr(a.in[0], a.in[1], row) + lane;
#pragma unroll
            for (int j = 0; j < 4; ++j) nx[j] = __builtin_nontemporal_load(xr + 64 * j); }
          for (; row < rend; ++row) {
              f32x4 v[4];
#pragma unroll
              for (int j = 0; j < 4; ++j) v[j] = nx[j];
              if (row + 1 < rend) { const f32x4* xn = (const f32x4*)xrow_ptr(a.in[0], a.in[1], row + 1) + lane;
#pragma unroll
                  for (int j = 0; j < 4; ++j) nx[j] = __builtin_nontemporal_load(xn + 64 * j); }
              float s = 0.f;
#pragma unroll
              for (int j = 0; j < 4; ++j) s += (v[j].x * v[j].x + v[j].y * v[j].y) + (v[j].z * v[j].z + v[j].w * v[j].w);
              const float rstd = 1.0f / sqrtf(wave_sum(s) * (1.f / DM) + EPSN);
              u32x2* o8 = (u32x2*)(hn + (size_t)row * DM) + lane;
#pragma unroll
              for (int j = 0; j < 4; ++j) { u32x2 w; w.x = cvt_pk_bf16(v[j].x * rstd * gv[j].x, v[j].y * rstd * gv[j].y); w.y = cvt_pk_bf16(v[j].z * rstd * gv[j].z, v[j].w * rstd * gv[j].w); o8[64 * j] = w; }
          }
      } }
}

__device__ __forceinline__ float quad_max(float x) {
    const auto r = __builtin_amdgcn_permlane32_swap(__float_as_uint(x), __float_as_uint(x), false, false);
    x = fmaxf(__uint_as_float(r[0]), __uint_as_float(r[1]));
    const auto q = __builtin_amdgcn_permlane16_swap(__float_as_uint(x), __float_as_uint(x), false, false);
    return fmaxf(__uint_as_float(q[0]), __uint_as_float(q[1]));
}
__device__ __forceinline__ float quad_sum(float x) {
    const auto r = __builtin_amdgcn_permlane32_swap(__float_as_uint(x), __float_as_uint(x), false, false);
    x = __uint_as_float(r[0]) + __uint_as_float(r[1]);
    const auto q = __builtin_amdgcn_permlane16_swap(__float_as_uint(x), __float_as_uint(x), false, false);
    return __uint_as_float(q[0]) + __uint_as_float(q[1]);
}
struct KVBuf { bf16x8 kA0, kA1, kB0, kB1; bf16x4 vA[4], vB[4]; };
__device__ __forceinline__ void step_params(int s, int& gi, int& ls) { gi = s < 12 ? 0 : (s < 18 ? 1 : 2); ls = s < 12 ? s : (s < 18 ? s - 12 : s - 18); }
__device__ __forceinline__ void attn_load(KVBuf& b, const bf16_t* Kp, const bf16_t* Vt, int s, int sq, int h, int blk, int r, int lane) {
    int gi, ls; step_params(s, gi, ls);
    const int sh = 2 * gi, Lg = SEQL >> sh, rho = r & ((1 << sh) - 1);
    int uA = ((256 * blk) >> sh) - 64 + 32 * ls, uB = uA + 16;
    if (uA < 0 || uA >= Lg) uA = 0; if (uB < 0 || uB >= Lg) uB = 0;
    const int kl = lane & 15, quad = lane >> 4;
    const bf16_t* kh = Kp + (size_t)(sq * 24 + gi * 8 + h) * SEQL * 64 + quad * 128 + kl * 8;
    const bf16_t* ka = kh + (size_t)((rho * Lg + uA) >> 4) * 1024; const bf16_t* kb = kh + (size_t)((rho * Lg + uB) >> 4) * 1024;
    b.kA0 = *(const bf16x8*)ka; b.kA1 = *(const bf16x8*)(ka + 512); b.kB0 = *(const bf16x8*)kb; b.kB1 = *(const bf16x8*)(kb + 512);
    const bf16_t* vbase = Vt + (size_t)(((sq * 3 + gi) * 8 + h) * 512) * 1024 + quad * 64 + kl * 4;
    const bf16_t* va = vbase + (size_t)((rho * Lg + uA) >> 4) * 1024; const bf16_t* vb = vbase + (size_t)((rho * Lg + uB) >> 4) * 1024;
#pragma unroll
    for (int dt = 0; dt < 4; ++dt) { b.vA[dt] = *(const bf16x4*)(va + dt * 256); b.vB[dt] = *(const bf16x4*)(vb + dt * 256); }
}
struct QF { bf16x8 a0, a1, b0, b1, c0, c1; };
template <int gi>
__device__ __forceinline__ void attn_compute(const KVBuf& b, const bf16x8 q0, const bf16x8 q1, f32x4 (&o)[4], float& mrun, float& lrun, int s, int blk, int r, int lane) {
    const int ls = gi == 0 ? s : (gi == 1 ? s - 12 : s - 18);
    const int sh = 2 * gi, Lg = SEQL >> sh;
    const int uA = ((256 * blk) >> sh) - 64 + 32 * ls;
    const int qi = lane & 15, quad = lane >> 4;
    const int uq = (256 * blk + r + 16 * qi) >> sh;
    const int lo = max(0, uq - 64), hi = min(Lg - 1, uq + 64);
    f32x4 sA = (f32x4){0.f, 0.f, 0.f, 0.f}, sB = sA;
    sA = __builtin_amdgcn_mfma_f32_16x16x32_bf16(b.kA0, q0, sA, 0, 0, 0); sA = __builtin_amdgcn_mfma_f32_16x16x32_bf16(b.kA1, q1, sA, 0, 0, 0);
    sB = __builtin_amdgcn_mfma_f32_16x16x32_bf16(b.kB0, q0, sB, 0, 0, 0); sB = __builtin_amdgcn_mfma_f32_16x16x32_bf16(b.kB1, q1, sB, 0, 0, 0);
    const float NEGINF = -__builtin_inff();
    const unsigned span = (unsigned)(hi - lo);
    float mx = NEGINF;
#pragma unroll
    for (int j = 0; j < 4; ++j) {
        const int ua = uA + quad * 4 + j, ub = ua + 16;
        sA[j] = ((unsigned)(ua - lo) <= span) ? sA[j] : NEGINF; sB[j] = ((unsigned)(ub - lo) <= span) ? sB[j] : NEGINF;
        mx = fmaxf(mx, fmaxf(sA[j], sB[j]));
    }
    mx = quad_max(mx);
    const float mnew = fmaxf(mrun, mx), alpha = __builtin_amdgcn_exp2f(mrun - mnew);
    mrun = mnew;
    float ps = 0.f;
#pragma unroll
    for (int j = 0; j < 4; ++j) { sA[j] = __builtin_amdgcn_exp2f(sA[j] - mnew); sB[j] = __builtin_amdgcn_exp2f(sB[j] - mnew); ps += sA[j] + sB[j]; }
    lrun = lrun * alpha + ps;
    u32x4 pw; pw.x = cvt_pk_bf16(sA[0], sA[1]); pw.y = cvt_pk_bf16(sA[2], sA[3]); pw.z = cvt_pk_bf16(sB[0], sB[1]); pw.w = cvt_pk_bf16(sB[2], sB[3]);
    const bf16x8 pf = __builtin_bit_cast(bf16x8, pw);
#pragma unroll
    for (int dt = 0; dt < 4; ++dt) {
        o[dt] *= alpha;
        bf16x8 vf; vf[0] = b.vA[dt][0]; vf[1] = b.vA[dt][1]; vf[2] = b.vA[dt][2]; vf[3] = b.vA[dt][3]; vf[4] = b.vB[dt][0]; vf[5] = b.vB[dt][1]; vf[6] = b.vB[dt][2]; vf[7] = b.vB[dt][3];
#ifdef DBG_ATT2
        for (int e = 0; e < 8; ++e) o[dt][e & 3] += 1e-3f * __uint_as_float(((unsigned)(unsigned short)vf[e]) << 16);
#else
        o[dt] = __builtin_amdgcn_mfma_f32_16x16x32_bf16(vf, pf, o[dt], 0, 0, 0);
#endif
    }
}
template <int gi>
__device__ __forceinline__ void attn_compute2(const KVBuf& b, const KVBuf& c, const bf16x8 q0, const bf16x8 q1, f32x4 (&o)[4], float& mrun, float& lrun, int s, int blk, int r, int lane) {
    const int ls = gi == 0 ? s : (gi == 1 ? s - 12 : s - 18);
    const int sh = 2 * gi, Lg = SEQL >> sh;
    const int uA = ((256 * blk) >> sh) - 64 + 32 * ls;
    const int qi = lane & 15, quad = lane >> 4;
    const int uq = (256 * blk + r + 16 * qi) >> sh;
    const int lo = max(0, uq - 64), hi = min(Lg - 1, uq + 64);
    const f32x4 z4 = (f32x4){0.f, 0.f, 0.f, 0.f};
    f32x4 sA = __builtin_amdgcn_mfma_f32_16x16x32_bf16(b.kA0, q0, z4, 0, 0, 0), sB = __builtin_amdgcn_mfma_f32_16x16x32_bf16(b.kB0, q0, z4, 0, 0, 0);
    f32x4 sC = __builtin_amdgcn_mfma_f32_16x16x32_bf16(c.kA0, q0, z4, 0, 0, 0), sD = __builtin_amdgcn_mfma_f32_16x16x32_bf16(c.kB0, q0, z4, 0, 0, 0);
    sA = __builtin_amdgcn_mfma_f32_16x16x32_bf16(b.kA1, q1, sA, 0, 0, 0); sB = __builtin_amdgcn_mfma_f32_16x16x32_bf16(b.kB1, q1, sB, 0, 0, 0);
    sC = __builtin_amdgcn_mfma_f32_16x16x32_bf16(c.kA1, q1, sC, 0, 0, 0); sD = __builtin_amdgcn_mfma_f32_16x16x32_bf16(c.kB1, q1, sD, 0, 0, 0);
    const float NEGINF = -__builtin_inff();
    const unsigned span = (unsigned)(hi - lo);
    float mx = NEGINF;
#pragma unroll
    for (int j = 0; j < 4; ++j) {
        const int ua = uA + quad * 4 + j;
        sA[j] = ((unsigned)(ua - lo) <= span) ? sA[j] : NEGINF; sB[j] = ((unsigned)(ua + 16 - lo) <= span) ? sB[j] : NEGINF;
        sC[j] = ((unsigned)(ua + 32 - lo) <= span) ? sC[j] : NEGINF; sD[j] = ((unsigned)(ua + 48 - lo) <= span) ? sD[j] : NEGINF;
        mx = fmaxf(fmaxf(mx, fmaxf(sA[j], sB[j])), fmaxf(sC[j], sD[j]));
    }
    mx = quad_max(mx);
    const float mnew = fmaxf(mrun, mx), alpha = __builtin_amdgcn_exp2f(mrun - mnew);
    mrun = mnew;
    float ps = 0.f;
#pragma unroll
    for (int j = 0; j < 4; ++j) { sA[j] = __builtin_amdgcn_exp2f(sA[j] - mnew); sB[j] = __builtin_amdgcn_exp2f(sB[j] - mnew); sC[j] = __builtin_amdgcn_exp2f(sC[j] - mnew); sD[j] = __builtin_amdgcn_exp2f(sD[j] - mnew); ps += (sA[j] + sB[j]) + (sC[j] + sD[j]); }
    lrun = lrun * alpha + ps;
    u32x4 pw, pv; pw.x = cvt_pk_bf16(sA[0], sA[1]); pw.y = cvt_pk_bf16(sA[2], sA[3]); pw.z = cvt_pk_bf16(sB[0], sB[1]); pw.w = cvt_pk_bf16(sB[2], sB[3]);
    pv.x = cvt_pk_bf16(sC[0], sC[1]); pv.y = cvt_pk_bf16(sC[2], sC[3]); pv.z = cvt_pk_bf16(sD[0], sD[1]); pv.w = cvt_pk_bf16(sD[2], sD[3]);
    const bf16x8 pf = __builtin_bit_cast(bf16x8, pw), pg = __builtin_bit_cast(bf16x8, pv);
#pragma unroll
    for (int dt = 0; dt < 4; ++dt) {
        o[dt] *= alpha;
        bf16x8 vf, vg;
        vf[0] = b.vA[dt][0]; vf[1] = b.vA[dt][1]; vf[2] = b.vA[dt][2]; vf[3] = b.vA[dt][3]; vf[4] = b.vB[dt][0]; vf[5] = b.vB[dt][1]; vf[6] = b.vB[dt][2]; vf[7] = b.vB[dt][3];
        vg[0] = c.vA[dt][0]; vg[1] = c.vA[dt][1]; vg[2] = c.vA[dt][2]; vg[3] = c.vA[dt][3]; vg[4] = c.vB[dt][0]; vg[5] = c.vB[dt][1]; vg[6] = c.vB[dt][2]; vg[7] = c.vB[dt][3];
        o[dt] = __builtin_amdgcn_mfma_f32_16x16x32_bf16(vf, pf, o[dt], 0, 0, 0);
        o[dt] = __builtin_amdgcn_mfma_f32_16x16x32_bf16(vg, pg, o[dt], 0, 0, 0);
    }
}
__device__ __forceinline__ void step_attention(const Args& a, LAS unsigned char* lds, int pass, int tid, int bx) {
    unsigned char* ws = a.ws;
    const int lane = tid & 63;
    const bf16_t* Qp = (const bf16_t*)(ws + WS_Q); const bf16_t* Kp = (const bf16_t*)(ws + WS_K); const bf16_t* Vt = (const bf16_t*)(ws + WS_VT);
    const bf16_t* ZA = (const bf16_t*)(ws + WS_ZA); bf16_t* GAO = (bf16_t*)(ws + WS_GAO);
    const int xcd = bx & 7;
    unsigned* ctr = (unsigned*)(ws + WS_CTL) + 16 + pass * 8 + xcd;
    LAS unsigned* slot = (LAS unsigned*)(lds + 3 * 16384);
    constexpr int NGRP = 3 * 32 * 2;
    for (;;) {
        __syncthreads();
        if (tid == 0) slot[0] = atomicAdd(ctr, 1u);
        __syncthreads();
        const unsigned grp = (unsigned)__builtin_amdgcn_readfirstlane((int)slot[0]);
        if (grp >= (unsigned)NGRP) break;
        const int wv_ = tid >> 6; const int r = ((wv_ & 3) << 2) + (wv_ >> 2) + 2 * (int)(grp & 1)  , blk = (grp >> 1) & 31, pair = xcd * 3 + (int)(grp >> 6);
        const int h = pair & 7, sq = pair >> 3;
        const int qi = lane & 15, quad = lane >> 4;
        const int tq = sq * SEQL + 256 * blk + r + 16 * qi;
        QF qf;
        { const int pos = 256 * blk + r + 16 * qi;
          const bf16_t* qa = Qp + ((size_t)(sq * 24 + h) * SEQL + pos) * 64 + quad * 8;
          const bf16_t* qb = Qp + ((size_t)(sq * 24 + 8 + h) * SEQL + (pos & 3) * 2048 + (pos >> 2)) * 64 + quad * 8;
          const bf16_t* qc = Qp + ((size_t)(sq * 24 + 16 + h) * SEQL + (pos & 15) * 512 + (pos >> 4)) * 64 + quad * 8;
          qf.a0 = *(const bf16x8*)qa; qf.a1 = *(const bf16x8*)(qa + 32); qf.b0 = *(const bf16x8*)qb; qf.b1 = *(const bf16x8*)(qb + 32); qf.c0 = *(const bf16x8*)qc; qf.c1 = *(const bf16x8*)(qc + 32); }
        f32x4 o[4];
#pragma unroll
        for (int dt = 0; dt < 4; ++dt) o[dt] = (f32x4){0.f, 0.f, 0.f, 0.f};
        float mrun = -1e30f, lrun = 0.f;
        KVBuf b0, b1;
#define ATT_SB __builtin_amdgcn_sched_barrier(0);
        {
            const int wv = tid >> 6, region = wv >> 1;
            const bf16_t* gsrc = (region < 2 ? Kp + (size_t)(sq * 24 + h) * SEQL * 64 : Vt + (size_t)((sq * 3) * 8 + h) * 512 * 1024) + (wv & 1) * 512 + lane * 8;
            const int ubase = 256 * blk - 64 + (region & 1) * 16;
#define ATT_DMA(S) do { int uT = ubase + 32 * (S); if (uT < 0 || uT >= SEQL) uT = 0; \
                __builtin_amdgcn_global_load_lds((const unsigned*)(gsrc + (size_t)(uT >> 4) * 1024), (LAS unsigned*)(lds + (((S) >> 1) % 3) * 16384 + ((S) & 1) * 8192 + wv * 1024), 16, 0, 0); } while (0)
            ATT_DMA(0); ATT_DMA(1); ATT_DMA(2); ATT_DMA(3);
            const int kl = lane & 15;
            const unsigned foff = (unsigned)(quad * 256 + kl * 16), voff = (unsigned)(4096 + quad * 128 + kl * 8);
#pragma unroll 1
            for (int d = 0; d < 6; ++d) {
                if (d < 5) asm volatile("s_waitcnt vmcnt(2)" ::: "memory"); else asm volatile("s_waitcnt vmcnt(0)" ::: "memory");
                __syncthreads();
                if (d + 2 < 6) { ATT_DMA(2 * d + 4); ATT_DMA(2 * d + 5); }
                LAS unsigned char* kb = lds + (d % 3) * 16384;
                b0.kA0 = *(const LAS bf16x8*)(kb + foff); b0.kA1 = *(const LAS bf16x8*)(kb + foff + 1024); b0.kB0 = *(const LAS bf16x8*)(kb + 2048 + foff); b0.kB1 = *(const LAS bf16x8*)(kb + 2048 + foff + 1024);
                b1.kA0 = *(const LAS bf16x8*)(kb + 8192 + foff); b1.kA1 = *(const LAS bf16x8*)(kb + 8192 + foff + 1024); b1.kB0 = *(const LAS bf16x8*)(kb + 8192 + 2048 + foff); b1.kB1 = *(const LAS bf16x8*)(kb + 8192 + 2048 + foff + 1024);
#pragma unroll
                for (int dt = 0; dt < 4; ++dt) { b0.vA[dt] = *(const LAS bf16x4*)(kb + voff + dt * 512); b0.vB[dt] = *(const LAS bf16x4*)(kb + 2048 + voff + dt * 512);
                                                 b1.vA[dt] = *(const LAS bf16x4*)(kb + 8192 + voff + dt * 512); b1.vB[dt] = *(const LAS bf16x4*)(kb + 8192 + 2048 + voff + dt * 512); }
                attn_compute2<0>(b0, b1, qf.a0, qf.a1, o, mrun, lrun, 2 * d, blk, r, lane);
            }
#undef ATT_DMA
        }
        attn_load(b0, Kp, Vt, 12, sq, h, blk, r, lane);
#define ATT_LOOP(GI, S0, S1, QA, QB) _Pragma("unroll 1") for (int s = S0; s < S1; s += 2) { \
            ATT_SB attn_load(b1, Kp, Vt, s + 1, sq, h, blk, r, lane); ATT_SB attn_compute<GI>(b0, QA, QB, o, mrun, lrun, s, blk, r, lane); \
            ATT_SB attn_load(b0, Kp, Vt, s + 2, sq, h, blk, r, lane); ATT_SB attn_compute<GI>(b1, QA, QB, o, mrun, lrun, s + 1, blk, r, lane); ATT_SB }
        ATT_LOOP(1, 12, 18, qf.b0, qf.b1)
        ATT_LOOP(2, 18, 22, qf.c0, qf.c1)
#undef ATT_LOOP
        attn_compute<2>(b0, qf.c0, qf.c1, o, mrun, lrun, 22, blk, r, lane);
        const float l = quad_sum(lrun);
        float inv = 1.0f / l;
#ifdef DBG_ATT1
        for (int dt = 0; dt < 4; ++dt) o[dt] = (f32x4){1.f, 1.f, 1.f, 1.f};
#endif
#pragma unroll
        for (int dt = 0; dt < 4; ++dt) {
            const size_t off = (size_t)tq * 512 + h * 64 + 16 * dt + 4 * quad;
            const u32x2 z = *(const u32x2*)(ZA + off);
            u32x2 w; w.x = cvt_pk_bf16(o[dt][0] * inv * bf_lo(z.x), o[dt][1] * inv * bf_hi(z.x)); w.y = cvt_pk_bf16(o[dt][2] * inv * bf_lo(z.y), o[dt][3] * inv * bf_hi(z.y));
            *(u32x2*)(GAO + off) = w;
        }
    }
}

__device__ __forceinline__ f32x2 cmul(f32x2 a, f32x2 b) { return (f32x2){a.x * b.x - a.y * b.y, a.x * b.y + a.y * b.x}; }
__device__ __forceinline__ void step_scan(const Args& a, LAS unsigned char* lds, int tid, int it0, int it1, int itstep) {
    unsigned char* ws = a.ws; const int G = gridDim.x;
    const float* PW = (const float*)(ws + WS_PW); const float* S = (const float*)(ws + WS_S); bf16_t* UH = (bf16_t*)(ws + WS_UH);
    LAS f32x2* carry = (LAS f32x2*)lds;
    for (int it = it0; it < it1; it += itstep) {
        const int dir = it & 1, g = (it >> 1) & 31, sq = it >> 6; const int seg = tid >> 6, n = tid & 63;
        const f32x2 P = (f32x2){PW[((dir * 32 + g) * 64 + n) * 2], PW[((dir * 32 + g) * 64 + n) * 2 + 1]};
        f32x2 z[32];
        { const int c0 = dir ? (NCH - 1 - seg * 32) : seg * 32; const long stp = dir ? -256 : 256;
          const float* sp = S + ((size_t)g * CHP + sq * NCH + c0) * 256 + dir * 128 + n;
#pragma unroll
          for (int i = 0; i < 32; ++i) { z[i] = (f32x2){sp[0], sp[64]}; sp += stp; } }
        f32x2 zz = (f32x2){0.f, 0.f};
#pragma unroll
        for (int i = 0; i < 32; ++i) { const f32x2 t = z[i]; z[i] = zz; zz = cmul(P, zz) + t; }
        __syncthreads();
        carry[seg * 64 + n] = zz;
        __syncthreads();
        f32x2 P32 = P;
#pragma unroll
        for (int k = 0; k < 5; ++k) P32 = cmul(P32, P32);
        f32x2 x = (f32x2){0.f, 0.f};
        for (int sp = 0; sp < seg; ++sp) x = cmul(P32, x) + carry[sp * 64 + n];
        f32x2 pwr = (f32x2){1.f, 0.f};
        { const int c0 = dir ? (NCH - 1 - seg * 32) : seg * 32; const long stp = dir ? -(long)UHK : (long)UHK;
          bf16_t* up = UH + ((size_t)g * CHP + sq * NCH + c0) * UHK + 512 + dir * 128 + n;
#pragma unroll
          for (int i = 0; i < 32; ++i) {
              const f32x2 hin = z[i] + cmul(pwr, x);
              up[0] = (bf16_t)(cvt_pk_bf16(hin.x, 0.f) & 0xffffu); up[64] = (bf16_t)(cvt_pk_bf16(hin.y, 0.f) & 0xffffu);
              pwr = cmul(pwr, P); up += stp;
          } }
    }
}

__device__ __forceinline__ void step_final_norm(const Args& a, int pass, int tid, int bx) {
    const int lane = tid & 63, wave = tid >> 6, G = gridDim.x;
    const f32x4* gr = (const f32x4*)a.in[16] + lane;
    f32x4 gv[4];
#pragma unroll
    for (int j = 0; j < 4; ++j) gv[j] = gr[64 * j];
    const bf16_t* accp = (const bf16_t*)(a.ws + WS_ACC);
    int row = bx * 8 + wave;
    f32x4 nx[4]; u32x2 na[4];
    if (row < TP) { const f32x4* xr = (const f32x4*)xrow_ptr(a.in[0], a.in[1], pass * TP + row) + lane; const u32x2* ar = (const u32x2*)(accp + (size_t)row * DM) + lane;
#pragma unroll
        for (int j = 0; j < 4; ++j) { nx[j] = __builtin_nontemporal_load(xr + 64 * j); na[j] = ar[64 * j]; } }
    for (; row < TP; row += G * 8) {
        f32x4 v[4];
#pragma unroll
        for (int j = 0; j < 4; ++j) v[j] = nx[j] + (f32x4){bf_lo(na[j].x), bf_hi(na[j].x), bf_lo(na[j].y), bf_hi(na[j].y)};
        const int nrow = row + G * 8;
        if (nrow < TP) { const f32x4* xn = (const f32x4*)xrow_ptr(a.in[0], a.in[1], pass * TP + nrow) + lane; const u32x2* an = (const u32x2*)(accp + (size_t)nrow * DM) + lane;
#pragma unroll
            for (int j = 0; j < 4; ++j) { nx[j] = __builtin_nontemporal_load(xn + 64 * j); na[j] = an[64 * j]; } }
        float s = 0.f;
#pragma unroll
        for (int j = 0; j < 4; ++j) s += (v[j].x * v[j].x + v[j].y * v[j].y) + (v[j].z * v[j].z + v[j].w * v[j].w);
        const float rstd = 1.0f / sqrtf(wave_sum(s) * (1.f / DM) + EPSN);
        f32x4* xr = (f32x4*)(a.out + (size_t)(pass * TP + row) * DM) + lane;
#pragma unroll
        for (int j = 0; j < 4; ++j) __builtin_nontemporal_store(v[j] * rstd * gv[j], xr + 64 * j);
    }
}


#define XB_TMO      128
#define XB_XCNT(j)  (256  + 64 * (j))
#define XB_XSUB(j)  (1280 + 64 * (j))
#define XB_XGEN(j)  (2304 + 64 * (j))
#define XB_TOP      3328
#define XB_TOPGEN   3392
#define XCD_BAR_WORDS 3456
#define XB_SLOT(b)  (4096 + 2 * (b))
#define XB_SPIN_CAP (1u << 18)
__device__ __forceinline__ unsigned xb_ld(unsigned* p)              { return __hip_atomic_load(p, __ATOMIC_RELAXED, __HIP_MEMORY_SCOPE_AGENT); }
__device__ __forceinline__ unsigned xb_add(unsigned* p, unsigned v) { return __hip_atomic_fetch_add(p, v, __ATOMIC_RELAXED, __HIP_MEMORY_SCOPE_AGENT); }
__device__ __forceinline__ unsigned xb_xcc_id() { return (unsigned)__builtin_amdgcn_s_getreg((3 << 11) | 20) & 0xFu; }
#define XB_SPIN(cond, bar) do { unsigned _sp = 0; while (cond) { __builtin_amdgcn_s_sleep(1); \
    if ((++_sp & 255u) == 0u) { if (xb_ld(&(bar)[XB_TMO])) break; if (_sp > XB_SPIN_CAP) { atomicAdd(&(bar)[XB_TMO], 1u); break; } } } } while (0)
__device__ __forceinline__ void xcd_barrier_complete(unsigned* bar, unsigned x, unsigned& nloc, unsigned& nx) {
    const unsigned G = gridDim.x;
    unsigned sum, cnt, mine, sp = 0u;
    for (;;) {
        sum = 0u; cnt = 0u; mine = 0u;
#pragma unroll
        for (unsigned j = 0; j < 16; ++j) { const unsigned c = xb_ld(&bar[XB_XCNT(j)]); sum += c; cnt += (c > 0u) ? 1u : 0u; mine = (j == x) ? c : mine; }
        if (sum == G) break;
        __builtin_amdgcn_s_sleep(1);
        if ((++sp & 255u) == 0u) { if (xb_ld(&bar[XB_TMO])) break; if (sp > XB_SPIN_CAP) { atomicAdd(&bar[XB_TMO], 1u); break; } }
    }
    nloc = mine > 0u ? mine : 1u; nx = cnt > 0u ? cnt : 1u;
}
__device__ __forceinline__ void xcd_barrier(unsigned* bar) {
    asm volatile("s_waitcnt vmcnt(0)" ::: "memory");
    __syncthreads();
    if (threadIdx.x == 0) {
        __builtin_amdgcn_s_waitcnt(0);
        const unsigned x = xb_xcc_id();
        unsigned* slot = bar + XB_SLOT(blockIdx.x);
        unsigned nloc = xb_ld(slot), nx = xb_ld(slot + 1);
        if (nloc == 0u) { xcd_barrier_complete(bar, x, nloc, nx); __hip_atomic_store(slot, nloc, __ATOMIC_RELAXED, __HIP_MEMORY_SCOPE_AGENT); __hip_atomic_store(slot + 1, nx, __ATOMIC_RELAXED, __HIP_MEMORY_SCOPE_AGENT); }
        const unsigned old = xb_add(&bar[XB_XSUB(x)], 1u);
        const unsigned gen = old / nloc;
        if (old + 1u == (gen + 1u) * nloc) {
            __builtin_amdgcn_fence(__ATOMIC_RELEASE, "agent");
            asm volatile("s_waitcnt vmcnt(0)" ::: "memory");
            const unsigned og = xb_add(&bar[XB_TOP], 1u);
            const unsigned tg = og / nx;
            if (og + 1u == (tg + 1u) * nx) xb_add(&bar[XB_TOPGEN], 1u);
            else XB_SPIN(xb_ld(&bar[XB_TOPGEN]) == tg, bar);
            __builtin_amdgcn_fence(__ATOMIC_ACQUIRE, "agent");
            xb_add(&bar[XB_XGEN(x)], 1u);
            asm volatile("s_waitcnt vmcnt(0)" ::: "memory");
        } else {
            XB_SPIN(xb_ld(&bar[XB_XGEN(x)]) == gen, bar);
            __builtin_amdgcn_fence(__ATOMIC_ACQUIRE, "agent");
            asm volatile("s_waitcnt vmcnt(0)" ::: "memory");
        }
    }
    __syncthreads();
}

constexpr int NSTEPS = 1 + 10 * NPASS;
__host__ __device__ __forceinline__ bool sync_after(int st) { if (st == 0) return true; const int k = (st - 1) % 10; return !(k == 1 || k == 6 || k == 9); }

__global__ void __launch_bounds__(512, 2) fwd_kernel(Args a) {
    extern __shared__ __attribute__((aligned(16))) unsigned char lds_raw[];
    LAS unsigned char* lds = (LAS unsigned char*)lds_raw;
    cg::grid_group grid = cg::this_grid();
    const int G = gridDim.x;
    unsigned char* ws = a.ws;
    unsigned* bar = (unsigned*)(ws + WS_BAR);
    if (a.do_sync == 2) grid.sync();
    if (a.do_sync && threadIdx.x == 0) (void)xb_add(&bar[XB_XCNT(xb_xcc_id())], 1u);
    for (int st = a.st_lo; st < a.st_hi; ++st) {
        int tid = threadIdx.x, bx = blockIdx.x;
        asm volatile("" : "+v"(tid), "+s"(bx));
#ifndef NO_SETUP
        if (st == 0) { step_setup(a, lds, tid, bx); }
#else
        if (st == 0) {}
#endif
        else {
            const int pass = (st - 1) / 10, k = (st - 1) % 10;
            GemmD g; g.lgnN = 0; g.pass = pass; g.nb = 1; g.sA = 0; g.sB = 0;
            bool has_gemm = true;
            const bool fz = (G == 256);
            const bool split_ay = false;
            const bf16_t* sgp = (const bf16_t*)((unsigned char*)a.out + OUT_HN_OFF) + (size_t)pass * TP * DM;
#define DESC_Y { g.A = (const bf16_t*)(ws + WS_UH); g.lda = UHK; g.sA = (unsigned)(CHP * UHK * 2); g.Bt = (const bf16_t*)(ws + WS_MTC); g.ldb = UHK; g.sB = (unsigned)(512 * UHK * 2); g.K = UHK; g.nM = CHP / BM; g.nN = 2; g.nb = 32; g.mode = MODE_Y; }
#define DESC_A { g.A = (const bf16_t*)(ws + WS_GAO); g.lda = 512; g.Bt = (const bf16_t*)(ws + WS_WA); g.ldb = 512; g.K = 512; g.nM = TP / BM; g.nN = 4; g.lgnN = 2; g.mode = MODE_A; }
#define DESC_GLU { g.A = sgp; g.lda = 512; g.Bt = (const bf16_t*)(ws + WS_WGLU); g.ldb = 512; g.K = 512; g.nM = TP / BM; g.nN = 2; g.lgnN = 1; g.mode = MODE_GLU; }
#define DESC_NONE { has_gemm = false; g.A = nullptr; g.Bt = nullptr; g.lda = g.ldb = g.K = 0; g.nM = g.nN = 0; g.mode = 0; }
            switch (k) {
            case 0: g.A = (const bf16_t*)((unsigned char*)a.out + OUT_HN_OFF) + (size_t)pass * TP * DM; g.lda = DM; g.Bt = (const bf16_t*)(ws + WS_WIN); g.ldb = DM; g.K = DM; g.nM = TP / BM; g.nN = INC / BM; g.lgnN = 5; g.mode = MODE_PROJ; break;
            case 1: g.A = (const bf16_t*)(ws + WS_UH); g.lda = UHK; g.sA = (unsigned)(CHP * UHK * 2); g.Bt = (const bf16_t*)(ws + WS_BST); g.ldb = 512; g.sB = (unsigned)(256 * 512 * 2); g.K = 512; g.nM = CHP / BM; g.nN = 1; g.nb = 32; g.mode = MODE_S; break;
            case 2: if (fz) DESC_Y else DESC_NONE break;
            case 4: if (fz) { if (bx < 128) DESC_A else DESC_GLU } else DESC_Y break;
            case 5: if (fz) DESC_NONE else DESC_GLU break;
            case 6: if (fz) DESC_NONE else DESC_A break;
            case 7: g.A = (const bf16_t*)(ws + WS_SB); g.lda = 512; g.Bt = (const bf16_t*)(ws + WS_WB); g.ldb = 512; g.K = 512; g.nM = TP / BM; g.nN = 4; g.lgnN = 2; g.mode = MODE_B; break;
            case 8: g.A = (const bf16_t*)(ws + WS_M1); g.lda = 1024; g.Bt = (const bf16_t*)(ws + WS_WOUT); g.ldb = 1024; g.K = 1024; g.nM = TP / BM; g.nN = 4; g.lgnN = 2; g.mode = MODE_OUT; break;
            default: DESC_NONE break;
            }
#undef DESC_Y
#undef DESC_A
#undef DESC_GLU
#undef DESC_NONE
            { const int total = g.nM * g.nN * g.nb; g.u0 = bx; g.ustride = G; g.ucount = total > bx ? (total - bx + G - 1) / G : 0; }
            if (fz && k == 2) { g.u0 = (bx / SEQP) * 6 + (bx % SEQP); g.ustride = SEQP; g.ucount = bx < SEQP * 32 ? 2 : 0; }
            if (fz && k == 4) { if (bx < 128) { g.u0 = bx; g.ustride = 128; g.ucount = 3; } else { g.u0 = bx - 128; g.ustride = 128; g.ucount = (bx - 128) < 64 ? 2 : 1; } }
            const bool fuse_scan = (G >= SEQP * 32);
            if (has_gemm) {
#ifndef NO_GEMM
                gemm_phase(a, lds, g, G, bx, tid);
#endif
#ifndef NO_SCAN
                if (k == 1 && fuse_scan && bx < SEQP * 32) {
                    asm volatile("s_waitcnt vmcnt(0)" ::: "memory"); __syncthreads();
                    const int it0 = (bx % SEQP) * 64 + (bx / SEQP) * 2;
                    step_scan(a, lds, tid, it0, it0 + 2, 1);
                    asm volatile("s_waitcnt vmcnt(0)" ::: "memory"); __syncthreads();
                }
#endif
            }
#ifndef NO_ATTN
            else if (k == (fz ? 3 : 2)) step_attention(a, lds, pass, tid, bx);
#endif
#ifndef NO_SCAN
            else if (k == 3 && !fz && !fuse_scan) step_scan(a, lds, tid, bx, SEQP * 32 * 2, G);
#endif
            else if (k == 9) step_final_norm(a, pass, tid, bx);
        }
        { bool need = sync_after(st) && !(st > 0 && (st - 1) % 10 == 3 && G >= SEQP * 32);
          if (G == 256 && st > 0) { const int kk = (st - 1) % 10; need = (kk == 0 || kk == 3 || kk == 4 || kk == 7 || kk == 8); }
          if (a.do_sync && st + 1 < a.st_hi && need) xcd_barrier(bar); }
    }
}

extern "C" void kernel_launch(void* const* d_in, const int* in_sizes, int n_in, void* d_out, int out_size, void* d_ws, size_t ws_size, hipStream_t stream) {
    constexpr int LDS_BYTES = STAGE_BYTES + 32768;
    static int grid = 0;
    if (grid == 0) {
        if (n_in != 17 || out_size != TTOK * DM || ws_size < WS_END) { fprintf(stderr, "kernel_launch: unexpected shapes (n_in %d out %d ws %zu need %zu)\n", n_in, out_size, ws_size, (size_t)WS_END); grid = -1; return; }
        int dev = 0, cus = 0, per_cu = 0;
        hipGetDevice(&dev); hipDeviceGetAttribute(&cus, hipDeviceAttributeMultiprocessorCount, dev);
        hipFuncSetAttribute((const void*)fwd_kernel, hipFuncAttributeMaxDynamicSharedMemorySize, LDS_BYTES);
        hipOccupancyMaxActiveBlocksPerMultiprocessor(&per_cu, (const void*)fwd_kernel, 512, LDS_BYTES);
        if (per_cu < 1) per_cu = 1;
        grid = cus * 1;
        (void)hipGetLastError();
    }
    if (grid < 0) return;
    (void)hipMemsetAsync((unsigned char*)d_ws + WS_BAR, 0, WS_BAR_BYTES + 4096, stream);
    Args a{};
    for (int i = 0; i < 17; ++i) a.in[i] = (const float*)d_in[i];
    a.out = (float*)d_out; a.ws = (unsigned char*)d_ws; a.pad = 0;
#ifndef MULTI_LAUNCH
#define MULTI_LAUNCH 0
#endif
#if MULTI_LAUNCH
    a.do_sync = 0;
    for (int st = 0; st < NSTEPS; ++st) {
        a.st_lo = st; a.st_hi = st + 1;
        hipLaunchKernelGGL(fwd_kernel, dim3(grid), dim3(512), LDS_BYTES, stream, a);
    }
#else
    a.do_sync = 1; a.st_lo = 0; a.st_hi = NSTEPS;
    void* args[] = {&a};
    hipError_t e = hipLaunchCooperativeKernel((const void*)fwd_kernel, dim3(grid), dim3(512), args, LDS_BYTES, stream);
    if (e != hipSuccess) fprintf(stderr, "cooperative launch failed: %s (grid %d)\n", hipGetErrorString(e), grid);
#endif
}
```

```cpp
#include <hip/hip_runtime.h>
#include <hip/hip_cooperative_groups.h>
#include <cstdio>

namespace cg = cooperative_groups;

#define LAS __attribute__((address_space(3)))
typedef unsigned short bf16_t;
typedef short bf16x8 __attribute__((ext_vector_type(8)));
typedef short bf16x4 __attribute__((ext_vector_type(4)));
typedef float f32x4 __attribute__((ext_vector_type(4)));
typedef float f32x2 __attribute__((ext_vector_type(2)));
typedef unsigned u32x4 __attribute__((ext_vector_type(4)));
typedef unsigned u32x2 __attribute__((ext_vector_type(2)));

constexpr int DM = 1024, SEQL = 8192, NSEQ = 6, TTOK = NSEQ * SEQL;
constexpr int NPASS = 2, SEQP = 3, TP = SEQP * SEQL;
constexpr int INC = 8192, QKVW = 1536;
constexpr int LC = 32, NCH = SEQL / LC  , CHP = SEQP * NCH  ;
constexpr int UHK = LC * 16 + 256;
constexpr float EPSN = 1e-6f;
constexpr float QSCALE = 0.18033688011112042f;

constexpr size_t AL(size_t x) { return (x + 255) & ~(size_t)255; }
constexpr size_t WS_WIN = 4096;
constexpr size_t WS_WGLU = WS_WIN + (size_t)INC * DM * 2;
constexpr size_t WS_WA = WS_WGLU + (size_t)512 * 512 * 2;
constexpr size_t WS_WB = WS_WA + (size_t)1024 * 512 * 2;
constexpr size_t WS_WOUT = WS_WB + (size_t)1024 * 512 * 2;
constexpr size_t WS_MTC = WS_WOUT + (size_t)1024 * 1024 * 2;
constexpr size_t WS_BST = WS_MTC + (size_t)32 * 512 * UHK * 2;
constexpr size_t WS_ROPE = WS_BST + (size_t)32 * 256 * 512 * 2;
constexpr size_t WS_PW = WS_ROPE + (size_t)2 * SEQL * 32 * 4;
constexpr size_t WS_KT = WS_PW + (size_t)2 * 32 * 64 * 8;
constexpr size_t WS_Q = WS_KT + (size_t)32 * 2 * 32 * 256 * 4;
constexpr size_t WS_K = WS_Q + (size_t)TP * QKVW * 2;
constexpr size_t WS_VT = WS_K + (size_t)TP * QKVW * 2;
constexpr size_t WS_ZA = WS_VT + (size_t)TP * QKVW * 2;
constexpr size_t WS_ZB = WS_ZA + (size_t)TP * 512 * 2;
constexpr size_t WS_GA = WS_ZB + (size_t)TP * 512 * 2;
constexpr size_t WS_GB = WS_GA + (size_t)TP * 1024 * 2;
constexpr size_t WS_UH = WS_GB + (size_t)TP * 1024 * 2;
constexpr size_t WS_S = WS_UH + (size_t)32 * CHP * UHK * 2;
constexpr size_t WS_GAO = WS_S + (size_t)32 * CHP * 256 * 4;
constexpr size_t WS_BAR = WS_GAO + (size_t)TP * 512 * 2;
constexpr size_t WS_BAR_BYTES = 32768;
constexpr size_t WS_CTL = WS_BAR + WS_BAR_BYTES;
constexpr size_t WS_END = WS_CTL + 4096;
constexpr size_t WS_SB = WS_Q + (size_t)TP * 512 * 2;
constexpr size_t WS_M1 = WS_K;
constexpr size_t WS_ACC = WS_Q;
constexpr size_t OUT_HN_OFF = (size_t)SEQP * SEQL * DM * 4;

struct Args {
    const float* in[17];
    float* out;
    unsigned char* ws;
    int st_lo, st_hi;
    int do_sync, pad;
};

typedef __bf16 bf16v2 __attribute__((ext_vector_type(2)));
__device__ __forceinline__ unsigned cvt_pk_bf16(float lo, float hi) { const f32x2 v = (f32x2){lo, hi}; const bf16v2 r = __builtin_convertvector(v, bf16v2); return __builtin_bit_cast(unsigned, r); }
__device__ __forceinline__ float bf_lo(unsigned w) { return __uint_as_float(w << 16); }
__device__ __forceinline__ float bf_hi(unsigned w) { return __uint_as_float(w & 0xffff0000u); }
__device__ __forceinline__ float fast_rcp(float x) { return __builtin_amdgcn_rcpf(x); }
__device__ __forceinline__ float sigmoidf_(float x) { return fast_rcp(1.0f + __builtin_amdgcn_exp2f(-1.4426950408889634f * x)); }
__device__ __forceinline__ float siluf_(float x) { return x * sigmoidf_(x); }
__device__ __forceinline__ float gelu_tanh(float x) { const float u = x * (1.5957691216057308f + 0.07135481627260025f * x * x); return x * sigmoidf_(u); }
__device__ __forceinline__ float wave_sum(float v) {
#pragma unroll
    for (int o = 1; o < 64; o <<= 1) v += __shfl_xor(v, o);
    return v;
}
__device__ __forceinline__ const float* xrow_ptr(const float* xp, const float* xs, int tg) {
    return tg < 4 * SEQL ? xp + (size_t)tg * DM : xs + (size_t)(tg - 4 * SEQL) * DM;
}

constexpr int BM = 256, BK = 64, HALF = 128, HTB = HALF * BK * 2, STAGE_BYTES = 8 * HTB, NXCD = 8, WGM = 8;
__host__ __device__ __forceinline__ int lds_byte(int r, int c) { const int st = (r >> 4) * 2 + (c >> 5), rr = r & 15, cc = c & 31, ob = rr * 64 + cc * 2; return st * 1024 + (ob ^ (((ob >> 9) & 1) << 5)); }
__host__ __device__ __forceinline__ void stage_rc(int b, int& R, int& C) { const int st = b / 1024, sb = b % 1024, swz = sb ^ (((sb >> 9) & 1) << 5); R = (st >> 1) * 16 + swz / 64; C = (st & 1) * 32 + (swz % 64) / 2; }
__host__ __device__ __forceinline__ int perm32(int rho) { const int n = rho >> 4, i = rho & 15; return 8 * (i >> 2) + 4 * n + (i & 3); }

enum { MODE_PROJ = 0, MODE_S = 1, MODE_Y = 2, MODE_GLU = 3, MODE_A = 4, MODE_B = 5, MODE_OUT = 6 };
struct Unit { int pm, pn, bz; };
struct GemmD {
    const bf16_t* A; const bf16_t* Bt;
    int lda, ldb, K, nM, nN, nb;
    unsigned sA, sB;
    int mode, pass, lgnN;
    int u0, ustride, ucount;
};
__device__ __forceinline__ bool unit_next(const GemmD& g, int i, int G, int c, int& pm, int& pn, int& bz) {
    const bool ok = i < g.ucount;
    const int Li = ok ? g.u0 + i * g.ustride : 0;
    if (g.nb == 1) {
        const int lg = g.lgnN, q = (g.nM << lg) >> 3;
        const int wgid = (Li & 7) * q + (Li >> 3);
        const int gid = wgid >> (3 + lg), rem = wgid & ((8 << lg) - 1);
        pm = gid * 8 + (rem & 7); pn = rem >> 3; bz = 0;
    } else {
        const int nwg = g.nM * g.nN;
        const int w = Li % nwg; bz = Li / nwg; pm = w % g.nM; pn = w / g.nM;
    }
    return ok;
}

__device__ __forceinline__ void epilogue(const Args& a, LAS unsigned char* lds, const GemmD& g, const f32x4 (&acc)[2][2][4][2], const Unit& u, int wr, int wc, int fr, int fq) {
    asm volatile("" : "+v"(fr), "+v"(fq));
    unsigned char* ws = a.ws;
    const int rbase = u.pm * BM + wr * 64 + fr;
    const int cl = wc * 32 + fq * 8;
    if (g.mode == MODE_PROJ) {
        const int pn = u.pn;
        if (pn < 12) {
            const bool isq = pn < 6;
            bf16_t* dst = (bf16_t*)(ws + (isq ? WS_Q : WS_K));
            const float* rc = (const float*)(ws + WS_ROPE); const float* rs = rc + SEQL * 32;
            const int a4 = 4 * (4 * (wc & 1) + fq);
            const int pq = isq ? pn : pn - 6, gi = pq >> 1, sh = 2 * gi, dmask = (1 << sh) - 1, Lg = SEQL >> sh;
            const float sc = isq ? QSCALE : 1.0f;
            const int pos0 = rbase & (SEQL - 1);
            const f32x4 cb = *(const f32x4*)(rc + pos0 * 32 + a4), sb = *(const f32x4*)(rs + pos0 * 32 + a4);
            const f32x4 c16 = *(const f32x4*)(rc + 16 * 32 + a4), s16 = *(const f32x4*)(rs + 16 * 32 + a4);
            const f32x4 c128 = *(const f32x4*)(rc + 128 * 32 + a4), s128 = *(const f32x4*)(rs + 128 * 32 + a4);
#pragma unroll
            for (int ai = 0; ai < 2; ++ai) {
                asm volatile("" ::: "memory");
                f32x4 cvv[4], svv[4];
                cvv[0] = ai ? cb * c128 - sb * s128 : cb; svv[0] = ai ? sb * c128 + cb * s128 : sb;
#pragma unroll
                for (int m = 1; m < 4; ++m) { cvv[m] = cvv[m - 1] * c16 - svv[m - 1] * s16; svv[m] = svv[m - 1] * c16 + cvv[m - 1] * s16; }
#pragma unroll
                for (int m = 0; m < 4; ++m) {
                    const int tl = rbase + ai * HALF + m * 16; const int pos = tl & (SEQL - 1), sq = tl >> 13;
                    const int kidx = (pos & dmask) * Lg + (pos >> sh);
                    const f32x4 cv = cvv[m] * sc, sv = svv[m] * sc;
#pragma unroll
                    for (int bj = 0; bj < 2; ++bj) {
                        const f32x4 x1 = acc[ai][bj][m][0], x2 = acc[ai][bj][m][1];
                        const f32x4 o1 = x1 * cv - x2 * sv, o2 = x2 * cv + x1 * sv;
                        const int head = pq * 4 + 2 * bj + (wc >> 1);
                        const int ch = 4 * (wc & 1) + fq;
                        bf16_t* p = dst + (size_t)(sq * 24 + head) * SEQL * 64 + (isq ? (size_t)kidx * 64 + ch * 8 : (size_t)(kidx >> 4) * 1024 + ch * 128 + (kidx & 15) * 8);
                        u32x4 w; w.x = cvt_pk_bf16(o1[0], o1[1]); w.y = cvt_pk_bf16(o1[2], o1[3]); w.z = cvt_pk_bf16(o2[0], o2[1]); w.w = cvt_pk_bf16(o2[2], o2[3]);
                        *(u32x4*)p = w;
                    }
                }
            }
        } else if (pn < 18) {
            bf16_t* dst = (bf16_t*)(ws + WS_VT);
            const int gi = (pn - 12) >> 1, sh = 2 * gi;
            const int wid = wr * 4 + wc, lane = fq * 16 + fr;
            LAS bf16_t* tile = (LAS bf16_t*)(lds + STAGE_BYTES + wid * 4096);
#pragma unroll
            for (int ai = 0; ai < 2; ++ai) {
                const int tl0 = u.pm * BM + wr * 64 + ai * HALF;
                const int pos0 = tl0 & (SEQL - 1), sq = tl0 >> 13;
#pragma unroll
                for (int bj = 0; bj < 2; ++bj) {
                    asm volatile("" ::: "memory");
                    const int h = (4 * (pn - 12) + 2 * bj + (wc >> 1)) & 7;
#pragma unroll
                    for (int m = 0; m < 4; ++m) {
                        const int t = 16 * m + fr;
                        const int slot = gi == 0 ? t : (gi == 1 ? ((t & 3) * 16 + (t >> 2)) : ((t & 15) * 4 + (t >> 4)));
#pragma unroll
                        for (int n = 0; n < 2; ++n)
#pragma unroll
                            for (int j = 0; j < 4; ++j) { const unsigned w = cvt_pk_bf16(acc[ai][bj][m][n][j], 0.f); tile[(8 * fq + 4 * n + j) * 64 + slot] = (bf16_t)(w & 0xffffu); }
                    }
                    bf16_t* hb0 = dst + (size_t)(((sq * 3 + gi) * 8 + h) * 512) * 1024;
#pragma unroll
                    for (int i = 0; i < 4; ++i) {
                        const int c = lane + 64 * i, d = c >> 3, s8 = (c & 7) * 8;
                        const u32x4 v = *(const LAS u32x4*)(tile + d * 64 + s8);
                        const int dg = 32 * (wc & 1) + d; const int doff = (dg >> 4) * 256 + (dg & 15) * 4;
                        if (gi == 0) { const int kidx = pos0 + s8; bf16_t* q = hb0 + (size_t)(kidx >> 4) * 1024 + doff + ((kidx & 15) >> 2) * 64; *(u32x2*)q = (u32x2){v.x, v.y}; *(u32x2*)(q + 64) = (u32x2){v.z, v.w}; }
                        else if (gi == 1) { const int kidx = (s8 >> 4) * 2048 + (pos0 >> 2) + (s8 & 15); bf16_t* q = hb0 + (size_t)(kidx >> 4) * 1024 + doff + ((kidx & 15) >> 2) * 64; *(u32x2*)q = (u32x2){v.x, v.y}; *(u32x2*)(q + 64) = (u32x2){v.z, v.w}; }
                        else { const int ka = (s8 >> 2) * 512 + (pos0 >> 4), kb = ka + 512;
                            *(u32x2*)(hb0 + (size_t)(ka >> 4) * 1024 + doff + ((ka & 15) >> 2) * 64) = (u32x2){v.x, v.y}; *(u32x2*)(hb0 + (size_t)(kb >> 4) * 1024 + doff + ((kb & 15) >> 2) * 64) = (u32x2){v.z, v.w}; }
                    }
                }
            }
        } else if (pn == 20 || pn == 21) {
            bf16_t* dst = (bf16_t*)(ws + WS_UH);
#pragma unroll
            for (int ai = 0; ai < 2; ++ai)
#pragma unroll
                for (int m = 0; m < 4; ++m) { asm volatile("" ::: "memory");
                    const int tl = rbase + ai * HALF + m * 16;
#pragma unroll
                    for (int bj = 0; bj < 2; ++bj) {
                        const int gg = 16 * (pn - 20) + 8 * bj + 2 * wc + (fq >> 1);
                        bf16_t* p = dst + ((size_t)(gg * CHP + (tl >> 5)) * UHK) + (tl & 31) * 16 + 8 * (fq & 1);
                        const f32x4 v0 = acc[ai][bj][m][0], v1 = acc[ai][bj][m][1];
                        u32x4 w; w.x = cvt_pk_bf16(v0[0], v0[1]); w.y = cvt_pk_bf16(v0[2], v0[3]); w.z = cvt_pk_bf16(v1[0], v1[1]); w.w = cvt_pk_bf16(v1[2], v1[3]);
                        *(u32x4*)p = w;
                    }
                }
        } else {
            bf16_t* dst; int ld, c0; bool silu;
            if (pn < 20) { dst = (bf16_t*)(ws + WS_ZA); ld = 512; c0 = (pn - 18) * 256; silu = true; }
            else if (pn < 24) { dst = (bf16_t*)(ws + WS_ZB); ld = 512; c0 = (pn - 22) * 256; silu = true; }
            else if (pn < 28) { dst = (bf16_t*)(ws + WS_GA); ld = 1024; c0 = (pn - 24) * 256; silu = false; }
            else { dst = (bf16_t*)(ws + WS_GB); ld = 1024; c0 = (pn - 28) * 256; silu = false; }
#pragma unroll
            for (int ai = 0; ai < 2; ++ai)
#pragma unroll
                for (int m = 0; m < 4; ++m) { asm volatile("" ::: "memory");
                    const int tl = rbase + ai * HALF + m * 16;
#pragma unroll
                    for (int bj = 0; bj < 2; ++bj) {
                        f32x4 v0 = acc[ai][bj][m][0], v1 = acc[ai][bj][m][1];
#pragma unroll
                        for (int j = 0; j < 4; ++j) { const float s0 = sigmoidf_(v0[j]), s1 = sigmoidf_(v1[j]); v0[j] = silu ? v0[j] * s0 : s0; v1[j] = silu ? v1[j] * s1 : s1; }
                        u32x4 w; w.x = cvt_pk_bf16(v0[0], v0[1]); w.y = cvt_pk_bf16(v0[2], v0[3]); w.z = cvt_pk_bf16(v1[0], v1[1]); w.w = cvt_pk_bf16(v1[2], v1[3]);
                        *(u32x4*)(dst + (size_t)tl * ld + c0 + cl + bj * HALF) = w;
                    }
                }
        }
    } else if (g.mode == MODE_S) {
        float* dst = (float*)(ws + WS_S) + (size_t)u.bz * CHP * 256;
#pragma unroll
        for (int ai = 0; ai < 2; ++ai)
#pragma unroll
            for (int m = 0; m < 4; ++m) { asm volatile("" ::: "memory");
                const int r = rbase + ai * HALF + m * 16;
#pragma unroll
                for (int bj = 0; bj < 2; ++bj) { float* p = dst + (size_t)r * 256 + cl + bj * HALF; *(f32x4*)p = acc[ai][bj][m][0]; *(f32x4*)(p + 4) = acc[ai][bj][m][1]; }
            }
    } else if (g.mode == MODE_Y) {
        bf16_t* dst = (bf16_t*)((unsigned char*)a.out + OUT_HN_OFF) + (size_t)g.pass * TP * DM;
#pragma unroll
        for (int ai = 0; ai < 2; ++ai)
#pragma unroll
            for (int m = 0; m < 4; ++m) { asm volatile("" ::: "memory");
                const int r = rbase + ai * HALF + m * 16;
#pragma unroll
                for (int bj = 0; bj < 2; ++bj) {
                    const int t = 16 * u.pn + 8 * bj + 2 * wc + (fq >> 1);
                    f32x4 v0 = acc[ai][bj][m][0], v1 = acc[ai][bj][m][1];
#pragma unroll
                    for (int j = 0; j < 4; ++j) { v0[j] = gelu_tanh(v0[j]); v1[j] = gelu_tanh(v1[j]); }
                    u32x4 w; w.x = cvt_pk_bf16(v0[0], v0[1]); w.y = cvt_pk_bf16(v0[2], v0[3]); w.z = cvt_pk_bf16(v1[0], v1[1]); w.w = cvt_pk_bf16(v1[2], v1[3]);
                    *(u32x4*)(dst + (size_t)(r * LC + t) * 512 + u.bz * 16 + 8 * (fq & 1)) = w;
                }
            }
    } else if (g.mode == MODE_GLU) {
        const bf16_t* sg = (const bf16_t*)((unsigned char*)a.out + OUT_HN_OFF) + (size_t)g.pass * TP * DM; const bf16_t* zb = (const bf16_t*)(ws + WS_ZB); bf16_t* dst = (bf16_t*)(ws + WS_SB);
        u32x4 sq4[2][2][2], zq4[2][2][2];
#define EPI_LD(ST, BUF) _Pragma("unroll") for (int m2 = 0; m2 < 2; ++m2) _Pragma("unroll") for (int bj = 0; bj < 2; ++bj) { \
            const size_t off = (size_t)(rbase + ((ST) >> 1) * HALF + (2 * ((ST) & 1) + m2) * 16) * 512 + u.pn * BM + cl + bj * HALF; sq4[BUF][m2][bj] = *(const u32x4*)(sg + off); zq4[BUF][m2][bj] = *(const u32x4*)(zb + off); }
        EPI_LD(0, 0)
#pragma unroll
        for (int st = 0; st < 4; ++st) {
            if (st == 0) EPI_LD(1, 1) else if (st == 1) EPI_LD(2, 0) else if (st == 2) EPI_LD(3, 1)
            const int ai = st >> 1, buf = st & 1;
#pragma unroll
            for (int m2 = 0; m2 < 2; ++m2)
#pragma unroll
                for (int bj = 0; bj < 2; ++bj) {
                    const int m = 2 * (st & 1) + m2;
                    const size_t off = (size_t)(rbase + ai * HALF + m * 16) * 512 + u.pn * BM + cl + bj * HALF;
                    const u32x4 s4 = sq4[buf][m2][bj], z4 = zq4[buf][m2][bj];
                    const f32x4 v0 = acc[ai][bj][m][0], v1 = acc[ai][bj][m][1];
                    u32x4 w;
                    w.x = cvt_pk_bf16(bf_lo(s4.x) * sigmoidf_(v0[0]) * bf_lo(z4.x), bf_hi(s4.x) * sigmoidf_(v0[1]) * bf_hi(z4.x));
                    w.y = cvt_pk_bf16(bf_lo(s4.y) * sigmoidf_(v0[2]) * bf_lo(z4.y), bf_hi(s4.y) * sigmoidf_(v0[3]) * bf_hi(z4.y));
                    w.z = cvt_pk_bf16(bf_lo(s4.z) * sigmoidf_(v1[0]) * bf_lo(z4.z), bf_hi(s4.z) * sigmoidf_(v1[1]) * bf_hi(z4.z));
                    w.w = cvt_pk_bf16(bf_lo(s4.w) * sigmoidf_(v1[2]) * bf_lo(z4.w), bf_hi(s4.w) * sigmoidf_(v1[3]) * bf_hi(z4.w));
                    *(u32x4*)(dst + off) = w;
                }
        }
#undef EPI_LD
    } else if (g.mode == MODE_A || g.mode == MODE_B) {
        const bool isb = g.mode == MODE_B;
        const bf16_t* gt = (const bf16_t*)(ws + (isb ? WS_GB : WS_GA)); bf16_t* dst = (bf16_t*)(ws + WS_M1);
        u32x4 gq4[2][2][2], pq4[2][2][2];
#define EPI_LD(ST, BUF) _Pragma("unroll") for (int m2 = 0; m2 < 2; ++m2) _Pragma("unroll") for (int bj = 0; bj < 2; ++bj) { \
            const size_t off = (size_t)(rbase + ((ST) >> 1) * HALF + (2 * ((ST) & 1) + m2) * 16) * 1024 + u.pn * BM + cl + bj * HALF; gq4[BUF][m2][bj] = *(const u32x4*)(gt + off); \
            pq4[BUF][m2][bj] = (u32x4){0u, 0u, 0u, 0u}; if (isb) pq4[BUF][m2][bj] = *(const u32x4*)(dst + off); }
        EPI_LD(0, 0)
#pragma unroll
        for (int st = 0; st < 4; ++st) {
            if (st == 0) EPI_LD(1, 1) else if (st == 1) EPI_LD(2, 0) else if (st == 2) EPI_LD(3, 1)
            const int ai = st >> 1, buf = st & 1;
#pragma unroll
            for (int m2 = 0; m2 < 2; ++m2)
#pragma unroll
                for (int bj = 0; bj < 2; ++bj) {
                    const int m = 2 * (st & 1) + m2;
                    const size_t off = (size_t)(rbase + ai * HALF + m * 16) * 1024 + u.pn * BM + cl + bj * HALF;
                    const u32x4 g4 = gq4[buf][m2][bj], p4 = pq4[buf][m2][bj];
                    const f32x4 v0 = acc[ai][bj][m][0], v1 = acc[ai][bj][m][1];
                    u32x4 w;
                    w.x = cvt_pk_bf16(bf_lo(p4.x) + bf_lo(g4.x) * v0[0], bf_hi(p4.x) + bf_hi(g4.x) * v0[1]);
                    w.y = cvt_pk_bf16(bf_lo(p4.y) + bf_lo(g4.y) * v0[2], bf_hi(p4.y) + bf_hi(g4.y) * v0[3]);
                    w.z = cvt_pk_bf16(bf_lo(p4.z) + bf_lo(g4.z) * v1[0], bf_hi(p4.z) + bf_hi(g4.z) * v1[1]);
                    w.w = cvt_pk_bf16(bf_lo(p4.w) + bf_lo(g4.w) * v1[2], bf_hi(p4.w) + bf_hi(g4.w) * v1[3]);
                    *(u32x4*)(dst + off) = w;
                }
        }
#undef EPI_LD
    } else {
        bf16_t* dst = (bf16_t*)(ws + WS_ACC);
#pragma unroll
        for (int ai = 0; ai < 2; ++ai)
#pragma unroll
            for (int m = 0; m < 4; ++m) {
                const int tl = rbase + ai * HALF + m * 16;
#pragma unroll
                for (int bj = 0; bj < 2; ++bj) {
                    const f32x4 v0 = acc[ai][bj][m][0], v1 = acc[ai][bj][m][1];
                    u32x4 w; w.x = cvt_pk_bf16(v0[0], v0[1]); w.y = cvt_pk_bf16(v0[2], v0[3]); w.z = cvt_pk_bf16(v1[0], v1[1]); w.w = cvt_pk_bf16(v1[2], v1[3]);
                    *(u32x4*)(dst + (size_t)tl * DM + u.pn * BM + cl + bj * HALF) = w;
                }
            }
    }
}

__device__ __forceinline__ void gemm_phase(const Args& a, LAS unsigned char* lds, const GemmD& g, int G, int cidx, int tid) {
    const int wid = __builtin_amdgcn_readfirstlane(tid >> 6), lane = tid & 63, wr = wid >> 2, wc = wid & 3, fr = lane & 15, fq = lane >> 4;
    const int K = g.K, nt = K / BK;
    unsigned voffA[2], voffB[2];
#pragma unroll
    for (int i = 0; i < 2; ++i) { int R, C; stage_rc(tid * 16 + i * 8192, R, C); const int Rb = (R & ~31) + perm32(R & 31);
        voffA[i] = (unsigned)(R * g.lda + C) * 2u; voffB[i] = (unsigned)(Rb * g.ldb + C) * 2u; }
    const size_t kstep = (size_t)(BK * 2);
    const size_t hstepA = (size_t)HALF * g.lda * 2, hstepB = (size_t)HALF * g.ldb * 2;
    const size_t tstepA = 2 * hstepA, tstepB = 2 * hstepB;
    const unsigned ldsw = (unsigned)wid * 1024u;
    const int aoff = lds_byte(wr * 64 + fr, fq * 8), boff = lds_byte(wc * 32 + fr, fq * 8);
#define PG8_SA(b, h) (((b) * 2 + (h)) * HTB)
#define PG8_SB(b, h) ((4 + (b) * 2 + (h)) * HTB)
#define PG8_STAGE(bufoff, gbase, voff) do { _Pragma("unroll") for (int _i = 0; _i < 2; ++_i) \
        __builtin_amdgcn_global_load_lds((const unsigned*)((const char*)(gbase) + (voff)[_i]), (LAS unsigned*)(lds + (bufoff) + ldsw + _i * 8192), 16, 0, 0); } while (0)
#define PG8_LDA(dst, b, h) do { _Pragma("unroll") for (int m = 0; m < 4; ++m) _Pragma("unroll") for (int k = 0; k < 2; ++k) dst[m][k] = *(const LAS bf16x8*)(lds + PG8_SA(b, h) + aoff + m * 2048 + k * 1024); } while (0)
#define PG8_LDB(dst, b, h) do { _Pragma("unroll") for (int n = 0; n < 2; ++n) _Pragma("unroll") for (int k = 0; k < 2; ++k) dst[n][k] = *(const LAS bf16x8*)(lds + PG8_SB(b, h) + boff + n * 2048 + k * 1024); } while (0)
#define PG8_MMA(ai, bj, At, Bt) do { __builtin_amdgcn_s_setprio(1); _Pragma("unroll") for (int m = 0; m < 4; ++m) _Pragma("unroll") for (int n = 0; n < 2; ++n) _Pragma("unroll") for (int k = 0; k < 2; ++k) \
        acc[ai][bj][m][n] = __builtin_amdgcn_mfma_f32_16x16x32_bf16(Bt[n][k], At[m][k], acc[ai][bj][m][n], 0, 0, 0); __builtin_amdgcn_s_setprio(0); } while (0)
#define PG8_WAIT_V(n) asm volatile("s_waitcnt vmcnt(" #n ")" ::: "memory")
#define PG8_WAIT_L(n) asm volatile("s_waitcnt lgkmcnt(" #n ")" ::: "memory")
#define PG8_BAR __builtin_amdgcn_s_barrier()
#define PG8_SCHED __builtin_amdgcn_sched_barrier(0)
    Unit cur, nxt; int ui = 0;
    { int pm_, pn_, bz_; if (!unit_next(g, 0, G, cidx, pm_, pn_, bz_)) return; cur.pm = pm_; cur.pn = pn_; cur.bz = bz_; }
    f32x4 acc[2][2][4][2];
#pragma unroll
    for (int a = 0; a < 2; ++a)
#pragma unroll
        for (int b = 0; b < 2; ++b)
#pragma unroll
            for (int m = 0; m < 4; ++m)
#pragma unroll
                for (int n = 0; n < 2; ++n) acc[a][b][m][n] = (f32x4){0.f, 0.f, 0.f, 0.f};
    bf16x8 At[4][2], B0[2][2], B1[2][2];
    const char* cA = (const char*)g.A + (size_t)cur.bz * g.sA + (size_t)cur.pm * tstepA; const char* cB = (const char*)g.Bt + (size_t)cur.bz * g.sB + (size_t)cur.pn * tstepB;
    PG8_STAGE(PG8_SB(0, 0), cB, voffB); PG8_STAGE(PG8_SA(0, 0), cA, voffA); PG8_STAGE(PG8_SB(0, 1), cB + hstepB, voffB); PG8_STAGE(PG8_SA(0, 1), cA + hstepA, voffA);
    if (wr == 1) PG8_BAR;
    PG8_WAIT_V(4); PG8_BAR;
    PG8_STAGE(PG8_SB(1, 0), cB + kstep, voffB); PG8_STAGE(PG8_SA(1, 0), cA + kstep, voffA); PG8_STAGE(PG8_SB(1, 1), cB + hstepB + kstep, voffB);
    PG8_WAIT_V(6); PG8_BAR;
    for (;;) {
        int npm, npn, nbz; const bool has_next = unit_next(g, ui + 1, G, cidx, npm, npn, nbz); nxt.pm = npm; nxt.pn = npn; nxt.bz = nbz;
        const char* nA = has_next ? (const char*)g.A + (size_t)nxt.bz * g.sA + (size_t)nxt.pm * tstepA : cA; const char* nB = has_next ? (const char*)g.Bt + (size_t)nxt.bz * g.sB + (size_t)nxt.pn * tstepB : cB;
        for (int t = 0; t < nt; t += 2) {
            const bool last = (t == nt - 2);
            const char* a1 = cA + (size_t)(t + 1) * kstep;
            const char* a2 = last ? nA : cA + (size_t)(t + 2) * kstep; const char* b2 = last ? nB : cB + (size_t)(t + 2) * kstep;
            const char* a3 = a2 + kstep; const char* b3 = b2 + kstep;
            PG8_LDB(B0, 0, 0); PG8_SCHED; PG8_LDA(At, 0, 0); PG8_STAGE(PG8_SA(1, 1), a1 + hstepA, voffA);
            PG8_WAIT_L(8); PG8_BAR; PG8_WAIT_L(0); PG8_MMA(0, 0, At, B0); PG8_BAR; PG8_SCHED;
            PG8_LDB(B1, 0, 1); PG8_STAGE(PG8_SB(0, 0), b2, voffB);
            PG8_BAR; PG8_WAIT_L(0); PG8_MMA(0, 1, At, B1); PG8_BAR;
            PG8_LDA(At, 0, 1); PG8_STAGE(PG8_SA(0, 0), a2, voffA);
            PG8_BAR; PG8_WAIT_L(0); PG8_MMA(1, 0, At, B0); PG8_BAR; PG8_SCHED;
            PG8_STAGE(PG8_SB(0, 1), b2 + hstepB, voffB);
            PG8_WAIT_V(6); PG8_BAR; PG8_MMA(1, 1, At, B1); PG8_BAR;
            PG8_LDB(B0, 1, 0); PG8_SCHED; PG8_LDA(At, 1, 0); PG8_STAGE(PG8_SA(0, 1), a2 + hstepA, voffA);
            PG8_WAIT_L(8); PG8_BAR; PG8_WAIT_L(0); PG8_MMA(0, 0, At, B0); PG8_BAR; PG8_SCHED;
            PG8_LDB(B1, 1, 1); PG8_STAGE(PG8_SB(1, 0), b3, voffB);
            PG8_BAR; PG8_WAIT_L(0); PG8_MMA(0, 1, At, B1); PG8_BAR;
            PG8_LDA(At, 1, 1); PG8_STAGE(PG8_SA(1, 0), a3, voffA);
            PG8_BAR; PG8_WAIT_L(0); PG8_MMA(1, 0, At, B0); PG8_BAR; PG8_SCHED;
            PG8_STAGE(PG8_SB(1, 1), b3 + hstepB, voffB);
            PG8_WAIT_V(6); PG8_BAR; PG8_MMA(1, 1, At, B1); PG8_BAR;
        }
#ifndef NO_EPI
        epilogue(a, lds, g, acc, cur, wr, wc, fr, fq);
#else
        if (g.mode == 99) *(f32x4*)(g.out) = acc[0][0][0][0] + acc[1][1][3][1] + acc[0][1][2][0]+acc[1][0][1][1];
#endif
        if (!has_next) break;
#pragma unroll
        for (int a = 0; a < 2; ++a)
#pragma unroll
            for (int b = 0; b < 2; ++b)
#pragma unroll
                for (int m = 0; m < 4; ++m)
#pragma unroll
                    for (int n = 0; n < 2; ++n) acc[a][b][m][n] = (f32x4){0.f, 0.f, 0.f, 0.f};
        cur = nxt; cA = nA; cB = nB; ++ui;
    }
    PG8_WAIT_V(0);
    if (wr == 0) PG8_BAR;
    PG8_BAR;
#undef PG8_SA
#undef PG8_SB
#undef PG8_STAGE
#undef PG8_LDA
#undef PG8_LDB
#undef PG8_MMA
#undef PG8_WAIT_V
#undef PG8_WAIT_L
#undef PG8_BAR
#undef PG8_SCHED
}

__device__ __forceinline__ int qk_perm_row(int n) { const int i = n & 63; return (n & ~63) + 8 * ((i & 31) >> 2) + (i & 3) + 4 * (i >> 5); }
__device__ __forceinline__ void transpose_item(const float* W, int K, int N, bf16_t* WT, bool permqk, LAS float* scr, int item, int lane) {
    const int nblk = N / 32, kb = item / nblk, nb = item % nblk, k0 = 64 * kb, n0 = 32 * nb;
#pragma unroll 8
    for (int i = 0; i < 32; ++i) { const int kk = 2 * i + (lane >> 5); scr[kk * 33 + (lane & 31)] = W[(size_t)(k0 + kk) * N + n0 + (lane & 31)]; }
    asm volatile("s_waitcnt lgkmcnt(0)" ::: "memory");
    const int c = lane & 7;
#pragma unroll
    for (int j = 0; j < 4; ++j) { const int n = (lane >> 3) + 8 * j; const LAS float* s = scr + (8 * c) * 33 + n;
        u32x4 o; o.x = cvt_pk_bf16(s[0 * 33], s[1 * 33]); o.y = cvt_pk_bf16(s[2 * 33], s[3 * 33]); o.z = cvt_pk_bf16(s[4 * 33], s[5 * 33]); o.w = cvt_pk_bf16(s[6 * 33], s[7 * 33]);
        int row = n0 + n; if (permqk && row < 2 * QKVW) row = qk_perm_row(row);
        *(u32x4*)(WT + (size_t)row * K + k0 + 8 * c) = o; }
    asm volatile("s_waitcnt lgkmcnt(0)" ::: "memory");
}
__device__ __forceinline__ void reduce_angle(double a, float& c, float& s) {
    const double k = __builtin_rint(a * 0.6366197723675814); const float x = (float)(a - k * 1.5707963267948966), x2 = x * x;
    const float sn = x * (1.0f + x2 * (-1.6666666667e-1f + x2 * (8.3333333333e-3f + x2 * (-1.9841269841e-4f + x2 * 2.7557319224e-6f))));
    const float cs = 1.0f + x2 * (-0.5f + x2 * (4.1666666667e-2f + x2 * (-1.3888888889e-3f + x2 * (2.4801587302e-5f + x2 * -2.7557319224e-7f))));
    const int q = ((int)k) & 3;
    c = (q == 0) ? cs : (q == 1) ? -sn : (q == 2) ? -cs : sn;
    s = (q == 0) ? sn : (q == 1) ? cs : (q == 2) ? -sn : -cs;
}
__device__ __forceinline__ void rms_row_to_bf16(const float* xrow, const float* gw, bf16_t* orow, int lane) {
    const f32x4* xr = (const f32x4*)xrow + lane; const f32x4* gr = (const f32x4*)gw + lane;
    f32x4 v[4]; float s = 0.f;
#pragma unroll
    for (int j = 0; j < 4; ++j) { v[j] = xr[64 * j]; s += (v[j].x * v[j].x + v[j].y * v[j].y) + (v[j].z * v[j].z + v[j].w * v[j].w); }
    const float rstd = 1.0f / sqrtf(wave_sum(s) * (1.f / DM) + EPSN);
    u32x2* o8 = (u32x2*)orow + lane;
#pragma unroll
    for (int j = 0; j < 4; ++j) { const f32x4 gv = gr[64 * j]; u32x2 w; w.x = cvt_pk_bf16(v[j].x * rstd * gv.x, v[j].y * rstd * gv.y); w.y = cvt_pk_bf16(v[j].z * rstd * gv.z, v[j].w * rstd * gv.w); o8[64 * j] = w; }
}

__device__ __forceinline__ void ssm_load_bc(const Args& a, int g, int dir, LAS f32x2* Bb, LAS f32x2* Cc, int tid) {
    const float* lam_re = a.in[4]; const float* lam_im = a.in[5]; const float* log_step = a.in[6];
    const float* b_re = a.in[7]; const float* b_im = a.in[8]; const float* c_re = a.in[9]; const float* c_im = a.in[10];
    const float dt = expf(log_step[dir * 32 + g]);
    for (int idx = tid; idx < 1024; idx += 512) {
        { const int n = idx >> 4; const float lr = lam_re[(dir * 32 + g) * 64 + n], li = lam_im[(dir * 32 + g) * 64 + n];
          const float ar = lr * dt; float cb, sb, ch, sh; reduce_angle((double)li * (double)dt, cb, sb); reduce_angle(0.5 * (double)li * (double)dt, ch, sh);
          const float em1 = expm1f(ar), ea = em1 + 1.0f;
          const float nr = em1 * cb - 2.0f * sh * sh, ni = ea * sb;
          const float den = 1.0f / (lr * lr + li * li); const float cr = (nr * lr + ni * li) * den, ci = (ni * lr - nr * li) * den;
          const float br = b_re[(size_t)((dir * 32 + g) * 64) * 16 + idx], bi = b_im[(size_t)((dir * 32 + g) * 64) * 16 + idx];
          Bb[idx] = (f32x2){cr * br - ci * bi, cr * bi + ci * br}; }
        { Cc[idx] = (f32x2){c_re[(size_t)((dir * 32 + g) * 16) * 64 + idx], c_im[(size_t)((dir * 32 + g) * 16) * 64 + idx]}; }
    }
}
__device__ __forceinline__ void ssm_setup_item(const Args& a, LAS unsigned char* lds, int item, int tid) {
    const int g = item >> 1, dir = item & 1;
    LAS f32x2* pw = (LAS f32x2*)lds; LAS f32x2* Bb = pw + 33 * 64; LAS f32x2* Cc = Bb + 1024;
    LAS float* KT = (LAS float*)(Cc + 1024); LAS float* K0 = KT + 32 * 256; LAS f32x2* Bb0 = (LAS f32x2*)(K0 + 256); LAS f32x2* Cc0 = Bb0 + 1024;
    const float* lam_re = a.in[4]; const float* lam_im = a.in[5]; const float* log_step = a.in[6];
    unsigned char* ws = a.ws;
    const float dt = expf(log_step[dir * 32 + g]);
    __syncthreads();
    for (int idx = tid; idx < 33 * 64; idx += 512) {
        const int tau = idx >> 6, n = idx & 63; const float lr = lam_re[(dir * 32 + g) * 64 + n], li = lam_im[(dir * 32 + g) * 64 + n];
        const float mag = expf(lr * dt * (float)tau); float c, s; reduce_angle((double)li * (double)dt * (double)tau, c, s);
        pw[idx] = (f32x2){mag * c, mag * s};
    }
    ssm_load_bc(a, g, dir, Bb, Cc, tid);
    if (dir == 1) ssm_load_bc(a, g, 0, Bb0, Cc0, tid);
    __syncthreads();
    if (tid < 64) { float* PW = (float*)(ws + WS_PW); const f32x2 p = pw[32 * 64 + tid]; PW[((dir * 32 + g) * 64 + tid) * 2] = p.x; PW[((dir * 32 + g) * 64 + tid) * 2 + 1] = p.y; }
    for (int o = tid; o < 32 * 256; o += 512) {
        const int tau = o >> 8, co = (o >> 4) & 15, ci = o & 15; float acc = 0.f;
_Pragma("unroll 4")
        for (int n = 0; n < 64; ++n) { const f32x2 c = Cc[co * 64 + n], p = pw[tau * 64 + n], b = Bb[n * 16 + ci]; const float tr = c.x * p.x - c.y * p.y, ti = c.x * p.y + c.y * p.x; acc += tr * b.x - ti * b.y; }
        KT[o] = acc; }
    if (dir == 1 && tid < 256) { const int co = tid >> 4, ci = tid & 15; float acc = 0.f;
_Pragma("unroll 4")
        for (int n = 0; n < 64; ++n) { const f32x2 c = Cc0[co * 64 + n], b = Bb0[n * 16 + ci]; acc += c.x * b.x - c.y * b.y; }
        K0[tid] = acc; }
    { bf16_t* BsT = (bf16_t*)(ws + WS_BST) + (size_t)g * 256 * 512;
      for (int ch = tid; ch < 128 * 64; ch += 512) {
          const int row = ch >> 6, part = row >> 6, n = row & 63, kc = ch & 63, s = kc >> 1, ci0 = (kc & 1) * 8; const int e = dir ? s : 31 - s; const f32x2 p = pw[e * 64 + n];
          float v[8];
#pragma unroll
          for (int j = 0; j < 8; ++j) { const f32x2 b = Bb[n * 16 + ci0 + j]; v[j] = part ? (p.x * b.y + p.y * b.x) : (p.x * b.x - p.y * b.y); }
          u32x4 w; w.x = cvt_pk_bf16(v[0], v[1]); w.y = cvt_pk_bf16(v[2], v[3]); w.z = cvt_pk_bf16(v[4], v[5]); w.w = cvt_pk_bf16(v[6], v[7]);
          *(u32x4*)(BsT + (size_t)(dir * 128 + row) * 512 + s * 16 + ci0) = w; } }
    bf16_t* MtC = (bf16_t*)(ws + WS_MTC) + (size_t)g * 512 * UHK;
    { for (int ch = tid; ch < 512 * 16; ch += 512) {
          const int row = ch >> 4, t = row >> 4, co = row & 15, cc = ch & 15, part = cc >> 3, n0 = (cc & 7) * 8; const int e = dir ? 32 - t : t + 1;
          float v[8];
#pragma unroll
          for (int j = 0; j < 8; ++j) { const f32x2 c = Cc[co * 64 + n0 + j], p = pw[e * 64 + n0 + j]; v[j] = part ? -(c.x * p.y + c.y * p.x) : (c.x * p.x - c.y * p.y); }
          u32x4 w; w.x = cvt_pk_bf16(v[0], v[1]); w.y = cvt_pk_bf16(v[2], v[3]); w.z = cvt_pk_bf16(v[4], v[5]); w.w = cvt_pk_bf16(v[6], v[7]);
          *(u32x4*)(MtC + (size_t)row * UHK + 512 + dir * 128 + part * 64 + n0) = w; } }
    __syncthreads();
    { const float* dsk = a.in[11];
      for (int ch = tid; ch < 512 * 64; ch += 512) {
          const int kc = ch & 63, row = ch >> 6; const int s = kc >> 1, ci0 = (kc & 1) * 8, t = row >> 4, co = row & 15;
          if (dir == 0 ? (t > s) : (s >= t)) {
              const int tau = dir == 0 ? t - s : s - t;
              float v[8];
#pragma unroll
              for (int j = 0; j < 8; ++j) v[j] = KT[tau * 256 + co * 16 + ci0 + j];
              if (t == s) { const float dv = dsk[g * 16 + co];
#pragma unroll
                  for (int j = 0; j < 8; ++j) v[j] += K0[co * 16 + ci0 + j] + ((ci0 + j == co) ? dv : 0.f); }
              u32x4 w; w.x = cvt_pk_bf16(v[0], v[1]); w.y = cvt_pk_bf16(v[2], v[3]); w.z = cvt_pk_bf16(v[4], v[5]); w.w = cvt_pk_bf16(v[6], v[7]);
              *(u32x4*)(MtC + (size_t)row * UHK + s * 16 + ci0) = w;
          }
      } }
    __syncthreads();
}

__device__ __forceinline__ void step_setup(const Args& a, LAS unsigned char* lds, int tid, int bx) {
    const int lane = tid & 63, wave = tid >> 6, G = gridDim.x;
    unsigned char* ws = a.ws;
    for (int it = bx; it < 64; it += G) ssm_setup_item(a, lds, it, tid);
    { float* rc = (float*)(ws + WS_ROPE); float* rs = rc + SEQL * 32;
      for (int idx = bx * 512 + tid; idx < SEQL * 32; idx += G * 512) {
          const int pos = idx >> 5, i = idx & 31; double inv = 1.0; for (int k = 0; k < i; ++k) inv *= 0.7498942093324558;
          float c, s; reduce_angle((double)pos * inv, c, s); rc[idx] = c; rs[idx] = s; } }
    { LAS float* scr = (LAS float*)(lds) + wave * (64 * 33);
      const int gw = bx * 8 + wave, NGW = G * 8;
      constexpr int I_IN = (DM / 64) * (INC / 32), I_GLU = (512 / 64) * (512 / 32), I_AB = (512 / 64) * (1024 / 32), I_OUT = (1024 / 64) * (1024 / 32);
      constexpr int NIT = I_IN + I_GLU + 2 * I_AB + I_OUT;
      for (int it = gw; it < NIT; it += NGW) {
          int r = it;
          if (r < I_IN) { transpose_item(a.in[3], DM, INC, (bf16_t*)(ws + WS_WIN), true, scr, r, lane); continue; } r -= I_IN;
          if (r < I_GLU) { transpose_item(a.in[12], 512, 512, (bf16_t*)(ws + WS_WGLU), false, scr, r, lane); continue; } r -= I_GLU;
          if (r < I_AB) { transpose_item(a.in[13], 512, 1024, (bf16_t*)(ws + WS_WA), false, scr, r, lane); continue; } r -= I_AB;
          if (r < I_AB) { transpose_item(a.in[14], 512, 1024, (bf16_t*)(ws + WS_WB), false, scr, r, lane); continue; } r -= I_AB;
          transpose_item(a.in[15], 1024, 1024, (bf16_t*)(ws + WS_WOUT), false, scr, r, lane);
      } }
    { bf16_t* hn = (bf16_t*)((unsigned char*)a.out + OUT_HN_OFF);
      const f32x4* gr = (const f32x4*)a.in[2] + lane;
      f32x4 gv[4];
#pragma unroll
      for (int j = 0; j < 4; ++j) gv[j] = gr[64 * j];
      unsigned* rctr = (unsigned*)(ws + WS_CTL) + 4;
      constexpr int RCH = 16;
      for (;;) {
          unsigned cidx = 0; if (lane == 0) cidx = atomicAdd(rctr, 1u);
          cidx = (unsigned)__builtin_amdgcn_readfirstlane((int)cidx);
          if (cidx >= (unsigned)(TTOK / RCH)) break;
          int row = (int)cidx * RCH; const int rend = row + RCH;
          f32x4 nx[4];
          { const f32x4* xr = (const f32x4*)xrow_ptr(a.in[0], a.in[1], row) + lane;
#pragma unroll
            for (int j = 0; j < 4; ++j) nx[j] = __builtin_nontemporal_load(xr + 64 * j); }
          for (; row < rend; ++row) {
              f32x4 v[4];
#pragma unroll
              for (int j = 0; j < 4; ++j) v[j] = nx[j];
              if (row + 1 < rend) { const f32x4* xn = (const f32x4*)xrow_ptr(a.in[0], a.in[1], row + 1) + lane;
#pragma unroll
                  for (int j = 0; j < 4; ++j) nx[j] = __builtin_nontemporal_load(xn + 64 * j); }
              float s = 0.f;
#pragma unroll
              for (int j = 0; j < 4; ++j) s += (v[j].x * v[j].x + v[j].y * v[j].y) + (v[j].z * v[j].z + v[j].w * v[j].w);
              const float rstd = 1.0f / sqrtf(wave_sum(s) * (1.f / DM) + EPSN);
              u32x2* o8 = (u32x2*)(hn + (size_t)row * DM) + lane;
#pragma unroll
              for (int j = 0; j < 4; ++j) { u32x2 w; w.x = cvt_pk_bf16(v[j].x * rstd * gv[j].x, v[j].y * rstd * gv[j].y); w.y = cvt_pk_bf16(v[j].z * rstd * gv[j].z, v[j].w * rstd * gv[j].w); o8[64 * j] = w; }
          }
      } }
}

__device__ __forceinline__ float quad_max(float x) {
    const auto r = __builtin_amdgcn_permlane32_swap(__float_as_uint(x), __float_as_uint(x), false, false);
    x = fmaxf(__uint_as_float(r[0]), __uint_as_float(r[1]));
    const auto q = __builtin_amdgcn_permlane16_swap(__float_as_uint(x), __float_as_uint(x), false, false);
    return fmaxf(__uint_as_float(q[0]), __uint_as_float(q[1]));
}
__device__ __forceinline__ float quad_sum(float x) {
    const auto r = __builtin_amdgcn_permlane32_swap(__float_as_uint(x), __float_as_uint(x), false, false);
    x = __uint_as_float(r[0]) + __uint_as_float(r[1]);
    const auto q = __builtin_amdgcn_permlane16_swap(__float_as_uint(x), __float_as_uint(x), false, false);
    return __uint_as_float(q[0]) + __uint_as_float(q[1]);
}
struct KVBuf { bf16x8 kA0, kA1, kB0, kB1; bf16x4 vA[4], vB[4]; };
__device__ __forceinline__ void step_params(int s, int& gi, int& ls) { gi = s < 12 ? 0 : (s < 18 ? 1 : 2); ls = s < 12 ? s : (s < 18 ? s - 12 : s - 18); }
__device__ __forceinline__ void attn_load(KVBuf& b, const bf16_t* Kp, const bf16_t* Vt, int s, int sq, int h, int blk, int r, int lane) {
    int gi, ls; step_params(s, gi, ls);
    const int sh = 2 * gi, Lg = SEQL >> sh, rho = r & ((1 << sh) - 1);
    int uA = ((256 * blk) >> sh) - 64 + 32 * ls, uB = uA + 16;
    if (uA < 0 || uA >= Lg) uA = 0; if (uB < 0 || uB >= Lg) uB = 0;
    const int kl = lane & 15, quad = lane >> 4;
    const bf16_t* kh = Kp + (size_t)(sq * 24 + gi * 8 + h) * SEQL * 64 + quad * 128 + kl * 8;
    const bf16_t* ka = kh + (size_t)((rho * Lg + uA) >> 4) * 1024; const bf16_t* kb = kh + (size_t)((rho * Lg + uB) >> 4) * 1024;
    b.kA0 = *(const bf16x8*)ka; b.kA1 = *(const bf16x8*)(ka + 512); b.kB0 = *(const bf16x8*)kb; b.kB1 = *(const bf16x8*)(kb + 512);
    const bf16_t* vbase = Vt + (size_t)(((sq * 3 + gi) * 8 + h) * 512) * 1024 + quad * 64 + kl * 4;
    const bf16_t* va = vbase + (size_t)((rho * Lg + uA) >> 4) * 1024; const bf16_t* vb = vbase + (size_t)((rho * Lg + uB) >> 4) * 1024;
#pragma unroll
    for (int dt = 0; dt < 4; ++dt) { b.vA[dt] = *(const bf16x4*)(va + dt * 256); b.vB[dt] = *(const bf16x4*)(vb + dt * 256); }
}
struct QF { bf16x8 a0, a1, b0, b1, c0, c1; };
template <int gi>
__device__ __forceinline__ void attn_compute(const KVBuf& b, const bf16x8 q0, const bf16x8 q1, f32x4 (&o)[4], float& mrun, float& lrun, int s, int blk, int r, int lane) {
    const int ls = gi == 0 ? s : (gi == 1 ? s - 12 : s - 18);
    const int sh = 2 * gi, Lg = SEQL >> sh;
    const int uA = ((256 * blk) >> sh) - 64 + 32 * ls;
    const int qi = lane & 15, quad = lane >> 4;
    const int uq = (256 * blk + r + 16 * qi) >> sh;
    const int lo = max(0, uq - 64), hi = min(Lg - 1, uq + 64);
    f32x4 sA = (f32x4){0.f, 0.f, 0.f, 0.f}, sB = sA;
    sA = __builtin_amdgcn_mfma_f32_16x16x32_bf16(b.kA0, q0, sA, 0, 0, 0); sA = __builtin_amdgcn_mfma_f32_16x16x32_bf16(b.kA1, q1, sA, 0, 0, 0);
    sB = __builtin_amdgcn_mfma_f32_16x16x32_bf16(b.kB0, q0, sB, 0, 0, 0); sB = __builtin_amdgcn_mfma_f32_16x16x32_bf16(b.kB1, q1, sB, 0, 0, 0);
    const float NEGINF = -__builtin_inff();
    const unsigned span = (unsigned)(hi - lo);
    float mx = NEGINF;
#pragma unroll
    for (int j = 0; j < 4; ++j) {
        const int ua = uA + quad * 4 + j, ub = ua + 16;
        sA[j] = ((unsigned)(ua - lo) <= span) ? sA[j] : NEGINF; sB[j] = ((unsigned)(ub - lo) <= span) ? sB[j] : NEGINF;
        mx = fmaxf(mx, fmaxf(sA[j], sB[j]));
    }
    mx = quad_max(mx);
    const float mnew = fmaxf(mrun, mx), alpha = __builtin_amdgcn_exp2f(mrun - mnew);
    mrun = mnew;
    float ps = 0.f;
#pragma unroll
    for (int j = 0; j < 4; ++j) { sA[j] = __builtin_amdgcn_exp2f(sA[j] - mnew); sB[j] = __builtin_amdgcn_exp2f(sB[j] - mnew); ps += sA[j] + sB[j]; }
    lrun = lrun * alpha + ps;
    u32x4 pw; pw.x = cvt_pk_bf16(sA[0], sA[1]); pw.y = cvt_pk_bf16(sA[2], sA[3]); pw.z = cvt_pk_bf16(sB[0], sB[1]); pw.w = cvt_pk_bf16(sB[2], sB[3]);
    const bf16x8 pf = __builtin_bit_cast(bf16x8, pw);
#pragma unroll
    for (int dt = 0; dt < 4; ++dt) {
        o[dt] *= alpha;
        bf16x8 vf; vf[0] = b.vA[dt][0]; vf[1] = b.vA[dt][1]; vf[2] = b.vA[dt][2]; vf[3] = b.vA[dt][3]; vf[4] = b.vB[dt][0]; vf[5] = b.vB[dt][1]; vf[6] = b.vB[dt][2]; vf[7] = b.vB[dt][3];
#ifdef DBG_ATT2
        for (int e = 0; e < 8; ++e) o[dt][e & 3] += 1e-3f * __uint_as_float(((unsigned)(unsigned short)vf[e]) << 16);
#else
        o[dt] = __builtin_amdgcn_mfma_f32_16x16x32_bf16(vf, pf, o[dt], 0, 0, 0);
#endif
    }
}
template <int gi>
__device__ __forceinline__ void attn_compute2(const KVBuf& b, const KVBuf& c, const bf16x8 q0, const bf16x8 q1, f32x4 (&o)[4], float& mrun, float& lrun, int s, int blk, int r, int lane) {
    const int ls = gi == 0 ? s : (gi == 1 ? s - 12 : s - 18);
    const int sh = 2 * gi, Lg = SEQL >> sh;
    const int uA = ((256 * blk) >> sh) - 64 + 32 * ls;
    const int qi = lane & 15, quad = lane >> 4;
    const int uq = (256 * blk + r + 16 * qi) >> sh;
    const int lo = max(0, uq - 64), hi = min(Lg - 1, uq + 64);
    const f32x4 z4 = (f32x4){0.f, 0.f, 0.f, 0.f};
    f32x4 sA = __builtin_amdgcn_mfma_f32_16x16x32_bf16(b.kA0, q0, z4, 0, 0, 0), sB = __builtin_amdgcn_mfma_f32_16x16x32_bf16(b.kB0, q0, z4, 0, 0, 0);
    f32x4 sC = __builtin_amdgcn_mfma_f32_16x16x32_bf16(c.kA0, q0, z4, 0, 0, 0), sD = __builtin_amdgcn_mfma_f32_16x16x32_bf16(c.kB0, q0, z4, 0, 0, 0);
    sA = __builtin_amdgcn_mfma_f32_16x16x32_bf16(b.kA1, q1, sA, 0, 0, 0); sB = __builtin_amdgcn_mfma_f32_16x16x32_bf16(b.kB1, q1, sB, 0, 0, 0);
    sC = __builtin_amdgcn_mfma_f32_16x16x32_bf16(c.kA1, q1, sC, 0, 0, 0); sD = __builtin_amdgcn_mfma_f32_16x16x32_bf16(c.kB1, q1, sD, 0, 0, 0);
    const float NEGINF = -__builtin_inff();
    const unsigned span = (unsigned)(hi - lo);
    float mx = NEGINF;
#pragma unroll
    for (int j = 0; j < 4; ++j) {
        const int ua = uA + quad * 4 + j;
        sA[j] = ((unsigned)(ua - lo) <= span) ? sA[j] : NEGINF; sB[j] = ((unsigned)(ua + 16 - lo) <= span) ? sB[j] : NEGINF;
        sC[j] = ((unsigned)(ua + 32 - lo) <= span) ? sC[j] : NEGINF; sD[j] = ((unsigned)(ua + 48 - lo) <= span) ? sD[j] : NEGINF;
        mx = fmaxf(fmaxf(mx, fmaxf(sA[j], sB[j])), fmaxf(sC[j], sD[j]));
    }
    mx = quad_max(mx);
    const float mnew = fmaxf(mrun, mx), alpha = __builtin_amdgcn_exp2f(mrun - mnew);
    mrun = mnew;
    float ps = 0.f;
#pragma unroll
    for (int j = 0; j < 4; ++j) { sA[j] = __builtin_amdgcn_exp2f(sA[j] - mnew); sB[j] = __builtin_amdgcn_exp2f(sB[j] - mnew); sC[j] = __builtin_amdgcn_exp2f(sC[j] - mnew); sD[j] = __builtin_amdgcn_exp2f(sD[j] - mnew); ps += (sA[j] + sB[j]) + (sC[j] + sD[j]); }
    lrun = lrun * alpha + ps;
    u32x4 pw, pv; pw.x = cvt_pk_bf16(sA[0], sA[1]); pw.y = cvt_pk_bf16(sA[2], sA[3]); pw.z = cvt_pk_bf16(sB[0], sB[1]); pw.w = cvt_pk_bf16(sB[2], sB[3]);
    pv.x = cvt_pk_bf16(sC[0], sC[1]); pv.y = cvt_pk_bf16(sC[2], sC[3]); pv.z = cvt_pk_bf16(sD[0], sD[1]); pv.w = cvt_pk_bf16(sD[2], sD[3]);
    const bf16x8 pf = __builtin_bit_cast(bf16x8, pw), pg = __builtin_bit_cast(bf16x8, pv);
#pragma unroll
    for (int dt = 0; dt < 4; ++dt) {
        o[dt] *= alpha;
        bf16x8 vf, vg;
        vf[0] = b.vA[dt][0]; vf[1] = b.vA[dt][1]; vf[2] = b.vA[dt][2]; vf[3] = b.vA[dt][3]; vf[4] = b.vB[dt][0]; vf[5] = b.vB[dt][1]; vf[6] = b.vB[dt][2]; vf[7] = b.vB[dt][3];
        vg[0] = c.vA[dt][0]; vg[1] = c.vA[dt][1]; vg[2] = c.vA[dt][2]; vg[3] = c.vA[dt][3]; vg[4] = c.vB[dt][0]; vg[5] = c.vB[dt][1]; vg[6] = c.vB[dt][2]; vg[7] = c.vB[dt][3];
        o[dt] = __builtin_amdgcn_mfma_f32_16x16x32_bf16(vf, pf, o[dt], 0, 0, 0);
        o[dt] = __builtin_amdgcn_mfma_f32_16x16x32_bf16(vg, pg, o[dt], 0, 0, 0);
    }
}
__device__ __forceinline__ void step_attention(const Args& a, LAS unsigned char* lds, int pass, int tid, int bx) {
    unsigned char* ws = a.ws;
    const int lane = tid & 63;
    const bf16_t* Qp = (const bf16_t*)(ws + WS_Q); const bf16_t* Kp = (const bf16_t*)(ws + WS_K); const bf16_t* Vt = (const bf16_t*)(ws + WS_VT);
    const bf16_t* ZA = (const bf16_t*)(ws + WS_ZA); bf16_t* GAO = (bf16_t*)(ws + WS_GAO);
    const int xcd = bx & 7;
    unsigned* ctr = (unsigned*)(ws + WS_CTL) + 16 + pass * 8 + xcd;
    LAS unsigned* slot = (LAS unsigned*)(lds + 3 * 16384);
    constexpr int NGRP = 3 * 32 * 2;
    for (;;) {
        __syncthreads();
        if (tid == 0) slot[0] = atomicAdd(ctr, 1u);
        __syncthreads();
        const unsigned grp = (unsigned)__builtin_amdgcn_readfirstlane((int)slot[0]);
        if (grp >= (unsigned)NGRP) break;
        const int wv_ = tid >> 6; const int r = ((wv_ & 3) << 2) + (wv_ >> 2) + 2 * (int)(grp & 1)  , blk = (grp >> 1) & 31, pair = xcd * 3 + (int)(grp >> 6);
        const int h = pair & 7, sq = pair >> 3;
        const int qi = lane & 15, quad = lane >> 4;
        const int tq = sq * SEQL + 256 * blk + r + 16 * qi;
        QF qf;
        { const int pos = 256 * blk + r + 16 * qi;
          const bf16_t* qa = Qp + ((size_t)(sq * 24 + h) * SEQL + pos) * 64 + quad * 8;
          const bf16_t* qb = Qp + ((size_t)(sq * 24 + 8 + h) * SEQL + (pos & 3) * 2048 + (pos >> 2)) * 64 + quad * 8;
          const bf16_t* qc = Qp + ((size_t)(sq * 24 + 16 + h) * SEQL + (pos & 15) * 512 + (pos >> 4)) * 64 + quad * 8;
          qf.a0 = *(const bf16x8*)qa; qf.a1 = *(const bf16x8*)(qa + 32); qf.b0 = *(const bf16x8*)qb; qf.b1 = *(const bf16x8*)(qb + 32); qf.c0 = *(const bf16x8*)qc; qf.c1 = *(const bf16x8*)(qc + 32); }
        f32x4 o[4];
#pragma unroll
        for (int dt = 0; dt < 4; ++dt) o[dt] = (f32x4){0.f, 0.f, 0.f, 0.f};
        float mrun = -1e30f, lrun = 0.f;
        KVBuf b0, b1;
#define ATT_SB __builtin_amdgcn_sched_barrier(0);
        {
            const int wv = tid >> 6, region = wv >> 1;
            const bf16_t* gsrc = (region < 2 ? Kp + (size_t)(sq * 24 + h) * SEQL * 64 : Vt + (size_t)((sq * 3) * 8 + h) * 512 * 1024) + (wv & 1) * 512 + lane * 8;
            const int ubase = 256 * blk - 64 + (region & 1) * 16;
#define ATT_DMA(S) do { int uT = ubase + 32 * (S); if (uT < 0 || uT >= SEQL) uT = 0; \
                __builtin_amdgcn_global_load_lds((const unsigned*)(gsrc + (size_t)(uT >> 4) * 1024), (LAS unsigned*)(lds + (((S) >> 1) % 3) * 16384 + ((S) & 1) * 8192 + wv * 1024), 16, 0, 0); } while (0)
            ATT_DMA(0); ATT_DMA(1); ATT_DMA(2); ATT_DMA(3);
            const int kl = lane & 15;
            const unsigned foff = (unsigned)(quad * 256 + kl * 16), voff = (unsigned)(4096 + quad * 128 + kl * 8);
#pragma unroll 1
            for (int d = 0; d < 6; ++d) {
                if (d < 5) asm volatile("s_waitcnt vmcnt(2)" ::: "memory"); else asm volatile("s_waitcnt vmcnt(0)" ::: "memory");
                __syncthreads();
                if (d + 2 < 6) { ATT_DMA(2 * d + 4); ATT_DMA(2 * d + 5); }
                LAS unsigned char* kb = lds + (d % 3) * 16384;
                b0.kA0 = *(const LAS bf16x8*)(kb + foff); b0.kA1 = *(const LAS bf16x8*)(kb + foff + 1024); b0.kB0 = *(const LAS bf16x8*)(kb + 2048 + foff); b0.kB1 = *(const LAS bf16x8*)(kb + 2048 + foff + 1024);
                b1.kA0 = *(const LAS bf16x8*)(kb + 8192 + foff); b1.kA1 = *(const LAS bf16x8*)(kb + 8192 + foff + 1024); b1.kB0 = *(const LAS bf16x8*)(kb + 8192 + 2048 + foff); b1.kB1 = *(const LAS bf16x8*)(kb + 8192 + 2048 + foff + 1024);
#pragma unroll
                for (int dt = 0; dt < 4; ++dt) { b0.vA[dt] = *(const LAS bf16x4*)(kb + voff + dt * 512); b0.vB[dt] = *(const LAS bf16x4*)(kb + 2048 + voff + dt * 512);
                                                 b1.vA[dt] = *(const LAS bf16x4*)(kb + 8192 + voff + dt * 512); b1.vB[dt] = *(const LAS bf16x4*)(kb + 8192 + 2048 + voff + dt * 512); }
                attn_compute2<0>(b0, b1, qf.a0, qf.a1, o, mrun, lrun, 2 * d, blk, r, lane);
            }
#undef ATT_DMA
        }
        attn_load(b0, Kp, Vt, 12, sq, h, blk, r, lane);
#define ATT_LOOP(GI, S0, S1, QA, QB) _Pragma("unroll 1") for (int s = S0; s < S1; s += 2) { \
            ATT_SB attn_load(b1, Kp, Vt, s + 1, sq, h, blk, r, lane); ATT_SB attn_compute<GI>(b0, QA, QB, o, mrun, lrun, s, blk, r, lane); \
            ATT_SB attn_load(b0, Kp, Vt, s + 2, sq, h, blk, r, lane); ATT_SB attn_compute<GI>(b1, QA, QB, o, mrun, lrun, s + 1, blk, r, lane); ATT_SB }
        ATT_LOOP(1, 12, 18, qf.b0, qf.b1)
        ATT_LOOP(2, 18, 22, qf.c0, qf.c1)
#undef ATT_LOOP
        attn_compute<2>(b0, qf.c0, qf.c1, o, mrun, lrun, 22, blk, r, lane);
        const float l = quad_sum(lrun);
        float inv = 1.0f / l;
#ifdef DBG_ATT1
        for (int dt = 0; dt < 4; ++dt) o[dt] = (f32x4){1.f, 1.f, 1.f, 1.f};
#endif
#pragma unroll
        for (int dt = 0; dt < 4; ++dt) {
            const size_t off = (size_t)tq * 512 + h * 64 + 16 * dt + 4 * quad;
            const u32x2 z = *(const u32x2*)(ZA + off);
            u32x2 w; w.x = cvt_pk_bf16(o[dt][0] * inv * bf_lo(z.x), o[dt][1] * inv * bf_hi(z.x)); w.y = cvt_pk_bf16(o[dt][2] * inv * bf_lo(z.y), o[dt][3] * inv * bf_hi(z.y));
            *(u32x2*)(GAO + off) = w;
        }
    }
}

__device__ __forceinline__ f32x2 cmul(f32x2 a, f32x2 b) { return (f32x2){a.x * b.x - a.y * b.y, a.x * b.y + a.y * b.x}; }
__device__ __forceinline__ void step_scan(const Args& a, LAS unsigned char* lds, int tid, int it0, int it1, int itstep) {
    unsigned char* ws = a.ws; const int G = gridDim.x;
    const float* PW = (const float*)(ws + WS_PW); const float* S = (const float*)(ws + WS_S); bf16_t* UH = (bf16_t*)(ws + WS_UH);
    LAS f32x2* carry = (LAS f32x2*)lds;
    for (int it = it0; it < it1; it += itstep) {
        const int dir = it & 1, g = (it >> 1) & 31, sq = it >> 6; const int seg = tid >> 6, n = tid & 63;
        const f32x2 P = (f32x2){PW[((dir * 32 + g) * 64 + n) * 2], PW[((dir * 32 + g) * 64 + n) * 2 + 1]};
        f32x2 z[32];
        { const int c0 = dir ? (NCH - 1 - seg * 32) : seg * 32; const long stp = dir ? -256 : 256;
          const float* sp = S + ((size_t)g * CHP + sq * NCH + c0) * 256 + dir * 128 + n;
#pragma unroll
          for (int i = 0; i < 32; ++i) { z[i] = (f32x2){sp[0], sp[64]}; sp += stp; } }
        f32x2 zz = (f32x2){0.f, 0.f};
#pragma unroll
        for (int i = 0; i < 32; ++i) { const f32x2 t = z[i]; z[i] = zz; zz = cmul(P, zz) + t; }
        __syncthreads();
        carry[seg * 64 + n] = zz;
        __syncthreads();
        f32x2 P32 = P;
#pragma unroll
        for (int k = 0; k < 5; ++k) P32 = cmul(P32, P32);
        f32x2 x = (f32x2){0.f, 0.f};
        for (int sp = 0; sp < seg; ++sp) x = cmul(P32, x) + carry[sp * 64 + n];
        f32x2 pwr = (f32x2){1.f, 0.f};
        { const int c0 = dir ? (NCH - 1 - seg * 32) : seg * 32; const long stp = dir ? -(long)UHK : (long)UHK;
          bf16_t* up = UH + ((size_t)g * CHP + sq * NCH + c0) * UHK + 512 + dir * 128 + n;
#pragma unroll
          for (int i = 0; i < 32; ++i) {
              const f32x2 hin = z[i] + cmul(pwr, x);
              up[0] = (bf16_t)(cvt_pk_bf16(hin.x, 0.f) & 0xffffu); up[64] = (bf16_t)(cvt_pk_bf16(hin.y, 0.f) & 0xffffu);
              pwr = cmul(pwr, P); up += stp;
          } }
    }
}

__device__ __forceinline__ void step_final_norm(const Args& a, int pass, int tid, int bx) {
    const int lane = tid & 63, wave = tid >> 6, G = gridDim.x;
    const f32x4* gr = (const f32x4*)a.in[16] + lane;
    f32x4 gv[4];
#pragma unroll
    for (int j = 0; j < 4; ++j) gv[j] = gr[64 * j];
    const bf16_t* accp = (const bf16_t*)(a.ws + WS_ACC);
    int row = bx * 8 + wave;
    f32x4 nx[4]; u32x2 na[4];
    if (row < TP) { const f32x4* xr = (const f32x4*)xrow_ptr(a.in[0], a.in[1], pass * TP + row) + lane; const u32x2* ar = (const u32x2*)(accp + (size_t)row * DM) + lane;
#pragma unroll
        for (int j = 0; j < 4; ++j) { nx[j] = __builtin_nontemporal_load(xr + 64 * j); na[j] = ar[64 * j]; } }
    for (; row < TP; row += G * 8) {
        f32x4 v[4];
#pragma unroll
        for (int j = 0; j < 4; ++j) v[j] = nx[j] + (f32x4){bf_lo(na[j].x), bf_hi(na[j].x), bf_lo(na[j].y), bf_hi(na[j].y)};
        const int nrow = row + G * 8;
        if (nrow < TP) { const f32x4* xn = (const f32x4*)xrow_ptr(a.in[0], a.in[1], pass * TP + nrow) + lane; const u32x2* an = (const u32x2*)(accp + (size_t)nrow * DM) + lane;
#pragma unroll
            for (int j = 0; j < 4; ++j) { nx[j] = __builtin_nontemporal_load(xn + 64 * j); na[j] = an[64 * j]; } }
        float s = 0.f;
#pragma unroll
        for (int j = 0; j < 4; ++j) s += (v[j].x * v[j].x + v[j].y * v[j].y) + (v[j].z * v[j].z + v[j].w * v[j].w);
        const float rstd = 1.0f / sqrtf(wave_sum(s) * (1.f / DM) + EPSN);
        f32x4* xr = (f32x4*)(a.out + (size_t)(pass * TP + row) * DM) + lane;
#pragma unroll
        for (int j = 0; j < 4; ++j) __builtin_nontemporal_store(v[j] * rstd * gv[j], xr + 64 * j);
    }
}


#define XB_TMO      128
#define XB_XCNT(j)  (256  + 64 * (j))
#define XB_XSUB(j)  (1280 + 64 * (j))
#define XB_XGEN(j)  (2304 + 64 * (j))
#define XB_TOP      3328
#define XB_TOPGEN   3392
#define XCD_BAR_WORDS 3456
#define XB_SLOT(b)  (4096 + 2 * (b))
#define XB_SPIN_CAP (1u << 18)
__device__ __forceinline__ unsigned xb_ld(unsigned* p)              { return __hip_atomic_load(p, __ATOMIC_RELAXED, __HIP_MEMORY_SCOPE_AGENT); }
__device__ __forceinline__ unsigned xb_add(unsigned* p, unsigned v) { return __hip_atomic_fetch_add(p, v, __ATOMIC_RELAXED, __HIP_MEMORY_SCOPE_AGENT); }
__device__ __forceinline__ unsigned xb_xcc_id() { return (unsigned)__builtin_amdgcn_s_getreg((3 << 11) | 20) & 0xFu; }
#define XB_SPIN(cond, bar) do { unsigned _sp = 0; while (cond) { __builtin_amdgcn_s_sleep(1); \
    if ((++_sp & 255u) == 0u) { if (xb_ld(&(bar)[XB_TMO])) break; if (_sp > XB_SPIN_CAP) { atomicAdd(&(bar)[XB_TMO], 1u); break; } } } } while (0)
__device__ __forceinline__ void xcd_barrier_complete(unsigned* bar, unsigned x, unsigned& nloc, unsigned& nx) {
    const unsigned G = gridDim.x;
    unsigned sum, cnt, mine, sp = 0u;
    for (;;) {
        sum = 0u; cnt = 0u; mine = 0u;
#pragma unroll
        for (unsigned j = 0; j < 16; ++j) { const unsigned c = xb_ld(&bar[XB_XCNT(j)]); sum += c; cnt += (c > 0u) ? 1u : 0u; mine = (j == x) ? c : mine; }
        if (sum == G) break;
        __builtin_amdgcn_s_sleep(1);
        if ((++sp & 255u) == 0u) { if (xb_ld(&bar[XB_TMO])) break; if (sp > XB_SPIN_CAP) { atomicAdd(&bar[XB_TMO], 1u); break; } }
    }
    nloc = mine > 0u ? mine : 1u; nx = cnt > 0u ? cnt : 1u;
}
__device__ __forceinline__ void xcd_barrier(unsigned* bar) {
    asm volatile("s_waitcnt vmcnt(0)" ::: "memory");
    __syncthreads();
    if (threadIdx.x == 0) {
        __builtin_amdgcn_s_waitcnt(0);
        const unsigned x = xb_xcc_id();
        unsigned* slot = bar + XB_SLOT(blockIdx.x);
        unsigned nloc = xb_ld(slot), nx = xb_ld(slot + 1);
        if (nloc == 0u) { xcd_barrier_complete(bar, x, nloc, nx); __hip_atomic_store(slot, nloc, __ATOMIC_RELAXED, __HIP_MEMORY_SCOPE_AGENT); __hip_atomic_store(slot + 1, nx, __ATOMIC_RELAXED, __HIP_MEMORY_SCOPE_AGENT); }
        const unsigned old = xb_add(&bar[XB_XSUB(x)], 1u);
        const unsigned gen = old / nloc;
        if (old + 1u == (gen + 1u) * nloc) {
            __builtin_amdgcn_fence(__ATOMIC_RELEASE, "agent");
            asm volatile("s_waitcnt vmcnt(0)" ::: "memory");
            const unsigned og = xb_add(&bar[XB_TOP], 1u);
            const unsigned tg = og / nx;
            if (og + 1u == (tg + 1u) * nx) xb_add(&bar[XB_TOPGEN], 1u);
            else XB_SPIN(xb_ld(&bar[XB_TOPGEN]) == tg, bar);
            __builtin_amdgcn_fence(__ATOMIC_ACQUIRE, "agent");
            xb_add(&bar[XB_XGEN(x)], 1u);
            asm volatile("s_waitcnt vmcnt(0)" ::: "memory");
        } else {
            XB_SPIN(xb_ld(&bar[XB_XGEN(x)]) == gen, bar);
            __builtin_amdgcn_fence(__ATOMIC_ACQUIRE, "agent");
            asm volatile("s_waitcnt vmcnt(0)" ::: "memory");
        }
    }
    __syncthreads();
}

constexpr int NSTEPS = 1 + 10 * NPASS;
__host__ __device__ __forceinline__ bool sync_after(int st) { if (st == 0) return true; const int k = (st - 1) % 10; return !(k == 1 || k == 6 || k == 9); }

__global__ void __launch_bounds__(512, 2) fwd_kernel(Args a) {
    extern __shared__ __attribute__((aligned(16))) unsigned char lds_raw[];
    LAS unsigned char* lds = (LAS unsigned char*)lds_raw;
    cg::grid_group grid = cg::this_grid();
    const int G = gridDim.x;
    unsigned char* ws = a.ws;
    unsigned* bar = (unsigned*)(ws + WS_BAR);
    if (a.do_sync == 2) grid.sync();
    if (a.do_sync && threadIdx.x == 0) (void)xb_add(&bar[XB_XCNT(xb_xcc_id())], 1u);
    for (int st = a.st_lo; st < a.st_hi; ++st) {
        int tid = threadIdx.x, bx = blockIdx.x;
        asm volatile("" : "+v"(tid), "+s"(bx));
#ifndef NO_SETUP
        if (st == 0) { step_setup(a, lds, tid, bx); }
#else
        if (st == 0) {}
#endif
        else {
            const int pass = (st - 1) / 10, k = (st - 1) % 10;
            GemmD g; g.lgnN = 0; g.pass = pass; g.nb = 1; g.sA = 0; g.sB = 0;
            bool has_gemm = true;
            const bool fz = (G == 256);
            const bool split_ay = false;
            const bf16_t* sgp = (const bf16_t*)((unsigned char*)a.out + OUT_HN_OFF) + (size_t)pass * TP * DM;
#define DESC_Y { g.A = (const bf16_t*)(ws + WS_UH); g.lda = UHK; g.sA = (unsigned)(CHP * UHK * 2); g.Bt = (const bf16_t*)(ws + WS_MTC); g.ldb = UHK; g.sB = (unsigned)(512 * UHK * 2); g.K = UHK; g.nM = CHP / BM; g.nN = 2; g.nb = 32; g.mode = MODE_Y; }
#define DESC_A { g.A = (const bf16_t*)(ws + WS_GAO); g.lda = 512; g.Bt = (const bf16_t*)(ws + WS_WA); g.ldb = 512; g.K = 512; g.nM = TP / BM; g.nN = 4; g.lgnN = 2; g.mode = MODE_A; }
#define DESC_GLU { g.A = sgp; g.lda = 512; g.Bt = (const bf16_t*)(ws + WS_WGLU); g.ldb = 512; g.K = 512; g.nM = TP / BM; g.nN = 2; g.lgnN = 1; g.mode = MODE_GLU; }
#define DESC_NONE { has_gemm = false; g.A = nullptr; g.Bt = nullptr; g.lda = g.ldb = g.K = 0; g.nM = g.nN = 0; g.mode = 0; }
            switch (k) {
            case 0: g.A = (const bf16_t*)((unsigned char*)a.out + OUT_HN_OFF) + (size_t)pass * TP * DM; g.lda = DM; g.Bt = (const bf16_t*)(ws + WS_WIN); g.ldb = DM; g.K = DM; g.nM = TP / BM; g.nN = INC / BM; g.lgnN = 5; g.mode = MODE_PROJ; break;
            case 1: g.A = (const bf16_t*)(ws + WS_UH); g.lda = UHK; g.sA = (unsigned)(CHP * UHK * 2); g.Bt = (const bf16_t*)(ws + WS_BST); g.ldb = 512; g.sB = (unsigned)(256 * 512 * 2); g.K = 512; g.nM = CHP / BM; g.nN = 1; g.nb = 32; g.mode = MODE_S; break;
            case 2: if (fz) DESC_Y else DESC_NONE break;
            case 4: if (fz) { if (bx < 128) DESC_A else DESC_GLU } else DESC_Y break;
            case 5: if (fz) DESC_NONE else DESC_GLU break;
            case 6: if (fz) DESC_NONE else DESC_A break;
            case 7: g.A = (const bf16_t*)(ws + WS_SB); g.lda = 512; g.Bt = (const bf16_t*)(ws + WS_WB); g.ldb = 512; g.K = 512; g.nM = TP / BM; g.nN = 4; g.lgnN = 2; g.mode = MODE_B; break;
            case 8: g.A = (const bf16_t*)(ws + WS_M1); g.lda = 1024; g.Bt = (const bf16_t*)(ws + WS_WOUT); g.ldb = 1024; g.K = 1024; g.nM = TP / BM; g.nN = 4; g.lgnN = 2; g.mode = MODE_OUT; break;
            default: DESC_NONE break;
            }
#undef DESC_Y
#undef DESC_A
#undef DESC_GLU
#undef DESC_NONE
            { const int total = g.nM * g.nN * g.nb; g.u0 = bx; g.ustride = G; g.ucount = total > bx ? (total - bx + G - 1) / G : 0; }
            if (fz && k == 2) { g.u0 = (bx / SEQP) * 6 + (bx % SEQP); g.ustride = SEQP; g.ucount = bx < SEQP * 32 ? 2 : 0; }
            if (fz && k == 4) { if (bx < 128) { g.u0 = bx; g.ustride = 128; g.ucount = 3; } else { g.u0 = bx - 128; g.ustride = 128; g.ucount = (bx - 128) < 64 ? 2 : 1; } }
            const bool fuse_scan = (G >= SEQP * 32);
            if (has_gemm) {
#ifndef NO_GEMM
                gemm_phase(a, lds, g, G, bx, tid);
#endif
#ifndef NO_SCAN
                if (k == 1 && fuse_scan && bx < SEQP * 32) {
                    asm volatile("s_waitcnt vmcnt(0)" ::: "memory"); __syncthreads();
                    const int it0 = (bx % SEQP) * 64 + (bx / SEQP) * 2;
                    step_scan(a, lds, tid, it0, it0 + 2, 1);
                    asm volatile("s_waitcnt vmcnt(0)" ::: "memory"); __syncthreads();
                }
#endif
            }
#ifndef NO_ATTN
            else if (k == (fz ? 3 : 2)) step_attention(a, lds, pass, tid, bx);
#endif
#ifndef NO_SCAN
            else if (k == 3 && !fz && !fuse_scan) step_scan(a, lds, tid, bx, SEQP * 32 * 2, G);
#endif
            else if (k == 9) step_final_norm(a, pass, tid, bx);
        }
        { bool need = sync_after(st) && !(st > 0 && (st - 1) % 10 == 3 && G >= SEQP * 32);
          if (G == 256 && st > 0) { const int kk = (st - 1) % 10; need = (kk == 0 || kk == 3 || kk == 4 || kk == 7 || kk == 8); }
          if (a.do_sync && st + 1 < a.st_hi && need) xcd_barrier(bar); }
    }
}

extern "C" void kernel_launch(void* const* d_in, const int* in_sizes, int n_in, void* d_out, int out_size, void* d_ws, size_t ws_size, hipStream_t stream) {
    constexpr int LDS_BYTES = STAGE_BYTES + 32768;
    static int grid = 0;
    if (grid == 0) {
        if (n_in != 17 || out_size != TTOK * DM || ws_size < WS_END) { fprintf(stderr, "kernel_launch: unexpected shapes (n_in %d out %d ws %zu need %zu)\n", n_in, out_size, ws_size, (size_t)WS_END); grid = -1; return; }
        int dev = 0, cus = 0, per_cu = 0;
        hipGetDevice(&dev); hipDeviceGetAttribute(&cus, hipDeviceAttributeMultiprocessorCount, dev);
        hipFuncSetAttribute((const void*)fwd_kernel, hipFuncAttributeMaxDynamicSharedMemorySize, LDS_BYTES);
        hipOccupancyMaxActiveBlocksPerMultiprocessor(&per_cu, (const void*)fwd_kernel, 512, LDS_BYTES);
        if (per_cu < 1) per_cu = 1;
        grid = cus * 1;
        (void)hipGetLastError();
    }
    if (grid < 0) return;
    (void)hipMemsetAsync((unsigned char*)d_ws + WS_BAR, 0, WS_BAR_BYTES + 4096, stream);
    Args a{};
    for (int i = 0; i < 17; ++i) a.in[i] = (const float*)d_in[i];
    a.out = (float*)d_out; a.ws = (unsigned char*)d_ws; a.pad = 0;
#ifndef MULTI_LAUNCH
#define MULTI_LAUNCH 0
#endif
#if MULTI_LAUNCH
    a.do_sync = 0;
    for (int st = 0; st < NSTEPS; ++st) {
        a.st_lo = st; a.st_hi = st + 1;
        hipLaunchKernelGGL(fwd_kernel, dim3(grid), dim3(512), LDS_BYTES, stream, a);
    }
#else
    a.do_sync = 1; a.st_lo = 0; a.st_hi = NSTEPS;
    void* args[] = {&a};
    hipError_t e = hipLaunchCooperativeKernel((const void*)fwd_kernel, dim3(grid), dim3(512), args, LDS_BYTES, stream);
    if (e != hipSuccess) fprintf(stderr, "cooperative launch failed: %s (grid %d)\n", hipGetErrorString(e), grid);
#endif
}
```

```cpp
#include <hip/hip_runtime.h>
#include <hip/hip_cooperative_groups.h>
#include <cstdio>

namespace cg = cooperative_groups;

#define LAS __attribute__((address_space(3)))
typedef unsigned short bf16_t;
typedef short bf16x8 __attribute__((ext_vector_type(8)));
typedef short bf16x4 __attribute__((ext_vector_type(4)));
typedef float f32x4 __attribute__((ext_vector_type(4)));
typedef float f32x2 __attribute__((ext_vector_type(2)));
typedef unsigned u32x4 __attribute__((ext_vector_type(4)));
typedef unsigned u32x2 __attribute__((ext_vector_type(2)));

constexpr int DM = 1024, SEQL = 8192, NSEQ = 6, TTOK = NSEQ * SEQL;
constexpr int NPASS = 2, SEQP = 3, TP = SEQP * SEQL;
constexpr int INC = 8192, QKVW = 1536;
constexpr int LC = 32, NCH = SEQL / LC  , CHP = SEQP * NCH  ;
constexpr int UHK = LC * 16 + 256;
constexpr float EPSN = 1e-6f;
constexpr float QSCALE = 0.18033688011112042f;

constexpr size_t AL(size_t x) { return (x + 255) & ~(size_t)255; }
constexpr size_t WS_WIN = 4096;
constexpr size_t WS_WGLU = WS_WIN + (size_t)INC * DM * 2;
constexpr size_t WS_WA = WS_WGLU + (size_t)512 * 512 * 2;
constexpr size_t WS_WB = WS_WA + (size_t)1024 * 512 * 2;
constexpr size_t WS_WOUT = WS_WB + (size_t)1024 * 512 * 2;
constexpr size_t WS_MTC = WS_WOUT + (size_t)1024 * 1024 * 2;
constexpr size_t WS_BST = WS_MTC + (size_t)32 * 512 * UHK * 2;
constexpr size_t WS_ROPE = WS_BST + (size_t)32 * 256 * 512 * 2;
constexpr size_t WS_PW = WS_ROPE + (size_t)2 * SEQL * 32 * 4;
constexpr size_t WS_KT = WS_PW + (size_t)2 * 32 * 64 * 8;
constexpr size_t WS_Q = WS_KT + (size_t)32 * 2 * 32 * 256 * 4;
constexpr size_t WS_K = WS_Q + (size_t)TP * QKVW * 2;
constexpr size_t WS_VT = WS_K + (size_t)TP * QKVW * 2;
constexpr size_t WS_ZA = WS_VT + (size_t)TP * QKVW * 2;
constexpr size_t WS_ZB = WS_ZA + (size_t)TP * 512 * 2;
constexpr size_t WS_GA = WS_ZB + (size_t)TP * 512 * 2;
constexpr size_t WS_GB = WS_GA + (size_t)TP * 1024 * 2;
constexpr size_t WS_UH = WS_GB + (size_t)TP * 1024 * 2;
constexpr size_t WS_S = WS_UH + (size_t)32 * CHP * UHK * 2;
constexpr size_t WS_GAO = WS_S + (size_t)32 * CHP * 256 * 4;
constexpr size_t WS_BAR = WS_GAO + (size_t)TP * 512 * 2;
constexpr size_t WS_BAR_BYTES = 32768;
constexpr size_t WS_CTL = WS_BAR + WS_BAR_BYTES;
constexpr size_t WS_END = WS_CTL + 4096;
constexpr size_t WS_SB = WS_Q + (size_t)TP * 512 * 2;
constexpr size_t WS_M1 = WS_K;
constexpr size_t WS_ACC = WS_Q;
constexpr size_t OUT_HN_OFF = (size_t)SEQP * SEQL * DM * 4;

struct Args {
    const float* in[17];
    float* out;
    unsigned char* ws;
    int st_lo, st_hi;
    int do_sync, pad;
};

typedef __bf16 bf16v2 __attribute__((ext_vector_type(2)));
__device__ __forceinline__ unsigned cvt_pk_bf16(float lo, float hi) { const f32x2 v = (f32x2){lo, hi}; const bf16v2 r = __builtin_convertvector(v, bf16v2); return __builtin_bit_cast(unsigned, r); }
__device__ __forceinline__ float bf_lo(unsigned w) { return __uint_as_float(w << 16); }
__device__ __forceinline__ float bf_hi(unsigned w) { return __uint_as_float(w & 0xffff0000u); }
__device__ __forceinline__ float fast_rcp(float x) { return __builtin_amdgcn_rcpf(x); }
__device__ __forceinline__ float sigmoidf_(float x) { return fast_rcp(1.0f + __builtin_amdgcn_exp2f(-1.4426950408889634f * x)); }
__device__ __forceinline__ float siluf_(float x) { return x * sigmoidf_(x); }
__device__ __forceinline__ float gelu_tanh(float x) { const float u = x * (1.5957691216057308f + 0.07135481627260025f * x * x); return x * sigmoidf_(u); }
__device__ __forceinline__ float wave_sum(float v) {
#pragma unroll
    for (int o = 1; o < 64; o <<= 1) v += __shfl_xor(v, o);
    return v;
}
__device__ __forceinline__ const float* xrow_ptr(const float* xp, const float* xs, int tg) {
    return tg < 4 * SEQL ? xp + (size_t)tg * DM : xs + (size_t)(tg - 4 * SEQL) * DM;
}

constexpr int BM = 256, BK = 64, HALF = 128, HTB = HALF * BK * 2, STAGE_BYTES = 8 * HTB, NXCD = 8, WGM = 8;
__host__ __device__ __forceinline__ int lds_byte(int r, int c) { const int st = (r >> 4) * 2 + (c >> 5), rr = r & 15, cc = c & 31, ob = rr * 64 + cc * 2; return st * 1024 + (ob ^ (((ob >> 9) & 1) << 5)); }
__host__ __device__ __forceinline__ void stage_rc(int b, int& R, int& C) { const int st = b / 1024, sb = b % 1024, swz = sb ^ (((sb >> 9) & 1) << 5); R = (st >> 1) * 16 + swz / 64; C = (st & 1) * 32 + (swz % 64) / 2; }
__host__ __device__ __forceinline__ int perm32(int rho) { const int n = rho >> 4, i = rho & 15; return 8 * (i >> 2) + 4 * n + (i & 3); }

enum { MODE_PROJ = 0, MODE_S = 1, MODE_Y = 2, MODE_GLU = 3, MODE_A = 4, MODE_B = 5, MODE_OUT = 6 };
struct Unit { int pm, pn, bz; };
struct GemmD {
    const bf16_t* A; const bf16_t* Bt;
    int lda, ldb, K, nM, nN, nb;
    unsigned sA, sB;
    int mode, pass, lgnN;
    int u0, ustride, ucount;
};
__device__ __forceinline__ bool unit_next(const GemmD& g, int i, int G, int c, int& pm, int& pn, int& bz) {
    const bool ok = i < g.ucount;
    const int Li = ok ? g.u0 + i * g.ustride : 0;
    if (g.nb == 1) {
        const int lg = g.lgnN, q = (g.nM << lg) >> 3;
        const int wgid = (Li & 7) * q + (Li >> 3);
        const int gid = wgid >> (3 + lg), rem = wgid & ((8 << lg) - 1);
        pm = gid * 8 + (rem & 7); pn = rem >> 3; bz = 0;
    } else {
        const int nwg = g.nM * g.nN;
        const int w = Li % nwg; bz = Li / nwg; pm = w % g.nM; pn = w / g.nM;
    }
    return ok;
}

__device__ __forceinline__ void epilogue(const Args& a, LAS unsigned char* lds, const GemmD& g, const f32x4 (&acc)[2][2][4][2], const Unit& u, int wr, int wc, int fr, int fq) {
    asm volatile("" : "+v"(fr), "+v"(fq));
    unsigned char* ws = a.ws;
    const int rbase = u.pm * BM + wr * 64 + fr;
    const int cl = wc * 32 + fq * 8;
    if (g.mode == MODE_PROJ) {
        const int pn = u.pn;
        if (pn < 12) {
            const bool isq = pn < 6;
            bf16_t* dst = (bf16_t*)(ws + (isq ? WS_Q : WS_K));
            const float* rc = (const float*)(ws + WS_ROPE); const float* rs = rc + SEQL * 32;
            const int a4 = 4 * (4 * (wc & 1) + fq);
            const int pq = isq ? pn : pn - 6, gi = pq >> 1, sh = 2 * gi, dmask = (1 << sh) - 1, Lg = SEQL >> sh;
            const float sc = isq ? QSCALE : 1.0f;
            const int pos0 = rbase & (SEQL - 1);
            const f32x4 cb = *(const f32x4*)(rc + pos0 * 32 + a4), sb = *(const f32x4*)(rs + pos0 * 32 + a4);
            const f32x4 c16 = *(const f32x4*)(rc + 16 * 32 + a4), s16 = *(const f32x4*)(rs + 16 * 32 + a4);
            const f32x4 c128 = *(const f32x4*)(rc + 128 * 32 + a4), s128 = *(const f32x4*)(rs + 128 * 32 + a4);
#pragma unroll
            for (int ai = 0; ai < 2; ++ai) {
                asm volatile("" ::: "memory");
                f32x4 cvv[4], svv[4];
                cvv[0] = ai ? cb * c128 - sb * s128 : cb; svv[0] = ai ? sb * c128 + cb * s128 : sb;
#pragma unroll
                for (int m = 1; m < 4; ++m) { cvv[m] = cvv[m - 1] * c16 - svv[m - 1] * s16; svv[m] = svv[m - 1] * c16 + cvv[m - 1] * s16; }
#pragma unroll
                for (int m = 0; m < 4; ++m) {
                    const int tl = rbase + ai * HALF + m * 16; const int pos = tl & (SEQL - 1), sq = tl >> 13;
                    const int kidx = (pos & dmask) * Lg + (pos >> sh);
                    const f32x4 cv = cvv[m] * sc, sv = svv[m] * sc;
#pragma unroll
                    for (int bj = 0; bj < 2; ++bj) {
                        const f32x4 x1 = acc[ai][bj][m][0], x2 = acc[ai][bj][m][1];
                        const f32x4 o1 = x1 * cv - x2 * sv, o2 = x2 * cv + x1 * sv;
                        const int head = pq * 4 + 2 * bj + (wc >> 1);
                        const int ch = 4 * (wc & 1) + fq;
                        bf16_t* p = dst + (size_t)(sq * 24 + head) * SEQL * 64 + (isq ? (size_t)kidx * 64 + ch * 8 : (size_t)(kidx >> 4) * 1024 + ch * 128 + (kidx & 15) * 8);
                        u32x4 w; w.x = cvt_pk_bf16(o1[0], o1[1]); w.y = cvt_pk_bf16(o1[2], o1[3]); w.z = cvt_pk_bf16(o2[0], o2[1]); w.w = cvt_pk_bf16(o2[2], o2[3]);
                        *(u32x4*)p = w;
                    }
                }
            }
        } else if (pn < 18) {
            bf16_t* dst = (bf16_t*)(ws + WS_VT);
            const int gi = (pn - 12) >> 1, sh = 2 * gi;
            const int wid = wr * 4 + wc, lane = fq * 16 + fr;
            LAS bf16_t* tile = (LAS bf16_t*)(lds + STAGE_BYTES + wid * 4096);
#pragma unroll
            for (int ai = 0; ai < 2; ++ai) {
                const int tl0 = u.pm * BM + wr * 64 + ai * HALF;
                const int pos0 = tl0 & (SEQL - 1), sq = tl0 >> 13;
#pragma unroll
                for (int bj = 0; bj < 2; ++bj) {
                    asm volatile("" ::: "memory");
                    const int h = (4 * (pn - 12) + 2 * bj + (wc >> 1)) & 7;
#pragma unroll
                    for (int m = 0; m < 4; ++m) {
                        const int t = 16 * m + fr;
                        const int slot = gi == 0 ? t : (gi == 1 ? ((t & 3) * 16 + (t >> 2)) : ((t & 15) * 4 + (t >> 4)));
#pragma unroll
                        for (int n = 0; n < 2; ++n)
#pragma unroll
                            for (int j = 0; j < 4; ++j) { const unsigned w = cvt_pk_bf16(acc[ai][bj][m][n][j], 0.f); tile[(8 * fq + 4 * n + j) * 64 + slot] = (bf16_t)(w & 0xffffu); }
                    }
                    bf16_t* hb0 = dst + (size_t)(((sq * 3 + gi) * 8 + h) * 512) * 1024;
#pragma unroll
                    for (int i = 0; i < 4; ++i) {
                        const int c = lane + 64 * i, d = c >> 3, s8 = (c & 7) * 8;
                        const u32x4 v = *(const LAS u32x4*)(tile + d * 64 + s8);
                        const int dg = 32 * (wc & 1) + d; const int doff = (dg >> 4) * 256 + (dg & 15) * 4;
                        if (gi == 0) { const int kidx = pos0 + s8; bf16_t* q = hb0 + (size_t)(kidx >> 4) * 1024 + doff + ((kidx & 15) >> 2) * 64; *(u32x2*)q = (u32x2){v.x, v.y}; *(u32x2*)(q + 64) = (u32x2){v.z, v.w}; }
                        else if (gi == 1) { const int kidx = (s8 >> 4) * 2048 + (pos0 >> 2) + (s8 & 15); bf16_t* q = hb0 + (size_t)(kidx >> 4) * 1024 + doff + ((kidx & 15) >> 2) * 64; *(u32x2*)q = (u32x2){v.x, v.y}; *(u32x2*)(q + 64) = (u32x2){v.z, v.w}; }
                        else { const int ka = (s8 >> 2) * 512 + (pos0 >> 4), kb = ka + 512;
                            *(u32x2*)(hb0 + (size_t)(ka >> 4) * 1024 + doff + ((ka & 15) >> 2) * 64) = (u32x2){v.x, v.y}; *(u32x2*)(hb0 + (size_t)(kb >> 4) * 1024 + doff + ((kb & 15) >> 2) * 64) = (u32x2){v.z, v.w}; }
                    }
                }
            }
        } else if (pn == 20 || pn == 21) {
            bf16_t* dst = (bf16_t*)(ws + WS_UH);
#pragma unroll
            for (int ai = 0; ai < 2; ++ai)
#pragma unroll
                for (int m = 0; m < 4; ++m) { asm volatile("" ::: "memory");
                    const int tl = rbase + ai * HALF + m * 16;
#pragma unroll
                    for (int bj = 0; bj < 2; ++bj) {
                        const int gg = 16 * (pn - 20) + 8 * bj + 2 * wc + (fq >> 1);
                        bf16_t* p = dst + ((size_t)(gg * CHP + (tl >> 5)) * UHK) + (tl & 31) * 16 + 8 * (fq & 1);
                        const f32x4 v0 = acc[ai][bj][m][0], v1 = acc[ai][bj][m][1];
                        u32x4 w; w.x = cvt_pk_bf16(v0[0], v0[1]); w.y = cvt_pk_bf16(v0[2], v0[3]); w.z = cvt_pk_bf16(v1[0], v1[1]); w.w = cvt_pk_bf16(v1[2], v1[3]);
                        *(u32x4*)p = w;
                    }
                }
        } else {
            bf16_t* dst; int ld, c0; bool silu;
            if (pn < 20) { dst = (bf16_t*)(ws + WS_ZA); ld = 512; c0 = (pn - 18) * 256; silu = true; }
            else if (pn < 24) { dst = (bf16_t*)(ws + WS_ZB); ld = 512; c0 = (pn - 22) * 256; silu = true; }
            else if (pn < 28) { dst = (bf16_t*)(ws + WS_GA); ld = 1024; c0 = (pn - 24) * 256; silu = false; }
            else { dst = (bf16_t*)(ws + WS_GB); ld = 1024; c0 = (pn - 28) * 256; silu = false; }
#pragma unroll
            for (int ai = 0; ai < 2; ++ai)
#pragma unroll
                for (int m = 0; m < 4; ++m) { asm volatile("" ::: "memory");
                    const int tl = rbase + ai * HALF + m * 16;
#pragma unroll
                    for (int bj = 0; bj < 2; ++bj) {
                        f32x4 v0 = acc[ai][bj][m][0], v1 = acc[ai][bj][m][1];
#pragma unroll
                        for (int j = 0; j < 4; ++j) { const float s0 = sigmoidf_(v0[j]), s1 = sigmoidf_(v1[j]); v0[j] = silu ? v0[j] * s0 : s0; v1[j] = silu ? v1[j] * s1 : s1; }
                        u32x4 w; w.x = cvt_pk_bf16(v0[0], v0[1]); w.y = cvt_pk_bf16(v0[2], v0[3]); w.z = cvt_pk_bf16(v1[0], v1[1]); w.w = cvt_pk_bf16(v1[2], v1[3]);
                        *(u32x4*)(dst + (size_t)tl * ld + c0 + cl + bj * HALF) = w;
                    }
                }
        }
    } else if (g.mode == MODE_S) {
        float* dst = (float*)(ws + WS_S) + (size_t)u.bz * CHP * 256;
#pragma unroll
        for (int ai = 0; ai < 2; ++ai)
#pragma unroll
            for (int m = 0; m < 4; ++m) { asm volatile("" ::: "memory");
                const int r = rbase + ai * HALF + m * 16;
#pragma unroll
                for (int bj = 0; bj < 2; ++bj) { float* p = dst + (size_t)r * 256 + cl + bj * HALF; *(f32x4*)p = acc[ai][bj][m][0]; *(f32x4*)(p + 4) = acc[ai][bj][m][1]; }
            }
    } else if (g.mode == MODE_Y) {
        bf16_t* dst = (bf16_t*)((unsigned char*)a.out + OUT_HN_OFF) + (size_t)g.pass * TP * DM;
#pragma unroll
        for (int ai = 0; ai < 2; ++ai)
#pragma unroll
            for (int m = 0; m < 4; ++m) { asm volatile("" ::: "memory");
                const int r = rbase + ai * HALF + m * 16;
#pragma unroll
                for (int bj = 0; bj < 2; ++bj) {
                    const int t = 16 * u.pn + 8 * bj + 2 * wc + (fq >> 1);
                    f32x4 v0 = acc[ai][bj][m][0], v1 = acc[ai][bj][m][1];
#pragma unroll
                    for (int j = 0; j < 4; ++j) { v0[j] = gelu_tanh(v0[j]); v1[j] = gelu_tanh(v1[j]); }
                    u32x4 w; w.x = cvt_pk_bf16(v0[0], v0[1]); w.y = cvt_pk_bf16(v0[2], v0[3]); w.z = cvt_pk_bf16(v1[0], v1[1]); w.w = cvt_pk_bf16(v1[2], v1[3]);
                    *(u32x4*)(dst + (size_t)(r * LC + t) * 512 + u.bz * 16 + 8 * (fq & 1)) = w;
                }
            }
    } else if (g.mode == MODE_GLU) {
        const bf16_t* sg = (const bf16_t*)((unsigned char*)a.out + OUT_HN_OFF) + (size_t)g.pass * TP * DM; const bf16_t* zb = (const bf16_t*)(ws + WS_ZB); bf16_t* dst = (bf16_t*)(ws + WS_SB);
        u32x4 sq4[2][2][2], zq4[2][2][2];
#define EPI_LD(ST, BUF) _Pragma("unroll") for (int m2 = 0; m2 < 2; ++m2) _Pragma("unroll") for (int bj = 0; bj < 2; ++bj) { \
            const size_t off = (size_t)(rbase + ((ST) >> 1) * HALF + (2 * ((ST) & 1) + m2) * 16) * 512 + u.pn * BM + cl + bj * HALF; sq4[BUF][m2][bj] = *(const u32x4*)(sg + off); zq4[BUF][m2][bj] = *(const u32x4*)(zb + off); }
        EPI_LD(0, 0)
#pragma unroll
        for (int st = 0; st < 4; ++st) {
            if (st == 0) EPI_LD(1, 1) else if (st == 1) EPI_LD(2, 0) else if (st == 2) EPI_LD(3, 1)
            const int ai = st >> 1, buf = st & 1;
#pragma unroll
            for (int m2 = 0; m2 < 2; ++m2)
#pragma unroll
                for (int bj = 0; bj < 2; ++bj) {
                    const int m = 2 * (st & 1) + m2;
                    const size_t off = (size_t)(rbase + ai * HALF + m * 16) * 512 + u.pn * BM + cl + bj * HALF;
                    const u32x4 s4 = sq4[buf][m2][bj], z4 = zq4[buf][m2][bj];
                    const f32x4 v0 = acc[ai][bj][m][0], v1 = acc[ai][bj][m][1];
                    u32x4 w;
                    w.x = cvt_pk_bf16(bf_lo(s4.x) * sigmoidf_(v0[0]) * bf_lo(z4.x), bf_hi(s4.x) * sigmoidf_(v0[1]) * bf_hi(z4.x));
                    w.y = cvt_pk_bf16(bf_lo(s4.y) * sigmoidf_(v0[2]) * bf_lo(z4.y), bf_hi(s4.y) * sigmoidf_(v0[3]) * bf_hi(z4.y));
                    w.z = cvt_pk_bf16(bf_lo(s4.z) * sigmoidf_(v1[0]) * bf_lo(z4.z), bf_hi(s4.z) * sigmoidf_(v1[1]) * bf_hi(z4.z));
                    w.w = cvt_pk_bf16(bf_lo(s4.w) * sigmoidf_(v1[2]) * bf_lo(z4.w), bf_hi(s4.w) * sigmoidf_(v1[3]) * bf_hi(z4.w));
                    *(u32x4*)(dst + off) = w;
                }
        }
#undef EPI_LD
    } else if (g.mode == MODE_A || g.mode == MODE_B) {
        const bool isb = g.mode == MODE_B;
        const bf16_t* gt = (const bf16_t*)(ws + (isb ? WS_GB : WS_GA)); bf16_t* dst = (bf16_t*)(ws + WS_M1);
        u32x4 gq4[2][2][2], pq4[2][2][2];
#define EPI_LD(ST, BUF) _Pragma("unroll") for (int m2 = 0; m2 < 2; ++m2) _Pragma("unroll") for (int bj = 0; bj < 2; ++bj) { \
            const size_t off = (size_t)(rbase + ((ST) >> 1) * HALF + (2 * ((ST) & 1) + m2) * 16) * 1024 + u.pn * BM + cl + bj * HALF; gq4[BUF][m2][bj] = *(const u32x4*)(gt + off); \
            pq4[BUF][m2][bj] = (u32x4){0u, 0u, 0u, 0u}; if (isb) pq4[BUF][m2][bj] = *(const u32x4*)(dst + off); }
        EPI_LD(0, 0)
#pragma unroll
        for (int st = 0; st < 4; ++st) {
            if (st == 0) EPI_LD(1, 1) else if (st == 1) EPI_LD(2, 0) else if (st == 2) EPI_LD(3, 1)
            const int ai = st >> 1, buf = st & 1;
#pragma unroll
            for (int m2 = 0; m2 < 2; ++m2)
#pragma unroll
                for (int bj = 0; bj < 2; ++bj) {
                    const int m = 2 * (st & 1) + m2;
                    const size_t off = (size_t)(rbase + ai * HALF + m * 16) * 1024 + u.pn * BM + cl + bj * HALF;
                    const u32x4 g4 = gq4[buf][m2][bj], p4 = pq4[buf][m2][bj];
                    const f32x4 v0 = acc[ai][bj][m][0], v1 = acc[ai][bj][m][1];
                    u32x4 w;
                    w.x = cvt_pk_bf16(bf_lo(p4.x) + bf_lo(g4.x) * v0[0], bf_hi(p4.x) + bf_hi(g4.x) * v0[1]);
                    w.y = cvt_pk_bf16(bf_lo(p4.y) + bf_lo(g4.y) * v0[2], bf_hi(p4.y) + bf_hi(g4.y) * v0[3]);
                    w.z = cvt_pk_bf16(bf_lo(p4.z) + bf_lo(g4.z) * v1[0], bf_hi(p4.z) + bf_hi(g4.z) * v1[1]);
                    w.w = cvt_pk_bf16(bf_lo(p4.w) + bf_lo(g4.w) * v1[2], bf_hi(p4.w) + bf_hi(g4.w) * v1[3]);
                    *(u32x4*)(dst + off) = w;
                }
        }
#undef EPI_LD
    } else {
        bf16_t* dst = (bf16_t*)(ws + WS_ACC);
#pragma unroll
        for (int ai = 0; ai < 2; ++ai)
#pragma unroll
            for (int m = 0; m < 4; ++m) {
                const int tl = rbase + ai * HALF + m * 16;
#pragma unroll
                for (int bj = 0; bj < 2; ++bj) {
                    const f32x4 v0 = acc[ai][bj][m][0], v1 = acc[ai][bj][m][1];
                    u32x4 w; w.x = cvt_pk_bf16(v0[0], v0[1]); w.y = cvt_pk_bf16(v0[2], v0[3]); w.z = cvt_pk_bf16(v1[0], v1[1]); w.w = cvt_pk_bf16(v1[2], v1[3]);
                    *(u32x4*)(dst + (size_t)tl * DM + u.pn * BM + cl + bj * HALF) = w;
                }
            }
    }
}

__device__ __forceinline__ void gemm_phase(const Args& a, LAS unsigned char* lds, const GemmD& g, int G, int cidx, int tid) {
    const int wid = __builtin_amdgcn_readfirstlane(tid >> 6), lane = tid & 63, wr = wid >> 2, wc = wid & 3, fr = lane & 15, fq = lane >> 4;
    const int K = g.K, nt = K / BK;
    unsigned voffA[2], voffB[2];
#pragma unroll
    for (int i = 0; i < 2; ++i) { int R, C; stage_rc(tid * 16 + i * 8192, R, C); const int Rb = (R & ~31) + perm32(R & 31);
        voffA[i] = (unsigned)(R * g.lda + C) * 2u; voffB[i] = (unsigned)(Rb * g.ldb + C) * 2u; }
    const size_t kstep = (size_t)(BK * 2);
    const size_t hstepA = (size_t)HALF * g.lda * 2, hstepB = (size_t)HALF * g.ldb * 2;
    const size_t tstepA = 2 * hstepA, tstepB = 2 * hstepB;
    const unsigned ldsw = (unsigned)wid * 1024u;
    const int aoff = lds_byte(wr * 64 + fr, fq * 8), boff = lds_byte(wc * 32 + fr, fq * 8);
#define PG8_SA(b, h) (((b) * 2 + (h)) * HTB)
#define PG8_SB(b, h) ((4 + (b) * 2 + (h)) * HTB)
#define PG8_STAGE(bufoff, gbase, voff) do { _Pragma("unroll") for (int _i = 0; _i < 2; ++_i) \
        __builtin_amdgcn_global_load_lds((const unsigned*)((const char*)(gbase) + (voff)[_i]), (LAS unsigned*)(lds + (bufoff) + ldsw + _i * 8192), 16, 0, 0); } while (0)
#define PG8_LDA(dst, b, h) do { _Pragma("unroll") for (int m = 0; m < 4; ++m) _Pragma("unroll") for (int k = 0; k < 2; ++k) dst[m][k] = *(const LAS bf16x8*)(lds + PG8_SA(b, h) + aoff + m * 2048 + k * 1024); } while (0)
#define PG8_LDB(dst, b, h) do { _Pragma("unroll") for (int n = 0; n < 2; ++n) _Pragma("unroll") for (int k = 0; k < 2; ++k) dst[n][k] = *(const LAS bf16x8*)(lds + PG8_SB(b, h) + boff + n * 2048 + k * 1024); } while (0)
#define PG8_MMA(ai, bj, At, Bt) do { __builtin_amdgcn_s_setprio(1); _Pragma("unroll") for (int m = 0; m < 4; ++m) _Pragma("unroll") for (int n = 0; n < 2; ++n) _Pragma("unroll") for (int k = 0; k < 2; ++k) \
        acc[ai][bj][m][n] = __builtin_amdgcn_mfma_f32_16x16x32_bf16(Bt[n][k], At[m][k], acc[ai][bj][m][n], 0, 0, 0); __builtin_amdgcn_s_setprio(0); } while (0)
#define PG8_WAIT_V(n) asm volatile("s_waitcnt vmcnt(" #n ")" ::: "memory")
#define PG8_WAIT_L(n) asm volatile("s_waitcnt lgkmcnt(" #n ")" ::: "memory")
#define PG8_BAR __builtin_amdgcn_s_barrier()
#define PG8_SCHED __builtin_amdgcn_sched_barrier(0)
    Unit cur, nxt; int ui = 0;
    { int pm_, pn_, bz_; if (!unit_next(g, 0, G, cidx, pm_, pn_, bz_)) return; cur.pm = pm_; cur.pn = pn_; cur.bz = bz_; }
    f32x4 acc[2][2][4][2];
#pragma unroll
    for (int a = 0; a < 2; ++a)
#pragma unroll
        for (int b = 0; b < 2; ++b)
#pragma unroll
            for (int m = 0; m < 4; ++m)
#pragma unroll
                for (int n = 0; n < 2; ++n) acc[a][b][m][n] = (f32x4){0.f, 0.f, 0.f, 0.f};
    bf16x8 At[4][2], B0[2][2], B1[2][2];
    const char* cA = (const char*)g.A + (size_t)cur.bz * g.sA + (size_t)cur.pm * tstepA; const char* cB = (const char*)g.Bt + (size_t)cur.bz * g.sB + (size_t)cur.pn * tstepB;
    PG8_STAGE(PG8_SB(0, 0), cB, voffB); PG8_STAGE(PG8_SA(0, 0), cA, voffA); PG8_STAGE(PG8_SB(0, 1), cB + hstepB, voffB); PG8_STAGE(PG8_SA(0, 1), cA + hstepA, voffA);
    if (wr == 1) PG8_BAR;
    PG8_WAIT_V(4); PG8_BAR;
    PG8_STAGE(PG8_SB(1, 0), cB + kstep, voffB); PG8_STAGE(PG8_SA(1, 0), cA + kstep, voffA); PG8_STAGE(PG8_SB(1, 1), cB + hstepB + kstep, voffB);
    PG8_WAIT_V(6); PG8_BAR;
    for (;;) {
        int npm, npn, nbz; const bool has_next = unit_next(g, ui + 1, G, cidx, npm, npn, nbz); nxt.pm = npm; nxt.pn = npn; nxt.bz = nbz;
        const char* nA = has_next ? (const char*)g.A + (size_t)nxt.bz * g.sA + (size_t)nxt.pm * tstepA : cA; const char* nB = has_next ? (const char*)g.Bt + (size_t)nxt.bz * g.sB + (size_t)nxt.pn * tstepB : cB;
        for (int t = 0; t < nt; t += 2) {
            const bool last = (t == nt - 2);
            const char* a1 = cA + (size_t)(t + 1) * kstep;
            const char* a2 = last ? nA : cA + (size_t)(t + 2) * kstep; const char* b2 = last ? nB : cB + (size_t)(t + 2) * kstep;
            const char* a3 = a2 + kstep; const char* b3 = b2 + kstep;
            PG8_LDB(B0, 0, 0); PG8_SCHED; PG8_LDA(At, 0, 0); PG8_STAGE(PG8_SA(1, 1), a1 + hstepA, voffA);
            PG8_WAIT_L(8); PG8_BAR; PG8_WAIT_L(0); PG8_MMA(0, 0, At, B0); PG8_BAR; PG8_SCHED;
            PG8_LDB(B1, 0, 1); PG8_STAGE(PG8_SB(0, 0), b2, voffB);
            PG8_BAR; PG8_WAIT_L(0); PG8_MMA(0, 1, At, B1); PG8_BAR;
            PG8_LDA(At, 0, 1); PG8_STAGE(PG8_SA(0, 0), a2, voffA);
            PG8_BAR; PG8_WAIT_L(0); PG8_MMA(1, 0, At, B0); PG8_BAR; PG8_SCHED;
            PG8_STAGE(PG8_SB(0, 1), b2 + hstepB, voffB);
            PG8_WAIT_V(6); PG8_BAR; PG8_MMA(1, 1, At, B1); PG8_BAR;
            PG8_LDB(B0, 1, 0); PG8_SCHED; PG8_LDA(At, 1, 0); PG8_STAGE(PG8_SA(0, 1), a2 + hstepA, voffA);
            PG8_WAIT_L(8); PG8_BAR; PG8_WAIT_L(0); PG8_MMA(0, 0, At, B0); PG8_BAR; PG8_SCHED;
            PG8_LDB(B1, 1, 1); PG8_STAGE(PG8_SB(1, 0), b3, voffB);
            PG8_BAR; PG8_WAIT_L(0); PG8_MMA(0, 1, At, B1); PG8_BAR;
            PG8_LDA(At, 1, 1); PG8_STAGE(PG8_SA(1, 0), a3, voffA);
            PG8_BAR; PG8_WAIT_L(0); PG8_MMA(1, 0, At, B0); PG8_BAR; PG8_SCHED;
            PG8_STAGE(PG8_SB(1, 1), b3 + hstepB, voffB);
            PG8_WAIT_V(6); PG8_BAR; PG8_MMA(1, 1, At, B1); PG8_BAR;
        }
#ifndef NO_EPI
        epilogue(a, lds, g, acc, cur, wr, wc, fr, fq);
#else
        if (g.mode == 99) *(f32x4*)(g.out) = acc[0][0][0][0] + acc[1][1][3][1] + acc[0][1][2][0]+acc[1][0][1][1];
#endif
        if (!has_next) break;
#pragma unroll
        for (int a = 0; a < 2; ++a)
#pragma unroll
            for (int b = 0; b < 2; ++b)
#pragma unroll
                for (int m = 0; m < 4; ++m)
#pragma unroll
                    for (int n = 0; n < 2; ++n) acc[a][b][m][n] = (f32x4){0.f, 0.f, 0.f, 0.f};
        cur = nxt; cA = nA; cB = nB; ++ui;
    }
    PG8_WAIT_V(0);
    if (wr == 0) PG8_BAR;
    PG8_BAR;
#undef PG8_SA
#undef PG8_SB
#undef PG8_STAGE
#undef PG8_LDA
#undef PG8_LDB
#undef PG8_MMA
#undef PG8_WAIT_V
#undef PG8_WAIT_L
#undef PG8_BAR
#undef PG8_SCHED
}

__device__ __forceinline__ int qk_perm_row(int n) { const int i = n & 63; return (n & ~63) + 8 * ((i & 31) >> 2) + (i & 3) + 4 * (i >> 5); }
__device__ __forceinline__ void transpose_item(const float* W, int K, int N, bf16_t* WT, bool permqk, LAS float* scr, int item, int lane) {
    const int nblk = N / 32, kb = item / nblk, nb = item % nblk, k0 = 64 * kb, n0 = 32 * nb;
#pragma unroll 8
    for (int i = 0; i < 32; ++i) { const int kk = 2 * i + (lane >> 5); scr[kk * 33 + (lane & 31)] = W[(size_t)(k0 + kk) * N + n0 + (lane & 31)]; }
    asm volatile("s_waitcnt lgkmcnt(0)" ::: "memory");
    const int c = lane & 7;
#pragma unroll
    for (int j = 0; j < 4; ++j) { const int n = (lane >> 3) + 8 * j; const LAS float* s = scr + (8 * c) * 33 + n;
        u32x4 o; o.x = cvt_pk_bf16(s[0 * 33], s[1 * 33]); o.y = cvt_pk_bf16(s[2 * 33], s[3 * 33]); o.z = cvt_pk_bf16(s[4 * 33], s[5 * 33]); o.w = cvt_pk_bf16(s[6 * 33], s[7 * 33]);
        int row = n0 + n; if (permqk && row < 2 * QKVW) row = qk_perm_row(row);
        *(u32x4*)(WT + (size_t)row * K + k0 + 8 * c) = o; }
    asm volatile("s_waitcnt lgkmcnt(0)" ::: "memory");
}
__device__ __forceinline__ void reduce_angle(double a, float& c, float& s) {
    const double k = __builtin_rint(a * 0.6366197723675814); const float x = (float)(a - k * 1.5707963267948966), x2 = x * x;
    const float sn = x * (1.0f + x2 * (-1.6666666667e-1f + x2 * (8.3333333333e-3f + x2 * (-1.9841269841e-4f + x2 * 2.7557319224e-6f))));
    const float cs = 1.0f + x2 * (-0.5f + x2 * (4.1666666667e-2f + x2 * (-1.3888888889e-3f + x2 * (2.4801587302e-5f + x2 * -2.7557319224e-7f))));
    const int q = ((int)k) & 3;
    c = (q == 0) ? cs : (q == 1) ? -sn : (q == 2) ? -cs : sn;
    s = (q == 0) ? sn : (q == 1) ? cs : (q == 2) ? -sn : -cs;
}
__device__ __forceinline__ void rms_row_to_bf16(const float* xrow, const float* gw, bf16_t* orow, int lane) {
    const f32x4* xr = (const f32x4*)xrow + lane; const f32x4* gr = (const f32x4*)gw + lane;
    f32x4 v[4]; float s = 0.f;
#pragma unroll
    for (int j = 0; j < 4; ++j) { v[j] = xr[64 * j]; s += (v[j].x * v[j].x + v[j].y * v[j].y) + (v[j].z * v[j].z + v[j].w * v[j].w); }
    const float rstd = 1.0f / sqrtf(wave_sum(s) * (1.f / DM) + EPSN);
    u32x2* o8 = (u32x2*)orow + lane;
#pragma unroll
    for (int j = 0; j < 4; ++j) { const f32x4 gv = gr[64 * j]; u32x2 w; w.x = cvt_pk_bf16(v[j].x * rstd * gv.x, v[j].y * rstd * gv.y); w.y = cvt_pk_bf16(v[j].z * rstd * gv.z, v[j].w * rstd * gv.w); o8[64 * j] = w; }
}

__device__ __forceinline__ void ssm_load_bc(const Args& a, int g, int dir, LAS f32x2* Bb, LAS f32x2* Cc, int tid) {
    const float* lam_re = a.in[4]; const float* lam_im = a.in[5]; const float* log_step = a.in[6];
    const float* b_re = a.in[7]; const float* b_im = a.in[8]; const float* c_re = a.in[9]; const float* c_im = a.in[10];
    const float dt = expf(log_step[dir * 32 + g]);
    for (int idx = tid; idx < 1024; idx += 512) {
        { const int n = idx >> 4; const float lr = lam_re[(dir * 32 + g) * 64 + n], li = lam_im[(dir * 32 + g) * 64 + n];
          const float ar = lr * dt; float cb, sb, ch, sh; reduce_angle((double)li * (double)dt, cb, sb); reduce_angle(0.5 * (double)li * (double)dt, ch, sh);
          const float em1 = expm1f(ar), ea = em1 + 1.0f;
          const float nr = em1 * cb - 2.0f * sh * sh, ni = ea * sb;
          const float den = 1.0f / (lr * lr + li * li); const float cr = (nr * lr + ni * li) * den, ci = (ni * lr - nr * li) * den;
          const float br = b_re[(size_t)((dir * 32 + g) * 64) * 16 + idx], bi = b_im[(size_t)((dir * 32 + g) * 64) * 16 + idx];
          Bb[idx] = (f32x2){cr * br - ci * bi, cr * bi + ci * br}; }
        { Cc[idx] = (f32x2){c_re[(size_t)((dir * 32 + g) * 16) * 64 + idx], c_im[(size_t)((dir * 32 + g) * 16) * 64 + idx]}; }
    }
}
__device__ __forceinline__ void ssm_setup_item(const Args& a, LAS unsigned char* lds, int item, int tid) {
    const int g = item >> 1, dir = item & 1;
    LAS f32x2* pw = (LAS f32x2*)lds; LAS f32x2* Bb = pw + 33 * 64; LAS f32x2* Cc = Bb + 1024;
    LAS float* KT = (LAS float*)(Cc + 1024); LAS float* K0 = KT + 32 * 256; LAS f32x2* Bb0 = (LAS f32x2*)(K0 + 256); LAS f32x2* Cc0 = Bb0 + 1024;
    const float* lam_re = a.in[4]; const float* lam_im = a.in[5]; const float* log_step = a.in[6];
    unsigned char* ws = a.ws;
    const float dt = expf(log_step[dir * 32 + g]);
    __syncthreads();
    for (int idx = tid; idx < 33 * 64; idx += 512) {
        const int tau = idx >> 6, n = idx & 63; const float lr = lam_re[(dir * 32 + g) * 64 + n], li = lam_im[(dir * 32 + g) * 64 + n];
        const float mag = expf(lr * dt * (float)tau); float c, s; reduce_angle((double)li * (double)dt * (double)tau, c, s);
        pw[idx] = (f32x2){mag * c, mag * s};
    }
    ssm_load_bc(a, g, dir, Bb, Cc, tid);
    if (dir == 1) ssm_load_bc(a, g, 0, Bb0, Cc0, tid);
    __syncthreads();
    if (tid < 64) { float* PW = (float*)(ws + WS_PW); const f32x2 p = pw[32 * 64 + tid]; PW[((dir * 32 + g) * 64 + tid) * 2] = p.x; PW[((dir * 32 + g) * 64 + tid) * 2 + 1] = p.y; }
    for (int o = tid; o < 32 * 256; o += 512) {
        const int tau = o >> 8, co = (o >> 4) & 15, ci = o & 15; float acc = 0.f;
_Pragma("unroll 4")
        for (int n = 0; n < 64; ++n) { const f32x2 c = Cc[co * 64 + n], p = pw[tau * 64 + n], b = Bb[n * 16 + ci]; const float tr = c.x * p.x - c.y * p.y, ti = c.x * p.y + c.y * p.x; acc += tr * b.x - ti * b.y; }
        KT[o] = acc; }
    if (dir == 1 && tid < 256) { const int co = tid >> 4, ci = tid & 15; float acc = 0.f;
_Pragma("unroll 4")
        for (int n = 0; n < 64; ++n) { const f32x2 c = Cc0[co * 64 + n], b = Bb0[n * 16 + ci]; acc += c.x * b.x - c.y * b.y; }
        K0[tid] = acc; }
    { bf16_t* BsT = (bf16_t*)(ws + WS_BST) + (size_t)g * 256 * 512;
      for (int ch = tid; ch < 128 * 64; ch += 512) {
          const int row = ch >> 6, part = row >> 6, n = row & 63, kc = ch & 63, s = kc >> 1, ci0 = (kc & 1) * 8; const int e = dir ? s : 31 - s; const f32x2 p = pw[e * 64 + n];
          float v[8];
#pragma unroll
          for (int j = 0; j < 8; ++j) { const f32x2 b = Bb[n * 16 + ci0 + j]; v[j] = part ? (p.x * b.y + p.y * b.x) : (p.x * b.x - p.y * b.y); }
          u32x4 w; w.x = cvt_pk_bf16(v[0], v[1]); w.y = cvt_pk_bf16(v[2], v[3]); w.z = cvt_pk_bf16(v[4], v[5]); w.w = cvt_pk_bf16(v[6], v[7]);
          *(u32x4*)(BsT + (size_t)(dir * 128 + row) * 512 + s * 16 + ci0) = w; } }
    bf16_t* MtC = (bf16_t*)(ws + WS_MTC) + (size_t)g * 512 * UHK;
    { for (int ch = tid; ch < 512 * 16; ch += 512) {
          const int row = ch >> 4, t = row >> 4, co = row & 15, cc = ch & 15, part = cc >> 3, n0 = (cc & 7) * 8; const int e = dir ? 32 - t : t + 1;
          float v[8];
#pragma unroll
          for (int j = 0; j < 8; ++j) { const f32x2 c = Cc[co * 64 + n0 + j], p = pw[e * 64 + n0 + j]; v[j] = part ? -(c.x * p.y + c.y * p.x) : (c.x * p.x - c.y * p.y); }
          u32x4 w; w.x = cvt_pk_bf16(v[0], v[1]); w.y = cvt_pk_bf16(v[2], v[3]); w.z = cvt_pk_bf16(v[4], v[5]); w.w = cvt_pk_bf16(v[6], v[7]);
          *(u32x4*)(MtC + (size_t)row * UHK + 512 + dir * 128 + part * 64 + n0) = w; } }
    __syncthreads();
    { const float* dsk = a.in[11];
      for (int ch = tid; ch < 512 * 64; ch += 512) {
          const int kc = ch & 63, row = ch >> 6; const int s = kc >> 1, ci0 = (kc & 1) * 8, t = row >> 4, co = row & 15;
          if (dir == 0 ? (t > s) : (s >= t)) {
              const int tau = dir == 0 ? t - s : s - t;
              float v[8];
#pragma unroll
              for (int j = 0; j < 8; ++j) v[j] = KT[tau * 256 + co * 16 + ci0 + j];
              if (t == s) { const float dv = dsk[g * 16 + co];
#pragma unroll
                  for (int j = 0; j < 8; ++j) v[j] += K0[co * 16 + ci0 + j] + ((ci0 + j == co) ? dv : 0.f); }
              u32x4 w; w.x = cvt_pk_bf16(v[0], v[1]); w.y = cvt_pk_bf16(v[2], v[3]); w.z = cvt_pk_bf16(v[4], v[5]); w.w = cvt_pk_bf16(v[6], v[7]);
              *(u32x4*)(MtC + (size_t)row * UHK + s * 16 + ci0) = w;
          }
      } }
    __syncthreads();
}

__device__ __forceinline__ void step_setup(const Args& a, LAS unsigned char* lds, int tid, int bx) {
    const int lane = tid & 63, wave = tid >> 6, G = gridDim.x;
    unsigned char* ws = a.ws;
    for (int it = bx; it < 64; it += G) ssm_setup_item(a, lds, it, tid);
    { float* rc = (float*)(ws + WS_ROPE); float* rs = rc + SEQL * 32;
      for (int idx = bx * 512 + tid; idx < SEQL * 32; idx += G * 512) {
          const int pos = idx >> 5, i = idx & 31; double inv = 1.0; for (int k = 0; k < i; ++k) inv *= 0.7498942093324558;
          float c, s; reduce_angle((double)pos * inv, c, s); rc[idx] = c; rs[idx] = s; } }
    { LAS float* scr = (LAS float*)(lds) + wave * (64 * 33);
      const int gw = bx * 8 + wave, NGW = G * 8;
      constexpr int I_IN = (DM / 64) * (INC / 32), I_GLU = (512 / 64) * (512 / 32), I_AB = (512 / 64) * (1024 / 32), I_OUT = (1024 / 64) * (1024 / 32);
      constexpr int NIT = I_IN + I_GLU + 2 * I_AB + I_OUT;
      for (int it = gw; it < NIT; it += NGW) {
          int r = it;
          if (r < I_IN) { transpose_item(a.in[3], DM, INC, (bf16_t*)(ws + WS_WIN), true, scr, r, lane); continue; } r -= I_IN;
          if (r < I_GLU) { transpose_item(a.in[12], 512, 512, (bf16_t*)(ws + WS_WGLU), false, scr, r, lane); continue; } r -= I_GLU;
          if (r < I_AB) { transpose_item(a.in[13], 512, 1024, (bf16_t*)(ws + WS_WA), false, scr, r, lane); continue; } r -= I_AB;
          if (r < I_AB) { transpose_item(a.in[14], 512, 1024, (bf16_t*)(ws + WS_WB), false, scr, r, lane); continue; } r -= I_AB;
          transpose_item(a.in[15], 1024, 1024, (bf16_t*)(ws + WS_WOUT), false, scr, r, lane);
      } }
    { bf16_t* hn = (bf16_t*)((unsigned char*)a.out + OUT_HN_OFF);
      const f32x4* gr = (const f32x4*)a.in[2] + lane;
      f32x4 gv[4];
#pragma unroll
      for (int j = 0; j < 4; ++j) gv[j] = gr[64 * j];
      unsigned* rctr = (unsigned*)(ws + WS_CTL) + 4;
      constexpr int RCH = 16;
      for (;;) {
          unsigned cidx = 0; if (lane == 0) cidx = atomicAdd(rctr, 1u);
          cidx = (unsigned)__builtin_amdgcn_readfirstlane((int)cidx);
          if (cidx >= (unsigned)(TTOK / RCH)) break;
          int row = (int)cidx * RCH; const int rend = row + RCH;
          f32x4 nx[4];
          { const f32x4* xr = (const f32x4*)xrow_ptr(a.in[0], a.in[1], row) + lane;
#pragma unroll
            for (int j = 0; j < 4; ++j) nx[j] = __builtin_nontemporal_load(xr + 64 * j); }
          for (; row < rend; ++row) {
              f32x4 v[4];
#pragma unroll
              for (int j = 0; j < 4; ++j) v[j] = nx[j];
              if (row + 1 < rend) { const f32x4* xn = (const f32x4*)xrow_ptr(a.in[0], a.in[1], row + 1) + lane;
#pragma unroll
                  for (int j = 0; j < 4; ++j) nx[j] = __builtin_nontemporal_load(xn + 64 * j); }
              float s = 0.f;
#pragma unroll
              for (int j = 0; j < 4; ++j) s += (v[j].x * v[j].x + v[j].y * v[j].y) + (v[j].z * v[j].z + v[j].w * v[j].w);
              const float rstd = 1.0f / sqrtf(wave_sum(s) * (1.f / DM) + EPSN);
              u32x2* o8 = (u32x2*)(hn + (size_t)row * DM) + lane;
#pragma unroll
              for (int j = 0; j < 4; ++j) { u32x2 w; w.x = cvt_pk_bf16(v[j].x * rstd * gv[j].x, v[j].y * rstd * gv[j].y); w.y = cvt_pk_bf16(v[j].z * rstd * gv[j].z, v[j].w * rstd * gv[j].w); o8[64 * j] = w; }
          }
      } }
}

__device__ __forceinline__ float quad_max(float x) {
    const auto r = __builtin_amdgcn_permlane32_swap(__float_as_uint(x), __float_as_uint(x), false, false);
    x = fmaxf(__uint_as_float(r[0]), __uint_as_float(r[1]));
    const auto q = __builtin_amdgcn_permlane16_swap(__float_as_uint(x), __float_as_uint(x), false, false);
    return fmaxf(__uint_as_float(q[0]), __uint_as_float(q[1]));
}
__device__ __forceinline__ float quad_sum(float x) {
    const auto r = __builtin_amdgcn_permlane32_swap(__float_as_uint(x), __float_as_uint(x), false, false);
    x = __uint_as_float(r[0]) + __uint_as_float(r[1]);
    const auto q = __builtin_amdgcn_permlane16_swap(__float_as_uint(x), __float_as_uint(x), false, false);
    return __uint_as_float(q[0]) + __uint_as_float(q[1]);
}
struct KVBuf { bf16x8 kA0, kA1, kB0, kB1; bf16x4 vA[4], vB[4]; };
__device__ __forceinline__ void step_params(int s, int& gi, int& ls) { gi = s < 12 ? 0 : (s < 18 ? 1 : 2); ls = s < 12 ? s : (s < 18 ? s - 12 : s - 18); }
__device__ __forceinline__ void attn_load(KVBuf& b, const bf16_t* Kp, const bf16_t* Vt, int s, int sq, int h, int blk, int r, int lane) {
    int gi, ls; step_params(s, gi, ls);
    const int sh = 2 * gi, Lg = SEQL >> sh, rho = r & ((1 << sh) - 1);
    int uA = ((256 * blk) >> sh) - 64 + 32 * ls, uB = uA + 16;
    if (uA < 0 || uA >= Lg) uA = 0; if (uB < 0 || uB >= Lg) uB = 0;
    const int kl = lane & 15, quad = lane >> 4;
    const bf16_t* kh = Kp + (size_t)(sq * 24 + gi * 8 + h) * SEQL * 64 + quad * 128 + kl * 8;
    const bf16_t* ka = kh + (size_t)((rho * Lg + uA) >> 4) * 1024; const bf16_t* kb = kh + (size_t)((rho * Lg + uB) >> 4) * 1024;
    b.kA0 = *(const bf16x8*)ka; b.kA1 = *(const bf16x8*)(ka + 512); b.kB0 = *(const bf16x8*)kb; b.kB1 = *(const bf16x8*)(kb + 512);
    const bf16_t* vbase = Vt + (size_t)(((sq * 3 + gi) * 8 + h) * 512) * 1024 + quad * 64 + kl * 4;
    const bf16_t* va = vbase + (size_t)((rho * Lg + uA) >> 4) * 1024; const bf16_t* vb = vbase + (size_t)((rho * Lg + uB) >> 4) * 1024;
#pragma unroll
    for (int dt = 0; dt < 4; ++dt) { b.vA[dt] = *(const bf16x4*)(va + dt * 256); b.vB[dt] = *(const bf16x4*)(vb + dt * 256); }
}
struct QF { bf16x8 a0, a1, b0, b1, c0, c1; };
template <int gi>
__device__ __forceinline__ void attn_compute(const KVBuf& b, const bf16x8 q0, const bf16x8 q1, f32x4 (&o)[4], float& mrun, float& lrun, int s, int blk, int r, int lane) {
    const int ls = gi == 0 ? s : (gi == 1 ? s - 12 : s - 18);
    const int sh = 2 * gi, Lg = SEQL >> sh;
    const int uA = ((256 * blk) >> sh) - 64 + 32 * ls;
    const int qi = lane & 15, quad = lane >> 4;
    const int uq = (256 * blk + r + 16 * qi) >> sh;
    const int lo = max(0, uq - 64), hi = min(Lg - 1, uq + 64);
    f32x4 sA = (f32x4){0.f, 0.f, 0.f, 0.f}, sB = sA;
    sA = __builtin_amdgcn_mfma_f32_16x16x32_bf16(b.kA0, q0, sA, 0, 0, 0); sA = __builtin_amdgcn_mfma_f32_16x16x32_bf16(b.kA1, q1, sA, 0, 0, 0);
    sB = __builtin_amdgcn_mfma_f32_16x16x32_bf16(b.kB0, q0, sB, 0, 0, 0); sB = __builtin_amdgcn_mfma_f32_16x16x32_bf16(b.kB1, q1, sB, 0, 0, 0);
    const float NEGINF = -__builtin_inff();
    const unsigned span = (unsigned)(hi - lo);
    float mx = NEGINF;
#pragma unroll
    for (int j = 0; j < 4; ++j) {
        const int ua = uA + quad * 4 + j, ub = ua + 16;
        sA[j] = ((unsigned)(ua - lo) <= span) ? sA[j] : NEGINF; sB[j] = ((unsigned)(ub - lo) <= span) ? sB[j] : NEGINF;
        mx = fmaxf(mx, fmaxf(sA[j], sB[j]));
    }
    mx = quad_max(mx);
    const float mnew = fmaxf(mrun, mx), alpha = __builtin_amdgcn_exp2f(mrun - mnew);
    mrun = mnew;
    float ps = 0.f;
#pragma unroll
    for (int j = 0; j < 4; ++j) { sA[j] = __builtin_amdgcn_exp2f(sA[j] - mnew); sB[j] = __builtin_amdgcn_exp2f(sB[j] - mnew); ps += sA[j] + sB[j]; }
    lrun = lrun * alpha + ps;
    u32x4 pw; pw.x = cvt_pk_bf16(sA[0], sA[1]); pw.y = cvt_pk_bf16(sA[2], sA[3]); pw.z = cvt_pk_bf16(sB[0], sB[1]); pw.w = cvt_pk_bf16(sB[2], sB[3]);
    const bf16x8 pf = __builtin_bit_cast(bf16x8, pw);
#pragma unroll
    for (int dt = 0; dt < 4; ++dt) {
        o[dt] *= alpha;
        bf16x8 vf; vf[0] = b.vA[dt][0]; vf[1] = b.vA[dt][1]; vf[2] = b.vA[dt][2]; vf[3] = b.vA[dt][3]; vf[4] = b.vB[dt][0]; vf[5] = b.vB[dt][1]; vf[6] = b.vB[dt][2]; vf[7] = b.vB[dt][3];
#ifdef DBG_ATT2
        for (int e = 0; e < 8; ++e) o[dt][e & 3] += 1e-3f * __uint_as_float(((unsigned)(unsigned short)vf[e]) << 16);
#else
        o[dt] = __builtin_amdgcn_mfma_f32_16x16x32_bf16(vf, pf, o[dt], 0, 0, 0);
#endif
    }
}
template <int gi>
__device__ __forceinline__ void attn_compute2(const KVBuf& b, const KVBuf& c, const bf16x8 q0, const bf16x8 q1, f32x4 (&o)[4], float& mrun, float& lrun, int s, int blk, int r, int lane) {
    const int ls = gi == 0 ? s : (gi == 1 ? s - 12 : s - 18);
    const int sh = 2 * gi, Lg = SEQL >> sh;
    const int uA = ((256 * blk) >> sh) - 64 + 32 * ls;
    const int qi = lane & 15, quad = lane >> 4;
    const int uq = (256 * blk + r + 16 * qi) >> sh;
    const int lo = max(0, uq - 64), hi = min(Lg - 1, uq + 64);
    const f32x4 z4 = (f32x4){0.f, 0.f, 0.f, 0.f};
    f32x4 sA = __builtin_amdgcn_mfma_f32_16x16x32_bf16(b.kA0, q0, z4, 0, 0, 0), sB = __builtin_amdgcn_mfma_f32_16x16x32_bf16(b.kB0, q0, z4, 0, 0, 0);
    f32x4 sC = __builtin_amdgcn_mfma_f32_16x16x32_bf16(c.kA0, q0, z4, 0, 0, 0), sD = __builtin_amdgcn_mfma_f32_16x16x32_bf16(c.kB0, q0, z4, 0, 0, 0);
    sA = __builtin_amdgcn_mfma_f32_16x16x32_bf16(b.kA1, q1, sA, 0, 0, 0); sB = __builtin_amdgcn_mfma_f32_16x16x32_bf16(b.kB1, q1, sB, 0, 0, 0);
    sC = __builtin_amdgcn_mfma_f32_16x16x32_bf16(c.kA1, q1, sC, 0, 0, 0); sD = __builtin_amdgcn_mfma_f32_16x16x32_bf16(c.kB1, q1, sD, 0, 0, 0);
    const float NEGINF = -__builtin_inff();
    const unsigned span = (unsigned)(hi - lo);
    float mx = NEGINF;
#pragma unroll
    for (int j = 0; j < 4; ++j) {
        const int ua = uA + quad * 4 + j;
        sA[j] = ((unsigned)(ua - lo) <= span) ? sA[j] : NEGINF; sB[j] = ((unsigned)(ua + 16 - lo) <= span) ? sB[j] : NEGINF;
        sC[j] = ((unsigned)(ua + 32 - lo) <= span) ? sC[j] : NEGINF; sD[j] = ((unsigned)(ua + 48 - lo) <= span) ? sD[j] : NEGINF;
        mx = fmaxf(fmaxf(mx, fmaxf(sA[j], sB[j])), fmaxf(sC[j], sD[j]));
    }
    mx = quad_max(mx);
    const float mnew = fmaxf(mrun, mx), alpha = __builtin_amdgcn_exp2f(mrun - mnew);
    mrun = mnew;
    float ps = 0.f;
#pragma unroll
    for (int j = 0; j < 4; ++j) { sA[j] = __builtin_amdgcn_exp2f(sA[j] - mnew); sB[j] = __builtin_amdgcn_exp2f(sB[j] - mnew); sC[j] = __builtin_amdgcn_exp2f(sC[j] - mnew); sD[j] = __builtin_amdgcn_exp2f(sD[j] - mnew); ps += (sA[j] + sB[j]) + (sC[j] + sD[j]); }
    lrun = lrun * alpha + ps;
    u32x4 pw, pv; pw.x = cvt_pk_bf16(sA[0], sA[1]); pw.y = cvt_pk_bf16(sA[2], sA[3]); pw.z = cvt_pk_bf16(sB[0], sB[1]); pw.w = cvt_pk_bf16(sB[2], sB[3]);
    pv.x = cvt_pk_bf16(sC[0], sC[1]); pv.y = cvt_pk_bf16(sC[2], sC[3]); pv.z = cvt_pk_bf16(sD[0], sD[1]); pv.w = cvt_pk_bf16(sD[2], sD[3]);
    const bf16x8 pf = __builtin_bit_cast(bf16x8, pw), pg = __builtin_bit_cast(bf16x8, pv);
#pragma unroll
    for (int dt = 0; dt < 4; ++dt) {
        o[dt] *= alpha;
        bf16x8 vf, vg;
        vf[0] = b.vA[dt][0]; vf[1] = b.vA[dt][1]; vf[2] = b.vA[dt][2]; vf[3] = b.vA[dt][3]; vf[4] = b.vB[dt][0]; vf[5] = b.vB[dt][1]; vf[6] = b.vB[dt][2]; vf[7] = b.vB[dt][3];
        vg[0] = c.vA[dt][0]; vg[1] = c.vA[dt][1]; vg[2] = c.vA[dt][2]; vg[3] = c.vA[dt][3]; vg[4] = c.vB[dt][0]; vg[5] = c.vB[dt][1]; vg[6] = c.vB[dt][2]; vg[7] = c.vB[dt][3];
        o[dt] = __builtin_amdgcn_mfma_f32_16x16x32_bf16(vf, pf, o[dt], 0, 0, 0);
        o[dt] = __builtin_amdgcn_mfma_f32_16x16x32_bf16(vg, pg, o[dt], 0, 0, 0);
    }
}
__device__ __forceinline__ void step_attention(const Args& a, LAS unsigned char* lds, int pass, int tid, int bx) {
    unsigned char* ws = a.ws;
    const int lane = tid & 63;
    const bf16_t* Qp = (const bf16_t*)(ws + WS_Q); const bf16_t* Kp = (const bf16_t*)(ws + WS_K); const bf16_t* Vt = (const bf16_t*)(ws + WS_VT);
    const bf16_t* ZA = (const bf16_t*)(ws + WS_ZA); bf16_t* GAO = (bf16_t*)(ws + WS_GAO);
    const int xcd = bx & 7;
    unsigned* ctr = (unsigned*)(ws + WS_CTL) + 16 + pass * 8 + xcd;
    LAS unsigned* slot = (LAS unsigned*)(lds + 3 * 16384);
    constexpr int NGRP = 3 * 32 * 2;
    for (;;) {
        __syncthreads();
        if (tid == 0) slot[0] = atomicAdd(ctr, 1u);
        __syncthreads();
        const unsigned grp = (unsigned)__builtin_amdgcn_readfirstlane((int)slot[0]);
        if (grp >= (unsigned)NGRP) break;
        const int wv_ = tid >> 6; const int r = ((wv_ & 3) << 2) + (wv_ >> 2) + 2 * (int)(grp & 1)  , blk = (grp >> 1) & 31, pair = xcd * 3 + (int)(grp >> 6);
        const int h = pair & 7, sq = pair >> 3;
        const int qi = lane & 15, quad = lane >> 4;
        const int tq = sq * SEQL + 256 * blk + r + 16 * qi;
        QF qf;
        { const int pos = 256 * blk + r + 16 * qi;
          const bf16_t* qa = Qp + ((size_t)(sq * 24 + h) * SEQL + pos) * 64 + quad * 8;
          const bf16_t* qb = Qp + ((size_t)(sq * 24 + 8 + h) * SEQL + (pos & 3) * 2048 + (pos >> 2)) * 64 + quad * 8;
          const bf16_t* qc = Qp + ((size_t)(sq * 24 + 16 + h) * SEQL + (pos & 15) * 512 + (pos >> 4)) * 64 + quad * 8;
          qf.a0 = *(const bf16x8*)qa; qf.a1 = *(const bf16x8*)(qa + 32); qf.b0 = *(const bf16x8*)qb; qf.b1 = *(const bf16x8*)(qb + 32); qf.c0 = *(const bf16x8*)qc; qf.c1 = *(const bf16x8*)(qc + 32); }
        f32x4 o[4];
#pragma unroll
        for (int dt = 0; dt < 4; ++dt) o[dt] = (f32x4){0.f, 0.f, 0.f, 0.f};
        float mrun = -1e30f, lrun = 0.f;
        u32x2 zpre[4];
#pragma unroll
        for (int dt = 0; dt < 4; ++dt) zpre[dt] = *(const u32x2*)(ZA + (size_t)tq * 512 + h * 64 + 16 * dt + 4 * quad);
        KVBuf b0, b1;
#define ATT_SB __builtin_amdgcn_sched_barrier(0);
        {
            const int wv = tid >> 6, region = wv >> 1;
            const bf16_t* gsrc = (region < 2 ? Kp + (size_t)(sq * 24 + h) * SEQL * 64 : Vt + (size_t)((sq * 3) * 8 + h) * 512 * 1024) + (wv & 1) * 512 + lane * 8;
            const int ubase = 256 * blk - 64 + (region & 1) * 16;
#define ATT_DMA(S) do { int uT = ubase + 32 * (S); if (uT < 0 || uT >= SEQL) uT = 0; \
                __builtin_amdgcn_global_load_lds((const unsigned*)(gsrc + (size_t)(uT >> 4) * 1024), (LAS unsigned*)(lds + (((S) >> 1) % 3) * 16384 + ((S) & 1) * 8192 + wv * 1024), 16, 0, 0); } while (0)
            ATT_DMA(0); ATT_DMA(1); ATT_DMA(2); ATT_DMA(3);
            const int kl = lane & 15;
            const unsigned foff = (unsigned)(quad * 256 + kl * 16), voff = (unsigned)(4096 + quad * 128 + kl * 8);
#pragma unroll 1
            for (int d = 0; d < 6; ++d) {
                if (d < 5) asm volatile("s_waitcnt vmcnt(2)" ::: "memory"); else asm volatile("s_waitcnt vmcnt(0)" ::: "memory");
                __syncthreads();
                if (d + 2 < 6) { ATT_DMA(2 * d + 4); ATT_DMA(2 * d + 5); }
                LAS unsigned char* kb = lds + (d % 3) * 16384;
                b0.kA0 = *(const LAS bf16x8*)(kb + foff); b0.kA1 = *(const LAS bf16x8*)(kb + foff + 1024); b0.kB0 = *(const LAS bf16x8*)(kb + 2048 + foff); b0.kB1 = *(const LAS bf16x8*)(kb + 2048 + foff + 1024);
                b1.kA0 = *(const LAS bf16x8*)(kb + 8192 + foff); b1.kA1 = *(const LAS bf16x8*)(kb + 8192 + foff + 1024); b1.kB0 = *(const LAS bf16x8*)(kb + 8192 + 2048 + foff); b1.kB1 = *(const LAS bf16x8*)(kb + 8192 + 2048 + foff + 1024);
#pragma unroll
                for (int dt = 0; dt < 4; ++dt) { b0.vA[dt] = *(const LAS bf16x4*)(kb + voff + dt * 512); b0.vB[dt] = *(const LAS bf16x4*)(kb + 2048 + voff + dt * 512);
                                                 b1.vA[dt] = *(const LAS bf16x4*)(kb + 8192 + voff + dt * 512); b1.vB[dt] = *(const LAS bf16x4*)(kb + 8192 + 2048 + voff + dt * 512); }
                attn_compute2<0>(b0, b1, qf.a0, qf.a1, o, mrun, lrun, 2 * d, blk, r, lane);
            }
#undef ATT_DMA
        }
        attn_load(b0, Kp, Vt, 12, sq, h, blk, r, lane);
#define ATT_LOOP(GI, S0, S1, QA, QB) _Pragma("unroll 1") for (int s = S0; s < S1; s += 2) { \
            ATT_SB attn_load(b1, Kp, Vt, s + 1, sq, h, blk, r, lane); ATT_SB attn_compute<GI>(b0, QA, QB, o, mrun, lrun, s, blk, r, lane); \
            ATT_SB attn_load(b0, Kp, Vt, s + 2, sq, h, blk, r, lane); ATT_SB attn_compute<GI>(b1, QA, QB, o, mrun, lrun, s + 1, blk, r, lane); ATT_SB }
        ATT_LOOP(1, 12, 18, qf.b0, qf.b1)
        ATT_LOOP(2, 18, 22, qf.c0, qf.c1)
#undef ATT_LOOP
        attn_compute<2>(b0, qf.c0, qf.c1, o, mrun, lrun, 22, blk, r, lane);
        const float l = quad_sum(lrun);
        float inv = 1.0f / l;
#ifdef DBG_ATT1
        for (int dt = 0; dt < 4; ++dt) o[dt] = (f32x4){1.f, 1.f, 1.f, 1.f};
#endif
#pragma unroll
        for (int dt = 0; dt < 4; ++dt) {
            const size_t off = (size_t)tq * 512 + h * 64 + 16 * dt + 4 * quad;
            const u32x2 z = zpre[dt];
            u32x2 w; w.x = cvt_pk_bf16(o[dt][0] * inv * bf_lo(z.x), o[dt][1] * inv * bf_hi(z.x)); w.y = cvt_pk_bf16(o[dt][2] * inv * bf_lo(z.y), o[dt][3] * inv * bf_hi(z.y));
            *(u32x2*)(GAO + off) = w;
        }
    }
}

__device__ __forceinline__ f32x2 cmul(f32x2 a, f32x2 b) { return (f32x2){a.x * b.x - a.y * b.y, a.x * b.y + a.y * b.x}; }
__device__ __forceinline__ void step_scan(const Args& a, LAS unsigned char* lds, int tid, int it0, int it1, int itstep) {
    unsigned char* ws = a.ws; const int G = gridDim.x;
    const float* PW = (const float*)(ws + WS_PW); const float* S = (const float*)(ws + WS_S); bf16_t* UH = (bf16_t*)(ws + WS_UH);
    LAS f32x2* carry = (LAS f32x2*)lds;
    for (int it = it0; it < it1; it += itstep) {
        const int dir = it & 1, g = (it >> 1) & 31, sq = it >> 6; const int seg = tid >> 6, n = tid & 63;
        const f32x2 P = (f32x2){PW[((dir * 32 + g) * 64 + n) * 2], PW[((dir * 32 + g) * 64 + n) * 2 + 1]};
        f32x2 z[32];
        { const int c0 = dir ? (NCH - 1 - seg * 32) : seg * 32; const long stp = dir ? -256 : 256;
          const float* sp = S + ((size_t)g * CHP + sq * NCH + c0) * 256 + dir * 128 + n;
#pragma unroll
          for (int i = 0; i < 32; ++i) { z[i] = (f32x2){sp[0], sp[64]}; sp += stp; } }
        f32x2 zz = (f32x2){0.f, 0.f};
#pragma unroll
        for (int i = 0; i < 32; ++i) { const f32x2 t = z[i]; z[i] = zz; zz = cmul(P, zz) + t; }
        __syncthreads();
        carry[seg * 64 + n] = zz;
        __syncthreads();
        f32x2 P32 = P;
#pragma unroll
        for (int k = 0; k < 5; ++k) P32 = cmul(P32, P32);
        f32x2 x = (f32x2){0.f, 0.f};
        for (int sp = 0; sp < seg; ++sp) x = cmul(P32, x) + carry[sp * 64 + n];
        f32x2 pwr = (f32x2){1.f, 0.f};
        { const int c0 = dir ? (NCH - 1 - seg * 32) : seg * 32; const long stp = dir ? -(long)UHK : (long)UHK;
          bf16_t* up = UH + ((size_t)g * CHP + sq * NCH + c0) * UHK + 512 + dir * 128 + n;
#pragma unroll
          for (int i = 0; i < 32; ++i) {
              const f32x2 hin = z[i] + cmul(pwr, x);
              up[0] = (bf16_t)(cvt_pk_bf16(hin.x, 0.f) & 0xffffu); up[64] = (bf16_t)(cvt_pk_bf16(hin.y, 0.f) & 0xffffu);
              pwr = cmul(pwr, P); up += stp;
          } }
    }
}

__device__ __forceinline__ void step_final_norm(const Args& a, int pass, int tid, int bx) {
    const int lane = tid & 63, wave = tid >> 6, G = gridDim.x;
    const f32x4* gr = (const f32x4*)a.in[16] + lane;
    f32x4 gv[4];
#pragma unroll
    for (int j = 0; j < 4; ++j) gv[j] = gr[64 * j];
    const bf16_t* accp = (const bf16_t*)(a.ws + WS_ACC);
    int row = bx * 8 + wave;
    f32x4 nx[4]; u32x2 na[4];
    if (row < TP) { const f32x4* xr = (const f32x4*)xrow_ptr(a.in[0], a.in[1], pass * TP + row) + lane; const u32x2* ar = (const u32x2*)(accp + (size_t)row * DM) + lane;
#pragma unroll
        for (int j = 0; j < 4; ++j) { nx[j] = __builtin_nontemporal_load(xr + 64 * j); na[j] = ar[64 * j]; } }
    for (; row < TP; row += G * 8) {
        f32x4 v[4];
#pragma unroll
        for (int j = 0; j < 4; ++j) v[j] = nx[j] + (f32x4){bf_lo(na[j].x), bf_hi(na[j].x), bf_lo(na[j].y), bf_hi(na[j].y)};
        const int nrow = row + G * 8;
        if (nrow < TP) { const f32x4* xn = (const f32x4*)xrow_ptr(a.in[0], a.in[1], pass * TP + nrow) + lane; const u32x2* an = (const u32x2*)(accp + (size_t)nrow * DM) + lane;
#pragma unroll
            for (int j = 0; j < 4; ++j) { nx[j] = __builtin_nontemporal_load(xn + 64 * j); na[j] = an[64 * j]; } }
        float s = 0.f;
#pragma unroll
        for (int j = 0; j < 4; ++j) s += (v[j].x * v[j].x + v[j].y * v[j].y) + (v[j].z * v[j].z + v[j].w * v[j].w);
        const float rstd = 1.0f / sqrtf(wave_sum(s) * (1.f / DM) + EPSN);
        f32x4* xr = (f32x4*)(a.out + (size_t)(pass * TP + row) * DM) + lane;
#pragma unroll
        for (int j = 0; j < 4; ++j) __builtin_nontemporal_store(v[j] * rstd * gv[j], xr + 64 * j);
    }
}


#define XB_TMO      128
#define XB_XCNT(j)  (256  + 64 * (j))
#define XB_XSUB(j)  (1280 + 64 * (j))
#define XB_XGEN(j)  (2304 + 64 * (j))
#define XB_TOP      3328
#define XB_TOPGEN   3392
#define XCD_BAR_WORDS 3456
#define XB_SLOT(b)  (4096 + 2 * (b))
#define XB_SPIN_CAP (1u << 18)
__device__ __forceinline__ unsigned xb_ld(unsigned* p)              { return __hip_atomic_load(p, __ATOMIC_RELAXED, __HIP_MEMORY_SCOPE_AGENT); }
__device__ __forceinline__ unsigned xb_add(unsigned* p, unsigned v) { return __hip_atomic_fetch_add(p, v, __ATOMIC_RELAXED, __HIP_MEMORY_SCOPE_AGENT); }
__device__ __forceinline__ unsigned xb_xcc_id() { return (unsigned)__builtin_amdgcn_s_getreg((3 << 11) | 20) & 0xFu; }
#define XB_SPIN(cond, bar) do { unsigned _sp = 0; while (cond) { __builtin_amdgcn_s_sleep(1); \
    if ((++_sp & 255u) == 0u) { if (xb_ld(&(bar)[XB_TMO])) break; if (_sp > XB_SPIN_CAP) { atomicAdd(&(bar)[XB_TMO], 1u); break; } } } } while (0)
__device__ __forceinline__ void xcd_barrier_complete(unsigned* bar, unsigned x, unsigned& nloc, unsigned& nx) {
    const unsigned G = gridDim.x;
    unsigned sum, cnt, mine, sp = 0u;
    for (;;) {
        sum = 0u; cnt = 0u; mine = 0u;
#pragma unroll
        for (unsigned j = 0; j < 16; ++j) { const unsigned c = xb_ld(&bar[XB_XCNT(j)]); sum += c; cnt += (c > 0u) ? 1u : 0u; mine = (j == x) ? c : mine; }
        if (sum == G) break;
        __builtin_amdgcn_s_sleep(1);
        if ((++sp & 255u) == 0u) { if (xb_ld(&bar[XB_TMO])) break; if (sp > XB_SPIN_CAP) { atomicAdd(&bar[XB_TMO], 1u); break; } }
    }
    nloc = mine > 0u ? mine : 1u; nx = cnt > 0u ? cnt : 1u;
}
__device__ __forceinline__ void xcd_barrier(unsigned* bar) {
    asm volatile("s_waitcnt vmcnt(0)" ::: "memory");
    __syncthreads();
    if (threadIdx.x == 0) {
        __builtin_amdgcn_s_waitcnt(0);
        const unsigned x = xb_xcc_id();
        unsigned* slot = bar + XB_SLOT(blockIdx.x);
        unsigned nloc = xb_ld(slot), nx = xb_ld(slot + 1);
        if (nloc == 0u) { xcd_barrier_complete(bar, x, nloc, nx); __hip_atomic_store(slot, nloc, __ATOMIC_RELAXED, __HIP_MEMORY_SCOPE_AGENT); __hip_atomic_store(slot + 1, nx, __ATOMIC_RELAXED, __HIP_MEMORY_SCOPE_AGENT); }
        const unsigned old = xb_add(&bar[XB_XSUB(x)], 1u);
        const unsigned gen = old / nloc;
        if (old + 1u == (gen + 1u) * nloc) {
            __builtin_amdgcn_fence(__ATOMIC_RELEASE, "agent");
            asm volatile("s_waitcnt vmcnt(0)" ::: "memory");
            const unsigned og = xb_add(&bar[XB_TOP], 1u);
            const unsigned tg = og / nx;
            if (og + 1u == (tg + 1u) * nx) xb_add(&bar[XB_TOPGEN], 1u);
            else XB_SPIN(xb_ld(&bar[XB_TOPGEN]) == tg, bar);
            __builtin_amdgcn_fence(__ATOMIC_ACQUIRE, "agent");
            xb_add(&bar[XB_XGEN(x)], 1u);
            asm volatile("s_waitcnt vmcnt(0)" ::: "memory");
        } else {
            XB_SPIN(xb_ld(&bar[XB_XGEN(x)]) == gen, bar);
            __builtin_amdgcn_fence(__ATOMIC_ACQUIRE, "agent");
            asm volatile("s_waitcnt vmcnt(0)" ::: "memory");
        }
    }
    __syncthreads();
}

constexpr int NSTEPS = 1 + 10 * NPASS;
__host__ __device__ __forceinline__ bool sync_after(int st) { if (st == 0) return true; const int k = (st - 1) % 10; return !(k == 1 || k == 6 || k == 9); }

__global__ void __launch_bounds__(512, 2) fwd_kernel(Args a) {
    extern __shared__ __attribute__((aligned(16))) unsigned char lds_raw[];
    LAS unsigned char* lds = (LAS unsigned char*)lds_raw;
    cg::grid_group grid = cg::this_grid();
    const int G = gridDim.x;
    unsigned char* ws = a.ws;
    unsigned* bar = (unsigned*)(ws + WS_BAR);
    if (a.do_sync == 2) grid.sync();
    if (a.do_sync && threadIdx.x == 0) (void)xb_add(&bar[XB_XCNT(xb_xcc_id())], 1u);
    for (int st = a.st_lo; st < a.st_hi; ++st) {
        int tid = threadIdx.x, bx = blockIdx.x;
        asm volatile("" : "+v"(tid), "+s"(bx));
#ifndef NO_SETUP
        if (st == 0) { step_setup(a, lds, tid, bx); }
#else
        if (st == 0) {}
#endif
        else {
            const int pass = (st - 1) / 10, k = (st - 1) % 10;
            GemmD g; g.lgnN = 0; g.pass = pass; g.nb = 1; g.sA = 0; g.sB = 0;
            bool has_gemm = true;
            const bool fz = (G == 256);
            const bool split_ay = false;
            const bf16_t* sgp = (const bf16_t*)((unsigned char*)a.out + OUT_HN_OFF) + (size_t)pass * TP * DM;
#define DESC_Y { g.A = (const bf16_t*)(ws + WS_UH); g.lda = UHK; g.sA = (unsigned)(CHP * UHK * 2); g.Bt = (const bf16_t*)(ws + WS_MTC); g.ldb = UHK; g.sB = (unsigned)(512 * UHK * 2); g.K = UHK; g.nM = CHP / BM; g.nN = 2; g.nb = 32; g.mode = MODE_Y; }
#define DESC_A { g.A = (const bf16_t*)(ws + WS_GAO); g.lda = 512; g.Bt = (const bf16_t*)(ws + WS_WA); g.ldb = 512; g.K = 512; g.nM = TP / BM; g.nN = 4; g.lgnN = 2; g.mode = MODE_A; }
#define DESC_GLU { g.A = sgp; g.lda = 512; g.Bt = (const bf16_t*)(ws + WS_WGLU); g.ldb = 512; g.K = 512; g.nM = TP / BM; g.nN = 2; g.lgnN = 1; g.mode = MODE_GLU; }
#define DESC_NONE { has_gemm = false; g.A = nullptr; g.Bt = nullptr; g.lda = g.ldb = g.K = 0; g.nM = g.nN = 0; g.mode = 0; }
            switch (k) {
            case 0: g.A = (const bf16_t*)((unsigned char*)a.out + OUT_HN_OFF) + (size_t)pass * TP * DM; g.lda = DM; g.Bt = (const bf16_t*)(ws + WS_WIN); g.ldb = DM; g.K = DM; g.nM = TP / BM; g.nN = INC / BM; g.lgnN = 5; g.mode = MODE_PROJ; break;
            case 1: g.A = (const bf16_t*)(ws + WS_UH); g.lda = UHK; g.sA = (unsigned)(CHP * UHK * 2); g.Bt = (const bf16_t*)(ws + WS_BST); g.ldb = 512; g.sB = (unsigned)(256 * 512 * 2); g.K = 512; g.nM = CHP / BM; g.nN = 1; g.nb = 32; g.mode = MODE_S; break;
            case 2: if (fz) DESC_Y else DESC_NONE break;
            case 4: if (fz) { if (bx < 128) DESC_A else DESC_GLU } else DESC_Y break;
            case 5: if (fz) DESC_NONE else DESC_GLU break;
            case 6: if (fz) DESC_NONE else DESC_A break;
            case 7: g.A = (const bf16_t*)(ws + WS_SB); g.lda = 512; g.Bt = (const bf16_t*)(ws + WS_WB); g.ldb = 512; g.K = 512; g.nM = TP / BM; g.nN = 4; g.lgnN = 2; g.mode = MODE_B; break;
            case 8: g.A = (const bf16_t*)(ws + WS_M1); g.lda = 1024; g.Bt = (const bf16_t*)(ws + WS_WOUT); g.ldb = 1024; g.K = 1024; g.nM = TP / BM; g.nN = 4; g.lgnN = 2; g.mode = MODE_OUT; break;
            default: DESC_NONE break;
            }
#undef DESC_Y
#undef DESC_A
#undef DESC_GLU
#undef DESC_NONE
            { const int total = g.nM * g.nN * g.nb; g.u0 = bx; g.ustride = G; g.ucount = total > bx ? (total - bx + G - 1) / G : 0; }
            if (fz && k == 2) { g.u0 = (bx / SEQP) * 6 + (bx % SEQP); g.ustride = SEQP; g.ucount = bx < SEQP * 32 ? 2 : 0; }
            if (fz && k == 4) { if (bx < 128) { g.u0 = bx; g.ustride = 128; g.ucount = 3; } else { g.u0 = bx - 128; g.ustride = 128; g.ucount = (bx - 128) < 64 ? 2 : 1; } }
            const bool fuse_scan = (G >= SEQP * 32);
            if (has_gemm) {
#ifndef NO_GEMM
                gemm_phase(a, lds, g, G, bx, tid);
#endif
#ifndef NO_SCAN
                if (k == 1 && fuse_scan && bx < SEQP * 32) {
                    asm volatile("s_waitcnt vmcnt(0)" ::: "memory"); __syncthreads();
                    const int it0 = (bx % SEQP) * 64 + (bx / SEQP) * 2;
                    step_scan(a, lds, tid, it0, it0 + 2, 1);
                    asm volatile("s_waitcnt vmcnt(0)" ::: "memory"); __syncthreads();
                }
#endif
            }
#ifndef NO_ATTN
            else if (k == (fz ? 3 : 2)) step_attention(a, lds, pass, tid, bx);
#endif
#ifndef NO_SCAN
            else if (k == 3 && !fz && !fuse_scan) step_scan(a, lds, tid, bx, SEQP * 32 * 2, G);
#endif
            else if (k == 9) step_final_norm(a, pass, tid, bx);
        }
        { bool need = sync_after(st) && !(st > 0 && (st - 1) % 10 == 3 && G >= SEQP * 32);
          if (G == 256 && st > 0) { const int kk = (st - 1) % 10; need = (kk == 0 || kk == 3 || kk == 4 || kk == 7 || kk == 8); }
          if (a.do_sync && st + 1 < a.st_hi && need) xcd_barrier(bar); }
    }
}

extern "C" void kernel_launch(void* const* d_in, const int* in_sizes, int n_in, void* d_out, int out_size, void* d_ws, size_t ws_size, hipStream_t stream) {
    constexpr int LDS_BYTES = STAGE_BYTES + 32768;
    static int grid = 0;
    if (grid == 0) {
        if (n_in != 17 || out_size != TTOK * DM || ws_size < WS_END) { fprintf(stderr, "kernel_launch: unexpected shapes (n_in %d out %d ws %zu need %zu)\n", n_in, out_size, ws_size, (size_t)WS_END); grid = -1; return; }
        int dev = 0, cus = 0, per_cu = 0;
        hipGetDevice(&dev); hipDeviceGetAttribute(&cus, hipDeviceAttributeMultiprocessorCount, dev);
        hipFuncSetAttribute((const void*)fwd_kernel, hipFuncAttributeMaxDynamicSharedMemorySize, LDS_BYTES);
        hipOccupancyMaxActiveBlocksPerMultiprocessor(&per_cu, (const void*)fwd_kernel, 512, LDS_BYTES);
        if (per_cu < 1) per_cu = 1;
        grid = cus * 1;
        (void)hipGetLastError();
    }
    if (grid < 0) return;
    (void)hipMemsetAsync((unsigned char*)d_ws + WS_BAR, 0, WS_BAR_BYTES + 4096, stream);
    Args a{};
    for (int i = 0; i < 17; ++i) a.in[i] = (const float*)d_in[i];
    a.out = (float*)d_out; a.ws = (unsigned char*)d_ws; a.pad = 0;
#ifndef MULTI_LAUNCH
#define MULTI_LAUNCH 0
#endif
#if MULTI_LAUNCH
    a.do_sync = 0;
    for (int st = 0; st < NSTEPS; ++st) {
        a.st_lo = st; a.st_hi = st + 1;
        hipLaunchKernelGGL(fwd_kernel, dim3(grid), dim3(512), LDS_BYTES, stream, a);
    }
#else
    a.do_sync = 1; a.st_lo = 0; a.st_hi = NSTEPS;
    void* args[] = {&a};
    hipError_t e = hipLaunchCooperativeKernel((const void*)fwd_kernel, dim3(grid), dim3(512), args, LDS_BYTES, stream);
    if (e != hipSuccess) fprintf(stderr, "cooperative launch failed: %s (grid %d)\n", hipGetErrorString(e), grid);
#endif
}
```

```cpp
#include <hip/hip_runtime.h>
#include <hip/hip_cooperative_groups.h>
#include <cstdio>

namespace cg = cooperative_groups;

#define LAS __attribute__((address_space(3)))
typedef unsigned short bf16_t;
typedef short bf16x8 __attribute__((ext_vector_type(8)));
typedef short bf16x4 __attribute__((ext_vector_type(4)));
typedef float f32x4 __attribute__((ext_vector_type(4)));
typedef float f32x2 __attribute__((ext_vector_type(2)));
typedef unsigned u32x4 __attribute__((ext_vector_type(4)));
typedef unsigned u32x2 __attribute__((ext_vector_type(2)));

constexpr int DM = 1024, SEQL = 8192, NSEQ = 6, TTOK = NSEQ * SEQL;
constexpr int NPASS = 2, SEQP = 3, TP = SEQP * SEQL;
constexpr int INC = 8192, QKVW = 1536;
constexpr int LC = 32, NCH = SEQL / LC  , CHP = SEQP * NCH  ;
constexpr int UHK = LC * 16 + 256;
constexpr float EPSN = 1e-6f;
constexpr float QSCALE = 0.18033688011112042f;

constexpr size_t AL(size_t x) { return (x + 255) & ~(size_t)255; }
constexpr size_t WS_WIN = 4096;
constexpr size_t WS_WGLU = WS_WIN + (size_t)INC * DM * 2;
constexpr size_t WS_WA = WS_WGLU + (size_t)512 * 512 * 2;
constexpr size_t WS_WB = WS_WA + (size_t)1024 * 512 * 2;
constexpr size_t WS_WOUT = WS_WB + (size_t)1024 * 512 * 2;
constexpr size_t WS_MTC = WS_WOUT + (size_t)1024 * 1024 * 2;
constexpr size_t WS_BST = WS_MTC + (size_t)32 * 512 * UHK * 2;
constexpr size_t WS_ROPE = WS_BST + (size_t)32 * 256 * 512 * 2;
constexpr size_t WS_PW = WS_ROPE + (size_t)2 * SEQL * 32 * 4;
constexpr size_t WS_KT = WS_PW + (size_t)2 * 32 * 64 * 8;
constexpr size_t WS_Q = WS_KT + (size_t)32 * 2 * 32 * 256 * 4;
constexpr size_t WS_K = WS_Q + (size_t)TP * QKVW * 2;
constexpr size_t WS_VT = WS_K + (size_t)TP * QKVW * 2;
constexpr size_t WS_ZA = WS_VT + (size_t)TP * QKVW * 2;
constexpr size_t WS_ZB = WS_ZA + (size_t)TP * 512 * 2;
constexpr size_t WS_GA = WS_ZB + (size_t)TP * 512 * 2;
constexpr size_t WS_GB = WS_GA + (size_t)TP * 1024 * 2;
constexpr size_t WS_UH = WS_GB + (size_t)TP * 1024 * 2;
constexpr size_t WS_S = WS_UH + (size_t)32 * CHP * UHK * 2;
constexpr size_t WS_GAO = WS_S + (size_t)32 * CHP * 256 * 4;
constexpr size_t WS_BAR = WS_GAO + (size_t)TP * 512 * 2;
constexpr size_t WS_BAR_BYTES = 32768;
constexpr size_t WS_CTL = WS_BAR + WS_BAR_BYTES;
constexpr size_t WS_END = WS_CTL + 4096;
constexpr size_t WS_SB = WS_Q + (size_t)TP * 512 * 2;
constexpr size_t WS_M1 = WS_K;
constexpr size_t WS_ACC = WS_Q;
constexpr size_t OUT_HN_OFF = (size_t)SEQP * SEQL * DM * 4;

struct Args {
    const float* in[17];
    float* out;
    unsigned char* ws;
    int st_lo, st_hi;
    int do_sync, pad;
};

typedef __bf16 bf16v2 __attribute__((ext_vector_type(2)));
__device__ __forceinline__ unsigned cvt_pk_bf16(float lo, float hi) { const f32x2 v = (f32x2){lo, hi}; const bf16v2 r = __builtin_convertvector(v, bf16v2); return __builtin_bit_cast(unsigned, r); }
__device__ __forceinline__ float bf_lo(unsigned w) { return __uint_as_float(w << 16); }
__device__ __forceinline__ float bf_hi(unsigned w) { return __uint_as_float(w & 0xffff0000u); }
__device__ __forceinline__ float fast_rcp(float x) { return __builtin_amdgcn_rcpf(x); }
__device__ __forceinline__ float sigmoidf_(float x) { return fast_rcp(1.0f + __builtin_amdgcn_exp2f(-1.4426950408889634f * x)); }
__device__ __forceinline__ float siluf_(float x) { return x * sigmoidf_(x); }
__device__ __forceinline__ float gelu_tanh(float x) { const float u = x * (1.5957691216057308f + 0.07135481627260025f * x * x); return x * sigmoidf_(u); }
__device__ __forceinline__ float wave_sum(float v) {
#pragma unroll
    for (int o = 1; o < 64; o <<= 1) v += __shfl_xor(v, o);
    return v;
}
__device__ __forceinline__ const float* xrow_ptr(const float* xp, const float* xs, int tg) {
    return tg < 4 * SEQL ? xp + (size_t)tg * DM : xs + (size_t)(tg - 4 * SEQL) * DM;
}

constexpr int BM = 256, BK = 64, HALF = 128, HTB = HALF * BK * 2, STAGE_BYTES = 8 * HTB, NXCD = 8, WGM = 8;
__host__ __device__ __forceinline__ int lds_byte(int r, int c) { const int st = (r >> 4) * 2 + (c >> 5), rr = r & 15, cc = c & 31, ob = rr * 64 + cc * 2; return st * 1024 + (ob ^ (((ob >> 9) & 1) << 5)); }
__host__ __device__ __forceinline__ void stage_rc(int b, int& R, int& C) { const int st = b / 1024, sb = b % 1024, swz = sb ^ (((sb >> 9) & 1) << 5); R = (st >> 1) * 16 + swz / 64; C = (st & 1) * 32 + (swz % 64) / 2; }
__host__ __device__ __forceinline__ int perm32(int rho) { const int n = rho >> 4, i = rho & 15; return 8 * (i >> 2) + 4 * n + (i & 3); }

enum { MODE_PROJ = 0, MODE_S = 1, MODE_Y = 2, MODE_GLU = 3, MODE_A = 4, MODE_B = 5, MODE_OUT = 6 };
struct Unit { int pm, pn, bz; };
struct GemmD {
    const bf16_t* A; const bf16_t* Bt;
    int lda, ldb, K, nM, nN, nb;
    unsigned sA, sB;
    int mode, pass, lgnN;
    int u0, ustride, ucount;
};
__device__ __forceinline__ bool unit_next(const GemmD& g, int i, int G, int c, int& pm, int& pn, int& bz) {
    const bool ok = i < g.ucount;
    const int Li = ok ? g.u0 + i * g.ustride : 0;
    if (g.nb == 1) {
        const int lg = g.lgnN, q = (g.nM << lg) >> 3;
        const int wgid = (Li & 7) * q + (Li >> 3);
        const int gid = wgid >> (3 + lg), rem = wgid & ((8 << lg) - 1);
        pm = gid * 8 + (rem & 7); pn = rem >> 3; bz = 0;
    } else {
        const int nwg = g.nM * g.nN;
        const int w = Li % nwg; bz = Li / nwg; pm = w % g.nM; pn = w / g.nM;
    }
    return ok;
}

__device__ __forceinline__ void epilogue(const Args& a, LAS unsigned char* lds, const GemmD& g, const f32x4 (&acc)[2][2][4][2], const Unit& u, int wr, int wc, int fr, int fq) {
    asm volatile("" : "+v"(fr), "+v"(fq));
    unsigned char* ws = a.ws;
    const int rbase = u.pm * BM + wr * 64 + fr;
    const int cl = wc * 32 + fq * 8;
    if (g.mode == MODE_PROJ) {
        const int pn = u.pn;
        if (pn < 12) {
            const bool isq = pn < 6;
            bf16_t* dst = (bf16_t*)(ws + (isq ? WS_Q : WS_K));
            const float* rc = (const float*)(ws + WS_ROPE); const float* rs = rc + SEQL * 32;
            const int a4 = 4 * (4 * (wc & 1) + fq);
            const int pq = isq ? pn : pn - 6, gi = pq >> 1, sh = 2 * gi, dmask = (1 << sh) - 1, Lg = SEQL >> sh;
            const float sc = isq ? QSCALE : 1.0f;
            const int pos0 = rbase & (SEQL - 1);
            const f32x4 cb = *(const f32x4*)(rc + pos0 * 32 + a4), sb = *(const f32x4*)(rs + pos0 * 32 + a4);
            const f32x4 c16 = *(const f32x4*)(rc + 16 * 32 + a4), s16 = *(const f32x4*)(rs + 16 * 32 + a4);
            const f32x4 c128 = *(const f32x4*)(rc + 128 * 32 + a4), s128 = *(const f32x4*)(rs + 128 * 32 + a4);
#pragma unroll
            for (int ai = 0; ai < 2; ++ai) {
                asm volatile("" ::: "memory");
                f32x4 cvv[4], svv[4];
                cvv[0] = ai ? cb * c128 - sb * s128 : cb; svv[0] = ai ? sb * c128 + cb * s128 : sb;
#pragma unroll
                for (int m = 1; m < 4; ++m) { cvv[m] = cvv[m - 1] * c16 - svv[m - 1] * s16; svv[m] = svv[m - 1] * c16 + cvv[m - 1] * s16; }
#pragma unroll
                for (int m = 0; m < 4; ++m) {
                    const int tl = rbase + ai * HALF + m * 16; const int pos = tl & (SEQL - 1), sq = tl >> 13;
                    const int kidx = (pos & dmask) * Lg + (pos >> sh);
                    const f32x4 cv = cvv[m] * sc, sv = svv[m] * sc;
#pragma unroll
                    for (int bj = 0; bj < 2; ++bj) {
                        const f32x4 x1 = acc[ai][bj][m][0], x2 = acc[ai][bj][m][1];
                        const f32x4 o1 = x1 * cv - x2 * sv, o2 = x2 * cv + x1 * sv;
                        const int head = pq * 4 + 2 * bj + (wc >> 1);
                        const int ch = 4 * (wc & 1) + fq;
                        bf16_t* p = dst + (size_t)(sq * 24 + head) * SEQL * 64 + (isq ? (size_t)kidx * 64 + ch * 8 : (size_t)(kidx >> 4) * 1024 + ch * 128 + (kidx & 15) * 8);
                        u32x4 w; w.x = cvt_pk_bf16(o1[0], o1[1]); w.y = cvt_pk_bf16(o1[2], o1[3]); w.z = cvt_pk_bf16(o2[0], o2[1]); w.w = cvt_pk_bf16(o2[2], o2[3]);
                        *(u32x4*)p = w;
                    }
                }
            }
        } else if (pn < 18) {
            bf16_t* dst = (bf16_t*)(ws + WS_VT);
            const int gi = (pn - 12) >> 1, sh = 2 * gi;
            const int wid = wr * 4 + wc, lane = fq * 16 + fr;
            LAS bf16_t* tile = (LAS bf16_t*)(lds + STAGE_BYTES + wid * 4096);
#pragma unroll
            for (int ai = 0; ai < 2; ++ai) {
                const int tl0 = u.pm * BM + wr * 64 + ai * HALF;
                const int pos0 = tl0 & (SEQL - 1), sq = tl0 >> 13;
#pragma unroll
                for (int bj = 0; bj < 2; ++bj) {
                    asm volatile("" ::: "memory");
                    const int h = (4 * (pn - 12) + 2 * bj + (wc >> 1)) & 7;
#pragma unroll
                    for (int m = 0; m < 4; ++m) {
                        const int t = 16 * m + fr;
                        const int slot = gi == 0 ? t : (gi == 1 ? ((t & 3) * 16 + (t >> 2)) : ((t & 15) * 4 + (t >> 4)));
#pragma unroll
                        for (int n = 0; n < 2; ++n)
#pragma unroll
                            for (int j = 0; j < 4; ++j) { const unsigned w = cvt_pk_bf16(acc[ai][bj][m][n][j], 0.f); tile[(8 * fq + 4 * n + j) * 64 + slot] = (bf16_t)(w & 0xffffu); }
                    }
                    bf16_t* hb0 = dst + (size_t)(((sq * 3 + gi) * 8 + h) * 512) * 1024;
#pragma unroll
                    for (int i = 0; i < 4; ++i) {
                        const int c = lane + 64 * i, d = c & 31, s8 = (c >> 5) * 8;
                        const u32x4 v = *(const LAS u32x4*)(tile + d * 64 + s8);
                        const int dg = 32 * (wc & 1) + d; const int doff = (dg >> 4) * 256 + (dg & 15) * 4;
                        if (gi == 0) { const int kidx = pos0 + s8; bf16_t* q = hb0 + (size_t)(kidx >> 4) * 1024 + doff + ((kidx & 15) >> 2) * 64; *(u32x2*)q = (u32x2){v.x, v.y}; *(u32x2*)(q + 64) = (u32x2){v.z, v.w}; }
                        else if (gi == 1) { const int kidx = (s8 >> 4) * 2048 + (pos0 >> 2) + (s8 & 15); bf16_t* q = hb0 + (size_t)(kidx >> 4) * 1024 + doff + ((kidx & 15) >> 2) * 64; *(u32x2*)q = (u32x2){v.x, v.y}; *(u32x2*)(q + 64) = (u32x2){v.z, v.w}; }
                        else { const int ka = (s8 >> 2) * 512 + (pos0 >> 4), kb = ka + 512;
                            *(u32x2*)(hb0 + (size_t)(ka >> 4) * 1024 + doff + ((ka & 15) >> 2) * 64) = (u32x2){v.x, v.y}; *(u32x2*)(hb0 + (size_t)(kb >> 4) * 1024 + doff + ((kb & 15) >> 2) * 64) = (u32x2){v.z, v.w}; }
                    }
                }
            }
        } else if (pn == 20 || pn == 21) {
            bf16_t* dst = (bf16_t*)(ws + WS_UH);
#pragma unroll
            for (int ai = 0; ai < 2; ++ai)
#pragma unroll
                for (int m = 0; m < 4; ++m) { asm volatile("" ::: "memory");
                    const int tl = rbase + ai * HALF + m * 16;
#pragma unroll
                    for (int bj = 0; bj < 2; ++bj) {
                        const int gg = 16 * (pn - 20) + 8 * bj + 2 * wc + (fq >> 1);
                        bf16_t* p = dst + ((size_t)(gg * CHP + (tl >> 5)) * UHK) + (tl & 31) * 16 + 8 * (fq & 1);
                        const f32x4 v0 = acc[ai][bj][m][0], v1 = acc[ai][bj][m][1];
                        u32x4 w; w.x = cvt_pk_bf16(v0[0], v0[1]); w.y = cvt_pk_bf16(v0[2], v0[3]); w.z = cvt_pk_bf16(v1[0], v1[1]); w.w = cvt_pk_bf16(v1[2], v1[3]);
                        *(u32x4*)p = w;
                    }
                }
        } else {
            bf16_t* dst; int ld, c0; bool silu;
            if (pn < 20) { dst = (bf16_t*)(ws + WS_ZA); ld = 512; c0 = (pn - 18) * 256; silu = true; }
            else if (pn < 24) { dst = (bf16_t*)(ws + WS_ZB); ld = 512; c0 = (pn - 22) * 256; silu = true; }
            else if (pn < 28) { dst = (bf16_t*)(ws + WS_GA); ld = 1024; c0 = (pn - 24) * 256; silu = false; }
            else { dst = (bf16_t*)(ws + WS_GB); ld = 1024; c0 = (pn - 28) * 256; silu = false; }
#pragma unroll
            for (int ai = 0; ai < 2; ++ai)
#pragma unroll
                for (int m = 0; m < 4; ++m) { asm volatile("" ::: "memory");
                    const int tl = rbase + ai * HALF + m * 16;
#pragma unroll
                    for (int bj = 0; bj < 2; ++bj) {
                        f32x4 v0 = acc[ai][bj][m][0], v1 = acc[ai][bj][m][1];
#pragma unroll
                        for (int j = 0; j < 4; ++j) { const float s0 = sigmoidf_(v0[j]), s1 = sigmoidf_(v1[j]); v0[j] = silu ? v0[j] * s0 : s0; v1[j] = silu ? v1[j] * s1 : s1; }
                        u32x4 w; w.x = cvt_pk_bf16(v0[0], v0[1]); w.y = cvt_pk_bf16(v0[2], v0[3]); w.z = cvt_pk_bf16(v1[0], v1[1]); w.w = cvt_pk_bf16(v1[2], v1[3]);
                        *(u32x4*)(dst + (size_t)tl * ld + c0 + cl + bj * HALF) = w;
                    }
                }
        }
    } else if (g.mode == MODE_S) {
        float* dst = (float*)(ws + WS_S) + (size_t)u.bz * CHP * 256;
#pragma unroll
        for (int ai = 0; ai < 2; ++ai)
#pragma unroll
            for (int m = 0; m < 4; ++m) { asm volatile("" ::: "memory");
                const int r = rbase + ai * HALF + m * 16;
#pragma unroll
                for (int bj = 0; bj < 2; ++bj) { float* p = dst + (size_t)r * 256 + cl + bj * HALF; *(f32x4*)p = acc[ai][bj][m][0]; *(f32x4*)(p + 4) = acc[ai][bj][m][1]; }
            }
    } else if (g.mode == MODE_Y) {
        bf16_t* dst = (bf16_t*)((unsigned char*)a.out + OUT_HN_OFF) + (size_t)g.pass * TP * DM;
#pragma unroll
        for (int ai = 0; ai < 2; ++ai)
#pragma unroll
            for (int m = 0; m < 4; ++m) { asm volatile("" ::: "memory");
                const int r = rbase + ai * HALF + m * 16;
#pragma unroll
                for (int bj = 0; bj < 2; ++bj) {
                    const int t = 16 * u.pn + 8 * bj + 2 * wc + (fq >> 1);
                    f32x4 v0 = acc[ai][bj][m][0], v1 = acc[ai][bj][m][1];
#pragma unroll
                    for (int j = 0; j < 4; ++j) { v0[j] = gelu_tanh(v0[j]); v1[j] = gelu_tanh(v1[j]); }
                    u32x4 w; w.x = cvt_pk_bf16(v0[0], v0[1]); w.y = cvt_pk_bf16(v0[2], v0[3]); w.z = cvt_pk_bf16(v1[0], v1[1]); w.w = cvt_pk_bf16(v1[2], v1[3]);
                    *(u32x4*)(dst + (size_t)(r * LC + t) * 512 + u.bz * 16 + 8 * (fq & 1)) = w;
                }
            }
    } else if (g.mode == MODE_GLU) {
        const bf16_t* sg = (const bf16_t*)((unsigned char*)a.out + OUT_HN_OFF) + (size_t)g.pass * TP * DM; const bf16_t* zb = (const bf16_t*)(ws + WS_ZB); bf16_t* dst = (bf16_t*)(ws + WS_SB);
        u32x4 sq4[2][2][2], zq4[2][2][2];
#define EPI_LD(ST, BUF) _Pragma("unroll") for (int m2 = 0; m2 < 2; ++m2) _Pragma("unroll") for (int bj = 0; bj < 2; ++bj) { \
            const size_t off = (size_t)(rbase + ((ST) >> 1) * HALF + (2 * ((ST) & 1) + m2) * 16) * 512 + u.pn * BM + cl + bj * HALF; sq4[BUF][m2][bj] = *(const u32x4*)(sg + off); zq4[BUF][m2][bj] = *(const u32x4*)(zb + off); }
        EPI_LD(0, 0)
#pragma unroll
        for (int st = 0; st < 4; ++st) {
            if (st == 0) EPI_LD(1, 1) else if (st == 1) EPI_LD(2, 0) else if (st == 2) EPI_LD(3, 1)
            const int ai = st >> 1, buf = st & 1;
#pragma unroll
            for (int m2 = 0; m2 < 2; ++m2)
#pragma unroll
                for (int bj = 0; bj < 2; ++bj) {
                    const int m = 2 * (st & 1) + m2;
                    const size_t off = (size_t)(rbase + ai * HALF + m * 16) * 512 + u.pn * BM + cl + bj * HALF;
                    const u32x4 s4 = sq4[buf][m2][bj], z4 = zq4[buf][m2][bj];
                    const f32x4 v0 = acc[ai][bj][m][0], v1 = acc[ai][bj][m][1];
                    u32x4 w;
                    w.x = cvt_pk_bf16(bf_lo(s4.x) * sigmoidf_(v0[0]) * bf_lo(z4.x), bf_hi(s4.x) * sigmoidf_(v0[1]) * bf_hi(z4.x));
                    w.y = cvt_pk_bf16(bf_lo(s4.y) * sigmoidf_(v0[2]) * bf_lo(z4.y), bf_hi(s4.y) * sigmoidf_(v0[3]) * bf_hi(z4.y));
                    w.z = cvt_pk_bf16(bf_lo(s4.z) * sigmoidf_(v1[0]) * bf_lo(z4.z), bf_hi(s4.z) * sigmoidf_(v1[1]) * bf_hi(z4.z));
                    w.w = cvt_pk_bf16(bf_lo(s4.w) * sigmoidf_(v1[2]) * bf_lo(z4.w), bf_hi(s4.w) * sigmoidf_(v1[3]) * bf_hi(z4.w));
                    *(u32x4*)(dst + off) = w;
                }
        }
#undef EPI_LD
    } else if (g.mode == MODE_A || g.mode == MODE_B) {
        const bool isb = g.mode == MODE_B;
        const bf16_t* gt = (const bf16_t*)(ws + (isb ? WS_GB : WS_GA)); bf16_t* dst = (bf16_t*)(ws + WS_M1);
        u32x4 gq4[2][2][2], pq4[2][2][2];
#define EPI_LD(ST, BUF) _Pragma("unroll") for (int m2 = 0; m2 < 2; ++m2) _Pragma("unroll") for (int bj = 0; bj < 2; ++bj) { \
            const size_t off = (size_t)(rbase + ((ST) >> 1) * HALF + (2 * ((ST) & 1) + m2) * 16) * 1024 + u.pn * BM + cl + bj * HALF; gq4[BUF][m2][bj] = *(const u32x4*)(gt + off); \
            pq4[BUF][m2][bj] = (u32x4){0u, 0u, 0u, 0u}; if (isb) pq4[BUF][m2][bj] = *(const u32x4*)(dst + off); }
        EPI_LD(0, 0)
#pragma unroll
        for (int st = 0; st < 4; ++st) {
            if (st == 0) EPI_LD(1, 1) else if (st == 1) EPI_LD(2, 0) else if (st == 2) EPI_LD(3, 1)
            const int ai = st >> 1, buf = st & 1;
#pragma unroll
            for (int m2 = 0; m2 < 2; ++m2)
#pragma unroll
                for (int bj = 0; bj < 2; ++bj) {
                    const int m = 2 * (st & 1) + m2;
                    const size_t off = (size_t)(rbase + ai * HALF + m * 16) * 1024 + u.pn * BM + cl + bj * HALF;
                    const u32x4 g4 = gq4[buf][m2][bj], p4 = pq4[buf][m2][bj];
                    const f32x4 v0 = acc[ai][bj][m][0], v1 = acc[ai][bj][m][1];
                    u32x4 w;
                    w.x = cvt_pk_bf16(bf_lo(p4.x) + bf_lo(g4.x) * v0[0], bf_hi(p4.x) + bf_hi(g4.x) * v0[1]);
                    w.y = cvt_pk_bf16(bf_lo(p4.y) + bf_lo(g4.y) * v0[2], bf_hi(p4.y) + bf_hi(g4.y) * v0[3]);
                    w.z = cvt_pk_bf16(bf_lo(p4.z) + bf_lo(g4.z) * v1[0], bf_hi(p4.z) + bf_hi(g4.z) * v1[1]);
                    w.w = cvt_pk_bf16(bf_lo(p4.w) + bf_lo(g4.w) * v1[2], bf_hi(p4.w) + bf_hi(g4.w) * v1[3]);
                    *(u32x4*)(dst + off) = w;
                }
        }
#undef EPI_LD
    } else {
        bf16_t* dst = (bf16_t*)(ws + WS_ACC);
#pragma unroll
        for (int ai = 0; ai < 2; ++ai)
#pragma unroll
            for (int m = 0; m < 4; ++m) {
                const int tl = rbase + ai * HALF + m * 16;
#pragma unroll
                for (int bj = 0; bj < 2; ++bj) {
                    const f32x4 v0 = acc[ai][bj][m][0], v1 = acc[ai][bj][m][1];
                    u32x4 w; w.x = cvt_pk_bf16(v0[0], v0[1]); w.y = cvt_pk_bf16(v0[2], v0[3]); w.z = cvt_pk_bf16(v1[0], v1[1]); w.w = cvt_pk_bf16(v1[2], v1[3]);
                    *(u32x4*)(dst + (size_t)tl * DM + u.pn * BM + cl + bj * HALF) = w;
                }
            }
    }
}

__device__ __forceinline__ void gemm_phase(const Args& a, LAS unsigned char* lds, const GemmD& g, int G, int cidx, int tid) {
    const int wid = __builtin_amdgcn_readfirstlane(tid >> 6), lane = tid & 63, wr = wid >> 2, wc = wid & 3, fr = lane & 15, fq = lane >> 4;
    const int K = g.K, nt = K / BK;
    unsigned voffA[2], voffB[2];
#pragma unroll
    for (int i = 0; i < 2; ++i) { int R, C; stage_rc(tid * 16 + i * 8192, R, C); const int Rb = (R & ~31) + perm32(R & 31);
        voffA[i] = (unsigned)(R * g.lda + C) * 2u; voffB[i] = (unsigned)(Rb * g.ldb + C) * 2u; }
    const size_t kstep = (size_t)(BK * 2);
    const size_t hstepA = (size_t)HALF * g.lda * 2, hstepB = (size_t)HALF * g.ldb * 2;
    const size_t tstepA = 2 * hstepA, tstepB = 2 * hstepB;
    const unsigned ldsw = (unsigned)wid * 1024u;
    const int aoff = lds_byte(wr * 64 + fr, fq * 8), boff = lds_byte(wc * 32 + fr, fq * 8);
#define PG8_SA(b, h) (((b) * 2 + (h)) * HTB)
#define PG8_SB(b, h) ((4 + (b) * 2 + (h)) * HTB)
#define PG8_STAGE(bufoff, gbase, voff) do { _Pragma("unroll") for (int _i = 0; _i < 2; ++_i) \
        __builtin_amdgcn_global_load_lds((const unsigned*)((const char*)(gbase) + (voff)[_i]), (LAS unsigned*)(lds + (bufoff) + ldsw + _i * 8192), 16, 0, 0); } while (0)
#define PG8_LDA(dst, b, h) do { _Pragma("unroll") for (int m = 0; m < 4; ++m) _Pragma("unroll") for (int k = 0; k < 2; ++k) dst[m][k] = *(const LAS bf16x8*)(lds + PG8_SA(b, h) + aoff + m * 2048 + k * 1024); } while (0)
#define PG8_LDB(dst, b, h) do { _Pragma("unroll") for (int n = 0; n < 2; ++n) _Pragma("unroll") for (int k = 0; k < 2; ++k) dst[n][k] = *(const LAS bf16x8*)(lds + PG8_SB(b, h) + boff + n * 2048 + k * 1024); } while (0)
#define PG8_MMA(ai, bj, At, Bt) do { __builtin_amdgcn_s_setprio(1); _Pragma("unroll") for (int m = 0; m < 4; ++m) _Pragma("unroll") for (int n = 0; n < 2; ++n) _Pragma("unroll") for (int k = 0; k < 2; ++k) \
        acc[ai][bj][m][n] = __builtin_amdgcn_mfma_f32_16x16x32_bf16(Bt[n][k], At[m][k], acc[ai][bj][m][n], 0, 0, 0); __builtin_amdgcn_s_setprio(0); } while (0)
#define PG8_WAIT_V(n) asm volatile("s_waitcnt vmcnt(" #n ")" ::: "memory")
#define PG8_WAIT_L(n) asm volatile("s_waitcnt lgkmcnt(" #n ")" ::: "memory")
#define PG8_BAR __builtin_amdgcn_s_barrier()
#define PG8_SCHED __builtin_amdgcn_sched_barrier(0)
    Unit cur, nxt; int ui = 0;
    { int pm_, pn_, bz_; if (!unit_next(g, 0, G, cidx, pm_, pn_, bz_)) return; cur.pm = pm_; cur.pn = pn_; cur.bz = bz_; }
    f32x4 acc[2][2][4][2];
#pragma unroll
    for (int a = 0; a < 2; ++a)
#pragma unroll
        for (int b = 0; b < 2; ++b)
#pragma unroll
            for (int m = 0; m < 4; ++m)
#pragma unroll
                for (int n = 0; n < 2; ++n) acc[a][b][m][n] = (f32x4){0.f, 0.f, 0.f, 0.f};
    bf16x8 At[4][2], B0[2][2], B1[2][2];
    const char* cA = (const char*)g.A + (size_t)cur.bz * g.sA + (size_t)cur.pm * tstepA; const char* cB = (const char*)g.Bt + (size_t)cur.bz * g.sB + (size_t)cur.pn * tstepB;
    PG8_STAGE(PG8_SB(0, 0), cB, voffB); PG8_STAGE(PG8_SA(0, 0), cA, voffA); PG8_STAGE(PG8_SB(0, 1), cB + hstepB, voffB); PG8_STAGE(PG8_SA(0, 1), cA + hstepA, voffA);
    if (wr == 1) PG8_BAR;
    PG8_WAIT_V(4); PG8_BAR;
    PG8_STAGE(PG8_SB(1, 0), cB + kstep, voffB); PG8_STAGE(PG8_SA(1, 0), cA + kstep, voffA); PG8_STAGE(PG8_SB(1, 1), cB + hstepB + kstep, voffB);
    PG8_WAIT_V(6); PG8_BAR;
    for (;;) {
        int npm, npn, nbz; const bool has_next = unit_next(g, ui + 1, G, cidx, npm, npn, nbz); nxt.pm = npm; nxt.pn = npn; nxt.bz = nbz;
        const char* nA = has_next ? (const char*)g.A + (size_t)nxt.bz * g.sA + (size_t)nxt.pm * tstepA : cA; const char* nB = has_next ? (const char*)g.Bt + (size_t)nxt.bz * g.sB + (size_t)nxt.pn * tstepB : cB;
        for (int t = 0; t < nt; t += 2) {
            const bool last = (t == nt - 2);
            const char* a1 = cA + (size_t)(t + 1) * kstep;
            const char* a2 = last ? nA : cA + (size_t)(t + 2) * kstep; const char* b2 = last ? nB : cB + (size_t)(t + 2) * kstep;
            const char* a3 = a2 + kstep; const char* b3 = b2 + kstep;
            PG8_LDB(B0, 0, 0); PG8_SCHED; PG8_LDA(At, 0, 0); PG8_STAGE(PG8_SA(1, 1), a1 + hstepA, voffA);
            PG8_WAIT_L(8); PG8_BAR; PG8_WAIT_L(0); PG8_MMA(0, 0, At, B0); PG8_BAR; PG8_SCHED;
            PG8_LDB(B1, 0, 1); PG8_STAGE(PG8_SB(0, 0), b2, voffB);
            PG8_BAR; PG8_WAIT_L(0); PG8_MMA(0, 1, At, B1); PG8_BAR;
            PG8_LDA(At, 0, 1); PG8_STAGE(PG8_SA(0, 0), a2, voffA);
            PG8_BAR; PG8_WAIT_L(0); PG8_MMA(1, 0, At, B0); PG8_BAR; PG8_SCHED;
            PG8_STAGE(PG8_SB(0, 1), b2 + hstepB, voffB);
            PG8_WAIT_V(6); PG8_BAR; PG8_MMA(1, 1, At, B1); PG8_BAR;
            PG8_LDB(B0, 1, 0); PG8_SCHED; PG8_LDA(At, 1, 0); PG8_STAGE(PG8_SA(0, 1), a2 + hstepA, voffA);
            PG8_WAIT_L(8); PG8_BAR; PG8_WAIT_L(0); PG8_MMA(0, 0, At, B0); PG8_BAR; PG8_SCHED;
            PG8_LDB(B1, 1, 1); PG8_STAGE(PG8_SB(1, 0), b3, voffB);
            PG8_BAR; PG8_WAIT_L(0); PG8_MMA(0, 1, At, B1); PG8_BAR;
            PG8_LDA(At, 1, 1); PG8_STAGE(PG8_SA(1, 0), a3, voffA);
            PG8_BAR; PG8_WAIT_L(0); PG8_MMA(1, 0, At, B0); PG8_BAR; PG8_SCHED;
            PG8_STAGE(PG8_SB(1, 1), b3 + hstepB, voffB);
            PG8_WAIT_V(6); PG8_BAR; PG8_MMA(1, 1, At, B1); PG8_BAR;
        }
#ifndef NO_EPI
        epilogue(a, lds, g, acc, cur, wr, wc, fr, fq);
#else
        if (g.mode == 99) *(f32x4*)(g.out) = acc[0][0][0][0] + acc[1][1][3][1] + acc[0][1][2][0]+acc[1][0][1][1];
#endif
        if (!has_next) break;
#pragma unroll
        for (int a = 0; a < 2; ++a)
#pragma unroll
            for (int b = 0; b < 2; ++b)
#pragma unroll
                for (int m = 0; m < 4; ++m)
#pragma unroll
                    for (int n = 0; n < 2; ++n) acc[a][b][m][n] = (f32x4){0.f, 0.f, 0.f, 0.f};
        cur = nxt; cA = nA; cB = nB; ++ui;
    }
    PG8_WAIT_V(0);
    if (wr == 0) PG8_BAR;
    PG8_BAR;
#undef PG8_SA
#undef PG8_SB
#undef PG8_STAGE
#undef PG8_LDA
#undef PG8_LDB
#undef PG8_MMA
#undef PG8_WAIT_V
#undef PG8_WAIT_L
#undef PG8_BAR
#undef PG8_SCHED
}

__device__ __forceinline__ int qk_perm_row(int n) { const int i = n & 63; return (n & ~63) + 8 * ((i & 31) >> 2) + (i & 3) + 4 * (i >> 5); }
__device__ __forceinline__ void transpose_item(const float* W, int K, int N, bf16_t* WT, bool permqk, LAS float* scr, int item, int lane) {
    const int nblk = N / 32, kb = item / nblk, nb = item % nblk, k0 = 64 * kb, n0 = 32 * nb;
#pragma unroll 8
    for (int i = 0; i < 32; ++i) { const int kk = 2 * i + (lane >> 5); scr[kk * 33 + (lane & 31)] = W[(size_t)(k0 + kk) * N + n0 + (lane & 31)]; }
    asm volatile("s_waitcnt lgkmcnt(0)" ::: "memory");
    const int c = lane & 7;
#pragma unroll
    for (int j = 0; j < 4; ++j) { const int n = (lane >> 3) + 8 * j; const LAS float* s = scr + (8 * c) * 33 + n;
        u32x4 o; o.x = cvt_pk_bf16(s[0 * 33], s[1 * 33]); o.y = cvt_pk_bf16(s[2 * 33], s[3 * 33]); o.z = cvt_pk_bf16(s[4 * 33], s[5 * 33]); o.w = cvt_pk_bf16(s[6 * 33], s[7 * 33]);
        int row = n0 + n; if (permqk && row < 2 * QKVW) row = qk_perm_row(row);
        *(u32x4*)(WT + (size_t)row * K + k0 + 8 * c) = o; }
    asm volatile("s_waitcnt lgkmcnt(0)" ::: "memory");
}
__device__ __forceinline__ void reduce_angle(double a, float& c, float& s) {
    const double k = __builtin_rint(a * 0.6366197723675814); const float x = (float)(a - k * 1.5707963267948966), x2 = x * x;
    const float sn = x * (1.0f + x2 * (-1.6666666667e-1f + x2 * (8.3333333333e-3f + x2 * (-1.9841269841e-4f + x2 * 2.7557319224e-6f))));
    const float cs = 1.0f + x2 * (-0.5f + x2 * (4.1666666667e-2f + x2 * (-1.3888888889e-3f + x2 * (2.4801587302e-5f + x2 * -2.7557319224e-7f))));
    const int q = ((int)k) & 3;
    c = (q == 0) ? cs : (q == 1) ? -sn : (q == 2) ? -cs : sn;
    s = (q == 0) ? sn : (q == 1) ? cs : (q == 2) ? -sn : -cs;
}
__device__ __forceinline__ void rms_row_to_bf16(const float* xrow, const float* gw, bf16_t* orow, int lane) {
    const f32x4* xr = (const f32x4*)xrow + lane; const f32x4* gr = (const f32x4*)gw + lane;
    f32x4 v[4]; float s = 0.f;
#pragma unroll
    for (int j = 0; j < 4; ++j) { v[j] = xr[64 * j]; s += (v[j].x * v[j].x + v[j].y * v[j].y) + (v[j].z * v[j].z + v[j].w * v[j].w); }
    const float rstd = 1.0f / sqrtf(wave_sum(s) * (1.f / DM) + EPSN);
    u32x2* o8 = (u32x2*)orow + lane;
#pragma unroll
    for (int j = 0; j < 4; ++j) { const f32x4 gv = gr[64 * j]; u32x2 w; w.x = cvt_pk_bf16(v[j].x * rstd * gv.x, v[j].y * rstd * gv.y); w.y = cvt_pk_bf16(v[j].z * rstd * gv.z, v[j].w * rstd * gv.w); o8[64 * j] = w; }
}

__device__ __forceinline__ void ssm_load_bc(const Args& a, int g, int dir, LAS f32x2* Bb, LAS f32x2* Cc, int tid) {
    const float* lam_re = a.in[4]; const float* lam_im = a.in[5]; const float* log_step = a.in[6];
    const float* b_re = a.in[7]; const float* b_im = a.in[8]; const float* c_re = a.in[9]; const float* c_im = a.in[10];
    const float dt = expf(log_step[dir * 32 + g]);
    for (int idx = tid; idx < 1024; idx += 512) {
        { const int n = idx >> 4; const float lr = lam_re[(dir * 32 + g) * 64 + n], li = lam_im[(dir * 32 + g) * 64 + n];
          const float ar = lr * dt; float cb, sb, ch, sh; reduce_angle((double)li * (double)dt, cb, sb); reduce_angle(0.5 * (double)li * (double)dt, ch, sh);
          const float em1 = expm1f(ar), ea = em1 + 1.0f;
          const float nr = em1 * cb - 2.0f * sh * sh, ni = ea * sb;
          const float den = 1.0f / (lr * lr + li * li); const float cr = (nr * lr + ni * li) * den, ci = (ni * lr - nr * li) * den;
          const float br = b_re[(size_t)((dir * 32 + g) * 64) * 16 + idx], bi = b_im[(size_t)((dir * 32 + g) * 64) * 16 + idx];
          Bb[idx] = (f32x2){cr * br - ci * bi, cr * bi + ci * br}; }
        { Cc[idx] = (f32x2){c_re[(size_t)((dir * 32 + g) * 16) * 64 + idx], c_im[(size_t)((dir * 32 + g) * 16) * 64 + idx]}; }
    }
}
__device__ __forceinline__ void ssm_setup_item(const Args& a, LAS unsigned char* lds, int item, int tid) {
    const int g = item >> 1, dir = item & 1;
    LAS f32x2* pw = (LAS f32x2*)lds; LAS f32x2* Bb = pw + 33 * 64; LAS f32x2* Cc = Bb + 1024;
    LAS float* KT = (LAS float*)(Cc + 1024); LAS float* K0 = KT + 32 * 256; LAS f32x2* Bb0 = (LAS f32x2*)(K0 + 256); LAS f32x2* Cc0 = Bb0 + 1024;
    const float* lam_re = a.in[4]; const float* lam_im = a.in[5]; const float* log_step = a.in[6];
    unsigned char* ws = a.ws;
    const float dt = expf(log_step[dir * 32 + g]);
    __syncthreads();
    for (int idx = tid; idx < 33 * 64; idx += 512) {
        const int tau = idx >> 6, n = idx & 63; const float lr = lam_re[(dir * 32 + g) * 64 + n], li = lam_im[(dir * 32 + g) * 64 + n];
        const float mag = expf(lr * dt * (float)tau); float c, s; reduce_angle((double)li * (double)dt * (double)tau, c, s);
        pw[idx] = (f32x2){mag * c, mag * s};
    }
    ssm_load_bc(a, g, dir, Bb, Cc, tid);
    if (dir == 1) ssm_load_bc(a, g, 0, Bb0, Cc0, tid);
    __syncthreads();
    if (tid < 64) { float* PW = (float*)(ws + WS_PW); const f32x2 p = pw[32 * 64 + tid]; PW[((dir * 32 + g) * 64 + tid) * 2] = p.x; PW[((dir * 32 + g) * 64 + tid) * 2 + 1] = p.y; }
    for (int o = tid; o < 32 * 256; o += 512) {
        const int tau = o >> 8, co = (o >> 4) & 15, ci = o & 15; float acc = 0.f;
_Pragma("unroll 4")
        for (int n = 0; n < 64; ++n) { const f32x2 c = Cc[co * 64 + n], p = pw[tau * 64 + n], b = Bb[n * 16 + ci]; const float tr = c.x * p.x - c.y * p.y, ti = c.x * p.y + c.y * p.x; acc += tr * b.x - ti * b.y; }
        KT[o] = acc; }
    if (dir == 1 && tid < 256) { const int co = tid >> 4, ci = tid & 15; float acc = 0.f;
_Pragma("unroll 4")
        for (int n = 0; n < 64; ++n) { const f32x2 c = Cc0[co * 64 + n], b = Bb0[n * 16 + ci]; acc += c.x * b.x - c.y * b.y; }
        K0[tid] = acc; }
    { bf16_t* BsT = (bf16_t*)(ws + WS_BST) + (size_t)g * 256 * 512;
      for (int ch = tid; ch < 128 * 64; ch += 512) {
          const int row = ch >> 6, part = row >> 6, n = row & 63, kc = ch & 63, s = kc >> 1, ci0 = (kc & 1) * 8; const int e = dir ? s : 31 - s; const f32x2 p = pw[e * 64 + n];
          float v[8];
#pragma unroll
          for (int j = 0; j < 8; ++j) { const f32x2 b = Bb[n * 16 + ci0 + j]; v[j] = part ? (p.x * b.y + p.y * b.x) : (p.x * b.x - p.y * b.y); }
          u32x4 w; w.x = cvt_pk_bf16(v[0], v[1]); w.y = cvt_pk_bf16(v[2], v[3]); w.z = cvt_pk_bf16(v[4], v[5]); w.w = cvt_pk_bf16(v[6], v[7]);
          *(u32x4*)(BsT + (size_t)(dir * 128 + row) * 512 + s * 16 + ci0) = w; } }
    bf16_t* MtC = (bf16_t*)(ws + WS_MTC) + (size_t)g * 512 * UHK;
    { for (int ch = tid; ch < 512 * 16; ch += 512) {
          const int row = ch >> 4, t = row >> 4, co = row & 15, cc = ch & 15, part = cc >> 3, n0 = (cc & 7) * 8; const int e = dir ? 32 - t : t + 1;
          float v[8];
#pragma unroll
          for (int j = 0; j < 8; ++j) { const f32x2 c = Cc[co * 64 + n0 + j], p = pw[e * 64 + n0 + j]; v[j] = part ? -(c.x * p.y + c.y * p.x) : (c.x * p.x - c.y * p.y); }
          u32x4 w; w.x = cvt_pk_bf16(v[0], v[1]); w.y = cvt_pk_bf16(v[2], v[3]); w.z = cvt_pk_bf16(v[4], v[5]); w.w = cvt_pk_bf16(v[6], v[7]);
          *(u32x4*)(MtC + (size_t)row * UHK + 512 + dir * 128 + part * 64 + n0) = w; } }
    __syncthreads();
    { const float* dsk = a.in[11];
      for (int ch = tid; ch < 512 * 64; ch += 512) {
          const int kc = ch & 63, row = ch >> 6; const int s = kc >> 1, ci0 = (kc & 1) * 8, t = row >> 4, co = row & 15;
          if (dir == 0 ? (t > s) : (s >= t)) {
              const int tau = dir == 0 ? t - s : s - t;
              float v[8];
#pragma unroll
              for (int j = 0; j < 8; ++j) v[j] = KT[tau * 256 + co * 16 + ci0 + j];
              if (t == s) { const float dv = dsk[g * 16 + co];
#pragma unroll
                  for (int j = 0; j < 8; ++j) v[j] += K0[co * 16 + ci0 + j] + ((ci0 + j == co) ? dv : 0.f); }
              u32x4 w; w.x = cvt_pk_bf16(v[0], v[1]); w.y = cvt_pk_bf16(v[2], v[3]); w.z = cvt_pk_bf16(v[4], v[5]); w.w = cvt_pk_bf16(v[6], v[7]);
              *(u32x4*)(MtC + (size_t)row * UHK + s * 16 + ci0) = w;
          }
      } }
    __syncthreads();
}

__device__ __forceinline__ void step_setup(const Args& a, LAS unsigned char* lds, int tid, int bx) {
    const int lane = tid & 63, wave = tid >> 6, G = gridDim.x;
    unsigned char* ws = a.ws;
    for (int it = bx; it < 64; it += G) ssm_setup_item(a, lds, it, tid);
    { float* rc = (float*)(ws + WS_ROPE); float* rs = rc + SEQL * 32;
      for (int idx = bx * 512 + tid; idx < SEQL * 32; idx += G * 512) {
          const int pos = idx >> 5, i = idx & 31; double inv = 1.0; for (int k = 0; k < i; ++k) inv *= 0.7498942093324558;
          float c, s; reduce_angle((double)pos * inv, c, s); rc[idx] = c; rs[idx] = s; } }
    { LAS float* scr = (LAS float*)(lds) + wave * (64 * 33);
      const int gw = bx * 8 + wave, NGW = G * 8;
      constexpr int I_IN = (DM / 64) * (INC / 32), I_GLU = (512 / 64) * (512 / 32), I_AB = (512 / 64) * (1024 / 32), I_OUT = (1024 / 64) * (1024 / 32);
      constexpr int NIT = I_IN + I_GLU + 2 * I_AB + I_OUT;
      for (int it = gw; it < NIT; it += NGW) {
          int r = it;
          if (r < I_IN) { transpose_item(a.in[3], DM, INC, (bf16_t*)(ws + WS_WIN), true, scr, r, lane); continue; } r -= I_IN;
          if (r < I_GLU) { transpose_item(a.in[12], 512, 512, (bf16_t*)(ws + WS_WGLU), false, scr, r, lane); continue; } r -= I_GLU;
          if (r < I_AB) { transpose_item(a.in[13], 512, 1024, (bf16_t*)(ws + WS_WA), false, scr, r, lane); continue; } r -= I_AB;
          if (r < I_AB) { transpose_item(a.in[14], 512, 1024, (bf16_t*)(ws + WS_WB), false, scr, r, lane); continue; } r -= I_AB;
          transpose_item(a.in[15], 1024, 1024, (bf16_t*)(ws + WS_WOUT), false, scr, r, lane);
      } }
    { bf16_t* hn = (bf16_t*)((unsigned char*)a.out + OUT_HN_OFF);
      const f32x4* gr = (const f32x4*)a.in[2] + lane;
      f32x4 gv[4];
#pragma unroll
      for (int j = 0; j < 4; ++j) gv[j] = gr[64 * j];
      unsigned* rctr = (unsigned*)(ws + WS_CTL) + 4;
      constexpr int RCH = 16;
      for (;;) {
          unsigned cidx = 0; if (lane == 0) cidx = atomicAdd(rctr, 1u);
          cidx = (unsigned)__builtin_amdgcn_readfirstlane((int)cidx);
          if (cidx >= (unsigned)(TTOK / RCH)) break;
          int row = (int)cidx * RCH; const int rend = row + RCH;
          f32x4 nx[4];
          { const f32x4* xr = (const f32x4*)xrow_ptr(a.in[0], a.in[1], row) + lane;
#pragma unroll
            for (int j = 0; j < 4; ++j) nx[j] = __builtin_nontemporal_load(xr + 64 * j); }
          for (; row < rend; ++row) {
              f32x4 v[4];
#pragma unroll
              for (int j = 0; j < 4; ++j) v[j] = nx[j];
              if (row + 1 < rend) { const f32x4* xn = (const f32x4*)xrow_ptr(a.in[0], a.in[1], row + 1) + lane;
#pragma unroll
                  for (int j = 0; j < 4; ++j) nx[j] = __builtin_nontemporal_load(xn + 64 * j); }
              float s = 0.f;
#pragma unroll
              for (int j = 0; j < 4; ++j) s += (v[j].x * v[j].x + v[j].y * v[j].y) + (v[j].z * v[j].z + v[j].w * v[j].w);
              const float rstd = 1.0f / sqrtf(wave_sum(s) * (1.f / DM) + EPSN);
              u32x2* o8 = (u32x2*)(hn + (size_t)row * DM) + lane;
#pragma unroll
              for (int j = 0; j < 4; ++j) { u32x2 w; w.x = cvt_pk_bf16(v[j].x * rstd * gv[j].x, v[j].y * rstd * gv[j].y); w.y = cvt_pk_bf16(v[j].z * rstd * gv[j].z, v[j].w * rstd * gv[j].w); o8[64 * j] = w; }
          }
      } }
}

__device__ __forceinline__ float quad_max(float x) {
    const auto r = __builtin_amdgcn_permlane32_swap(__float_as_uint(x), __float_as_uint(x), false, false);
    x = fmaxf(__uint_as_float(r[0]), __uint_as_float(r[1]));
    const auto q = __builtin_amdgcn_permlane16_swap(__float_as_uint(x), __float_as_uint(x), false, false);
    return fmaxf(__uint_as_float(q[0]), __uint_as_float(q[1]));
}
__device__ __forceinline__ float quad_sum(float x) {
    const auto r = __builtin_amdgcn_permlane32_swap(__float_as_uint(x), __float_as_uint(x), false, false);
    x = __uint_as_float(r[0]) + __uint_as_float(r[1]);
    const auto q = __builtin_amdgcn_permlane16_swap(__float_as_uint(x), __float_as_uint(x), false, false);
    return __uint_as_float(q[0]) + __uint_as_float(q[1]);
}
struct KVBuf { bf16x8 kA0, kA1, kB0, kB1; bf16x4 vA[4], vB[4]; };
__device__ __forceinline__ void step_params(int s, int& gi, int& ls) { gi = s < 12 ? 0 : (s < 18 ? 1 : 2); ls = s < 12 ? s : (s < 18 ? s - 12 : s - 18); }
__device__ __forceinline__ void attn_load(KVBuf& b, const bf16_t* Kp, const bf16_t* Vt, int s, int sq, int h, int blk, int r, int lane) {
    int gi, ls; step_params(s, gi, ls);
    const int sh = 2 * gi, Lg = SEQL >> sh, rho = r & ((1 << sh) - 1);
    int uA = ((256 * blk) >> sh) - 64 + 32 * ls, uB = uA + 16;
    if (uA < 0 || uA >= Lg) uA = 0; if (uB < 0 || uB >= Lg) uB = 0;
    const int kl = lane & 15, quad = lane >> 4;
    const bf16_t* kh = Kp + (size_t)(sq * 24 + gi * 8 + h) * SEQL * 64 + quad * 128 + kl * 8;
    const bf16_t* ka = kh + (size_t)((rho * Lg + uA) >> 4) * 1024; const bf16_t* kb = kh + (size_t)((rho * Lg + uB) >> 4) * 1024;
    b.kA0 = *(const bf16x8*)ka; b.kA1 = *(const bf16x8*)(ka + 512); b.kB0 = *(const bf16x8*)kb; b.kB1 = *(const bf16x8*)(kb + 512);
    const bf16_t* vbase = Vt + (size_t)(((sq * 3 + gi) * 8 + h) * 512) * 1024 + quad * 64 + kl * 4;
    const bf16_t* va = vbase + (size_t)((rho * Lg + uA) >> 4) * 1024; const bf16_t* vb = vbase + (size_t)((rho * Lg + uB) >> 4) * 1024;
#pragma unroll
    for (int dt = 0; dt < 4; ++dt) { b.vA[dt] = *(const bf16x4*)(va + dt * 256); b.vB[dt] = *(const bf16x4*)(vb + dt * 256); }
}
struct QF { bf16x8 a0, a1, b0, b1, c0, c1; };
template <int gi>
__device__ __forceinline__ void attn_compute(const KVBuf& b, const bf16x8 q0, const bf16x8 q1, f32x4 (&o)[4], float& mrun, float& lrun, int s, int blk, int r, int lane) {
    const int ls = gi == 0 ? s : (gi == 1 ? s - 12 : s - 18);
    const int sh = 2 * gi, Lg = SEQL >> sh;
    const int uA = ((256 * blk) >> sh) - 64 + 32 * ls;
    const int qi = lane & 15, quad = lane >> 4;
    const int uq = (256 * blk + r + 16 * qi) >> sh;
    const int lo = max(0, uq - 64), hi = min(Lg - 1, uq + 64);
    f32x4 sA = (f32x4){0.f, 0.f, 0.f, 0.f}, sB = sA;
    sA = __builtin_amdgcn_mfma_f32_16x16x32_bf16(b.kA0, q0, sA, 0, 0, 0); sA = __builtin_amdgcn_mfma_f32_16x16x32_bf16(b.kA1, q1, sA, 0, 0, 0);
    sB = __builtin_amdgcn_mfma_f32_16x16x32_bf16(b.kB0, q0, sB, 0, 0, 0); sB = __builtin_amdgcn_mfma_f32_16x16x32_bf16(b.kB1, q1, sB, 0, 0, 0);
    const float NEGINF = -__builtin_inff();
    const unsigned span = (unsigned)(hi - lo);
    float mx = NEGINF;
#pragma unroll
    for (int j = 0; j < 4; ++j) {
        const int ua = uA + quad * 4 + j, ub = ua + 16;
        sA[j] = ((unsigned)(ua - lo) <= span) ? sA[j] : NEGINF; sB[j] = ((unsigned)(ub - lo) <= span) ? sB[j] : NEGINF;
        mx = fmaxf(mx, fmaxf(sA[j], sB[j]));
    }
    mx = quad_max(mx);
    const float mnew = fmaxf(mrun, mx), alpha = __builtin_amdgcn_exp2f(mrun - mnew);
    mrun = mnew;
    float ps = 0.f;
#pragma unroll
    for (int j = 0; j < 4; ++j) { sA[j] = __builtin_amdgcn_exp2f(sA[j] - mnew); sB[j] = __builtin_amdgcn_exp2f(sB[j] - mnew); ps += sA[j] + sB[j]; }
    lrun = lrun * alpha + ps;
    u32x4 pw; pw.x = cvt_pk_bf16(sA[0], sA[1]); pw.y = cvt_pk_bf16(sA[2], sA[3]); pw.z = cvt_pk_bf16(sB[0], sB[1]); pw.w = cvt_pk_bf16(sB[2], sB[3]);
    const bf16x8 pf = __builtin_bit_cast(bf16x8, pw);
#pragma unroll
    for (int dt = 0; dt < 4; ++dt) {
        o[dt] *= alpha;
        bf16x8 vf; vf[0] = b.vA[dt][0]; vf[1] = b.vA[dt][1]; vf[2] = b.vA[dt][2]; vf[3] = b.vA[dt][3]; vf[4] = b.vB[dt][0]; vf[5] = b.vB[dt][1]; vf[6] = b.vB[dt][2]; vf[7] = b.vB[dt][3];
#ifdef DBG_ATT2
        for (int e = 0; e < 8; ++e) o[dt][e & 3] += 1e-3f * __uint_as_float(((unsigned)(unsigned short)vf[e]) << 16);
#else
        o[dt] = __builtin_amdgcn_mfma_f32_16x16x32_bf16(vf, pf, o[dt], 0, 0, 0);
#endif
    }
}
template <int gi>
__device__ __forceinline__ void attn_compute2(const KVBuf& b, const KVBuf& c, const bf16x8 q0, const bf16x8 q1, f32x4 (&o)[4], float& mrun, float& lrun, int s, int blk, int r, int lane) {
    const int ls = gi == 0 ? s : (gi == 1 ? s - 12 : s - 18);
    const int sh = 2 * gi, Lg = SEQL >> sh;
    const int uA = ((256 * blk) >> sh) - 64 + 32 * ls;
    const int qi = lane & 15, quad = lane >> 4;
    const int uq = (256 * blk + r + 16 * qi) >> sh;
    const int lo = max(0, uq - 64), hi = min(Lg - 1, uq + 64);
    const f32x4 z4 = (f32x4){0.f, 0.f, 0.f, 0.f};
    f32x4 sA = __builtin_amdgcn_mfma_f32_16x16x32_bf16(b.kA0, q0, z4, 0, 0, 0), sB = __builtin_amdgcn_mfma_f32_16x16x32_bf16(b.kB0, q0, z4, 0, 0, 0);
    f32x4 sC = __builtin_amdgcn_mfma_f32_16x16x32_bf16(c.kA0, q0, z4, 0, 0, 0), sD = __builtin_amdgcn_mfma_f32_16x16x32_bf16(c.kB0, q0, z4, 0, 0, 0);
    sA = __builtin_amdgcn_mfma_f32_16x16x32_bf16(b.kA1, q1, sA, 0, 0, 0); sB = __builtin_amdgcn_mfma_f32_16x16x32_bf16(b.kB1, q1, sB, 0, 0, 0);
    sC = __builtin_amdgcn_mfma_f32_16x16x32_bf16(c.kA1, q1, sC, 0, 0, 0); sD = __builtin_amdgcn_mfma_f32_16x16x32_bf16(c.kB1, q1, sD, 0, 0, 0);
    const float NEGINF = -__builtin_inff();
    const unsigned span = (unsigned)(hi - lo);
    float mx = NEGINF;
#pragma unroll
    for (int j = 0; j < 4; ++j) {
        const int ua = uA + quad * 4 + j;
        sA[j] = ((unsigned)(ua - lo) <= span) ? sA[j] : NEGINF; sB[j] = ((unsigned)(ua + 16 - lo) <= span) ? sB[j] : NEGINF;
        sC[j] = ((unsigned)(ua + 32 - lo) <= span) ? sC[j] : NEGINF; sD[j] = ((unsigned)(ua + 48 - lo) <= span) ? sD[j] : NEGINF;
        mx = fmaxf(fmaxf(mx, fmaxf(sA[j], sB[j])), fmaxf(sC[j], sD[j]));
    }
    mx = quad_max(mx);
    const float mnew = fmaxf(mrun, mx), alpha = __builtin_amdgcn_exp2f(mrun - mnew);
    mrun = mnew;
    float ps = 0.f;
#pragma unroll
    for (int j = 0; j < 4; ++j) { sA[j] = __builtin_amdgcn_exp2f(sA[j] - mnew); sB[j] = __builtin_amdgcn_exp2f(sB[j] - mnew); sC[j] = __builtin_amdgcn_exp2f(sC[j] - mnew); sD[j] = __builtin_amdgcn_exp2f(sD[j] - mnew); ps += (sA[j] + sB[j]) + (sC[j] + sD[j]); }
    lrun = lrun * alpha + ps;
    u32x4 pw, pv; pw.x = cvt_pk_bf16(sA[0], sA[1]); pw.y = cvt_pk_bf16(sA[2], sA[3]); pw.z = cvt_pk_bf16(sB[0], sB[1]); pw.w = cvt_pk_bf16(sB[2], sB[3]);
    pv.x = cvt_pk_bf16(sC[0], sC[1]); pv.y = cvt_pk_bf16(sC[2], sC[3]); pv.z = cvt_pk_bf16(sD[0], sD[1]); pv.w = cvt_pk_bf16(sD[2], sD[3]);
    const bf16x8 pf = __builtin_bit_cast(bf16x8, pw), pg = __builtin_bit_cast(bf16x8, pv);
#pragma unroll
    for (int dt = 0; dt < 4; ++dt) {
        o[dt] *= alpha;
        bf16x8 vf, vg;
        vf[0] = b.vA[dt][0]; vf[1] = b.vA[dt][1]; vf[2] = b.vA[dt][2]; vf[3] = b.vA[dt][3]; vf[4] = b.vB[dt][0]; vf[5] = b.vB[dt][1]; vf[6] = b.vB[dt][2]; vf[7] = b.vB[dt][3];
        vg[0] = c.vA[dt][0]; vg[1] = c.vA[dt][1]; vg[2] = c.vA[dt][2]; vg[3] = c.vA[dt][3]; vg[4] = c.vB[dt][0]; vg[5] = c.vB[dt][1]; vg[6] = c.vB[dt][2]; vg[7] = c.vB[dt][3];
        o[dt] = __builtin_amdgcn_mfma_f32_16x16x32_bf16(vf, pf, o[dt], 0, 0, 0);
        o[dt] = __builtin_amdgcn_mfma_f32_16x16x32_bf16(vg, pg, o[dt], 0, 0, 0);
    }
}
__device__ __forceinline__ void step_attention(const Args& a, LAS unsigned char* lds, int pass, int tid, int bx) {
    unsigned char* ws = a.ws;
    const int lane = tid & 63;
    const bf16_t* Qp = (const bf16_t*)(ws + WS_Q); const bf16_t* Kp = (const bf16_t*)(ws + WS_K); const bf16_t* Vt = (const bf16_t*)(ws + WS_VT);
    const bf16_t* ZA = (const bf16_t*)(ws + WS_ZA); bf16_t* GAO = (bf16_t*)(ws + WS_GAO);
    const int xcd = bx & 7;
    unsigned* ctr = (unsigned*)(ws + WS_CTL) + 16 + pass * 8 + xcd;
    LAS unsigned* slot = (LAS unsigned*)(lds + 3 * 16384);
    constexpr int NGRP = 3 * 32 * 2;
    for (;;) {
        __syncthreads();
        if (tid == 0) slot[0] = atomicAdd(ctr, 1u);
        __syncthreads();
        const unsigned grp = (unsigned)__builtin_amdgcn_readfirstlane((int)slot[0]);
        if (grp >= (unsigned)NGRP) break;
        const int wv_ = tid >> 6; const int r = ((wv_ & 3) << 2) + (wv_ >> 2) + 2 * (int)(grp & 1)  , blk = (grp >> 1) & 31, pair = xcd * 3 + (int)(grp >> 6);
        const int h = pair & 7, sq = pair >> 3;
        const int qi = lane & 15, quad = lane >> 4;
        const int tq = sq * SEQL + 256 * blk + r + 16 * qi;
        QF qf;
        { const int pos = 256 * blk + r + 16 * qi;
          const bf16_t* qa = Qp + ((size_t)(sq * 24 + h) * SEQL + pos) * 64 + quad * 8;
          const bf16_t* qb = Qp + ((size_t)(sq * 24 + 8 + h) * SEQL + (pos & 3) * 2048 + (pos >> 2)) * 64 + quad * 8;
          const bf16_t* qc = Qp + ((size_t)(sq * 24 + 16 + h) * SEQL + (pos & 15) * 512 + (pos >> 4)) * 64 + quad * 8;
          qf.a0 = *(const bf16x8*)qa; qf.a1 = *(const bf16x8*)(qa + 32); qf.b0 = *(const bf16x8*)qb; qf.b1 = *(const bf16x8*)(qb + 32); qf.c0 = *(const bf16x8*)qc; qf.c1 = *(const bf16x8*)(qc + 32); }
        f32x4 o[4];
#pragma unroll
        for (int dt = 0; dt < 4; ++dt) o[dt] = (f32x4){0.f, 0.f, 0.f, 0.f};
        float mrun = -1e30f, lrun = 0.f;
        u32x2 zpre[4];
#pragma unroll
        for (int dt = 0; dt < 4; ++dt) zpre[dt] = *(const u32x2*)(ZA + (size_t)tq * 512 + h * 64 + 16 * dt + 4 * quad);
        KVBuf b0, b1;
#define ATT_SB __builtin_amdgcn_sched_barrier(0);
        {
            const int wv = tid >> 6, region = wv >> 1;
            const bf16_t* gsrc = (region < 2 ? Kp + (size_t)(sq * 24 + h) * SEQL * 64 : Vt + (size_t)((sq * 3) * 8 + h) * 512 * 1024) + (wv & 1) * 512 + lane * 8;
            const int ubase = 256 * blk - 64 + (region & 1) * 16;
#define ATT_DMA(S) do { int uT = ubase + 32 * (S); if (uT < 0 || uT >= SEQL) uT = 0; \
                __builtin_amdgcn_global_load_lds((const unsigned*)(gsrc + (size_t)(uT >> 4) * 1024), (LAS unsigned*)(lds + (((S) >> 1) % 3) * 16384 + ((S) & 1) * 8192 + wv * 1024), 16, 0, 0); } while (0)
            ATT_DMA(0); ATT_DMA(1); ATT_DMA(2); ATT_DMA(3);
            const int kl = lane & 15;
            const unsigned foff = (unsigned)(quad * 256 + kl * 16), voff = (unsigned)(4096 + quad * 128 + kl * 8);
#pragma unroll 1
            for (int d = 0; d < 6; ++d) {
                if (d < 5) asm volatile("s_waitcnt vmcnt(2)" ::: "memory"); else asm volatile("s_waitcnt vmcnt(0)" ::: "memory");
                __syncthreads();
                if (d + 2 < 6) { ATT_DMA(2 * d + 4); ATT_DMA(2 * d + 5); }
                LAS unsigned char* kb = lds + (d % 3) * 16384;
                b0.kA0 = *(const LAS bf16x8*)(kb + foff); b0.kA1 = *(const LAS bf16x8*)(kb + foff + 1024); b0.kB0 = *(const LAS bf16x8*)(kb + 2048 + foff); b0.kB1 = *(const LAS bf16x8*)(kb + 2048 + foff + 1024);
                b1.kA0 = *(const LAS bf16x8*)(kb + 8192 + foff); b1.kA1 = *(const LAS bf16x8*)(kb + 8192 + foff + 1024); b1.kB0 = *(const LAS bf16x8*)(kb + 8192 + 2048 + foff); b1.kB1 = *(const LAS bf16x8*)(kb + 8192 + 2048 + foff + 1024);
#pragma unroll
                for (int dt = 0; dt < 4; ++dt) { b0.vA[dt] = *(const LAS bf16x4*)(kb + voff + dt * 512); b0.vB[dt] = *(const LAS bf16x4*)(kb + 2048 + voff + dt * 512);
                                                 b1.vA[dt] = *(const LAS bf16x4*)(kb + 8192 + voff + dt * 512); b1.vB[dt] = *(const LAS bf16x4*)(kb + 8192 + 2048 + voff + dt * 512); }
                attn_compute2<0>(b0, b1, qf.a0, qf.a1, o, mrun, lrun, 2 * d, blk, r, lane);
            }
#undef ATT_DMA
        }
        attn_load(b0, Kp, Vt, 12, sq, h, blk, r, lane);
#define ATT_LOOP(GI, S0, S1, QA, QB) _Pragma("unroll 1") for (int s = S0; s < S1; s += 2) { \
            ATT_SB attn_load(b1, Kp, Vt, s + 1, sq, h, blk, r, lane); ATT_SB attn_compute<GI>(b0, QA, QB, o, mrun, lrun, s, blk, r, lane); \
            ATT_SB attn_load(b0, Kp, Vt, s + 2, sq, h, blk, r, lane); ATT_SB attn_compute<GI>(b1, QA, QB, o, mrun, lrun, s + 1, blk, r, lane); ATT_SB }
        ATT_LOOP(1, 12, 18, qf.b0, qf.b1)
        ATT_LOOP(2, 18, 22, qf.c0, qf.c1)
#undef ATT_LOOP
        attn_compute<2>(b0, qf.c0, qf.c1, o, mrun, lrun, 22, blk, r, lane);
        const float l = quad_sum(lrun);
        float inv = 1.0f / l;
#ifdef DBG_ATT1
        for (int dt = 0; dt < 4; ++dt) o[dt] = (f32x4){1.f, 1.f, 1.f, 1.f};
#endif
#pragma unroll
        for (int dt = 0; dt < 4; ++dt) {
            const size_t off = (size_t)tq * 512 + h * 64 + 16 * dt + 4 * quad;
            const u32x2 z = zpre[dt];
            u32x2 w; w.x = cvt_pk_bf16(o[dt][0] * inv * bf_lo(z.x), o[dt][1] * inv * bf_hi(z.x)); w.y = cvt_pk_bf16(o[dt][2] * inv * bf_lo(z.y), o[dt][3] * inv * bf_hi(z.y));
            *(u32x2*)(GAO + off) = w;
        }
    }
}

__device__ __forceinline__ f32x2 cmul(f32x2 a, f32x2 b) { return (f32x2){a.x * b.x - a.y * b.y, a.x * b.y + a.y * b.x}; }
__device__ __forceinline__ void step_scan(const Args& a, LAS unsigned char* lds, int tid, int it0, int it1, int itstep) {
    unsigned char* ws = a.ws; const int G = gridDim.x;
    const float* PW = (const float*)(ws + WS_PW); const float* S = (const float*)(ws + WS_S); bf16_t* UH = (bf16_t*)(ws + WS_UH);
    LAS f32x2* carry = (LAS f32x2*)lds;
    for (int it = it0; it < it1; it += itstep) {
        const int dir = it & 1, g = (it >> 1) & 31, sq = it >> 6; const int seg = tid >> 6, n = tid & 63;
        const f32x2 P = (f32x2){PW[((dir * 32 + g) * 64 + n) * 2], PW[((dir * 32 + g) * 64 + n) * 2 + 1]};
        f32x2 z[32];
        { const int c0 = dir ? (NCH - 1 - seg * 32) : seg * 32; const long stp = dir ? -256 : 256;
          const float* sp = S + ((size_t)g * CHP + sq * NCH + c0) * 256 + dir * 128 + n;
#pragma unroll
          for (int i = 0; i < 32; ++i) { z[i] = (f32x2){sp[0], sp[64]}; sp += stp; } }
        f32x2 zz = (f32x2){0.f, 0.f};
#pragma unroll
        for (int i = 0; i < 32; ++i) { const f32x2 t = z[i]; z[i] = zz; zz = cmul(P, zz) + t; }
        __syncthreads();
        carry[seg * 64 + n] = zz;
        __syncthreads();
        f32x2 P32 = P;
#pragma unroll
        for (int k = 0; k < 5; ++k) P32 = cmul(P32, P32);
        f32x2 x = (f32x2){0.f, 0.f};
        for (int sp = 0; sp < seg; ++sp) x = cmul(P32, x) + carry[sp * 64 + n];
        f32x2 pwr = (f32x2){1.f, 0.f};
        { const int c0 = dir ? (NCH - 1 - seg * 32) : seg * 32; const long stp = dir ? -(long)UHK : (long)UHK;
          bf16_t* up = UH + ((size_t)g * CHP + sq * NCH + c0) * UHK + 512 + dir * 128 + n;
#pragma unroll
          for (int i = 0; i < 32; ++i) {
              const f32x2 hin = z[i] + cmul(pwr, x);
              up[0] = (bf16_t)(cvt_pk_bf16(hin.x, 0.f) & 0xffffu); up[64] = (bf16_t)(cvt_pk_bf16(hin.y, 0.f) & 0xffffu);
              pwr = cmul(pwr, P); up += stp;
          } }
    }
}

__device__ __forceinline__ void step_final_norm(const Args& a, int pass, int tid, int bx) {
    const int lane = tid & 63, wave = tid >> 6, G = gridDim.x;
    const f32x4* gr = (const f32x4*)a.in[16] + lane;
    f32x4 gv[4];
#pragma unroll
    for (int j = 0; j < 4; ++j) gv[j] = gr[64 * j];
    const bf16_t* accp = (const bf16_t*)(a.ws + WS_ACC);
    int row = bx * 8 + wave;
    f32x4 nx[4]; u32x2 na[4];
    if (row < TP) { const f32x4* xr = (const f32x4*)xrow_ptr(a.in[0], a.in[1], pass * TP + row) + lane; const u32x2* ar = (const u32x2*)(accp + (size_t)row * DM) + lane;
#pragma unroll
        for (int j = 0; j < 4; ++j) { nx[j] = __builtin_nontemporal_load(xr + 64 * j); na[j] = ar[64 * j]; } }
    for (; row < TP; row += G * 8) {
        f32x4 v[4];
#pragma unroll
        for (int j = 0; j < 4; ++j) v[j] = nx[j] + (f32x4){bf_lo(na[j].x), bf_hi(na[j].x), bf_lo(na[j].y), bf_hi(na[j].y)};
        const int nrow = row + G * 8;
        if (nrow < TP) { const f32x4* xn = (const f32x4*)xrow_ptr(a.in[0], a.in[1], pass * TP + nrow) + lane; const u32x2* an = (const u32x2*)(accp + (size_t)nrow * DM) + lane;
#pragma unroll
            for (int j = 0; j < 4; ++j) { nx[j] = __builtin_nontemporal_load(xn + 64 * j); na[j] = an[64 * j]; } }
        float s = 0.f;
#pragma unroll
        for (int j = 0; j < 4; ++j) s += (v[j].x * v[j].x + v[j].y * v[j].y) + (v[j].z * v[j].z + v[j].w * v[j].w);
        const float rstd = 1.0f / sqrtf(wave_sum(s) * (1.f / DM) + EPSN);
        f32x4* xr = (f32x4*)(a.out + (size_t)(pass * TP + row) * DM) + lane;
#pragma unroll
        for (int j = 0; j < 4; ++j) __builtin_nontemporal_store(v[j] * rstd * gv[j], xr + 64 * j);
    }
}


#define XB_TMO      128
#define XB_XCNT(j)  (256  + 64 * (j))
#define XB_XSUB(j)  (1280 + 64 * (j))
#define XB_XGEN(j)  (2304 + 64 * (j))
#define XB_TOP      3328
#define XB_TOPGEN   3392
#define XCD_BAR_WORDS 3456
#define XB_SLOT(b)  (4096 + 2 * (b))
#define XB_SPIN_CAP (1u << 18)
__device__ __forceinline__ unsigned xb_ld(unsigned* p)              { return __hip_atomic_load(p, __ATOMIC_RELAXED, __HIP_MEMORY_SCOPE_AGENT); }
__device__ __forceinline__ unsigned xb_add(unsigned* p, unsigned v) { return __hip_atomic_fetch_add(p, v, __ATOMIC_RELAXED, __HIP_MEMORY_SCOPE_AGENT); }
__device__ __forceinline__ unsigned xb_xcc_id() { return (unsigned)__builtin_amdgcn_s_getreg((3 << 11) | 20) & 0xFu; }
#define XB_SPIN(cond, bar) do { unsigned _sp = 0; while (cond) { __builtin_amdgcn_s_sleep(1); \
    if ((++_sp & 255u) == 0u) { if (xb_ld(&(bar)[XB_TMO])) break; if (_sp > XB_SPIN_CAP) { atomicAdd(&(bar)[XB_TMO], 1u); break; } } } } while (0)
__device__ __forceinline__ void xcd_barrier_complete(unsigned* bar, unsigned x, unsigned& nloc, unsigned& nx) {
    const unsigned G = gridDim.x;
    unsigned sum, cnt, mine, sp = 0u;
    for (;;) {
        sum = 0u; cnt = 0u; mine = 0u;
#pragma unroll
        for (unsigned j = 0; j < 16; ++j) { const unsigned c = xb_ld(&bar[XB_XCNT(j)]); sum += c; cnt += (c > 0u) ? 1u : 0u; mine = (j == x) ? c : mine; }
        if (sum == G) break;
        __builtin_amdgcn_s_sleep(1);
        if ((++sp & 255u) == 0u) { if (xb_ld(&bar[XB_TMO])) break; if (sp > XB_SPIN_CAP) { atomicAdd(&bar[XB_TMO], 1u); break; } }
    }
    nloc = mine > 0u ? mine : 1u; nx = cnt > 0u ? cnt : 1u;
}
__device__ __forceinline__ void xcd_barrier(unsigned* bar) {
    asm volatile("s_waitcnt vmcnt(0)" ::: "memory");
    __syncthreads();
    if (threadIdx.x == 0) {
        __builtin_amdgcn_s_waitcnt(0);
        const unsigned x = xb_xcc_id();
        unsigned* slot = bar + XB_SLOT(blockIdx.x);
        unsigned nloc = xb_ld(slot), nx = xb_ld(slot + 1);
        if (nloc == 0u) { xcd_barrier_complete(bar, x, nloc, nx); __hip_atomic_store(slot, nloc, __ATOMIC_RELAXED, __HIP_MEMORY_SCOPE_AGENT); __hip_atomic_store(slot + 1, nx, __ATOMIC_RELAXED, __HIP_MEMORY_SCOPE_AGENT); }
        const unsigned old = xb_add(&bar[XB_XSUB(x)], 1u);
        const unsigned gen = old / nloc;
        if (old + 1u == (gen + 1u) * nloc) {
            __builtin_amdgcn_fence(__ATOMIC_RELEASE, "agent");
            asm volatile("s_waitcnt vmcnt(0)" ::: "memory");
            const unsigned og = xb_add(&bar[XB_TOP], 1u);
            const unsigned tg = og / nx;
            if (og + 1u == (tg + 1u) * nx) xb_add(&bar[XB_TOPGEN], 1u);
            else XB_SPIN(xb_ld(&bar[XB_TOPGEN]) == tg, bar);
            __builtin_amdgcn_fence(__ATOMIC_ACQUIRE, "agent");
            xb_add(&bar[XB_XGEN(x)], 1u);
            asm volatile("s_waitcnt vmcnt(0)" ::: "memory");
        } else {
            XB_SPIN(xb_ld(&bar[XB_XGEN(x)]) == gen, bar);
            __builtin_amdgcn_fence(__ATOMIC_ACQUIRE, "agent");
            asm volatile("s_waitcnt vmcnt(0)" ::: "memory");
        }
    }
    __syncthreads();
}

constexpr int NSTEPS = 1 + 10 * NPASS;
__host__ __device__ __forceinline__ bool sync_after(int st) { if (st == 0) return true; const int k = (st - 1) % 10; return !(k == 1 || k == 6 || k == 9); }

__global__ void __launch_bounds__(512, 2) fwd_kernel(Args a) {
    extern __shared__ __attribute__((aligned(16))) unsigned char lds_raw[];
    LAS unsigned char* lds = (LAS unsigned char*)lds_raw;
    cg::grid_group grid = cg::this_grid();
    const int G = gridDim.x;
    unsigned char* ws = a.ws;
    unsigned* bar = (unsigned*)(ws + WS_BAR);
    if (a.do_sync == 2) grid.sync();
    if (a.do_sync && threadIdx.x == 0) (void)xb_add(&bar[XB_XCNT(xb_xcc_id())], 1u);
    for (int st = a.st_lo; st < a.st_hi; ++st) {
        int tid = threadIdx.x, bx = blockIdx.x;
        asm volatile("" : "+v"(tid), "+s"(bx));
#ifndef NO_SETUP
        if (st == 0) { step_setup(a, lds, tid, bx); }
#else
        if (st == 0) {}
#endif
        else {
            const int pass = (st - 1) / 10, k = (st - 1) % 10;
            GemmD g; g.lgnN = 0; g.pass = pass; g.nb = 1; g.sA = 0; g.sB = 0;
            bool has_gemm = true;
            const bool fz = (G == 256);
            const bool split_ay = false;
            const bf16_t* sgp = (const bf16_t*)((unsigned char*)a.out + OUT_HN_OFF) + (size_t)pass * TP * DM;
#define DESC_Y { g.A = (const bf16_t*)(ws + WS_UH); g.lda = UHK; g.sA = (unsigned)(CHP * UHK * 2); g.Bt = (const bf16_t*)(ws + WS_MTC); g.ldb = UHK; g.sB = (unsigned)(512 * UHK * 2); g.K = UHK; g.nM = CHP / BM; g.nN = 2; g.nb = 32; g.mode = MODE_Y; }
#define DESC_A { g.A = (const bf16_t*)(ws + WS_GAO); g.lda = 512; g.Bt = (const bf16_t*)(ws + WS_WA); g.ldb = 512; g.K = 512; g.nM = TP / BM; g.nN = 4; g.lgnN = 2; g.mode = MODE_A; }
#define DESC_GLU { g.A = sgp; g.lda = 512; g.Bt = (const bf16_t*)(ws + WS_WGLU); g.ldb = 512; g.K = 512; g.nM = TP / BM; g.nN = 2; g.lgnN = 1; g.mode = MODE_GLU; }
#define DESC_NONE { has_gemm = false; g.A = nullptr; g.Bt = nullptr; g.lda = g.ldb = g.K = 0; g.nM = g.nN = 0; g.mode = 0; }
            switch (k) {
            case 0: g.A = (const bf16_t*)((unsigned char*)a.out + OUT_HN_OFF) + (size_t)pass * TP * DM; g.lda = DM; g.Bt = (const bf16_t*)(ws + WS_WIN); g.ldb = DM; g.K = DM; g.nM = TP / BM; g.nN = INC / BM; g.lgnN = 5; g.mode = MODE_PROJ; break;
            case 1: g.A = (const bf16_t*)(ws + WS_UH); g.lda = UHK; g.sA = (unsigned)(CHP * UHK * 2); g.Bt = (const bf16_t*)(ws + WS_BST); g.ldb = 512; g.sB = (unsigned)(256 * 512 * 2); g.K = 512; g.nM = CHP / BM; g.nN = 1; g.nb = 32; g.mode = MODE_S; break;
            case 2: if (fz) DESC_Y else DESC_NONE break;
            case 4: if (fz) { if (bx < 128) DESC_A else DESC_GLU } else DESC_Y break;
            case 5: if (fz) DESC_NONE else DESC_GLU break;
            case 6: if (fz) DESC_NONE else DESC_A break;
            case 7: g.A = (const bf16_t*)(ws + WS_SB); g.lda = 512; g.Bt = (const bf16_t*)(ws + WS_WB); g.ldb = 512; g.K = 512; g.nM = TP / BM; g.nN = 4; g.lgnN = 2; g.mode = MODE_B; break;
            case 8: g.A = (const bf16_t*)(ws + WS_M1); g.lda = 1024; g.Bt = (const bf16_t*)(ws + WS_WOUT); g.ldb = 1024; g.K = 1024; g.nM = TP / BM; g.nN = 4; g.lgnN = 2; g.mode = MODE_OUT; break;
            default: DESC_NONE break;
            }
#undef DESC_Y
#undef DESC_A
#undef DESC_GLU
#undef DESC_NONE
            { const int total = g.nM * g.nN * g.nb; g.u0 = bx; g.ustride = G; g.ucount = total > bx ? (total - bx + G - 1) / G : 0; }
            if (fz && k == 2) { g.u0 = (bx / SEQP) * 6 + (bx % SEQP); g.ustride = SEQP; g.ucount = bx < SEQP * 32 ? 2 : 0; }
            if (fz && k == 4) { if (bx < 128) { g.u0 = bx; g.ustride = 128; g.ucount = 3; } else { g.u0 = bx - 128; g.ustride = 128; g.ucount = (bx - 128) < 64 ? 2 : 1; } }
            const bool fuse_scan = (G >= SEQP * 32);
            if (has_gemm) {
#ifndef NO_GEMM
                gemm_phase(a, lds, g, G, bx, tid);
#endif
#ifndef NO_SCAN
                if (k == 1 && fuse_scan && bx < SEQP * 32) {
                    asm volatile("s_waitcnt vmcnt(0)" ::: "memory"); __syncthreads();
                    const int it0 = (bx % SEQP) * 64 + (bx / SEQP) * 2;
                    step_scan(a, lds, tid, it0, it0 + 2, 1);
                    asm volatile("s_waitcnt vmcnt(0)" ::: "memory"); __syncthreads();
                }
#endif
            }
#ifndef NO_ATTN
            else if (k == (fz ? 3 : 2)) step_attention(a, lds, pass, tid, bx);
#endif
#ifndef NO_SCAN
            else if (k == 3 && !fz && !fuse_scan) step_scan(a, lds, tid, bx, SEQP * 32 * 2, G);
#endif
            else if (k == 9) step_final_norm(a, pass, tid, bx);
        }
        { bool need = sync_after(st) && !(st > 0 && (st - 1) % 10 == 3 && G >= SEQP * 32);
          if (G == 256 && st > 0) { const int kk = (st - 1) % 10; need = (kk == 0 || kk == 3 || kk == 4 || kk == 7 || kk == 8); }
          if (a.do_sync && st + 1 < a.st_hi && need) xcd_barrier(bar); }
    }
}

extern "C" void kernel_launch(void* const* d_in, const int* in_sizes, int n_in, void* d_out, int out_size, void* d_ws, size_t ws_size, hipStream_t stream) {
    constexpr int LDS_BYTES = STAGE_BYTES + 32768;
    static int grid = 0;
    if (grid == 0) {
        if (n_in != 17 || out_size != TTOK * DM || ws_size < WS_END) { fprintf(stderr, "kernel_launch: unexpected shapes (n_in %d out %d ws %zu need %zu)\n", n_in, out_size, ws_size, (size_t)WS_END); grid = -1; return; }
        int dev = 0, cus = 0, per_cu = 0;
        hipGetDevice(&dev); hipDeviceGetAttribute(&cus, hipDeviceAttributeMultiprocessorCount, dev);
        hipFuncSetAttribute((const void*)fwd_kernel, hipFuncAttributeMaxDynamicSharedMemorySize, LDS_BYTES);
        hipOccupancyMaxActiveBlocksPerMultiprocessor(&per_cu, (const void*)fwd_kernel, 512, LDS_BYTES);
        if (per_cu < 1) per_cu = 1;
        grid = cus * 1;
        (void)hipGetLastError();
    }
    if (grid < 0) return;
    (void)hipMemsetAsync((unsigned char*)d_ws + WS_BAR, 0, WS_BAR_BYTES + 4096, stream);
    Args a{};
    for (int i = 0; i < 17; ++i) a.in[i] = (const float*)d_in[i];
    a.out = (float*)d_out; a.ws = (unsigned char*)d_ws; a.pad = 0;
#ifndef MULTI_LAUNCH
#define MULTI_LAUNCH 0
#endif
#if MULTI_LAUNCH
    a.do_sync = 0;
    for (int st = 0; st < NSTEPS; ++st) {
        a.st_lo = st; a.st_hi = st + 1;
        hipLaunchKernelGGL(fwd_kernel, dim3(grid), dim3(512), LDS_BYTES, stream, a);
    }
#else
    a.do_sync = 1; a.st_lo = 0; a.st_hi = NSTEPS;
    void* args[] = {&a};
    hipError_t e = hipLaunchCooperativeKernel((const void*)fwd_kernel, dim3(grid), dim3(512), args, LDS_BYTES, stream);
    if (e != hipSuccess) fprintf(stderr, "cooperative launch failed: %s (grid %d)\n", hipGetErrorString(e), grid);
#endif
}
```

```cpp
#include <hip/hip_runtime.h>
#include <hip/hip_cooperative_groups.h>
#include <cstdio>

namespace cg = cooperative_groups;

#define LAS __attribute__((address_space(3)))
typedef unsigned short bf16_t;
typedef short bf16x8 __attribute__((ext_vector_type(8)));
typedef short bf16x4 __attribute__((ext_vector_type(4)));
typedef float f32x4 __attribute__((ext_vector_type(4)));
typedef float f32x2 __attribute__((ext_vector_type(2)));
typedef unsigned u32x4 __attribute__((ext_vector_type(4)));
typedef unsigned u32x2 __attribute__((ext_vector_type(2)));

constexpr int DM = 1024, SEQL = 8192, NSEQ = 6, TTOK = NSEQ * SEQL;
constexpr int NPASS = 2, SEQP = 3, TP = SEQP * SEQL;
constexpr int INC = 8192, QKVW = 1536;
constexpr int LC = 32, NCH = SEQL / LC  , CHP = SEQP * NCH  ;
constexpr int UHK = LC * 16 + 256;
constexpr float EPSN = 1e-6f;
constexpr float QSCALE = 0.18033688011112042f;

constexpr size_t AL(size_t x) { return (x + 255) & ~(size_t)255; }
constexpr size_t WS_WIN = 4096;
constexpr size_t WS_WGLU = WS_WIN + (size_t)INC * DM * 2;
constexpr size_t WS_WA = WS_WGLU + (size_t)512 * 512 * 2;
constexpr size_t WS_WB = WS_WA + (size_t)1024 * 512 * 2;
constexpr size_t WS_WOUT = WS_WB + (size_t)1024 * 512 * 2;
constexpr size_t WS_MTC = WS_WOUT + (size_t)1024 * 1024 * 2;
constexpr size_t WS_BST = WS_MTC + (size_t)32 * 512 * UHK * 2;
constexpr size_t WS_ROPE = WS_BST + (size_t)32 * 256 * 512 * 2;
constexpr size_t WS_PW = WS_ROPE + (size_t)2 * SEQL * 32 * 4;
constexpr size_t WS_KT = WS_PW + (size_t)2 * 32 * 64 * 8;
constexpr size_t WS_Q = WS_KT + (size_t)32 * 2 * 32 * 256 * 4;
constexpr size_t WS_K = WS_Q + (size_t)TP * QKVW * 2;
constexpr size_t WS_VT = WS_K + (size_t)TP * QKVW * 2;
constexpr size_t WS_ZA = WS_VT + (size_t)TP * QKVW * 2;
constexpr size_t WS_ZB = WS_ZA + (size_t)TP * 512 * 2;
constexpr size_t WS_GA = WS_ZB + (size_t)TP * 512 * 2;
constexpr size_t WS_GB = WS_GA + (size_t)TP * 1024 * 2;
constexpr size_t WS_UH = WS_GB + (size_t)TP * 1024 * 2;
constexpr size_t WS_S = WS_UH + (size_t)32 * CHP * UHK * 2;
constexpr size_t WS_GAO = WS_S + (size_t)32 * CHP * 256 * 4;
constexpr size_t WS_BAR = WS_GAO + (size_t)TP * 512 * 2;
constexpr size_t WS_BAR_BYTES = 32768;
constexpr size_t WS_CTL = WS_BAR + WS_BAR_BYTES;
constexpr size_t WS_END = WS_CTL + 4096;
constexpr size_t WS_SB = WS_Q + (size_t)TP * 512 * 2;
constexpr size_t WS_M1 = WS_K;
constexpr size_t WS_ACC = WS_Q;
constexpr size_t OUT_HN_OFF = (size_t)SEQP * SEQL * DM * 4;

struct Args {
    const float* in[17];
    float* out;
    unsigned char* ws;
    int st_lo, st_hi;
    int do_sync, pad;
};

typedef __bf16 bf16v2 __attribute__((ext_vector_type(2)));
__device__ __forceinline__ unsigned cvt_pk_bf16(float lo, float hi) { const f32x2 v = (f32x2){lo, hi}; const bf16v2 r = __builtin_convertvector(v, bf16v2); return __builtin_bit_cast(unsigned, r); }
__device__ __forceinline__ float bf_lo(unsigned w) { return __uint_as_float(w << 16); }
__device__ __forceinline__ float bf_hi(unsigned w) { return __uint_as_float(w & 0xffff0000u); }
__device__ __forceinline__ float fast_rcp(float x) { return __builtin_amdgcn_rcpf(x); }
__device__ __forceinline__ float sigmoidf_(float x) { return fast_rcp(1.0f + __builtin_amdgcn_exp2f(-1.4426950408889634f * x)); }
__device__ __forceinline__ float siluf_(float x) { return x * sigmoidf_(x); }
__device__ __forceinline__ float gelu_tanh(float x) { const float u = x * (1.5957691216057308f + 0.07135481627260025f * x * x); return x * sigmoidf_(u); }
__device__ __forceinline__ float wave_sum(float v) {
#pragma unroll
    for (int o = 1; o < 64; o <<= 1) v += __shfl_xor(v, o);
    return v;
}
__device__ __forceinline__ const float* xrow_ptr(const float* xp, const float* xs, int tg) {
    return tg < 4 * SEQL ? xp + (size_t)tg * DM : xs + (size_t)(tg - 4 * SEQL) * DM;
}

constexpr int BM = 256, BK = 64, HALF = 128, HTB = HALF * BK * 2, STAGE_BYTES = 8 * HTB, NXCD = 8, WGM = 8;
__host__ __device__ __forceinline__ int lds_byte(int r, int c) { const int st = (r >> 4) * 2 + (c >> 5), rr = r & 15, cc = c & 31, ob = rr * 64 + cc * 2; return st * 1024 + (ob ^ (((ob >> 9) & 1) << 5)); }
__host__ __device__ __forceinline__ void stage_rc(int b, int& R, int& C) { const int st = b / 1024, sb = b % 1024, swz = sb ^ (((sb >> 9) & 1) << 5); R = (st >> 1) * 16 + swz / 64; C = (st & 1) * 32 + (swz % 64) / 2; }
__host__ __device__ __forceinline__ int perm32(int rho) { const int n = rho >> 4, i = rho & 15; return 8 * (i >> 2) + 4 * n + (i & 3); }

enum { MODE_PROJ = 0, MODE_S = 1, MODE_Y = 2, MODE_GLU = 3, MODE_A = 4, MODE_B = 5, MODE_OUT = 6 };
struct Unit { int pm, pn, bz; };
struct GemmD {
    const bf16_t* A; const bf16_t* Bt;
    int lda, ldb, K, nM, nN, nb;
    unsigned sA, sB;
    int mode, pass, lgnN;
    int u0, ustride, ucount;
};
__device__ __forceinline__ bool unit_next(const GemmD& g, int i, int G, int c, int& pm, int& pn, int& bz) {
    const bool ok = i < g.ucount;
    const int Li = ok ? g.u0 + i * g.ustride : 0;
    if (g.nb == 1) {
        const int lg = g.lgnN, q = (g.nM << lg) >> 3;
        const int wgid = (Li & 7) * q + (Li >> 3);
        const int gid = wgid >> (3 + lg), rem = wgid & ((8 << lg) - 1);
        pm = gid * 8 + (rem & 7); pn = rem >> 3; bz = 0;
    } else {
        const int nwg = g.nM * g.nN;
        const int w = Li % nwg; bz = Li / nwg; pm = w % g.nM; pn = w / g.nM;
    }
    return ok;
}

__device__ __forceinline__ void epilogue(const Args& a, LAS unsigned char* lds, const GemmD& g, const f32x4 (&acc)[2][2][4][2], const Unit& u, int wr, int wc, int fr, int fq) {
    asm volatile("" : "+v"(fr), "+v"(fq));
    unsigned char* ws = a.ws;
    const int rbase = u.pm * BM + wr * 64 + fr;
    const int cl = wc * 32 + fq * 8;
    if (g.mode == MODE_PROJ) {
        const int pn = u.pn;
        if (pn < 12) {
            const bool isq = pn < 6;
            bf16_t* dst = (bf16_t*)(ws + (isq ? WS_Q : WS_K));
            const float* rc = (const float*)(ws + WS_ROPE); const float* rs = rc + SEQL * 32;
            const int a4 = 4 * (4 * (wc & 1) + fq);
            const int pq = isq ? pn : pn - 6, gi = pq >> 1, sh = 2 * gi, dmask = (1 << sh) - 1, Lg = SEQL >> sh;
            const float sc = isq ? QSCALE : 1.0f;
            const int pos0 = rbase & (SEQL - 1);
            const f32x4 cb = *(const f32x4*)(rc + pos0 * 32 + a4), sb = *(const f32x4*)(rs + pos0 * 32 + a4);
            const f32x4 c16 = *(const f32x4*)(rc + 16 * 32 + a4), s16 = *(const f32x4*)(rs + 16 * 32 + a4);
            const f32x4 c128 = *(const f32x4*)(rc + 128 * 32 + a4), s128 = *(const f32x4*)(rs + 128 * 32 + a4);
#pragma unroll
            for (int ai = 0; ai < 2; ++ai) {
                asm volatile("" ::: "memory");
                f32x4 cvv[4], svv[4];
                cvv[0] = ai ? cb * c128 - sb * s128 : cb; svv[0] = ai ? sb * c128 + cb * s128 : sb;
#pragma unroll
                for (int m = 1; m < 4; ++m) { cvv[m] = cvv[m - 1] * c16 - svv[m - 1] * s16; svv[m] = svv[m - 1] * c16 + cvv[m - 1] * s16; }
#pragma unroll
                for (int m = 0; m < 4; ++m) {
                    const int tl = rbase + ai * HALF + m * 16; const int pos = tl & (SEQL - 1), sq = tl >> 13;
                    const int kidx = (pos & dmask) * Lg + (pos >> sh);
                    const f32x4 cv = cvv[m] * sc, sv = svv[m] * sc;
#pragma unroll
                    for (int bj = 0; bj < 2; ++bj) {
                        const f32x4 x1 = acc[ai][bj][m][0], x2 = acc[ai][bj][m][1];
                        const f32x4 o1 = x1 * cv - x2 * sv, o2 = x2 * cv + x1 * sv;
                        const int head = pq * 4 + 2 * bj + (wc >> 1);
                        const int ch = 4 * (wc & 1) + fq;
                        bf16_t* p = dst + (size_t)(sq * 24 + head) * SEQL * 64 + (isq ? (size_t)kidx * 64 + ch * 8 : (size_t)(kidx >> 4) * 1024 + ch * 128 + (kidx & 15) * 8);
                        u32x4 w; w.x = cvt_pk_bf16(o1[0], o1[1]); w.y = cvt_pk_bf16(o1[2], o1[3]); w.z = cvt_pk_bf16(o2[0], o2[1]); w.w = cvt_pk_bf16(o2[2], o2[3]);
                        *(u32x4*)p = w;
                    }
                }
            }
        } else if (pn < 18) {
            bf16_t* dst = (bf16_t*)(ws + WS_VT);
            const int gi = (pn - 12) >> 1, sh = 2 * gi;
            const int wid = wr * 4 + wc, lane = fq * 16 + fr;
            LAS bf16_t* tile = (LAS bf16_t*)(lds + STAGE_BYTES + wid * 4096);
#pragma unroll
            for (int ai = 0; ai < 2; ++ai) {
                const int tl0 = u.pm * BM + wr * 64 + ai * HALF;
                const int pos0 = tl0 & (SEQL - 1), sq = tl0 >> 13;
#pragma unroll
                for (int bj = 0; bj < 2; ++bj) {
                    asm volatile("" ::: "memory");
                    const int h = (4 * (pn - 12) + 2 * bj + (wc >> 1)) & 7;
#pragma unroll
                    for (int m = 0; m < 4; ++m) {
                        const int t = 16 * m + fr;
                        const int slot = gi == 0 ? t : (gi == 1 ? ((t & 3) * 16 + (t >> 2)) : ((t & 15) * 4 + (t >> 4)));
#pragma unroll
                        for (int n = 0; n < 2; ++n)
#pragma unroll
                            for (int j = 0; j < 4; ++j) { const unsigned w = cvt_pk_bf16(acc[ai][bj][m][n][j], 0.f); tile[(8 * fq + 4 * n + j) * 64 + slot] = (bf16_t)(w & 0xffffu); }
                    }
                    bf16_t* hb0 = dst + (size_t)(((sq * 3 + gi) * 8 + h) * 512) * 1024;
#pragma unroll
                    for (int i = 0; i < 4; ++i) {
                        const int c = lane + 64 * i, d = c & 31, s8 = (c >> 5) * 8;
                        const u32x4 v = *(const LAS u32x4*)(tile + d * 64 + s8);
                        const int dg = 32 * (wc & 1) + d; const int doff = (dg >> 4) * 256 + (dg & 15) * 4;
                        if (gi == 0) { const int kidx = pos0 + s8; bf16_t* q = hb0 + (size_t)(kidx >> 4) * 1024 + doff + ((kidx & 15) >> 2) * 64; *(u32x2*)q = (u32x2){v.x, v.y}; *(u32x2*)(q + 64) = (u32x2){v.z, v.w}; }
                        else if (gi == 1) { const int kidx = (s8 >> 4) * 2048 + (pos0 >> 2) + (s8 & 15); bf16_t* q = hb0 + (size_t)(kidx >> 4) * 1024 + doff + ((kidx & 15) >> 2) * 64; *(u32x2*)q = (u32x2){v.x, v.y}; *(u32x2*)(q + 64) = (u32x2){v.z, v.w}; }
                        else { const int ka = (s8 >> 2) * 512 + (pos0 >> 4), kb = ka + 512;
                            *(u32x2*)(hb0 + (size_t)(ka >> 4) * 1024 + doff + ((ka & 15) >> 2) * 64) = (u32x2){v.x, v.y}; *(u32x2*)(hb0 + (size_t)(kb >> 4) * 1024 + doff + ((kb & 15) >> 2) * 64) = (u32x2){v.z, v.w}; }
                    }
                }
            }
        } else if (pn == 20 || pn == 21) {
            bf16_t* dst = (bf16_t*)(ws + WS_UH);
#pragma unroll
            for (int ai = 0; ai < 2; ++ai)
#pragma unroll
                for (int m = 0; m < 4; ++m) { asm volatile("" ::: "memory");
                    const int tl = rbase + ai * HALF + m * 16;
#pragma unroll
                    for (int bj = 0; bj < 2; ++bj) {
                        const int gg = 16 * (pn - 20) + 8 * bj + 2 * wc + (fq >> 1);
                        bf16_t* p = dst + ((size_t)(gg * CHP + (tl >> 5)) * UHK) + (tl & 31) * 16 + 8 * (fq & 1);
                        const f32x4 v0 = acc[ai][bj][m][0], v1 = acc[ai][bj][m][1];
                        u32x4 w; w.x = cvt_pk_bf16(v0[0], v0[1]); w.y = cvt_pk_bf16(v0[2], v0[3]); w.z = cvt_pk_bf16(v1[0], v1[1]); w.w = cvt_pk_bf16(v1[2], v1[3]);
                        *(u32x4*)p = w;
                    }
                }
        } else {
            bf16_t* dst; int ld, c0; bool silu;
            if (pn < 20) { dst = (bf16_t*)(ws + WS_ZA); ld = 512; c0 = (pn - 18) * 256; silu = true; }
            else if (pn < 24) { dst = (bf16_t*)(ws + WS_ZB); ld = 512; c0 = (pn - 22) * 256; silu = true; }
            else if (pn < 28) { dst = (bf16_t*)(ws + WS_GA); ld = 1024; c0 = (pn - 24) * 256; silu = false; }
            else { dst = (bf16_t*)(ws + WS_GB); ld = 1024; c0 = (pn - 28) * 256; silu = false; }
#pragma unroll
            for (int ai = 0; ai < 2; ++ai)
#pragma unroll
                for (int m = 0; m < 4; ++m) { asm volatile("" ::: "memory");
                    const int tl = rbase + ai * HALF + m * 16;
#pragma unroll
                    for (int bj = 0; bj < 2; ++bj) {
                        f32x4 v0 = acc[ai][bj][m][0], v1 = acc[ai][bj][m][1];
                        if (silu) {
#pragma unroll
                            for (int j = 0; j < 4; ++j) { v0[j] *= sigmoidf_(v0[j]); v1[j] *= sigmoidf_(v1[j]); }
                        } else {
#pragma unroll
                            for (int j = 0; j < 4; ++j) { v0[j] = sigmoidf_(v0[j]); v1[j] = sigmoidf_(v1[j]); }
                        }
                        u32x4 w; w.x = cvt_pk_bf16(v0[0], v0[1]); w.y = cvt_pk_bf16(v0[2], v0[3]); w.z = cvt_pk_bf16(v1[0], v1[1]); w.w = cvt_pk_bf16(v1[2], v1[3]);
                        *(u32x4*)(dst + (size_t)tl * ld + c0 + cl + bj * HALF) = w;
                    }
                }
        }
    } else if (g.mode == MODE_S) {
        float* dst = (float*)(ws + WS_S) + (size_t)u.bz * CHP * 256;
#pragma unroll
        for (int ai = 0; ai < 2; ++ai)
#pragma unroll
            for (int m = 0; m < 4; ++m) { asm volatile("" ::: "memory");
                const int r = rbase + ai * HALF + m * 16;
#pragma unroll
                for (int bj = 0; bj < 2; ++bj) { float* p = dst + (size_t)r * 256 + cl + bj * HALF; *(f32x4*)p = acc[ai][bj][m][0]; *(f32x4*)(p + 4) = acc[ai][bj][m][1]; }
            }
    } else if (g.mode == MODE_Y) {
        bf16_t* dst = (bf16_t*)((unsigned char*)a.out + OUT_HN_OFF) + (size_t)g.pass * TP * DM;
#pragma unroll
        for (int ai = 0; ai < 2; ++ai)
#pragma unroll
            for (int m = 0; m < 4; ++m) { asm volatile("" ::: "memory");
                const int r = rbase + ai * HALF + m * 16;
#pragma unroll
                for (int bj = 0; bj < 2; ++bj) {
                    const int t = 16 * u.pn + 8 * bj + 2 * wc + (fq >> 1);
                    f32x4 v0 = acc[ai][bj][m][0], v1 = acc[ai][bj][m][1];
#pragma unroll
                    for (int j = 0; j < 4; ++j) { v0[j] = gelu_tanh(v0[j]); v1[j] = gelu_tanh(v1[j]); }
                    u32x4 w; w.x = cvt_pk_bf16(v0[0], v0[1]); w.y = cvt_pk_bf16(v0[2], v0[3]); w.z = cvt_pk_bf16(v1[0], v1[1]); w.w = cvt_pk_bf16(v1[2], v1[3]);
                    *(u32x4*)(dst + (size_t)(r * LC + t) * 512 + u.bz * 16 + 8 * (fq & 1)) = w;
                }
            }
    } else if (g.mode == MODE_GLU) {
        const bf16_t* sg = (const bf16_t*)((unsigned char*)a.out + OUT_HN_OFF) + (size_t)g.pass * TP * DM; const bf16_t* zb = (const bf16_t*)(ws + WS_ZB); bf16_t* dst = (bf16_t*)(ws + WS_SB);
        u32x4 sq4[2][2][2], zq4[2][2][2];
#define EPI_LD(ST, BUF) _Pragma("unroll") for (int m2 = 0; m2 < 2; ++m2) _Pragma("unroll") for (int bj = 0; bj < 2; ++bj) { \
            const size_t off = (size_t)(rbase + ((ST) >> 1) * HALF + (2 * ((ST) & 1) + m2) * 16) * 512 + u.pn * BM + cl + bj * HALF; sq4[BUF][m2][bj] = *(const u32x4*)(sg + off); zq4[BUF][m2][bj] = *(const u32x4*)(zb + off); }
        EPI_LD(0, 0)
#pragma unroll
        for (int st = 0; st < 4; ++st) {
            if (st == 0) EPI_LD(1, 1) else if (st == 1) EPI_LD(2, 0) else if (st == 2) EPI_LD(3, 1)
            const int ai = st >> 1, buf = st & 1;
#pragma unroll
            for (int m2 = 0; m2 < 2; ++m2)
#pragma unroll
                for (int bj = 0; bj < 2; ++bj) {
                    const int m = 2 * (st & 1) + m2;
                    const size_t off = (size_t)(rbase + ai * HALF + m * 16) * 512 + u.pn * BM + cl + bj * HALF;
                    const u32x4 s4 = sq4[buf][m2][bj], z4 = zq4[buf][m2][bj];
                    const f32x4 v0 = acc[ai][bj][m][0], v1 = acc[ai][bj][m][1];
                    u32x4 w;
                    w.x = cvt_pk_bf16(bf_lo(s4.x) * sigmoidf_(v0[0]) * bf_lo(z4.x), bf_hi(s4.x) * sigmoidf_(v0[1]) * bf_hi(z4.x));
                    w.y = cvt_pk_bf16(bf_lo(s4.y) * sigmoidf_(v0[2]) * bf_lo(z4.y), bf_hi(s4.y) * sigmoidf_(v0[3]) * bf_hi(z4.y));
                    w.z = cvt_pk_bf16(bf_lo(s4.z) * sigmoidf_(v1[0]) * bf_lo(z4.z), bf_hi(s4.z) * sigmoidf_(v1[1]) * bf_hi(z4.z));
                    w.w = cvt_pk_bf16(bf_lo(s4.w) * sigmoidf_(v1[2]) * bf_lo(z4.w), bf_hi(s4.w) * sigmoidf_(v1[3]) * bf_hi(z4.w));
                    *(u32x4*)(dst + off) = w;
                }
        }
#undef EPI_LD
    } else if (g.mode == MODE_A || g.mode == MODE_B) {
        const bool isb = g.mode == MODE_B;
        const bf16_t* gt = (const bf16_t*)(ws + (isb ? WS_GB : WS_GA)); bf16_t* dst = (bf16_t*)(ws + WS_M1);
        u32x4 gq4[2][2][2], pq4[2][2][2];
#define EPI_LD(ST, BUF) _Pragma("unroll") for (int m2 = 0; m2 < 2; ++m2) _Pragma("unroll") for (int bj = 0; bj < 2; ++bj) { \
            const size_t off = (size_t)(rbase + ((ST) >> 1) * HALF + (2 * ((ST) & 1) + m2) * 16) * 1024 + u.pn * BM + cl + bj * HALF; gq4[BUF][m2][bj] = *(const u32x4*)(gt + off); \
            pq4[BUF][m2][bj] = (u32x4){0u, 0u, 0u, 0u}; if (isb) pq4[BUF][m2][bj] = *(const u32x4*)(dst + off); }
        EPI_LD(0, 0)
#pragma unroll
        for (int st = 0; st < 4; ++st) {
            if (st == 0) EPI_LD(1, 1) else if (st == 1) EPI_LD(2, 0) else if (st == 2) EPI_LD(3, 1)
            const int ai = st >> 1, buf = st & 1;
#pragma unroll
            for (int m2 = 0; m2 < 2; ++m2)
#pragma unroll
                for (int bj = 0; bj < 2; ++bj) {
                    const int m = 2 * (st & 1) + m2;
                    const size_t off = (size_t)(rbase + ai * HALF + m * 16) * 1024 + u.pn * BM + cl + bj * HALF;
                    const u32x4 g4 = gq4[buf][m2][bj], p4 = pq4[buf][m2][bj];
                    const f32x4 v0 = acc[ai][bj][m][0], v1 = acc[ai][bj][m][1];
                    u32x4 w;
                    w.x = cvt_pk_bf16(bf_lo(p4.x) + bf_lo(g4.x) * v0[0], bf_hi(p4.x) + bf_hi(g4.x) * v0[1]);
                    w.y = cvt_pk_bf16(bf_lo(p4.y) + bf_lo(g4.y) * v0[2], bf_hi(p4.y) + bf_hi(g4.y) * v0[3]);
                    w.z = cvt_pk_bf16(bf_lo(p4.z) + bf_lo(g4.z) * v1[0], bf_hi(p4.z) + bf_hi(g4.z) * v1[1]);
                    w.w = cvt_pk_bf16(bf_lo(p4.w) + bf_lo(g4.w) * v1[2], bf_hi(p4.w) + bf_hi(g4.w) * v1[3]);
                    *(u32x4*)(dst + off) = w;
                }
        }
#undef EPI_LD
    } else {
        bf16_t* dst = (bf16_t*)(ws + WS_ACC);
#pragma unroll
        for (int ai = 0; ai < 2; ++ai)
#pragma unroll
            for (int m = 0; m < 4; ++m) {
                const int tl = rbase + ai * HALF + m * 16;
#pragma unroll
                for (int bj = 0; bj < 2; ++bj) {
                    const f32x4 v0 = acc[ai][bj][m][0], v1 = acc[ai][bj][m][1];
                    u32x4 w; w.x = cvt_pk_bf16(v0[0], v0[1]); w.y = cvt_pk_bf16(v0[2], v0[3]); w.z = cvt_pk_bf16(v1[0], v1[1]); w.w = cvt_pk_bf16(v1[2], v1[3]);
                    *(u32x4*)(dst + (size_t)tl * DM + u.pn * BM + cl + bj * HALF) = w;
                }
            }
    }
}

__device__ __forceinline__ void gemm_phase(const Args& a, LAS unsigned char* lds, const GemmD& g, int G, int cidx, int tid) {
    const int wid = __builtin_amdgcn_readfirstlane(tid >> 6), lane = tid & 63, wr = wid >> 2, wc = wid & 3, fr = lane & 15, fq = lane >> 4;
    const int K = g.K, nt = K / BK;
    unsigned voffA[2], voffB[2];
#pragma unroll
    for (int i = 0; i < 2; ++i) { int R, C; stage_rc(tid * 16 + i * 8192, R, C); const int Rb = (R & ~31) + perm32(R & 31);
        voffA[i] = (unsigned)(R * g.lda + C) * 2u; voffB[i] = (unsigned)(Rb * g.ldb + C) * 2u; }
    const size_t kstep = (size_t)(BK * 2);
    const size_t hstepA = (size_t)HALF * g.lda * 2, hstepB = (size_t)HALF * g.ldb * 2;
    const size_t tstepA = 2 * hstepA, tstepB = 2 * hstepB;
    const unsigned ldsw = (unsigned)wid * 1024u;
    const int aoff = lds_byte(wr * 64 + fr, fq * 8), boff = lds_byte(wc * 32 + fr, fq * 8);
#define PG8_SA(b, h) (((b) * 2 + (h)) * HTB)
#define PG8_SB(b, h) ((4 + (b) * 2 + (h)) * HTB)
#define PG8_STAGE(bufoff, gbase, voff) do { _Pragma("unroll") for (int _i = 0; _i < 2; ++_i) \
        __builtin_amdgcn_global_load_lds((const unsigned*)((const char*)(gbase) + (voff)[_i]), (LAS unsigned*)(lds + (bufoff) + ldsw + _i * 8192), 16, 0, 0); } while (0)
#define PG8_LDA(dst, b, h) do { _Pragma("unroll") for (int m = 0; m < 4; ++m) _Pragma("unroll") for (int k = 0; k < 2; ++k) dst[m][k] = *(const LAS bf16x8*)(lds + PG8_SA(b, h) + aoff + m * 2048 + k * 1024); } while (0)
#define PG8_LDB(dst, b, h) do { _Pragma("unroll") for (int n = 0; n < 2; ++n) _Pragma("unroll") for (int k = 0; k < 2; ++k) dst[n][k] = *(const LAS bf16x8*)(lds + PG8_SB(b, h) + boff + n * 2048 + k * 1024); } while (0)
#define PG8_MMA(ai, bj, At, Bt) do { __builtin_amdgcn_s_setprio(1); _Pragma("unroll") for (int m = 0; m < 4; ++m) _Pragma("unroll") for (int n = 0; n < 2; ++n) _Pragma("unroll") for (int k = 0; k < 2; ++k) \
        acc[ai][bj][m][n] = __builtin_amdgcn_mfma_f32_16x16x32_bf16(Bt[n][k], At[m][k], acc[ai][bj][m][n], 0, 0, 0); __builtin_amdgcn_s_setprio(0); } while (0)
#define PG8_WAIT_V(n) asm volatile("s_waitcnt vmcnt(" #n ")" ::: "memory")
#define PG8_WAIT_L(n) asm volatile("s_waitcnt lgkmcnt(" #n ")" ::: "memory")
#define PG8_BAR __builtin_amdgcn_s_barrier()
#define PG8_SCHED __builtin_amdgcn_sched_barrier(0)
    Unit cur, nxt; int ui = 0;
    { int pm_, pn_, bz_; if (!unit_next(g, 0, G, cidx, pm_, pn_, bz_)) return; cur.pm = pm_; cur.pn = pn_; cur.bz = bz_; }
    f32x4 acc[2][2][4][2];
#pragma unroll
    for (int a = 0; a < 2; ++a)
#pragma unroll
        for (int b = 0; b < 2; ++b)
#pragma unroll
            for (int m = 0; m < 4; ++m)
#pragma unroll
                for (int n = 0; n < 2; ++n) acc[a][b][m][n] = (f32x4){0.f, 0.f, 0.f, 0.f};
    bf16x8 At[4][2], B0[2][2], B1[2][2];
    const char* cA = (const char*)g.A + (size_t)cur.bz * g.sA + (size_t)cur.pm * tstepA; const char* cB = (const char*)g.Bt + (size_t)cur.bz * g.sB + (size_t)cur.pn * tstepB;
    PG8_STAGE(PG8_SB(0, 0), cB, voffB); PG8_STAGE(PG8_SA(0, 0), cA, voffA); PG8_STAGE(PG8_SB(0, 1), cB + hstepB, voffB); PG8_STAGE(PG8_SA(0, 1), cA + hstepA, voffA);
    if (wr == 1) PG8_BAR;
    PG8_WAIT_V(4); PG8_BAR;
    PG8_STAGE(PG8_SB(1, 0), cB + kstep, voffB); PG8_STAGE(PG8_SA(1, 0), cA + kstep, voffA); PG8_STAGE(PG8_SB(1, 1), cB + hstepB + kstep, voffB);
    PG8_WAIT_V(6); PG8_BAR;
    for (;;) {
        int npm, npn, nbz; const bool has_next = unit_next(g, ui + 1, G, cidx, npm, npn, nbz); nxt.pm = npm; nxt.pn = npn; nxt.bz = nbz;
        const char* nA = has_next ? (const char*)g.A + (size_t)nxt.bz * g.sA + (size_t)nxt.pm * tstepA : cA; const char* nB = has_next ? (const char*)g.Bt + (size_t)nxt.bz * g.sB + (size_t)nxt.pn * tstepB : cB;
        for (int t = 0; t < nt; t += 2) {
            const bool last = (t == nt - 2);
            const char* a1 = cA + (size_t)(t + 1) * kstep;
            const char* a2 = last ? nA : cA + (size_t)(t + 2) * kstep; const char* b2 = last ? nB : cB + (size_t)(t + 2) * kstep;
            const char* a3 = a2 + kstep; const char* b3 = b2 + kstep;
            PG8_LDB(B0, 0, 0); PG8_SCHED; PG8_LDA(At, 0, 0); PG8_STAGE(PG8_SA(1, 1), a1 + hstepA, voffA);
            PG8_WAIT_L(8); PG8_BAR; PG8_WAIT_L(0); PG8_MMA(0, 0, At, B0); PG8_BAR; PG8_SCHED;
            PG8_LDB(B1, 0, 1); PG8_STAGE(PG8_SB(0, 0), b2, voffB);
            PG8_BAR; PG8_WAIT_L(0); PG8_MMA(0, 1, At, B1); PG8_BAR;
            PG8_LDA(At, 0, 1); PG8_STAGE(PG8_SA(0, 0), a2, voffA);
            PG8_BAR; PG8_WAIT_L(0); PG8_MMA(1, 0, At, B0); PG8_BAR; PG8_SCHED;
            PG8_STAGE(PG8_SB(0, 1), b2 + hstepB, voffB);
            PG8_WAIT_V(6); PG8_BAR; PG8_MMA(1, 1, At, B1); PG8_BAR;
            PG8_LDB(B0, 1, 0); PG8_SCHED; PG8_LDA(At, 1, 0); PG8_STAGE(PG8_SA(0, 1), a2 + hstepA, voffA);
            PG8_WAIT_L(8); PG8_BAR; PG8_WAIT_L(0); PG8_MMA(0, 0, At, B0); PG8_BAR; PG8_SCHED;
            PG8_LDB(B1, 1, 1); PG8_STAGE(PG8_SB(1, 0), b3, voffB);
            PG8_BAR; PG8_WAIT_L(0); PG8_MMA(0, 1, At, B1); PG8_BAR;
            PG8_LDA(At, 1, 1); PG8_STAGE(PG8_SA(1, 0), a3, voffA);
            PG8_BAR; PG8_WAIT_L(0); PG8_MMA(1, 0, At, B0); PG8_BAR; PG8_SCHED;
            PG8_STAGE(PG8_SB(1, 1), b3 + hstepB, voffB);
            PG8_WAIT_V(6); PG8_BAR; PG8_MMA(1, 1, At, B1); PG8_BAR;
        }
#ifndef NO_EPI
        epilogue(a, lds, g, acc, cur, wr, wc, fr, fq);
#else
        if (g.mode == 99) *(f32x4*)(g.out) = acc[0][0][0][0] + acc[1][1][3][1] + acc[0][1][2][0]+acc[1][0][1][1];
#endif
        if (!has_next) break;
#pragma unroll
        for (int a = 0; a < 2; ++a)
#pragma unroll
            for (int b = 0; b < 2; ++b)
#pragma unroll
                for (int m = 0; m < 4; ++m)
#pragma unroll
                    for (int n = 0; n < 2; ++n) acc[a][b][m][n] = (f32x4){0.f, 0.f, 0.f, 0.f};
        cur = nxt; cA = nA; cB = nB; ++ui;
    }
    PG8_WAIT_V(0);
    if (wr == 0) PG8_BAR;
    PG8_BAR;
#undef PG8_SA
#undef PG8_SB
#undef PG8_STAGE
#undef PG8_LDA
#undef PG8_LDB
#undef PG8_MMA
#undef PG8_WAIT_V
#undef PG8_WAIT_L
#undef PG8_BAR
#undef PG8_SCHED
}

__device__ __forceinline__ int qk_perm_row(int n) { const int i = n & 63; return (n & ~63) + 8 * ((i & 31) >> 2) + (i & 3) + 4 * (i >> 5); }
__device__ __forceinline__ void transpose_item(const float* W, int K, int N, bf16_t* WT, bool permqk, LAS float* scr, int item, int lane) {
    const int nblk = N / 32, kb = item / nblk, nb = item % nblk, k0 = 64 * kb, n0 = 32 * nb;
#pragma unroll 8
    for (int i = 0; i < 32; ++i) { const int kk = 2 * i + (lane >> 5); scr[kk * 33 + (lane & 31)] = W[(size_t)(k0 + kk) * N + n0 + (lane & 31)]; }
    asm volatile("s_waitcnt lgkmcnt(0)" ::: "memory");
    const int c = lane & 7;
#pragma unroll
    for (int j = 0; j < 4; ++j) { const int n = (lane >> 3) + 8 * j; const LAS float* s = scr + (8 * c) * 33 + n;
        u32x4 o; o.x = cvt_pk_bf16(s[0 * 33], s[1 * 33]); o.y = cvt_pk_bf16(s[2 * 33], s[3 * 33]); o.z = cvt_pk_bf16(s[4 * 33], s[5 * 33]); o.w = cvt_pk_bf16(s[6 * 33], s[7 * 33]);
        int row = n0 + n; if (permqk && row < 2 * QKVW) row = qk_perm_row(row);
        *(u32x4*)(WT + (size_t)row * K + k0 + 8 * c) = o; }
    asm volatile("s_waitcnt lgkmcnt(0)" ::: "memory");
}
__device__ __forceinline__ void reduce_angle(double a, float& c, float& s) {
    const double k = __builtin_rint(a * 0.6366197723675814); const float x = (float)(a - k * 1.5707963267948966), x2 = x * x;
    const float sn = x * (1.0f + x2 * (-1.6666666667e-1f + x2 * (8.3333333333e-3f + x2 * (-1.9841269841e-4f + x2 * 2.7557319224e-6f))));
    const float cs = 1.0f + x2 * (-0.5f + x2 * (4.1666666667e-2f + x2 * (-1.3888888889e-3f + x2 * (2.4801587302e-5f + x2 * -2.7557319224e-7f))));
    const int q = ((int)k) & 3;
    c = (q == 0) ? cs : (q == 1) ? -sn : (q == 2) ? -cs : sn;
    s = (q == 0) ? sn : (q == 1) ? cs : (q == 2) ? -sn : -cs;
}
__device__ __forceinline__ void rms_row_to_bf16(const float* xrow, const float* gw, bf16_t* orow, int lane) {
    const f32x4* xr = (const f32x4*)xrow + lane; const f32x4* gr = (const f32x4*)gw + lane;
    f32x4 v[4]; float s = 0.f;
#pragma unroll
    for (int j = 0; j < 4; ++j) { v[j] = xr[64 * j]; s += (v[j].x * v[j].x + v[j].y * v[j].y) + (v[j].z * v[j].z + v[j].w * v[j].w); }
    const float rstd = 1.0f / sqrtf(wave_sum(s) * (1.f / DM) + EPSN);
    u32x2* o8 = (u32x2*)orow + lane;
#pragma unroll
    for (int j = 0; j < 4; ++j) { const f32x4 gv = gr[64 * j]; u32x2 w; w.x = cvt_pk_bf16(v[j].x * rstd * gv.x, v[j].y * rstd * gv.y); w.y = cvt_pk_bf16(v[j].z * rstd * gv.z, v[j].w * rstd * gv.w); o8[64 * j] = w; }
}

__device__ __forceinline__ void ssm_load_bc(const Args& a, int g, int dir, LAS f32x2* Bb, LAS f32x2* Cc, int tid) {
    const float* lam_re = a.in[4]; const float* lam_im = a.in[5]; const float* log_step = a.in[6];
    const float* b_re = a.in[7]; const float* b_im = a.in[8]; const float* c_re = a.in[9]; const float* c_im = a.in[10];
    const float dt = expf(log_step[dir * 32 + g]);
    for (int idx = tid; idx < 1024; idx += 512) {
        { const int n = idx >> 4; const float lr = lam_re[(dir * 32 + g) * 64 + n], li = lam_im[(dir * 32 + g) * 64 + n];
          const float ar = lr * dt; float cb, sb, ch, sh; reduce_angle((double)li * (double)dt, cb, sb); reduce_angle(0.5 * (double)li * (double)dt, ch, sh);
          const float em1 = expm1f(ar), ea = em1 + 1.0f;
          const float nr = em1 * cb - 2.0f * sh * sh, ni = ea * sb;
          const float den = 1.0f / (lr * lr + li * li); const float cr = (nr * lr + ni * li) * den, ci = (ni * lr - nr * li) * den;
          const float br = b_re[(size_t)((dir * 32 + g) * 64) * 16 + idx], bi = b_im[(size_t)((dir * 32 + g) * 64) * 16 + idx];
          Bb[idx] = (f32x2){cr * br - ci * bi, cr * bi + ci * br}; }
        { Cc[idx] = (f32x2){c_re[(size_t)((dir * 32 + g) * 16) * 64 + idx], c_im[(size_t)((dir * 32 + g) * 16) * 64 + idx]}; }
    }
}
__device__ __forceinline__ void ssm_setup_item(const Args& a, LAS unsigned char* lds, int item, int tid) {
    const int g = item >> 1, dir = item & 1;
    LAS f32x2* pw = (LAS f32x2*)lds; LAS f32x2* Bb = pw + 33 * 64; LAS f32x2* Cc = Bb + 1024;
    LAS float* KT = (LAS float*)(Cc + 1024); LAS float* K0 = KT + 32 * 256; LAS f32x2* Bb0 = (LAS f32x2*)(K0 + 256); LAS f32x2* Cc0 = Bb0 + 1024;
    const float* lam_re = a.in[4]; const float* lam_im = a.in[5]; const float* log_step = a.in[6];
    unsigned char* ws = a.ws;
    const float dt = expf(log_step[dir * 32 + g]);
    __syncthreads();
    for (int idx = tid; idx < 33 * 64; idx += 512) {
        const int tau = idx >> 6, n = idx & 63; const float lr = lam_re[(dir * 32 + g) * 64 + n], li = lam_im[(dir * 32 + g) * 64 + n];
        const float mag = expf(lr * dt * (float)tau); float c, s; reduce_angle((double)li * (double)dt * (double)tau, c, s);
        pw[idx] = (f32x2){mag * c, mag * s};
    }
    ssm_load_bc(a, g, dir, Bb, Cc, tid);
    if (dir == 1) ssm_load_bc(a, g, 0, Bb0, Cc0, tid);
    __syncthreads();
    if (tid < 64) { float* PW = (float*)(ws + WS_PW); const f32x2 p = pw[32 * 64 + tid]; PW[((dir * 32 + g) * 64 + tid) * 2] = p.x; PW[((dir * 32 + g) * 64 + tid) * 2 + 1] = p.y; }
    for (int o = tid; o < 32 * 256; o += 512) {
        const int tau = o >> 8, co = (o >> 4) & 15, ci = o & 15; float acc = 0.f;
_Pragma("unroll 4")
        for (int n = 0; n < 64; ++n) { const f32x2 c = Cc[co * 64 + n], p = pw[tau * 64 + n], b = Bb[n * 16 + ci]; const float tr = c.x * p.x - c.y * p.y, ti = c.x * p.y + c.y * p.x; acc += tr * b.x - ti * b.y; }
        KT[o] = acc; }
    if (dir == 1 && tid < 256) { const int co = tid >> 4, ci = tid & 15; float acc = 0.f;
_Pragma("unroll 4")
        for (int n = 0; n < 64; ++n) { const f32x2 c = Cc0[co * 64 + n], b = Bb0[n * 16 + ci]; acc += c.x * b.x - c.y * b.y; }
        K0[tid] = acc; }
    { bf16_t* BsT = (bf16_t*)(ws + WS_BST) + (size_t)g * 256 * 512;
      for (int ch = tid; ch < 128 * 64; ch += 512) {
          const int row = ch >> 6, part = row >> 6, n = row & 63, kc = ch & 63, s = kc >> 1, ci0 = (kc & 1) * 8; const int e = dir ? s : 31 - s; const f32x2 p = pw[e * 64 + n];
          float v[8];
#pragma unroll
          for (int j = 0; j < 8; ++j) { const f32x2 b = Bb[n * 16 + ci0 + j]; v[j] = part ? (p.x * b.y + p.y * b.x) : (p.x * b.x - p.y * b.y); }
          u32x4 w; w.x = cvt_pk_bf16(v[0], v[1]); w.y = cvt_pk_bf16(v[2], v[3]); w.z = cvt_pk_bf16(v[4], v[5]); w.w = cvt_pk_bf16(v[6], v[7]);
          *(u32x4*)(BsT + (size_t)(dir * 128 + row) * 512 + s * 16 + ci0) = w; } }
    bf16_t* MtC = (bf16_t*)(ws + WS_MTC) + (size_t)g * 512 * UHK;
    { for (int ch = tid; ch < 512 * 16; ch += 512) {
          const int row = ch >> 4, t = row >> 4, co = row & 15, cc = ch & 15, part = cc >> 3, n0 = (cc & 7) * 8; const int e = dir ? 32 - t : t + 1;
          float v[8];
#pragma unroll
          for (int j = 0; j < 8; ++j) { const f32x2 c = Cc[co * 64 + n0 + j], p = pw[e * 64 + n0 + j]; v[j] = part ? -(c.x * p.y + c.y * p.x) : (c.x * p.x - c.y * p.y); }
          u32x4 w; w.x = cvt_pk_bf16(v[0], v[1]); w.y = cvt_pk_bf16(v[2], v[3]); w.z = cvt_pk_bf16(v[4], v[5]); w.w = cvt_pk_bf16(v[6], v[7]);
          *(u32x4*)(MtC + (size_t)row * UHK + 512 + dir * 128 + part * 64 + n0) = w; } }
    __syncthreads();
    { const float* dsk = a.in[11];
      for (int ch = tid; ch < 512 * 64; ch += 512) {
          const int kc = ch & 63, row = ch >> 6; const int s = kc >> 1, ci0 = (kc & 1) * 8, t = row >> 4, co = row & 15;
          if (dir == 0 ? (t > s) : (s >= t)) {
              const int tau = dir == 0 ? t - s : s - t;
              float v[8];
#pragma unroll
              for (int j = 0; j < 8; ++j) v[j] = KT[tau * 256 + co * 16 + ci0 + j];
              if (t == s) { const float dv = dsk[g * 16 + co];
#pragma unroll
                  for (int j = 0; j < 8; ++j) v[j] += K0[co * 16 + ci0 + j] + ((ci0 + j == co) ? dv : 0.f); }
              u32x4 w; w.x = cvt_pk_bf16(v[0], v[1]); w.y = cvt_pk_bf16(v[2], v[3]); w.z = cvt_pk_bf16(v[4], v[5]); w.w = cvt_pk_bf16(v[6], v[7]);
              *(u32x4*)(MtC + (size_t)row * UHK + s * 16 + ci0) = w;
          }
      } }
    __syncthreads();
}

__device__ __forceinline__ void step_setup(const Args& a, LAS unsigned char* lds, int tid, int bx) {
    const int lane = tid & 63, wave = tid >> 6, G = gridDim.x;
    unsigned char* ws = a.ws;
    for (int it = bx; it < 64; it += G) ssm_setup_item(a, lds, it, tid);
    { float* rc = (float*)(ws + WS_ROPE); float* rs = rc + SEQL * 32;
      for (int idx = bx * 512 + tid; idx < SEQL * 32; idx += G * 512) {
          const int pos = idx >> 5, i = idx & 31; double inv = 1.0; for (int k = 0; k < i; ++k) inv *= 0.7498942093324558;
          float c, s; reduce_angle((double)pos * inv, c, s); rc[idx] = c; rs[idx] = s; } }
    { LAS float* scr = (LAS float*)(lds) + wave * (64 * 33);
      const int gw = bx * 8 + wave, NGW = G * 8;
      constexpr int I_IN = (DM / 64) * (INC / 32), I_GLU = (512 / 64) * (512 / 32), I_AB = (512 / 64) * (1024 / 32), I_OUT = (1024 / 64) * (1024 / 32);
      constexpr int NIT = I_IN + I_GLU + 2 * I_AB + I_OUT;
      for (int it = gw; it < NIT; it += NGW) {
          int r = it;
          if (r < I_IN) { transpose_item(a.in[3], DM, INC, (bf16_t*)(ws + WS_WIN), true, scr, r, lane); continue; } r -= I_IN;
          if (r < I_GLU) { transpose_item(a.in[12], 512, 512, (bf16_t*)(ws + WS_WGLU), false, scr, r, lane); continue; } r -= I_GLU;
          if (r < I_AB) { transpose_item(a.in[13], 512, 1024, (bf16_t*)(ws + WS_WA), false, scr, r, lane); continue; } r -= I_AB;
          if (r < I_AB) { transpose_item(a.in[14], 512, 1024, (bf16_t*)(ws + WS_WB), false, scr, r, lane); continue; } r -= I_AB;
          transpose_item(a.in[15], 1024, 1024, (bf16_t*)(ws + WS_WOUT), false, scr, r, lane);
      } }
    { bf16_t* hn = (bf16_t*)((unsigned char*)a.out + OUT_HN_OFF);
      const f32x4* gr = (const f32x4*)a.in[2] + lane;
      f32x4 gv[4];
#pragma unroll
      for (int j = 0; j < 4; ++j) gv[j] = gr[64 * j];
      unsigned* rctr = (unsigned*)(ws + WS_CTL) + 4;
      constexpr int RCH = 16;
      for (;;) {
          unsigned cidx = 0; if (lane == 0) cidx = atomicAdd(rctr, 1u);
          cidx = (unsigned)__builtin_amdgcn_readfirstlane((int)cidx);
          if (cidx >= (unsigned)(TTOK / RCH)) break;
          int row = (int)cidx * RCH; const int rend = row + RCH;
          f32x4 nx[4];
          { const f32x4* xr = (const f32x4*)xrow_ptr(a.in[0], a.in[1], row) + lane;
#pragma unroll
            for (int j = 0; j < 4; ++j) nx[j] = __builtin_nontemporal_load(xr + 64 * j); }
          for (; row < rend; ++row) {
              f32x4 v[4];
#pragma unroll
              for (int j = 0; j < 4; ++j) v[j] = nx[j];
              if (row + 1 < rend) { const f32x4* xn = (const f32x4*)xrow_ptr(a.in[0], a.in[1], row + 1) + lane;
#pragma unroll
                  for (int j = 0; j < 4; ++j) nx[j] = __builtin_nontemporal_load(xn + 64 * j); }
              float s = 0.f;
#pragma unroll
              for (int j = 0; j < 4; ++j) s += (v[j].x * v[j].x + v[j].y * v[j].y) + (v[j].z * v[j].z + v[j].w * v[j].w);
              const float rstd = 1.0f / sqrtf(wave_sum(s) * (1.f / DM) + EPSN);
              u32x2* o8 = (u32x2*)(hn + (size_t)row * DM) + lane;
#pragma unroll
              for (int j = 0; j < 4; ++j) { u32x2 w; w.x = cvt_pk_bf16(v[j].x * rstd * gv[j].x, v[j].y * rstd * gv[j].y); w.y = cvt_pk_bf16(v[j].z * rstd * gv[j].z, v[j].w * rstd * gv[j].w); o8[64 * j] = w; }
          }
      } }
}

__device__ __forceinline__ float quad_max(float x) {
    const auto r = __builtin_amdgcn_permlane32_swap(__float_as_uint(x), __float_as_uint(x), false, false);
    x = fmaxf(__uint_as_float(r[0]), __uint_as_float(r[1]));
    const auto q = __builtin_amdgcn_permlane16_swap(__float_as_uint(x), __float_as_uint(x), false, false);
    return fmaxf(__uint_as_float(q[0]), __uint_as_float(q[1]));
}
__device__ __forceinline__ float quad_sum(float x) {
    const auto r = __builtin_amdgcn_permlane32_swap(__float_as_uint(x), __float_as_uint(x), false, false);
    x = __uint_as_float(r[0]) + __uint_as_float(r[1]);
    const auto q = __builtin_amdgcn_permlane16_swap(__float_as_uint(x), __float_as_uint(x), false, false);
    return __uint_as_float(q[0]) + __uint_as_float(q[1]);
}
struct KVBuf { bf16x8 kA0, kA1, kB0, kB1; bf16x4 vA[4], vB[4]; };
__device__ __forceinline__ void step_params(int s, int& gi, int& ls) { gi = s < 12 ? 0 : (s < 18 ? 1 : 2); ls = s < 12 ? s : (s < 18 ? s - 12 : s - 18); }
__device__ __forceinline__ void attn_load(KVBuf& b, const bf16_t* Kp, const bf16_t* Vt, int s, int sq, int h, int blk, int r, int lane) {
    int gi, ls; step_params(s, gi, ls);
    const int sh = 2 * gi, Lg = SEQL >> sh, rho = r & ((1 << sh) - 1);
    int uA = ((256 * blk) >> sh) - 64 + 32 * ls, uB = uA + 16;
    if (uA < 0 || uA >= Lg) uA = 0; if (uB < 0 || uB >= Lg) uB = 0;
    const int kl = lane & 15, quad = lane >> 4;
    const bf16_t* kh = Kp + (size_t)(sq * 24 + gi * 8 + h) * SEQL * 64 + quad * 128 + kl * 8;
    const bf16_t* ka = kh + (size_t)((rho * Lg + uA) >> 4) * 1024; const bf16_t* kb = kh + (size_t)((rho * Lg + uB) >> 4) * 1024;
    b.kA0 = *(const bf16x8*)ka; b.kA1 = *(const bf16x8*)(ka + 512); b.kB0 = *(const bf16x8*)kb; b.kB1 = *(const bf16x8*)(kb + 512);
    const bf16_t* vbase = Vt + (size_t)(((sq * 3 + gi) * 8 + h) * 512) * 1024 + quad * 64 + kl * 4;
    const bf16_t* va = vbase + (size_t)((rho * Lg + uA) >> 4) * 1024; const bf16_t* vb = vbase + (size_t)((rho * Lg + uB) >> 4) * 1024;
#pragma unroll
    for (int dt = 0; dt < 4; ++dt) { b.vA[dt] = *(const bf16x4*)(va + dt * 256); b.vB[dt] = *(const bf16x4*)(vb + dt * 256); }
}
struct QF { bf16x8 a0, a1, b0, b1, c0, c1; };
template <int gi>
__device__ __forceinline__ void attn_compute(const KVBuf& b, const bf16x8 q0, const bf16x8 q1, f32x4 (&o)[4], float& mrun, float& lrun, int s, int blk, int r, int lane) {
    const int ls = gi == 0 ? s : (gi == 1 ? s - 12 : s - 18);
    const int sh = 2 * gi, Lg = SEQL >> sh;
    const int uA = ((256 * blk) >> sh) - 64 + 32 * ls;
    const int qi = lane & 15, quad = lane >> 4;
    const int uq = (256 * blk + r + 16 * qi) >> sh;
    const int lo = max(0, uq - 64), hi = min(Lg - 1, uq + 64);
    f32x4 sA = (f32x4){0.f, 0.f, 0.f, 0.f}, sB = sA;
    sA = __builtin_amdgcn_mfma_f32_16x16x32_bf16(b.kA0, q0, sA, 0, 0, 0); sA = __builtin_amdgcn_mfma_f32_16x16x32_bf16(b.kA1, q1, sA, 0, 0, 0);
    sB = __builtin_amdgcn_mfma_f32_16x16x32_bf16(b.kB0, q0, sB, 0, 0, 0); sB = __builtin_amdgcn_mfma_f32_16x16x32_bf16(b.kB1, q1, sB, 0, 0, 0);
    const float NEGINF = -__builtin_inff();
    const unsigned span = (unsigned)(hi - lo);
    float mx = NEGINF;
#pragma unroll
    for (int j = 0; j < 4; ++j) {
        const int ua = uA + quad * 4 + j, ub = ua + 16;
        sA[j] = ((unsigned)(ua - lo) <= span) ? sA[j] : NEGINF; sB[j] = ((unsigned)(ub - lo) <= span) ? sB[j] : NEGINF;
        mx = fmaxf(mx, fmaxf(sA[j], sB[j]));
    }
    mx = quad_max(mx);
    const float mnew = fmaxf(mrun, mx), alpha = __builtin_amdgcn_exp2f(mrun - mnew);
    mrun = mnew;
    float ps = 0.f;
#pragma unroll
    for (int j = 0; j < 4; ++j) { sA[j] = __builtin_amdgcn_exp2f(sA[j] - mnew); sB[j] = __builtin_amdgcn_exp2f(sB[j] - mnew); ps += sA[j] + sB[j]; }
    lrun = lrun * alpha + ps;
    u32x4 pw; pw.x = cvt_pk_bf16(sA[0], sA[1]); pw.y = cvt_pk_bf16(sA[2], sA[3]); pw.z = cvt_pk_bf16(sB[0], sB[1]); pw.w = cvt_pk_bf16(sB[2], sB[3]);
    const bf16x8 pf = __builtin_bit_cast(bf16x8, pw);
#pragma unroll
    for (int dt = 0; dt < 4; ++dt) {
        o[dt] *= alpha;
        bf16x8 vf; vf[0] = b.vA[dt][0]; vf[1] = b.vA[dt][1]; vf[2] = b.vA[dt][2]; vf[3] = b.vA[dt][3]; vf[4] = b.vB[dt][0]; vf[5] = b.vB[dt][1]; vf[6] = b.vB[dt][2]; vf[7] = b.vB[dt][3];
#ifdef DBG_ATT2
        for (int e = 0; e < 8; ++e) o[dt][e & 3] += 1e-3f * __uint_as_float(((unsigned)(unsigned short)vf[e]) << 16);
#else
        o[dt] = __builtin_amdgcn_mfma_f32_16x16x32_bf16(vf, pf, o[dt], 0, 0, 0);
#endif
    }
}
template <int gi>
__device__ __forceinline__ void attn_compute2(const KVBuf& b, const KVBuf& c, const bf16x8 q0, const bf16x8 q1, f32x4 (&o)[4], float& mrun, float& lrun, int s, int blk, int r, int lane) {
    const int ls = gi == 0 ? s : (gi == 1 ? s - 12 : s - 18);
    const int sh = 2 * gi, Lg = SEQL >> sh;
    const int uA = ((256 * blk) >> sh) - 64 + 32 * ls;
    const int qi = lane & 15, quad = lane >> 4;
    const int uq = (256 * blk + r + 16 * qi) >> sh;
    const int lo = max(0, uq - 64), hi = min(Lg - 1, uq + 64);
    const f32x4 z4 = (f32x4){0.f, 0.f, 0.f, 0.f};
    f32x4 sA = __builtin_amdgcn_mfma_f32_16x16x32_bf16(b.kA0, q0, z4, 0, 0, 0), sB = __builtin_amdgcn_mfma_f32_16x16x32_bf16(b.kB0, q0, z4, 0, 0, 0);
    f32x4 sC = __builtin_amdgcn_mfma_f32_16x16x32_bf16(c.kA0, q0, z4, 0, 0, 0), sD = __builtin_amdgcn_mfma_f32_16x16x32_bf16(c.kB0, q0, z4, 0, 0, 0);
    sA = __builtin_amdgcn_mfma_f32_16x16x32_bf16(b.kA1, q1, sA, 0, 0, 0); sB = __builtin_amdgcn_mfma_f32_16x16x32_bf16(b.kB1, q1, sB, 0, 0, 0);
    sC = __builtin_amdgcn_mfma_f32_16x16x32_bf16(c.kA1, q1, sC, 0, 0, 0); sD = __builtin_amdgcn_mfma_f32_16x16x32_bf16(c.kB1, q1, sD, 0, 0, 0);
    const float NEGINF = -__builtin_inff();
    const unsigned span = (unsigned)(hi - lo);
    float mx = NEGINF;
#pragma unroll
    for (int j = 0; j < 4; ++j) {
        const int ua = uA + quad * 4 + j;
        sA[j] = ((unsigned)(ua - lo) <= span) ? sA[j] : NEGINF; sB[j] = ((unsigned)(ua + 16 - lo) <= span) ? sB[j] : NEGINF;
        sC[j] = ((unsigned)(ua + 32 - lo) <= span) ? sC[j] : NEGINF; sD[j] = ((unsigned)(ua + 48 - lo) <= span) ? sD[j] : NEGINF;
        mx = fmaxf(fmaxf(mx, fmaxf(sA[j], sB[j])), fmaxf(sC[j], sD[j]));
    }
    mx = quad_max(mx);
    const float mnew = fmaxf(mrun, mx), alpha = __builtin_amdgcn_exp2f(mrun - mnew);
    mrun = mnew;
    float ps = 0.f;
#pragma unroll
    for (int j = 0; j < 4; ++j) { sA[j] = __builtin_amdgcn_exp2f(sA[j] - mnew); sB[j] = __builtin_amdgcn_exp2f(sB[j] - mnew); sC[j] = __builtin_amdgcn_exp2f(sC[j] - mnew); sD[j] = __builtin_amdgcn_exp2f(sD[j] - mnew); ps += (sA[j] + sB[j]) + (sC[j] + sD[j]); }
    lrun = lrun * alpha + ps;
    u32x4 pw, pv; pw.x = cvt_pk_bf16(sA[0], sA[1]); pw.y = cvt_pk_bf16(sA[2], sA[3]); pw.z = cvt_pk_bf16(sB[0], sB[1]); pw.w = cvt_pk_bf16(sB[2], sB[3]);
    pv.x = cvt_pk_bf16(sC[0], sC[1]); pv.y = cvt_pk_bf16(sC[2], sC[3]); pv.z = cvt_pk_bf16(sD[0], sD[1]); pv.w = cvt_pk_bf16(sD[2], sD[3]);
    const bf16x8 pf = __builtin_bit_cast(bf16x8, pw), pg = __builtin_bit_cast(bf16x8, pv);
#pragma unroll
    for (int dt = 0; dt < 4; ++dt) {
        o[dt] *= alpha;
        bf16x8 vf, vg;
        vf[0] = b.vA[dt][0]; vf[1] = b.vA[dt][1]; vf[2] = b.vA[dt][2]; vf[3] = b.vA[dt][3]; vf[4] = b.vB[dt][0]; vf[5] = b.vB[dt][1]; vf[6] = b.vB[dt][2]; vf[7] = b.vB[dt][3];
        vg[0] = c.vA[dt][0]; vg[1] = c.vA[dt][1]; vg[2] = c.vA[dt][2]; vg[3] = c.vA[dt][3]; vg[4] = c.vB[dt][0]; vg[5] = c.vB[dt][1]; vg[6] = c.vB[dt][2]; vg[7] = c.vB[dt][3];
        o[dt] = __builtin_amdgcn_mfma_f32_16x16x32_bf16(vf, pf, o[dt], 0, 0, 0);
        o[dt] = __builtin_amdgcn_mfma_f32_16x16x32_bf16(vg, pg, o[dt], 0, 0, 0);
    }
}
__device__ __forceinline__ void step_attention(const Args& a, LAS unsigned char* lds, int pass, int tid, int bx) {
    unsigned char* ws = a.ws;
    const int lane = tid & 63;
    const bf16_t* Qp = (const bf16_t*)(ws + WS_Q); const bf16_t* Kp = (const bf16_t*)(ws + WS_K); const bf16_t* Vt = (const bf16_t*)(ws + WS_VT);
    const bf16_t* ZA = (const bf16_t*)(ws + WS_ZA); bf16_t* GAO = (bf16_t*)(ws + WS_GAO);
    const int xcd = bx & 7;
    unsigned* ctr = (unsigned*)(ws + WS_CTL) + 16 + pass * 8 + xcd;
    LAS unsigned* slot = (LAS unsigned*)(lds + 3 * 16384);
    constexpr int NGRP = 3 * 32 * 2;
    for (;;) {
        __syncthreads();
        if (tid == 0) slot[0] = atomicAdd(ctr, 1u);
        __syncthreads();
        const unsigned grp = (unsigned)__builtin_amdgcn_readfirstlane((int)slot[0]);
        if (grp >= (unsigned)NGRP) break;
        const int wv_ = tid >> 6; const int r = ((wv_ & 3) << 2) + (wv_ >> 2) + 2 * (int)(grp & 1)  , blk = (grp >> 1) & 31, pair = xcd * 3 + (int)(grp >> 6);
        const int h = pair & 7, sq = pair >> 3;
        const int qi = lane & 15, quad = lane >> 4;
        const int tq = sq * SEQL + 256 * blk + r + 16 * qi;
        QF qf;
        { const int pos = 256 * blk + r + 16 * qi;
          const bf16_t* qa = Qp + ((size_t)(sq * 24 + h) * SEQL + pos) * 64 + quad * 8;
          const bf16_t* qb = Qp + ((size_t)(sq * 24 + 8 + h) * SEQL + (pos & 3) * 2048 + (pos >> 2)) * 64 + quad * 8;
          const bf16_t* qc = Qp + ((size_t)(sq * 24 + 16 + h) * SEQL + (pos & 15) * 512 + (pos >> 4)) * 64 + quad * 8;
          qf.a0 = *(const bf16x8*)qa; qf.a1 = *(const bf16x8*)(qa + 32); qf.b0 = *(const bf16x8*)qb; qf.b1 = *(const bf16x8*)(qb + 32); qf.c0 = *(const bf16x8*)qc; qf.c1 = *(const bf16x8*)(qc + 32); }
        f32x4 o[4];
#pragma unroll
        for (int dt = 0; dt < 4; ++dt) o[dt] = (f32x4){0.f, 0.f, 0.f, 0.f};
        float mrun = -1e30f, lrun = 0.f;
        u32x2 zpre[4];
#pragma unroll
        for (int dt = 0; dt < 4; ++dt) zpre[dt] = *(const u32x2*)(ZA + (size_t)tq * 512 + h * 64 + 16 * dt + 4 * quad);
        KVBuf b0, b1;
#define ATT_SB __builtin_amdgcn_sched_barrier(0);
        {
            const int wv = tid >> 6, region = wv >> 1;
            const bf16_t* gsrc = (region < 2 ? Kp + (size_t)(sq * 24 + h) * SEQL * 64 : Vt + (size_t)((sq * 3) * 8 + h) * 512 * 1024) + (wv & 1) * 512 + lane * 8;
            const int ubase = 256 * blk - 64 + (region & 1) * 16;
#define ATT_DMA(S) do { int uT = ubase + 32 * (S); if (uT < 0 || uT >= SEQL) uT = 0; \
                __builtin_amdgcn_global_load_lds((const unsigned*)(gsrc + (size_t)(uT >> 4) * 1024), (LAS unsigned*)(lds + (((S) >> 1) % 3) * 16384 + ((S) & 1) * 8192 + wv * 1024), 16, 0, 0); } while (0)
            ATT_DMA(0); ATT_DMA(1); ATT_DMA(2); ATT_DMA(3);
            const int kl = lane & 15;
            const unsigned foff = (unsigned)(quad * 256 + kl * 16), voff = (unsigned)(4096 + quad * 128 + kl * 8);
#pragma unroll 1
            for (int d = 0; d < 6; ++d) {
                if (d < 5) asm volatile("s_waitcnt vmcnt(2)" ::: "memory"); else asm volatile("s_waitcnt vmcnt(0)" ::: "memory");
                __syncthreads();
                if (d + 2 < 6) { ATT_DMA(2 * d + 4); ATT_DMA(2 * d + 5); }
                LAS unsigned char* kb = lds + (d % 3) * 16384;
                b0.kA0 = *(const LAS bf16x8*)(kb + foff); b0.kA1 = *(const LAS bf16x8*)(kb + foff + 1024); b0.kB0 = *(const LAS bf16x8*)(kb + 2048 + foff); b0.kB1 = *(const LAS bf16x8*)(kb + 2048 + foff + 1024);
                b1.kA0 = *(const LAS bf16x8*)(kb + 8192 + foff); b1.kA1 = *(const LAS bf16x8*)(kb + 8192 + foff + 1024); b1.kB0 = *(const LAS bf16x8*)(kb + 8192 + 2048 + foff); b1.kB1 = *(const LAS bf16x8*)(kb + 8192 + 2048 + foff + 1024);
#pragma unroll
                for (int dt = 0; dt < 4; ++dt) { b0.vA[dt] = *(const LAS bf16x4*)(kb + voff + dt * 512); b0.vB[dt] = *(const LAS bf16x4*)(kb + 2048 + voff + dt * 512);
                                                 b1.vA[dt] = *(const LAS bf16x4*)(kb + 8192 + voff + dt * 512); b1.vB[dt] = *(const LAS bf16x4*)(kb + 8192 + 2048 + voff + dt * 512); }
                attn_compute2<0>(b0, b1, qf.a0, qf.a1, o, mrun, lrun, 2 * d, blk, r, lane);
            }
#undef ATT_DMA
        }
        attn_load(b0, Kp, Vt, 12, sq, h, blk, r, lane);
#define ATT_LOOP(GI, S0, S1, QA, QB) _Pragma("unroll 1") for (int s = S0; s < S1; s += 2) { \
            ATT_SB attn_load(b1, Kp, Vt, s + 1, sq, h, blk, r, lane); ATT_SB attn_compute<GI>(b0, QA, QB, o, mrun, lrun, s, blk, r, lane); \
            ATT_SB attn_load(b0, Kp, Vt, s + 2, sq, h, blk, r, lane); ATT_SB attn_compute<GI>(b1, QA, QB, o, mrun, lrun, s + 1, blk, r, lane); ATT_SB }
        ATT_LOOP(1, 12, 18, qf.b0, qf.b1)
        ATT_LOOP(2, 18, 22, qf.c0, qf.c1)
#undef ATT_LOOP
        attn_compute<2>(b0, qf.c0, qf.c1, o, mrun, lrun, 22, blk, r, lane);
        const float l = quad_sum(lrun);
        float inv = 1.0f / l;
#ifdef DBG_ATT1
        for (int dt = 0; dt < 4; ++dt) o[dt] = (f32x4){1.f, 1.f, 1.f, 1.f};
#endif
#pragma unroll
        for (int dt = 0; dt < 4; ++dt) {
            const size_t off = (size_t)tq * 512 + h * 64 + 16 * dt + 4 * quad;
            const u32x2 z = zpre[dt];
            u32x2 w; w.x = cvt_pk_bf16(o[dt][0] * inv * bf_lo(z.x), o[dt][1] * inv * bf_hi(z.x)); w.y = cvt_pk_bf16(o[dt][2] * inv * bf_lo(z.y), o[dt][3] * inv * bf_hi(z.y));
            *(u32x2*)(GAO + off) = w;
        }
    }
}

__device__ __forceinline__ f32x2 cmul(f32x2 a, f32x2 b) { return (f32x2){a.x * b.x - a.y * b.y, a.x * b.y + a.y * b.x}; }
__device__ __forceinline__ void step_scan(const Args& a, LAS unsigned char* lds, int tid, int it0, int it1, int itstep) {
    unsigned char* ws = a.ws; const int G = gridDim.x;
    const float* PW = (const float*)(ws + WS_PW); const float* S = (const float*)(ws + WS_S); bf16_t* UH = (bf16_t*)(ws + WS_UH);
    LAS f32x2* carry = (LAS f32x2*)lds;
    for (int it = it0; it < it1; it += itstep) {
        const int dir = it & 1, g = (it >> 1) & 31, sq = it >> 6; const int seg = tid >> 6, n = tid & 63;
        const f32x2 P = (f32x2){PW[((dir * 32 + g) * 64 + n) * 2], PW[((dir * 32 + g) * 64 + n) * 2 + 1]};
        f32x2 z[32];
        { const int c0 = dir ? (NCH - 1 - seg * 32) : seg * 32; const long stp = dir ? -256 : 256;
          const float* sp = S + ((size_t)g * CHP + sq * NCH + c0) * 256 + dir * 128 + n;
#pragma unroll
          for (int i = 0; i < 32; ++i) { z[i] = (f32x2){sp[0], sp[64]}; sp += stp; } }
        f32x2 zz = (f32x2){0.f, 0.f};
#pragma unroll
        for (int i = 0; i < 32; ++i) { const f32x2 t = z[i]; z[i] = zz; zz = cmul(P, zz) + t; }
        __syncthreads();
        carry[seg * 64 + n] = zz;
        __syncthreads();
        f32x2 P32 = P;
#pragma unroll
        for (int k = 0; k < 5; ++k) P32 = cmul(P32, P32);
        f32x2 x = (f32x2){0.f, 0.f};
        for (int sp = 0; sp < seg; ++sp) x = cmul(P32, x) + carry[sp * 64 + n];
        f32x2 pwr = (f32x2){1.f, 0.f};
        { const int c0 = dir ? (NCH - 1 - seg * 32) : seg * 32; const long stp = dir ? -(long)UHK : (long)UHK;
          bf16_t* up = UH + ((size_t)g * CHP + sq * NCH + c0) * UHK + 512 + dir * 128 + n;
#pragma unroll
          for (int i = 0; i < 32; ++i) {
              const f32x2 hin = z[i] + cmul(pwr, x);
              up[0] = (bf16_t)(cvt_pk_bf16(hin.x, 0.f) & 0xffffu); up[64] = (bf16_t)(cvt_pk_bf16(hin.y, 0.f) & 0xffffu);
              pwr = cmul(pwr, P); up += stp;
          } }
    }
}

__device__ __forceinline__ void step_final_norm(const Args& a, int pass, int tid, int bx) {
    const int lane = tid & 63, wave = tid >> 6, G = gridDim.x;
    const f32x4* gr = (const f32x4*)a.in[16] + lane;
    f32x4 gv[4];
#pragma unroll
    for (int j = 0; j < 4; ++j) gv[j] = gr[64 * j];
    const bf16_t* accp = (const bf16_t*)(a.ws + WS_ACC);
    int row = bx * 8 + wave;
    f32x4 nx[4]; u32x2 na[4];
    if (row < TP) { const f32x4* xr = (const f32x4*)xrow_ptr(a.in[0], a.in[1], pass * TP + row) + lane; const u32x2* ar = (const u32x2*)(accp + (size_t)row * DM) + lane;
#pragma unroll
        for (int j = 0; j < 4; ++j) { nx[j] = __builtin_nontemporal_load(xr + 64 * j); na[j] = ar[64 * j]; } }
    for (; row < TP; row += G * 8) {
        f32x4 v[4];
#pragma unroll
        for (int j = 0; j < 4; ++j) v[j] = nx[j] + (f32x4){bf_lo(na[j].x), bf_hi(na[j].x), bf_lo(na[j].y), bf_hi(na[j].y)};
        const int nrow = row + G * 8;
        if (nrow < TP) { const f32x4* xn = (const f32x4*)xrow_ptr(a.in[0], a.in[1], pass * TP + nrow) + lane; const u32x2* an = (const u32x2*)(accp + (size_t)nrow * DM) + lane;
#pragma unroll
            for (int j = 0; j < 4; ++j) { nx[j] = __builtin_nontemporal_load(xn + 64 * j); na[j] = an[64 * j]; } }
        float s = 0.f;
#pragma unroll
        for (int j = 0; j < 4; ++j) s += (v[j].x * v[j].x + v[j].y * v[j].y) + (v[j].z * v[j].z + v[j].w * v[j].w);
        const float rstd = 1.0f / sqrtf(wave_sum(s) * (1.f / DM) + EPSN);
        f32x4* xr = (f32x4*)(a.out + (size_t)(pass * TP + row) * DM) + lane;
#pragma unroll
        for (int j = 0; j < 4; ++j) __builtin_nontemporal_store(v[j] * rstd * gv[j], xr + 64 * j);
    }
}


#define XB_TMO      128
#define XB_XCNT(j)  (256  + 64 * (j))
#define XB_XSUB(j)  (1280 + 64 * (j))
#define XB_XGEN(j)  (2304 + 64 * (j))
#define XB_TOP      3328
#define XB_TOPGEN   3392
#define XCD_BAR_WORDS 3456
#define XB_SLOT(b)  (4096 + 2 * (b))
#define XB_SPIN_CAP (1u << 18)
__device__ __forceinline__ unsigned xb_ld(unsigned* p)              { return __hip_atomic_load(p, __ATOMIC_RELAXED, __HIP_MEMORY_SCOPE_AGENT); }
__device__ __forceinline__ unsigned xb_add(unsigned* p, unsigned v) { return __hip_atomic_fetch_add(p, v, __ATOMIC_RELAXED, __HIP_MEMORY_SCOPE_AGENT); }
__device__ __forceinline__ unsigned xb_xcc_id() { return (unsigned)__builtin_amdgcn_s_getreg((3 << 11) | 20) & 0xFu; }
#define XB_SPIN(cond, bar) do { unsigned _sp = 0; while (cond) { __builtin_amdgcn_s_sleep(1); \
    if ((++_sp & 255u) == 0u) { if (xb_ld(&(bar)[XB_TMO])) break; if (_sp > XB_SPIN_CAP) { atomicAdd(&(bar)[XB_TMO], 1u); break; } } } } while (0)
__device__ __forceinline__ void xcd_barrier_complete(unsigned* bar, unsigned x, unsigned& nloc, unsigned& nx) {
    const unsigned G = gridDim.x;
    unsigned sum, cnt, mine, sp = 0u;
    for (;;) {
        sum = 0u; cnt = 0u; mine = 0u;
#pragma unroll
        for (unsigned j = 0; j < 16; ++j) { const unsigned c = xb_ld(&bar[XB_XCNT(j)]); sum += c; cnt += (c > 0u) ? 1u : 0u; mine = (j == x) ? c : mine; }
        if (sum == G) break;
        __builtin_amdgcn_s_sleep(1);
        if ((++sp & 255u) == 0u) { if (xb_ld(&bar[XB_TMO])) break; if (sp > XB_SPIN_CAP) { atomicAdd(&bar[XB_TMO], 1u); break; } }
    }
    nloc = mine > 0u ? mine : 1u; nx = cnt > 0u ? cnt : 1u;
}
__device__ __forceinline__ void xcd_barrier(unsigned* bar) {
    asm volatile("s_waitcnt vmcnt(0)" ::: "memory");
    __syncthreads();
    if (threadIdx.x == 0) {
        __builtin_amdgcn_s_waitcnt(0);
        const unsigned x = xb_xcc_id();
        unsigned* slot = bar + XB_SLOT(blockIdx.x);
        unsigned nloc = xb_ld(slot), nx = xb_ld(slot + 1);
        if (nloc == 0u) { xcd_barrier_complete(bar, x, nloc, nx); __hip_atomic_store(slot, nloc, __ATOMIC_RELAXED, __HIP_MEMORY_SCOPE_AGENT); __hip_atomic_store(slot + 1, nx, __ATOMIC_RELAXED, __HIP_MEMORY_SCOPE_AGENT); }
        const unsigned old = xb_add(&bar[XB_XSUB(x)], 1u);
        const unsigned gen = old / nloc;
        if (old + 1u == (gen + 1u) * nloc) {
            __builtin_amdgcn_fence(__ATOMIC_RELEASE, "agent");
            asm volatile("s_waitcnt vmcnt(0)" ::: "memory");
            const unsigned og = xb_add(&bar[XB_TOP], 1u);
            const unsigned tg = og / nx;
            if (og + 1u == (tg + 1u) * nx) xb_add(&bar[XB_TOPGEN], 1u);
            else XB_SPIN(xb_ld(&bar[XB_TOPGEN]) == tg, bar);
            __builtin_amdgcn_fence(__ATOMIC_ACQUIRE, "agent");
            xb_add(&bar[XB_XGEN(x)], 1u);
            asm volatile("s_waitcnt vmcnt(0)" ::: "memory");
        } else {
            XB_SPIN(xb_ld(&bar[XB_XGEN(x)]) == gen, bar);
            __builtin_amdgcn_fence(__ATOMIC_ACQUIRE, "agent");
            asm volatile("s_waitcnt vmcnt(0)" ::: "memory");
        }
    }
    __syncthreads();
}

constexpr int NSTEPS = 1 + 10 * NPASS;
__host__ __device__ __forceinline__ bool sync_after(int st) { if (st == 0) return true; const int k = (st - 1) % 10; return !(k == 1 || k == 6 || k == 9); }

__global__ void __launch_bounds__(512, 2) fwd_kernel(Args a) {
    extern __shared__ __attribute__((aligned(16))) unsigned char lds_raw[];
    LAS unsigned char* lds = (LAS unsigned char*)lds_raw;
    cg::grid_group grid = cg::this_grid();
    const int G = gridDim.x;
    unsigned char* ws = a.ws;
    unsigned* bar = (unsigned*)(ws + WS_BAR);
    if (a.do_sync == 2) grid.sync();
    if (a.do_sync && threadIdx.x == 0) (void)xb_add(&bar[XB_XCNT(xb_xcc_id())], 1u);
    for (int st = a.st_lo; st < a.st_hi; ++st) {
        int tid = threadIdx.x, bx = blockIdx.x;
        asm volatile("" : "+v"(tid), "+s"(bx));
#ifndef NO_SETUP
        if (st == 0) { step_setup(a, lds, tid, bx); }
#else
        if (st == 0) {}
#endif
        else {
            const int pass = (st - 1) / 10, k = (st - 1) % 10;
            GemmD g; g.lgnN = 0; g.pass = pass; g.nb = 1; g.sA = 0; g.sB = 0;
            bool has_gemm = true;
            const bool fz = (G == 256);
            const bool split_ay = false;
            const bf16_t* sgp = (const bf16_t*)((unsigned char*)a.out + OUT_HN_OFF) + (size_t)pass * TP * DM;
#define DESC_Y { g.A = (const bf16_t*)(ws + WS_UH); g.lda = UHK; g.sA = (unsigned)(CHP * UHK * 2); g.Bt = (const bf16_t*)(ws + WS_MTC); g.ldb = UHK; g.sB = (unsigned)(512 * UHK * 2); g.K = UHK; g.nM = CHP / BM; g.nN = 2; g.nb = 32; g.mode = MODE_Y; }
#define DESC_A { g.A = (const bf16_t*)(ws + WS_GAO); g.lda = 512; g.Bt = (const bf16_t*)(ws + WS_WA); g.ldb = 512; g.K = 512; g.nM = TP / BM; g.nN = 4; g.lgnN = 2; g.mode = MODE_A; }
#define DESC_GLU { g.A = sgp; g.lda = 512; g.Bt = (const bf16_t*)(ws + WS_WGLU); g.ldb = 512; g.K = 512; g.nM = TP / BM; g.nN = 2; g.lgnN = 1; g.mode = MODE_GLU; }
#define DESC_NONE { has_gemm = false; g.A = nullptr; g.Bt = nullptr; g.lda = g.ldb = g.K = 0; g.nM = g.nN = 0; g.mode = 0; }
            switch (k) {
            case 0: g.A = (const bf16_t*)((unsigned char*)a.out + OUT_HN_OFF) + (size_t)pass * TP * DM; g.lda = DM; g.Bt = (const bf16_t*)(ws + WS_WIN); g.ldb = DM; g.K = DM; g.nM = TP / BM; g.nN = INC / BM; g.lgnN = 5; g.mode = MODE_PROJ; break;
            case 1: g.A = (const bf16_t*)(ws + WS_UH); g.lda = UHK; g.sA = (unsigned)(CHP * UHK * 2); g.Bt = (const bf16_t*)(ws + WS_BST); g.ldb = 512; g.sB = (unsigned)(256 * 512 * 2); g.K = 512; g.nM = CHP / BM; g.nN = 1; g.nb = 32; g.mode = MODE_S; break;
            case 2: if (fz) DESC_Y else DESC_NONE break;
            case 4: if (fz) { if (bx < 128) DESC_A else DESC_GLU } else DESC_Y break;
            case 5: if (fz) DESC_NONE else DESC_GLU break;
            case 6: if (fz) DESC_NONE else DESC_A break;
            case 7: g.A = (const bf16_t*)(ws + WS_SB); g.lda = 512; g.Bt = (const bf16_t*)(ws + WS_WB); g.ldb = 512; g.K = 512; g.nM = TP / BM; g.nN = 4; g.lgnN = 2; g.mode = MODE_B; break;
            case 8: g.A = (const bf16_t*)(ws + WS_M1); g.lda = 1024; g.Bt = (const bf16_t*)(ws + WS_WOUT); g.ldb = 1024; g.K = 1024; g.nM = TP / BM; g.nN = 4; g.lgnN = 2; g.mode = MODE_OUT; break;
            default: DESC_NONE break;
            }
#undef DESC_Y
#undef DESC_A
#undef DESC_GLU
#undef DESC_NONE
            { const int total = g.nM * g.nN * g.nb; g.u0 = bx; g.ustride = G; g.ucount = total > bx ? (total - bx + G - 1) / G : 0; }
            if (fz && k == 2) { g.u0 = (bx / SEQP) * 6 + (bx % SEQP); g.ustride = SEQP; g.ucount = bx < SEQP * 32 ? 2 : 0; }
            if (fz && k == 4) { if (bx < 128) { g.u0 = bx; g.ustride = 128; g.ucount = 3; } else { g.u0 = bx - 128; g.ustride = 128; g.ucount = (bx - 128) < 64 ? 2 : 1; } }
            const bool fuse_scan = (G >= SEQP * 32);
            if (has_gemm) {
#ifndef NO_GEMM
                gemm_phase(a, lds, g, G, bx, tid);
#endif
#ifndef NO_SCAN
                if (k == 1 && fuse_scan && bx < SEQP * 32) {
                    asm volatile("s_waitcnt vmcnt(0)" ::: "memory"); __syncthreads();
                    const int it0 = (bx % SEQP) * 64 + (bx / SEQP) * 2;
                    step_scan(a, lds, tid, it0, it0 + 2, 1);
                    asm volatile("s_waitcnt vmcnt(0)" ::: "memory"); __syncthreads();
                }
#endif
            }
#ifndef NO_ATTN
            else if (k == (fz ? 3 : 2)) step_attention(a, lds, pass, tid, bx);
#endif
#ifndef NO_SCAN
            else if (k == 3 && !fz && !fuse_scan) step_scan(a, lds, tid, bx, SEQP * 32 * 2, G);
#endif
            else if (k == 9) step_final_norm(a, pass, tid, bx);
        }
        { bool need = sync_after(st) && !(st > 0 && (st - 1) % 10 == 3 && G >= SEQP * 32);
          if (G == 256 && st > 0) { const int kk = (st - 1) % 10; need = (kk == 0 || kk == 3 || kk == 4 || kk == 7 || kk == 8); }
          if (a.do_sync && st + 1 < a.st_hi && need) xcd_barrier(bar); }
    }
}

extern "C" void kernel_launch(void* const* d_in, const int* in_sizes, int n_in, void* d_out, int out_size, void* d_ws, size_t ws_size, hipStream_t stream) {
    constexpr int LDS_BYTES = STAGE_BYTES + 32768;
    static int grid = 0;
    if (grid == 0) {
        if (n_in != 17 || out_size != TTOK * DM || ws_size < WS_END) { fprintf(stderr, "kernel_launch: unexpected shapes (n_in %d out %d ws %zu need %zu)\n", n_in, out_size, ws_size, (size_t)WS_END); grid = -1; return; }
        int dev = 0, cus = 0, per_cu = 0;
        hipGetDevice(&dev); hipDeviceGetAttribute(&cus, hipDeviceAttributeMultiprocessorCount, dev);
        hipFuncSetAttribute((const void*)fwd_kernel, hipFuncAttributeMaxDynamicSharedMemorySize, LDS_BYTES);
        hipOccupancyMaxActiveBlocksPerMultiprocessor(&per_cu, (const void*)fwd_kernel, 512, LDS_BYTES);
        if (per_cu < 1) per_cu = 1;
        grid = cus * 1;
        (void)hipGetLastError();
    }
    if (grid < 0) return;
    (void)hipMemsetAsync((unsigned char*)d_ws + WS_BAR, 0, WS_BAR_BYTES + 4096, stream);
    Args a{};
    for (int i = 0; i < 17; ++i) a.in[i] = (const float*)d_in[i];
    a.out = (float*)d_out; a.ws = (unsigned char*)d_ws; a.pad = 0;
#ifndef MULTI_LAUNCH
#define MULTI_LAUNCH 0
#endif
#if MULTI_LAUNCH
    a.do_sync = 0;
    for (int st = 0; st < NSTEPS; ++st) {
        a.st_lo = st; a.st_hi = st + 1;
        hipLaunchKernelGGL(fwd_kernel, dim3(grid), dim3(512), LDS_BYTES, stream, a);
    }
#else
    a.do_sync = 1; a.st_lo = 0; a.st_hi = NSTEPS;
    void* args[] = {&a};
    hipError_t e = hipLaunchCooperativeKernel((const void*)fwd_kernel, dim3(grid), dim3(512), args, LDS_BYTES, stream);
    if (e != hipSuccess) fprintf(stderr, "cooperative launch failed: %s (grid %d)\n", hipGetErrorString(e), grid);
#endif
}
```
